# Optimizing an MI355X kernel written in HIP

```python
import math
import jax, jax.numpy as jnp
from jax import lax
import numpy as np

D_MODEL = 1024
BATCH = 16
SEQ = 2048
DEPTH = 2

N_MIXERS = 2
N_LAYERS_A = (DEPTH + 1) // 2
N_LAYERS_B = DEPTH // 2

A_HEADS = 4
A_QK_DIM = D_MODEL // (2 * A_HEADS)
A_V_DIM = D_MODEL // A_HEADS
A_CHUNK = 128
A_HQ = A_HEADS * A_QK_DIM
A_HV = A_HEADS * A_V_DIM
A_IN_COLS = 2 * A_HQ + 2 * A_HV + 2 * A_HEADS

B_HEADS = 8
B_HEAD_DIM = D_MODEL // (2 * B_HEADS)
B_V_DIM = 2 * B_HEAD_DIM
B_ROT_DIM = B_HEAD_DIM // 4
ROPE_THETA = 500000.0
Q_BLOCK = 128
B_IN_COLS = 3 * D_MODEL

N_EXPERTS = 16
N_GROUPS = 4
EXPERTS_PER_GROUP = N_EXPERTS // N_GROUPS
TOP_K = 2
D_EXPERT = 512
MOE_BLOCK = 128

EPS = 1e-6

kernel_name = "hybrid_mlstm_diffattn_grouped_moe"


def _rms(x, g):
    xf = x.astype(jnp.float32)
    y = xf * lax.rsqrt(jnp.mean(xf * xf, axis=-1, keepdims=True) + EPS)
    return y * g.astype(jnp.float32)


def _chunks(t):
    b_, h_, s_ = t.shape[:3]
    t = t.reshape(b_, h_, s_ // A_CHUNK, A_CHUNK, *t.shape[3:])
    return jnp.moveaxis(t, 2, 0)


def _mlstm_chunkwise(q, k, v, i_pre, log_f):
    b_, h_, s_, dk = q.shape
    dv = v.shape[-1]
    causal = jnp.tril(jnp.ones((A_CHUNK, A_CHUNK), dtype=bool))

    def step(carry, inp):
        C, n, m = carry
        qc, kc, vc, ic, fc = inp
        b = jnp.cumsum(fc, axis=-1)
        log_d = b[..., :, None] - b[..., None, :] + ic[..., None, :]
        log_d = jnp.where(causal, log_d, -jnp.inf)
        log_inter = b + m[..., None]
        m_t = jnp.maximum(jnp.max(log_d, axis=-1), log_inter)
        d = jnp.exp(log_d - m_t[..., None])
        inter = jnp.exp(log_inter - m_t)
        s = jnp.einsum('bhtd,bhsd->bhts', qc, kc) * d
        num = jnp.einsum('bhts,bhsv->bhtv', s, vc) + inter[..., None] * jnp.einsum('bhtd,bhdv->bhtv', qc, C)
        den = jnp.sum(s, axis=-1) + inter * jnp.einsum('bhtd,bhd->bht', qc, n)
        h = num / jnp.maximum(jnp.abs(den), jnp.exp(-m_t))[..., None]
        b_last = b[..., -1]
        log_w = b_last[..., None] - b + ic
        m_new = jnp.maximum(b_last + m, jnp.max(log_w, axis=-1))
        w = jnp.exp(log_w - m_new[..., None])
        decay = jnp.exp(b_last + m - m_new)
        kw = kc * w[..., None]
        C_new = decay[..., None, None] * C + jnp.einsum('bhsd,bhsv->bhdv', kw, vc)
        n_new = decay[..., None] * n + jnp.sum(kw, axis=2)
        return (C_new, n_new, m_new), h

    init = (jnp.zeros((b_, h_, dk, dv), jnp.float32), jnp.zeros((b_, h_, dk), jnp.float32),
            jnp.zeros((b_, h_), jnp.float32))
    _, hs = lax.scan(step, init, (_chunks(q), _chunks(k), _chunks(v), _chunks(i_pre), _chunks(log_f)))
    return jnp.moveaxis(hs, 0, 2).reshape(b_, h_, s_, dv)


def _mlstm_mixer(h, w_in, b_if, h_norm, w_out):
    b_, s_, _ = h.shape
    proj = h @ w_in.astype(h.dtype)
    q = proj[..., :A_HQ].reshape(b_, s_, A_HEADS, A_QK_DIM)
    k = proj[..., A_HQ:2 * A_HQ].reshape(b_, s_, A_HEADS, A_QK_DIM)
    v = proj[..., 2 * A_HQ:2 * A_HQ + A_HV].reshape(b_, s_, A_HEADS, A_V_DIM)
    o = proj[..., 2 * A_HQ + A_HV:2 * A_HQ + 2 * A_HV]
    gates = proj[..., 2 * A_HQ + 2 * A_HV:].astype(jnp.float32) + b_if.astype(jnp.float32)
    i_pre = jnp.transpose(gates[..., :A_HEADS], (0, 2, 1))
    log_f = jax.nn.log_sigmoid(jnp.transpose(gates[..., A_HEADS:], (0, 2, 1)))
    q = jnp.transpose(q, (0, 2, 1, 3)).astype(jnp.float32)
    k = jnp.transpose(k, (0, 2, 1, 3)).astype(jnp.float32) * (A_QK_DIM ** -0.5)
    v = jnp.transpose(v, (0, 2, 1, 3)).astype(jnp.float32)
    hout = _mlstm_chunkwise(q, k, v, i_pre, log_f)
    hout = _rms(jnp.transpose(hout, (0, 2, 1, 3)), h_norm.reshape(A_HEADS, A_V_DIM))
    hout = hout.reshape(b_, s_, A_HV) * jax.nn.sigmoid(o.astype(jnp.float32))
    return hout.astype(h.dtype) @ w_out.astype(h.dtype)


def _partial_rope(t, positions):
    half = B_ROT_DIM // 2
    inv_freq = ROPE_THETA ** (-jnp.arange(0, B_ROT_DIM, 2, dtype=jnp.float32) / B_ROT_DIM)
    ang = positions.astype(jnp.float32)[..., None] * inv_freq
    cos = jnp.cos(ang)[:, :, None, None, :]
    sin = jnp.sin(ang)[:, :, None, None, :]
    x1 = t[..., :half]
    x2 = t[..., half:B_ROT_DIM]
    return jnp.concatenate([x1 * cos - x2 * sin, x2 * cos + x1 * sin, t[..., B_ROT_DIM:]], axis=-1)


def _diff_attention(h, positions, w_in, q_norm, k_norm, lam_q1, lam_k1, lam_q2, lam_k2, o_norm, w_out, layer_idx):
    b_, s_, _ = h.shape
    proj = h @ w_in.astype(h.dtype)
    q = proj[..., :D_MODEL].reshape(b_, s_, B_HEADS, 2, B_HEAD_DIM)
    k = proj[..., D_MODEL:2 * D_MODEL].reshape(b_, s_, B_HEADS, 2, B_HEAD_DIM)
    v = proj[..., 2 * D_MODEL:].reshape(b_, s_, B_HEADS, B_V_DIM).astype(jnp.float32)
    q = _partial_rope(_rms(q, q_norm), positions)
    k = _partial_rope(_rms(k, k_norm), positions)
    q = jnp.transpose(q, (0, 2, 3, 1, 4)) * (B_HEAD_DIM ** -0.5)
    k = jnp.transpose(k, (0, 2, 3, 1, 4))
    v = jnp.transpose(v, (0, 2, 1, 3))
    lam_init = 0.8 - 0.6 * math.exp(-0.3 * layer_idx)
    lam = (jnp.exp(jnp.sum(lam_q1.astype(jnp.float32) * lam_k1.astype(jnp.float32)))
           - jnp.exp(jnp.sum(lam_q2.astype(jnp.float32) * lam_k2.astype(jnp.float32))) + lam_init)
    outs = []
    for j in range(s_ // Q_BLOCK):
        s0 = j * Q_BLOCK
        e = s0 + Q_BLOCK
        sc = jnp.einsum('bhcqd,bhckd->bhcqk', q[:, :, :, s0:e], k[:, :, :, :e])
        mask = (s0 + jnp.arange(Q_BLOCK))[:, None] >= jnp.arange(e)[None, :]
        p = jax.nn.softmax(jnp.where(mask, sc, -jnp.inf), axis=-1)
        a = p[:, :, 0] - lam * p[:, :, 1]
        outs.append(jnp.einsum('bhqk,bhkv->bhqv', a, v[:, :, :e]))
    o = jnp.concatenate(outs, axis=2)
    o = _rms(o, o_norm) * (1.0 - lam_init)
    o = jnp.transpose(o, (0, 2, 1, 3)).reshape(b_, s_, D_MODEL)
    return o.astype(h.dtype) @ w_out.astype(h.dtype)


def _grouped_moe(h, w_router, router_bias, w_gu, w_down):
    b_, s_, d_ = h.shape
    n_tok = b_ * s_
    xt = h.reshape(n_tok, d_)
    scores = jax.nn.sigmoid((xt @ w_router.astype(h.dtype)).astype(jnp.float32))
    biased = (scores + router_bias.astype(jnp.float32)).reshape(n_tok, N_GROUPS, EXPERTS_PER_GROUP)
    grp_score = jnp.sum(lax.top_k(biased, 2)[0], axis=-1)
    g_sel = jnp.argmax(grp_score, axis=-1)
    in_grp = jnp.take_along_axis(biased, g_sel[:, None, None], axis=1)[:, 0]
    _, local_idx = lax.top_k(in_grp, TOP_K)
    expert_idx = g_sel[:, None].astype(jnp.int32) * EXPERTS_PER_GROUP + local_idx.astype(jnp.int32)
    gate_w = jnp.take_along_axis(scores, expert_idx, axis=1)
    gate_w = gate_w / jnp.sum(gate_w, axis=-1, keepdims=True)
    n_assign = n_tok * TOP_K
    n_blocks = (n_assign + N_EXPERTS * (MOE_BLOCK - 1) + MOE_BLOCK - 1) // MOE_BLOCK
    cap = n_blocks * MOE_BLOCK
    flat_e = expert_idx.reshape(n_assign)
    flat_tok = jnp.repeat(jnp.arange(n_tok, dtype=jnp.int32), TOP_K)
    order = jnp.argsort(flat_e, stable=True)
    sorted_e = flat_e[order]
    sorted_tok = flat_tok[order]
    sorted_w = gate_w.reshape(n_assign)[order]
    counts = jnp.bincount(flat_e, length=N_EXPERTS).astype(jnp.int32)
    starts = jnp.cumsum(counts) - counts
    padded = ((counts + MOE_BLOCK - 1) // MOE_BLOCK) * MOE_BLOCK
    pad_ends = jnp.cumsum(padded)
    pad_starts = pad_ends - padded
    dest = pad_starts[sorted_e] + (jnp.arange(n_assign, dtype=jnp.int32) - starts[sorted_e])
    buf_tok = jnp.full((cap,), n_tok, jnp.int32).at[dest].set(sorted_tok)
    x_pad = jnp.concatenate([xt, jnp.zeros((1, d_), xt.dtype)], axis=0)
    xb = x_pad[buf_tok].reshape(n_blocks, MOE_BLOCK, d_)
    block_e = jnp.minimum(jnp.searchsorted(pad_ends, jnp.arange(n_blocks, dtype=jnp.int32) * MOE_BLOCK, side='right'),
                          N_EXPERTS - 1)

    def expert_block(args):
        xblk, e = args
        gu = xblk @ w_gu[e].astype(xblk.dtype)
        act = jax.nn.silu(gu[:, :D_EXPERT]) * gu[:, D_EXPERT:]
        return act @ w_down[e].astype(xblk.dtype)

    yb = lax.map(expert_block, (xb, block_e)).reshape(cap, d_)
    contrib = yb[dest].astype(jnp.float32) * sorted_w[:, None]
    y = jax.ops.segment_sum(contrib, sorted_tok, num_segments=n_tok)
    return y.reshape(b_, s_, d_).astype(h.dtype)


def setup_inputs(seed: int = 0) -> dict:
    key = jax.random.key(seed)
    ks = jax.random.split(key, 24)
    f32 = jnp.float32
    nrm = lambda k, shape, s: jax.random.normal(k, shape, f32) * s
    offs = jax.random.randint(ks[2], (BATCH, 1), 0, 4096, dtype=jnp.int32)
    positions = offs + jnp.arange(SEQ, dtype=jnp.int32)[None, :]
    f_bias = jnp.linspace(3.0, 6.0, A_HEADS, dtype=f32)[None, :] + nrm(ks[8], (N_LAYERS_A, A_HEADS), 0.1)
    i_bias = nrm(ks[9], (N_LAYERS_A, A_HEADS), 0.1)
    return {
        "x": nrm(ks[0], (BATCH, SEQ, D_MODEL), 1.0),
        "c": nrm(ks[1], (BATCH, D_MODEL), 1.0),
        "positions": positions,
        "norm1": 1.0 + nrm(ks[3], (DEPTH, D_MODEL), 0.02),
        "norm2": 1.0 + nrm(ks[4], (DEPTH, D_MODEL), 0.02),
        "w_ada": nrm(ks[5], (DEPTH, D_MODEL, 6 * D_MODEL), 0.5 * D_MODEL ** -0.5),
        "b_ada": nrm(ks[6], (DEPTH, 6 * D_MODEL), 0.02),
        "a_w_in": nrm(ks[7], (N_LAYERS_A, D_MODEL, A_IN_COLS), D_MODEL ** -0.5),
        "a_b_if": jnp.concatenate([i_bias, f_bias], axis=-1),
        "a_h_norm": 1.0 + nrm(ks[10], (N_LAYERS_A, A_HV), 0.02),
        "a_w_out": nrm(ks[11], (N_LAYERS_A, A_HV, D_MODEL), A_HV ** -0.5),
        "b_w_in": nrm(ks[12], (N_LAYERS_B, D_MODEL, B_IN_COLS), D_MODEL ** -0.5),
        "b_q_norm": 1.0 + nrm(ks[13], (N_LAYERS_B, B_HEAD_DIM), 0.02),
        "b_k_norm": 1.0 + nrm(ks[14], (N_LAYERS_B, B_HEAD_DIM), 0.02),
        "b_lam_q1": nrm(ks[15], (N_LAYERS_B, B_HEAD_DIM), 0.1),
        "b_lam_k1": nrm(ks[16], (N_LAYERS_B, B_HEAD_DIM), 0.1),
        "b_lam_q2": nrm(ks[17], (N_LAYERS_B, B_HEAD_DIM), 0.1),
        "b_lam_k2": nrm(ks[18], (N_LAYERS_B, B_HEAD_DIM), 0.1),
        "b_o_norm": 1.0 + nrm(ks[19], (N_LAYERS_B, B_V_DIM), 0.02),
        "b_w_out": nrm(ks[20], (N_LAYERS_B, D_MODEL, D_MODEL), D_MODEL ** -0.5),
        "w_router": nrm(ks[21], (D_MODEL, N_EXPERTS), D_MODEL ** -0.5),
        "router_bias": nrm(ks[22], (N_EXPERTS,), 0.01),
        "moe_w_gu": nrm(ks[23], (DEPTH, N_EXPERTS, D_MODEL, 2 * D_EXPERT), D_MODEL ** -0.5),
        "moe_w_down": nrm(jax.random.fold_in(key, 99), (DEPTH, N_EXPERTS, D_EXPERT, D_MODEL), D_EXPERT ** -0.5),
    }


def reference(x, c, positions, norm1, norm2, w_ada, b_ada, a_w_in, a_b_if, a_h_norm, a_w_out,
              b_w_in, b_q_norm, b_k_norm, b_lam_q1, b_lam_k1, b_lam_q2, b_lam_k2, b_o_norm, b_w_out,
              w_router, router_bias, moe_w_gu, moe_w_down):
    c_act = jax.nn.silu(c.astype(jnp.float32))
    for l in range(DEPTH):
        mod = (c_act @ w_ada[l].astype(jnp.float32) + b_ada[l].astype(jnp.float32))[:, None, :]
        sh1, sc1, g1, sh2, sc2, g2 = jnp.split(mod, 6, axis=-1)
        h = (_rms(x, norm1[l]) * (1.0 + sc1) + sh1).astype(x.dtype)
        j = l // N_MIXERS
        if l % N_MIXERS == 0:
            y = _mlstm_mixer(h, a_w_in[j], a_b_if[j], a_h_norm[j], a_w_out[j])
        else:
            y = _diff_attention(h, positions, b_w_in[j], b_q_norm[j], b_k_norm[j], b_lam_q1[j], b_lam_k1[j],
                                b_lam_q2[j], b_lam_k2[j], b_o_norm[j], b_w_out[j], l)
        x = (x.astype(jnp.float32) + g1 * y.astype(jnp.float32)).astype(x.dtype)
        h = (_rms(x, norm2[l]) * (1.0 + sc2) + sh2).astype(x.dtype)
        y = _grouped_moe(h, w_router, router_bias, moe_w_gu[l], moe_w_down[l])
        x = (x.astype(jnp.float32) + g2 * y.astype(jnp.float32)).astype(x.dtype)
    return x
```

```cpp
#include <hip/hip_runtime.h>
#include <hip/hip_cooperative_groups.h>
#include <hip/hip_bf16.h>
#include <cstdio>
#include <cstdint>
#include <cmath>
namespace cg = cooperative_groups;

#define GAS __attribute__((address_space(1)))
#define LAS __attribute__((address_space(3)))
typedef unsigned short bf16_t;
typedef float f32x4 __attribute__((ext_vector_type(4)));
typedef float f32x2 __attribute__((ext_vector_type(2)));
typedef short bf16x8 __attribute__((ext_vector_type(8)));
typedef short s16x4 __attribute__((ext_vector_type(4)));
typedef unsigned u32x4 __attribute__((ext_vector_type(4)));
typedef unsigned u32x2 __attribute__((ext_vector_type(2)));
typedef __bf16 bf16x2_t __attribute__((ext_vector_type(2)));

constexpr int NTOK = 32768, DM = 1024, SEQ = 2048, NB = 16;
constexpr int NEXP = 16, DEXP = 512;
constexpr int NTHREADS = 512, NWAVES = 8;
constexpr int LDS_BYTES = 147456;
constexpr int MISC_OFF = LDS_BYTES - 128;
constexpr int TAB_OFF = 131072;
constexpr float EPS = 1e-6f;
constexpr int MAXTILES = 272, CAP = MAXTILES * 256;

constexpr size_t MiB = 1u << 20;
constexpr size_t WS_CTL = 0, CTL_BYTES = 1 * MiB;
constexpr int CW_BAR = 4096;
constexpr size_t WS_MOD = 1 * MiB;
constexpr size_t WS_ROUTE = 2 * MiB;
constexpr size_t RT_BLKCNT = WS_ROUTE;
constexpr size_t RT_INFO = WS_ROUTE + 64 * 1024;
constexpr size_t RT_W = RT_INFO + 128 * 1024;
constexpr size_t RT_DEST = RT_W + 256 * 1024;
constexpr size_t RT_BUFTOK = RT_DEST + 256 * 1024;
constexpr size_t RT_META = RT_BUFTOK + 320 * 1024;
constexpr size_t WS_GATES = 4 * MiB;
constexpr size_t WS_WAIN = 6 * MiB, WS_WAOUT = 12 * MiB, WS_WBIN = 14 * MiB, WS_WBOUT = 20 * MiB;
constexpr size_t WS_WGU = 22 * MiB;
constexpr size_t WS_WDN = 86 * MiB;
constexpr size_t WS_H = 118 * MiB;
constexpr size_t WS_PROJ = 184 * MiB;
constexpr size_t WS_HOUT = 376 * MiB;
constexpr size_t WS_END = 504 * MiB;

__device__ __forceinline__ unsigned cvtpk(float lo, float hi) { f32x2 v = {lo, hi}; bf16x2_t b = __builtin_convertvector(v, bf16x2_t); return __builtin_bit_cast(unsigned, b); }
__device__ __forceinline__ float bf2f(unsigned short h) { return __uint_as_float(((unsigned)h) << 16); }
__device__ __forceinline__ float bflo(unsigned w) { return __uint_as_float(w << 16); }
__device__ __forceinline__ float bfhi(unsigned w) { return __uint_as_float(w & 0xffff0000u); }
__device__ __forceinline__ float wave_sum(float v) {
#pragma unroll
    for (int o = 1; o < 64; o <<= 1) v += __shfl_xor(v, o);
    return v;
}
__device__ __forceinline__ float sigmoidf_(float x) { return 1.0f / (1.0f + __expf(-x)); }

#define XB_TMO      128
#define XB_XCNT(j)  (256  + 64 * (j))
#define XB_XSUB(j)  (1280 + 64 * (j))
#define XB_XGEN(j)  (2304 + 64 * (j))
#define XB_TOP      3328
#define XB_TOPGEN   3392
#define XCD_BAR_WORDS 3456
#define XB_SPIN_CAP (1u << 18)
__device__ __forceinline__ unsigned xb_ld(unsigned* p)              { return __hip_atomic_load(p, __ATOMIC_RELAXED, __HIP_MEMORY_SCOPE_AGENT); }
__device__ __forceinline__ unsigned xb_add(unsigned* p, unsigned v) { return __hip_atomic_fetch_add(p, v, __ATOMIC_RELAXED, __HIP_MEMORY_SCOPE_AGENT); }
__device__ __forceinline__ unsigned xb_xcc_id() { return (unsigned)__builtin_amdgcn_s_getreg((3 << 11) | 20) & 0xFu; }
#define XB_SPIN(cond, bar) do { unsigned _sp = 0; while (cond) { __builtin_amdgcn_s_sleep(1); \
    if ((++_sp & 255u) == 0u) { if (xb_ld(&(bar)[XB_TMO])) break; if (_sp > XB_SPIN_CAP) { atomicAdd(&(bar)[XB_TMO], 1u); break; } } } } while (0)
struct XcdBarrier { unsigned* bar; unsigned x; volatile LAS unsigned* st; };
__device__ __forceinline__ XcdBarrier xcd_barrier_post(unsigned* bar, volatile LAS unsigned* st) {
    XcdBarrier b; b.bar = bar; b.x = xb_xcc_id(); b.st = st;
    if (threadIdx.x == 0) (void)xb_add(&bar[XB_XCNT(b.x)], 1u);
    return b;
}
__device__ __forceinline__ void xcd_barrier_complete(unsigned* bar, unsigned x, unsigned& nloc, unsigned& nx) {
    const unsigned G = gridDim.x * gridDim.y * gridDim.z;
    unsigned sum, cnt, mine, sp = 0u;
    for (;;) {
        sum = 0u; cnt = 0u; mine = 0u;
#pragma unroll
        for (unsigned j = 0; j < 16; ++j) { const unsigned c = xb_ld(&bar[XB_XCNT(j)]); sum += c; cnt += (c > 0u) ? 1u : 0u; mine = (j == x) ? c : mine; }
        if (sum == G) break;
        __builtin_amdgcn_s_sleep(1);
        if ((++sp & 255u) == 0u) { if (xb_ld(&bar[XB_TMO])) break; if (sp > XB_SPIN_CAP) { atomicAdd(&bar[XB_TMO], 1u); break; } }
    }
    nloc = mine > 0u ? mine : 1u; nx = cnt > 0u ? cnt : 1u;
}
__device__ __forceinline__ void xcd_barrier(const XcdBarrier& b) {
    asm volatile("s_waitcnt vmcnt(0)" ::: "memory");
    __syncthreads();
    if (threadIdx.x == 0) {
        unsigned* bar = b.bar;
        __builtin_amdgcn_s_waitcnt(0);
        unsigned nloc = b.st[0], nx = b.st[1];
        if (nloc == 0u) { xcd_barrier_complete(bar, b.x, nloc, nx); b.st[0] = nloc; b.st[1] = nx; }
        const unsigned old = xb_add(&bar[XB_XSUB(b.x)], 1u);
        const unsigned gen = old / nloc;
        if (old + 1u == (gen + 1u) * nloc) {
            __builtin_amdgcn_fence(__ATOMIC_RELEASE, "agent");
            asm volatile("s_waitcnt vmcnt(0)" ::: "memory");
            const unsigned og = xb_add(&bar[XB_TOP], 1u);
            const unsigned tg = og / nx;
            if (og + 1u == (tg + 1u) * nx) xb_add(&bar[XB_TOPGEN], 1u);
            else XB_SPIN(xb_ld(&bar[XB_TOPGEN]) == tg, bar);
            __builtin_amdgcn_fence(__ATOMIC_ACQUIRE, "agent");
            xb_add(&bar[XB_XGEN(b.x)], 1u);
            asm volatile("s_waitcnt vmcnt(0)" ::: "memory");
        } else {
            XB_SPIN(xb_ld(&bar[XB_XGEN(b.x)]) == gen, bar);
            __builtin_amdgcn_fence(__ATOMIC_ACQUIRE, "agent");
            asm volatile("s_waitcnt vmcnt(0)" ::: "memory");
        }
    }
    __syncthreads();
}

namespace pg8 {
constexpr int BM = 256, BK = 64, HALF = 128, HTB = HALF * BK * 2, STAGE_BYTES = 8 * HTB, NXCD = 8, WGM = 8;
__device__ __forceinline__ int lds_byte(int r, int c) { const int st = (r >> 4) * 2 + (c >> 5), rr = r & 15, cc = c & 31, ob = rr * 64 + cc * 2; return st * 1024 + (ob ^ (((ob >> 9) & 1) << 5)); }
__device__ __forceinline__ void stage_rc(int b, int& R, int& C) { const int st = b / 1024, sb = b % 1024, swz = sb ^ (((sb >> 9) & 1) << 5); R = (st >> 1) * 16 + swz / 64; C = (st & 1) * 32 + (swz % 64) / 2; }
__device__ __forceinline__ int perm32(int rho) { const int n = rho >> 4, i = rho & 15; return 8 * (i >> 2) + 4 * n + (i & 3); }

struct Unit { int pm, pn, e; };

struct StaticOrder {
    int nM, nN, nwg, G, c;
    __device__ void init(int M, int N, int G_, int c_) { nM = M / BM; nN = N / BM; nwg = nM * nN; G = G_; c = c_; }
    __device__ __forceinline__ bool next(int i, Unit& u) const {
        const long L = (long)i * G + c; if (L >= nwg) return false;
        int wgid = (int)L; { const int q = nwg / NXCD, r = nwg % NXCD, xcd = wgid % NXCD, off = wgid / NXCD; wgid = (xcd < r ? xcd * (q + 1) : r * (q + 1) + (xcd - r) * q) + off; }
        const int nig = WGM * nN, gid = wgid / nig, fm = gid * WGM, gsz = (nM - fm) < WGM ? (nM - fm) : WGM;
        u.pm = __builtin_amdgcn_readfirstlane(fm + ((wgid % nig) % gsz)); u.pn = __builtin_amdgcn_readfirstlane((wgid % nig) / gsz); u.e = 0; return true;
    }
};
struct MoeOrder {
    int G, c, ntiles; const LAS int* ts;
    __device__ __forceinline__ bool next(int i, Unit& u) const {
        const int L = i * G + c; const int tile = L >> 2; if (tile >= ntiles) return false;
        int e = 0;
#pragma unroll
        for (int k = 1; k < 16; ++k) e += (tile >= ts[k]) ? 1 : 0;
        u.pm = __builtin_amdgcn_readfirstlane(tile); u.pn = __builtin_amdgcn_readfirstlane(L & 3); u.e = __builtin_amdgcn_readfirstlane(e); return true;
    }
};

struct EpiBf16 {
    static constexpr bool PERM = true;
    bf16_t* O; int ldc; int s_lo, s_hi; float scale;
    __device__ __forceinline__ void operator()(const f32x4 (&acc)[2][2][4][2], const Unit& u, int wr, int wc, int fr, int fq) const {
        const int row0 = u.pm * BM + wr * 64 + fr; const int col0 = u.pn * BM + wc * 32 + 8 * fq;
        const float sc = (u.pn >= s_lo && u.pn < s_hi) ? scale : 1.0f;
#pragma unroll
        for (int ai = 0; ai < 2; ++ai)
#pragma unroll
            for (int m = 0; m < 4; ++m) { bf16_t* rowp = O + (size_t)(row0 + ai * HALF + m * 16) * ldc + col0;
#pragma unroll
                for (int bj = 0; bj < 2; ++bj) { const f32x4 v0 = acc[ai][bj][m][0] * sc, v1 = acc[ai][bj][m][1] * sc;
                    u32x4 w; w.x = cvtpk(v0[0], v0[1]); w.y = cvtpk(v0[2], v0[3]); w.z = cvtpk(v1[0], v1[1]); w.w = cvtpk(v1[2], v1[3]);
                    *(u32x4*)(rowp + bj * HALF) = w; } }
    }
};
struct EpiSwiGLU {
    static constexpr bool PERM = true;
    bf16_t* O;
    __device__ __forceinline__ void operator()(const f32x4 (&acc)[2][2][4][2], const Unit& u, int wr, int wc, int fr, int fq) const {
        const int row0 = u.pm * BM + wr * 64 + fr; const int col0 = u.pn * 128 + wc * 32 + 8 * fq;
#pragma unroll
        for (int ai = 0; ai < 2; ++ai)
#pragma unroll
            for (int m = 0; m < 4; ++m) { bf16_t* rowp = O + (size_t)(row0 + ai * HALF + m * 16) * DEXP + col0;
                float a[8];
#pragma unroll
                for (int n = 0; n < 2; ++n)
#pragma unroll
                    for (int j = 0; j < 4; ++j) { const float g = acc[ai][0][m][n][j], up = acc[ai][1][m][n][j]; a[n * 4 + j] = g * up / (1.0f + __expf(-g)); }
                u32x4 w; w.x = cvtpk(a[0], a[1]); w.y = cvtpk(a[2], a[3]); w.z = cvtpk(a[4], a[5]); w.w = cvtpk(a[6], a[7]);
                *(u32x4*)rowp = w; }
    }
};
struct EpiResid {
    static constexpr bool PERM = false;
    const float* base; float* out; const float* gate;
    __device__ __forceinline__ void operator()(const f32x4 (&acc)[2][2][4][2], const Unit& u, int wr, int wc, int fr, int fq) const {
        const int row0 = u.pm * BM + wr * 64 + fr, col0 = u.pn * BM + wc * 32 + 4 * fq;
        const int b = (u.pm * BM) / SEQ;
        f32x4 gv[2][2];
#pragma unroll
        for (int bj = 0; bj < 2; ++bj)
#pragma unroll
            for (int n = 0; n < 2; ++n) gv[bj][n] = *(const f32x4*)(gate + (size_t)b * 6144 + col0 + bj * HALF + n * 16);
#pragma unroll
        for (int ai = 0; ai < 2; ++ai)
#pragma unroll
            for (int m = 0; m < 4; ++m) { const size_t off = (size_t)(row0 + ai * HALF + m * 16) * DM + col0;
#pragma unroll
                for (int bj = 0; bj < 2; ++bj)
#pragma unroll
                    for (int n = 0; n < 2; ++n) { const f32x4 bs = *(const f32x4*)(base + off + bj * HALF + n * 16);
                        *(f32x4*)(out + off + bj * HALF + n * 16) = bs + gv[bj][n] * acc[ai][bj][m][n]; }
                asm volatile("" ::: "memory"); }
    }
};

template <class Epi, class Sched, bool GATHER>
__device__ __forceinline__ void gemm_phase(LAS unsigned char* lds, const bf16_t* A, const bf16_t* Bt, size_t bstride, int K, const Sched& S, const Epi& E, const int* aidx) {
    int tid = threadIdx.x; asm volatile("" : "+v"(tid));
    const int wid = __builtin_amdgcn_readfirstlane(tid >> 6), lane = tid & 63, wr = wid >> 2, wc = wid & 3, fr = lane & 15, fq = lane >> 4;
    const int nt = K / BK;
    int RA[2], CA[2]; unsigned voffB[2];
#pragma unroll
    for (int i = 0; i < 2; ++i) { int R, C; stage_rc(tid * 16 + i * 8192, R, C); const int Rb = Epi::PERM ? ((R & ~31) + perm32(R & 31)) : R;
        RA[i] = R; CA[i] = C; voffB[i] = (unsigned)(Rb * K + C) * 2u; }
    const size_t kstep = (size_t)(BK * 2);
    const size_t hstep = (size_t)HALF * K * 2;
    const size_t tstep = 2 * hstep;
    const unsigned ldsw = (unsigned)wid * 1024u;
    const int aoff = lds_byte(wr * 64 + fr, fq * 8), boff = lds_byte(wc * 32 + fr, fq * 8);
#define PG8_SA(b, h) (((b) * 2 + (h)) * HTB)
#define PG8_SB(b, h) ((4 + (b) * 2 + (h)) * HTB)
#define PG8_STAGE(bufoff, gbase, voff) do { _Pragma("unroll") for (int _i = 0; _i < 2; ++_i) \
        __builtin_amdgcn_global_load_lds((const unsigned*)((const char*)(gbase) + (voff)[_i]), (LAS unsigned*)(lds + (bufoff) + ldsw + _i * 8192), 16, 0, 0); } while (0)
#define PG8_LDA(dst, b, h) do { _Pragma("unroll") for (int m = 0; m < 4; ++m) _Pragma("unroll") for (int k = 0; k < 2; ++k) dst[m][k] = *(const LAS bf16x8*)(lds + PG8_SA(b, h) + aoff + m * 2048 + k * 1024); } while (0)
#define PG8_LDB(dst, b, h) do { _Pragma("unroll") for (int n = 0; n < 2; ++n) _Pragma("unroll") for (int k = 0; k < 2; ++k) dst[n][k] = *(const LAS bf16x8*)(lds + PG8_SB(b, h) + boff + n * 2048 + k * 1024); } while (0)
#define PG8_MMA(ai, bj, At, Bt_) do { __builtin_amdgcn_s_setprio(1); _Pragma("unroll") for (int m = 0; m < 4; ++m) _Pragma("unroll") for (int n = 0; n < 2; ++n) _Pragma("unroll") for (int k = 0; k < 2; ++k) \
        acc[ai][bj][m][n] = __builtin_amdgcn_mfma_f32_16x16x32_bf16(Bt_[n][k], At[m][k], acc[ai][bj][m][n], 0, 0, 0); __builtin_amdgcn_s_setprio(0); } while (0)
#define PG8_WAIT_V(n) asm volatile("s_waitcnt vmcnt(" #n ")" ::: "memory")
#define PG8_WAIT_L(n) asm volatile("s_waitcnt lgkmcnt(" #n ")" ::: "memory")
#define PG8_BAR __builtin_amdgcn_s_barrier()
#define PG8_SCHED __builtin_amdgcn_sched_barrier(0)
#define PG8_AOFF(dst, U) do { _Pragma("unroll") for (int _h = 0; _h < 2; ++_h) _Pragma("unroll") for (int _i = 0; _i < 2; ++_i) { \
        const int _row = (U).pm * BM + _h * HALF + RA[_i]; const int _src = GATHER ? aidx[_row] : _row; dst[_h][_i] = (unsigned)(_src * K + CA[_i]) * 2u; } } while (0)
#define PG8_STAGE_A(bufoff, kb, offs, h) do { _Pragma("unroll") for (int _i = 0; _i < 2; ++_i) \
        __builtin_amdgcn_global_load_lds((const unsigned*)((const char*)A + (kb) + (offs)[h][_i]), (LAS unsigned*)(lds + (bufoff) + ldsw + _i * 8192), 16, 0, 0); } while (0)
    Unit cur, nxt; int ui = 0;
    if (!S.next(0, cur)) return;
    f32x4 acc[2][2][4][2];
#pragma unroll
    for (int a = 0; a < 2; ++a)
#pragma unroll
        for (int b = 0; b < 2; ++b)
#pragma unroll
            for (int m = 0; m < 4; ++m)
#pragma unroll
                for (int n = 0; n < 2; ++n) acc[a][b][m][n] = (f32x4){0.f, 0.f, 0.f, 0.f};
    bf16x8 At[4][2], B0[2][2], B1[2][2];
    unsigned ac[2][2], an[2][2];
    PG8_AOFF(ac, cur);
    const char* cB = (const char*)Bt + ((size_t)cur.e * bstride) * 2 + (size_t)cur.pn * tstep;
    PG8_STAGE(PG8_SB(0, 0), cB, voffB); PG8_STAGE(PG8_SB(0, 1), cB + hstep, voffB); PG8_STAGE_A(PG8_SA(0, 0), 0, ac, 0); PG8_STAGE_A(PG8_SA(0, 1), 0, ac, 1);
    if (wr == 1) PG8_BAR;
    PG8_WAIT_V(2); PG8_BAR;
    PG8_STAGE(PG8_SB(1, 0), cB + kstep, voffB); PG8_STAGE_A(PG8_SA(1, 0), kstep, ac, 0); PG8_STAGE(PG8_SB(1, 1), cB + hstep + kstep, voffB);
    PG8_WAIT_V(6); PG8_BAR;
    for (;;) {
        const bool has_next = S.next(ui + 1, nxt);
        if (has_next) { PG8_AOFF(an, nxt); } else {
#pragma unroll
            for (int h = 0; h < 2; ++h)
#pragma unroll
                for (int i = 0; i < 2; ++i) an[h][i] = ac[h][i]; }
        const char* nB = has_next ? (const char*)Bt + ((size_t)nxt.e * bstride) * 2 + (size_t)nxt.pn * tstep : cB;
        for (int t = 0; t < nt; t += 2) {
            const bool last = (t == nt - 2);
            const size_t k1 = (size_t)(t + 1) * kstep;
            const size_t k2 = last ? 0 : (size_t)(t + 2) * kstep;
            const size_t k3 = k2 + kstep;
            const char* b2 = last ? nB : cB + (size_t)(t + 2) * kstep; const char* b3 = b2 + kstep;
            unsigned a2[2][2];
#pragma unroll
            for (int h = 0; h < 2; ++h)
#pragma unroll
                for (int i = 0; i < 2; ++i) a2[h][i] = last ? an[h][i] : ac[h][i];
            PG8_LDB(B0, 0, 0); PG8_LDB(B1, 0, 1); PG8_SCHED; PG8_LDA(At, 0, 0); PG8_STAGE_A(PG8_SA(1, 1), k1, ac, 1);
            PG8_WAIT_V(8); PG8_WAIT_L(0); PG8_BAR; PG8_MMA(0, 0, At, B0); PG8_MMA(0, 1, At, B1); PG8_BAR; PG8_SCHED;
            PG8_LDA(At, 0, 1); PG8_STAGE(PG8_SB(0, 0), b2, voffB); PG8_STAGE(PG8_SB(0, 1), b2 + hstep, voffB); PG8_STAGE_A(PG8_SA(0, 0), k2, a2, 0);
            PG8_WAIT_V(8); PG8_WAIT_L(0); PG8_BAR; PG8_MMA(1, 0, At, B0); PG8_MMA(1, 1, At, B1); PG8_BAR; PG8_SCHED;
            PG8_LDB(B0, 1, 0); PG8_LDB(B1, 1, 1); PG8_SCHED; PG8_LDA(At, 1, 0); PG8_STAGE_A(PG8_SA(0, 1), k2, a2, 1);
            PG8_WAIT_V(8); PG8_WAIT_L(0); PG8_BAR; PG8_MMA(0, 0, At, B0); PG8_MMA(0, 1, At, B1); PG8_BAR; PG8_SCHED;
            PG8_LDA(At, 1, 1); PG8_STAGE(PG8_SB(1, 0), b3, voffB); PG8_STAGE(PG8_SB(1, 1), b3 + hstep, voffB); PG8_STAGE_A(PG8_SA(1, 0), k3, a2, 0);
            PG8_WAIT_V(8); PG8_WAIT_L(0); PG8_BAR; PG8_MMA(1, 0, At, B0); PG8_MMA(1, 1, At, B1); PG8_BAR; PG8_SCHED;
        }
        if (wr == 0) PG8_BAR;
        E(acc, cur, wr, wc, fr, fq);
        if (!has_next) break;
#pragma unroll
        for (int a = 0; a < 2; ++a)
#pragma unroll
            for (int b = 0; b < 2; ++b)
#pragma unroll
                for (int m = 0; m < 4; ++m)
#pragma unroll
                    for (int n = 0; n < 2; ++n) acc[a][b][m][n] = (f32x4){0.f, 0.f, 0.f, 0.f};
        cur = nxt; cB = nB; ++ui;
#pragma unroll
        for (int h = 0; h < 2; ++h)
#pragma unroll
            for (int i = 0; i < 2; ++i) ac[h][i] = an[h][i];
        if (wr == 1) PG8_BAR;
    }
    PG8_WAIT_V(0);
    PG8_BAR;
#undef PG8_SA
#undef PG8_SB
#undef PG8_STAGE
#undef PG8_LDA
#undef PG8_LDB
#undef PG8_MMA
#undef PG8_WAIT_V
#undef PG8_WAIT_L
#undef PG8_BAR
#undef PG8_SCHED
#undef PG8_AOFF
#undef PG8_STAGE_A
}
}

namespace attn_body {
using bf16 = __hip_bfloat16;
using f32x16 = __attribute__((ext_vector_type(16))) float;
constexpr int D = 64, PQ = 3072, PO = 2048;
constexpr int NW = 8, QBLK = 32, QB = QBLK * NW, KVBLK = 64, NQB = SEQ / QB;
__device__ __forceinline__ int crow(int r, int hi) { return (r & 3) + 8 * (r >> 2) + 4 * hi; }
#define SBAR() __builtin_amdgcn_sched_barrier(0)
__device__ __forceinline__ void cmask(f32x16& p0, f32x16& p1, int jb, int qrel, int hi) {
    const float NEG = -INFINITY; int kb = 64 * jb + 4 * hi;
#pragma unroll
    for (int r = 0; r < 16; ++r) { int kv = kb + (r & 3) + 8 * (r >> 2); if (kv > qrel) p0[r] = NEG; if (kv + 32 > qrel) p1[r] = NEG; }
}
constexpr int NSLOT = 3, SLOTB = 8192;
constexpr int LDS_K = 0, LDS_V = NSLOT * SLOTB, LDS_WS = 2 * NSLOT * SLOTB, LDS_OST = LDS_WS + NW * 64 * 4, ATT_LDS_BYTES = LDS_OST + NW * 4096;
__device__ __forceinline__ void glds16(const void* gsrc, unsigned lds_dst) { unsigned keep;
    asm volatile("s_mov_b32 %0, m0\n\ts_mov_b32 m0, %2\n\ts_nop 0\n\tglobal_load_lds_dwordx4 %1, off\n\ts_mov_b32 m0, %0" : "=&s"(keep) : "v"(gsrc), "s"(lds_dst) : "memory"); }
__device__ __forceinline__ float max3f(float a, float b, float c) { float r; asm("v_max3_f32 %0, %1, %2, %3" : "=v"(r) : "v"(a), "v"(b), "v"(c)); return r; }
__device__ __forceinline__ float max2f(float a, float b) { float r; asm("v_max_f32_e32 %0, %1, %2" : "=v"(r) : "v"(a), "v"(b)); return r; }
__device__ __forceinline__ float fadd_s(float a, float b) { float r; asm("v_add_f32_e32 %0, %1, %2" : "=v"(r) : "v"(a), "v"(b)); return r; }
__device__ __forceinline__ float fsub_s(float a, float b) { float r; asm("v_sub_f32_e32 %0, %1, %2" : "=v"(r) : "v"(a), "v"(b)); return r; }
__device__ __forceinline__ unsigned cvtpk_s(float lo, float hi) { f32x2 v = {lo, hi}; bf16x2_t b = __builtin_convertvector(v, bf16x2_t); return __builtin_bit_cast(unsigned, b); }
#define WAIT_BAR(N) asm volatile("s_waitcnt vmcnt(" #N ") lgkmcnt(0)\n\ts_barrier" ::: "memory")
__device__ __forceinline__ void qkt(f32x16& p0, f32x16& p1, const char* Kslot, const bf16x8* qr, const f32x16& negm, int r32, int hi) {
    const char* kb = Kslot + hi * 1024 + r32 * 16;
#pragma unroll
    for (int d0 = 0; d0 < 4; ++d0) {
        const bf16x8 b0 = *reinterpret_cast<const bf16x8*>(kb + d0 * 2048);
        const bf16x8 b1 = *reinterpret_cast<const bf16x8*>(kb + d0 * 2048 + 512);
        if (d0 == 0) { p0 = __builtin_amdgcn_mfma_f32_32x32x16_bf16(b0, qr[0], negm, 0, 0, 0); p1 = __builtin_amdgcn_mfma_f32_32x32x16_bf16(b1, qr[0], negm, 0, 0, 0); }
        else { p0 = __builtin_amdgcn_mfma_f32_32x32x16_bf16(b0, qr[d0], p0, 0, 0, 0); p1 = __builtin_amdgcn_mfma_f32_32x32x16_bf16(b1, qr[d0], p1, 0, 0, 0); } }
}
typedef __attribute__((address_space(3))) const char* lds_cptr;
typedef short v4i16_t __attribute__((ext_vector_type(4)));
__device__ __forceinline__ void kload8(bf16x8* kf, lds_cptr kp) {
    kf[0] = *(const LAS bf16x8*)(kp);        kf[1] = *(const LAS bf16x8*)(kp + 512);
    kf[2] = *(const LAS bf16x8*)(kp + 2048); kf[3] = *(const LAS bf16x8*)(kp + 2560);
    kf[4] = *(const LAS bf16x8*)(kp + 4096); kf[5] = *(const LAS bf16x8*)(kp + 4608);
    kf[6] = *(const LAS bf16x8*)(kp + 6144); kf[7] = *(const LAS bf16x8*)(kp + 6656);
}
__device__ __forceinline__ void kload2(bf16x8* kf, lds_cptr kp, int j) { kf[2 * j] = *(const LAS bf16x8*)(kp + j * 2048); kf[2 * j + 1] = *(const LAS bf16x8*)(kp + j * 2048 + 512); }
__device__ __forceinline__ s16x4 vtr(lds_cptr p) { return __builtin_bit_cast(s16x4, __builtin_amdgcn_ds_read_tr16_b64_v4i16((LAS v4i16_t*)p)); }
__device__ __forceinline__ float rowmax(const f32x16& p0, const f32x16& p1) {
    float a = max3f(p0[0], p0[1], p1[0]), b = max3f(p0[2], p0[3], p1[1]); a = max3f(a, p1[2], p1[3]);
#pragma unroll
    for (int r = 4; r < 16; r += 4) { a = max3f(a, p0[r], p0[r + 1]); b = max3f(b, p0[r + 2], p0[r + 3]); a = max3f(a, p1[r], p1[r + 1]); b = max3f(b, p1[r + 2], p1[r + 3]); }
    const float m = max2f(a, b);
    auto rr = __builtin_amdgcn_permlane32_swap(__float_as_uint(m), __float_as_uint(m), false, false);
    return max2f(__uint_as_float(rr[0]), __uint_as_float(rr[1]));
}
__device__ __forceinline__ void pv(f32x16* o, int vb, bf16x8 pa0, bf16x8 pa1, bf16x8 pa2, bf16x8 pa3) {
#pragma unroll
    for (int d0 = 0; d0 < 2; ++d0) { s16x4 lo[4], hi[4];
#pragma unroll
        for (int ks = 0; ks < 4; ++ks) {
            asm volatile("ds_read_b64_tr_b16 %0,%1 offset:%c2" : "=&v"(lo[ks]) : "v"(vb), "i"(d0 * 4096 + ks * 1024) : "memory");
            asm volatile("ds_read_b64_tr_b16 %0,%1 offset:%c2" : "=&v"(hi[ks]) : "v"(vb), "i"(d0 * 4096 + ks * 1024 + 512) : "memory"); }
        asm volatile("s_waitcnt lgkmcnt(0)" ::: "memory"); SBAR();
#define PK(k) (bf16x8){lo[k][0], lo[k][1], lo[k][2], lo[k][3], hi[k][0], hi[k][1], hi[k][2], hi[k][3]}
        o[d0] = __builtin_amdgcn_mfma_f32_32x32x16_bf16(pa0, PK(0), o[d0], 0, 0, 0);
        o[d0] = __builtin_amdgcn_mfma_f32_32x32x16_bf16(pa1, PK(1), o[d0], 0, 0, 0);
        o[d0] = __builtin_amdgcn_mfma_f32_32x32x16_bf16(pa2, PK(2), o[d0], 0, 0, 0);
        o[d0] = __builtin_amdgcn_mfma_f32_32x32x16_bf16(pa3, PK(3), o[d0], 0, 0, 0);
#undef PK
    }
}
#define ATTN_STORE16(p, v) (*(u32x4*)(p) = (v))
template <int THRL> __device__ __forceinline__ void attn_unit(int pair, int qb, const bf16* Pb, bf16* Obuf, char* shm) {
    const int b = pair >> 5, v5 = pair & 31, hc = v5 >> 1; const int qc = hc * 64, kc = 1024 + hc * 64, vc = 2048 + (v5 >> 2) * 128 + (v5 & 1) * 64, oc = v5 * 64;
    int tid = threadIdx.x; asm volatile("" : "+v"(tid));
    const int lane = tid & 63, r32 = lane & 31, hi = lane >> 5; const int wid = __builtin_amdgcn_readfirstlane(tid >> 6);
    const long rowbase = (long)b * SEQ; const int q0 = qb * QB;
    const bf16* Qw = Pb + (rowbase + q0 + wid * QBLK) * PQ + qc;
    const bf16* Kh = Pb + rowbase * PQ + kc, *Vh = Pb + rowbase * PQ + vc;
    const unsigned lds0 = (unsigned)(uintptr_t)shm;
    float* wsf = (float*)(shm + LDS_WS) + wid * 64;
    const bf16* ksrc = Kh + (long)lane * PQ + wid * 8;
    const bf16* vsrc = Vh + (long)(16 * (wid & 3) + (lane >> 2)) * PQ + (wid >> 2) * 32 + (lane & 3) * 8;
    const unsigned kdst = lds0 + LDS_K + wid * 1024, vdst = lds0 + LDS_V + wid * 1024;
#define DMA_K(t, slot) glds16(ksrc + (long)(t) * KVBLK * PQ, (unsigned)__builtin_amdgcn_readfirstlane(kdst + (slot)))
#define DMA_V(t, slot) glds16(vsrc + (long)(t) * KVBLK * PQ, (unsigned)__builtin_amdgcn_readfirstlane(vdst + (slot)))
    const int vb0 = (int)(lds0 + LDS_V) + ((lane >> 4) & 1) * 32 + (lane & 3) * 8 + (4 * hi + ((lane & 15) >> 2)) * 64;
    const char* Kbase = shm + LDS_K; bf16x8 kf[8];
    const lds_cptr shm3 = (lds_cptr)shm; const lds_cptr kp0 = shm3 + LDS_K + hi * 1024 + r32 * 16; const lds_cptr vp0 = shm3 + LDS_V + ((lane >> 4) & 1) * 32 + (lane & 3) * 8 + (4 * hi + ((lane & 15) >> 2)) * 64;
    const int NT = (q0 + QB) / KVBLK;
    DMA_K(0, 0); DMA_V(0, 0); DMA_K(1, SLOTB);
    bf16x8 qr[4];
#pragma unroll
    for (int d0 = 0; d0 < 4; ++d0) qr[d0] = *reinterpret_cast<const bf16x8*>(&Qw[(long)r32 * PQ + d0 * 16 + hi * 8]);
    float mhat = 0.f, l_reg = 0.f; f32x16 o[2]; o[0] = f32x16{}; o[1] = f32x16{}; f32x16 negm = f32x16{}; asm volatile("" : "+v"(negm));
    const int qrel = wid * QBLK + r32;
#define CMASK(P0, P1, t) do { int jb_ = (t) - (NT - 4); if (jb_ >= 0) cmask(P0, P1, jb_, qrel, hi); } while (0)
    bool resc = false;
#define START(P0, P1) do { const float rm = rowmax(P0, P1); resc = false; \
    { const float dl = rm; mhat = fadd_s(mhat, dl); \
      _Pragma("unroll") for (int r = 0; r < 16; ++r) { P0[r] = fsub_s(P0[r], dl); P1[r] = fsub_s(P1[r], dl); } \
      _Pragma("unroll") for (int r = 0; r < 16; ++r) negm[r] = -mhat; asm volatile("" : "+v"(negm)); } \
    _Pragma("unroll") for (int r = 0; r < 16; ++r) P0[r] = __builtin_amdgcn_exp2f(P0[r]); } while (0)
#define RESC() do { if (resc) { asm volatile("s_waitcnt lgkmcnt(0)" ::: "memory"); \
      _Pragma("unroll") for (int d_ = 0; d_ < 2; ++d_) _Pragma("unroll") for (int r = 0; r < 16; ++r) o[d_][r] *= wsf[crow(r, hi)]; } } while (0)
    f32x16 pA0, pA1, pB0, pB1;
    int sl_prev = 0, sl_cur = 0, sl_next = SLOTB;
#define ROT() do { sl_prev = sl_cur; sl_cur = sl_next; sl_next = (sl_next == (NSLOT - 1) * SLOTB) ? 0 : sl_next + SLOTB; } while (0)
    DMA_K(2, 2 * SLOTB);
    WAIT_BAR(3);
    qkt(pA0, pA1, Kbase, qr, negm, r32, hi); asm volatile("s_nop 15\n\ts_nop 7" : "+v"(pA0), "+v"(pA1)); CMASK(pA0, pA1, 0);
    START(pA0, pA1);
    _Pragma("unroll") for (int r = 0; r < 16; ++r) pA1[r] = __builtin_amdgcn_exp2f(pA1[r]);
    WAIT_BAR(0);
    DMA_K(3, 0); DMA_V(1, SLOTB);
    ROT();
    kload8(kf, kp0 + sl_cur);
    WAIT_BAR(2);
    s16x4 vlo[8], vhi[8]; u32x4 pw0, pw1, pw2, pw3;
#define PKW(P, B) cvtpk_s(P[B], P[B + 1])
#define PAF(k) __builtin_bit_cast(bf16x8, pw##k)
#define VFR(i) (bf16x8){vlo[i][0], vlo[i][1], vlo[i][2], vlo[i][3], vhi[i][0], vhi[i][1], vhi[i][2], vhi[i][3]}
#define PIN(x) asm volatile("" : "+v"(x))
#define MX3(a, b, c) __builtin_fmaxf(__builtin_fmaxf((a), (b)), (c))
#define GAPA(MF, A0, A1, A2, A3, W0, W1, PW) do { MF; sacc += A0; sacc += A1; sacc += A2; sacc += A3; PIN(sacc); W0; W1; PIN(PW); SBAR(); } while (0)
#define EX(v) __builtin_amdgcn_exp2f(v)
#define GAPB(MF, X, B) do { MF; X[B] = EX(X[B]); X[B + 1] = EX(X[B + 1]); X[B + 2] = EX(X[B + 2]); X[B + 3] = EX(X[B + 3]); PIN(X); SBAR(); } while (0)
#define VRD(i) do { vlo[i] = vtr(vp_ + (((i) >> 2) * 4096 + ((i) & 3) * 1024)); vhi[i] = vtr(vp_ + (((i) >> 2) * 4096 + ((i) & 3) * 1024 + 512)); } while (0)
#define KRD(G, j) do { if (G) { kload2(kf, kp0 + sl_next, j); SBAR(); } } while (0)
#define STEP(C0, C1, P0, P1, t, GK, GV, GL) do { SBAR(); \
    const lds_cptr vp_ = vp0 + sl_prev; \
    VRD(0); SBAR(); float sacc = (P0[0] + P0[1]); \
    GAPA(C0 = __builtin_amdgcn_mfma_f32_32x32x16_bf16(kf[0], qr[0], negm, 0, 0, 0), P0[2], P0[3], P0[4], P0[5],     pw0[0] = PKW(P0, 0), pw0[1] = PKW(P0, 2), pw0); \
    VRD(4); SBAR(); GAPA(C1 = __builtin_amdgcn_mfma_f32_32x32x16_bf16(kf[1], qr[0], negm, 0, 0, 0), P0[6], P0[7], P0[8], P0[9],     pw0[2] = PKW(P0, 4), pw0[3] = PKW(P0, 6), pw0); \
    VRD(1); SBAR(); GAPA(C0 = __builtin_amdgcn_mfma_f32_32x32x16_bf16(kf[2], qr[1], C0, 0, 0, 0),   P0[10], P0[11], P0[12], P0[13], pw1[0] = PKW(P0, 8), pw1[1] = PKW(P0, 10), pw1); \
    VRD(5); SBAR(); GAPA(C1 = __builtin_amdgcn_mfma_f32_32x32x16_bf16(kf[3], qr[1], C1, 0, 0, 0),   P0[14], P0[15], P1[0], P1[1],   pw1[2] = PKW(P0, 12), pw1[3] = PKW(P0, 14), pw1); \
    VRD(2); SBAR(); GAPA(C0 = __builtin_amdgcn_mfma_f32_32x32x16_bf16(kf[4], qr[2], C0, 0, 0, 0),   P1[2], P1[3], P1[4], P1[5],     pw2[0] = PKW(P1, 0), pw2[1] = PKW(P1, 2), pw2); \
    VRD(6); SBAR(); GAPA(C1 = __builtin_amdgcn_mfma_f32_32x32x16_bf16(kf[5], qr[2], C1, 0, 0, 0),   P1[6], P1[7], P1[8], P1[9],     pw2[2] = PKW(P1, 4), pw2[3] = PKW(P1, 6), pw2); \
    VRD(3); SBAR(); GAPA(C0 = __builtin_amdgcn_mfma_f32_32x32x16_bf16(kf[6], qr[3], C0, 0, 0, 0),   P1[10], P1[11], P1[12], P1[13], pw3[0] = PKW(P1, 8), pw3[1] = PKW(P1, 10), pw3); \
    VRD(7); SBAR(); GAPA(C1 = __builtin_amdgcn_mfma_f32_32x32x16_bf16(kf[7], qr[3], C1, 0, 0, 0),   P1[14], P1[15], 0.f, 0.f,       pw3[2] = PKW(P1, 12), pw3[3] = PKW(P1, 14), pw3); \
    l_reg += sacc; \
    if (GK) { DMA_K((t) + 3, sl_cur); } if (GV) { DMA_V((t) + 1, sl_next); } \
    CMASK(C0, C1, t); \
    { float a = MX3(C0[0], C0[1], C1[0]), b = MX3(C0[2], C0[3], C1[1]); a = MX3(a, C1[2], C1[3]); \
      _Pragma("unroll") for (int r = 4; r < 16; r += 4) { a = MX3(a, C0[r], C0[r + 1]); b = MX3(b, C0[r + 2], C0[r + 3]); a = MX3(a, C1[r], C1[r + 1]); b = MX3(b, C1[r + 2], C1[r + 3]); } \
      float rm = __builtin_fmaxf(a, b); { auto rr = __builtin_amdgcn_permlane32_swap(__float_as_uint(rm), __float_as_uint(rm), false, false); rm = __builtin_fmaxf(__uint_as_float(rr[0]), __uint_as_float(rr[1])); } \
      resc = false; \
      if (__builtin_expect(__any(rm > (float)THRL), 0)) { const float dl = __builtin_fmaxf(rm, 0.f); mhat += dl; \
        _Pragma("unroll") for (int r = 0; r < 16; ++r) { C0[r] -= dl; C1[r] -= dl; } \
        _Pragma("unroll") for (int r = 0; r < 16; ++r) negm[r] = -mhat; asm volatile("" : "+v"(negm)); \
        const float f = __builtin_amdgcn_exp2f(-dl); l_reg *= f; if (hi == 0) wsf[r32] = f; resc = true; } } \
    SBAR(); \
    GAPB(o[0] = __builtin_amdgcn_mfma_f32_32x32x16_bf16(PAF(0), VFR(0), o[0], 0, 0, 0), C0, 0); \
    GAPB(o[1] = __builtin_amdgcn_mfma_f32_32x32x16_bf16(PAF(0), VFR(4), o[1], 0, 0, 0), C0, 4); \
    KRD(GL, 0); GAPB(o[0] = __builtin_amdgcn_mfma_f32_32x32x16_bf16(PAF(1), VFR(1), o[0], 0, 0, 0), C0, 8); \
    KRD(GL, 1); GAPB(o[1] = __builtin_amdgcn_mfma_f32_32x32x16_bf16(PAF(1), VFR(5), o[1], 0, 0, 0), C0, 12); \
    KRD(GL, 2); GAPB(o[0] = __builtin_amdgcn_mfma_f32_32x32x16_bf16(PAF(2), VFR(2), o[0], 0, 0, 0), C1, 0); \
    KRD(GL, 3); GAPB(o[1] = __builtin_amdgcn_mfma_f32_32x32x16_bf16(PAF(2), VFR(6), o[1], 0, 0, 0), C1, 4); \
    GAPB(o[0] = __builtin_amdgcn_mfma_f32_32x32x16_bf16(PAF(3), VFR(3), o[0], 0, 0, 0), C1, 8); \
    GAPB(o[1] = __builtin_amdgcn_mfma_f32_32x32x16_bf16(PAF(3), VFR(7), o[1], 0, 0, 0), C1, 12); \
    } while (0)
    int t = 1;
#undef CMASK
#define CMASK(P0, P1, t) do {} while (0)
    for (; t + 5 < NT; t += 2) {
        STEP(pB0, pB1, pA0, pA1, t, true, true, true);     WAIT_BAR(2); RESC(); ROT();
        STEP(pA0, pA1, pB0, pB1, t + 1, true, true, true); WAIT_BAR(2); RESC(); ROT();
    }
#undef CMASK
#define CMASK(P0, P1, t) do { int jb_ = (t) - (NT - 4); if (jb_ >= 0) cmask(P0, P1, jb_, qrel, hi); } while (0)
#define ENDW(tt) do { if ((tt) + 3 < NT) { WAIT_BAR(2); } else if ((tt) + 2 < NT) { WAIT_BAR(1); } else { WAIT_BAR(0); } } while (0)
    for (; t + 1 < NT; t += 2) {
        STEP(pB0, pB1, pA0, pA1, t, (t + 3 < NT), (t + 1 < NT), (t + 1 < NT));         ENDW(t);     RESC(); ROT();
        STEP(pA0, pA1, pB0, pB1, t + 1, (t + 4 < NT), (t + 2 < NT), (t + 2 < NT));     ENDW(t + 1); RESC(); ROT();
    }
    STEP(pB0, pB1, pA0, pA1, NT - 1, false, false, false); RESC();
    { float sacc = pB0[0] + pB0[1]; _Pragma("unroll") for (int r = 2; r < 16; ++r) sacc += pB0[r]; _Pragma("unroll") for (int r = 0; r < 16; ++r) sacc += pB1[r]; l_reg += sacc;
      pw0 = (u32x4){PKW(pB0, 0), PKW(pB0, 2), PKW(pB0, 4), PKW(pB0, 6)}; pw1 = (u32x4){PKW(pB0, 8), PKW(pB0, 10), PKW(pB0, 12), PKW(pB0, 14)}; pw2 = (u32x4){PKW(pB1, 0), PKW(pB1, 2), PKW(pB1, 4), PKW(pB1, 6)}; pw3 = (u32x4){PKW(pB1, 8), PKW(pB1, 10), PKW(pB1, 12), PKW(pB1, 14)};
      SBAR(); pv(o, vb0 + sl_cur, PAF(0), PAF(1), PAF(2), PAF(3)); }
#undef PKW
#undef PAF
#undef VFR
#undef PIN
#undef MX3
#undef GAPA
#undef GAPB
#undef EX
#undef VRD
#undef KRD
#undef STEP
#undef ENDW
    { auto rr = __builtin_amdgcn_permlane32_swap(__float_as_uint(l_reg), __float_as_uint(l_reg), false, false); l_reg = __uint_as_float(rr[0]) + __uint_as_float(rr[1]); }
    if (hi == 0) wsf[32 + r32] = l_reg; asm volatile("s_waitcnt lgkmcnt(0)" ::: "memory");
    float rli[16];
#pragma unroll
    for (int r = 0; r < 16; ++r) rli[r] = __builtin_amdgcn_rcpf(wsf[32 + crow(r, hi)]);
    bf16* Ow = Obuf + (rowbase + q0 + wid * QBLK) * PO + oc;
    { bf16* stg = (bf16*)(shm + LDS_OST) + wid * 2048;
#pragma unroll
      for (int r = 0; r < 16; ++r) { const int orow = crow(r, hi);
#pragma unroll
        for (int d0 = 0; d0 < 2; ++d0) stg[orow * 64 + d0 * 32 + r32] = __float2bfloat16(o[d0][r] * rli[r]); }
      asm volatile("s_waitcnt lgkmcnt(0)" ::: "memory");
#pragma unroll
      for (int i = 0; i < 4; ++i) { const int row = i * 8 + (lane >> 3), ch = lane & 7; const u32x4 v = *(const u32x4*)(stg + row * 64 + ch * 8); ATTN_STORE16(Ow + (long)row * PO + ch * 8, v); } }
    asm volatile("s_waitcnt lgkmcnt(0)\n\ts_barrier" ::: "memory");
#undef DMA_K
#undef DMA_V
#undef CMASK
#undef START
#undef RESC
#undef ROT
}
#undef SBAR
#undef WAIT_BAR
}

struct Params {
    const float* x; const float* c; const int* positions; const float* norm1; const float* norm2; const float* w_ada; const float* b_ada;
    const float* a_w_in; const float* a_b_if; const float* a_h_norm; const float* a_w_out;
    const float* b_w_in; const float* b_q_norm; const float* b_k_norm; const float* b_lam_q1; const float* b_lam_k1; const float* b_lam_q2; const float* b_lam_k2;
    const float* b_o_norm; const float* b_w_out; const float* w_router; const float* router_bias; const float* moe_w_gu; const float* moe_w_down;
    float* out; unsigned char* ws;
};
struct Frame { LAS unsigned char* lds; int tid, lane, wave, G, bid, vcu; };
__device__ __forceinline__ Frame make_frame(unsigned char* lds) {
    Frame F; F.lds = (LAS unsigned char*)lds; int t = threadIdx.x; asm volatile("" : "+v"(t)); F.tid = t; F.lane = t & 63; F.wave = __builtin_amdgcn_readfirstlane(t >> 6);
    F.G = gridDim.x; F.bid = blockIdx.x; F.vcu = (F.G % 8 == 0) ? (F.bid % 8) * (F.G / 8) + F.bid / 8 : F.bid; return F;
}

__device__ __forceinline__ void transpose_item(const float* W, int ldw, int K, bf16_t* WT, int drow0, LAS float* scr, int k0, int n0, int lane) {
#pragma unroll 8
    for (int i = 0; i < 32; ++i) { const int kk = 2 * i + (lane >> 5); scr[kk * 33 + (lane & 31)] = W[(size_t)(k0 + kk) * ldw + n0 + (lane & 31)]; }
    asm volatile("s_waitcnt lgkmcnt(0)" ::: "memory");
    const int c = lane & 7;
#pragma unroll
    for (int j = 0; j < 4; ++j) { const int n = (lane >> 3) + 8 * j; const LAS float* s = scr + (8 * c) * 33 + n;
        u32x4 o; o.x = cvtpk(s[0 * 33], s[1 * 33]); o.y = cvtpk(s[2 * 33], s[3 * 33]); o.z = cvtpk(s[4 * 33], s[5 * 33]); o.w = cvtpk(s[6 * 33], s[7 * 33]);
        *(u32x4*)(WT + (size_t)(drow0 + n) * K + k0 + 8 * c) = o; }
    asm volatile("s_waitcnt lgkmcnt(0)" ::: "memory");
}
__device__ __forceinline__ void phase_prep(unsigned char* lds_, const Params& p) {
    const Frame F = make_frame(lds_);
    LAS float* cact = (LAS float*)F.lds;
    LAS float* red = (LAS float*)(F.lds + 65536);
    float* mod = (float*)(p.ws + WS_MOD);
    for (int i = F.tid; i < NB * DM; i += NTHREADS) { const int b = i >> 10, k = i & 1023; const float v = p.c[i]; cact[k * 16 + b] = v / (1.0f + expf(-v)); }
    __syncthreads();
    for (int task = F.bid; task < 192; task += F.G) {
        const int l = task / 96, cb = task % 96;
        const float* W = p.w_ada + (size_t)l * DM * 6144 + cb * 64 + F.lane;
        float acc[16];
#pragma unroll
        for (int b = 0; b < 16; ++b) acc[b] = 0.f;
        const int kbeg = F.wave * 128;
#pragma unroll 4
        for (int k = kbeg; k < kbeg + 128; ++k) {
            const float wv = W[(size_t)k * 6144];
            const LAS f32x4* cc = (const LAS f32x4*)(cact + k * 16);
            const f32x4 c0 = cc[0], c1 = cc[1], c2 = cc[2], c3 = cc[3];
            acc[0] += c0[0] * wv; acc[1] += c0[1] * wv; acc[2] += c0[2] * wv; acc[3] += c0[3] * wv;
            acc[4] += c1[0] * wv; acc[5] += c1[1] * wv; acc[6] += c1[2] * wv; acc[7] += c1[3] * wv;
            acc[8] += c2[0] * wv; acc[9] += c2[1] * wv; acc[10] += c2[2] * wv; acc[11] += c2[3] * wv;
            acc[12] += c3[0] * wv; acc[13] += c3[1] * wv; acc[14] += c3[2] * wv; acc[15] += c3[3] * wv;
        }
#pragma unroll
        for (int b = 0; b < 16; ++b) red[(F.wave * 16 + b) * 64 + F.lane] = acc[b];
        __syncthreads();
        for (int o = F.tid; o < 1024; o += NTHREADS) { const int b = o >> 6, cl = o & 63; float s = 0.f;
#pragma unroll
            for (int w = 0; w < 8; ++w) s += red[(w * 16 + b) * 64 + cl];
            mod[((size_t)l * 16 + b) * 6144 + cb * 64 + cl] = s + p.b_ada[(size_t)l * 6144 + cb * 64 + cl]; }
        __syncthreads();
    }
    LAS float* scr = (LAS float*)(F.lds + F.wave * 16384);
    const int gw = F.vcu * NWAVES + F.wave, NGW = F.G * NWAVES;
    constexpr int I0 = 16 * 96, I1 = 16 * 32, I2 = 16 * 96, I3 = 16 * 32, I4 = 32 * 512, I5 = 32 * 256;
    constexpr int NITEMS = I0 + I1 + I2 + I3 + I4 + I5;
    for (int it = gw; it < NITEMS; it += NGW) {
        int r = it;
        if (r < I0) { const int kb = r / 96, nb = r % 96; transpose_item(p.a_w_in, 3080, 1024, (bf16_t*)(p.ws + WS_WAIN), 32 * nb, scr, 64 * kb, 32 * nb, F.lane); continue; } r -= I0;
        if (r < I1) { const int kb = r / 32, nb = r % 32; transpose_item(p.a_w_out, 1024, 1024, (bf16_t*)(p.ws + WS_WAOUT), 32 * nb, scr, 64 * kb, 32 * nb, F.lane); continue; } r -= I1;
        if (r < I2) { const int kb = r / 96, nb = r % 96; transpose_item(p.b_w_in, 3072, 1024, (bf16_t*)(p.ws + WS_WBIN), 32 * nb, scr, 64 * kb, 32 * nb, F.lane); continue; } r -= I2;
        if (r < I3) { const int kb = r / 32, nb = r % 32; transpose_item(p.b_w_out, 1024, 1024, (bf16_t*)(p.ws + WS_WBOUT), 32 * nb, scr, 64 * kb, 32 * nb, F.lane); continue; } r -= I3;
        if (r < I4) { const int mi = r / 512, q = r % 512, kb = q / 32, nb = q % 32; const int n0 = 32 * nb;
            const int drow = ((n0 & 511) >> 7) * 256 + (n0 >> 9) * 128 + (n0 & 127);
            transpose_item(p.moe_w_gu + (size_t)mi * 1024 * 1024, 1024, 1024, (bf16_t*)(p.ws + WS_WGU) + (size_t)mi * 1024 * 1024, drow, scr, 64 * kb, n0, F.lane); continue; } r -= I4;
        { const int mi = r / 256, q = r % 256, kb = q / 32, nb = q % 32;
            transpose_item(p.moe_w_down + (size_t)mi * 512 * 1024, 1024, 512, (bf16_t*)(p.ws + WS_WDN) + (size_t)mi * 1024 * 512, 32 * nb, scr, 64 * kb, 32 * nb, F.lane); }
    }
}

struct RowConst { f32x4 a[4], b[4]; };
__device__ __forceinline__ RowConst load_rowconst(const float* norm, const float* modb, int sh_off, int sc_off, int lane) {
    RowConst rc;
#pragma unroll
    for (int j = 0; j < 4; ++j) { const int c = 256 * j + 4 * lane;
        const f32x4 nv = *(const f32x4*)(norm + c), sc = *(const f32x4*)(modb + sc_off + c); rc.b[j] = *(const f32x4*)(modb + sh_off + c);
        rc.a[j] = nv * (sc + 1.0f); }
    return rc;
}
__device__ __forceinline__ void row_norm_store(const f32x4 (&v)[4], const RowConst& rc, f32x4 (&h)[4], bf16_t* hrow, int lane) {
    float ss = 0.f;
#pragma unroll
    for (int j = 0; j < 4; ++j) ss += (v[j][0] * v[j][0] + v[j][1] * v[j][1]) + (v[j][2] * v[j][2] + v[j][3] * v[j][3]);
    const float r = 1.0f / sqrtf(wave_sum(ss) * (1.0f / DM) + EPS);
#pragma unroll
    for (int j = 0; j < 4; ++j) { h[j] = v[j] * r * rc.a[j] + rc.b[j];
        u32x2 w; w.x = cvtpk(h[j][0], h[j][1]); w.y = cvtpk(h[j][2], h[j][3]); *(u32x2*)(hrow + 256 * j + 4 * lane) = w; }
}

__device__ __forceinline__ void phase_hprep0(unsigned char* lds_, const Params& p) {
    const Frame F = make_frame(lds_);
    LAS f32x4* Wg = (LAS f32x4*)F.lds;
    for (int idx = F.tid; idx < 2048; idx += NTHREADS) { const int ln = idx & 63, half = (idx >> 6) & 1, i = (idx >> 7) & 3, j = idx >> 9; const int c = 256 * j + 4 * ln + i;
        Wg[idx] = *(const f32x4*)(p.a_w_in + (size_t)c * 3080 + 3072 + half * 4); }
    __syncthreads();
    const float* mod = (const float*)(p.ws + WS_MOD);
    bf16_t* H = (bf16_t*)(p.ws + WS_H); float* gates = (float*)(p.ws + WS_GATES);
    const float bif = (F.lane < 8) ? p.a_b_if[F.lane] : 0.f;
    for (int chunk = F.bid; chunk < 256; chunk += F.G) {
        const int row0 = chunk * 128 + F.wave * 16; const int b = row0 / SEQ;
        const RowConst rc = load_rowconst(p.norm1, mod + (size_t)b * 6144, 0, 1024, F.lane);
        for (int r = 0; r < 16; ++r) { const int row = row0 + r;
            f32x4 v[4], h[4];
#pragma unroll
            for (int j = 0; j < 4; ++j) v[j] = *(const f32x4*)(p.x + (size_t)row * DM + 256 * j + 4 * F.lane);
            row_norm_store(v, rc, h, H + (size_t)row * DM, F.lane);
            float g[8];
#pragma unroll
            for (int q = 0; q < 8; ++q) g[q] = 0.f;
#pragma unroll
            for (int j = 0; j < 4; ++j)
#pragma unroll
                for (int i = 0; i < 4; ++i) { const float hv = h[j][i]; const f32x4 w0 = Wg[((j * 4 + i) * 2 + 0) * 64 + F.lane], w1 = Wg[((j * 4 + i) * 2 + 1) * 64 + F.lane];
                    g[0] += hv * w0[0]; g[1] += hv * w0[1]; g[2] += hv * w0[2]; g[3] += hv * w0[3]; g[4] += hv * w1[0]; g[5] += hv * w1[1]; g[6] += hv * w1[2]; g[7] += hv * w1[3]; }
            float mine = 0.f;
#pragma unroll
            for (int q = 0; q < 8; ++q) { const float s = wave_sum(g[q]); if (F.lane == q) mine = s; }
            if (F.lane < 8) { float val = mine + bif;
                if (F.lane >= 4) val = fminf(val, 0.f) - log1pf(expf(-fabsf(val)));
                gates[(size_t)row * 8 + F.lane] = val; }
        }
    }
}

namespace mls {
constexpr int RSK = 272, RSV = 176, RSP = 272, RSC = 272;
constexpr int OFF_K = 0, OFF_V = 34816, OFF_P = OFF_V + 22528, OFF_C = OFF_P + 34816, OFF_G = OFF_C + 21760;
typedef short v4i16_t __attribute__((ext_vector_type(4)));
__device__ __forceinline__ bf16x8 tr2(const LAS unsigned char* base, int row, int col, int rs, int lane) {
    const int i = lane & 15, g = lane >> 4;
    const LAS unsigned char* p0 = base + (row + 8 * g + (i >> 2)) * rs + (col + 4 * (i & 3)) * 2;
    const s16x4 lo = __builtin_bit_cast(s16x4, __builtin_amdgcn_ds_read_tr16_b64_v4i16((LAS v4i16_t*)p0));
    const s16x4 hi = __builtin_bit_cast(s16x4, __builtin_amdgcn_ds_read_tr16_b64_v4i16((LAS v4i16_t*)(p0 + 4 * rs)));
    return (bf16x8){lo[0], lo[1], lo[2], lo[3], hi[0], hi[1], hi[2], hi[3]};
}
}
__device__ __forceinline__ void phase_mlstm(unsigned char* lds_, const Params& p) {
    const Frame F = make_frame(lds_);
    using namespace mls;
    const bf16_t* PR = (const bf16_t*)(p.ws + WS_PROJ); const float* gates = (const float*)(p.ws + WS_GATES); bf16_t* HO = (bf16_t*)(p.ws + WS_HOUT);
    LAS unsigned char* Ks = F.lds + OFF_K; LAS unsigned char* Vs = F.lds + OFF_V; LAS unsigned char* Ps = F.lds + OFF_P; LAS unsigned char* Cs = F.lds + OFF_C;
    LAS float* gu = (LAS float*)(F.lds + OFF_G); LAS float* gwv = gu + 128; LAS float* gin = gu + 256; LAS float* gfl = gu + 384; LAS float* gwg = gu + 512;
    const int w = F.wave, lane = F.lane, c = lane & 15, g = lane >> 4, tid = F.tid;
    for (int item = F.vcu; item < 256; item += F.G) {
        const int bh = item >> 2, sl = item & 3, b = bh >> 2, h = bh & 3;
        const size_t tok0 = (size_t)b * SEQ;
        const bf16_t* Qg = PR + h * 128; const bf16_t* Kg = PR + 512 + h * 128; const bf16_t* Vg = PR + 1024 + h * 256 + sl * 64;
        __syncthreads();
        if (tid < 256) { const int row = tid >> 1, part = tid & 1; u32x4 z = {0u, 0u, 0u, 0u}; if (part == 0) z.x = 0x3F80u; *(LAS u32x4*)(Vs + row * RSV + 128 + part * 16) = z; }
        f32x4 cacc[5];
#pragma unroll
        for (int vt = 0; vt < 5; ++vt) cacc[vt] = (f32x4){0.f, 0.f, 0.f, 0.f};
        for (int i = tid; i < 80 * RSC / 16; i += NTHREADS) *(LAS u32x4*)(Cs + i * 16) = (u32x4){0u, 0u, 0u, 0u};
        float m_prev = 0.f;
        u32x4 kst[4], vst[2]; bf16x8 qf[4], qn[4]; float glf0 = 0.f, glf1 = 0.f, gi0 = 0.f, gi1 = 0.f;
        auto load_chunk = [&](int ch) {
            const size_t t0 = tok0 + (size_t)ch * 128;
#pragma unroll
            for (int k = 0; k < 4; ++k) { const int pc = tid + 512 * k, row = pc >> 4, c16 = pc & 15; kst[k] = *(const u32x4*)(Kg + (t0 + row) * 3072 + c16 * 8); }
#pragma unroll
            for (int k = 0; k < 2; ++k) { const int pc = tid + 512 * k, row = pc >> 3, c16 = pc & 7; vst[k] = *(const u32x4*)(Vg + (t0 + row) * 3072 + c16 * 8); }
#pragma unroll
            for (int ks = 0; ks < 4; ++ks) qn[ks] = *(const bf16x8*)(Qg + (t0 + 16 * w + c) * 3072 + 32 * ks + 8 * g);
            if (w == 0) { const float* gp = gates + (t0 + 2 * lane) * 8; gi0 = gp[h]; glf0 = gp[4 + h]; gi1 = gp[8 + h]; glf1 = gp[12 + h]; }
        };
        auto store_chunk = [&]() {
#pragma unroll
            for (int k = 0; k < 4; ++k) { const int pc = tid + 512 * k, row = pc >> 4, c16 = pc & 15; *(LAS u32x4*)(Ks + row * RSK + c16 * 16) = kst[k]; }
#pragma unroll
            for (int k = 0; k < 2; ++k) { const int pc = tid + 512 * k, row = pc >> 3, c16 = pc & 7; *(LAS u32x4*)(Vs + row * RSV + c16 * 16) = vst[k]; }
#pragma unroll
            for (int ks = 0; ks < 4; ++ks) qf[ks] = qn[ks];
            if (w == 0) {
                float s = glf0 + glf1;
#pragma unroll
                for (int d = 1; d < 64; d <<= 1) { const float t = __shfl_up(s, d); if (lane >= d) s += t; }
                const float b1 = s, b0 = s - glf1;
                const float u0 = gi0 - b0, u1 = gi1 - b1;
                float m = fmaxf(u0, u1);
#pragma unroll
                for (int d = 1; d < 64; d <<= 1) { const float t = __shfl_up(m, d); if (lane >= d) m = fmaxf(m, t); }
                float ex = __shfl_up(m, 1); if (lane == 0) ex = -INFINITY;
                const float wv0 = fmaxf(fmaxf(ex, u0), m_prev), wv1 = fmaxf(m, m_prev);
                const float wlast = __shfl(wv1, 63), blast = __shfl(b1, 63);
                gu[2 * lane] = u0; gu[2 * lane + 1] = u1; gwv[2 * lane] = wv0; gwv[2 * lane + 1] = wv1;
                gin[2 * lane] = __expf(m_prev - wv0); gin[2 * lane + 1] = __expf(m_prev - wv1);
                gfl[2 * lane] = __expf(-(b0 + wv0)); gfl[2 * lane + 1] = __expf(-(b1 + wv1));
                gwg[2 * lane] = __expf(u0 - wlast); gwg[2 * lane + 1] = __expf(u1 - wlast);
                m_prev = blast + wlast;
            }
        };
        load_chunk(0);
        store_chunk();
        __syncthreads();
        for (int ch = 0; ch < 16; ++ch) {
            if (ch < 15) load_chunk(ch + 1);
            {
                const int t = 16 * w + c; const float wt = gwv[t];
#pragma unroll
                for (int j = 0; j < 8; ++j) {
                    if (j <= w) {
                        f32x4 sa = (f32x4){0.f, 0.f, 0.f, 0.f};
#pragma unroll
                        for (int ks = 0; ks < 4; ++ks) { const bf16x8 kf = *(const LAS bf16x8*)(Ks + (16 * j + c) * RSK + (32 * ks + 8 * g) * 2); sa = __builtin_amdgcn_mfma_f32_16x16x32_bf16(kf, qf[ks], sa, 0, 0, 0); }
                        const f32x4 uv = *(const LAS f32x4*)(gu + 16 * j + 4 * g);
                        float pv_[4];
#pragma unroll
                        for (int r = 0; r < 4; ++r) { const int s = 16 * j + 4 * g + r; const float e = __expf(uv[r] - wt); pv_[r] = (s <= t) ? sa[r] * e : 0.f; }
                        u32x2 pk; pk.x = cvtpk(pv_[0], pv_[1]); pk.y = cvtpk(pv_[2], pv_[3]);
                        *(LAS u32x2*)(Ps + t * RSP + (16 * j + 4 * g) * 2) = pk;
                    } else if (j == w + 1 && (w & 1) == 0) {
                        *(LAS u32x2*)(Ps + t * RSP + (16 * j + 4 * g) * 2) = (u32x2){0u, 0u};
                    }
                }
            }
            f32x4 nacc[5];
#pragma unroll
            for (int vt = 0; vt < 5; ++vt) { nacc[vt] = (f32x4){0.f, 0.f, 0.f, 0.f};
#pragma unroll
                for (int ks = 0; ks < 4; ++ks) { const bf16x8 cf = *(const LAS bf16x8*)(Cs + (16 * vt + c) * RSC + (32 * ks + 8 * g) * 2); nacc[vt] = __builtin_amdgcn_mfma_f32_16x16x32_bf16(qf[ks], cf, nacc[vt], 0, 0, 0); } }
            { const f32x4 iv = *(const LAS f32x4*)(gin + 16 * w + 4 * g);
#pragma unroll
              for (int vt = 0; vt < 5; ++vt) nacc[vt] = nacc[vt] * iv; }
            __syncthreads();
            for (int ks = 0; ks <= (w >> 1); ++ks) {
                const bf16x8 pf = *(const LAS bf16x8*)(Ps + (16 * w + c) * RSP + (32 * ks + 8 * g) * 2);
#pragma unroll
                for (int vt = 0; vt < 5; ++vt) { const bf16x8 vf = tr2(Vs, 32 * ks, 16 * vt, RSV, lane); nacc[vt] = __builtin_amdgcn_mfma_f32_16x16x32_bf16(pf, vf, nacc[vt], 0, 0, 0); }
            }
            { const f32x4 fl = *(const LAS f32x4*)(gfl + 16 * w + 4 * g);
#pragma unroll
              for (int r = 0; r < 4; ++r) { const float den = __shfl(nacc[4][r], lane & 48); const float inv = 1.0f / fmaxf(fabsf(den), fl[r]);
                  bf16_t* orow = HO + (tok0 + (size_t)ch * 128 + 16 * w + 4 * g + r) * DM + h * 256 + sl * 64 + c;
#pragma unroll
                  for (int vt = 0; vt < 4; ++vt) orow[16 * vt] = (bf16_t)(cvtpk(nacc[vt][r] * inv, 0.f) & 0xffffu); } }
            { const float decay = gin[127];
#pragma unroll
              for (int vt = 0; vt < 5; ++vt) cacc[vt] = cacc[vt] * decay;
#pragma unroll
              for (int ks = 0; ks < 4; ++ks) {
                  bf16x8 kf = tr2(Ks, 32 * ks, 16 * w, RSK, lane);
                  const f32x4 w0 = *(const LAS f32x4*)(gwg + 32 * ks + 8 * g), w1 = *(const LAS f32x4*)(gwg + 32 * ks + 8 * g + 4);
                  u32x4 kw = __builtin_bit_cast(u32x4, kf);
                  kw.x = cvtpk(bflo(kw.x) * w0[0], bfhi(kw.x) * w0[1]); kw.y = cvtpk(bflo(kw.y) * w0[2], bfhi(kw.y) * w0[3]);
                  kw.z = cvtpk(bflo(kw.z) * w1[0], bfhi(kw.z) * w1[1]); kw.w = cvtpk(bflo(kw.w) * w1[2], bfhi(kw.w) * w1[3]);
                  kf = __builtin_bit_cast(bf16x8, kw);
#pragma unroll
                  for (int vt = 0; vt < 5; ++vt) { const bf16x8 vf = tr2(Vs, 32 * ks, 16 * vt, RSV, lane); cacc[vt] = __builtin_amdgcn_mfma_f32_16x16x32_bf16(kf, vf, cacc[vt], 0, 0, 0); }
              } }
            __syncthreads();
#pragma unroll
            for (int vt = 0; vt < 5; ++vt) { u32x2 pk; pk.x = cvtpk(cacc[vt][0], cacc[vt][1]); pk.y = cvtpk(cacc[vt][2], cacc[vt][3]); *(LAS u32x2*)(Cs + (16 * vt + c) * RSC + (16 * w + 4 * g) * 2) = pk; }
            if (ch < 15) store_chunk();
            __syncthreads();
        }
    }
}

__device__ __forceinline__ void phase_aprep(unsigned char* lds_, const Params& p) {
    const Frame F = make_frame(lds_);
    const bf16_t* HO = (const bf16_t*)(p.ws + WS_HOUT); const bf16_t* PR = (const bf16_t*)(p.ws + WS_PROJ); bf16_t* A2 = (bf16_t*)(p.ws + WS_H);
    float hn[16];
#pragma unroll
    for (int i = 0; i < 16; ++i) hn[i] = p.a_h_norm[16 * F.lane + i];
    const int gw = F.bid * NWAVES + F.wave, NGW = F.G * NWAVES;
    for (int row = gw; row < NTOK; row += NGW) {
        const u32x4 h0 = *(const u32x4*)(HO + (size_t)row * DM + 16 * F.lane), h1 = *(const u32x4*)(HO + (size_t)row * DM + 16 * F.lane + 8);
        const u32x4 o0 = *(const u32x4*)(PR + (size_t)row * 3072 + 2048 + 16 * F.lane), o1 = *(const u32x4*)(PR + (size_t)row * 3072 + 2048 + 16 * F.lane + 8);
        float hv[16], ov[16];
#pragma unroll
        for (int i = 0; i < 4; ++i) { hv[2 * i] = bflo(h0[i]); hv[2 * i + 1] = bfhi(h0[i]); hv[8 + 2 * i] = bflo(h1[i]); hv[8 + 2 * i + 1] = bfhi(h1[i]);
            ov[2 * i] = bflo(o0[i]); ov[2 * i + 1] = bfhi(o0[i]); ov[8 + 2 * i] = bflo(o1[i]); ov[8 + 2 * i + 1] = bfhi(o1[i]); }
        float ss = 0.f;
#pragma unroll
        for (int i = 0; i < 16; ++i) ss += hv[i] * hv[i];
        ss += __shfl_xor(ss, 1); ss += __shfl_xor(ss, 2); ss += __shfl_xor(ss, 4); ss += __shfl_xor(ss, 8);
        const float r = 1.0f / sqrtf(ss * (1.0f / 256.0f) + EPS);
        float y[16];
#pragma unroll
        for (int i = 0; i < 16; ++i) y[i] = hv[i] * r * hn[i] * sigmoidf_(ov[i]);
        u32x4 w0, w1; w0.x = cvtpk(y[0], y[1]); w0.y = cvtpk(y[2], y[3]); w0.z = cvtpk(y[4], y[5]); w0.w = cvtpk(y[6], y[7]);
        w1.x = cvtpk(y[8], y[9]); w1.y = cvtpk(y[10], y[11]); w1.z = cvtpk(y[12], y[13]); w1.w = cvtpk(y[14], y[15]);
        *(u32x4*)(A2 + (size_t)row * DM + 16 * F.lane) = w0; *(u32x4*)(A2 + (size_t)row * DM + 16 * F.lane + 8) = w1;
    }
}

__device__ __forceinline__ void phase_hprep_router(unsigned char* lds_, const Params& p, int layer) {
    const Frame F = make_frame(lds_);
    LAS f32x4* Wr = (LAS f32x4*)F.lds;
    LAS int* cnt = (LAS int*)(F.lds + 65536);
    for (int idx = F.tid; idx < 4096; idx += NTHREADS) { const int ln = idx & 63, q = (idx >> 6) & 3, i = (idx >> 8) & 3, j = idx >> 10; const int c = 256 * j + 4 * ln + i;
        Wr[idx] = *(const f32x4*)(p.w_router + (size_t)c * 16 + q * 4); }
    const float* mod = (const float*)(p.ws + WS_MOD) + (size_t)layer * 16 * 6144;
    bf16_t* H = (bf16_t*)(p.ws + WS_H);
    int* blkcnt = (int*)(p.ws + RT_BLKCNT); int* info = (int*)(p.ws + RT_INFO); float* tw = (float*)(p.ws + RT_W);
    if (F.bid == 0) { for (int i = F.tid; i < 256 * DM / 8; i += NTHREADS) *(u32x4*)(H + (size_t)NTOK * DM + i * 8) = (u32x4){0u, 0u, 0u, 0u}; }
    float rb[16];
#pragma unroll
    for (int e = 0; e < 16; ++e) rb[e] = p.router_bias[e];
    for (int chunk = F.bid; chunk < 256; chunk += F.G) {
        if (F.tid < 16) cnt[F.tid] = 0;
        __syncthreads();
        const int row0 = chunk * 128 + F.wave * 16; const int b = row0 / SEQ;
        const RowConst rc = load_rowconst(p.norm2 + (size_t)layer * DM, mod + (size_t)b * 6144, 3072, 4096, F.lane);
        for (int r = 0; r < 16; ++r) { const int row = row0 + r;
            f32x4 v[4], h[4];
#pragma unroll
            for (int j = 0; j < 4; ++j) v[j] = *(const f32x4*)(p.out + (size_t)row * DM + 256 * j + 4 * F.lane);
            row_norm_store(v, rc, h, H + (size_t)row * DM, F.lane);
            float lg[16];
#pragma unroll
            for (int e = 0; e < 16; ++e) lg[e] = 0.f;
#pragma unroll
            for (int j = 0; j < 4; ++j)
#pragma unroll
                for (int i = 0; i < 4; ++i) { const float hv = h[j][i];
#pragma unroll
                    for (int q = 0; q < 4; ++q) { const f32x4 wq = Wr[((j * 4 + i) * 4 + q) * 64 + F.lane]; lg[4 * q] += hv * wq[0]; lg[4 * q + 1] += hv * wq[1]; lg[4 * q + 2] += hv * wq[2]; lg[4 * q + 3] += hv * wq[3]; } }
            float sc[16], bs[16];
#pragma unroll
            for (int e = 0; e < 16; ++e) { const float s = wave_sum(lg[e]); sc[e] = 1.0f / (1.0f + expf(-s)); bs[e] = sc[e] + rb[e]; }
            int gsel = 0; float gbest = -INFINITY;
#pragma unroll
            for (int gI = 0; gI < 4; ++gI) { const float a = bs[4 * gI], b2 = bs[4 * gI + 1], c2 = bs[4 * gI + 2], d2 = bs[4 * gI + 3];
                const float hi1 = fmaxf(a, b2), lo1 = fminf(a, b2), hi2 = fmaxf(c2, d2), lo2 = fminf(c2, d2);
                const float top = fmaxf(hi1, hi2), sec = fmaxf(fminf(hi1, hi2), fmaxf(lo1, lo2)); const float gs = top + sec;
                if (gs > gbest) { gbest = gs; gsel = gI; } }
            float v0 = 0.f, v1 = 0.f, v2 = 0.f, v3 = 0.f, s0 = 0.f, s1 = 0.f, s2 = 0.f, s3 = 0.f;
#pragma unroll
            for (int gI = 0; gI < 4; ++gI) if (gI == gsel) { v0 = bs[4 * gI]; v1 = bs[4 * gI + 1]; v2 = bs[4 * gI + 2]; v3 = bs[4 * gI + 3]; s0 = sc[4 * gI]; s1 = sc[4 * gI + 1]; s2 = sc[4 * gI + 2]; s3 = sc[4 * gI + 3]; }
            int i1 = 0; float b1 = v0; if (v1 > b1) { b1 = v1; i1 = 1; } if (v2 > b1) { b1 = v2; i1 = 2; } if (v3 > b1) { b1 = v3; i1 = 3; }
            int i2 = -1; float bb = -INFINITY;
            if (i1 != 0 && v0 > bb) { bb = v0; i2 = 0; } if (i1 != 1 && v1 > bb) { bb = v1; i2 = 1; } if (i1 != 2 && v2 > bb) { bb = v2; i2 = 2; } if (i1 != 3 && v3 > bb) { bb = v3; i2 = 3; }
            const float sa = (i1 == 0) ? s0 : (i1 == 1) ? s1 : (i1 == 2) ? s2 : s3;
            const float sb = (i2 == 0) ? s0 : (i2 == 1) ? s1 : (i2 == 2) ? s2 : s3;
            const int e0 = gsel * 4 + i1, e1 = gsel * 4 + i2;
            if (F.lane == 0) { const int r0 = __hip_atomic_fetch_add(&cnt[e0], 1, __ATOMIC_RELAXED, __HIP_MEMORY_SCOPE_WORKGROUP); const int r1 = __hip_atomic_fetch_add(&cnt[e1], 1, __ATOMIC_RELAXED, __HIP_MEMORY_SCOPE_WORKGROUP);
                info[row] = e0 | (e1 << 4) | (r0 << 8) | (r1 << 16); const float inv = 1.0f / (sa + sb); *(f32x2*)(tw + (size_t)row * 2) = (f32x2){sa * inv, sb * inv}; }
        }
        __syncthreads();
        if (F.tid < 16) blkcnt[chunk * 16 + F.tid] = cnt[F.tid];
        __syncthreads();
    }
}

__device__ __forceinline__ void phase_layout(unsigned char* lds_, const Params& p) {
    const Frame F = make_frame(lds_);
    LAS int* lc = (LAS int*)F.lds;
    LAS int* tot = lc + 4096;
    LAS int* sst = tot + 16;
    LAS int* tst = sst + 16;
    const int* blkcnt = (const int*)(p.ws + RT_BLKCNT); const int* info = (const int*)(p.ws + RT_INFO);
    int* dest = (int*)(p.ws + RT_DEST); int* buftok = (int*)(p.ws + RT_BUFTOK); int* meta = (int*)(p.ws + RT_META);
    for (int i = F.tid; i < 4096; i += NTHREADS) lc[i] = blkcnt[i];
    __syncthreads();
    { const int e = F.tid >> 5, li = F.tid & 31; int v[8]; int s = 0;
#pragma unroll
      for (int k = 0; k < 8; ++k) { v[k] = lc[(8 * li + k) * 16 + e]; s += v[k]; }
      int inc = s;
#pragma unroll
      for (int d = 1; d < 32; d <<= 1) { const int t = __shfl_up(inc, d, 32); if (li >= d) inc += t; }
      int run = inc - s;
      __syncthreads();
#pragma unroll
      for (int k = 0; k < 8; ++k) { lc[(8 * li + k) * 16 + e] = run; run += v[k]; }
      if (li == 31) tot[e] = inc; }
    __syncthreads();
    if (F.tid == 0) { int ts = 0; for (int e = 0; e < 16; ++e) { tst[e] = ts; sst[e] = ts * 256; ts += (tot[e] + 255) >> 8; } tst[16] = ts;
        if (F.bid == 0) { meta[0] = ts; for (int e = 0; e <= 16; ++e) meta[1 + e] = tst[e]; } }
    __syncthreads();
    for (int chunk = F.bid; chunk < 256; chunk += F.G) {
        if (F.tid < 128) { const int tok = chunk * 128 + F.tid; const int inf = info[tok]; const int e0 = inf & 15, e1 = (inf >> 4) & 15, r0 = (inf >> 8) & 255, r1 = (inf >> 16) & 255;
            const int d0 = sst[e0] + lc[chunk * 16 + e0] + r0, d1 = sst[e1] + lc[chunk * 16 + e1] + r1;
            buftok[d0] = tok; buftok[d1] = tok; dest[tok * 2] = d0; dest[tok * 2 + 1] = d1; }
    }
    for (int e = F.bid; e < 16; e += F.G) { const int beg = sst[e] + tot[e], end = tst[e + 1] * 256; for (int s = beg + F.tid; s < end; s += NTHREADS) buftok[s] = NTOK; }
}

__device__ __forceinline__ void phase_combine(unsigned char* lds_, const Params& p, int layer, bool next_prep) {
    const Frame F = make_frame(lds_);
    const float* mod = (const float*)(p.ws + WS_MOD) + (size_t)layer * 16 * 6144;
    const float* modn = (const float*)(p.ws + WS_MOD) + (size_t)(layer + 1) * 16 * 6144;
    const bf16_t* Y = (const bf16_t*)(p.ws + WS_PROJ); bf16_t* H = (bf16_t*)(p.ws + WS_H);
    const int* dest = (const int*)(p.ws + RT_DEST); const float* tw = (const float*)(p.ws + RT_W);
    for (int chunk = F.bid; chunk < 256; chunk += F.G) {
        const int row0 = chunk * 128 + F.wave * 16; const int b = row0 / SEQ;
        f32x4 g2[4];
#pragma unroll
        for (int j = 0; j < 4; ++j) g2[j] = *(const f32x4*)(mod + (size_t)b * 6144 + 5120 + 256 * j + 4 * F.lane);
        RowConst rc;
        if (next_prep) rc = load_rowconst(p.norm1 + (size_t)(layer + 1) * DM, modn + (size_t)b * 6144, 0, 1024, F.lane);
        for (int r = 0; r < 16; ++r) { const int row = row0 + r;
            const int d0 = dest[row * 2], d1 = dest[row * 2 + 1]; const float w0 = tw[row * 2], w1 = tw[row * 2 + 1];
            f32x4 v[4];
#pragma unroll
            for (int j = 0; j < 4; ++j) { const f32x4 xv = *(const f32x4*)(p.out + (size_t)row * DM + 256 * j + 4 * F.lane);
                const u32x2 ya = *(const u32x2*)(Y + (size_t)d0 * DM + 256 * j + 4 * F.lane), yb = *(const u32x2*)(Y + (size_t)d1 * DM + 256 * j + 4 * F.lane);
                f32x4 yy; yy[0] = w0 * bflo(ya.x) + w1 * bflo(yb.x); yy[1] = w0 * bfhi(ya.x) + w1 * bfhi(yb.x); yy[2] = w0 * bflo(ya.y) + w1 * bflo(yb.y); yy[3] = w0 * bfhi(ya.y) + w1 * bfhi(yb.y);
                v[j] = xv + g2[j] * yy; *(f32x4*)(p.out + (size_t)row * DM + 256 * j + 4 * F.lane) = v[j]; }
            if (next_prep) { f32x4 h[4]; row_norm_store(v, rc, h, H + (size_t)row * DM, F.lane); }
        }
    }
}

__device__ __forceinline__ void phase_qkprep(unsigned char* lds_, const Params& p) {
    const Frame F = make_frame(lds_);
    bf16_t* PR = (bf16_t*)(p.ws + WS_PROJ);
    const int lane = F.lane, half = lane & 1, sh = lane >> 1;
    float nw[32];
    { const float* nsrc = (sh < 16) ? p.b_q_norm : p.b_k_norm;
#pragma unroll
      for (int i = 0; i < 32; ++i) nw[i] = nsrc[half * 32 + i]; }
    const float qscale = (sh < 16) ? 0.125f * 1.4426950408889634f : 1.0f;
    const float invf_tab[8] = {1.0f, 0.19391788f, 0.037604144f, 0.0072920943f, 0.0014140673f, 0.00027421273f, 5.3174683e-05f, 1.0311522e-05f};
    float invf = 0.f;
#pragma unroll
    for (int i = 0; i < 8; ++i) if ((lane & 7) == i) invf = invf_tab[i];
    const int gw = F.bid * NWAVES + F.wave, NGW = F.G * NWAVES;
    for (int row = gw; row < NTOK; row += NGW) {
        const float pos = (float)p.positions[row];
        const float ang = pos * invf;
        const double rev = (double)ang * 0.15915494309189535; const float fr = (float)(rev - rint(rev));
        const float cs = __builtin_amdgcn_cosf(fr), sn = __builtin_amdgcn_sinf(fr);
        bf16_t* ptr = PR + (size_t)row * 3072 + sh * 64 + half * 32;
        u32x4 raw[4];
#pragma unroll
        for (int k = 0; k < 4; ++k) raw[k] = *(const u32x4*)(ptr + 8 * k);
        float v[32];
#pragma unroll
        for (int k = 0; k < 4; ++k)
#pragma unroll
            for (int i = 0; i < 4; ++i) { v[8 * k + 2 * i] = bflo(raw[k][i]); v[8 * k + 2 * i + 1] = bfhi(raw[k][i]); }
        float ss = 0.f;
#pragma unroll
        for (int i = 0; i < 32; ++i) ss += v[i] * v[i];
        ss += __shfl_xor(ss, 1);
        const float r = 1.0f / sqrtf(ss * (1.0f / 64.0f) + EPS);
#pragma unroll
        for (int i = 0; i < 32; ++i) v[i] = v[i] * r * nw[i];
        float y1[8], y2[8];
#pragma unroll
        for (int i = 0; i < 8; ++i) { const float ci = __shfl(cs, i), si = __shfl(sn, i); y1[i] = v[i] * ci - v[8 + i] * si; y2[i] = v[8 + i] * ci + v[i] * si; }
        if (half == 0) {
#pragma unroll
            for (int i = 0; i < 8; ++i) { v[i] = y1[i]; v[8 + i] = y2[i]; } }
#pragma unroll
        for (int k = 0; k < 4; ++k) { u32x4 o;
#pragma unroll
            for (int i = 0; i < 4; ++i) o[i] = cvtpk(v[8 * k + 2 * i] * qscale, v[8 * k + 2 * i + 1] * qscale);
            *(u32x4*)(ptr + 8 * k) = o; }
    }
}

__device__ __forceinline__ void phase_attn(unsigned char* lds_, const Params& p) {
    const Frame F = make_frame(lds_);
    const attn_body::bf16* PR = (const attn_body::bf16*)(p.ws + WS_PROJ); attn_body::bf16* O4 = (attn_body::bf16*)(p.ws + WS_HOUT);
    for (int u = 0; ; ++u) {
        const int pair = F.vcu + (u >> 3) * F.G; if (pair >= 512) break;
        attn_body::attn_unit<8>(pair, 7 - (u & 7), PR, O4, (char*)lds_);
    }
}

__device__ __forceinline__ void phase_ocombine(unsigned char* lds_, const Params& p) {
    const Frame F = make_frame(lds_);
    const bf16_t* O4 = (const bf16_t*)(p.ws + WS_HOUT); bf16_t* A2 = (bf16_t*)(p.ws + WS_H);
    const float lam_init = 0.8f - 0.6f * 0.7408182206817179f;
    const float s1 = wave_sum(p.b_lam_q1[F.lane] * p.b_lam_k1[F.lane]), s2 = wave_sum(p.b_lam_q2[F.lane] * p.b_lam_k2[F.lane]);
    const float lam = expf(s1) - expf(s2) + lam_init;
    const int lane = F.lane, hh = lane >> 3, sub = lane & 7, half = sub >> 2, j0 = (sub & 3) * 16;
    float on[16];
#pragma unroll
    for (int i = 0; i < 16; ++i) on[i] = p.b_o_norm[half * 64 + j0 + i] * (1.0f - lam_init);
    const int gw = F.bid * NWAVES + F.wave, NGW = F.G * NWAVES;
    for (int row = gw; row < NTOK; row += NGW) {
        const bf16_t* pa = O4 + (size_t)row * 2048 + ((hh * 2 + 0) * 2 + half) * 64 + j0; const bf16_t* pb = O4 + (size_t)row * 2048 + ((hh * 2 + 1) * 2 + half) * 64 + j0;
        const u32x4 a0 = *(const u32x4*)pa, a1 = *(const u32x4*)(pa + 8), b0 = *(const u32x4*)pb, b1 = *(const u32x4*)(pb + 8);
        float d[16];
#pragma unroll
        for (int i = 0; i < 4; ++i) { d[2 * i] = bflo(a0[i]) - lam * bflo(b0[i]); d[2 * i + 1] = bfhi(a0[i]) - lam * bfhi(b0[i]); d[8 + 2 * i] = bflo(a1[i]) - lam * bflo(b1[i]); d[8 + 2 * i + 1] = bfhi(a1[i]) - lam * bfhi(b1[i]); }
        float ss = 0.f;
#pragma unroll
        for (int i = 0; i < 16; ++i) ss += d[i] * d[i];
        ss += __shfl_xor(ss, 1); ss += __shfl_xor(ss, 2); ss += __shfl_xor(ss, 4);
        const float r = 1.0f / sqrtf(ss * (1.0f / 128.0f) + EPS);
        u32x4 w0, w1;
        w0.x = cvtpk(d[0] * r * on[0], d[1] * r * on[1]); w0.y = cvtpk(d[2] * r * on[2], d[3] * r * on[3]); w0.z = cvtpk(d[4] * r * on[4], d[5] * r * on[5]); w0.w = cvtpk(d[6] * r * on[6], d[7] * r * on[7]);
        w1.x = cvtpk(d[8] * r * on[8], d[9] * r * on[9]); w1.y = cvtpk(d[10] * r * on[10], d[11] * r * on[11]); w1.z = cvtpk(d[12] * r * on[12], d[13] * r * on[13]); w1.w = cvtpk(d[14] * r * on[14], d[15] * r * on[15]);
        bf16_t* po = A2 + (size_t)row * DM + hh * 128 + half * 64 + j0;
        *(u32x4*)po = w0; *(u32x4*)(po + 8) = w1;
    }
}

#ifndef PHASE_MASK
#define PHASE_MASK 0xFFFFFFFFu
#endif
#define PH(n) ((PHASE_MASK >> (n)) & 1u)

template <int LAYER>
__device__ __forceinline__ void layer_body(const Params& p, const XcdBarrier& bar, unsigned char* lds) {
    const int G_ = gridDim.x, bid_ = blockIdx.x; LAS unsigned char* ldsl = (LAS unsigned char*)lds;
#define SEAM() xcd_barrier(bar)
    const float* mod = (const float*)(p.ws + WS_MOD);
    LAS int* tab = (LAS int*)(ldsl + TAB_OFF);
    if (PH(2)) { pg8::StaticOrder S; S.init(NTOK, 3072, G_, bid_);
      pg8::EpiBf16 E{(bf16_t*)(p.ws + WS_PROJ), 3072, LAYER == 0 ? 2 : 0, LAYER == 0 ? 4 : 0, 0.08838834764831845f};
      pg8::gemm_phase<pg8::EpiBf16, pg8::StaticOrder, false>(ldsl, (const bf16_t*)(p.ws + WS_H), (const bf16_t*)(p.ws + (LAYER == 0 ? WS_WAIN : WS_WBIN)), 0, 1024, S, E, nullptr); }
    SEAM();
    if (LAYER == 0) {
        if (PH(3)) phase_mlstm(lds, p);
        SEAM();
        if (PH(4)) phase_aprep(lds, p);
    } else {
        if (PH(5)) phase_qkprep(lds, p);
        SEAM();
        if (PH(6)) phase_attn(lds, p);
        SEAM();
        if (PH(7)) phase_ocombine(lds, p);
    }
    SEAM();
    if (PH(8)) { pg8::StaticOrder S; S.init(NTOK, 1024, G_, bid_);
      pg8::EpiResid E{LAYER == 0 ? p.x : p.out, p.out, mod + (size_t)LAYER * 16 * 6144 + 2048};
      pg8::gemm_phase<pg8::EpiResid, pg8::StaticOrder, false>(ldsl, (const bf16_t*)(p.ws + WS_H), (const bf16_t*)(p.ws + (LAYER == 0 ? WS_WAOUT : WS_WBOUT)), 0, 1024, S, E, nullptr); }
    SEAM();
    if (PH(9)) phase_hprep_router(lds, p, LAYER);
    SEAM();
    if (PH(10)) phase_layout(lds, p);
    SEAM();
    if (PH(11)) { const int* meta = (const int*)(p.ws + RT_META);
      __syncthreads();
      if ((int)threadIdx.x < 17) tab[(int)threadIdx.x] = meta[1 + (int)threadIdx.x];
      __syncthreads();
      pg8::MoeOrder S{G_, bid_, tab[16], tab};
      pg8::EpiSwiGLU E1{(bf16_t*)(p.ws + WS_HOUT)};
      pg8::gemm_phase<pg8::EpiSwiGLU, pg8::MoeOrder, true>(ldsl, (const bf16_t*)(p.ws + WS_H), (const bf16_t*)(p.ws + WS_WGU) + (size_t)LAYER * 16 * 1024 * 1024, (size_t)1024 * 1024, 1024, S, E1, (const int*)(p.ws + RT_BUFTOK));
      SEAM();
      pg8::EpiBf16 E2{(bf16_t*)(p.ws + WS_PROJ), 1024, 0, 0, 1.0f};
      pg8::gemm_phase<pg8::EpiBf16, pg8::MoeOrder, false>(ldsl, (const bf16_t*)(p.ws + WS_HOUT), (const bf16_t*)(p.ws + WS_WDN) + (size_t)LAYER * 16 * 1024 * 512, (size_t)1024 * 512, 512, S, E2, nullptr); }
    SEAM();
    if (PH(12)) phase_combine(lds, p, LAYER, LAYER == 0);
#undef SEAM
}
__global__ void __launch_bounds__(NTHREADS, 2) mk_fwd(Params p) {
    extern __shared__ __attribute__((aligned(16))) unsigned char lds[];
    cg::grid_group grid = cg::this_grid();
    volatile LAS unsigned* misc = (volatile LAS unsigned*)((LAS unsigned char*)lds + MISC_OFF);
    if (threadIdx.x < 32) misc[threadIdx.x] = 0u;
    __syncthreads();
    unsigned* ctl = (unsigned*)p.ws;
    XcdBarrier bar = xcd_barrier_post(ctl + CW_BAR, misc + 8);
    if (PH(0)) phase_prep(lds, p);
    grid.sync();
    if (PH(1)) phase_hprep0(lds, p);
    xcd_barrier(bar);
    layer_body<0>(p, bar, lds);
    xcd_barrier(bar);
    layer_body<1>(p, bar, lds);
    if (xb_ld(ctl + CW_BAR + XB_TMO) != 0u) { __syncthreads(); for (size_t i = (size_t)blockIdx.x * NTHREADS + threadIdx.x; i < (size_t)NTOK * DM / 4; i += (size_t)gridDim.x * NTHREADS) ((f32x4*)p.out)[i] = (f32x4){1e30f, 1e30f, 1e30f, 1e30f}; }
}

extern "C" void kernel_launch(void* const* d_in, const int* in_sizes, int n_in, void* d_out, int out_size, void* d_ws, size_t ws_size, hipStream_t stream) {
    static int grid_blocks = 0;
    if (!grid_blocks) {
        int dev = 0, cus = 0, per_cu = 0;
        (void)hipGetDevice(&dev);
        (void)hipDeviceGetAttribute(&cus, hipDeviceAttributeMultiprocessorCount, dev);
        (void)hipFuncSetAttribute((const void*)mk_fwd, hipFuncAttributeMaxDynamicSharedMemorySize, LDS_BYTES);
        (void)hipOccupancyMaxActiveBlocksPerMultiprocessor(&per_cu, (const void*)mk_fwd, NTHREADS, LDS_BYTES);
        if (per_cu < 1) { fprintf(stderr, "kernel_launch: occupancy query reports %d blocks/CU\n", per_cu); per_cu = 1; }
        grid_blocks = cus;
        if (ws_size < WS_END || n_in != 24) fprintf(stderr, "kernel_launch: unexpected ws_size %zu (need %zu) or n_in %d\n", ws_size, (size_t)WS_END, n_in);
    }
    (void)hipMemsetAsync(d_ws, 0, CTL_BYTES, stream);
    Params p{};
    const float** pf = (const float**)&p;
    p.x = (const float*)d_in[0]; p.c = (const float*)d_in[1]; p.positions = (const int*)d_in[2]; p.norm1 = (const float*)d_in[3]; p.norm2 = (const float*)d_in[4];
    p.w_ada = (const float*)d_in[5]; p.b_ada = (const float*)d_in[6]; p.a_w_in = (const float*)d_in[7]; p.a_b_if = (const float*)d_in[8]; p.a_h_norm = (const float*)d_in[9];
    p.a_w_out = (const float*)d_in[10]; p.b_w_in = (const float*)d_in[11]; p.b_q_norm = (const float*)d_in[12]; p.b_k_norm = (const float*)d_in[13];
    p.b_lam_q1 = (const float*)d_in[14]; p.b_lam_k1 = (const float*)d_in[15]; p.b_lam_q2 = (const float*)d_in[16]; p.b_lam_k2 = (const float*)d_in[17];
    p.b_o_norm = (const float*)d_in[18]; p.b_w_out = (const float*)d_in[19]; p.w_router = (const float*)d_in[20]; p.router_bias = (const float*)d_in[21];
    p.moe_w_gu = (const float*)d_in[22]; p.moe_w_down = (const float*)d_in[23];
    p.out = (float*)d_out; p.ws = (unsigned char*)d_ws; (void)pf;
    void* args[] = {&p};
    hipError_t e = hipLaunchCooperativeKernel((const void*)mk_fwd, dim3(grid_blocks), dim3(NTHREADS), args, LDS_BYTES, stream);
    if (e != hipSuccess) fprintf(stderr, "cooperative launch failed: %s (grid %d)\n", hipGetErrorString(e), grid_blocks);
}
```

```cpp
#include <hip/hip_runtime.h>
#include <hip/hip_cooperative_groups.h>
#include <hip/hip_bf16.h>
#include <cstdio>
#include <cstdint>
#include <cmath>
namespace cg = cooperative_groups;

#define GAS __attribute__((address_space(1)))
#define LAS __attribute__((address_space(3)))
typedef unsigned short bf16_t;
typedef float f32x4 __attribute__((ext_vector_type(4)));
typedef float f32x2 __attribute__((ext_vector_type(2)));
typedef short bf16x8 __attribute__((ext_vector_type(8)));
typedef short s16x4 __attribute__((ext_vector_type(4)));
typedef unsigned u32x4 __attribute__((ext_vector_type(4)));
typedef unsigned u32x2 __attribute__((ext_vector_type(2)));
typedef __bf16 bf16x2_t __attribute__((ext_vector_type(2)));
typedef int i32x8 __attribute__((ext_vector_type(8)));

constexpr int NTOK = 32768, DM = 1024, SEQ = 2048, NB = 16;
constexpr int NEXP = 16, DEXP = 512;
constexpr int NTHREADS = 512, NWAVES = 8;
constexpr int LDS_BYTES = 147456;
constexpr int MISC_OFF = LDS_BYTES - 128;
constexpr int TAB_OFF = 131072;
constexpr float EPS = 1e-6f;
constexpr int MAXTILES = 272, CAP = MAXTILES * 256;
constexpr float S8_H = 8.0f, S8_WGU = 256.0f, S8_ACT = 4.0f, S8_WDN = 128.0f;

constexpr size_t MiB = 1u << 20;
constexpr size_t WS_CTL = 0, CTL_BYTES = 1 * MiB;
constexpr int CW_BAR = 4096;
constexpr size_t WS_MOD = 1 * MiB;
constexpr size_t WS_ROUTE = 2 * MiB;
constexpr size_t RT_BLKCNT = WS_ROUTE;
constexpr size_t RT_INFO = WS_ROUTE + 64 * 1024;
constexpr size_t RT_W = RT_INFO + 128 * 1024;
constexpr size_t RT_DEST = RT_W + 256 * 1024;
constexpr size_t RT_BUFTOK = RT_DEST + 256 * 1024;
constexpr size_t RT_META = RT_BUFTOK + 320 * 1024;
constexpr size_t WS_GATES = 4 * MiB;
constexpr size_t WS_WAIN = 6 * MiB, WS_WAOUT = 12 * MiB, WS_WBIN = 14 * MiB, WS_WBOUT = 20 * MiB;
constexpr size_t WS_WGU = 22 * MiB;
constexpr size_t WS_WDN = 86 * MiB;
constexpr size_t WS_H = 118 * MiB;
constexpr size_t WS_PROJ = 184 * MiB;
constexpr size_t WS_HOUT = 376 * MiB;
constexpr size_t WS_END = 504 * MiB;

__device__ __forceinline__ unsigned cvtpk(float lo, float hi) { f32x2 v = {lo, hi}; bf16x2_t b = __builtin_convertvector(v, bf16x2_t); return __builtin_bit_cast(unsigned, b); }
__device__ __forceinline__ float clamp448(float v) { return fminf(fmaxf(v, -448.0f), 448.0f); }
__device__ __forceinline__ unsigned cvt4_fp8(float a, float b, float c, float d) {
    int w = __builtin_amdgcn_cvt_pk_fp8_f32(clamp448(a), clamp448(b), 0, false); w = __builtin_amdgcn_cvt_pk_fp8_f32(clamp448(c), clamp448(d), w, true); return (unsigned)w; }
__device__ __forceinline__ float bf2f(unsigned short h) { return __uint_as_float(((unsigned)h) << 16); }
__device__ __forceinline__ float bflo(unsigned w) { return __uint_as_float(w << 16); }
__device__ __forceinline__ float bfhi(unsigned w) { return __uint_as_float(w & 0xffff0000u); }
__device__ __forceinline__ float wave_sum(float v) {
#pragma unroll
    for (int o = 1; o < 64; o <<= 1) v += __shfl_xor(v, o);
    return v;
}
__device__ __forceinline__ float sigmoidf_(float x) { return 1.0f / (1.0f + __expf(-x)); }

#define XB_TMO      128
#define XB_XCNT(j)  (256  + 64 * (j))
#define XB_XSUB(j)  (1280 + 64 * (j))
#define XB_XGEN(j)  (2304 + 64 * (j))
#define XB_TOP      3328
#define XB_TOPGEN   3392
#define XCD_BAR_WORDS 3456
#define XB_SPIN_CAP (1u << 18)
__device__ __forceinline__ unsigned xb_ld(unsigned* p)              { return __hip_atomic_load(p, __ATOMIC_RELAXED, __HIP_MEMORY_SCOPE_AGENT); }
__device__ __forceinline__ unsigned xb_add(unsigned* p, unsigned v) { return __hip_atomic_fetch_add(p, v, __ATOMIC_RELAXED, __HIP_MEMORY_SCOPE_AGENT); }
__device__ __forceinline__ unsigned xb_xcc_id() { return (unsigned)__builtin_amdgcn_s_getreg((3 << 11) | 20) & 0xFu; }
#define XB_SPIN(cond, bar) do { unsigned _sp = 0; while (cond) { __builtin_amdgcn_s_sleep(1); \
    if ((++_sp & 255u) == 0u) { if (xb_ld(&(bar)[XB_TMO])) break; if (_sp > XB_SPIN_CAP) { atomicAdd(&(bar)[XB_TMO], 1u); break; } } } } while (0)
struct XcdBarrier { unsigned* bar; unsigned x; volatile LAS unsigned* st; };
__device__ __forceinline__ XcdBarrier xcd_barrier_post(unsigned* bar, volatile LAS unsigned* st) {
    XcdBarrier b; b.bar = bar; b.x = xb_xcc_id(); b.st = st;
    if (threadIdx.x == 0) (void)xb_add(&bar[XB_XCNT(b.x)], 1u);
    return b;
}
__device__ __forceinline__ void xcd_barrier_complete(unsigned* bar, unsigned x, unsigned& nloc, unsigned& nx) {
    const unsigned G = gridDim.x * gridDim.y * gridDim.z;
    unsigned sum, cnt, mine, sp = 0u;
    for (;;) {
        sum = 0u; cnt = 0u; mine = 0u;
#pragma unroll
        for (unsigned j = 0; j < 16; ++j) { const unsigned c = xb_ld(&bar[XB_XCNT(j)]); sum += c; cnt += (c > 0u) ? 1u : 0u; mine = (j == x) ? c : mine; }
        if (sum == G) break;
        __builtin_amdgcn_s_sleep(1);
        if ((++sp & 255u) == 0u) { if (xb_ld(&bar[XB_TMO])) break; if (sp > XB_SPIN_CAP) { atomicAdd(&bar[XB_TMO], 1u); break; } }
    }
    nloc = mine > 0u ? mine : 1u; nx = cnt > 0u ? cnt : 1u;
}
__device__ __forceinline__ void xcd_barrier(const XcdBarrier& b) {
    asm volatile("s_waitcnt vmcnt(0)" ::: "memory");
    __syncthreads();
    if (threadIdx.x == 0) {
        unsigned* bar = b.bar;
        __builtin_amdgcn_s_waitcnt(0);
        unsigned nloc = b.st[0], nx = b.st[1];
        if (nloc == 0u) { xcd_barrier_complete(bar, b.x, nloc, nx); b.st[0] = nloc; b.st[1] = nx; }
        const unsigned old = xb_add(&bar[XB_XSUB(b.x)], 1u);
        const unsigned gen = old / nloc;
        if (old + 1u == (gen + 1u) * nloc) {
            __builtin_amdgcn_fence(__ATOMIC_RELEASE, "agent");
            asm volatile("s_waitcnt vmcnt(0)" ::: "memory");
            const unsigned og = xb_add(&bar[XB_TOP], 1u);
            const unsigned tg = og / nx;
            if (og + 1u == (tg + 1u) * nx) xb_add(&bar[XB_TOPGEN], 1u);
            else XB_SPIN(xb_ld(&bar[XB_TOPGEN]) == tg, bar);
            __builtin_amdgcn_fence(__ATOMIC_ACQUIRE, "agent");
            xb_add(&bar[XB_XGEN(b.x)], 1u);
            asm volatile("s_waitcnt vmcnt(0)" ::: "memory");
        } else {
            XB_SPIN(xb_ld(&bar[XB_XGEN(b.x)]) == gen, bar);
            __builtin_amdgcn_fence(__ATOMIC_ACQUIRE, "agent");
            asm volatile("s_waitcnt vmcnt(0)" ::: "memory");
        }
    }
    __syncthreads();
}

namespace pg8 {
constexpr int BM = 256, BK = 64, HALF = 128, HTB = HALF * BK * 2, STAGE_BYTES = 8 * HTB, NXCD = 8, WGM = 8;
__device__ __forceinline__ int lds_byte(int r, int c) { const int st = (r >> 4) * 2 + (c >> 5), rr = r & 15, cc = c & 31, ob = rr * 64 + cc * 2; return st * 1024 + (ob ^ (((ob >> 9) & 1) << 5)); }
__device__ __forceinline__ void stage_rc(int b, int& R, int& C) { const int st = b / 1024, sb = b % 1024, swz = sb ^ (((sb >> 9) & 1) << 5); R = (st >> 1) * 16 + swz / 64; C = (st & 1) * 32 + (swz % 64) / 2; }
__device__ __forceinline__ int perm32(int rho) { const int n = rho >> 4, i = rho & 15; return 8 * (i >> 2) + 4 * n + (i & 3); }

struct Unit { int pm, pn, e; };

struct StaticOrder {
    int nM, nN, nwg, G, c;
    __device__ void init(int M, int N, int G_, int c_) { nM = M / BM; nN = N / BM; nwg = nM * nN; G = G_; c = c_; }
    __device__ __forceinline__ bool next(int i, Unit& u) const {
        const long L = (long)i * G + c; if (L >= nwg) return false;
        int wgid = (int)L; { const int q = nwg / NXCD, r = nwg % NXCD, xcd = wgid % NXCD, off = wgid / NXCD; wgid = (xcd < r ? xcd * (q + 1) : r * (q + 1) + (xcd - r) * q) + off; }
        const int nig = WGM * nN, gid = wgid / nig, fm = gid * WGM, gsz = (nM - fm) < WGM ? (nM - fm) : WGM;
        u.pm = __builtin_amdgcn_readfirstlane(fm + ((wgid % nig) % gsz)); u.pn = __builtin_amdgcn_readfirstlane((wgid % nig) / gsz); u.e = 0; return true;
    }
};
struct MoeOrder {
    int G, c, ntiles; const LAS int* ts;
    __device__ __forceinline__ bool next(int i, Unit& u) const {
        const int L = i * G + c; const int tile = L >> 2; if (tile >= ntiles) return false;
        int e = 0;
#pragma unroll
        for (int k = 1; k < 16; ++k) e += (tile >= ts[k]) ? 1 : 0;
        u.pm = __builtin_amdgcn_readfirstlane(tile); u.pn = __builtin_amdgcn_readfirstlane(L & 3); u.e = __builtin_amdgcn_readfirstlane(e); return true;
    }
};

struct EpiBf16 {
    static constexpr bool PERM = true;
    bf16_t* O; int ldc; int s_lo, s_hi; float scale;
    __device__ __forceinline__ void operator()(const f32x4 (&acc)[2][2][4][2], const Unit& u, int wr, int wc, int fr, int fq) const {
        const int row0 = u.pm * BM + wr * 64 + fr; const int col0 = u.pn * BM + wc * 32 + 8 * fq;
        const float sc = (u.pn >= s_lo && u.pn < s_hi) ? scale : 1.0f;
#pragma unroll
        for (int ai = 0; ai < 2; ++ai)
#pragma unroll
            for (int m = 0; m < 4; ++m) { bf16_t* rowp = O + (size_t)(row0 + ai * HALF + m * 16) * ldc + col0;
#pragma unroll
                for (int bj = 0; bj < 2; ++bj) { const f32x4 v0 = acc[ai][bj][m][0] * sc, v1 = acc[ai][bj][m][1] * sc;
                    u32x4 w; w.x = cvtpk(v0[0], v0[1]); w.y = cvtpk(v0[2], v0[3]); w.z = cvtpk(v1[0], v1[1]); w.w = cvtpk(v1[2], v1[3]);
                    *(u32x4*)(rowp + bj * HALF) = w; } }
    }
};
struct EpiSwiGLU {
    static constexpr bool PERM = true;
    bf16_t* O;
    __device__ __forceinline__ void operator()(const f32x4 (&acc)[2][2][4][2], const Unit& u, int wr, int wc, int fr, int fq) const {
        const int row0 = u.pm * BM + wr * 64 + fr; const int col0 = u.pn * 128 + wc * 32 + 8 * fq;
#pragma unroll
        for (int ai = 0; ai < 2; ++ai)
#pragma unroll
            for (int m = 0; m < 4; ++m) { bf16_t* rowp = O + (size_t)(row0 + ai * HALF + m * 16) * DEXP + col0;
                float a[8];
#pragma unroll
                for (int n = 0; n < 2; ++n)
#pragma unroll
                    for (int j = 0; j < 4; ++j) { const float g = acc[ai][0][m][n][j], up = acc[ai][1][m][n][j]; a[n * 4 + j] = g * up / (1.0f + __expf(-g)); }
                u32x4 w; w.x = cvtpk(a[0], a[1]); w.y = cvtpk(a[2], a[3]); w.z = cvtpk(a[4], a[5]); w.w = cvtpk(a[6], a[7]);
                *(u32x4*)rowp = w; }
    }
};
struct EpiResid {
    static constexpr bool PERM = false;
    const float* base; float* out; const float* gate;
    __device__ __forceinline__ void operator()(const f32x4 (&acc)[2][2][4][2], const Unit& u, int wr, int wc, int fr, int fq) const {
        const int row0 = u.pm * BM + wr * 64 + fr, col0 = u.pn * BM + wc * 32 + 4 * fq;
        const int b = (u.pm * BM) / SEQ;
        f32x4 gv[2][2];
#pragma unroll
        for (int bj = 0; bj < 2; ++bj)
#pragma unroll
            for (int n = 0; n < 2; ++n) gv[bj][n] = *(const f32x4*)(gate + (size_t)b * 6144 + col0 + bj * HALF + n * 16);
#pragma unroll
        for (int ai = 0; ai < 2; ++ai)
#pragma unroll
            for (int m = 0; m < 4; ++m) { const size_t off = (size_t)(row0 + ai * HALF + m * 16) * DM + col0;
#pragma unroll
                for (int bj = 0; bj < 2; ++bj)
#pragma unroll
                    for (int n = 0; n < 2; ++n) { const f32x4 bs = *(const f32x4*)(base + off + bj * HALF + n * 16);
                        *(f32x4*)(out + off + bj * HALF + n * 16) = bs + gv[bj][n] * acc[ai][bj][m][n]; }
                asm volatile("" ::: "memory"); }
    }
};

template <class Epi, class Sched, bool GATHER>
__device__ __forceinline__ void gemm_phase(LAS unsigned char* lds, const bf16_t* A, const bf16_t* Bt, size_t bstride, int K, const Sched& S, const Epi& E, const int* aidx) {
    int tid = threadIdx.x; asm volatile("" : "+v"(tid));
    const int wid = __builtin_amdgcn_readfirstlane(tid >> 6), lane = tid & 63, wr = wid >> 2, wc = wid & 3, fr = lane & 15, fq = lane >> 4;
    const int nt = K / BK;
    int RA[2], CA[2]; unsigned voffB[2];
#pragma unroll
    for (int i = 0; i < 2; ++i) { int R, C; stage_rc(tid * 16 + i * 8192, R, C); const int Rb = Epi::PERM ? ((R & ~31) + perm32(R & 31)) : R;
        RA[i] = R; CA[i] = C; voffB[i] = (unsigned)(Rb * K + C) * 2u; }
    const size_t kstep = (size_t)(BK * 2);
    const size_t hstep = (size_t)HALF * K * 2;
    const size_t tstep = 2 * hstep;
    const unsigned ldsw = (unsigned)wid * 1024u;
    const int aoff = lds_byte(wr * 64 + fr, fq * 8), boff = lds_byte(wc * 32 + fr, fq * 8);
#define PG8_SA(b, h) (((b) * 2 + (h)) * HTB)
#define PG8_SB(b, h) ((4 + (b) * 2 + (h)) * HTB)
#define PG8_STAGE(bufoff, gbase, voff) do { _Pragma("unroll") for (int _i = 0; _i < 2; ++_i) \
        __builtin_amdgcn_global_load_lds((const unsigned*)((const char*)(gbase) + (voff)[_i]), (LAS unsigned*)(lds + (bufoff) + ldsw + _i * 8192), 16, 0, 0); } while (0)
#define PG8_LDA(dst, b, h) do { _Pragma("unroll") for (int m = 0; m < 4; ++m) _Pragma("unroll") for (int k = 0; k < 2; ++k) dst[m][k] = *(const LAS bf16x8*)(lds + PG8_SA(b, h) + aoff + m * 2048 + k * 1024); } while (0)
#define PG8_LDB(dst, b, h) do { _Pragma("unroll") for (int n = 0; n < 2; ++n) _Pragma("unroll") for (int k = 0; k < 2; ++k) dst[n][k] = *(const LAS bf16x8*)(lds + PG8_SB(b, h) + boff + n * 2048 + k * 1024); } while (0)
#define PG8_MMA(ai, bj, At, Bt_) do { __builtin_amdgcn_s_setprio(1); _Pragma("unroll") for (int m = 0; m < 4; ++m) _Pragma("unroll") for (int n = 0; n < 2; ++n) _Pragma("unroll") for (int k = 0; k < 2; ++k) \
        acc[ai][bj][m][n] = __builtin_amdgcn_mfma_f32_16x16x32_bf16(Bt_[n][k], At[m][k], acc[ai][bj][m][n], 0, 0, 0); __builtin_amdgcn_s_setprio(0); } while (0)
#define PG8_WAIT_V(n) asm volatile("s_waitcnt vmcnt(" #n ")" ::: "memory")
#define PG8_WAIT_L(n) asm volatile("s_waitcnt lgkmcnt(" #n ")" ::: "memory")
#define PG8_BAR __builtin_amdgcn_s_barrier()
#define PG8_SCHED __builtin_amdgcn_sched_barrier(0)
#define PG8_AOFF(dst, U) do { _Pragma("unroll") for (int _h = 0; _h < 2; ++_h) _Pragma("unroll") for (int _i = 0; _i < 2; ++_i) { \
        const int _row = (U).pm * BM + _h * HALF + RA[_i]; const int _src = GATHER ? aidx[_row] : _row; dst[_h][_i] = (unsigned)(_src * K + CA[_i]) * 2u; } } while (0)
#define PG8_STAGE_A(bufoff, kb, offs, h) do { _Pragma("unroll") for (int _i = 0; _i < 2; ++_i) \
        __builtin_amdgcn_global_load_lds((const unsigned*)((const char*)A + (kb) + (offs)[h][_i]), (LAS unsigned*)(lds + (bufoff) + ldsw + _i * 8192), 16, 0, 0); } while (0)
    Unit cur, nxt; int ui = 0;
    if (!S.next(0, cur)) return;
    f32x4 acc[2][2][4][2];
#pragma unroll
    for (int a = 0; a < 2; ++a)
#pragma unroll
        for (int b = 0; b < 2; ++b)
#pragma unroll
            for (int m = 0; m < 4; ++m)
#pragma unroll
                for (int n = 0; n < 2; ++n) acc[a][b][m][n] = (f32x4){0.f, 0.f, 0.f, 0.f};
    bf16x8 At[4][2], B0[2][2], B1[2][2];
    unsigned ac[2][2], an[2][2];
    PG8_AOFF(ac, cur);
    const char* cB = (const char*)Bt + ((size_t)cur.e * bstride) * 2 + (size_t)cur.pn * tstep;
    PG8_STAGE(PG8_SB(0, 0), cB, voffB); PG8_STAGE(PG8_SB(0, 1), cB + hstep, voffB); PG8_STAGE_A(PG8_SA(0, 0), 0, ac, 0); PG8_STAGE_A(PG8_SA(0, 1), 0, ac, 1);
    if (wr == 1) PG8_BAR;
    PG8_WAIT_V(2); PG8_BAR;
    PG8_STAGE(PG8_SB(1, 0), cB + kstep, voffB); PG8_STAGE_A(PG8_SA(1, 0), kstep, ac, 0); PG8_STAGE(PG8_SB(1, 1), cB + hstep + kstep, voffB);
    PG8_WAIT_V(6); PG8_BAR;
    for (;;) {
        const bool has_next = S.next(ui + 1, nxt);
        if (has_next) { PG8_AOFF(an, nxt); } else {
#pragma unroll
            for (int h = 0; h < 2; ++h)
#pragma unroll
                for (int i = 0; i < 2; ++i) an[h][i] = ac[h][i]; }
        const char* nB = has_next ? (const char*)Bt + ((size_t)nxt.e * bstride) * 2 + (size_t)nxt.pn * tstep : cB;
#pragma unroll 1
        for (int t = 0; t < nt; t += 2) {
            const bool last = (t == nt - 2);
            const size_t k1 = (size_t)(t + 1) * kstep;
            const size_t k2 = last ? 0 : (size_t)(t + 2) * kstep;
            const size_t k3 = k2 + kstep;
            const char* b2 = last ? nB : cB + (size_t)(t + 2) * kstep; const char* b3 = b2 + kstep;
            unsigned a2[2][2];
#pragma unroll
            for (int h = 0; h < 2; ++h)
#pragma unroll
                for (int i = 0; i < 2; ++i) a2[h][i] = last ? an[h][i] : ac[h][i];
            PG8_LDB(B0, 0, 0); PG8_LDB(B1, 0, 1); PG8_SCHED; PG8_LDA(At, 0, 0); PG8_STAGE_A(PG8_SA(1, 1), k1, ac, 1);
            PG8_WAIT_V(8); PG8_WAIT_L(0); PG8_BAR; PG8_MMA(0, 0, At, B0); PG8_MMA(0, 1, At, B1); PG8_BAR; PG8_SCHED;
            PG8_LDA(At, 0, 1); PG8_STAGE(PG8_SB(0, 0), b2, voffB); PG8_STAGE(PG8_SB(0, 1), b2 + hstep, voffB); PG8_STAGE_A(PG8_SA(0, 0), k2, a2, 0);
            PG8_WAIT_V(8); PG8_WAIT_L(0); PG8_BAR; PG8_MMA(1, 0, At, B0); PG8_MMA(1, 1, At, B1); PG8_BAR; PG8_SCHED;
            PG8_LDB(B0, 1, 0); PG8_LDB(B1, 1, 1); PG8_SCHED; PG8_LDA(At, 1, 0); PG8_STAGE_A(PG8_SA(0, 1), k2, a2, 1);
            PG8_WAIT_V(8); PG8_WAIT_L(0); PG8_BAR; PG8_MMA(0, 0, At, B0); PG8_MMA(0, 1, At, B1); PG8_BAR; PG8_SCHED;
            PG8_LDA(At, 1, 1); PG8_STAGE(PG8_SB(1, 0), b3, voffB); PG8_STAGE(PG8_SB(1, 1), b3 + hstep, voffB); PG8_STAGE_A(PG8_SA(1, 0), k3, a2, 0);
            PG8_WAIT_V(8); PG8_WAIT_L(0); PG8_BAR; PG8_MMA(1, 0, At, B0); PG8_MMA(1, 1, At, B1); PG8_BAR; PG8_SCHED;
        }
        if (wr == 0) PG8_BAR;
        E(acc, cur, wr, wc, fr, fq);
        if (!has_next) break;
#pragma unroll
        for (int a = 0; a < 2; ++a)
#pragma unroll
            for (int b = 0; b < 2; ++b)
#pragma unroll
                for (int m = 0; m < 4; ++m)
#pragma unroll
                    for (int n = 0; n < 2; ++n) acc[a][b][m][n] = (f32x4){0.f, 0.f, 0.f, 0.f};
        cur = nxt; cB = nB; ++ui;
#pragma unroll
        for (int h = 0; h < 2; ++h)
#pragma unroll
            for (int i = 0; i < 2; ++i) ac[h][i] = an[h][i];
        if (wr == 1) PG8_BAR;
    }
    PG8_WAIT_V(0);
    PG8_BAR;
#undef PG8_SA
#undef PG8_SB
#undef PG8_STAGE
#undef PG8_LDA
#undef PG8_LDB
#undef PG8_MMA
#undef PG8_WAIT_V
#undef PG8_WAIT_L
#undef PG8_BAR
#undef PG8_SCHED
#undef PG8_AOFF
#undef PG8_STAGE_A
}

__device__ __forceinline__ int x8(int e) { return e ^ ((((e >> 1) ^ (e >> 2)) & 1) << 1); }
struct EpiSwiGLU8 {
    static constexpr bool PERM = true;
    unsigned char* O; float descale;
    __device__ __forceinline__ void operator()(const f32x4 (&acc)[2][2][4][2], const Unit& u, int wr, int wc, int fr, int fq) const {
        const int row0 = u.pm * BM + wr * 64 + fr; const int col0 = u.pn * 128 + wc * 32 + 8 * fq;
#pragma unroll
        for (int ai = 0; ai < 2; ++ai)
#pragma unroll
            for (int m = 0; m < 4; ++m) { unsigned char* rowp = O + (size_t)(row0 + ai * HALF + m * 16) * DEXP + col0;
                float a[8];
#pragma unroll
                for (int n = 0; n < 2; ++n)
#pragma unroll
                    for (int j = 0; j < 4; ++j) { const float g = acc[ai][0][m][n][j] * descale, up = acc[ai][1][m][n][j] * descale; a[n * 4 + j] = S8_ACT * g * up / (1.0f + __expf(-g)); }
                u32x2 w; w.x = cvt4_fp8(a[0], a[1], a[2], a[3]); w.y = cvt4_fp8(a[4], a[5], a[6], a[7]);
                *(u32x2*)rowp = w; }
    }
};
template <class Epi, class Sched, bool GATHER>
__device__ __forceinline__ void gemm_phase8(LAS unsigned char* lds, const unsigned char* A, const unsigned char* Bt, size_t bstride, int Kb, const Sched& S, const Epi& E, const int* aidx) {
    int tid = threadIdx.x; asm volatile("" : "+v"(tid));
    const int wid = __builtin_amdgcn_readfirstlane(tid >> 6), lane = tid & 63, wr = wid >> 2, wc = wid & 3, fr = lane & 15, fq = lane >> 4;
    const int nt = Kb / 128;
    int RA[2], CA[2]; unsigned voffB[2];
#pragma unroll
    for (int i = 0; i < 2; ++i) { const int b = tid * 16 + i * 8192; const int R = b >> 7, pc = (b >> 4) & 7; const int C = (pc ^ x8((R >> 1) & 7)) * 16;
        const int Rb = Epi::PERM ? ((R & ~31) + perm32(R & 31)) : R;
        RA[i] = R; CA[i] = C; voffB[i] = (unsigned)(Rb * Kb + C); }
    const size_t kstep = 128;
    const size_t hstep = (size_t)HALF * Kb;
    const size_t tstep = 2 * hstep;
    const unsigned ldsw = (unsigned)wid * 1024u;
    const int xa = x8((fr >> 1) & 7);
    const int aoff = (wr * 64 + fr) * 128 + (((2 * fq) ^ xa) << 4), boff = (wc * 32 + fr) * 128 + (((2 * fq) ^ xa) << 4);
    const int aoff1 = aoff ^ 16, boff1 = boff ^ 16;
#define PG8_SA(b, h) (((b) * 2 + (h)) * HTB)
#define PG8_SB(b, h) ((4 + (b) * 2 + (h)) * HTB)
#define PG8_STAGE(bufoff, gbase, voff) do { _Pragma("unroll") for (int _i = 0; _i < 2; ++_i) \
        __builtin_amdgcn_global_load_lds((const unsigned*)((const char*)(gbase) + (voff)[_i]), (LAS unsigned*)(lds + (bufoff) + ldsw + _i * 8192), 16, 0, 0); } while (0)
#define PG8_RD32(dst, off, off1) do { const u32x4 _lo = *(const LAS u32x4*)(lds + (off)), _hi = *(const LAS u32x4*)(lds + (off1)); \
        dst = (i32x8){(int)_lo.x, (int)_lo.y, (int)_lo.z, (int)_lo.w, (int)_hi.x, (int)_hi.y, (int)_hi.z, (int)_hi.w}; } while (0)
#define PG8_LDA(dst, b, h) do { _Pragma("unroll") for (int m = 0; m < 4; ++m) PG8_RD32(dst[m], PG8_SA(b, h) + aoff + m * 2048, PG8_SA(b, h) + aoff1 + m * 2048); } while (0)
#define PG8_LDB(dst, b, h) do { _Pragma("unroll") for (int n = 0; n < 2; ++n) PG8_RD32(dst[n], PG8_SB(b, h) + boff + n * 2048, PG8_SB(b, h) + boff1 + n * 2048); } while (0)
#define PG8_MMA(ai, bj, At, Bt_) do { __builtin_amdgcn_s_setprio(1); _Pragma("unroll") for (int m = 0; m < 4; ++m) _Pragma("unroll") for (int n = 0; n < 2; ++n) \
        asm volatile("v_mfma_scale_f32_16x16x128_f8f6f4 %0, %1, %2, %0, %3, %3 op_sel_hi:[0,0,0]" : "+v"(acc[ai][bj][m][n]) : "v"(Bt_[n]), "v"(At[m]), "v"(sc1)); __builtin_amdgcn_s_setprio(0); } while (0)
#define PG8_WAIT_V(n) asm volatile("s_waitcnt vmcnt(" #n ")" ::: "memory")
#define PG8_WAIT_L(n) asm volatile("s_waitcnt lgkmcnt(" #n ")" ::: "memory")
#define PG8_BAR __builtin_amdgcn_s_barrier()
#define PG8_SCHED __builtin_amdgcn_sched_barrier(0)
#define PG8_AOFF(dst, U) do { _Pragma("unroll") for (int _h = 0; _h < 2; ++_h) _Pragma("unroll") for (int _i = 0; _i < 2; ++_i) { \
        const int _row = (U).pm * BM + _h * HALF + RA[_i]; const int _src = GATHER ? aidx[_row] : _row; dst[_h][_i] = (unsigned)(_src * Kb + CA[_i]); } } while (0)
#define PG8_STAGE_A(bufoff, kb, offs, h) do { _Pragma("unroll") for (int _i = 0; _i < 2; ++_i) \
        __builtin_amdgcn_global_load_lds((const unsigned*)((const char*)A + (kb) + (offs)[h][_i]), (LAS unsigned*)(lds + (bufoff) + ldsw + _i * 8192), 16, 0, 0); } while (0)
    Unit cur, nxt; int ui = 0;
    if (!S.next(0, cur)) return;
    f32x4 acc[2][2][4][2];
#pragma unroll
    for (int a = 0; a < 2; ++a)
#pragma unroll
        for (int b = 0; b < 2; ++b)
#pragma unroll
            for (int m = 0; m < 4; ++m)
#pragma unroll
                for (int n = 0; n < 2; ++n) acc[a][b][m][n] = (f32x4){0.f, 0.f, 0.f, 0.f};
    i32x8 At[4], B0[2], B1[2];
    int sc1 = 0x7F7F7F7F; asm volatile("" : "+v"(sc1));
    unsigned ac[2][2], an[2][2];
    PG8_AOFF(ac, cur);
    const char* cB = (const char*)Bt + (size_t)cur.e * bstride + (size_t)cur.pn * tstep;
    PG8_STAGE(PG8_SB(0, 0), cB, voffB); PG8_STAGE(PG8_SB(0, 1), cB + hstep, voffB); PG8_STAGE_A(PG8_SA(0, 0), 0, ac, 0); PG8_STAGE_A(PG8_SA(0, 1), 0, ac, 1);
    if (wr == 1) PG8_BAR;
    PG8_WAIT_V(2); PG8_BAR;
    PG8_STAGE(PG8_SB(1, 0), cB + kstep, voffB); PG8_STAGE_A(PG8_SA(1, 0), kstep, ac, 0); PG8_STAGE(PG8_SB(1, 1), cB + hstep + kstep, voffB);
    PG8_WAIT_V(6); PG8_BAR;
    for (;;) {
        const bool has_next = S.next(ui + 1, nxt);
        if (has_next) { PG8_AOFF(an, nxt); } else {
#pragma unroll
            for (int h = 0; h < 2; ++h)
#pragma unroll
                for (int i = 0; i < 2; ++i) an[h][i] = ac[h][i]; }
        const char* nB = has_next ? (const char*)Bt + (size_t)nxt.e * bstride + (size_t)nxt.pn * tstep : cB;
#pragma unroll 1
        for (int t = 0; t < nt; t += 2) {
            const bool last = (t == nt - 2);
            const size_t k1 = (size_t)(t + 1) * kstep;
            const size_t k2 = last ? 0 : (size_t)(t + 2) * kstep;
            const size_t k3 = k2 + kstep;
            const char* b2 = last ? nB : cB + (size_t)(t + 2) * kstep; const char* b3 = b2 + kstep;
            unsigned a2[2][2];
#pragma unroll
            for (int h = 0; h < 2; ++h)
#pragma unroll
                for (int i = 0; i < 2; ++i) a2[h][i] = last ? an[h][i] : ac[h][i];
            PG8_LDB(B0, 0, 0); PG8_LDB(B1, 0, 1); PG8_SCHED; PG8_LDA(At, 0, 0); PG8_STAGE_A(PG8_SA(1, 1), k1, ac, 1);
            PG8_WAIT_V(8); PG8_WAIT_L(0); PG8_BAR; PG8_MMA(0, 0, At, B0); PG8_MMA(0, 1, At, B1); PG8_BAR; PG8_SCHED;
            PG8_LDA(At, 0, 1); PG8_STAGE(PG8_SB(0, 0), b2, voffB); PG8_STAGE(PG8_SB(0, 1), b2 + hstep, voffB); PG8_STAGE_A(PG8_SA(0, 0), k2, a2, 0);
            PG8_WAIT_V(8); PG8_WAIT_L(0); PG8_BAR; PG8_MMA(1, 0, At, B0); PG8_MMA(1, 1, At, B1); PG8_BAR; PG8_SCHED;
            PG8_LDB(B0, 1, 0); PG8_LDB(B1, 1, 1); PG8_SCHED; PG8_LDA(At, 1, 0); PG8_STAGE_A(PG8_SA(0, 1), k2, a2, 1);
            PG8_WAIT_V(8); PG8_WAIT_L(0); PG8_BAR; PG8_MMA(0, 0, At, B0); PG8_MMA(0, 1, At, B1); PG8_BAR; PG8_SCHED;
            PG8_LDA(At, 1, 1); PG8_STAGE(PG8_SB(1, 0), b3, voffB); PG8_STAGE(PG8_SB(1, 1), b3 + hstep, voffB); PG8_STAGE_A(PG8_SA(1, 0), k3, a2, 0);
            PG8_WAIT_V(8); PG8_WAIT_L(0); PG8_BAR; PG8_MMA(1, 0, At, B0); PG8_MMA(1, 1, At, B1); PG8_BAR; PG8_SCHED;
        }
        if (wr == 0) PG8_BAR;
        asm volatile("s_nop 15\n\ts_nop 15" ::: "memory");
        E(acc, cur, wr, wc, fr, fq);
        if (!has_next) break;
#pragma unroll
        for (int a = 0; a < 2; ++a)
#pragma unroll
            for (int b = 0; b < 2; ++b)
#pragma unroll
                for (int m = 0; m < 4; ++m)
#pragma unroll
                    for (int n = 0; n < 2; ++n) acc[a][b][m][n] = (f32x4){0.f, 0.f, 0.f, 0.f};
        cur = nxt; cB = nB; ++ui;
#pragma unroll
        for (int h = 0; h < 2; ++h)
#pragma unroll
            for (int i = 0; i < 2; ++i) ac[h][i] = an[h][i];
        if (wr == 1) PG8_BAR;
    }
    PG8_WAIT_V(0);
    PG8_BAR;
#undef PG8_SA
#undef PG8_SB
#undef PG8_STAGE
#undef PG8_RD32
#undef PG8_LDA
#undef PG8_LDB
#undef PG8_MMA
#undef PG8_WAIT_V
#undef PG8_WAIT_L
#undef PG8_BAR
#undef PG8_SCHED
#undef PG8_AOFF
#undef PG8_STAGE_A
}
}

namespace attn_body {
using bf16 = __hip_bfloat16;
using f32x16 = __attribute__((ext_vector_type(16))) float;
constexpr int D = 64, PQ = 3072, PO = 2048;
constexpr int NW = 8, QBLK = 32, QB = QBLK * NW, KVBLK = 64, NQB = SEQ / QB;
__device__ __forceinline__ int crow(int r, int hi) { return (r & 3) + 8 * (r >> 2) + 4 * hi; }
#define SBAR() __builtin_amdgcn_sched_barrier(0)
__device__ __forceinline__ void cmask(f32x16& p0, f32x16& p1, int jb, int qrel, int hi) {
    const float NEG = -INFINITY; int kb = 64 * jb + 4 * hi;
#pragma unroll
    for (int r = 0; r < 16; ++r) { int kv = kb + (r & 3) + 8 * (r >> 2); if (kv > qrel) p0[r] = NEG; if (kv + 32 > qrel) p1[r] = NEG; }
}
constexpr int NSLOT = 3, SLOTB = 8192;
constexpr int LDS_K = 0, LDS_V = NSLOT * SLOTB, LDS_WS = 2 * NSLOT * SLOTB, LDS_OST = LDS_WS + NW * 64 * 4, ATT_LDS_BYTES = LDS_OST + NW * 4096;
__device__ __forceinline__ void glds16(const void* gsrc, unsigned lds_dst) { unsigned keep;
    asm volatile("s_mov_b32 %0, m0\n\ts_mov_b32 m0, %2\n\ts_nop 0\n\tglobal_load_lds_dwordx4 %1, off\n\ts_mov_b32 m0, %0" : "=&s"(keep) : "v"(gsrc), "s"(lds_dst) : "memory"); }
__device__ __forceinline__ float max3f(float a, float b, float c) { float r; asm("v_max3_f32 %0, %1, %2, %3" : "=v"(r) : "v"(a), "v"(b), "v"(c)); return r; }
__device__ __forceinline__ float max2f(float a, float b) { float r; asm("v_max_f32_e32 %0, %1, %2" : "=v"(r) : "v"(a), "v"(b)); return r; }
__device__ __forceinline__ float fadd_s(float a, float b) { float r; asm("v_add_f32_e32 %0, %1, %2" : "=v"(r) : "v"(a), "v"(b)); return r; }
__device__ __forceinline__ float fsub_s(float a, float b) { float r; asm("v_sub_f32_e32 %0, %1, %2" : "=v"(r) : "v"(a), "v"(b)); return r; }
__device__ __forceinline__ unsigned cvtpk_s(float lo, float hi) { f32x2 v = {lo, hi}; bf16x2_t b = __builtin_convertvector(v, bf16x2_t); return __builtin_bit_cast(unsigned, b); }
#define WAIT_BAR(N) asm volatile("s_waitcnt vmcnt(" #N ") lgkmcnt(0)\n\ts_barrier" ::: "memory")
__device__ __forceinline__ void qkt(f32x16& p0, f32x16& p1, const char* Kslot, const bf16x8* qr, const f32x16& negm, int r32, int hi) {
    const char* kb = Kslot + hi * 1024 + r32 * 16;
#pragma unroll
    for (int d0 = 0; d0 < 4; ++d0) {
        const bf16x8 b0 = *reinterpret_cast<const bf16x8*>(kb + d0 * 2048);
        const bf16x8 b1 = *reinterpret_cast<const bf16x8*>(kb + d0 * 2048 + 512);
        if (d0 == 0) { p0 = __builtin_amdgcn_mfma_f32_32x32x16_bf16(b0, qr[0], negm, 0, 0, 0); p1 = __builtin_amdgcn_mfma_f32_32x32x16_bf16(b1, qr[0], negm, 0, 0, 0); }
        else { p0 = __builtin_amdgcn_mfma_f32_32x32x16_bf16(b0, qr[d0], p0, 0, 0, 0); p1 = __builtin_amdgcn_mfma_f32_32x32x16_bf16(b1, qr[d0], p1, 0, 0, 0); } }
}
typedef __attribute__((address_space(3))) const char* lds_cptr;
typedef short v4i16_t __attribute__((ext_vector_type(4)));
__device__ __forceinline__ void kload8(bf16x8* kf, lds_cptr kp) {
    kf[0] = *(const LAS bf16x8*)(kp);        kf[1] = *(const LAS bf16x8*)(kp + 512);
    kf[2] = *(const LAS bf16x8*)(kp + 2048); kf[3] = *(const LAS bf16x8*)(kp + 2560);
    kf[4] = *(const LAS bf16x8*)(kp + 4096); kf[5] = *(const LAS bf16x8*)(kp + 4608);
    kf[6] = *(const LAS bf16x8*)(kp + 6144); kf[7] = *(const LAS bf16x8*)(kp + 6656);
}
__device__ __forceinline__ void kload2(bf16x8* kf, lds_cptr kp, int j) { kf[2 * j] = *(const LAS bf16x8*)(kp + j * 2048); kf[2 * j + 1] = *(const LAS bf16x8*)(kp + j * 2048 + 512); }
__device__ __forceinline__ s16x4 vtr(lds_cptr p) { return __builtin_bit_cast(s16x4, __builtin_amdgcn_ds_read_tr16_b64_v4i16((LAS v4i16_t*)p)); }
__device__ __forceinline__ float rowmax(const f32x16& p0, const f32x16& p1) {
    float a = max3f(p0[0], p0[1], p1[0]), b = max3f(p0[2], p0[3], p1[1]); a = max3f(a, p1[2], p1[3]);
#pragma unroll
    for (int r = 4; r < 16; r += 4) { a = max3f(a, p0[r], p0[r + 1]); b = max3f(b, p0[r + 2], p0[r + 3]); a = max3f(a, p1[r], p1[r + 1]); b = max3f(b, p1[r + 2], p1[r + 3]); }
    const float m = max2f(a, b);
    auto rr = __builtin_amdgcn_permlane32_swap(__float_as_uint(m), __float_as_uint(m), false, false);
    return max2f(__uint_as_float(rr[0]), __uint_as_float(rr[1]));
}
__device__ __forceinline__ void pv(f32x16* o, int vb, bf16x8 pa0, bf16x8 pa1, bf16x8 pa2, bf16x8 pa3) {
#pragma unroll
    for (int d0 = 0; d0 < 2; ++d0) { s16x4 lo[4], hi[4];
#pragma unroll
        for (int ks = 0; ks < 4; ++ks) {
            asm volatile("ds_read_b64_tr_b16 %0,%1 offset:%c2" : "=&v"(lo[ks]) : "v"(vb), "i"(d0 * 4096 + ks * 1024) : "memory");
            asm volatile("ds_read_b64_tr_b16 %0,%1 offset:%c2" : "=&v"(hi[ks]) : "v"(vb), "i"(d0 * 4096 + ks * 1024 + 512) : "memory"); }
        asm volatile("s_waitcnt lgkmcnt(0)" ::: "memory"); SBAR();
#define PK(k) (bf16x8){lo[k][0], lo[k][1], lo[k][2], lo[k][3], hi[k][0], hi[k][1], hi[k][2], hi[k][3]}
        o[d0] = __builtin_amdgcn_mfma_f32_32x32x16_bf16(pa0, PK(0), o[d0], 0, 0, 0);
        o[d0] = __builtin_amdgcn_mfma_f32_32x32x16_bf16(pa1, PK(1), o[d0], 0, 0, 0);
        o[d0] = __builtin_amdgcn_mfma_f32_32x32x16_bf16(pa2, PK(2), o[d0], 0, 0, 0);
        o[d0] = __builtin_amdgcn_mfma_f32_32x32x16_bf16(pa3, PK(3), o[d0], 0, 0, 0);
#undef PK
    }
}
#define ATTN_STORE16(p, v) (*(u32x4*)(p) = (v))
template <int THRL> __device__ __forceinline__ void attn_unit(int pair, int qb, const bf16* Pb, bf16* Obuf, char* shm) {
    const int b = pair >> 5, v5 = pair & 31, hc = v5 >> 1; const int qc = hc * 64, kc = 1024 + hc * 64, vc = 2048 + (v5 >> 2) * 128 + (v5 & 1) * 64, oc = v5 * 64;
    int tid = threadIdx.x; asm volatile("" : "+v"(tid));
    const int lane = tid & 63, r32 = lane & 31, hi = lane >> 5; const int wid = __builtin_amdgcn_readfirstlane(tid >> 6);
    const long rowbase = (long)b * SEQ; const int q0 = qb * QB;
    const bf16* Qw = Pb + (rowbase + q0 + wid * QBLK) * PQ + qc;
    const bf16* Kh = Pb + rowbase * PQ + kc, *Vh = Pb + rowbase * PQ + vc;
    const unsigned lds0 = (unsigned)(uintptr_t)shm;
    float* wsf = (float*)(shm + LDS_WS) + wid * 64;
    const bf16* ksrc = Kh + (long)lane * PQ + wid * 8;
    const bf16* vsrc = Vh + (long)(16 * (wid & 3) + (lane >> 2)) * PQ + (wid >> 2) * 32 + (lane & 3) * 8;
    const unsigned kdst = lds0 + LDS_K + wid * 1024, vdst = lds0 + LDS_V + wid * 1024;
#define DMA_K(t, slot) glds16(ksrc + (long)(t) * KVBLK * PQ, (unsigned)__builtin_amdgcn_readfirstlane(kdst + (slot)))
#define DMA_V(t, slot) glds16(vsrc + (long)(t) * KVBLK * PQ, (unsigned)__builtin_amdgcn_readfirstlane(vdst + (slot)))
    const int vb0 = (int)(lds0 + LDS_V) + ((lane >> 4) & 1) * 32 + (lane & 3) * 8 + (4 * hi + ((lane & 15) >> 2)) * 64;
    const char* Kbase = shm + LDS_K; bf16x8 kf[8];
    const lds_cptr shm3 = (lds_cptr)shm; const lds_cptr kp0 = shm3 + LDS_K + hi * 1024 + r32 * 16; const lds_cptr vp0 = shm3 + LDS_V + ((lane >> 4) & 1) * 32 + (lane & 3) * 8 + (4 * hi + ((lane & 15) >> 2)) * 64;
    const int NT = (q0 + QB) / KVBLK;
    DMA_K(0, 0); DMA_V(0, 0); DMA_K(1, SLOTB);
    bf16x8 qr[4];
#pragma unroll
    for (int d0 = 0; d0 < 4; ++d0) qr[d0] = *reinterpret_cast<const bf16x8*>(&Qw[(long)r32 * PQ + d0 * 16 + hi * 8]);
    float mhat = 0.f, l_reg = 0.f; f32x16 o[2]; o[0] = f32x16{}; o[1] = f32x16{}; f32x16 negm = f32x16{}; asm volatile("" : "+v"(negm));
    const int qrel = wid * QBLK + r32;
#define CMASK(P0, P1, t) do { int jb_ = (t) - (NT - 4); if (jb_ >= 0) cmask(P0, P1, jb_, qrel, hi); } while (0)
    bool resc = false;
#define START(P0, P1) do { const float rm = rowmax(P0, P1); resc = false; \
    { const float dl = rm; mhat = fadd_s(mhat, dl); \
      _Pragma("unroll") for (int r = 0; r < 16; ++r) { P0[r] = fsub_s(P0[r], dl); P1[r] = fsub_s(P1[r], dl); } \
      _Pragma("unroll") for (int r = 0; r < 16; ++r) negm[r] = -mhat; asm volatile("" : "+v"(negm)); } \
    _Pragma("unroll") for (int r = 0; r < 16; ++r) P0[r] = __builtin_amdgcn_exp2f(P0[r]); } while (0)
#define RESC() do { if (resc) { asm volatile("s_waitcnt lgkmcnt(0)" ::: "memory"); \
      _Pragma("unroll") for (int d_ = 0; d_ < 2; ++d_) _Pragma("unroll") for (int r = 0; r < 16; ++r) o[d_][r] *= wsf[crow(r, hi)]; } } while (0)
    f32x16 pA0, pA1, pB0, pB1;
    int sl_prev = 0, sl_cur = 0, sl_next = SLOTB;
#define ROT() do { sl_prev = sl_cur; sl_cur = sl_next; sl_next = (sl_next == (NSLOT - 1) * SLOTB) ? 0 : sl_next + SLOTB; } while (0)
    DMA_K(2, 2 * SLOTB);
    WAIT_BAR(3);
    qkt(pA0, pA1, Kbase, qr, negm, r32, hi); asm volatile("s_nop 15\n\ts_nop 7" : "+v"(pA0), "+v"(pA1)); CMASK(pA0, pA1, 0);
    START(pA0, pA1);
    _Pragma("unroll") for (int r = 0; r < 16; ++r) pA1[r] = __builtin_amdgcn_exp2f(pA1[r]);
    WAIT_BAR(0);
    DMA_K(3, 0); DMA_V(1, SLOTB);
    ROT();
    kload8(kf, kp0 + sl_cur);
    WAIT_BAR(2);
    s16x4 vlo[8], vhi[8]; u32x4 pw0, pw1, pw2, pw3;
#define PKW(P, B) cvtpk_s(P[B], P[B + 1])
#define PAF(k) __builtin_bit_cast(bf16x8, pw##k)
#define VFR(i) (bf16x8){vlo[i][0], vlo[i][1], vlo[i][2], vlo[i][3], vhi[i][0], vhi[i][1], vhi[i][2], vhi[i][3]}
#define PIN(x) asm volatile("" : "+v"(x))
#define MX3(a, b, c) __builtin_fmaxf(__builtin_fmaxf((a), (b)), (c))
#define GAPA(MF, A0, A1, A2, A3, W0, W1, PW) do { MF; sacc += A0; sacc += A1; sacc += A2; sacc += A3; PIN(sacc); W0; W1; PIN(PW); SBAR(); } while (0)
#define EX(v) __builtin_amdgcn_exp2f(v)
#define GAPB(MF, X, B) do { MF; X[B] = EX(X[B]); X[B + 1] = EX(X[B + 1]); X[B + 2] = EX(X[B + 2]); X[B + 3] = EX(X[B + 3]); PIN(X); SBAR(); } while (0)
#define VRD(i) do { vlo[i] = vtr(vp_ + (((i) >> 2) * 4096 + ((i) & 3) * 1024)); vhi[i] = vtr(vp_ + (((i) >> 2) * 4096 + ((i) & 3) * 1024 + 512)); } while (0)
#define KRD(G, j) do { if (G) { kload2(kf, kp0 + sl_next, j); SBAR(); } } while (0)
#define STEP(C0, C1, P0, P1, t, GK, GV, GL) do { SBAR(); \
    const lds_cptr vp_ = vp0 + sl_prev; \
    VRD(0); SBAR(); float sacc = (P0[0] + P0[1]); \
    GAPA(C0 = __builtin_amdgcn_mfma_f32_32x32x16_bf16(kf[0], qr[0], negm, 0, 0, 0), P0[2], P0[3], P0[4], P0[5],     pw0[0] = PKW(P0, 0), pw0[1] = PKW(P0, 2), pw0); \
    VRD(4); SBAR(); GAPA(C1 = __builtin_amdgcn_mfma_f32_32x32x16_bf16(kf[1], qr[0], negm, 0, 0, 0), P0[6], P0[7], P0[8], P0[9],     pw0[2] = PKW(P0, 4), pw0[3] = PKW(P0, 6), pw0); \
    VRD(1); SBAR(); GAPA(C0 = __builtin_amdgcn_mfma_f32_32x32x16_bf16(kf[2], qr[1], C0, 0, 0, 0),   P0[10], P0[11], P0[12], P0[13], pw1[0] = PKW(P0, 8), pw1[1] = PKW(P0, 10), pw1); \
    VRD(5); SBAR(); GAPA(C1 = __builtin_amdgcn_mfma_f32_32x32x16_bf16(kf[3], qr[1], C1, 0, 0, 0),   P0[14], P0[15], P1[0], P1[1],   pw1[2] = PKW(P0, 12), pw1[3] = PKW(P0, 14), pw1); \
    VRD(2); SBAR(); GAPA(C0 = __builtin_amdgcn_mfma_f32_32x32x16_bf16(kf[4], qr[2], C0, 0, 0, 0),   P1[2], P1[3], P1[4], P1[5],     pw2[0] = PKW(P1, 0), pw2[1] = PKW(P1, 2), pw2); \
    VRD(6); SBAR(); GAPA(C1 = __builtin_amdgcn_mfma_f32_32x32x16_bf16(kf[5], qr[2], C1, 0, 0, 0),   P1[6], P1[7], P1[8], P1[9],     pw2[2] = PKW(P1, 4), pw2[3] = PKW(P1, 6), pw2); \
    VRD(3); SBAR(); GAPA(C0 = __builtin_amdgcn_mfma_f32_32x32x16_bf16(kf[6], qr[3], C0, 0, 0, 0),   P1[10], P1[11], P1[12], P1[13], pw3[0] = PKW(P1, 8), pw3[1] = PKW(P1, 10), pw3); \
    VRD(7); SBAR(); GAPA(C1 = __builtin_amdgcn_mfma_f32_32x32x16_bf16(kf[7], qr[3], C1, 0, 0, 0),   P1[14], P1[15], 0.f, 0.f,       pw3[2] = PKW(P1, 12), pw3[3] = PKW(P1, 14), pw3); \
    l_reg += sacc; \
    if (GK) { DMA_K((t) + 3, sl_cur); } if (GV) { DMA_V((t) + 1, sl_next); } \
    CMASK(C0, C1, t); \
    { float a = MX3(C0[0], C0[1], C1[0]), b = MX3(C0[2], C0[3], C1[1]); a = MX3(a, C1[2], C1[3]); \
      _Pragma("unroll") for (int r = 4; r < 16; r += 4) { a = MX3(a, C0[r], C0[r + 1]); b = MX3(b, C0[r + 2], C0[r + 3]); a = MX3(a, C1[r], C1[r + 1]); b = MX3(b, C1[r + 2], C1[r + 3]); } \
      float rm = __builtin_fmaxf(a, b); { auto rr = __builtin_amdgcn_permlane32_swap(__float_as_uint(rm), __float_as_uint(rm), false, false); rm = __builtin_fmaxf(__uint_as_float(rr[0]), __uint_as_float(rr[1])); } \
      resc = false; \
      if (__builtin_expect(__any(rm > (float)THRL), 0)) { const float dl = __builtin_fmaxf(rm, 0.f); mhat += dl; \
        _Pragma("unroll") for (int r = 0; r < 16; ++r) { C0[r] -= dl; C1[r] -= dl; } \
        _Pragma("unroll") for (int r = 0; r < 16; ++r) negm[r] = -mhat; asm volatile("" : "+v"(negm)); \
        const float f = __builtin_amdgcn_exp2f(-dl); l_reg *= f; if (hi == 0) wsf[r32] = f; resc = true; } } \
    SBAR(); \
    GAPB(o[0] = __builtin_amdgcn_mfma_f32_32x32x16_bf16(PAF(0), VFR(0), o[0], 0, 0, 0), C0, 0); \
    GAPB(o[1] = __builtin_amdgcn_mfma_f32_32x32x16_bf16(PAF(0), VFR(4), o[1], 0, 0, 0), C0, 4); \
    KRD(GL, 0); GAPB(o[0] = __builtin_amdgcn_mfma_f32_32x32x16_bf16(PAF(1), VFR(1), o[0], 0, 0, 0), C0, 8); \
    KRD(GL, 1); GAPB(o[1] = __builtin_amdgcn_mfma_f32_32x32x16_bf16(PAF(1), VFR(5), o[1], 0, 0, 0), C0, 12); \
    KRD(GL, 2); GAPB(o[0] = __builtin_amdgcn_mfma_f32_32x32x16_bf16(PAF(2), VFR(2), o[0], 0, 0, 0), C1, 0); \
    KRD(GL, 3); GAPB(o[1] = __builtin_amdgcn_mfma_f32_32x32x16_bf16(PAF(2), VFR(6), o[1], 0, 0, 0), C1, 4); \
    GAPB(o[0] = __builtin_amdgcn_mfma_f32_32x32x16_bf16(PAF(3), VFR(3), o[0], 0, 0, 0), C1, 8); \
    GAPB(o[1] = __builtin_amdgcn_mfma_f32_32x32x16_bf16(PAF(3), VFR(7), o[1], 0, 0, 0), C1, 12); \
    } while (0)
    int t = 1;
#undef CMASK
#define CMASK(P0, P1, t) do {} while (0)
    for (; t + 5 < NT; t += 2) {
        STEP(pB0, pB1, pA0, pA1, t, true, true, true);     WAIT_BAR(2); RESC(); ROT();
        STEP(pA0, pA1, pB0, pB1, t + 1, true, true, true); WAIT_BAR(2); RESC(); ROT();
    }
#undef CMASK
#define CMASK(P0, P1, t) do { int jb_ = (t) - (NT - 4); if (jb_ >= 0) cmask(P0, P1, jb_, qrel, hi); } while (0)
#define ENDW(tt) do { if ((tt) + 3 < NT) { WAIT_BAR(2); } else if ((tt) + 2 < NT) { WAIT_BAR(1); } else { WAIT_BAR(0); } } while (0)
    for (; t + 1 < NT; t += 2) {
        STEP(pB0, pB1, pA0, pA1, t, (t + 3 < NT), (t + 1 < NT), (t + 1 < NT));         ENDW(t);     RESC(); ROT();
        STEP(pA0, pA1, pB0, pB1, t + 1, (t + 4 < NT), (t + 2 < NT), (t + 2 < NT));     ENDW(t + 1); RESC(); ROT();
    }
    STEP(pB0, pB1, pA0, pA1, NT - 1, false, false, false); RESC();
    { float sacc = pB0[0] + pB0[1]; _Pragma("unroll") for (int r = 2; r < 16; ++r) sacc += pB0[r]; _Pragma("unroll") for (int r = 0; r < 16; ++r) sacc += pB1[r]; l_reg += sacc;
      pw0 = (u32x4){PKW(pB0, 0), PKW(pB0, 2), PKW(pB0, 4), PKW(pB0, 6)}; pw1 = (u32x4){PKW(pB0, 8), PKW(pB0, 10), PKW(pB0, 12), PKW(pB0, 14)}; pw2 = (u32x4){PKW(pB1, 0), PKW(pB1, 2), PKW(pB1, 4), PKW(pB1, 6)}; pw3 = (u32x4){PKW(pB1, 8), PKW(pB1, 10), PKW(pB1, 12), PKW(pB1, 14)};
      SBAR(); pv(o, vb0 + sl_cur, PAF(0), PAF(1), PAF(2), PAF(3)); }
#undef PKW
#undef PAF
#undef VFR
#undef PIN
#undef MX3
#undef GAPA
#undef GAPB
#undef EX
#undef VRD
#undef KRD
#undef STEP
#undef ENDW
    { auto rr = __builtin_amdgcn_permlane32_swap(__float_as_uint(l_reg), __float_as_uint(l_reg), false, false); l_reg = __uint_as_float(rr[0]) + __uint_as_float(rr[1]); }
    if (hi == 0) wsf[32 + r32] = l_reg; asm volatile("s_waitcnt lgkmcnt(0)" ::: "memory");
    float rli[16];
#pragma unroll
    for (int r = 0; r < 16; ++r) rli[r] = __builtin_amdgcn_rcpf(wsf[32 + crow(r, hi)]);
    bf16* Ow = Obuf + (rowbase + q0 + wid * QBLK) * PO + oc;
    { bf16* stg = (bf16*)(shm + LDS_OST) + wid * 2048;
#pragma unroll
      for (int r = 0; r < 16; ++r) { const int orow = crow(r, hi);
#pragma unroll
        for (int d0 = 0; d0 < 2; ++d0) stg[orow * 64 + d0 * 32 + r32] = __float2bfloat16(o[d0][r] * rli[r]); }
      asm volatile("s_waitcnt lgkmcnt(0)" ::: "memory");
#pragma unroll
      for (int i = 0; i < 4; ++i) { const int row = i * 8 + (lane >> 3), ch = lane & 7; const u32x4 v = *(const u32x4*)(stg + row * 64 + ch * 8); ATTN_STORE16(Ow + (long)row * PO + ch * 8, v); } }
    asm volatile("s_waitcnt lgkmcnt(0)\n\ts_barrier" ::: "memory");
#undef DMA_K
#undef DMA_V
#undef CMASK
#undef START
#undef RESC
#undef ROT
}
#undef SBAR
#undef WAIT_BAR
}

struct Params {
    const float* x; const float* c; const int* positions; const float* norm1; const float* norm2; const float* w_ada; const float* b_ada;
    const float* a_w_in; const float* a_b_if; const float* a_h_norm; const float* a_w_out;
    const float* b_w_in; const float* b_q_norm; const float* b_k_norm; const float* b_lam_q1; const float* b_lam_k1; const float* b_lam_q2; const float* b_lam_k2;
    const float* b_o_norm; const float* b_w_out; const float* w_router; const float* router_bias; const float* moe_w_gu; const float* moe_w_down;
    float* out; unsigned char* ws;
};
struct Frame { LAS unsigned char* lds; int tid, lane, wave, G, bid, vcu; };
__device__ __forceinline__ Frame make_frame(unsigned char* lds) {
    Frame F; F.lds = (LAS unsigned char*)lds; int t = threadIdx.x; asm volatile("" : "+v"(t)); F.tid = t; F.lane = t & 63; F.wave = __builtin_amdgcn_readfirstlane(t >> 6);
    F.G = gridDim.x; F.bid = blockIdx.x; F.vcu = (F.G % 8 == 0) ? (F.bid % 8) * (F.G / 8) + F.bid / 8 : F.bid; return F;
}

struct TItem { const float* W; bf16_t* WT; int ldw, K, drow0, k0, n0; float s8; };
__device__ __forceinline__ TItem decode_item(int it, const Params& p) {
    constexpr int I0 = 16 * 48, I1 = 16 * 16, I2 = 16 * 48, I3 = 16 * 16, I4 = 32 * 256;
    TItem t; int r = it;
    if (r < I0) { const int kb = r / 48, nb = r % 48; t = TItem{p.a_w_in, (bf16_t*)(p.ws + WS_WAIN), 3080, 1024, 64 * nb, 64 * kb, 64 * nb, 0.f}; return t; } r -= I0;
    if (r < I1) { const int kb = r / 16, nb = r % 16; t = TItem{p.a_w_out, (bf16_t*)(p.ws + WS_WAOUT), 1024, 1024, 64 * nb, 64 * kb, 64 * nb, 0.f}; return t; } r -= I1;
    if (r < I2) { const int kb = r / 48, nb = r % 48; t = TItem{p.b_w_in, (bf16_t*)(p.ws + WS_WBIN), 3072, 1024, 64 * nb, 64 * kb, 64 * nb, 0.f}; return t; } r -= I2;
    if (r < I3) { const int kb = r / 16, nb = r % 16; t = TItem{p.b_w_out, (bf16_t*)(p.ws + WS_WBOUT), 1024, 1024, 64 * nb, 64 * kb, 64 * nb, 0.f}; return t; } r -= I3;
    if (r < I4) { const int mi = r / 256, q = r % 256, kb = q / 16, nb = q % 16; const int n0 = 64 * nb;
        const int drow = ((n0 & 511) >> 7) * 256 + (n0 >> 9) * 128 + (n0 & 127);
        t = TItem{p.moe_w_gu + (size_t)mi * 1024 * 1024, (bf16_t*)(p.ws + WS_WGU + (size_t)mi * 1024 * 1024), 1024, 1024, drow, 64 * kb, n0, S8_WGU}; return t; } r -= I4;
    { const int mi = r / 128, q = r % 128, kb = q / 16, nb = q % 16;
      t = TItem{p.moe_w_down + (size_t)mi * 512 * 1024, (bf16_t*)(p.ws + WS_WDN + (size_t)mi * 1024 * 512), 1024, 512, 64 * nb, 64 * kb, 64 * nb, S8_WDN}; return t; }
}
__device__ __forceinline__ void phase_mod(unsigned char* lds_, const Params& p) {
    const Frame F = make_frame(lds_);
    LAS float* cact = (LAS float*)F.lds;
    LAS float* red = (LAS float*)(F.lds + 65536);
    float* mod = (float*)(p.ws + WS_MOD);
    for (int i = F.tid; i < NB * DM; i += NTHREADS) { const int b = i >> 10, k = i & 1023; const float v = p.c[i]; cact[k * 16 + b] = v / (1.0f + expf(-v)); }
    __syncthreads();
    for (int task = F.bid; task < 192; task += F.G) {
        const int l = task / 96, cb = task % 96;
        const float* W = p.w_ada + (size_t)l * DM * 6144 + cb * 64 + F.lane;
        float acc[16];
#pragma unroll
        for (int b = 0; b < 16; ++b) acc[b] = 0.f;
        const int kbeg = F.wave * 128;
        for (int kb = kbeg; kb < kbeg + 128; kb += 16) {
            float wv[16];
#pragma unroll
            for (int u = 0; u < 16; ++u) wv[u] = __builtin_nontemporal_load(W + (size_t)(kb + u) * 6144);
#pragma unroll
            for (int u = 0; u < 16; ++u) {
                const LAS f32x4* cc = (const LAS f32x4*)(cact + (kb + u) * 16);
                const f32x4 c0 = cc[0], c1 = cc[1], c2 = cc[2], c3 = cc[3]; const float w = wv[u];
                acc[0] += c0[0] * w; acc[1] += c0[1] * w; acc[2] += c0[2] * w; acc[3] += c0[3] * w;
                acc[4] += c1[0] * w; acc[5] += c1[1] * w; acc[6] += c1[2] * w; acc[7] += c1[3] * w;
                acc[8] += c2[0] * w; acc[9] += c2[1] * w; acc[10] += c2[2] * w; acc[11] += c2[3] * w;
                acc[12] += c3[0] * w; acc[13] += c3[1] * w; acc[14] += c3[2] * w; acc[15] += c3[3] * w;
            }
        }
#pragma unroll
        for (int b = 0; b < 16; ++b) red[(F.wave * 16 + b) * 64 + F.lane] = acc[b];
        __syncthreads();
        for (int o = F.tid; o < 1024; o += NTHREADS) { const int b = o >> 6, cl = o & 63; float s = 0.f;
#pragma unroll
            for (int w = 0; w < 8; ++w) s += red[(w * 16 + b) * 64 + cl];
            mod[((size_t)l * 16 + b) * 6144 + cb * 64 + cl] = s + p.b_ada[(size_t)l * 6144 + cb * 64 + cl]; }
        __syncthreads();
    }
}
__device__ __forceinline__ void phase_wconv(unsigned char* lds_, const Params& p) {
    const Frame F = make_frame(lds_);
    LAS float* scr = (LAS float*)(F.lds + F.wave * 17408);
    const int gw = F.vcu * NWAVES + F.wave, NGW = F.G * NWAVES;
    constexpr int NITEMS = 16 * 48 + 16 * 16 + 16 * 48 + 16 * 16 + 32 * 256 + 32 * 128;
    const int lane = F.lane, lr = lane >> 4, c4 = (lane & 15) * 4;
    f32x4 v[16];
    int it = gw;
    if (it < NITEMS) { const TItem t = decode_item(it, p);
#pragma unroll
        for (int i = 0; i < 16; ++i) v[i] = __builtin_nontemporal_load((const f32x4*)(t.W + (size_t)(t.k0 + 4 * i + lr) * t.ldw + t.n0 + c4)); }
    for (; it < NITEMS; it += NGW) {
        const TItem t = decode_item(it, p);
#pragma unroll
        for (int i = 0; i < 16; ++i) *(LAS f32x4*)(scr + (4 * i + lr) * 68 + c4) = v[i];
        const int itn = it + NGW;
        if (itn < NITEMS) { const TItem tn = decode_item(itn, p);
#pragma unroll
            for (int i = 0; i < 16; ++i) v[i] = __builtin_nontemporal_load((const f32x4*)(tn.W + (size_t)(tn.k0 + 4 * i + lr) * tn.ldw + tn.n0 + c4)); }
        if (t.s8 > 0.f) {
            unsigned char* orow8 = (unsigned char*)t.WT + (size_t)(t.drow0 + lane) * t.K + t.k0;
#pragma unroll
            for (int c = 0; c < 4; ++c) { float f[16];
#pragma unroll
                for (int q = 0; q < 16; ++q) f[q] = scr[(16 * c + q) * 68 + lane] * t.s8;
                u32x4 o; o.x = cvt4_fp8(f[0], f[1], f[2], f[3]); o.y = cvt4_fp8(f[4], f[5], f[6], f[7]); o.z = cvt4_fp8(f[8], f[9], f[10], f[11]); o.w = cvt4_fp8(f[12], f[13], f[14], f[15]);
                *(u32x4*)(orow8 + 16 * c) = o; }
        } else {
            bf16_t* orow = t.WT + (size_t)(t.drow0 + lane) * t.K + t.k0;
#pragma unroll
            for (int c = 0; c < 8; ++c) { float f[8];
#pragma unroll
                for (int q = 0; q < 8; ++q) f[q] = scr[(8 * c + q) * 68 + lane];
                u32x4 o; o.x = cvtpk(f[0], f[1]); o.y = cvtpk(f[2], f[3]); o.z = cvtpk(f[4], f[5]); o.w = cvtpk(f[6], f[7]);
                *(u32x4*)(orow + 8 * c) = o; }
        }
    }
}

struct RowConst { f32x4 a[4], b[4]; };
__device__ __forceinline__ RowConst load_rowconst(const float* norm, const float* modb, int sh_off, int sc_off, int lane) {
    RowConst rc;
#pragma unroll
    for (int j = 0; j < 4; ++j) { const int c = 256 * j + 4 * lane;
        const f32x4 nv = *(const f32x4*)(norm + c), sc = *(const f32x4*)(modb + sc_off + c); rc.b[j] = *(const f32x4*)(modb + sh_off + c);
        rc.a[j] = nv * (sc + 1.0f); }
    return rc;
}
__device__ __forceinline__ void row_norm_store(const f32x4 (&v)[4], const RowConst& rc, f32x4 (&h)[4], bf16_t* hrow, int lane) {
    float ss = 0.f;
#pragma unroll
    for (int j = 0; j < 4; ++j) ss += (v[j][0] * v[j][0] + v[j][1] * v[j][1]) + (v[j][2] * v[j][2] + v[j][3] * v[j][3]);
    const float r = 1.0f / sqrtf(wave_sum(ss) * (1.0f / DM) + EPS);
#pragma unroll
    for (int j = 0; j < 4; ++j) { h[j] = v[j] * r * rc.a[j] + rc.b[j];
        u32x2 w; w.x = cvtpk(h[j][0], h[j][1]); w.y = cvtpk(h[j][2], h[j][3]); *(u32x2*)(hrow + 256 * j + 4 * lane) = w; }
}


__device__ __forceinline__ float reduce16(const float (&v)[16], int lane) {
    float a[8], b[4], c[2];
    const bool b5 = (lane & 32) != 0, b4 = (lane & 16) != 0, b3 = (lane & 8) != 0, b2 = (lane & 4) != 0;
#pragma unroll
    for (int i = 0; i < 8; ++i) { const float send = b5 ? v[i] : v[8 + i], keep = b5 ? v[8 + i] : v[i]; a[i] = keep + __shfl_xor(send, 32); }
#pragma unroll
    for (int i = 0; i < 4; ++i) { const float send = b4 ? a[i] : a[4 + i], keep = b4 ? a[4 + i] : a[i]; b[i] = keep + __shfl_xor(send, 16); }
#pragma unroll
    for (int i = 0; i < 2; ++i) { const float send = b3 ? b[i] : b[2 + i], keep = b3 ? b[2 + i] : b[i]; c[i] = keep + __shfl_xor(send, 8); }
    const float send = b2 ? c[0] : c[1], keep = b2 ? c[1] : c[0];
    float d = keep + __shfl_xor(send, 4);
    d += __shfl_xor(d, 1); d += __shfl_xor(d, 2);
    return d;
}
__device__ __forceinline__ float reduce8(const float (&v)[8], int lane) {
    float b[4], c[2];
    const bool b5 = (lane & 32) != 0, b4 = (lane & 16) != 0, b3 = (lane & 8) != 0;
#pragma unroll
    for (int i = 0; i < 4; ++i) { const float send = b5 ? v[i] : v[4 + i], keep = b5 ? v[4 + i] : v[i]; b[i] = keep + __shfl_xor(send, 32); }
#pragma unroll
    for (int i = 0; i < 2; ++i) { const float send = b4 ? b[i] : b[2 + i], keep = b4 ? b[2 + i] : b[i]; c[i] = keep + __shfl_xor(send, 16); }
    const float send = b3 ? c[0] : c[1], keep = b3 ? c[1] : c[0];
    float d = keep + __shfl_xor(send, 8);
    d += __shfl_xor(d, 1); d += __shfl_xor(d, 2); d += __shfl_xor(d, 4);
    return d;
}

__device__ __forceinline__ void row_norm_store8(const f32x4 (&v)[4], const RowConst& rc, f32x4 (&h)[4], unsigned char* hrow, int lane) {
    float ss = 0.f;
#pragma unroll
    for (int j = 0; j < 4; ++j) ss += (v[j][0] * v[j][0] + v[j][1] * v[j][1]) + (v[j][2] * v[j][2] + v[j][3] * v[j][3]);
    const float r = 1.0f / sqrtf(wave_sum(ss) * (1.0f / DM) + EPS);
#pragma unroll
    for (int j = 0; j < 4; ++j) { h[j] = v[j] * r * rc.a[j] + rc.b[j];
        *(unsigned*)(hrow + 256 * j + 4 * lane) = cvt4_fp8(h[j][0] * S8_H, h[j][1] * S8_H, h[j][2] * S8_H, h[j][3] * S8_H); }
}
__device__ __forceinline__ void phase_hprep0(unsigned char* lds_, const Params& p) {
    const Frame F = make_frame(lds_);
    LAS f32x4* Wg = (LAS f32x4*)F.lds;
    for (int idx = F.tid; idx < 2048; idx += NTHREADS) { const int ln = idx & 63, half = (idx >> 6) & 1, i = (idx >> 7) & 3, j = idx >> 9; const int c = 256 * j + 4 * ln + i;
        Wg[idx] = *(const f32x4*)(p.a_w_in + (size_t)c * 3080 + 3072 + half * 4); }
    __syncthreads();
    const float* mod = (const float*)(p.ws + WS_MOD);
    bf16_t* H = (bf16_t*)(p.ws + WS_H); float* gates = (float*)(p.ws + WS_GATES);
    const float bif = p.a_b_if[F.lane & 7];
    for (int chunk = F.bid; chunk < 256; chunk += F.G) {
        const int row0 = chunk * 128 + F.wave * 16; const int b = row0 / SEQ;
        const RowConst rc = load_rowconst(p.norm1, mod + (size_t)b * 6144, 0, 1024, F.lane);
        for (int rb = 0; rb < 16; rb += 4) {
            f32x4 v[4][4];
#pragma unroll
            for (int rr = 0; rr < 4; ++rr)
#pragma unroll
                for (int j = 0; j < 4; ++j) v[rr][j] = __builtin_nontemporal_load((const f32x4*)(p.x + (size_t)(row0 + rb + rr) * DM + 256 * j + 4 * F.lane));
#pragma unroll
            for (int rr = 0; rr < 4; ++rr) { const int row = row0 + rb + rr;
                asm volatile("" ::: "memory");
                f32x4 h[4];
                row_norm_store(v[rr], rc, h, H + (size_t)row * DM, F.lane);
                float g[8];
#pragma unroll
                for (int q = 0; q < 8; ++q) g[q] = 0.f;
#pragma unroll
                for (int j = 0; j < 4; ++j)
#pragma unroll
                    for (int i = 0; i < 4; ++i) { const float hv = h[j][i]; const f32x4 w0 = Wg[((j * 4 + i) * 2 + 0) * 64 + F.lane], w1 = Wg[((j * 4 + i) * 2 + 1) * 64 + F.lane];
                        g[0] += hv * w0[0]; g[1] += hv * w0[1]; g[2] += hv * w0[2]; g[3] += hv * w0[3]; g[4] += hv * w1[0]; g[5] += hv * w1[1]; g[6] += hv * w1[2]; g[7] += hv * w1[3]; }
                const float d = reduce8(g, F.lane);
                const float mine = __shfl(d, 8 * (F.lane & 7));
                if (F.lane < 8) { float val = mine + bif;
                    if (F.lane >= 4) val = fminf(val, 0.f) - log1pf(expf(-fabsf(val)));
                    gates[(size_t)row * 8 + F.lane] = val; }
            }
        }
    }
}

namespace mls {
constexpr int RSK = 272, RSV = 176, RSP = 272, RSC = 272;
constexpr int OFF_K = 0, OFF_V = 34816, OFF_P = OFF_V + 22528, OFF_C = OFF_P + 34816, OFF_G = OFF_C + 21760;
typedef short v4i16_t __attribute__((ext_vector_type(4)));
__device__ __forceinline__ bf16x8 tr2(const LAS unsigned char* base, int row, int col, int rs, int lane) {
    const int i = lane & 15, g = lane >> 4;
    const LAS unsigned char* p0 = base + (row + 8 * g + (i >> 2)) * rs + (col + 4 * (i & 3)) * 2;
    const s16x4 lo = __builtin_bit_cast(s16x4, __builtin_amdgcn_ds_read_tr16_b64_v4i16((LAS v4i16_t*)p0));
    const s16x4 hi = __builtin_bit_cast(s16x4, __builtin_amdgcn_ds_read_tr16_b64_v4i16((LAS v4i16_t*)(p0 + 4 * rs)));
    return (bf16x8){lo[0], lo[1], lo[2], lo[3], hi[0], hi[1], hi[2], hi[3]};
}
}
__device__ __forceinline__ void phase_mlstm(unsigned char* lds_, const Params& p) {
    const Frame F = make_frame(lds_);
    using namespace mls;
    const bf16_t* PR = (const bf16_t*)(p.ws + WS_PROJ); const float* gates = (const float*)(p.ws + WS_GATES); bf16_t* HO = (bf16_t*)(p.ws + WS_HOUT);
    LAS unsigned char* Ks = F.lds + OFF_K; LAS unsigned char* Vs = F.lds + OFF_V; LAS unsigned char* Ps = F.lds + OFF_P; LAS unsigned char* Cs = F.lds + OFF_C;
    LAS float* gu = (LAS float*)(F.lds + OFF_G); LAS float* gwv = gu + 128; LAS float* gin = gu + 256; LAS float* gfl = gu + 384; LAS float* gwg = gu + 512;
    const int w = F.wave, lane = F.lane, c = lane & 15, g = lane >> 4, tid = F.tid;
    for (int item = F.vcu; item < 256; item += F.G) {
        const int bh = item >> 2, sl = item & 3, b = bh >> 2, h = bh & 3;
        const size_t tok0 = (size_t)b * SEQ;
        const bf16_t* Qg = PR + h * 128; const bf16_t* Kg = PR + 512 + h * 128; const bf16_t* Vg = PR + 1024 + h * 256 + sl * 64;
        __syncthreads();
        if (tid < 256) { const int row = tid >> 1, part = tid & 1; u32x4 z = {0u, 0u, 0u, 0u}; if (part == 0) z.x = 0x3F80u; *(LAS u32x4*)(Vs + row * RSV + 128 + part * 16) = z; }
        f32x4 cacc[5];
#pragma unroll
        for (int vt = 0; vt < 5; ++vt) cacc[vt] = (f32x4){0.f, 0.f, 0.f, 0.f};
        for (int i = tid; i < 80 * RSC / 16; i += NTHREADS) *(LAS u32x4*)(Cs + i * 16) = (u32x4){0u, 0u, 0u, 0u};
        float m_prev = 0.f;
        u32x4 kst[4], vst[2]; bf16x8 qf[4], qn[4]; float glf0 = 0.f, glf1 = 0.f, gi0 = 0.f, gi1 = 0.f;
        auto load_chunk = [&](int ch) {
            const size_t t0 = tok0 + (size_t)ch * 128;
#pragma unroll
            for (int k = 0; k < 4; ++k) { const int pc = tid + 512 * k, row = pc >> 4, c16 = pc & 15; kst[k] = *(const u32x4*)(Kg + (t0 + row) * 3072 + c16 * 8); }
#pragma unroll
            for (int k = 0; k < 2; ++k) { const int pc = tid + 512 * k, row = pc >> 3, c16 = pc & 7; vst[k] = *(const u32x4*)(Vg + (t0 + row) * 3072 + c16 * 8); }
#pragma unroll
            for (int ks = 0; ks < 4; ++ks) qn[ks] = *(const bf16x8*)(Qg + (t0 + 16 * w + c) * 3072 + 32 * ks + 8 * g);
            if (w == 0) { const float* gp = gates + (t0 + 2 * lane) * 8; gi0 = gp[h]; glf0 = gp[4 + h]; gi1 = gp[8 + h]; glf1 = gp[12 + h]; }
        };
        auto store_chunk = [&]() {
#pragma unroll
            for (int k = 0; k < 4; ++k) { const int pc = tid + 512 * k, row = pc >> 4, c16 = pc & 15; *(LAS u32x4*)(Ks + row * RSK + c16 * 16) = kst[k]; }
#pragma unroll
            for (int k = 0; k < 2; ++k) { const int pc = tid + 512 * k, row = pc >> 3, c16 = pc & 7; *(LAS u32x4*)(Vs + row * RSV + c16 * 16) = vst[k]; }
#pragma unroll
            for (int ks = 0; ks < 4; ++ks) qf[ks] = qn[ks];
            if (w == 0) {
                float s = glf0 + glf1;
#pragma unroll
                for (int d = 1; d < 64; d <<= 1) { const float t = __shfl_up(s, d); if (lane >= d) s += t; }
                const float b1 = s, b0 = s - glf1;
                const float u0 = gi0 - b0, u1 = gi1 - b1;
                float m = fmaxf(u0, u1);
#pragma unroll
                for (int d = 1; d < 64; d <<= 1) { const float t = __shfl_up(m, d); if (lane >= d) m = fmaxf(m, t); }
                float ex = __shfl_up(m, 1); if (lane == 0) ex = -INFINITY;
                const float wv0 = fmaxf(fmaxf(ex, u0), m_prev), wv1 = fmaxf(m, m_prev);
                const float wlast = __shfl(wv1, 63), blast = __shfl(b1, 63);
                gu[2 * lane] = u0; gu[2 * lane + 1] = u1; gwv[2 * lane] = wv0; gwv[2 * lane + 1] = wv1;
                gin[2 * lane] = __expf(m_prev - wv0); gin[2 * lane + 1] = __expf(m_prev - wv1);
                gfl[2 * lane] = __expf(-(b0 + wv0)); gfl[2 * lane + 1] = __expf(-(b1 + wv1));
                gwg[2 * lane] = __expf(u0 - wlast); gwg[2 * lane + 1] = __expf(u1 - wlast);
                m_prev = blast + wlast;
            }
        };
        load_chunk(0);
        store_chunk();
        __syncthreads();
        for (int ch = 0; ch < 16; ++ch) {
            if (ch < 15) load_chunk(ch + 1);
            {
                const int t = 16 * w + c; const float wt = gwv[t];
#pragma unroll
                for (int j = 0; j < 8; ++j) {
                    if (j <= w) {
                        f32x4 sa = (f32x4){0.f, 0.f, 0.f, 0.f};
#pragma unroll
                        for (int ks = 0; ks < 4; ++ks) { const bf16x8 kf = *(const LAS bf16x8*)(Ks + (16 * j + c) * RSK + (32 * ks + 8 * g) * 2); sa = __builtin_amdgcn_mfma_f32_16x16x32_bf16(kf, qf[ks], sa, 0, 0, 0); }
                        const f32x4 uv = *(const LAS f32x4*)(gu + 16 * j + 4 * g);
                        float pv_[4];
#pragma unroll
                        for (int r = 0; r < 4; ++r) { const int s = 16 * j + 4 * g + r; const float e = __expf(uv[r] - wt); pv_[r] = (s <= t) ? sa[r] * e : 0.f; }
                        u32x2 pk; pk.x = cvtpk(pv_[0], pv_[1]); pk.y = cvtpk(pv_[2], pv_[3]);
                        *(LAS u32x2*)(Ps + t * RSP + (16 * j + 4 * g) * 2) = pk;
                    } else if (j == w + 1 && (w & 1) == 0) {
                        *(LAS u32x2*)(Ps + t * RSP + (16 * j + 4 * g) * 2) = (u32x2){0u, 0u};
                    }
                }
            }
            f32x4 nacc[5];
#pragma unroll
            for (int vt = 0; vt < 5; ++vt) { nacc[vt] = (f32x4){0.f, 0.f, 0.f, 0.f};
#pragma unroll
                for (int ks = 0; ks < 4; ++ks) { const bf16x8 cf = *(const LAS bf16x8*)(Cs + (16 * vt + c) * RSC + (32 * ks + 8 * g) * 2); nacc[vt] = __builtin_amdgcn_mfma_f32_16x16x32_bf16(qf[ks], cf, nacc[vt], 0, 0, 0); } }
            { const f32x4 iv = *(const LAS f32x4*)(gin + 16 * w + 4 * g);
#pragma unroll
              for (int vt = 0; vt < 5; ++vt) nacc[vt] = nacc[vt] * iv; }
            __syncthreads();
            for (int ks = 0; ks <= (w >> 1); ++ks) {
                const bf16x8 pf = *(const LAS bf16x8*)(Ps + (16 * w + c) * RSP + (32 * ks + 8 * g) * 2);
#pragma unroll
                for (int vt = 0; vt < 5; ++vt) { const bf16x8 vf = tr2(Vs, 32 * ks, 16 * vt, RSV, lane); nacc[vt] = __builtin_amdgcn_mfma_f32_16x16x32_bf16(pf, vf, nacc[vt], 0, 0, 0); }
            }
            { const f32x4 fl = *(const LAS f32x4*)(gfl + 16 * w + 4 * g);
#pragma unroll
              for (int r = 0; r < 4; ++r) { const float den = __shfl(nacc[4][r], lane & 48); const float inv = 1.0f / fmaxf(fabsf(den), fl[r]);
                  bf16_t* orow = HO + (tok0 + (size_t)ch * 128 + 16 * w + 4 * g + r) * DM + h * 256 + sl * 64 + c;
#pragma unroll
                  for (int vt = 0; vt < 4; ++vt) orow[16 * vt] = (bf16_t)(cvtpk(nacc[vt][r] * inv, 0.f) & 0xffffu); } }
            { const float decay = gin[127];
#pragma unroll
              for (int vt = 0; vt < 5; ++vt) cacc[vt] = cacc[vt] * decay;
#pragma unroll
              for (int ks = 0; ks < 4; ++ks) {
                  bf16x8 kf = tr2(Ks, 32 * ks, 16 * w, RSK, lane);
                  const f32x4 w0 = *(const LAS f32x4*)(gwg + 32 * ks + 8 * g), w1 = *(const LAS f32x4*)(gwg + 32 * ks + 8 * g + 4);
                  u32x4 kw = __builtin_bit_cast(u32x4, kf);
                  kw.x = cvtpk(bflo(kw.x) * w0[0], bfhi(kw.x) * w0[1]); kw.y = cvtpk(bflo(kw.y) * w0[2], bfhi(kw.y) * w0[3]);
                  kw.z = cvtpk(bflo(kw.z) * w1[0], bfhi(kw.z) * w1[1]); kw.w = cvtpk(bflo(kw.w) * w1[2], bfhi(kw.w) * w1[3]);
                  kf = __builtin_bit_cast(bf16x8, kw);
#pragma unroll
                  for (int vt = 0; vt < 5; ++vt) { const bf16x8 vf = tr2(Vs, 32 * ks, 16 * vt, RSV, lane); cacc[vt] = __builtin_amdgcn_mfma_f32_16x16x32_bf16(kf, vf, cacc[vt], 0, 0, 0); }
              } }
            __syncthreads();
#pragma unroll
            for (int vt = 0; vt < 5; ++vt) { u32x2 pk; pk.x = cvtpk(cacc[vt][0], cacc[vt][1]); pk.y = cvtpk(cacc[vt][2], cacc[vt][3]); *(LAS u32x2*)(Cs + (16 * vt + c) * RSC + (16 * w + 4 * g) * 2) = pk; }
            if (ch < 15) store_chunk();
            __syncthreads();
        }
    }
}

__device__ __forceinline__ void phase_aprep(unsigned char* lds_, const Params& p) {
    const Frame F = make_frame(lds_);
    const bf16_t* HO = (const bf16_t*)(p.ws + WS_HOUT); const bf16_t* PR = (const bf16_t*)(p.ws + WS_PROJ); bf16_t* A2 = (bf16_t*)(p.ws + WS_H);
    float hn[16];
#pragma unroll
    for (int i = 0; i < 16; ++i) hn[i] = p.a_h_norm[16 * F.lane + i];
    const int gw = F.bid * NWAVES + F.wave, NGW = F.G * NWAVES;
    for (int rowb = gw; rowb < NTOK; rowb += 4 * NGW) {
        u32x4 h0[4], h1[4], o0[4], o1[4];
#pragma unroll
        for (int rr = 0; rr < 4; ++rr) { const int row = rowb + rr * NGW; if (row < NTOK) {
            h0[rr] = *(const u32x4*)(HO + (size_t)row * DM + 16 * F.lane); h1[rr] = *(const u32x4*)(HO + (size_t)row * DM + 16 * F.lane + 8);
            o0[rr] = *(const u32x4*)(PR + (size_t)row * 3072 + 2048 + 16 * F.lane); o1[rr] = *(const u32x4*)(PR + (size_t)row * 3072 + 2048 + 16 * F.lane + 8); } }
#pragma unroll
        for (int rr = 0; rr < 4; ++rr) { const int row = rowb + rr * NGW; if (row < NTOK) {
            float hv[16], ov[16];
#pragma unroll
            for (int i = 0; i < 4; ++i) { hv[2 * i] = bflo(h0[rr][i]); hv[2 * i + 1] = bfhi(h0[rr][i]); hv[8 + 2 * i] = bflo(h1[rr][i]); hv[8 + 2 * i + 1] = bfhi(h1[rr][i]);
                ov[2 * i] = bflo(o0[rr][i]); ov[2 * i + 1] = bfhi(o0[rr][i]); ov[8 + 2 * i] = bflo(o1[rr][i]); ov[8 + 2 * i + 1] = bfhi(o1[rr][i]); }
            float ss = 0.f;
#pragma unroll
            for (int i = 0; i < 16; ++i) ss += hv[i] * hv[i];
            ss += __shfl_xor(ss, 1); ss += __shfl_xor(ss, 2); ss += __shfl_xor(ss, 4); ss += __shfl_xor(ss, 8);
            const float r = 1.0f / sqrtf(ss * (1.0f / 256.0f) + EPS);
            float y[16];
#pragma unroll
            for (int i = 0; i < 16; ++i) y[i] = hv[i] * r * hn[i] * sigmoidf_(ov[i]);
            u32x4 w0, w1; w0.x = cvtpk(y[0], y[1]); w0.y = cvtpk(y[2], y[3]); w0.z = cvtpk(y[4], y[5]); w0.w = cvtpk(y[6], y[7]);
            w1.x = cvtpk(y[8], y[9]); w1.y = cvtpk(y[10], y[11]); w1.z = cvtpk(y[12], y[13]); w1.w = cvtpk(y[14], y[15]);
            *(u32x4*)(A2 + (size_t)row * DM + 16 * F.lane) = w0; *(u32x4*)(A2 + (size_t)row * DM + 16 * F.lane + 8) = w1; } }
    }
}

__device__ __forceinline__ void phase_hprep_router(unsigned char* lds_, const Params& p, int layer) {
    const Frame F = make_frame(lds_);
    LAS f32x4* Wr = (LAS f32x4*)F.lds;
    LAS int* cnt = (LAS int*)(F.lds + 65536);
    for (int idx = F.tid; idx < 4096; idx += NTHREADS) { const int ln = idx & 63, q = (idx >> 6) & 3, i = (idx >> 8) & 3, j = idx >> 10; const int c = 256 * j + 4 * ln + i;
        Wr[idx] = *(const f32x4*)(p.w_router + (size_t)c * 16 + q * 4); }
    const float* mod = (const float*)(p.ws + WS_MOD) + (size_t)layer * 16 * 6144;
    unsigned char* H = p.ws + WS_H;
    int* blkcnt = (int*)(p.ws + RT_BLKCNT); int* info = (int*)(p.ws + RT_INFO); float* tw = (float*)(p.ws + RT_W);
    if (F.bid == 0) { for (int i = F.tid; i < 256 * DM / 16; i += NTHREADS) *(u32x4*)(H + (size_t)NTOK * DM + i * 16) = (u32x4){0u, 0u, 0u, 0u}; }
    float rb[16];
#pragma unroll
    for (int e = 0; e < 16; ++e) rb[e] = p.router_bias[e];
    for (int chunk = F.bid; chunk < 256; chunk += F.G) {
        if (F.tid < 16) cnt[F.tid] = 0;
        __syncthreads();
        int lane = F.lane; asm volatile("" : "+v"(lane));
        const int row0 = chunk * 128 + F.wave * 16; const int b = row0 / SEQ;
        const RowConst rc = load_rowconst(p.norm2 + (size_t)layer * DM, mod + (size_t)b * 6144, 3072, 4096, lane);
        for (int rbk = 0; rbk < 16; rbk += 4) {
            f32x4 v[4][4];
#pragma unroll
            for (int rr = 0; rr < 4; ++rr)
#pragma unroll
                for (int j = 0; j < 4; ++j) v[rr][j] = *(const f32x4*)(p.out + (size_t)(row0 + rbk + rr) * DM + 256 * j + 4 * lane);
#pragma unroll
            for (int rr = 0; rr < 4; ++rr) { const int row = row0 + rbk + rr;
                asm volatile("" ::: "memory");
                f32x4 h[4];
                row_norm_store8(v[rr], rc, h, H + (size_t)row * DM, lane);
                float lg[16];
#pragma unroll
                for (int e = 0; e < 16; ++e) lg[e] = 0.f;
#pragma unroll
                for (int j = 0; j < 4; ++j)
#pragma unroll
                    for (int i = 0; i < 4; ++i) { const float hv = h[j][i]; if (i == 0 || i == 2) asm volatile("" ::: "memory");
#pragma unroll
                        for (int q = 0; q < 4; ++q) { const f32x4 wq = Wr[((j * 4 + i) * 4 + q) * 64 + lane]; lg[4 * q] += hv * wq[0]; lg[4 * q + 1] += hv * wq[1]; lg[4 * q + 2] += hv * wq[2]; lg[4 * q + 3] += hv * wq[3]; } }
                const float tot = reduce16(lg, lane);
                const float sg = 1.0f / (1.0f + expf(-tot));
                float sc[16], bs[16];
#pragma unroll
                for (int e = 0; e < 16; ++e) { sc[e] = __shfl(sg, 4 * e); bs[e] = sc[e] + rb[e]; }
                int gsel = 0; float gbest = -INFINITY;
#pragma unroll
                for (int gI = 0; gI < 4; ++gI) { const float a = bs[4 * gI], b2 = bs[4 * gI + 1], c2 = bs[4 * gI + 2], d2 = bs[4 * gI + 3];
                    const float hi1 = fmaxf(a, b2), lo1 = fminf(a, b2), hi2 = fmaxf(c2, d2), lo2 = fminf(c2, d2);
                    const float top = fmaxf(hi1, hi2), sec = fmaxf(fminf(hi1, hi2), fmaxf(lo1, lo2)); const float gs = top + sec;
                    if (gs > gbest) { gbest = gs; gsel = gI; } }
                float v0 = 0.f, v1 = 0.f, v2 = 0.f, v3 = 0.f, s0 = 0.f, s1 = 0.f, s2 = 0.f, s3 = 0.f;
#pragma unroll
                for (int gI = 0; gI < 4; ++gI) if (gI == gsel) { v0 = bs[4 * gI]; v1 = bs[4 * gI + 1]; v2 = bs[4 * gI + 2]; v3 = bs[4 * gI + 3]; s0 = sc[4 * gI]; s1 = sc[4 * gI + 1]; s2 = sc[4 * gI + 2]; s3 = sc[4 * gI + 3]; }
                int i1 = 0; float b1 = v0; if (v1 > b1) { b1 = v1; i1 = 1; } if (v2 > b1) { b1 = v2; i1 = 2; } if (v3 > b1) { b1 = v3; i1 = 3; }
                int i2 = -1; float bb = -INFINITY;
                if (i1 != 0 && v0 > bb) { bb = v0; i2 = 0; } if (i1 != 1 && v1 > bb) { bb = v1; i2 = 1; } if (i1 != 2 && v2 > bb) { bb = v2; i2 = 2; } if (i1 != 3 && v3 > bb) { bb = v3; i2 = 3; }
                const float sa = (i1 == 0) ? s0 : (i1 == 1) ? s1 : (i1 == 2) ? s2 : s3;
                const float sb = (i2 == 0) ? s0 : (i2 == 1) ? s1 : (i2 == 2) ? s2 : s3;
                const int e0 = gsel * 4 + i1, e1 = gsel * 4 + i2;
                if (lane == 0) { const int r0 = __hip_atomic_fetch_add(&cnt[e0], 1, __ATOMIC_RELAXED, __HIP_MEMORY_SCOPE_WORKGROUP); const int r1 = __hip_atomic_fetch_add(&cnt[e1], 1, __ATOMIC_RELAXED, __HIP_MEMORY_SCOPE_WORKGROUP);
                    info[row] = e0 | (e1 << 4) | (r0 << 8) | (r1 << 16); const float inv = 1.0f / (sa + sb); *(f32x2*)(tw + (size_t)row * 2) = (f32x2){sa * inv, sb * inv}; }
            }
        }
        __syncthreads();
        if (F.tid < 16) blkcnt[chunk * 16 + F.tid] = cnt[F.tid];
        __syncthreads();
    }
}

__device__ __forceinline__ void phase_layout(unsigned char* lds_, const Params& p) {
    const Frame F = make_frame(lds_);
    LAS int* lc = (LAS int*)F.lds;
    LAS int* tot = lc + 4096;
    LAS int* sst = tot + 16;
    LAS int* tst = sst + 16;
    const int* blkcnt = (const int*)(p.ws + RT_BLKCNT); const int* info = (const int*)(p.ws + RT_INFO);
    int* dest = (int*)(p.ws + RT_DEST); int* buftok = (int*)(p.ws + RT_BUFTOK); int* meta = (int*)(p.ws + RT_META);
    for (int i = F.tid; i < 4096; i += NTHREADS) lc[i] = blkcnt[i];
    __syncthreads();
    { const int e = F.tid >> 5, li = F.tid & 31; int v[8]; int s = 0;
      LAS int* part = tst + 32;
#pragma unroll
      for (int k = 0; k < 8; ++k) { v[k] = lc[(8 * li + k) * 16 + e]; s += v[k]; }
      part[e * 32 + li] = s;
      __syncthreads();
      int run = 0, all = 0;
      for (int k = 0; k < 32; ++k) { const int t = part[e * 32 + k]; all += t; if (k < li) run += t; }
#pragma unroll
      for (int k = 0; k < 8; ++k) { lc[(8 * li + k) * 16 + e] = run; run += v[k]; }
      if (li == 31) tot[e] = all; }
    __syncthreads();
    if (F.tid == 0) { int ts = 0; for (int e = 0; e < 16; ++e) { tst[e] = ts; sst[e] = ts * 256; ts += (tot[e] + 255) >> 8; } tst[16] = ts;
        if (F.bid == 0) { meta[0] = ts; for (int e = 0; e <= 16; ++e) meta[1 + e] = tst[e]; } }
    __syncthreads();
    for (int chunk = F.bid; chunk < 256; chunk += F.G) {
        if (F.tid < 128) { const int tok = chunk * 128 + F.tid; const int inf = info[tok]; const int e0 = inf & 15, e1 = (inf >> 4) & 15, r0 = (inf >> 8) & 255, r1 = (inf >> 16) & 255;
            const int d0 = sst[e0] + lc[chunk * 16 + e0] + r0, d1 = sst[e1] + lc[chunk * 16 + e1] + r1;
            buftok[d0] = tok; buftok[d1] = tok; dest[tok * 2] = d0; dest[tok * 2 + 1] = d1; }
    }
    for (int e = F.bid; e < 16; e += F.G) { const int beg = sst[e] + tot[e], end = tst[e + 1] * 256; for (int s = beg + F.tid; s < end; s += NTHREADS) buftok[s] = NTOK; }
}

__device__ __forceinline__ void phase_combine(unsigned char* lds_, const Params& p, int layer, bool next_prep) {
    const Frame F = make_frame(lds_);
    const float* mod = (const float*)(p.ws + WS_MOD) + (size_t)layer * 16 * 6144;
    const float* modn = (const float*)(p.ws + WS_MOD) + (size_t)(layer + 1) * 16 * 6144;
    const bf16_t* Y = (const bf16_t*)(p.ws + WS_PROJ); bf16_t* H = (bf16_t*)(p.ws + WS_H);
    const int* dest = (const int*)(p.ws + RT_DEST); const float* tw = (const float*)(p.ws + RT_W);
    for (int chunk = F.bid; chunk < 256; chunk += F.G) {
        const int row0 = chunk * 128 + F.wave * 16; const int b = row0 / SEQ;
        f32x4 g2[4];
#pragma unroll
        for (int j = 0; j < 4; ++j) g2[j] = *(const f32x4*)(mod + (size_t)b * 6144 + 5120 + 256 * j + 4 * F.lane);
        RowConst rc;
        if (next_prep) rc = load_rowconst(p.norm1 + (size_t)(layer + 1) * DM, modn + (size_t)b * 6144, 0, 1024, F.lane);
        for (int rb = 0; rb < 16; rb += 4) {
            int d0[4], d1[4]; float w0[4], w1[4];
#pragma unroll
            for (int rr = 0; rr < 4; ++rr) { const int row = row0 + rb + rr; d0[rr] = dest[row * 2]; d1[rr] = dest[row * 2 + 1]; w0[rr] = tw[row * 2]; w1[rr] = tw[row * 2 + 1]; }
            f32x4 xv[4][4]; u32x2 ya[4][4], yb[4][4];
#pragma unroll
            for (int rr = 0; rr < 4; ++rr)
#pragma unroll
                for (int j = 0; j < 4; ++j) { xv[rr][j] = *(const f32x4*)(p.out + (size_t)(row0 + rb + rr) * DM + 256 * j + 4 * F.lane);
                    ya[rr][j] = *(const u32x2*)(Y + (size_t)d0[rr] * DM + 256 * j + 4 * F.lane); yb[rr][j] = *(const u32x2*)(Y + (size_t)d1[rr] * DM + 256 * j + 4 * F.lane); }
#pragma unroll
            for (int rr = 0; rr < 4; ++rr) { const int row = row0 + rb + rr;
                f32x4 v[4];
#pragma unroll
                for (int j = 0; j < 4; ++j) { const u32x2 a = ya[rr][j], bq = yb[rr][j]; f32x4 yy;
                    yy[0] = w0[rr] * bflo(a.x) + w1[rr] * bflo(bq.x); yy[1] = w0[rr] * bfhi(a.x) + w1[rr] * bfhi(bq.x); yy[2] = w0[rr] * bflo(a.y) + w1[rr] * bflo(bq.y); yy[3] = w0[rr] * bfhi(a.y) + w1[rr] * bfhi(bq.y);
                    v[j] = xv[rr][j] + g2[j] * yy; *(f32x4*)(p.out + (size_t)row * DM + 256 * j + 4 * F.lane) = v[j]; }
                if (next_prep) { f32x4 h[4]; row_norm_store(v, rc, h, H + (size_t)row * DM, F.lane); }
            }
        }
    }
}

__device__ __forceinline__ void phase_qkprep(unsigned char* lds_, const Params& p) {
    const Frame F = make_frame(lds_);
    bf16_t* PR = (bf16_t*)(p.ws + WS_PROJ);
    const int lane = F.lane, half = lane & 1, sh = lane >> 1;
    float nw[32];
    { const float* nsrc = (sh < 16) ? p.b_q_norm : p.b_k_norm;
#pragma unroll
      for (int i = 0; i < 32; ++i) nw[i] = nsrc[half * 32 + i]; }
    const float qscale = (sh < 16) ? 0.125f * 1.4426950408889634f : 1.0f;
    const float invf_tab[8] = {1.0f, 0.19391788f, 0.037604144f, 0.0072920943f, 0.0014140673f, 0.00027421273f, 5.3174683e-05f, 1.0311522e-05f};
    float invf = 0.f;
#pragma unroll
    for (int i = 0; i < 8; ++i) if ((lane & 7) == i) invf = invf_tab[i];
    const int gw = F.bid * NWAVES + F.wave, NGW = F.G * NWAVES;
    for (int rowb = gw; rowb < NTOK; rowb += 4 * NGW) {
        u32x4 raw[4][4]; int posi[4];
#pragma unroll
        for (int rr = 0; rr < 4; ++rr) { const int row = rowb + rr * NGW; if (row < NTOK) { posi[rr] = p.positions[row]; const bf16_t* ptr = PR + (size_t)row * 3072 + sh * 64 + half * 32;
#pragma unroll
            for (int k = 0; k < 4; ++k) raw[rr][k] = *(const u32x4*)(ptr + 8 * k); } }
#pragma unroll
        for (int rr = 0; rr < 4; ++rr) { const int row = rowb + rr * NGW; if (row < NTOK) {
            const float ang = (float)posi[rr] * invf;
            const double rev = (double)ang * 0.15915494309189535; const float fr = (float)(rev - rint(rev));
            const float cs = __builtin_amdgcn_cosf(fr), sn = __builtin_amdgcn_sinf(fr);
            bf16_t* ptr = PR + (size_t)row * 3072 + sh * 64 + half * 32;
            float v[32];
#pragma unroll
            for (int k = 0; k < 4; ++k)
#pragma unroll
                for (int i = 0; i < 4; ++i) { v[8 * k + 2 * i] = bflo(raw[rr][k][i]); v[8 * k + 2 * i + 1] = bfhi(raw[rr][k][i]); }
            float ss = 0.f;
#pragma unroll
            for (int i = 0; i < 32; ++i) ss += v[i] * v[i];
            ss += __shfl_xor(ss, 1);
            const float r = 1.0f / sqrtf(ss * (1.0f / 64.0f) + EPS);
#pragma unroll
            for (int i = 0; i < 32; ++i) v[i] = v[i] * r * nw[i];
            float y1[8], y2[8];
#pragma unroll
            for (int i = 0; i < 8; ++i) { const float ci = __shfl(cs, i), si = __shfl(sn, i); y1[i] = v[i] * ci - v[8 + i] * si; y2[i] = v[8 + i] * ci + v[i] * si; }
            if (half == 0) {
#pragma unroll
                for (int i = 0; i < 8; ++i) { v[i] = y1[i]; v[8 + i] = y2[i]; } }
#pragma unroll
            for (int k = 0; k < 4; ++k) { u32x4 o;
#pragma unroll
                for (int i = 0; i < 4; ++i) o[i] = cvtpk(v[8 * k + 2 * i] * qscale, v[8 * k + 2 * i + 1] * qscale);
                *(u32x4*)(ptr + 8 * k) = o; } } }
    }
}

__device__ __forceinline__ void phase_attn(unsigned char* lds_, const Params& p) {
    const Frame F = make_frame(lds_);
    const attn_body::bf16* PR = (const attn_body::bf16*)(p.ws + WS_PROJ); attn_body::bf16* O4 = (attn_body::bf16*)(p.ws + WS_HOUT);
    for (int u = 0; ; ++u) {
        const int pair = F.vcu + (u >> 3) * F.G; if (pair >= 512) break;
        attn_body::attn_unit<8>(pair, 7 - (u & 7), PR, O4, (char*)lds_);
    }
}

__device__ __forceinline__ void phase_ocombine(unsigned char* lds_, const Params& p) {
    const Frame F = make_frame(lds_);
    const bf16_t* O4 = (const bf16_t*)(p.ws + WS_HOUT); bf16_t* A2 = (bf16_t*)(p.ws + WS_H);
    const float lam_init = 0.8f - 0.6f * 0.7408182206817179f;
    const float s1 = wave_sum(p.b_lam_q1[F.lane] * p.b_lam_k1[F.lane]), s2 = wave_sum(p.b_lam_q2[F.lane] * p.b_lam_k2[F.lane]);
    const float lam = expf(s1) - expf(s2) + lam_init;
    const int lane = F.lane, hh = lane >> 3, sub = lane & 7, half = sub >> 2, j0 = (sub & 3) * 16;
    float on[16];
#pragma unroll
    for (int i = 0; i < 16; ++i) on[i] = p.b_o_norm[half * 64 + j0 + i] * (1.0f - lam_init);
    const int gw = F.bid * NWAVES + F.wave, NGW = F.G * NWAVES;
    for (int rowb = gw; rowb < NTOK; rowb += 4 * NGW) {
        u32x4 a0[4], a1[4], b0[4], b1[4];
#pragma unroll
        for (int rr = 0; rr < 4; ++rr) { const int row = rowb + rr * NGW; if (row < NTOK) {
            const bf16_t* pa = O4 + (size_t)row * 2048 + ((hh * 2 + 0) * 2 + half) * 64 + j0; const bf16_t* pb = O4 + (size_t)row * 2048 + ((hh * 2 + 1) * 2 + half) * 64 + j0;
            a0[rr] = *(const u32x4*)pa; a1[rr] = *(const u32x4*)(pa + 8); b0[rr] = *(const u32x4*)pb; b1[rr] = *(const u32x4*)(pb + 8); } }
#pragma unroll
        for (int rr = 0; rr < 4; ++rr) { const int row = rowb + rr * NGW; if (row < NTOK) {
            float d[16];
#pragma unroll
            for (int i = 0; i < 4; ++i) { d[2 * i] = bflo(a0[rr][i]) - lam * bflo(b0[rr][i]); d[2 * i + 1] = bfhi(a0[rr][i]) - lam * bfhi(b0[rr][i]); d[8 + 2 * i] = bflo(a1[rr][i]) - lam * bflo(b1[rr][i]); d[8 + 2 * i + 1] = bfhi(a1[rr][i]) - lam * bfhi(b1[rr][i]); }
            float ss = 0.f;
#pragma unroll
            for (int i = 0; i < 16; ++i) ss += d[i] * d[i];
            ss += __shfl_xor(ss, 1); ss += __shfl_xor(ss, 2); ss += __shfl_xor(ss, 4);
            const float r = 1.0f / sqrtf(ss * (1.0f / 128.0f) + EPS);
            u32x4 w0, w1;
            w0.x = cvtpk(d[0] * r * on[0], d[1] * r * on[1]); w0.y = cvtpk(d[2] * r * on[2], d[3] * r * on[3]); w0.z = cvtpk(d[4] * r * on[4], d[5] * r * on[5]); w0.w = cvtpk(d[6] * r * on[6], d[7] * r * on[7]);
            w1.x = cvtpk(d[8] * r * on[8], d[9] * r * on[9]); w1.y = cvtpk(d[10] * r * on[10], d[11] * r * on[11]); w1.z = cvtpk(d[12] * r * on[12], d[13] * r * on[13]); w1.w = cvtpk(d[14] * r * on[14], d[15] * r * on[15]);
            bf16_t* po = A2 + (size_t)row * DM + hh * 128 + half * 64 + j0;
            *(u32x4*)po = w0; *(u32x4*)(po + 8) = w1; } }
    }
}


#ifndef PHASE_MASK
#define PHASE_MASK 0xFFFFFFFFu
#endif
#define PH(n) ((PHASE_MASK >> (n)) & 1u)

template <int LAYER>
__device__ __forceinline__ void layer_body(const Params& p, const XcdBarrier& bar, unsigned char* lds) {
    const int G_ = gridDim.x, bid_ = blockIdx.x; LAS unsigned char* ldsl = (LAS unsigned char*)lds;
#define SEAM() xcd_barrier(bar)
    const float* mod = (const float*)(p.ws + WS_MOD);
    LAS int* tab = (LAS int*)(ldsl + TAB_OFF);
    if (PH(2)) { pg8::StaticOrder S; S.init(NTOK, 3072, G_, bid_);
      pg8::EpiBf16 E{(bf16_t*)(p.ws + WS_PROJ), 3072, LAYER == 0 ? 2 : 0, LAYER == 0 ? 4 : 0, 0.08838834764831845f};
      pg8::gemm_phase<pg8::EpiBf16, pg8::StaticOrder, false>(ldsl, (const bf16_t*)(p.ws + WS_H), (const bf16_t*)(p.ws + (LAYER == 0 ? WS_WAIN : WS_WBIN)), 0, 1024, S, E, nullptr); }
    SEAM();
    if (LAYER == 0) {
        if (PH(3)) phase_mlstm(lds, p);
        SEAM();
        if (PH(4)) phase_aprep(lds, p);
    } else {
        if (PH(5)) phase_qkprep(lds, p);
        SEAM();
        if (PH(6)) phase_attn(lds, p);
        SEAM();
        if (PH(7)) phase_ocombine(lds, p);
    }
    SEAM();
    if (PH(8)) { pg8::StaticOrder S; S.init(NTOK, 1024, G_, bid_);
      pg8::EpiResid E{LAYER == 0 ? p.x : p.out, p.out, mod + (size_t)LAYER * 16 * 6144 + 2048};
      pg8::gemm_phase<pg8::EpiResid, pg8::StaticOrder, false>(ldsl, (const bf16_t*)(p.ws + WS_H), (const bf16_t*)(p.ws + (LAYER == 0 ? WS_WAOUT : WS_WBOUT)), 0, 1024, S, E, nullptr); }
    SEAM();
    if (PH(9)) phase_hprep_router(lds, p, LAYER);
    SEAM();
    if (PH(10)) phase_layout(lds, p);
    SEAM();
    if (PH(11)) { const int* meta = (const int*)(p.ws + RT_META);
      __syncthreads();
      if ((int)threadIdx.x < 17) tab[(int)threadIdx.x] = meta[1 + (int)threadIdx.x];
      __syncthreads();
      pg8::MoeOrder S{G_, bid_, tab[16], tab};
      pg8::EpiSwiGLU8 E1{p.ws + WS_HOUT, 1.0f / (S8_H * S8_WGU)};
      pg8::gemm_phase8<pg8::EpiSwiGLU8, pg8::MoeOrder, true>(ldsl, p.ws + WS_H, p.ws + WS_WGU + (size_t)LAYER * 16 * 1024 * 1024, (size_t)1024 * 1024, 1024, S, E1, (const int*)(p.ws + RT_BUFTOK));
      SEAM();
      pg8::EpiBf16 E2{(bf16_t*)(p.ws + WS_PROJ), 1024, 0, 1 << 30, 1.0f / (S8_ACT * S8_WDN)};
      pg8::gemm_phase8<pg8::EpiBf16, pg8::MoeOrder, false>(ldsl, p.ws + WS_HOUT, p.ws + WS_WDN + (size_t)LAYER * 16 * 1024 * 512, (size_t)1024 * 512, 512, S, E2, nullptr); }
    SEAM();
    if (PH(12)) phase_combine(lds, p, LAYER, LAYER == 0);
#undef SEAM
}
__global__ void __launch_bounds__(NTHREADS, 2) mk_fwd(Params p) {
    extern __shared__ __attribute__((aligned(16))) unsigned char lds[];
    cg::grid_group grid = cg::this_grid();
    volatile LAS unsigned* misc = (volatile LAS unsigned*)((LAS unsigned char*)lds + MISC_OFF);
    if (threadIdx.x < 32) misc[threadIdx.x] = 0u;
    __syncthreads();
    unsigned* ctl = (unsigned*)p.ws;
    XcdBarrier bar = xcd_barrier_post(ctl + CW_BAR, misc + 8);
    if (PH(0)) phase_mod(lds, p);
    __syncthreads();
    if (PH(0)) phase_wconv(lds, p);
    grid.sync();
    if (PH(1)) phase_hprep0(lds, p);
    xcd_barrier(bar);
    layer_body<0>(p, bar, lds);
    xcd_barrier(bar);
    layer_body<1>(p, bar, lds);
    if (xb_ld(ctl + CW_BAR + XB_TMO) != 0u) { __syncthreads(); for (size_t i = (size_t)blockIdx.x * NTHREADS + threadIdx.x; i < (size_t)NTOK * DM / 4; i += (size_t)gridDim.x * NTHREADS) ((f32x4*)p.out)[i] = (f32x4){1e30f, 1e30f, 1e30f, 1e30f}; }
}

extern "C" void kernel_launch(void* const* d_in, const int* in_sizes, int n_in, void* d_out, int out_size, void* d_ws, size_t ws_size, hipStream_t stream) {
    static int grid_blocks = 0;
    if (!grid_blocks) {
        int dev = 0, cus = 0, per_cu = 0;
        (void)hipGetDevice(&dev);
        (void)hipDeviceGetAttribute(&cus, hipDeviceAttributeMultiprocessorCount, dev);
        (void)hipFuncSetAttribute((const void*)mk_fwd, hipFuncAttributeMaxDynamicSharedMemorySize, LDS_BYTES);
        (void)hipOccupancyMaxActiveBlocksPerMultiprocessor(&per_cu, (const void*)mk_fwd, NTHREADS, LDS_BYTES);
        if (per_cu < 1) { fprintf(stderr, "kernel_launch: occupancy query reports %d blocks/CU\n", per_cu); per_cu = 1; }
        grid_blocks = cus;
        if (ws_size < WS_END || n_in != 24) fprintf(stderr, "kernel_launch: unexpected ws_size %zu (need %zu) or n_in %d\n", ws_size, (size_t)WS_END, n_in);
    }
    (void)hipMemsetAsync(d_ws, 0, CTL_BYTES, stream);
    Params p{};
    const float** pf = (const float**)&p;
    p.x = (const float*)d_in[0]; p.c = (const float*)d_in[1]; p.positions = (const int*)d_in[2]; p.norm1 = (const float*)d_in[3]; p.norm2 = (const float*)d_in[4];
    p.w_ada = (const float*)d_in[5]; p.b_ada = (const float*)d_in[6]; p.a_w_in = (const float*)d_in[7]; p.a_b_if = (const float*)d_in[8]; p.a_h_norm = (const float*)d_in[9];
    p.a_w_out = (const float*)d_in[10]; p.b_w_in = (const float*)d_in[11]; p.b_q_norm = (const float*)d_in[12]; p.b_k_norm = (const float*)d_in[13];
    p.b_lam_q1 = (const float*)d_in[14]; p.b_lam_k1 = (const float*)d_in[15]; p.b_lam_q2 = (const float*)d_in[16]; p.b_lam_k2 = (const float*)d_in[17];
    p.b_o_norm = (const float*)d_in[18]; p.b_w_out = (const float*)d_in[19]; p.w_router = (const float*)d_in[20]; p.router_bias = (const float*)d_in[21];
    p.moe_w_gu = (const float*)d_in[22]; p.moe_w_down = (const float*)d_in[23];
    p.out = (float*)d_out; p.ws = (unsigned char*)d_ws; (void)pf;
    void* args[] = {&p};
    hipError_t e = hipLaunchCooperativeKernel((const void*)mk_fwd, dim3(grid_blocks), dim3(NTHREADS), args, LDS_BYTES, stream);
    if (e != hipSuccess) fprintf(stderr, "cooperative launch failed: %s (grid %d)\n", hipGetErrorString(e), grid_blocks);
}
```

```cpp
#include <hip/hip_runtime.h>
#include <hip/hip_cooperative_groups.h>
#include <hip/hip_bf16.h>
#include <cstdio>
#include <cstdint>
#include <cmath>
namespace cg = cooperative_groups;

#define GAS __attribute__((address_space(1)))
#define LAS __attribute__((address_space(3)))
typedef unsigned short bf16_t;
typedef float f32x4 __attribute__((ext_vector_type(4)));
typedef float f32x2 __attribute__((ext_vector_type(2)));
typedef short bf16x8 __attribute__((ext_vector_type(8)));
typedef short s16x4 __attribute__((ext_vector_type(4)));
typedef unsigned u32x4 __attribute__((ext_vector_type(4)));
typedef unsigned u32x2 __attribute__((ext_vector_type(2)));
typedef __bf16 bf16x2_t __attribute__((ext_vector_type(2)));
typedef int i32x8 __attribute__((ext_vector_type(8)));
typedef int i32x4 __attribute__((ext_vector_type(4)));

constexpr int NTOK = 32768, DM = 1024, SEQ = 2048, NB = 16;
constexpr int NEXP = 16, DEXP = 512;
constexpr int NTHREADS = 512, NWAVES = 8;
constexpr int LDS_BYTES = 147456;
constexpr int MISC_OFF = LDS_BYTES - 128;
constexpr int TAB_OFF = 131072;
constexpr float EPS = 1e-6f;
constexpr int MAXTILES = 272, CAP = MAXTILES * 256;
constexpr float S8_H = 8.0f, S8_WGU = 256.0f, S8_ACT = 4.0f, S8_WDN = 128.0f, S8_WIN = 256.0f, S8_A2 = 16.0f, S8_WOUT = 256.0f, S8_Y = 16.0f;

constexpr size_t MiB = 1u << 20;
constexpr size_t WS_CTL = 0, CTL_BYTES = 1 * MiB;
constexpr int CW_BAR = 4096;
constexpr int CW_FLAGS = 8192;
constexpr size_t WS_MOD = 1 * MiB;
constexpr size_t WS_ROUTE = 2 * MiB;
constexpr size_t RT_BLKCNT = WS_ROUTE;
constexpr size_t RT_INFO = WS_ROUTE + 64 * 1024;
constexpr size_t RT_W = RT_INFO + 128 * 1024;
constexpr size_t RT_DEST = RT_W + 256 * 1024;
constexpr size_t RT_BUFTOK = RT_DEST + 256 * 1024;
constexpr size_t RT_META = RT_BUFTOK + 320 * 1024;
constexpr size_t WS_GATES = 4 * MiB;
constexpr size_t WS_SCALES = 5 * MiB;
constexpr size_t SC_RS_H = WS_SCALES;
constexpr size_t SC_RS_A = WS_SCALES + 128 * 1024;
constexpr size_t SC_RS_TOK = WS_SCALES + 256 * 1024;
constexpr size_t SC_RS_SLOT = WS_SCALES + 384 * 1024;
constexpr size_t SC_CW = WS_SCALES + 704 * 1024;
constexpr int CW_AIN = 0, CW_AOUT = 3072, CW_BIN = 4096, CW_GU = 7168, CW_BOUT = 7168 + 32 * 1024;
constexpr int WQ_OUT1 = 2;
constexpr float A2Q = 127.0f / 6.0f;
constexpr int WQ_IN0 = 2, WQ_IN1 = 1, WQ_OUT0 = 2, WQ_GU = 1;
constexpr size_t WS_WAIN = 6 * MiB, WS_WAOUT = 10 * MiB, WS_WBIN = 12 * MiB, WS_WBOUT = 16 * MiB;
constexpr size_t WS_WGU = 18 * MiB;
constexpr size_t WS_WDN = 50 * MiB;
constexpr size_t WS_H = 66 * MiB;
constexpr size_t WS_XB = 100 * MiB;
constexpr size_t WS_PROJ = 164 * MiB;
constexpr size_t WS_HOUT = 356 * MiB;
constexpr size_t WS_CS = 484 * MiB;
constexpr size_t WS_WAIN_BF = 488 * MiB;
constexpr size_t WS_WAOUT_BF = 506 * MiB, WS_WBOUT_BF = 508 * MiB;
constexpr size_t WS_A2B = 420 * MiB;
constexpr bool OUTPROJ_FP8 = false;
constexpr size_t WS_END = 510 * MiB;
constexpr bool INPROJ0_FP8 = false;

__device__ __forceinline__ unsigned cvtpk(float lo, float hi) { f32x2 v = {lo, hi}; bf16x2_t b = __builtin_convertvector(v, bf16x2_t); return __builtin_bit_cast(unsigned, b); }
__device__ __forceinline__ float clamp448(float v) { return fminf(fmaxf(v, -448.0f), 448.0f); }
__device__ __forceinline__ unsigned cvt4_fp8(float a, float b, float c, float d) {
    int w = __builtin_amdgcn_cvt_pk_fp8_f32(clamp448(a), clamp448(b), 0, false); w = __builtin_amdgcn_cvt_pk_fp8_f32(clamp448(c), clamp448(d), w, true); return (unsigned)w; }
__device__ __forceinline__ float bf2f(unsigned short h) { return __uint_as_float(((unsigned)h) << 16); }
__device__ __forceinline__ float bflo(unsigned w) { return __uint_as_float(w << 16); }
__device__ __forceinline__ float bfhi(unsigned w) { return __uint_as_float(w & 0xffff0000u); }
__device__ __forceinline__ int lane_id() { int l; asm volatile("v_mbcnt_lo_u32_b32 %0, -1, 0\n\tv_mbcnt_hi_u32_b32 %0, -1, %0" : "=v"(l)); return l; }
template <int M> __device__ __forceinline__ float sx(float v) {
    const int i = __float_as_int(v);
    if constexpr (M == 1) return __int_as_float(__builtin_amdgcn_mov_dpp(i, 0xB1, 0xF, 0xF, true));
    else if constexpr (M == 2) return __int_as_float(__builtin_amdgcn_mov_dpp(i, 0x4E, 0xF, 0xF, true));
    else if constexpr (M == 4) return __int_as_float(__builtin_amdgcn_ds_swizzle(i, 0x101F));
    else if constexpr (M == 8) return __int_as_float(__builtin_amdgcn_ds_swizzle(i, 0x201F));
    else if constexpr (M == 16) return __int_as_float(__builtin_amdgcn_ds_swizzle(i, 0x401F));
    else { static_assert(M == 1, "sx: mask"); return v; }
}
__device__ __forceinline__ float sx16p(float v, bool odd_row) {
    auto rr = __builtin_amdgcn_permlane16_swap(__float_as_uint(v), __float_as_uint(v), false, false);
    return __uint_as_float(odd_row ? rr[0] : rr[1]);
}
__device__ __forceinline__ float sx32(float v, bool upper) {
    auto rr = __builtin_amdgcn_permlane32_swap(__float_as_uint(v), __float_as_uint(v), false, false);
    return __uint_as_float(upper ? rr[0] : rr[1]);
}
__device__ __forceinline__ float bperm(float v, int src_lane) { return __int_as_float(__builtin_amdgcn_ds_bpermute(src_lane << 2, __float_as_int(v))); }
__device__ __forceinline__ float rdlane(float v, int l) { return __int_as_float(__builtin_amdgcn_readlane(__float_as_int(v), l)); }
__device__ __forceinline__ float wave_sum(float v) {
    v += sx<1>(v); v += sx<2>(v); v += sx<4>(v); v += sx<8>(v); v += sx<16>(v);
    { auto rr = __builtin_amdgcn_permlane32_swap(__float_as_uint(v), __float_as_uint(v), false, false); v = __uint_as_float(rr[0]) + __uint_as_float(rr[1]); }
    return v;
}
__device__ __forceinline__ float wave_max(float v) {
    v = fmaxf(v, sx<1>(v)); v = fmaxf(v, sx<2>(v)); v = fmaxf(v, sx<4>(v)); v = fmaxf(v, sx<8>(v)); v = fmaxf(v, sx<16>(v));
    { auto rr = __builtin_amdgcn_permlane32_swap(__float_as_uint(v), __float_as_uint(v), false, false); v = fmaxf(__uint_as_float(rr[0]), __uint_as_float(rr[1])); }
    return v;
}
__device__ __forceinline__ unsigned pack4_i8(float a, float b, float c, float d) {
    unsigned w = __builtin_amdgcn_cvt_pk_u8_f32(fminf(fmaxf(rintf(a), -127.f), 127.f) + 128.f, 0, 0u);
    w = __builtin_amdgcn_cvt_pk_u8_f32(fminf(fmaxf(rintf(b), -127.f), 127.f) + 128.f, 1, w);
    w = __builtin_amdgcn_cvt_pk_u8_f32(fminf(fmaxf(rintf(c), -127.f), 127.f) + 128.f, 2, w);
    w = __builtin_amdgcn_cvt_pk_u8_f32(fminf(fmaxf(rintf(d), -127.f), 127.f) + 128.f, 3, w);
    return w ^ 0x80808080u;
}
__device__ __forceinline__ f32x4 i2f4(f32x4 a) { return (f32x4){(float)__float_as_int(a[0]), (float)__float_as_int(a[1]), (float)__float_as_int(a[2]), (float)__float_as_int(a[3])}; }
__device__ __forceinline__ float sigmoidf_(float x) { return 1.0f / (1.0f + __expf(-x)); }

#define XB_TMO      128
#define XB_XCNT(j)  (256  + 64 * (j))
#define XB_XSUB(j)  (1280 + 64 * (j))
#define XB_XGEN(j)  (2304 + 64 * (j))
#define XB_TOP      3328
#define XB_TOPGEN   3392
#define XCD_BAR_WORDS 3456
#define XB_SPIN_CAP (1u << 18)
__device__ __forceinline__ unsigned xb_ld(unsigned* p)              { return __hip_atomic_load(p, __ATOMIC_RELAXED, __HIP_MEMORY_SCOPE_AGENT); }
__device__ __forceinline__ unsigned xb_add(unsigned* p, unsigned v) { return __hip_atomic_fetch_add(p, v, __ATOMIC_RELAXED, __HIP_MEMORY_SCOPE_AGENT); }
__device__ __forceinline__ unsigned xb_xcc_id() { return (unsigned)__builtin_amdgcn_s_getreg((3 << 11) | 20) & 0xFu; }
#define XB_SPIN(cond, bar) do { unsigned _sp = 0; while (cond) { __builtin_amdgcn_s_sleep(1); \
    if ((++_sp & 255u) == 0u) { if (xb_ld(&(bar)[XB_TMO])) break; if (_sp > XB_SPIN_CAP) { atomicAdd(&(bar)[XB_TMO], 1u); break; } } } } while (0)
struct XcdBarrier { unsigned* bar; unsigned x; volatile LAS unsigned* st; int wave; };
__device__ __forceinline__ XcdBarrier xcd_barrier_post(unsigned* bar, volatile LAS unsigned* st, int wave) {
    XcdBarrier b; b.bar = bar; b.x = xb_xcc_id(); b.st = st; b.wave = wave;
    if (wave == 0 && lane_id() == 0) st[3] = xb_add(&bar[XB_XCNT(b.x)], 1u);
    return b;
}
__device__ __forceinline__ void xcd_barrier_complete(unsigned* bar, unsigned x, unsigned& nloc, unsigned& nx, unsigned& dx) {
    const unsigned G = gridDim.x * gridDim.y * gridDim.z;
    unsigned sum, cnt, mine, below, sp = 0u;
    for (;;) {
        sum = 0u; cnt = 0u; mine = 0u; below = 0u;
#pragma unroll
        for (unsigned j = 0; j < 16; ++j) { const unsigned c = xb_ld(&bar[XB_XCNT(j)]); sum += c; cnt += (c > 0u) ? 1u : 0u; mine = (j == x) ? c : mine; below += (j < x && c > 0u) ? 1u : 0u; }
        if (sum == G) break;
        __builtin_amdgcn_s_sleep(1);
        if ((++sp & 255u) == 0u) { if (xb_ld(&bar[XB_TMO])) break; if (sp > XB_SPIN_CAP) { atomicAdd(&bar[XB_TMO], 1u); break; } }
    }
    nloc = mine > 0u ? mine : 1u; nx = cnt > 0u ? cnt : 1u; dx = below;
}
__device__ __forceinline__ void xcd_barrier(const XcdBarrier& b) {
    asm volatile("s_waitcnt vmcnt(0)" ::: "memory");
    __syncthreads();
    if (b.wave == 0 && lane_id() == 0) {
        unsigned* bar = b.bar;
        __builtin_amdgcn_s_waitcnt(0);
        unsigned nloc = b.st[0], nx = b.st[1];
        if (nloc == 0u) { unsigned dx; xcd_barrier_complete(bar, b.x, nloc, nx, dx); b.st[0] = nloc; b.st[1] = nx; b.st[2] = dx; }
        const unsigned old = xb_add(&bar[XB_XSUB(b.x)], 1u);
        const unsigned gen = old / nloc;
        if (old + 1u == (gen + 1u) * nloc) {
            __builtin_amdgcn_fence(__ATOMIC_RELEASE, "agent");
            asm volatile("s_waitcnt vmcnt(0)" ::: "memory");
            const unsigned og = xb_add(&bar[XB_TOP], 1u);
            const unsigned target = (og / nx + 1u) * nx;
            if (og + 1u != target) XB_SPIN(xb_ld(&bar[XB_TOP]) < target, bar);
            __builtin_amdgcn_fence(__ATOMIC_ACQUIRE, "agent");
            xb_add(&bar[XB_XGEN(b.x)], 1u);
            asm volatile("s_waitcnt vmcnt(0)" ::: "memory");
        } else {
            XB_SPIN(xb_ld(&bar[XB_XGEN(b.x)]) == gen, bar);
            __builtin_amdgcn_fence(__ATOMIC_ACQUIRE, "agent");
            asm volatile("s_waitcnt vmcnt(0)" ::: "memory");
        }
    }
    __syncthreads();
}

namespace pg8 {
constexpr int BM = 256, BK = 64, HALF = 128, HTB = HALF * BK * 2, STAGE_BYTES = 8 * HTB, NXCD = 8, WGM = 8;
__device__ __forceinline__ int lds_byte(int r, int c) { const int st = (r >> 4) * 2 + (c >> 5), rr = r & 15, cc = c & 31, ob = rr * 64 + cc * 2; return st * 1024 + (ob ^ (((ob >> 9) & 1) << 5)); }
__device__ __forceinline__ void stage_rc(int b, int& R, int& C) { const int st = b / 1024, sb = b % 1024, swz = sb ^ (((sb >> 9) & 1) << 5); R = (st >> 1) * 16 + swz / 64; C = (st & 1) * 32 + (swz % 64) / 2; }
__device__ __forceinline__ int perm32(int rho) { const int n = rho >> 4, i = rho & 15; return 8 * (i >> 2) + 4 * n + (i & 3); }

struct Unit { int pm, pn, e; };

struct StaticOrder {
    int nM, nN, nwg, G, c;
    __device__ void init(int M, int N, int G_, int c_) { nM = M / BM; nN = N / BM; nwg = nM * nN; G = G_; c = c_; }
    __device__ __forceinline__ bool next(int i, Unit& u) const {
        const long L = (long)i * G + c; if (L >= nwg) return false;
        int wgid = (int)L; { const int q = nwg / NXCD, r = nwg % NXCD, xcd = wgid % NXCD, off = wgid / NXCD; wgid = (xcd < r ? xcd * (q + 1) : r * (q + 1) + (xcd - r) * q) + off; }
        const int nig = WGM * nN, gid = wgid / nig, fm = gid * WGM, gsz = (nM - fm) < WGM ? (nM - fm) : WGM;
        u.pm = __builtin_amdgcn_readfirstlane(fm + ((wgid % nig) % gsz)); u.pn = __builtin_amdgcn_readfirstlane((wgid % nig) / gsz); u.e = 0; return true;
    }
};
template <bool WAIT>
struct MoeOrderT {
    int nx, dx, per, j, ntiles; const LAS int* ts; unsigned* flags;
    __device__ __forceinline__ bool next(int i, Unit& u) const {
        const int tlo = (dx * ntiles) / nx, thi = ((dx + 1) * ntiles) / nx, n = 4 * (thi - tlo);
        int jj = j; if (WAIT) { jj = j - (n % per); if (jj < 0) jj += per; }
        const int q = jj + i * per; if (q >= n) return false;
        const int tile = tlo + (q >> 2), pn = q & 3;
        int e = 0;
#pragma unroll
        for (int k = 1; k < 16; ++k) e += (tile >= ts[k]) ? 1 : 0;
        u.pm = __builtin_amdgcn_readfirstlane(tile); u.pn = __builtin_amdgcn_readfirstlane(pn); u.e = __builtin_amdgcn_readfirstlane(e);
        if (WAIT) { unsigned sp = 0u;
            while (xb_ld(flags + u.pm) < 32u) { __builtin_amdgcn_s_sleep(2); if (++sp > (1u << 22)) break; }
            asm volatile("" ::: "memory"); }
        return true;
    }
};
typedef MoeOrderT<false> MoeOrder;
typedef MoeOrderT<true> MoeOrderWait;

struct EpiBf16 {
    static constexpr bool PERM = true, HP = false, SIGNAL = false;
    bf16_t* O; int ldc; int s_lo, s_hi; float scale; float base;
    __device__ __forceinline__ void operator()(const f32x4 (&acc)[2][2][4][2], const Unit& u, int wr, int wc, int fr, int fq) const {
        const int row0 = u.pm * BM + wr * 64 + fr; const int col0 = u.pn * BM + wc * 32 + 8 * fq;
        const float sc = ((u.pn >= s_lo && u.pn < s_hi) ? scale : 1.0f) * base;
#pragma unroll
        for (int ai = 0; ai < 2; ++ai)
#pragma unroll
            for (int m = 0; m < 4; ++m) { bf16_t* rowp = O + (size_t)(row0 + ai * HALF + m * 16) * ldc + col0;
#pragma unroll
                for (int bj = 0; bj < 2; ++bj) { const f32x4 v0 = acc[ai][bj][m][0] * sc, v1 = acc[ai][bj][m][1] * sc;
                    u32x4 w; w.x = cvtpk(v0[0], v0[1]); w.y = cvtpk(v0[2], v0[3]); w.z = cvtpk(v1[0], v1[1]); w.w = cvtpk(v1[2], v1[3]);
                    *(u32x4*)(rowp + bj * HALF) = w; } }
    }
};
struct EpiSwiGLU {
    static constexpr bool PERM = true;
    bf16_t* O;
    __device__ __forceinline__ void operator()(const f32x4 (&acc)[2][2][4][2], const Unit& u, int wr, int wc, int fr, int fq) const {
        const int row0 = u.pm * BM + wr * 64 + fr; const int col0 = u.pn * 128 + wc * 32 + 8 * fq;
#pragma unroll
        for (int ai = 0; ai < 2; ++ai)
#pragma unroll
            for (int m = 0; m < 4; ++m) { bf16_t* rowp = O + (size_t)(row0 + ai * HALF + m * 16) * DEXP + col0;
                float a[8];
#pragma unroll
                for (int n = 0; n < 2; ++n)
#pragma unroll
                    for (int j = 0; j < 4; ++j) { const float g = acc[ai][0][m][n][j], up = acc[ai][1][m][n][j]; a[n * 4 + j] = g * up / (1.0f + __expf(-g)); }
                u32x4 w; w.x = cvtpk(a[0], a[1]); w.y = cvtpk(a[2], a[3]); w.z = cvtpk(a[4], a[5]); w.w = cvtpk(a[6], a[7]);
                *(u32x4*)rowp = w; }
    }
};
struct EpiResid {
    static constexpr bool PERM = false;
    const float* base; float* out; const float* gate;
    __device__ __forceinline__ void operator()(const f32x4 (&acc)[2][2][4][2], const Unit& u, int wr, int wc, int fr, int fq) const {
        const int row0 = u.pm * BM + wr * 64 + fr, col0 = u.pn * BM + wc * 32 + 4 * fq;
        const int b = (u.pm * BM) / SEQ;
        f32x4 gv[2][2];
#pragma unroll
        for (int bj = 0; bj < 2; ++bj)
#pragma unroll
            for (int n = 0; n < 2; ++n) gv[bj][n] = *(const f32x4*)(gate + (size_t)b * 6144 + col0 + bj * HALF + n * 16);
#pragma unroll
        for (int ai = 0; ai < 2; ++ai)
#pragma unroll
            for (int m = 0; m < 4; ++m) { const size_t off = (size_t)(row0 + ai * HALF + m * 16) * DM + col0;
#pragma unroll
                for (int bj = 0; bj < 2; ++bj)
#pragma unroll
                    for (int n = 0; n < 2; ++n) { const f32x4 bs = *(const f32x4*)(base + off + bj * HALF + n * 16);
                        *(f32x4*)(out + off + bj * HALF + n * 16) = bs + gv[bj][n] * acc[ai][bj][m][n]; }
                asm volatile("" ::: "memory"); }
    }
};

struct EpiProjI8 {
    static constexpr bool PERM = true, HP = false;
    bf16_t* O; const float* ra; const float* cw; float kscale;
    __device__ __forceinline__ void operator()(const f32x4 (&acc)[2][2][4][2], const Unit& u, int wr, int wc, int fr, int fq) const {
        const int row0 = u.pm * BM + wr * 64 + fr; const int col0 = u.pn * BM + wc * 32 + 8 * fq;
        const float ks = (u.pn >= 2 && u.pn < 4) ? kscale : 1.0f;
        f32x4 c0[2], c1[2];
#pragma unroll
        for (int bj = 0; bj < 2; ++bj) { c0[bj] = *(const f32x4*)(cw + col0 + bj * HALF) * ks; c1[bj] = *(const f32x4*)(cw + col0 + bj * HALF + 4) * ks; }
#pragma unroll
        for (int ai = 0; ai < 2; ++ai)
#pragma unroll
            for (int m = 0; m < 4; ++m) { const int row = row0 + ai * HALF + m * 16; const float rs = ra[row]; bf16_t* rowp = O + (size_t)row * 3072 + col0;
#pragma unroll
                for (int bj = 0; bj < 2; ++bj) { const f32x4 v0 = i2f4(acc[ai][bj][m][0]) * c0[bj] * rs, v1 = i2f4(acc[ai][bj][m][1]) * c1[bj] * rs;
                    u32x4 w; w.x = cvtpk(v0[0], v0[1]); w.y = cvtpk(v0[2], v0[3]); w.z = cvtpk(v1[0], v1[1]); w.w = cvtpk(v1[2], v1[3]);
                    *(u32x4*)(rowp + bj * HALF) = w; } }
    }
};
struct EpiFp8 {
    static constexpr bool PERM = true, HP = false, SIGNAL = false;
    unsigned char* O; int ldc; float scale;
    __device__ __forceinline__ void operator()(const f32x4 (&acc)[2][2][4][2], const Unit& u, int wr, int wc, int fr, int fq) const {
        const int row0 = u.pm * BM + wr * 64 + fr; const int col0 = u.pn * BM + wc * 32 + 8 * fq;
#pragma unroll
        for (int ai = 0; ai < 2; ++ai)
#pragma unroll
            for (int m = 0; m < 4; ++m) { unsigned char* rowp = O + (size_t)(row0 + ai * HALF + m * 16) * ldc + col0;
#pragma unroll
                for (int bj = 0; bj < 2; ++bj) { const f32x4 v0 = acc[ai][bj][m][0] * scale, v1 = acc[ai][bj][m][1] * scale;
                    u32x2 w; w.x = cvt4_fp8(v0[0], v0[1], v0[2], v0[3]); w.y = cvt4_fp8(v1[0], v1[1], v1[2], v1[3]);
                    *(u32x2*)(rowp + bj * HALF) = w; } }
    }
};
struct EpiQKV {
    static constexpr bool PERM = true, HP = true, SIGNAL = false;
    bf16_t* O; const float* qn; const float* kn; const float* cs; float descale;
    __device__ __forceinline__ void operator()(const f32x4 (&acc)[2][2][4][2], const Unit& u, int wr, int wc, int fr, int fq) const {
        const int row0 = u.pm * BM + wr * 64 + fr; const int col0 = u.pn * BM + wc * 64 + 8 * fq;
        const bool isqk = u.pn < 8; const bool odd = (fq & 1) != 0;
        float w[2][2][4];
        if (isqk) { const float* nw = (u.pn < 4) ? qn : kn;
#pragma unroll
            for (int bj = 0; bj < 2; ++bj)
#pragma unroll
                for (int n = 0; n < 2; ++n) { const f32x4 t = *(const f32x4*)(nw + 32 * bj + 8 * fq + 4 * n); w[bj][n][0] = t[0]; w[bj][n][1] = t[1]; w[bj][n][2] = t[2]; w[bj][n][3] = t[3]; } }
        const float qs = (u.pn < 4) ? 0.125f * 1.4426950408889634f : 1.0f;
#pragma unroll
        for (int ai = 0; ai < 2; ++ai)
#pragma unroll
            for (int m = 0; m < 4; ++m) { const int row = row0 + ai * HALF + m * 16; bf16_t* rowp = O + (size_t)row * 3072 + col0;
                float v[2][2][4];
#pragma unroll
                for (int bj = 0; bj < 2; ++bj)
#pragma unroll
                    for (int n = 0; n < 2; ++n)
#pragma unroll
                        for (int j = 0; j < 4; ++j) v[bj][n][j] = acc[ai][bj][m][n][j] * descale;
                if (isqk) {
                    float ss = 0.f;
#pragma unroll
                    for (int bj = 0; bj < 2; ++bj)
#pragma unroll
                        for (int n = 0; n < 2; ++n)
#pragma unroll
                            for (int j = 0; j < 4; ++j) ss += v[bj][n][j] * v[bj][n][j];
                    ss += sx16p(ss, odd);
                    { auto rr = __builtin_amdgcn_permlane32_swap(__float_as_uint(ss), __float_as_uint(ss), false, false); ss = __uint_as_float(rr[0]) + __uint_as_float(rr[1]); }
                    const float rn = 1.0f / sqrtf(ss * (1.0f / 64.0f) + EPS);
#pragma unroll
                    for (int bj = 0; bj < 2; ++bj)
#pragma unroll
                        for (int n = 0; n < 2; ++n)
#pragma unroll
                            for (int j = 0; j < 4; ++j) v[bj][n][j] = v[bj][n][j] * rn * w[bj][n][j];
                    const f32x4 c0 = *(const f32x4*)(cs + (size_t)row * 16), c1 = *(const f32x4*)(cs + (size_t)row * 16 + 4), s0 = *(const f32x4*)(cs + (size_t)row * 16 + 8), s1 = *(const f32x4*)(cs + (size_t)row * 16 + 12);
#pragma unroll
                    for (int n = 0; n < 2; ++n)
#pragma unroll
                        for (int j = 0; j < 4; ++j) { const float x = v[0][n][j]; const float pr = sx16p(x, odd); const float c = n ? c1[j] : c0[j], sn = n ? s1[j] : s0[j];
                            const float r0 = x * c - pr * sn, r1 = x * c + pr * sn; v[0][n][j] = (fq == 0) ? r0 : (fq == 1) ? r1 : x; }
#pragma unroll
                    for (int bj = 0; bj < 2; ++bj)
#pragma unroll
                        for (int n = 0; n < 2; ++n)
#pragma unroll
                            for (int j = 0; j < 4; ++j) v[bj][n][j] *= qs;
                }
#pragma unroll
                for (int bj = 0; bj < 2; ++bj) { u32x4 wv; wv.x = cvtpk(v[bj][0][0], v[bj][0][1]); wv.y = cvtpk(v[bj][0][2], v[bj][0][3]); wv.z = cvtpk(v[bj][1][0], v[bj][1][1]); wv.w = cvtpk(v[bj][1][2], v[bj][1][3]);
                    *(u32x4*)(rowp + 32 * bj) = wv; } }
    }
};
template <bool BASE_F32, bool I8 = false, bool STATIC_A = false> struct EpiResidB {
    static constexpr bool PERM = true, HP = false, SIGNAL = false;
    const void* base; bf16_t* out; const float* gate; float descale; const float* sc;
    __device__ __forceinline__ void operator()(const f32x4 (&acc)[2][2][4][2], const Unit& u, int wr, int wc, int fr, int fq) const {
        const int row0 = u.pm * BM + wr * 64 + fr, col0 = u.pn * BM + wc * 32 + 8 * fq;
        const int b = (u.pm * BM) / SEQ;
        const float* ra = sc + (SC_RS_A - WS_SCALES) / 4; const float* cw = sc + (SC_CW - WS_SCALES) / 4 + (STATIC_A ? CW_BOUT : CW_AOUT);
        f32x4 gv[2][2];
#pragma unroll
        for (int bj = 0; bj < 2; ++bj)
#pragma unroll
            for (int n = 0; n < 2; ++n) { gv[bj][n] = *(const f32x4*)(gate + (size_t)b * 6144 + col0 + bj * HALF + n * 4); if (!I8) gv[bj][n] = gv[bj][n] * descale; if (I8) gv[bj][n] = gv[bj][n] * *(const f32x4*)(cw + col0 + bj * HALF + n * 4); }
#pragma unroll
        for (int ai = 0; ai < 2; ++ai)
#pragma unroll
            for (int m = 0; m < 4; ++m) { const size_t off = (size_t)(row0 + ai * HALF + m * 16) * DM + col0; const float rs = !I8 ? 1.0f : STATIC_A ? descale : ra[row0 + ai * HALF + m * 16];
#pragma unroll
                for (int bj = 0; bj < 2; ++bj) { f32x4 b0, b1;
                    if (BASE_F32) { b0 = *(const f32x4*)((const float*)base + off + bj * HALF); b1 = *(const f32x4*)((const float*)base + off + bj * HALF + 4); }
                    else { const u32x4 r = *(const u32x4*)((const bf16_t*)base + off + bj * HALF); b0 = (f32x4){bflo(r.x), bfhi(r.x), bflo(r.y), bfhi(r.y)}; b1 = (f32x4){bflo(r.z), bfhi(r.z), bflo(r.w), bfhi(r.w)}; }
                    const f32x4 a0 = I8 ? i2f4(acc[ai][bj][m][0]) * rs : acc[ai][bj][m][0], a1 = I8 ? i2f4(acc[ai][bj][m][1]) * rs : acc[ai][bj][m][1];
                    const f32x4 v0 = b0 + gv[bj][0] * a0, v1 = b1 + gv[bj][1] * a1;
                    u32x4 w; w.x = cvtpk(v0[0], v0[1]); w.y = cvtpk(v0[2], v0[3]); w.z = cvtpk(v1[0], v1[1]); w.w = cvtpk(v1[2], v1[3]);
                    *(u32x4*)(out + off + bj * HALF) = w; }
                asm volatile("" ::: "memory"); }
    }
};
template <class Epi, class Sched, bool GATHER, bool I8 = false>
__device__ __forceinline__ void gemm_phase(LAS unsigned char* lds, int wv, const bf16_t* A, const bf16_t* Bt, size_t bstride, int K, const Sched& S, const Epi& E, const int* aidx) {
    int tid = wv * 64 + lane_id(); asm volatile("" : "+v"(tid));
    const int wid = wv, lane = tid & 63, wr = wid >> 2, wc = wid & 3, fr = lane & 15, fq = lane >> 4;
    const int nt = K / BK;
    int RA[2], CA[2]; unsigned voffB[2];
#pragma unroll
    for (int i = 0; i < 2; ++i) { int R, C; stage_rc(tid * 16 + i * 8192, R, C); const int Rb = Epi::PERM ? ((R & ~31) + perm32(R & 31)) : R;
        RA[i] = R; CA[i] = C; voffB[i] = (unsigned)(Rb * K + C) * 2u; }
    const size_t kstep = (size_t)(BK * 2);
    const size_t hstep = (size_t)HALF * K * 2;
    const size_t tstep = 2 * hstep;
    const unsigned ldsw = (unsigned)wid * 1024u;
    const int aoff = lds_byte(wr * 64 + fr, fq * 8), boff = lds_byte(wc * 32 + fr, fq * 8);
#define PG8_SA(b, h) (((b) * 2 + (h)) * HTB)
#define PG8_SB(b, h) ((4 + (b) * 2 + (h)) * HTB)
#define PG8_STAGE(bufoff, gbase, voff) do { _Pragma("unroll") for (int _i = 0; _i < 2; ++_i) \
        __builtin_amdgcn_global_load_lds((const unsigned*)((const char*)(gbase) + (voff)[_i]), (LAS unsigned*)(lds + (bufoff) + ldsw + _i * 8192), 16, 0, 0); } while (0)
#define PG8_LDA(dst, b, h) do { _Pragma("unroll") for (int m = 0; m < 4; ++m) _Pragma("unroll") for (int k = 0; k < 2; ++k) dst[m][k] = *(const LAS bf16x8*)(lds + PG8_SA(b, h) + aoff + m * 2048 + k * 1024); } while (0)
#define PG8_LDB(dst, b, h) do { _Pragma("unroll") for (int n = 0; n < 2; ++n) _Pragma("unroll") for (int k = 0; k < 2; ++k) dst[n][k] = *(const LAS bf16x8*)(lds + PG8_SB(b, h) + boff + n * 2048 + k * 1024); } while (0)
#define PG8_MMA(ai, bj, At, Bt_) do { __builtin_amdgcn_s_setprio(1); _Pragma("unroll") for (int m = 0; m < 4; ++m) _Pragma("unroll") for (int n = 0; n < 2; ++n) _Pragma("unroll") for (int k = 0; k < 2; ++k) { \
        if constexpr (I8) acc[ai][bj][m][n] = __builtin_bit_cast(f32x4, __builtin_amdgcn_mfma_i32_16x16x64_i8(__builtin_bit_cast(i32x4, Bt_[n][k]), __builtin_bit_cast(i32x4, At[m][k]), __builtin_bit_cast(i32x4, acc[ai][bj][m][n]), 0, 0, 0)); \
        else acc[ai][bj][m][n] = __builtin_amdgcn_mfma_f32_16x16x32_bf16(Bt_[n][k], At[m][k], acc[ai][bj][m][n], 0, 0, 0); } __builtin_amdgcn_s_setprio(0); } while (0)
#define PG8_WAIT_V(n) asm volatile("s_waitcnt vmcnt(" #n ")" ::: "memory")
#define PG8_WAIT_L(n) asm volatile("s_waitcnt lgkmcnt(" #n ")" ::: "memory")
#define PG8_BAR __builtin_amdgcn_s_barrier()
#define PG8_SCHED __builtin_amdgcn_sched_barrier(0)
#define PG8_AOFF(dst, U) do { _Pragma("unroll") for (int _h = 0; _h < 2; ++_h) _Pragma("unroll") for (int _i = 0; _i < 2; ++_i) { \
        const int _row = (U).pm * BM + _h * HALF + RA[_i]; const int _src = GATHER ? aidx[_row] : _row; dst[_h][_i] = (unsigned)(_src * K + CA[_i]) * 2u; } } while (0)
#define PG8_STAGE_A(bufoff, kb, offs, h) do { _Pragma("unroll") for (int _i = 0; _i < 2; ++_i) \
        __builtin_amdgcn_global_load_lds((const unsigned*)((const char*)A + (kb) + (offs)[h][_i]), (LAS unsigned*)(lds + (bufoff) + ldsw + _i * 8192), 16, 0, 0); } while (0)
    Unit cur, nxt; int ui = 0;
    if (!S.next(0, cur)) return;
    f32x4 acc[2][2][4][2];
#pragma unroll
    for (int a = 0; a < 2; ++a)
#pragma unroll
        for (int b = 0; b < 2; ++b)
#pragma unroll
            for (int m = 0; m < 4; ++m)
#pragma unroll
                for (int n = 0; n < 2; ++n) acc[a][b][m][n] = (f32x4){0.f, 0.f, 0.f, 0.f};
    bf16x8 At[4][2], B0[2][2], B1[2][2];
    unsigned ac[2][2], an[2][2];
    PG8_AOFF(ac, cur);
    const char* cB = (const char*)Bt + ((size_t)cur.e * bstride) * 2 + (size_t)cur.pn * tstep;
    PG8_STAGE(PG8_SB(0, 0), cB, voffB); PG8_STAGE(PG8_SB(0, 1), cB + hstep, voffB); PG8_STAGE_A(PG8_SA(0, 0), 0, ac, 0); PG8_STAGE_A(PG8_SA(0, 1), 0, ac, 1);
    if (wr == 1) PG8_BAR;
    PG8_WAIT_V(2); PG8_BAR;
    PG8_STAGE(PG8_SB(1, 0), cB + kstep, voffB); PG8_STAGE_A(PG8_SA(1, 0), kstep, ac, 0); PG8_STAGE(PG8_SB(1, 1), cB + hstep + kstep, voffB);
    PG8_WAIT_V(6); PG8_BAR;
    for (;;) {
        const bool has_next = S.next(ui + 1, nxt);
        if (has_next) { PG8_AOFF(an, nxt); } else {
#pragma unroll
            for (int h = 0; h < 2; ++h)
#pragma unroll
                for (int i = 0; i < 2; ++i) an[h][i] = ac[h][i]; }
        const char* nB = has_next ? (const char*)Bt + ((size_t)nxt.e * bstride) * 2 + (size_t)nxt.pn * tstep : cB;
#pragma unroll 1
        for (int t = 0; t < nt; t += 2) {
            const bool last = (t == nt - 2);
            const size_t k1 = (size_t)(t + 1) * kstep;
            const size_t k2 = last ? 0 : (size_t)(t + 2) * kstep;
            const size_t k3 = k2 + kstep;
            const char* b2 = last ? nB : cB + (size_t)(t + 2) * kstep; const char* b3 = b2 + kstep;
            unsigned a2[2][2];
#pragma unroll
            for (int h = 0; h < 2; ++h)
#pragma unroll
                for (int i = 0; i < 2; ++i) a2[h][i] = last ? an[h][i] : ac[h][i];
            PG8_LDB(B0, 0, 0); PG8_LDB(B1, 0, 1); PG8_SCHED; PG8_LDA(At, 0, 0); PG8_STAGE_A(PG8_SA(1, 1), k1, ac, 1);
            PG8_WAIT_V(8); PG8_WAIT_L(0); PG8_BAR; PG8_MMA(0, 0, At, B0); PG8_MMA(0, 1, At, B1); PG8_BAR; PG8_SCHED;
            PG8_LDA(At, 0, 1); PG8_STAGE(PG8_SB(0, 0), b2, voffB); PG8_STAGE(PG8_SB(0, 1), b2 + hstep, voffB); PG8_STAGE_A(PG8_SA(0, 0), k2, a2, 0);
            PG8_WAIT_V(8); PG8_WAIT_L(0); PG8_BAR; PG8_MMA(1, 0, At, B0); PG8_MMA(1, 1, At, B1); PG8_BAR; PG8_SCHED;
            PG8_LDB(B0, 1, 0); PG8_LDB(B1, 1, 1); PG8_SCHED; PG8_LDA(At, 1, 0); PG8_STAGE_A(PG8_SA(0, 1), k2, a2, 1);
            PG8_WAIT_V(8); PG8_WAIT_L(0); PG8_BAR; PG8_MMA(0, 0, At, B0); PG8_MMA(0, 1, At, B1); PG8_BAR; PG8_SCHED;
            PG8_LDA(At, 1, 1); PG8_STAGE(PG8_SB(1, 0), b3, voffB); PG8_STAGE(PG8_SB(1, 1), b3 + hstep, voffB); PG8_STAGE_A(PG8_SA(1, 0), k3, a2, 0);
            PG8_WAIT_V(8); PG8_WAIT_L(0); PG8_BAR; PG8_MMA(1, 0, At, B0); PG8_MMA(1, 1, At, B1); PG8_BAR; PG8_SCHED;
        }
        if (wr == 0) PG8_BAR;
        E(acc, cur, wr, wc, fr, fq);
        if (!has_next) break;
#pragma unroll
        for (int a = 0; a < 2; ++a)
#pragma unroll
            for (int b = 0; b < 2; ++b)
#pragma unroll
                for (int m = 0; m < 4; ++m)
#pragma unroll
                    for (int n = 0; n < 2; ++n) acc[a][b][m][n] = (f32x4){0.f, 0.f, 0.f, 0.f};
        cur = nxt; cB = nB; ++ui;
#pragma unroll
        for (int h = 0; h < 2; ++h)
#pragma unroll
            for (int i = 0; i < 2; ++i) ac[h][i] = an[h][i];
        if (wr == 1) PG8_BAR;
    }
    PG8_WAIT_V(0);
    PG8_BAR;
#undef PG8_SA
#undef PG8_SB
#undef PG8_STAGE
#undef PG8_LDA
#undef PG8_LDB
#undef PG8_MMA
#undef PG8_WAIT_V
#undef PG8_WAIT_L
#undef PG8_BAR
#undef PG8_SCHED
#undef PG8_AOFF
#undef PG8_STAGE_A
}

__device__ __forceinline__ int x8(int e) { return e ^ ((((e >> 1) ^ (e >> 2)) & 1) << 1); }
struct EpiSwiGLU8 {
    static constexpr bool PERM = true, HP = false, SIGNAL = true;
    unsigned char* O; float descale; unsigned* flags;
    __device__ __forceinline__ void operator()(const f32x4 (&acc)[2][2][4][2], const Unit& u, int wr, int wc, int fr, int fq) const {
        const int row0 = u.pm * BM + wr * 64 + fr; const int col0 = u.pn * 128 + wc * 32 + 8 * fq;
#pragma unroll
        for (int ai = 0; ai < 2; ++ai)
#pragma unroll
            for (int m = 0; m < 4; ++m) { unsigned char* rowp = O + (size_t)(row0 + ai * HALF + m * 16) * DEXP + col0;
                float a[8];
#pragma unroll
                for (int n = 0; n < 2; ++n)
#pragma unroll
                    for (int j = 0; j < 4; ++j) { const float g = acc[ai][0][m][n][j] * descale, up = acc[ai][1][m][n][j] * descale; a[n * 4 + j] = S8_ACT * g * up / (1.0f + __expf(-g)); }
                u32x2 w; w.x = cvt4_fp8(a[0], a[1], a[2], a[3]); w.y = cvt4_fp8(a[4], a[5], a[6], a[7]);
                *(u32x2*)rowp = w; }
    }
};
template <class Epi, class Sched, bool GATHER>
__device__ __forceinline__ void gemm_phase8(LAS unsigned char* lds, int wv, const unsigned char* A, const unsigned char* Bt, size_t bstride, int Kb, const Sched& S, const Epi& E, const int* aidx) {
    int tid = wv * 64 + lane_id(); asm volatile("" : "+v"(tid));
    const int wid = wv, lane = tid & 63, wr = wid >> 2, wc = wid & 3, fr = lane & 15, fq = lane >> 4;
    const int nt = Kb / 128;
    int RA[2], CA[2]; unsigned voffB[2], voffB1[2];
#pragma unroll
    for (int i = 0; i < 2; ++i) { const int b = tid * 16 + i * 8192; const int R = b >> 7, pc = (b >> 4) & 7; const int C = (pc ^ x8((R >> 1) & 7)) * 16;
        const int Rb = Epi::PERM ? ((R & ~31) + perm32(R & 31)) : R;
        RA[i] = R; CA[i] = C;
        if (Epi::HP) { const int g0 = 64 * (R >> 5) + perm32(R & 31); voffB[i] = (unsigned)(g0 * Kb + C); voffB1[i] = (unsigned)((g0 + 32) * Kb + C); }
        else { voffB[i] = (unsigned)(Rb * Kb + C); voffB1[i] = voffB[i] + (unsigned)(HALF * Kb); } }
    const size_t kstep = 128;
    const size_t hstep = (size_t)HALF * Kb;
    const size_t tstep = 2 * hstep;
    const unsigned ldsw = (unsigned)wid * 1024u;
    const int xa = x8((fr >> 1) & 7);
    const int aoff = (wr * 64 + fr) * 128 + (((2 * fq) ^ xa) << 4), boff = (wc * 32 + fr) * 128 + (((2 * fq) ^ xa) << 4);
    const int aoff1 = aoff ^ 16, boff1 = boff ^ 16;
#define PG8_SA(b, h) (((b) * 2 + (h)) * HTB)
#define PG8_SB(b, h) ((4 + (b) * 2 + (h)) * HTB)
#define PG8_STAGE(bufoff, gbase, voff) do { _Pragma("unroll") for (int _i = 0; _i < 2; ++_i) \
        __builtin_amdgcn_global_load_lds((const unsigned*)((const char*)(gbase) + (voff)[_i]), (LAS unsigned*)(lds + (bufoff) + ldsw + _i * 8192), 16, 0, 0); } while (0)
#define PG8_RD32(dst, off, off1) do { const u32x4 _lo = *(const LAS u32x4*)(lds + (off)), _hi = *(const LAS u32x4*)(lds + (off1)); \
        dst = (i32x8){(int)_lo.x, (int)_lo.y, (int)_lo.z, (int)_lo.w, (int)_hi.x, (int)_hi.y, (int)_hi.z, (int)_hi.w}; } while (0)
#define PG8_LDA(dst, b, h) do { _Pragma("unroll") for (int m = 0; m < 4; ++m) PG8_RD32(dst[m], PG8_SA(b, h) + aoff + m * 2048, PG8_SA(b, h) + aoff1 + m * 2048); } while (0)
#define PG8_LDB(dst, b, h) do { _Pragma("unroll") for (int n = 0; n < 2; ++n) PG8_RD32(dst[n], PG8_SB(b, h) + boff + n * 2048, PG8_SB(b, h) + boff1 + n * 2048); } while (0)
#define PG8_MMA(ai, bj, At, Bt_) do { __builtin_amdgcn_s_setprio(1); _Pragma("unroll") for (int m = 0; m < 4; ++m) _Pragma("unroll") for (int n = 0; n < 2; ++n) \
        asm volatile("v_mfma_scale_f32_16x16x128_f8f6f4 %0, %1, %2, %0, %3, %3 op_sel_hi:[0,0,0]" : "+v"(acc[ai][bj][m][n]) : "v"(Bt_[n]), "v"(At[m]), "v"(sc1)); __builtin_amdgcn_s_setprio(0); } while (0)
#define PG8_WAIT_V(n) asm volatile("s_waitcnt vmcnt(" #n ")" ::: "memory")
#define PG8_WAIT_L(n) asm volatile("s_waitcnt lgkmcnt(" #n ")" ::: "memory")
#define PG8_BAR __builtin_amdgcn_s_barrier()
#define PG8_SCHED __builtin_amdgcn_sched_barrier(0)
#define PG8_AOFF(dst, U) do { _Pragma("unroll") for (int _h = 0; _h < 2; ++_h) _Pragma("unroll") for (int _i = 0; _i < 2; ++_i) { \
        const int _row = (U).pm * BM + _h * HALF + RA[_i]; const int _src = GATHER ? aidx[_row] : _row; dst[_h][_i] = (unsigned)(_src * Kb + CA[_i]); } } while (0)
#define PG8_STAGE_A(bufoff, kb, offs, h) do { _Pragma("unroll") for (int _i = 0; _i < 2; ++_i) \
        __builtin_amdgcn_global_load_lds((const unsigned*)((const char*)A + (kb) + (offs)[h][_i]), (LAS unsigned*)(lds + (bufoff) + ldsw + _i * 8192), 16, 0, 0); } while (0)
    Unit cur, nxt; int ui = 0;
    if (!S.next(0, cur)) return;
    f32x4 acc[2][2][4][2];
#pragma unroll
    for (int a = 0; a < 2; ++a)
#pragma unroll
        for (int b = 0; b < 2; ++b)
#pragma unroll
            for (int m = 0; m < 4; ++m)
#pragma unroll
                for (int n = 0; n < 2; ++n) acc[a][b][m][n] = (f32x4){0.f, 0.f, 0.f, 0.f};
    i32x8 At[4], B0[2], B1[2];
    int sc1 = 0x7F7F7F7F; asm volatile("" : "+v"(sc1));
    unsigned ac[2][2], an[2][2];
    PG8_AOFF(ac, cur);
    const char* cB = (const char*)Bt + (size_t)cur.e * bstride + (size_t)cur.pn * tstep;
    PG8_STAGE(PG8_SB(0, 0), cB, voffB); PG8_STAGE(PG8_SB(0, 1), cB, voffB1); PG8_STAGE_A(PG8_SA(0, 0), 0, ac, 0); PG8_STAGE_A(PG8_SA(0, 1), 0, ac, 1);
    if (wr == 1) PG8_BAR;
    PG8_WAIT_V(2); PG8_BAR;
    PG8_STAGE(PG8_SB(1, 0), cB + kstep, voffB); PG8_STAGE_A(PG8_SA(1, 0), kstep, ac, 0); PG8_STAGE(PG8_SB(1, 1), cB + kstep, voffB1);
    PG8_WAIT_V(6); PG8_BAR;
    for (;;) {
        const bool has_next = S.next(ui + 1, nxt);
        if (has_next) { PG8_AOFF(an, nxt); } else {
#pragma unroll
            for (int h = 0; h < 2; ++h)
#pragma unroll
                for (int i = 0; i < 2; ++i) an[h][i] = ac[h][i]; }
        const char* nB = has_next ? (const char*)Bt + (size_t)nxt.e * bstride + (size_t)nxt.pn * tstep : cB;
#pragma unroll 1
        for (int t = 0; t < nt; t += 2) {
            const bool last = (t == nt - 2);
            const size_t k1 = (size_t)(t + 1) * kstep;
            const size_t k2 = last ? 0 : (size_t)(t + 2) * kstep;
            const size_t k3 = k2 + kstep;
            const char* b2 = last ? nB : cB + (size_t)(t + 2) * kstep; const char* b3 = b2 + kstep;
            unsigned a2[2][2];
#pragma unroll
            for (int h = 0; h < 2; ++h)
#pragma unroll
                for (int i = 0; i < 2; ++i) a2[h][i] = last ? an[h][i] : ac[h][i];
            PG8_LDB(B0, 0, 0); PG8_LDB(B1, 0, 1); PG8_SCHED; PG8_LDA(At, 0, 0); PG8_STAGE_A(PG8_SA(1, 1), k1, ac, 1);
            PG8_WAIT_V(8); PG8_WAIT_L(0); PG8_BAR; PG8_MMA(0, 0, At, B0); PG8_MMA(0, 1, At, B1); PG8_BAR; PG8_SCHED;
            PG8_LDA(At, 0, 1); PG8_STAGE(PG8_SB(0, 0), b2, voffB); PG8_STAGE(PG8_SB(0, 1), b2, voffB1); PG8_STAGE_A(PG8_SA(0, 0), k2, a2, 0);
            PG8_WAIT_V(8); PG8_WAIT_L(0); PG8_BAR; PG8_MMA(1, 0, At, B0); PG8_MMA(1, 1, At, B1); PG8_BAR; PG8_SCHED;
            PG8_LDB(B0, 1, 0); PG8_LDB(B1, 1, 1); PG8_SCHED; PG8_LDA(At, 1, 0); PG8_STAGE_A(PG8_SA(0, 1), k2, a2, 1);
            PG8_WAIT_V(8); PG8_WAIT_L(0); PG8_BAR; PG8_MMA(0, 0, At, B0); PG8_MMA(0, 1, At, B1); PG8_BAR; PG8_SCHED;
            PG8_LDA(At, 1, 1); PG8_STAGE(PG8_SB(1, 0), b3, voffB); PG8_STAGE(PG8_SB(1, 1), b3, voffB1); PG8_STAGE_A(PG8_SA(1, 0), k3, a2, 0);
            PG8_WAIT_V(8); PG8_WAIT_L(0); PG8_BAR; PG8_MMA(1, 0, At, B0); PG8_MMA(1, 1, At, B1); PG8_BAR; PG8_SCHED;
        }
        if (wr == 0) PG8_BAR;
        asm volatile("s_nop 15\n\ts_nop 15" ::: "memory");
        E(acc, cur, wr, wc, fr, fq);
        if constexpr (Epi::SIGNAL) { asm volatile("s_waitcnt vmcnt(0)" ::: "memory"); if (lane == 0) (void)xb_add(E.flags + cur.pm, 1u); }
        if (!has_next) break;
#pragma unroll
        for (int a = 0; a < 2; ++a)
#pragma unroll
            for (int b = 0; b < 2; ++b)
#pragma unroll
                for (int m = 0; m < 4; ++m)
#pragma unroll
                    for (int n = 0; n < 2; ++n) acc[a][b][m][n] = (f32x4){0.f, 0.f, 0.f, 0.f};
        cur = nxt; cB = nB; ++ui;
#pragma unroll
        for (int h = 0; h < 2; ++h)
#pragma unroll
            for (int i = 0; i < 2; ++i) ac[h][i] = an[h][i];
        if (wr == 1) PG8_BAR;
    }
    PG8_WAIT_V(0);
    PG8_BAR;
#undef PG8_SA
#undef PG8_SB
#undef PG8_STAGE
#undef PG8_RD32
#undef PG8_LDA
#undef PG8_LDB
#undef PG8_MMA
#undef PG8_WAIT_V
#undef PG8_WAIT_L
#undef PG8_BAR
#undef PG8_SCHED
#undef PG8_AOFF
#undef PG8_STAGE_A
}
}

namespace attn_body {
using bf16 = __hip_bfloat16;
using f32x16 = __attribute__((ext_vector_type(16))) float;
constexpr int D = 64, PQ = 3072, PO = 2048;
constexpr int NW = 8, QBLK = 32, QB = QBLK * NW, KVBLK = 64, NQB = SEQ / QB;
__device__ __forceinline__ int crow(int r, int hi) { return (r & 3) + 8 * (r >> 2) + 4 * hi; }
#define SBAR() __builtin_amdgcn_sched_barrier(0)
__device__ __forceinline__ void cmask(f32x16& p0, f32x16& p1, int jb, int qrel, int hi) {
    const float NEG = -INFINITY; int kb = 64 * jb + 4 * hi;
#pragma unroll
    for (int r = 0; r < 16; ++r) { int kv = kb + (r & 3) + 8 * (r >> 2); if (kv > qrel) p0[r] = NEG; if (kv + 32 > qrel) p1[r] = NEG; }
}
constexpr int NSLOT = 3, SLOTB = 8192;
constexpr int LDS_K = 0, LDS_V = NSLOT * SLOTB, LDS_WS = 2 * NSLOT * SLOTB, LDS_OST = LDS_WS + NW * 64 * 4, ATT_LDS_BYTES = LDS_OST + NW * 4096;
__device__ __forceinline__ void glds16(const void* gsrc, unsigned lds_dst) { unsigned keep;
    asm volatile("s_mov_b32 %0, m0\n\ts_mov_b32 m0, %2\n\ts_nop 0\n\tglobal_load_lds_dwordx4 %1, off\n\ts_mov_b32 m0, %0" : "=&s"(keep) : "v"(gsrc), "s"(lds_dst) : "memory"); }
__device__ __forceinline__ float max3f(float a, float b, float c) { float r; asm("v_max3_f32 %0, %1, %2, %3" : "=v"(r) : "v"(a), "v"(b), "v"(c)); return r; }
__device__ __forceinline__ float max2f(float a, float b) { float r; asm("v_max_f32_e32 %0, %1, %2" : "=v"(r) : "v"(a), "v"(b)); return r; }
__device__ __forceinline__ float fadd_s(float a, float b) { float r; asm("v_add_f32_e32 %0, %1, %2" : "=v"(r) : "v"(a), "v"(b)); return r; }
__device__ __forceinline__ float fsub_s(float a, float b) { float r; asm("v_sub_f32_e32 %0, %1, %2" : "=v"(r) : "v"(a), "v"(b)); return r; }
__device__ __forceinline__ unsigned cvtpk_s(float lo, float hi) { f32x2 v = {lo, hi}; bf16x2_t b = __builtin_convertvector(v, bf16x2_t); return __builtin_bit_cast(unsigned, b); }
#define WAIT_BAR(N) asm volatile("s_waitcnt vmcnt(" #N ") lgkmcnt(0)\n\ts_barrier" ::: "memory")
__device__ __forceinline__ void qkt(f32x16& p0, f32x16& p1, const char* Kslot, const bf16x8* qr, const f32x16& negm, int r32, int hi) {
    const char* kb = Kslot + hi * 1024 + r32 * 16;
#pragma unroll
    for (int d0 = 0; d0 < 4; ++d0) {
        const bf16x8 b0 = *reinterpret_cast<const bf16x8*>(kb + d0 * 2048);
        const bf16x8 b1 = *reinterpret_cast<const bf16x8*>(kb + d0 * 2048 + 512);
        if (d0 == 0) { p0 = __builtin_amdgcn_mfma_f32_32x32x16_bf16(b0, qr[0], negm, 0, 0, 0); p1 = __builtin_amdgcn_mfma_f32_32x32x16_bf16(b1, qr[0], negm, 0, 0, 0); }
        else { p0 = __builtin_amdgcn_mfma_f32_32x32x16_bf16(b0, qr[d0], p0, 0, 0, 0); p1 = __builtin_amdgcn_mfma_f32_32x32x16_bf16(b1, qr[d0], p1, 0, 0, 0); } }
}
typedef __attribute__((address_space(3))) const char* lds_cptr;
typedef short v4i16_t __attribute__((ext_vector_type(4)));
__device__ __forceinline__ void kload8(bf16x8* kf, lds_cptr kp) {
    kf[0] = *(const LAS bf16x8*)(kp);        kf[1] = *(const LAS bf16x8*)(kp + 512);
    kf[2] = *(const LAS bf16x8*)(kp + 2048); kf[3] = *(const LAS bf16x8*)(kp + 2560);
    kf[4] = *(const LAS bf16x8*)(kp + 4096); kf[5] = *(const LAS bf16x8*)(kp + 4608);
    kf[6] = *(const LAS bf16x8*)(kp + 6144); kf[7] = *(const LAS bf16x8*)(kp + 6656);
}
__device__ __forceinline__ void kload2(bf16x8* kf, lds_cptr kp, int j) { kf[2 * j] = *(const LAS bf16x8*)(kp + j * 2048); kf[2 * j + 1] = *(const LAS bf16x8*)(kp + j * 2048 + 512); }
__device__ __forceinline__ s16x4 vtr(lds_cptr p) { return __builtin_bit_cast(s16x4, __builtin_amdgcn_ds_read_tr16_b64_v4i16((LAS v4i16_t*)p)); }
__device__ __forceinline__ float rowmax(const f32x16& p0, const f32x16& p1) {
    float a = max3f(p0[0], p0[1], p1[0]), b = max3f(p0[2], p0[3], p1[1]); a = max3f(a, p1[2], p1[3]);
#pragma unroll
    for (int r = 4; r < 16; r += 4) { a = max3f(a, p0[r], p0[r + 1]); b = max3f(b, p0[r + 2], p0[r + 3]); a = max3f(a, p1[r], p1[r + 1]); b = max3f(b, p1[r + 2], p1[r + 3]); }
    const float m = max2f(a, b);
    auto rr = __builtin_amdgcn_permlane32_swap(__float_as_uint(m), __float_as_uint(m), false, false);
    return max2f(__uint_as_float(rr[0]), __uint_as_float(rr[1]));
}
__device__ __forceinline__ void pv(f32x16* o, int vb, bf16x8 pa0, bf16x8 pa1, bf16x8 pa2, bf16x8 pa3) {
#pragma unroll
    for (int d0 = 0; d0 < 2; ++d0) { s16x4 lo[4], hi[4];
#pragma unroll
        for (int ks = 0; ks < 4; ++ks) {
            asm volatile("ds_read_b64_tr_b16 %0,%1 offset:%c2" : "=&v"(lo[ks]) : "v"(vb), "i"(d0 * 4096 + ks * 1024) : "memory");
            asm volatile("ds_read_b64_tr_b16 %0,%1 offset:%c2" : "=&v"(hi[ks]) : "v"(vb), "i"(d0 * 4096 + ks * 1024 + 512) : "memory"); }
        asm volatile("s_waitcnt lgkmcnt(0)" ::: "memory"); SBAR();
#define PK(k) (bf16x8){lo[k][0], lo[k][1], lo[k][2], lo[k][3], hi[k][0], hi[k][1], hi[k][2], hi[k][3]}
        o[d0] = __builtin_amdgcn_mfma_f32_32x32x16_bf16(pa0, PK(0), o[d0], 0, 0, 0);
        o[d0] = __builtin_amdgcn_mfma_f32_32x32x16_bf16(pa1, PK(1), o[d0], 0, 0, 0);
        o[d0] = __builtin_amdgcn_mfma_f32_32x32x16_bf16(pa2, PK(2), o[d0], 0, 0, 0);
        o[d0] = __builtin_amdgcn_mfma_f32_32x32x16_bf16(pa3, PK(3), o[d0], 0, 0, 0);
#undef PK
    }
}
#define ATTN_STORE16(p, v) (*(u32x4*)(p) = (v))
template <int THRL> __device__ __forceinline__ void attn_unit(int wv, int pair, int qb, const bf16* Pb, bf16* Obuf, char* shm) {
    const int b = pair >> 5, v5 = pair & 31, hc = v5 >> 1; const int qc = hc * 64, kc = 1024 + hc * 64, vc = 2048 + (v5 >> 2) * 128 + (v5 & 1) * 64, oc = v5 * 64;
    int tid = wv * 64 + lane_id(); asm volatile("" : "+v"(tid));
    const int lane = tid & 63, r32 = lane & 31, hi = lane >> 5; const int wid = wv;
    const long rowbase = (long)b * SEQ; const int q0 = qb * QB;
    const bf16* Qw = Pb + (rowbase + q0 + wid * QBLK) * PQ + qc;
    const bf16* Kh = Pb + rowbase * PQ + kc, *Vh = Pb + rowbase * PQ + vc;
    const unsigned lds0 = (unsigned)(uintptr_t)shm;
    float* wsf = (float*)(shm + LDS_WS) + wid * 64;
    const bf16* ksrc = Kh + (long)lane * PQ + wid * 8;
    const bf16* vsrc = Vh + (long)(16 * (wid & 3) + (lane >> 2)) * PQ + (wid >> 2) * 32 + (lane & 3) * 8;
    const unsigned kdst = lds0 + LDS_K + wid * 1024, vdst = lds0 + LDS_V + wid * 1024;
#define DMA_K(t, slot) glds16(ksrc + (long)(t) * KVBLK * PQ, (unsigned)__builtin_amdgcn_readfirstlane(kdst + (slot)))
#define DMA_V(t, slot) glds16(vsrc + (long)(t) * KVBLK * PQ, (unsigned)__builtin_amdgcn_readfirstlane(vdst + (slot)))
    const int vb0 = (int)(lds0 + LDS_V) + ((lane >> 4) & 1) * 32 + (lane & 3) * 8 + (4 * hi + ((lane & 15) >> 2)) * 64;
    const char* Kbase = shm + LDS_K; bf16x8 kf[8];
    const lds_cptr shm3 = (lds_cptr)shm; const lds_cptr kp0 = shm3 + LDS_K + hi * 1024 + r32 * 16; const lds_cptr vp0 = shm3 + LDS_V + ((lane >> 4) & 1) * 32 + (lane & 3) * 8 + (4 * hi + ((lane & 15) >> 2)) * 64;
    const int NT = (q0 + QB) / KVBLK;
    DMA_K(0, 0); DMA_V(0, 0); DMA_K(1, SLOTB);
    bf16x8 qr[4];
#pragma unroll
    for (int d0 = 0; d0 < 4; ++d0) qr[d0] = *reinterpret_cast<const bf16x8*>(&Qw[(long)r32 * PQ + d0 * 16 + hi * 8]);
    float mhat = 0.f, l_reg = 0.f; f32x16 o[2]; o[0] = f32x16{}; o[1] = f32x16{}; f32x16 negm = f32x16{}; asm volatile("" : "+v"(negm));
    const int qrel = wid * QBLK + r32;
#define CMASK(P0, P1, t) do { int jb_ = (t) - (NT - 4); if (jb_ >= 0) cmask(P0, P1, jb_, qrel, hi); } while (0)
    bool resc = false;
#define START(P0, P1) do { const float rm = rowmax(P0, P1); resc = false; \
    { const float dl = rm; mhat = fadd_s(mhat, dl); \
      _Pragma("unroll") for (int r = 0; r < 16; ++r) { P0[r] = fsub_s(P0[r], dl); P1[r] = fsub_s(P1[r], dl); } \
      _Pragma("unroll") for (int r = 0; r < 16; ++r) negm[r] = -mhat; asm volatile("" : "+v"(negm)); } \
    _Pragma("unroll") for (int r = 0; r < 16; ++r) P0[r] = __builtin_amdgcn_exp2f(P0[r]); } while (0)
#define RESC() do { if (resc) { asm volatile("s_waitcnt lgkmcnt(0)" ::: "memory"); \
      _Pragma("unroll") for (int d_ = 0; d_ < 2; ++d_) _Pragma("unroll") for (int r = 0; r < 16; ++r) o[d_][r] *= wsf[crow(r, hi)]; } } while (0)
    f32x16 pA0, pA1, pB0, pB1;
    int sl_prev = 0, sl_cur = 0, sl_next = SLOTB;
#define ROT() do { sl_prev = sl_cur; sl_cur = sl_next; sl_next = (sl_next == (NSLOT - 1) * SLOTB) ? 0 : sl_next + SLOTB; } while (0)
    DMA_K(2, 2 * SLOTB);
    WAIT_BAR(3);
    qkt(pA0, pA1, Kbase, qr, negm, r32, hi); asm volatile("s_nop 15\n\ts_nop 7" : "+v"(pA0), "+v"(pA1)); CMASK(pA0, pA1, 0);
    START(pA0, pA1);
    _Pragma("unroll") for (int r = 0; r < 16; ++r) pA1[r] = __builtin_amdgcn_exp2f(pA1[r]);
    WAIT_BAR(0);
    DMA_K(3, 0); DMA_V(1, SLOTB);
    ROT();
    kload8(kf, kp0 + sl_cur);
    WAIT_BAR(2);
    s16x4 vlo[8], vhi[8]; u32x4 pw0, pw1, pw2, pw3;
#define PKW(P, B) cvtpk_s(P[B], P[B + 1])
#define PAF(k) __builtin_bit_cast(bf16x8, pw##k)
#define VFR(i) (bf16x8){vlo[i][0], vlo[i][1], vlo[i][2], vlo[i][3], vhi[i][0], vhi[i][1], vhi[i][2], vhi[i][3]}
#define PIN(x) asm volatile("" : "+v"(x))
#define MX3(a, b, c) __builtin_fmaxf(__builtin_fmaxf((a), (b)), (c))
#define GAPA(MF, A0, A1, A2, A3, W0, W1, PW) do { MF; sacc += A0; sacc += A1; sacc += A2; sacc += A3; PIN(sacc); W0; W1; PIN(PW); SBAR(); } while (0)
#define EX(v) __builtin_amdgcn_exp2f(v)
#define GAPB(MF, X, B) do { MF; X[B] = EX(X[B]); X[B + 1] = EX(X[B + 1]); X[B + 2] = EX(X[B + 2]); X[B + 3] = EX(X[B + 3]); PIN(X); SBAR(); } while (0)
#define VRD(i) do { vlo[i] = vtr(vp_ + (((i) >> 2) * 4096 + ((i) & 3) * 1024)); vhi[i] = vtr(vp_ + (((i) >> 2) * 4096 + ((i) & 3) * 1024 + 512)); } while (0)
#define KRD(G, j) do { if (G) { kload2(kf, kp0 + sl_next, j); SBAR(); } } while (0)
#define STEP(C0, C1, P0, P1, t, GK, GV, GL) do { SBAR(); \
    const lds_cptr vp_ = vp0 + sl_prev; \
    VRD(0); SBAR(); float sacc = (P0[0] + P0[1]); \
    GAPA(C0 = __builtin_amdgcn_mfma_f32_32x32x16_bf16(kf[0], qr[0], negm, 0, 0, 0), P0[2], P0[3], P0[4], P0[5],     pw0[0] = PKW(P0, 0), pw0[1] = PKW(P0, 2), pw0); \
    VRD(4); SBAR(); GAPA(C1 = __builtin_amdgcn_mfma_f32_32x32x16_bf16(kf[1], qr[0], negm, 0, 0, 0), P0[6], P0[7], P0[8], P0[9],     pw0[2] = PKW(P0, 4), pw0[3] = PKW(P0, 6), pw0); \
    VRD(1); SBAR(); GAPA(C0 = __builtin_amdgcn_mfma_f32_32x32x16_bf16(kf[2], qr[1], C0, 0, 0, 0),   P0[10], P0[11], P0[12], P0[13], pw1[0] = PKW(P0, 8), pw1[1] = PKW(P0, 10), pw1); \
    VRD(5); SBAR(); GAPA(C1 = __builtin_amdgcn_mfma_f32_32x32x16_bf16(kf[3], qr[1], C1, 0, 0, 0),   P0[14], P0[15], P1[0], P1[1],   pw1[2] = PKW(P0, 12), pw1[3] = PKW(P0, 14), pw1); \
    VRD(2); SBAR(); GAPA(C0 = __builtin_amdgcn_mfma_f32_32x32x16_bf16(kf[4], qr[2], C0, 0, 0, 0),   P1[2], P1[3], P1[4], P1[5],     pw2[0] = PKW(P1, 0), pw2[1] = PKW(P1, 2), pw2); \
    VRD(6); SBAR(); GAPA(C1 = __builtin_amdgcn_mfma_f32_32x32x16_bf16(kf[5], qr[2], C1, 0, 0, 0),   P1[6], P1[7], P1[8], P1[9],     pw2[2] = PKW(P1, 4), pw2[3] = PKW(P1, 6), pw2); \
    VRD(3); SBAR(); GAPA(C0 = __builtin_amdgcn_mfma_f32_32x32x16_bf16(kf[6], qr[3], C0, 0, 0, 0),   P1[10], P1[11], P1[12], P1[13], pw3[0] = PKW(P1, 8), pw3[1] = PKW(P1, 10), pw3); \
    VRD(7); SBAR(); GAPA(C1 = __builtin_amdgcn_mfma_f32_32x32x16_bf16(kf[7], qr[3], C1, 0, 0, 0),   P1[14], P1[15], 0.f, 0.f,       pw3[2] = PKW(P1, 12), pw3[3] = PKW(P1, 14), pw3); \
    l_reg += sacc; \
    if (GK) { DMA_K((t) + 3, sl_cur); } if (GV) { DMA_V((t) + 1, sl_next); } \
    CMASK(C0, C1, t); \
    { float a = MX3(C0[0], C0[1], C1[0]), b = MX3(C0[2], C0[3], C1[1]); a = MX3(a, C1[2], C1[3]); \
      _Pragma("unroll") for (int r = 4; r < 16; r += 4) { a = MX3(a, C0[r], C0[r + 1]); b = MX3(b, C0[r + 2], C0[r + 3]); a = MX3(a, C1[r], C1[r + 1]); b = MX3(b, C1[r + 2], C1[r + 3]); } \
      float rm = __builtin_fmaxf(a, b); { auto rr = __builtin_amdgcn_permlane32_swap(__float_as_uint(rm), __float_as_uint(rm), false, false); rm = __builtin_fmaxf(__uint_as_float(rr[0]), __uint_as_float(rr[1])); } \
      resc = false; \
      if (__builtin_expect(__any(rm > (float)THRL), 0)) { const float dl = __builtin_fmaxf(rm, 0.f); mhat += dl; \
        _Pragma("unroll") for (int r = 0; r < 16; ++r) { C0[r] -= dl; C1[r] -= dl; } \
        _Pragma("unroll") for (int r = 0; r < 16; ++r) negm[r] = -mhat; asm volatile("" : "+v"(negm)); \
        const float f = __builtin_amdgcn_exp2f(-dl); l_reg *= f; if (hi == 0) wsf[r32] = f; resc = true; } } \
    SBAR(); \
    GAPB(o[0] = __builtin_amdgcn_mfma_f32_32x32x16_bf16(PAF(0), VFR(0), o[0], 0, 0, 0), C0, 0); \
    GAPB(o[1] = __builtin_amdgcn_mfma_f32_32x32x16_bf16(PAF(0), VFR(4), o[1], 0, 0, 0), C0, 4); \
    KRD(GL, 0); GAPB(o[0] = __builtin_amdgcn_mfma_f32_32x32x16_bf16(PAF(1), VFR(1), o[0], 0, 0, 0), C0, 8); \
    KRD(GL, 1); GAPB(o[1] = __builtin_amdgcn_mfma_f32_32x32x16_bf16(PAF(1), VFR(5), o[1], 0, 0, 0), C0, 12); \
    KRD(GL, 2); GAPB(o[0] = __builtin_amdgcn_mfma_f32_32x32x16_bf16(PAF(2), VFR(2), o[0], 0, 0, 0), C1, 0); \
    KRD(GL, 3); GAPB(o[1] = __builtin_amdgcn_mfma_f32_32x32x16_bf16(PAF(2), VFR(6), o[1], 0, 0, 0), C1, 4); \
    GAPB(o[0] = __builtin_amdgcn_mfma_f32_32x32x16_bf16(PAF(3), VFR(3), o[0], 0, 0, 0), C1, 8); \
    GAPB(o[1] = __builtin_amdgcn_mfma_f32_32x32x16_bf16(PAF(3), VFR(7), o[1], 0, 0, 0), C1, 12); \
    } while (0)
    int t = 1;
#undef CMASK
#define CMASK(P0, P1, t) do {} while (0)
    for (; t + 5 < NT; t += 2) {
        STEP(pB0, pB1, pA0, pA1, t, true, true, true);     WAIT_BAR(2); RESC(); ROT();
        STEP(pA0, pA1, pB0, pB1, t + 1, true, true, true); WAIT_BAR(2); RESC(); ROT();
    }
#undef CMASK
#define CMASK(P0, P1, t) do { int jb_ = (t) - (NT - 4); if (jb_ >= 0) cmask(P0, P1, jb_, qrel, hi); } while (0)
#define ENDW(tt) do { if ((tt) + 3 < NT) { WAIT_BAR(2); } else if ((tt) + 2 < NT) { WAIT_BAR(1); } else { WAIT_BAR(0); } } while (0)
    for (; t + 1 < NT; t += 2) {
        STEP(pB0, pB1, pA0, pA1, t, (t + 3 < NT), (t + 1 < NT), (t + 1 < NT));         ENDW(t);     RESC(); ROT();
        STEP(pA0, pA1, pB0, pB1, t + 1, (t + 4 < NT), (t + 2 < NT), (t + 2 < NT));     ENDW(t + 1); RESC(); ROT();
    }
    STEP(pB0, pB1, pA0, pA1, NT - 1, false, false, false); RESC();
    { float sacc = pB0[0] + pB0[1]; _Pragma("unroll") for (int r = 2; r < 16; ++r) sacc += pB0[r]; _Pragma("unroll") for (int r = 0; r < 16; ++r) sacc += pB1[r]; l_reg += sacc;
      pw0 = (u32x4){PKW(pB0, 0), PKW(pB0, 2), PKW(pB0, 4), PKW(pB0, 6)}; pw1 = (u32x4){PKW(pB0, 8), PKW(pB0, 10), PKW(pB0, 12), PKW(pB0, 14)}; pw2 = (u32x4){PKW(pB1, 0), PKW(pB1, 2), PKW(pB1, 4), PKW(pB1, 6)}; pw3 = (u32x4){PKW(pB1, 8), PKW(pB1, 10), PKW(pB1, 12), PKW(pB1, 14)};
      SBAR(); pv(o, vb0 + sl_cur, PAF(0), PAF(1), PAF(2), PAF(3)); }
#undef PKW
#undef PAF
#undef VFR
#undef PIN
#undef MX3
#undef GAPA
#undef GAPB
#undef EX
#undef VRD
#undef KRD
#undef STEP
#undef ENDW
    { auto rr = __builtin_amdgcn_permlane32_swap(__float_as_uint(l_reg), __float_as_uint(l_reg), false, false); l_reg = __uint_as_float(rr[0]) + __uint_as_float(rr[1]); }
    if (hi == 0) wsf[32 + r32] = l_reg; asm volatile("s_waitcnt lgkmcnt(0)" ::: "memory");
    float rli[16];
#pragma unroll
    for (int r = 0; r < 16; ++r) rli[r] = __builtin_amdgcn_rcpf(wsf[32 + crow(r, hi)]);
    bf16* Ow = Obuf + (rowbase + q0 + wid * QBLK) * PO + oc;
    { bf16* stg = (bf16*)(shm + LDS_OST) + wid * 2048;
#pragma unroll
      for (int r = 0; r < 16; ++r) { const int orow = crow(r, hi);
#pragma unroll
        for (int d0 = 0; d0 < 2; ++d0) stg[orow * 64 + d0 * 32 + r32] = __float2bfloat16(o[d0][r] * rli[r]); }
      asm volatile("s_waitcnt lgkmcnt(0)" ::: "memory");
#pragma unroll
      for (int i = 0; i < 4; ++i) { const int row = i * 8 + (lane >> 3), ch = lane & 7; const u32x4 v = *(const u32x4*)(stg + row * 64 + ch * 8); ATTN_STORE16(Ow + (long)row * PO + ch * 8, v); } }
    asm volatile("s_waitcnt lgkmcnt(0)\n\ts_barrier" ::: "memory");
#undef DMA_K
#undef DMA_V
#undef CMASK
#undef START
#undef RESC
#undef ROT
}
#undef SBAR
#undef WAIT_BAR
}


namespace at2 {
using f32x16 = __attribute__((ext_vector_type(16))) float;
constexpr int PQ = 3072, PO = 256, DV = 128, DQ = 64;
constexpr int NW = 8, QBLK = 32, KVBLK = 64, QB = NW * QBLK;
constexpr int SHM_V = KVBLK * DV * 2, SHM_K = KVBLK * DQ * 2;
constexpr int OFF_VL = 0, OFF_KL = 2 * SHM_V, OFF_WS = 2 * SHM_V + 2 * SHM_K;
constexpr int OFF_OL = OFF_WS + 2048, OL_RS = 272, OL_WAVE = QBLK * OL_RS;
constexpr float THR2 = 8.f;
#define KSWZ64(row, colB) ((row) * 128 + ((colB) ^ (((row) & 7) << 4)))
#define SBAR() __builtin_amdgcn_sched_barrier(0)
__device__ __forceinline__ int v_st(int k, int c) { const int kk = (k & ~0xC) | ((k & 4) << 1) | ((k & 8) >> 1); return ((kk >> 3) * 4 + (c >> 5)) * 512 + ((kk & 7) * 32 + (c & 31)) * 2; }
__device__ __forceinline__ int v_rd_base(int lane) { return ((lane & 3) << 3) | (((lane >> 2) & 3) << 6) | (((lane >> 4) & 1) << 5) | (((lane >> 5) & 1) << 8); }
constexpr int v_rd_off(int d0, int ks, int half) { return d0 * 512 + ks * 4096 + half * 2048; }
__device__ __forceinline__ int crow(int r, int hi) { return (r & 3) + 8 * (r >> 2) + 4 * hi; }
__device__ __forceinline__ bf16x8 load8(const bf16_t* p) { return *reinterpret_cast<const bf16x8*>(p); }
__device__ __forceinline__ void mask_tile(f32x16& p0, f32x16& p1, int dq) {
    const float NEG = -__builtin_inff();
#pragma unroll
    for (int r = 0; r < 16; ++r) { const int c = (r & 3) + 8 * (r >> 2); if (dq - c < 0) p0[r] = NEG; if (dq - c - 32 < 0) p1[r] = NEG; }
}
__device__ __forceinline__ void partialSM(f32x16& p0, f32x16& p1, float& m_reg, float& mn, float& alpha) {
    float pmax = p0[0];
#pragma unroll
    for (int r = 1; r < 16; ++r) pmax = fmaxf(pmax, p0[r]);
#pragma unroll
    for (int r = 0; r < 16; ++r) pmax = fmaxf(pmax, p1[r]);
    { auto rr = __builtin_amdgcn_permlane32_swap(__float_as_uint(pmax), __float_as_uint(pmax), false, false); pmax = fmaxf(__uint_as_float(rr[0]), __uint_as_float(rr[1])); }
    if (__builtin_expect(__all((pmax - m_reg) <= THR2), 1)) { mn = m_reg; alpha = 1.f; }
    else { mn = fmaxf(m_reg, pmax); alpha = __builtin_amdgcn_exp2f(m_reg - mn); m_reg = mn; }
#pragma unroll
    for (int r = 0; r < 16; ++r) { p0[r] = p0[r] - mn; p1[r] = p1[r] - mn; }
#pragma unroll
    for (int r = 0; r < 16; ++r) p0[r] = __builtin_amdgcn_exp2f(p0[r]);
}
__device__ __forceinline__ void finishSM(f32x16& p0, f32x16& p1, float alpha, float& l_reg, bf16x8& pa0, bf16x8& pa1, bf16x8& pa2, bf16x8& pa3) {
#pragma unroll
    for (int r = 0; r < 16; ++r) p1[r] = __builtin_amdgcn_exp2f(p1[r]);
    float ps = 0;
#pragma unroll
    for (int r = 0; r < 16; ++r) ps += p0[r];
#pragma unroll
    for (int r = 0; r < 16; ++r) ps += p1[r];
    { auto rr = __builtin_amdgcn_permlane32_swap(__float_as_uint(ps), __float_as_uint(ps), false, false); ps = __uint_as_float(rr[0]) + __uint_as_float(rr[1]); }
    l_reg = l_reg * alpha + ps;
#define PK4(P, B_, OUT) do { unsigned a0 = cvtpk(P[B_+0], P[B_+1]), a1 = cvtpk(P[B_+2], P[B_+3]);                          \
        unsigned b0 = cvtpk(P[B_+4], P[B_+5]), b1 = cvtpk(P[B_+6], P[B_+7]);                                             \
        auto r0 = __builtin_amdgcn_permlane32_swap(a0, b0, false, false); auto r1 = __builtin_amdgcn_permlane32_swap(a1, b1, false, false); \
        u32x4 w = {r0[0], r1[0], r0[1], r1[1]}; OUT = *reinterpret_cast<bf16x8*>(&w); } while (0)
    PK4(p0, 0, pa0); PK4(p0, 8, pa1); PK4(p1, 0, pa2); PK4(p1, 8, pa3);
#undef PK4
}
template <int KB>
__device__ __forceinline__ void qkt(f32x16& p0, f32x16& p1, const char* K_lds, int r32, int hi, const bf16x8* qr) {
    p0 = f32x16{}; p1 = f32x16{};
#pragma unroll
    for (int d0 = 0; d0 < 4; ++d0) { const char* a = K_lds + KB * SHM_K + KSWZ64(r32, (d0 * 16 + hi * 8) * 2);
        bf16x8 b0 = *reinterpret_cast<const bf16x8*>(a);
        bf16x8 b1 = *reinterpret_cast<const bf16x8*>(a + 32 * 128);
        p0 = __builtin_amdgcn_mfma_f32_32x32x16_bf16(b0, qr[d0], p0, 0, 0, 0);
        p1 = __builtin_amdgcn_mfma_f32_32x32x16_bf16(b1, qr[d0], p1, 0, 0, 0); }
}
template <int VB>
__device__ __forceinline__ void pv_tile(f32x16* o, int vb0, bf16x8 pa0, bf16x8 pa1, bf16x8 pa2, bf16x8 pa3) {
#define TRRD(dst, off) asm volatile("ds_read_b64_tr_b16 %0, %1 offset:%2" : "=&v"(dst) : "v"(vb0), "i"(off) : "memory")
#define PV_D0(d0) do { s16x4 l0, l1, l2, l3, h0, h1, h2, h3; constexpr int b_ = VB * SHM_V + v_rd_off(d0, 0, 0); \
        TRRD(l0, b_); TRRD(h0, b_ + 2048); TRRD(l1, b_ + 4096); TRRD(h1, b_ + 6144); TRRD(l2, b_ + 8192); TRRD(h2, b_ + 10240); TRRD(l3, b_ + 12288); TRRD(h3, b_ + 14336); \
        asm volatile("s_waitcnt lgkmcnt(0)" ::: "memory"); SBAR();   \
        o[d0] = __builtin_amdgcn_mfma_f32_32x32x16_bf16(pa0, (bf16x8){l0[0], l0[1], l0[2], l0[3], h0[0], h0[1], h0[2], h0[3]}, o[d0], 0, 0, 0);   \
        o[d0] = __builtin_amdgcn_mfma_f32_32x32x16_bf16(pa1, (bf16x8){l1[0], l1[1], l1[2], l1[3], h1[0], h1[1], h1[2], h1[3]}, o[d0], 0, 0, 0);   \
        o[d0] = __builtin_amdgcn_mfma_f32_32x32x16_bf16(pa2, (bf16x8){l2[0], l2[1], l2[2], l2[3], h2[0], h2[1], h2[2], h2[3]}, o[d0], 0, 0, 0);   \
        o[d0] = __builtin_amdgcn_mfma_f32_32x32x16_bf16(pa3, (bf16x8){l3[0], l3[1], l3[2], l3[3], h3[0], h3[1], h3[2], h3[3]}, o[d0], 0, 0, 0); } while (0)
    PV_D0(0); PV_D0(1); PV_D0(2); PV_D0(3);
#undef PV_D0
#undef TRRD
}
struct BlockRef { const bf16_t* Q; const bf16_t* K; const bf16_t* V; int P0; int to_lds; float lam; };
struct Seam { bf16x8 qr[4]; bf16x8 st_v0, st_v1, st_k0; };
#define VMW() asm volatile("s_waitcnt vmcnt(0)" ::: "memory")
#define VMWN(n) asm volatile("s_waitcnt vmcnt(%0)" :: "i"(n) : "memory")
#define SLOAD_H(Kp, Vp, k0) do { S.st_v0 = load8((Vp) + (size_t)((k0) + sr) * PQ + sc); S.st_v1 = load8((Vp) + (size_t)((k0) + 32 + sr) * PQ + sc); \
                                 S.st_k0 = load8((Kp) + (size_t)((k0) + kr) * PQ + kc); } while (0)
#define SWRITE_HK(bf) do { *(bf16x8*)(K_lds + (bf) * SHM_K + kws) = S.st_k0; } while (0)
#define SWRITE_HV(bf) do { *(bf16x8*)(V_lds + (bf) * SHM_V + vst0) = S.st_v0; *(bf16x8*)(V_lds + (bf) * SHM_V + vst1) = S.st_v1; } while (0)
#define SWRITE_H(bf) do { SWRITE_HV(bf); SWRITE_HK(bf); } while (0)
__device__ __forceinline__ void prime(const BlockRef& cur, char* lds, Seam& S, int tid, int wid) {
    const int lane = tid & 63, r32 = lane & 31, hi = lane >> 5;
    const int sr = tid >> 4, sc = (tid & 15) * 8, kr = tid >> 3, kc = (tid & 7) * 8, kws = KSWZ64(kr, kc * 2); char* K_lds = lds + OFF_KL;
#pragma unroll
    for (int d0 = 0; d0 < 4; ++d0) S.qr[d0] = load8(cur.Q + (size_t)(wid * QBLK + r32) * PQ + d0 * 16 + hi * 8);
    SLOAD_H(cur.K, cur.V, 0); VMW(); SWRITE_HK(0);
    __syncthreads();
}
__device__ __forceinline__ void block(const BlockRef& cur, const BlockRef& nxt, char* lds, Seam& S, int tid, int wid) {
    asm volatile("" : "+v"(tid));
    const int lane = tid & 63, r32 = lane & 31, hi = lane >> 5;
    const int NT = (cur.P0 + QB - 1) / KVBLK + 1;
    const int qlo = cur.P0 + wid * QBLK, qm = qlo + r32 - 4 * hi;
    char* V_lds = lds + OFF_VL; char* K_lds = lds + OFF_KL;
    float* ws = (float*)(lds + OFF_WS) + wid * 64; float* li_l = ws, * al_l = ws + 32;
    float m_reg = -1e30f, l_reg = 0; f32x16 o[4] = {};
    const int sr = tid >> 4, sc = (tid & 15) * 8, vst0 = v_st(sr, sc), vst1 = v_st(32 + sr, sc), kr = tid >> 3, kc = (tid & 7) * 8, kws = KSWZ64(kr, kc * 2);
    const int vb0 = (int)(uintptr_t)V_lds + v_rd_base(lane);
    const bf16_t* Kh = cur.K; const bf16_t* Vh = cur.V;
#define RESC(a) do { if (__any((a) < 1.f)) { if (hi == 0) al_l[r32] = (a); asm volatile("s_waitcnt lgkmcnt(0)" ::: "memory");              \
                     _Pragma("unroll") for (int d_ = 0; d_ < 4; ++d_) _Pragma("unroll") for (int r = 0; r < 16; ++r) o[d_][r] *= al_l[crow(r, hi)]; } } while (0)
#define KBASE(t) ((t) * KVBLK)
#define MASKT(P0_, P1_, t) do { const int kb_ = KBASE(t); if (kb_ + KVBLK - 1 > qlo) mask_tile(P0_, P1_, qm - kb_); } while (0)
#define SEAM_K0() do { VMWN(4); SWRITE_HK(0); SBAR(); } while (0)
    f32x16 pA0, pA1, pB0, pB1; float mnA, mnB, alA, alB; bf16x8 pa0, pa1, pa2, pa3;
    SWRITE_HV(0); SBAR();
    if (NT > 1) SLOAD_H(Kh, Vh, KBASE(1));
    SBAR(); qkt<0>(pA0, pA1, K_lds, r32, hi, S.qr);
    MASKT(pA0, pA1, 0); partialSM(pA0, pA1, m_reg, mnA, alA);
    if (NT > 1) { VMW(); SWRITE_H(1); }
    __syncthreads();
#define HALF_STEP(PX0, PX1, mnX, alX, PY0, PY1, alY, t, KB, VB, SB) do {                                                      \
        SBAR(); qkt<KB>(PX0, PX1, K_lds, r32, hi, S.qr);                                                                      \
        finishSM(PY0, PY1, alY, l_reg, pa0, pa1, pa2, pa3); SBAR();                                                           \
        if ((t) + 1 < NT) { SLOAD_H(Kh, Vh, KBASE((t) + 1)); SBAR(); }                                                        \
        pv_tile<VB>(o, vb0, pa0, pa1, pa2, pa3); MASKT(PX0, PX1, (t)); partialSM(PX0, PX1, m_reg, mnX, alX);                 \
        __syncthreads();                                                                                                      \
        if ((t) + 1 < NT) { VMW(); SWRITE_H(SB); }                                                                            \
        RESC(alX); __syncthreads(); } while (0)
    for (int t = 1; t + 1 < NT; t += 2) {
        HALF_STEP(pB0, pB1, mnB, alB, pA0, pA1, alA, t, 1, 0, 0);
        HALF_STEP(pA0, pA1, mnA, alA, pB0, pB1, alB, t + 1, 0, 1, 1);
    }
    const bool even = wid >= 6;
    if (even) { SBAR(); qkt<1>(pB0, pB1, K_lds, r32, hi, S.qr); SBAR(); }
    SLOAD_H(nxt.K, nxt.V, 0); SBAR();
#pragma unroll
    for (int d0 = 0; d0 < 4; ++d0) S.qr[d0] = load8(nxt.Q + (size_t)(wid * QBLK + r32) * PQ + d0 * 16 + hi * 8);
    SBAR();
    finishSM(pA0, pA1, alA, l_reg, pa0, pa1, pa2, pa3); SBAR();
    pv_tile<0>(o, vb0, pa0, pa1, pa2, pa3);
    if (even) { MASKT(pB0, pB1, NT - 1); partialSM(pB0, pB1, m_reg, mnB, alB); __syncthreads(); RESC(alB);
        finishSM(pB0, pB1, alB, l_reg, pa0, pa1, pa2, pa3); SBAR(); pv_tile<1>(o, vb0, pa0, pa1, pa2, pa3); }
    else __syncthreads();
    SBAR(); SEAM_K0();
    if (hi == 0) li_l[r32] = l_reg; asm volatile("s_waitcnt lgkmcnt(0)" ::: "memory");
    float rli[16];
#pragma unroll
    for (int r = 0; r < 16; ++r) rli[r] = __builtin_amdgcn_rcpf(li_l[crow(r, hi)]);
    { char* Ol = lds + OFF_OL + wid * OL_WAVE;
      if (!cur.to_lds) {
#pragma unroll
          for (int d0 = 0; d0 < 4; ++d0)
#pragma unroll
              for (int hq = 0; hq < 2; ++hq) { u32x4 wv_;
#pragma unroll
                  for (int q = 0; q < 4; ++q) { const int r = hq * 8 + q * 2; wv_[q] = cvtpk(o[d0][r] * rli[r], o[d0][r + 1] * rli[r + 1]); }
                  *(u32x4*)(Ol + ((d0 * 2 + hq) * 64 + lane) * 16) = wv_; }
      } else {
          u32x4 o1w[8];
#pragma unroll
          for (int i = 0; i < 8; ++i) o1w[i] = *(const u32x4*)(Ol + (i * 64 + lane) * 16);
          asm volatile("s_waitcnt lgkmcnt(0)" ::: "memory");
#pragma unroll
          for (int r = 0; r < 16; ++r) { const int orow = crow(r, hi);
#pragma unroll
              for (int d0 = 0; d0 < 4; ++d0) { const unsigned w1 = o1w[d0 * 2 + (r >> 3)][(r & 7) >> 1]; const float o1v = (r & 1) ? bfhi(w1) : bflo(w1);
                  const float v = o1v - cur.lam * (o[d0][r] * rli[r]); const float vn = sx<1>(v);
                  if ((r32 & 1) == 0) *(unsigned*)(Ol + orow * OL_RS + (d0 * 32 + r32) * 2) = cvtpk(v, vn); } } } }
    asm volatile("s_waitcnt lgkmcnt(0)\n\ts_barrier" ::: "memory");
#undef RESC
#undef KBASE
#undef MASKT
#undef SEAM_K0
#undef HALF_STEP
}
#undef VMW
#undef VMWN
#undef SLOAD_H
#undef SWRITE_HK
#undef SWRITE_HV
#undef SWRITE_H
#undef SBAR
#undef KSWZ64
}

struct Params {
    const float* x; const float* c; const int* positions; const float* norm1; const float* norm2; const float* w_ada; const float* b_ada;
    const float* a_w_in; const float* a_b_if; const float* a_h_norm; const float* a_w_out;
    const float* b_w_in; const float* b_q_norm; const float* b_k_norm; const float* b_lam_q1; const float* b_lam_k1; const float* b_lam_q2; const float* b_lam_k2;
    const float* b_o_norm; const float* b_w_out; const float* w_router; const float* router_bias; const float* moe_w_gu; const float* moe_w_down;
    float* out; unsigned char* ws;
};
struct Frame { LAS unsigned char* lds; int tid, lane, wave, G, bid, vcu; };
__device__ __forceinline__ Frame make_frame(unsigned char* lds, int wv) {
    Frame F; F.lds = (LAS unsigned char*)lds; int t = wv * 64 + lane_id(); asm volatile("" : "+v"(t)); F.tid = t; F.lane = t & 63; F.wave = wv;
    F.G = gridDim.x; F.bid = blockIdx.x; F.vcu = (F.G % 8 == 0) ? (F.bid % 8) * (F.G / 8) + F.bid / 8 : F.bid; return F;
}

struct WItem { const float* W; unsigned char* WT; float* cs; int ldw, Kr, drow0, n0, mode; float s8; };
constexpr int NW_ITEMS = ((WQ_IN0 == 2) ? 48 : 0) + ((WQ_OUT0 == 2) ? 16 : 0) + ((WQ_OUT1 == 2) ? 16 : 0);
__device__ __forceinline__ WItem decode_witem(int it, const Params& p) {
    float* cw = (float*)(p.ws + SC_CW);
    if (WQ_IN0 == 2) { if (it < 48) { const int nb = it; return WItem{p.a_w_in, p.ws + WS_WAIN, cw + CW_AIN, 3080, 1024, 64 * nb, 64 * nb, 2, 0.f}; } it -= 48; }
    if (WQ_OUT0 == 2) { if (it < 16) { const int nb = it; return WItem{p.a_w_out, p.ws + WS_WAOUT, cw + CW_AOUT, 1024, 1024, 64 * nb, 64 * nb, 2, 0.f}; } it -= 16; }
    { const int nb = it; return WItem{p.b_w_out, p.ws + WS_WBOUT, cw + CW_BOUT, 1024, 1024, 64 * nb, 64 * nb, 2, 0.f}; }
}
__device__ __forceinline__ int witem_owner(int it, int G) { return (G == 256) ? 192 + (it & 63) : it % G; }
struct TItem { const float* W; bf16_t* WT; int ldw, K, drow0, k0, n0; float s8; };
__device__ __forceinline__ TItem decode_item(int it, const Params& p) {
    constexpr int I0 = (WQ_IN0 == 2) ? 0 : 16 * 48, I1 = (WQ_OUT0 == 2) ? 0 : 16 * 16, I2 = 16 * 48, I3 = (WQ_OUT1 == 2) ? 0 : 16 * 16, I4 = 32 * 256;
    TItem t; int r = it;
    if (r < I0) { const int kb = r / 48, nb = r % 48; t = (WQ_IN0 == 1) ? TItem{p.a_w_in, (bf16_t*)(p.ws + WS_WAIN), 3080, 1024, 64 * nb, 64 * kb, 64 * nb, S8_WIN} : TItem{p.a_w_in, (bf16_t*)(p.ws + WS_WAIN_BF), 3080, 1024, 64 * nb, 64 * kb, 64 * nb, 0.f}; return t; } r -= I0;
    if (r < I1) { const int kb = r / 16, nb = r % 16; t = (WQ_OUT0 == 1) ? TItem{p.a_w_out, (bf16_t*)(p.ws + WS_WAOUT), 1024, 1024, 64 * nb, 64 * kb, 64 * nb, S8_WOUT} : TItem{p.a_w_out, (bf16_t*)(p.ws + WS_WAOUT_BF), 1024, 1024, 64 * nb, 64 * kb, 64 * nb, 0.f}; return t; } r -= I1;
    if (r < I2) { const int kb = r / 48, nb = r % 48; t = TItem{p.b_w_in, (bf16_t*)(p.ws + WS_WBIN), 3072, 1024, 64 * nb, 64 * kb, 64 * nb, S8_WIN}; return t; } r -= I2;
    if (r < I3) { const int kb = r / 16, nb = r % 16; t = OUTPROJ_FP8 ? TItem{p.b_w_out, (bf16_t*)(p.ws + WS_WBOUT), 1024, 1024, 64 * nb, 64 * kb, 64 * nb, S8_WOUT} : TItem{p.b_w_out, (bf16_t*)(p.ws + WS_WBOUT_BF), 1024, 1024, 64 * nb, 64 * kb, 64 * nb, 0.f}; return t; } r -= I3;
    if (r < I4) { const int mi = r / 256, q = r % 256, kb = q / 16, nb = q % 16; const int n0 = 64 * nb;
        const int drow = ((n0 & 511) >> 7) * 256 + (n0 >> 9) * 128 + (n0 & 127);
        t = TItem{p.moe_w_gu + (size_t)mi * 1024 * 1024, (bf16_t*)(p.ws + WS_WGU + (size_t)mi * 1024 * 1024), 1024, 1024, drow, 64 * kb, n0, S8_WGU}; return t; } r -= I4;
    { const int mi = r / 128, q = r % 128, kb = q / 16, nb = q % 16;
      t = TItem{p.moe_w_down + (size_t)mi * 512 * 1024, (bf16_t*)(p.ws + WS_WDN + (size_t)mi * 1024 * 512), 1024, 512, 64 * nb, 64 * kb, 64 * nb, S8_WDN}; return t; }
}
__device__ __forceinline__ void phase_mod(unsigned char* lds_, int wv, const Params& p) {
    const Frame F = make_frame(lds_, wv);
    LAS float* cact = (LAS float*)F.lds;
    LAS float* red = (LAS float*)(F.lds + 65536);
    float* mod = (float*)(p.ws + WS_MOD);
    for (int i = F.tid; i < NB * DM; i += NTHREADS) { const int b = i >> 10, k = i & 1023; const float v = p.c[i]; cact[k * 16 + b] = v / (1.0f + expf(-v)); }
    __syncthreads();
    for (int task = F.bid; task < 192; task += F.G) {
        const int l = task / 96, cb = task % 96;
        const float* W = p.w_ada + (size_t)l * DM * 6144 + cb * 64 + F.lane;
        float acc[16];
#pragma unroll
        for (int b = 0; b < 16; ++b) acc[b] = 0.f;
        const int kbeg = F.wave * 128;
        for (int kb = kbeg; kb < kbeg + 128; kb += 16) {
            float wv[16];
#pragma unroll
            for (int u = 0; u < 16; ++u) wv[u] = __builtin_nontemporal_load(W + (size_t)(kb + u) * 6144);
#pragma unroll
            for (int u = 0; u < 16; ++u) {
                const LAS f32x4* cc = (const LAS f32x4*)(cact + (kb + u) * 16);
                const f32x4 c0 = cc[0], c1 = cc[1], c2 = cc[2], c3 = cc[3]; const float w = wv[u];
                acc[0] += c0[0] * w; acc[1] += c0[1] * w; acc[2] += c0[2] * w; acc[3] += c0[3] * w;
                acc[4] += c1[0] * w; acc[5] += c1[1] * w; acc[6] += c1[2] * w; acc[7] += c1[3] * w;
                acc[8] += c2[0] * w; acc[9] += c2[1] * w; acc[10] += c2[2] * w; acc[11] += c2[3] * w;
                acc[12] += c3[0] * w; acc[13] += c3[1] * w; acc[14] += c3[2] * w; acc[15] += c3[3] * w;
            }
        }
#pragma unroll
        for (int b = 0; b < 16; ++b) red[(F.wave * 16 + b) * 64 + F.lane] = acc[b];
        __syncthreads();
        for (int o = F.tid; o < 1024; o += NTHREADS) { const int b = o >> 6, cl = o & 63; float s = 0.f;
#pragma unroll
            for (int w = 0; w < 8; ++w) s += red[(w * 16 + b) * 64 + cl];
            mod[((size_t)l * 16 + b) * 6144 + cb * 64 + cl] = s + p.b_ada[(size_t)l * 6144 + cb * 64 + cl]; }
        __syncthreads();
    }
}
__device__ __forceinline__ void phase_wconv(unsigned char* lds_, int wv, const Params& p) {
    const Frame F = make_frame(lds_, wv);
    LAS float* scr = (LAS float*)(F.lds + F.wave * 17408);
    LAS float* cmaxw = (LAS float*)(F.lds + 8 * 17408);
    const int lane = F.lane, lr = lane >> 4, c4 = (lane & 15) * 4, w = F.wave;
    for (int it = 0; it < NW_ITEMS; ++it) {
        if (witem_owner(it, F.G) != F.bid) continue;
        const WItem t = decode_witem(it, p);
        const int RW = t.Kr >> 3, NH = RW >> 6;
        f32x4 v[2][16];
#pragma unroll
        for (int hf = 0; hf < 2; ++hf) if (hf < NH) {
#pragma unroll
            for (int i = 0; i < 16; ++i) v[hf][i] = __builtin_nontemporal_load((const f32x4*)(t.W + (size_t)(w * RW + hf * 64 + 4 * i + lr) * t.ldw + t.n0 + c4)); }
        __syncthreads();
        float qs = t.s8;
        if (t.mode == 2) {
            float mx[4] = {0.f, 0.f, 0.f, 0.f};
#pragma unroll
            for (int hf = 0; hf < 2; ++hf) if (hf < NH) {
#pragma unroll
                for (int i = 0; i < 16; ++i)
#pragma unroll
                    for (int q = 0; q < 4; ++q) mx[q] = fmaxf(mx[q], fabsf(v[hf][i][q])); }
#pragma unroll
            for (int q = 0; q < 4; ++q) { mx[q] = fmaxf(mx[q], sx<16>(mx[q])); auto rr = __builtin_amdgcn_permlane32_swap(__float_as_uint(mx[q]), __float_as_uint(mx[q]), false, false); mx[q] = fmaxf(__uint_as_float(rr[0]), __uint_as_float(rr[1])); }
            if (lr == 0) *(LAS f32x4*)(cmaxw + w * 64 + c4) = (f32x4){mx[0], mx[1], mx[2], mx[3]};
            __syncthreads();
            float cm = 0.f;
#pragma unroll
            for (int ww = 0; ww < 8; ++ww) cm = fmaxf(cm, cmaxw[ww * 64 + lane]);
            qs = cm > 0.f ? 127.0f / cm : 0.f;
            if (w == 0) t.cs[t.drow0 + lane] = cm * (1.0f / 127.0f);
        }
#pragma unroll
        for (int hf = 0; hf < 2; ++hf) if (hf < NH) {
#pragma unroll
            for (int i = 0; i < 16; ++i) *(LAS f32x4*)(scr + (4 * i + lr) * 68 + c4) = v[hf][i];
            const int k0 = w * RW + hf * 64;
            if (t.mode == 0) { bf16_t* orow = (bf16_t*)t.WT + (size_t)(t.drow0 + lane) * t.Kr + k0;
#pragma unroll
                for (int c = 0; c < 8; ++c) { float f[8];
#pragma unroll
                    for (int q = 0; q < 8; ++q) f[q] = scr[(8 * c + q) * 68 + lane];
                    u32x4 o; o.x = cvtpk(f[0], f[1]); o.y = cvtpk(f[2], f[3]); o.z = cvtpk(f[4], f[5]); o.w = cvtpk(f[6], f[7]);
                    *(u32x4*)(orow + 8 * c) = o; } }
            else { unsigned char* orow8 = t.WT + (size_t)(t.drow0 + lane) * t.Kr + k0;
#pragma unroll
                for (int c = 0; c < 4; ++c) { float f[16];
#pragma unroll
                    for (int q = 0; q < 16; ++q) f[q] = scr[(16 * c + q) * 68 + lane] * qs;
                    u32x4 o;
                    if (t.mode == 1) { o.x = cvt4_fp8(f[0], f[1], f[2], f[3]); o.y = cvt4_fp8(f[4], f[5], f[6], f[7]); o.z = cvt4_fp8(f[8], f[9], f[10], f[11]); o.w = cvt4_fp8(f[12], f[13], f[14], f[15]); }
                    else { o.x = pack4_i8(f[0], f[1], f[2], f[3]); o.y = pack4_i8(f[4], f[5], f[6], f[7]); o.z = pack4_i8(f[8], f[9], f[10], f[11]); o.w = pack4_i8(f[12], f[13], f[14], f[15]); }
                    *(u32x4*)(orow8 + 16 * c) = o; } }
            asm volatile("s_waitcnt lgkmcnt(0)" ::: "memory");
        }
    }
}

__device__ __forceinline__ void phase_wconv_pw(unsigned char* lds_, int wv, const Params& p) {
    const Frame F = make_frame(lds_, wv);
    LAS float* scr = (LAS float*)(F.lds + F.wave * 17408);
    const int gw = F.vcu * NWAVES + F.wave, NGW = F.G * NWAVES;
    constexpr int NITEMS = ((WQ_IN0 == 2) ? 0 : 16 * 48) + ((WQ_OUT0 == 2) ? 0 : 16 * 16) + 16 * 48 + ((WQ_OUT1 == 2) ? 0 : 16 * 16) + 32 * 256 + 32 * 128;
    const int lane = F.lane, lr = lane >> 4, c4 = (lane & 15) * 4;
    f32x4 v[16];
    int it = gw;
    if (it < NITEMS) { const TItem t = decode_item(it, p);
#pragma unroll
        for (int i = 0; i < 16; ++i) v[i] = __builtin_nontemporal_load((const f32x4*)(t.W + (size_t)(t.k0 + 4 * i + lr) * t.ldw + t.n0 + c4)); }
    for (; it < NITEMS; it += NGW) {
        const TItem t = decode_item(it, p);
#pragma unroll
        for (int i = 0; i < 16; ++i) *(LAS f32x4*)(scr + (4 * i + lr) * 68 + c4) = v[i];
        const int itn = it + NGW;
        if (itn < NITEMS) { const TItem tn = decode_item(itn, p);
#pragma unroll
            for (int i = 0; i < 16; ++i) v[i] = __builtin_nontemporal_load((const f32x4*)(tn.W + (size_t)(tn.k0 + 4 * i + lr) * tn.ldw + tn.n0 + c4)); }
        if (t.s8 > 0.f) {
            unsigned char* orow8 = (unsigned char*)t.WT + (size_t)(t.drow0 + lane) * t.K + t.k0;
#pragma unroll
            for (int c = 0; c < 4; ++c) { float f[16];
#pragma unroll
                for (int q = 0; q < 16; ++q) f[q] = scr[(16 * c + q) * 68 + lane] * t.s8;
                u32x4 o; o.x = cvt4_fp8(f[0], f[1], f[2], f[3]); o.y = cvt4_fp8(f[4], f[5], f[6], f[7]); o.z = cvt4_fp8(f[8], f[9], f[10], f[11]); o.w = cvt4_fp8(f[12], f[13], f[14], f[15]);
                *(u32x4*)(orow8 + 16 * c) = o; }
        } else {
            bf16_t* orow = t.WT + (size_t)(t.drow0 + lane) * t.K + t.k0;
#pragma unroll
            for (int c = 0; c < 8; ++c) { float f[8];
#pragma unroll
                for (int q = 0; q < 8; ++q) f[q] = scr[(8 * c + q) * 68 + lane];
                u32x4 o; o.x = cvtpk(f[0], f[1]); o.y = cvtpk(f[2], f[3]); o.z = cvtpk(f[4], f[5]); o.w = cvtpk(f[6], f[7]);
                *(u32x4*)(orow + 8 * c) = o; }
        }
    }
}

struct RowConst { f32x4 a[4], b[4]; };
__device__ __forceinline__ RowConst load_rowconst(const float* norm, const float* modb, int sh_off, int sc_off, int lane) {
    RowConst rc;
#pragma unroll
    for (int j = 0; j < 4; ++j) { const int c = 256 * j + 4 * lane;
        const f32x4 nv = *(const f32x4*)(norm + c), sc = *(const f32x4*)(modb + sc_off + c); rc.b[j] = *(const f32x4*)(modb + sh_off + c);
        rc.a[j] = nv * (sc + 1.0f); }
    return rc;
}
__device__ __forceinline__ void row_norm_store(const f32x4 (&v)[4], const RowConst& rc, f32x4 (&h)[4], bf16_t* hrow, int lane) {
    float ss = 0.f;
#pragma unroll
    for (int j = 0; j < 4; ++j) ss += (v[j][0] * v[j][0] + v[j][1] * v[j][1]) + (v[j][2] * v[j][2] + v[j][3] * v[j][3]);
    const float r = 1.0f / sqrtf(wave_sum(ss) * (1.0f / DM) + EPS);
#pragma unroll
    for (int j = 0; j < 4; ++j) { h[j] = v[j] * r * rc.a[j] + rc.b[j];
        u32x2 w; w.x = cvtpk(h[j][0], h[j][1]); w.y = cvtpk(h[j][2], h[j][3]); *(u32x2*)(hrow + 256 * j + 4 * lane) = w; }
}


__device__ __forceinline__ float reduce16(const float (&v)[16], int lane) {
    float a[8], b[4], c[2];
    const bool b5 = (lane & 32) != 0, b4 = (lane & 16) != 0, b3 = (lane & 8) != 0, b2 = (lane & 4) != 0;
#pragma unroll
    for (int i = 0; i < 8; ++i) { const float send = b5 ? v[i] : v[8 + i], keep = b5 ? v[8 + i] : v[i]; a[i] = keep + sx32(send, b5); }
#pragma unroll
    for (int i = 0; i < 4; ++i) { const float send = b4 ? a[i] : a[4 + i], keep = b4 ? a[4 + i] : a[i]; b[i] = keep + sx<16>(send); }
#pragma unroll
    for (int i = 0; i < 2; ++i) { const float send = b3 ? b[i] : b[2 + i], keep = b3 ? b[2 + i] : b[i]; c[i] = keep + sx<8>(send); }
    const float send = b2 ? c[0] : c[1], keep = b2 ? c[1] : c[0];
    float d = keep + sx<4>(send);
    d += sx<1>(d); d += sx<2>(d);
    return d;
}
__device__ __forceinline__ float reduce8(const float (&v)[8], int lane) {
    float b[4], c[2];
    const bool b5 = (lane & 32) != 0, b4 = (lane & 16) != 0, b3 = (lane & 8) != 0;
#pragma unroll
    for (int i = 0; i < 4; ++i) { const float send = b5 ? v[i] : v[4 + i], keep = b5 ? v[4 + i] : v[i]; b[i] = keep + sx32(send, b5); }
#pragma unroll
    for (int i = 0; i < 2; ++i) { const float send = b4 ? b[i] : b[2 + i], keep = b4 ? b[2 + i] : b[i]; c[i] = keep + sx<16>(send); }
    const float send = b3 ? c[0] : c[1], keep = b3 ? c[1] : c[0];
    float d = keep + sx<8>(send);
    d += sx<1>(d); d += sx<2>(d); d += sx<4>(d);
    return d;
}

__device__ __forceinline__ void row_norm_store8(const f32x4 (&v)[4], const RowConst& rc, f32x4 (&h)[4], unsigned char* hrow, int lane) {
    float ss = 0.f;
#pragma unroll
    for (int j = 0; j < 4; ++j) ss += (v[j][0] * v[j][0] + v[j][1] * v[j][1]) + (v[j][2] * v[j][2] + v[j][3] * v[j][3]);
    const float r = 1.0f / sqrtf(wave_sum(ss) * (1.0f / DM) + EPS);
#pragma unroll
    for (int j = 0; j < 4; ++j) { h[j] = v[j] * r * rc.a[j] + rc.b[j];
        *(unsigned*)(hrow + 256 * j + 4 * lane) = cvt4_fp8(h[j][0] * S8_H, h[j][1] * S8_H, h[j][2] * S8_H, h[j][3] * S8_H); }
}
__device__ __forceinline__ void row_norm_store_i8(const f32x4 (&v)[4], const RowConst& rc, f32x4 (&h)[4], unsigned char* hrow, float* rs_out, int lane) {
    float ss = 0.f;
#pragma unroll
    for (int j = 0; j < 4; ++j) ss += (v[j][0] * v[j][0] + v[j][1] * v[j][1]) + (v[j][2] * v[j][2] + v[j][3] * v[j][3]);
    const float r = 1.0f / sqrtf(wave_sum(ss) * (1.0f / DM) + EPS);
    float mx = 0.f;
#pragma unroll
    for (int j = 0; j < 4; ++j) { h[j] = v[j] * r * rc.a[j] + rc.b[j]; mx = fmaxf(fmaxf(mx, fmaxf(fabsf(h[j][0]), fabsf(h[j][1]))), fmaxf(fabsf(h[j][2]), fabsf(h[j][3]))); }
    mx = fmaxf(wave_max(mx), 1e-20f);
    const float qs = 127.0f / mx;
#pragma unroll
    for (int j = 0; j < 4; ++j) *(unsigned*)(hrow + 256 * j + 4 * lane) = pack4_i8(h[j][0] * qs, h[j][1] * qs, h[j][2] * qs, h[j][3] * qs);
    if (lane == 0) *rs_out = mx * (1.0f / 127.0f);
}
__device__ __forceinline__ void phase_hprep0(unsigned char* lds_, int wv, const Params& p) {
    const Frame F = make_frame(lds_, wv);
    LAS f32x4* Wg = (LAS f32x4*)F.lds;
    for (int idx = F.tid; idx < 2048; idx += NTHREADS) { const int ln = idx & 63, half = (idx >> 6) & 1, i = (idx >> 7) & 3, j = idx >> 9; const int c = 256 * j + 4 * ln + i;
        Wg[idx] = *(const f32x4*)(p.a_w_in + (size_t)c * 3080 + 3072 + half * 4); }
    __syncthreads();
    const float* mod = (const float*)(p.ws + WS_MOD);
    unsigned char* H = p.ws + WS_H; float* gates = (float*)(p.ws + WS_GATES);
    const float bif = p.a_b_if[F.lane & 7];
    float* cst = (float*)(p.ws + WS_CS);
    const float invf_tab[8] = {1.0f, 0.19391788f, 0.037604144f, 0.0072920943f, 0.0014140673f, 0.00027421273f, 5.3174683e-05f, 1.0311522e-05f};
    float invf = 0.f;
#pragma unroll
    for (int i = 0; i < 8; ++i) if ((F.lane & 7) == i) invf = invf_tab[i];
    for (int chunk = F.bid; chunk < 256; chunk += F.G) {
        const int row0 = chunk * 128 + F.wave * 16; const int b = row0 / SEQ;
        const RowConst rc = load_rowconst(p.norm1, mod + (size_t)b * 6144, 0, 1024, F.lane);
        for (int rb = 0; rb < 16; rb += 4) {
            f32x4 v[4][4];
#pragma unroll
            for (int rr = 0; rr < 4; ++rr)
#pragma unroll
                for (int j = 0; j < 4; ++j) v[rr][j] = __builtin_nontemporal_load((const f32x4*)(p.x + (size_t)(row0 + rb + rr) * DM + 256 * j + 4 * F.lane));
            f32x4 h[4][4];
#pragma unroll
            for (int rr = 0; rr < 4; ++rr) { const size_t row_ = (size_t)(row0 + rb + rr);
                if (WQ_IN0 == 2) row_norm_store_i8(v[rr], rc, h[rr], H + row_ * DM, (float*)(p.ws + SC_RS_H) + row_, F.lane);
                else if (WQ_IN0 == 1) row_norm_store8(v[rr], rc, h[rr], H + row_ * DM, F.lane);
                else row_norm_store(v[rr], rc, h[rr], (bf16_t*)H + row_ * DM, F.lane); }
            float g[4][8];
#pragma unroll
            for (int rr = 0; rr < 4; ++rr)
#pragma unroll
                for (int q = 0; q < 8; ++q) g[rr][q] = 0.f;
#pragma unroll
            for (int j = 0; j < 4; ++j)
#pragma unroll
                for (int i = 0; i < 4; ++i) { if (i == 0 || i == 2) asm volatile("" ::: "memory");
                    const f32x4 w0 = Wg[((j * 4 + i) * 2 + 0) * 64 + F.lane], w1 = Wg[((j * 4 + i) * 2 + 1) * 64 + F.lane];
#pragma unroll
                    for (int rr = 0; rr < 4; ++rr) { const float hv = h[rr][j][i];
                        g[rr][0] += hv * w0[0]; g[rr][1] += hv * w0[1]; g[rr][2] += hv * w0[2]; g[rr][3] += hv * w0[3]; g[rr][4] += hv * w1[0]; g[rr][5] += hv * w1[1]; g[rr][6] += hv * w1[2]; g[rr][7] += hv * w1[3]; } }
#pragma unroll
            for (int rr = 0; rr < 4; ++rr) { const int row = row0 + rb + rr;
                const float d = reduce8(g[rr], F.lane);
                const float mine = bperm(d, 8 * (F.lane & 7));
                if (F.lane < 16) { const float ang = (float)p.positions[row] * invf; const double rev = (double)ang * 0.15915494309189535; const float frc = (float)(rev - rint(rev));
                    cst[(size_t)row * 16 + F.lane] = (F.lane < 8) ? __builtin_amdgcn_cosf(frc) : __builtin_amdgcn_sinf(frc); }
                if (F.lane < 8) { float val = mine + bif;
                    if (F.lane >= 4) val = fminf(val, 0.f) - log1pf(expf(-fabsf(val)));
                    gates[(size_t)row * 8 + F.lane] = val; }
            }
        }
    }
}

namespace mls {
constexpr int RSK = 272, RSV = 176, RSP = 272, RSC = 272;
constexpr int OFF_K = 0, OFF_V = 34816, OFF_P = OFF_V + 22528, OFF_C = OFF_P + 34816, OFF_G = OFF_C + 21760;
typedef short v4i16_t __attribute__((ext_vector_type(4)));
__device__ __forceinline__ bf16x8 tr2(const LAS unsigned char* base, int row, int col, int rs, int lane) {
    const int i = lane & 15, g = lane >> 4;
    const LAS unsigned char* p0 = base + (row + 8 * g + (i >> 2)) * rs + (col + 4 * (i & 3)) * 2;
    const s16x4 lo = __builtin_bit_cast(s16x4, __builtin_amdgcn_ds_read_tr16_b64_v4i16((LAS v4i16_t*)p0));
    const s16x4 hi = __builtin_bit_cast(s16x4, __builtin_amdgcn_ds_read_tr16_b64_v4i16((LAS v4i16_t*)(p0 + 4 * rs)));
    return (bf16x8){lo[0], lo[1], lo[2], lo[3], hi[0], hi[1], hi[2], hi[3]};
}
}
__device__ __forceinline__ void phase_mlstm(unsigned char* lds_, int wv, const Params& p) {
    const Frame F = make_frame(lds_, wv);
    using namespace mls;
    const bf16_t* PR = (const bf16_t*)(p.ws + WS_PROJ); const float* gates = (const float*)(p.ws + WS_GATES); bf16_t* HO = (bf16_t*)(p.ws + WS_HOUT);
    LAS unsigned char* Ks = F.lds + OFF_K; LAS unsigned char* Vs = F.lds + OFF_V; LAS unsigned char* Ps = F.lds + OFF_P; LAS unsigned char* Cs = F.lds + OFF_C;
    LAS float* gbase = (LAS float*)(F.lds + OFF_G);
    const int w = F.wave, lane = F.lane, c = lane & 15, g = lane >> 4, tid = F.tid;
    for (int item = F.vcu; item < 256; item += F.G) {
        const int bh = item >> 2, sl = item & 3, b = bh >> 2, h = bh & 3;
        const size_t tok0 = (size_t)b * SEQ;
        const bf16_t* Qg = PR + h * 128; const bf16_t* Kg = PR + 512 + h * 128; const bf16_t* Vg = PR + 1024 + h * 256 + sl * 64;
        __syncthreads();
        if (tid < 256) { const int row = tid >> 1, part = tid & 1; u32x4 z = {0u, 0u, 0u, 0u}; if (part == 0) z.x = 0x3F80u; *(LAS u32x4*)(Vs + row * RSV + 128 + part * 16) = z; }
        f32x4 cacc[5];
#pragma unroll
        for (int vt = 0; vt < 5; ++vt) cacc[vt] = (f32x4){0.f, 0.f, 0.f, 0.f};
        for (int i = tid; i < 80 * RSC / 16; i += NTHREADS) *(LAS u32x4*)(Cs + i * 16) = (u32x4){0u, 0u, 0u, 0u};
        float m_prev = 0.f;
        u32x4 kst[4], vst[2]; bf16x8 qf[4], qn[4]; float glf0 = 0.f, glf1 = 0.f, gi0 = 0.f, gi1 = 0.f;
        auto load_chunk = [&](int ch) {
            const size_t t0 = tok0 + (size_t)ch * 128;
#pragma unroll
            for (int k = 0; k < 4; ++k) { const int pc = tid + 512 * k, row = pc >> 4, c16 = pc & 15; kst[k] = *(const u32x4*)(Kg + (t0 + row) * 3072 + c16 * 8); }
#pragma unroll
            for (int k = 0; k < 2; ++k) { const int pc = tid + 512 * k, row = pc >> 3, c16 = pc & 7; vst[k] = *(const u32x4*)(Vg + (t0 + row) * 3072 + c16 * 8); }
#pragma unroll
            for (int ks = 0; ks < 4; ++ks) qn[ks] = *(const bf16x8*)(Qg + (t0 + 16 * w + c) * 3072 + 32 * ks + 8 * g);
            if (w == 0) { const float* gp = gates + (t0 + 2 * lane) * 8; gi0 = gp[h]; glf0 = gp[4 + h]; gi1 = gp[8 + h]; glf1 = gp[12 + h]; }
        };
        auto gate_scan = [&](LAS float* gs) {
            LAS float* gu = gs; LAS float* gwv = gs + 128; LAS float* gin = gs + 256; LAS float* gfl = gs + 384; LAS float* gwg = gs + 512;
            float s = glf0 + glf1;
#pragma unroll
            for (int d = 1; d < 64; d <<= 1) { const float t = bperm(s, (lane - d) & 63); if (lane >= d) s += t; }
            const float b1 = s, b0 = s - glf1;
            const float u0 = gi0 - b0, u1 = gi1 - b1;
            float m = fmaxf(u0, u1);
#pragma unroll
            for (int d = 1; d < 64; d <<= 1) { const float t = bperm(m, (lane - d) & 63); if (lane >= d) m = fmaxf(m, t); }
            float ex = bperm(m, (lane - 1) & 63); if (lane == 0) ex = -INFINITY;
            const float wv0 = fmaxf(fmaxf(ex, u0), m_prev), wv1 = fmaxf(m, m_prev);
            const float wlast = rdlane(wv1, 63), blast = rdlane(b1, 63);
            gu[2 * lane] = u0; gu[2 * lane + 1] = u1; gwv[2 * lane] = wv0; gwv[2 * lane + 1] = wv1;
            gin[2 * lane] = __expf(m_prev - wv0); gin[2 * lane + 1] = __expf(m_prev - wv1);
            gfl[2 * lane] = __expf(-(b0 + wv0)); gfl[2 * lane + 1] = __expf(-(b1 + wv1));
            gwg[2 * lane] = __expf(u0 - wlast); gwg[2 * lane + 1] = __expf(u1 - wlast);
            m_prev = blast + wlast;
        };
        auto store_chunk = [&]() {
#pragma unroll
            for (int k = 0; k < 4; ++k) { const int pc = tid + 512 * k, row = pc >> 4, c16 = pc & 15; *(LAS u32x4*)(Ks + row * RSK + c16 * 16) = kst[k]; }
#pragma unroll
            for (int k = 0; k < 2; ++k) { const int pc = tid + 512 * k, row = pc >> 3, c16 = pc & 7; *(LAS u32x4*)(Vs + row * RSV + c16 * 16) = vst[k]; }
#pragma unroll
            for (int ks = 0; ks < 4; ++ks) qf[ks] = qn[ks];
        };
        load_chunk(0);
        store_chunk();
        if (w == 0) gate_scan(gbase);
        __syncthreads();
        for (int ch = 0; ch < 16; ++ch) {
            LAS float* gs = gbase + (ch & 1) * 640;
            LAS float* gu = gs; LAS float* gwv = gs + 128; LAS float* gin = gs + 256; LAS float* gfl = gs + 384; LAS float* gwg = gs + 512;
            if (ch < 15) load_chunk(ch + 1);
            {
                const int t = 16 * w + c; const float wt = gwv[t];
#pragma unroll
                for (int jp = 0; jp < 4; ++jp) {
                    if (2 * jp <= w) {
                        f32x4 sa0 = (f32x4){0.f, 0.f, 0.f, 0.f}, sa1 = sa0;
#pragma unroll
                        for (int ks = 0; ks < 4; ++ks) { const bf16x8 kf0 = *(const LAS bf16x8*)(Ks + (32 * jp + c) * RSK + (32 * ks + 8 * g) * 2), kf1 = *(const LAS bf16x8*)(Ks + (32 * jp + 16 + c) * RSK + (32 * ks + 8 * g) * 2);
                            sa0 = __builtin_amdgcn_mfma_f32_16x16x32_bf16(kf0, qf[ks], sa0, 0, 0, 0); sa1 = __builtin_amdgcn_mfma_f32_16x16x32_bf16(kf1, qf[ks], sa1, 0, 0, 0); }
                        const f32x4 uv0 = *(const LAS f32x4*)(gu + 32 * jp + 4 * g), uv1 = *(const LAS f32x4*)(gu + 32 * jp + 16 + 4 * g);
                        float p0_[4], p1_[4];
#pragma unroll
                        for (int r = 0; r < 4; ++r) { const int s0 = 32 * jp + 4 * g + r, s1 = s0 + 16;
                            const float e0 = __expf(uv0[r] - wt), e1 = __expf(uv1[r] - wt); p0_[r] = (s0 <= t) ? sa0[r] * e0 : 0.f; p1_[r] = (s1 <= t) ? sa1[r] * e1 : 0.f; }
                        u32x2 pk0, pk1; pk0.x = cvtpk(p0_[0], p0_[1]); pk0.y = cvtpk(p0_[2], p0_[3]); pk1.x = cvtpk(p1_[0], p1_[1]); pk1.y = cvtpk(p1_[2], p1_[3]);
                        *(LAS u32x2*)(Ps + t * RSP + (32 * jp + 4 * g) * 2) = pk0; *(LAS u32x2*)(Ps + t * RSP + (32 * jp + 16 + 4 * g) * 2) = pk1;
                    }
                }
            }
            f32x4 nacc[5];
#pragma unroll
            for (int vt = 0; vt < 5; ++vt) { nacc[vt] = (f32x4){0.f, 0.f, 0.f, 0.f};
#pragma unroll
                for (int ks = 0; ks < 4; ++ks) { const bf16x8 cf = *(const LAS bf16x8*)(Cs + (16 * vt + c) * RSC + (32 * ks + 8 * g) * 2); nacc[vt] = __builtin_amdgcn_mfma_f32_16x16x32_bf16(cf, qf[ks], nacc[vt], 0, 0, 0); } }
            { const float iv = gin[16 * w + c];
#pragma unroll
              for (int vt = 0; vt < 5; ++vt) nacc[vt] = nacc[vt] * iv; }
            if (w == 0 && ch < 15) gate_scan(gbase + ((ch + 1) & 1) * 640);
            for (int ks = 0; ks <= (w >> 1); ++ks) {
                const bf16x8 pf = *(const LAS bf16x8*)(Ps + (16 * w + c) * RSP + (32 * ks + 8 * g) * 2);
#pragma unroll
                for (int vt = 0; vt < 5; ++vt) { const bf16x8 vf = tr2(Vs, 32 * ks, 16 * vt, RSV, lane); nacc[vt] = __builtin_amdgcn_mfma_f32_16x16x32_bf16(vf, pf, nacc[vt], 0, 0, 0); }
            }
            { const float den = bperm(nacc[4][0], lane & 15); const float inv = 1.0f / fmaxf(fabsf(den), gfl[16 * w + c]);
              bf16_t* orow = HO + (tok0 + (size_t)ch * 128 + 16 * w + c) * DM + h * 256 + sl * 64 + 4 * g;
#pragma unroll
              for (int vt = 0; vt < 4; ++vt) { u32x2 pk; pk.x = cvtpk(nacc[vt][0] * inv, nacc[vt][1] * inv); pk.y = cvtpk(nacc[vt][2] * inv, nacc[vt][3] * inv); *(u32x2*)(orow + 16 * vt) = pk; } }
            { const float decay = gin[127];
#pragma unroll
              for (int vt = 0; vt < 5; ++vt) cacc[vt] = cacc[vt] * decay;
#pragma unroll
              for (int ks = 0; ks < 4; ++ks) {
                  bf16x8 kf = tr2(Ks, 32 * ks, 16 * w, RSK, lane);
                  const f32x4 w0 = *(const LAS f32x4*)(gwg + 32 * ks + 8 * g), w1 = *(const LAS f32x4*)(gwg + 32 * ks + 8 * g + 4);
                  u32x4 kw = __builtin_bit_cast(u32x4, kf);
                  kw.x = cvtpk(bflo(kw.x) * w0[0], bfhi(kw.x) * w0[1]); kw.y = cvtpk(bflo(kw.y) * w0[2], bfhi(kw.y) * w0[3]);
                  kw.z = cvtpk(bflo(kw.z) * w1[0], bfhi(kw.z) * w1[1]); kw.w = cvtpk(bflo(kw.w) * w1[2], bfhi(kw.w) * w1[3]);
                  kf = __builtin_bit_cast(bf16x8, kw);
#pragma unroll
                  for (int vt = 0; vt < 5; ++vt) { const bf16x8 vf = tr2(Vs, 32 * ks, 16 * vt, RSV, lane); cacc[vt] = __builtin_amdgcn_mfma_f32_16x16x32_bf16(kf, vf, cacc[vt], 0, 0, 0); }
              } }
            asm volatile("s_waitcnt lgkmcnt(0)\n\ts_barrier" ::: "memory");
#pragma unroll
            for (int vt = 0; vt < 5; ++vt) { u32x2 pk; pk.x = cvtpk(cacc[vt][0], cacc[vt][1]); pk.y = cvtpk(cacc[vt][2], cacc[vt][3]); *(LAS u32x2*)(Cs + (16 * vt + c) * RSC + (16 * w + 4 * g) * 2) = pk; }
            if (ch < 15) store_chunk();
            __syncthreads();
        }
    }
}

__device__ __forceinline__ void phase_aprep(unsigned char* lds_, int wv, const Params& p) {
    const Frame F = make_frame(lds_, wv);
    const bf16_t* HO = (const bf16_t*)(p.ws + WS_HOUT); const bf16_t* PR = (const bf16_t*)(p.ws + WS_PROJ); unsigned char* A2 = p.ws + WS_H;
    float hn[16];
#pragma unroll
    for (int i = 0; i < 16; ++i) hn[i] = p.a_h_norm[16 * F.lane + i];
    const int gw = F.bid * NWAVES + F.wave, NGW = F.G * NWAVES;
    for (int rowb = gw; rowb < NTOK; rowb += 4 * NGW) {
        u32x4 h0[4], h1[4], o0[4], o1[4];
#pragma unroll
        for (int rr = 0; rr < 4; ++rr) { const int row = rowb + rr * NGW; if (row < NTOK) {
            h0[rr] = *(const u32x4*)(HO + (size_t)row * DM + 16 * F.lane); h1[rr] = *(const u32x4*)(HO + (size_t)row * DM + 16 * F.lane + 8);
            o0[rr] = *(const u32x4*)(PR + (size_t)row * 3072 + 2048 + 16 * F.lane); o1[rr] = *(const u32x4*)(PR + (size_t)row * 3072 + 2048 + 16 * F.lane + 8); } }
#pragma unroll
        for (int rr = 0; rr < 4; ++rr) { const int row = rowb + rr * NGW; if (row < NTOK) {
            float hv[16], ov[16];
#pragma unroll
            for (int i = 0; i < 4; ++i) { hv[2 * i] = bflo(h0[rr][i]); hv[2 * i + 1] = bfhi(h0[rr][i]); hv[8 + 2 * i] = bflo(h1[rr][i]); hv[8 + 2 * i + 1] = bfhi(h1[rr][i]);
                ov[2 * i] = bflo(o0[rr][i]); ov[2 * i + 1] = bfhi(o0[rr][i]); ov[8 + 2 * i] = bflo(o1[rr][i]); ov[8 + 2 * i + 1] = bfhi(o1[rr][i]); }
            float ss = 0.f;
#pragma unroll
            for (int i = 0; i < 16; ++i) ss += hv[i] * hv[i];
            ss += sx<1>(ss); ss += sx<2>(ss); ss += sx<4>(ss); ss += sx<8>(ss);
            const float r = 1.0f / sqrtf(ss * (1.0f / 256.0f) + EPS);
            float y[16];
#pragma unroll
            for (int i = 0; i < 16; ++i) y[i] = hv[i] * r * hn[i] * sigmoidf_(ov[i]);
            if (WQ_OUT0 == 2) { float mx = 0.f;
#pragma unroll
                for (int i = 0; i < 16; ++i) mx = fmaxf(mx, fabsf(y[i]));
                mx = fmaxf(wave_max(mx), 1e-20f); const float qs = 127.0f / mx;
                u32x4 w; w.x = pack4_i8(y[0] * qs, y[1] * qs, y[2] * qs, y[3] * qs); w.y = pack4_i8(y[4] * qs, y[5] * qs, y[6] * qs, y[7] * qs); w.z = pack4_i8(y[8] * qs, y[9] * qs, y[10] * qs, y[11] * qs); w.w = pack4_i8(y[12] * qs, y[13] * qs, y[14] * qs, y[15] * qs);
                *(u32x4*)(A2 + (size_t)row * DM + 16 * F.lane) = w; if (F.lane == 0) ((float*)(p.ws + SC_RS_A))[row] = mx * (1.0f / 127.0f); }
            else if (OUTPROJ_FP8) { u32x4 w; w.x = cvt4_fp8(y[0] * S8_A2, y[1] * S8_A2, y[2] * S8_A2, y[3] * S8_A2); w.y = cvt4_fp8(y[4] * S8_A2, y[5] * S8_A2, y[6] * S8_A2, y[7] * S8_A2);
                w.z = cvt4_fp8(y[8] * S8_A2, y[9] * S8_A2, y[10] * S8_A2, y[11] * S8_A2); w.w = cvt4_fp8(y[12] * S8_A2, y[13] * S8_A2, y[14] * S8_A2, y[15] * S8_A2);
                *(u32x4*)(A2 + (size_t)row * DM + 16 * F.lane) = w; }
            else { bf16_t* a2b = (bf16_t*)(p.ws + WS_A2B) + (size_t)row * DM + 16 * F.lane; u32x4 w0, w1;
                w0.x = cvtpk(y[0], y[1]); w0.y = cvtpk(y[2], y[3]); w0.z = cvtpk(y[4], y[5]); w0.w = cvtpk(y[6], y[7]); w1.x = cvtpk(y[8], y[9]); w1.y = cvtpk(y[10], y[11]); w1.z = cvtpk(y[12], y[13]); w1.w = cvtpk(y[14], y[15]);
                *(u32x4*)a2b = w0; *(u32x4*)(a2b + 8) = w1; }
            } }
    }
}

__device__ __forceinline__ void phase_hprep_router(unsigned char* lds_, int wv, const Params& p, int layer) {
    const Frame F = make_frame(lds_, wv);
    LAS u32x4* Wf = (LAS u32x4*)F.lds;
    LAS float* mulc = (LAS float*)(F.lds + 65536);
    LAS float* addc = (LAS float*)(F.lds + 65536 + 4096);
    LAS int* cnt = (LAS int*)(F.lds + 73728);
    LAS float* lgs = (LAS float*)(F.lds + 73728 + 64);
    const float* mod = (const float*)(p.ws + WS_MOD) + (size_t)layer * 16 * 6144;
    unsigned char* H = p.ws + WS_H;
    const bf16_t* XB = (const bf16_t*)(p.ws + WS_XB);
    int* blkcnt = (int*)(p.ws + RT_BLKCNT); int* info = (int*)(p.ws + RT_INFO); float* tw = (float*)(p.ws + RT_W);
    if (F.bid == 0) { for (int i = F.tid; i < 256 * DM / 16; i += NTHREADS) *(u32x4*)(H + (size_t)NTOK * DM + i * 16) = (u32x4){0u, 0u, 0u, 0u}; }
    float rb[16];
#pragma unroll
    for (int e = 0; e < 16; ++e) rb[e] = p.router_bias[e];
    for (int chunk = F.bid; chunk < 256; chunk += F.G) {
        int lane = F.lane; asm volatile("" : "+v"(lane));
        const int fr = lane & 15, fq = lane >> 4;
        const int row = chunk * 128 + F.wave * 16 + fr; const int b = (chunk * 128) / SEQ;
        u32x4 xv[16][2];
        { const bf16_t* xrow = XB + (size_t)row * DM + 16 * fq;
#pragma unroll
          for (int s = 0; s < 16; ++s) { xv[s][0] = *(const u32x4*)(xrow + 64 * s); xv[s][1] = *(const u32x4*)(xrow + 64 * s + 8); } }
        if (chunk == F.bid) {
            for (int idx = F.tid; idx < 2048; idx += NTHREADS) { const int ln = idx & 63, ks = idx >> 6; const int col0 = 64 * (ks >> 1) + 16 * (ln >> 4) + 8 * (ks & 1);
                const float* wp = p.w_router + (size_t)col0 * 16 + (ln & 15); u32x4 hi, lo;
#pragma unroll
                for (int i = 0; i < 4; ++i) { const float a = wp[(2 * i) * 16], c = wp[(2 * i + 1) * 16]; const unsigned u = cvtpk(a, c); hi[i] = u; lo[i] = cvtpk(a - bflo(u), c - bfhi(u)); }
                Wf[idx] = hi; Wf[2048 + idx] = lo; } }
        for (int c = F.tid; c < DM; c += NTHREADS) { mulc[c] = p.norm2[(size_t)layer * DM + c] * (1.0f + mod[(size_t)b * 6144 + 4096 + c]); addc[c] = mod[(size_t)b * 6144 + 3072 + c]; }
        if (F.tid < 16) cnt[F.tid] = 0;
        __syncthreads();
        float ss = 0.f;
#pragma unroll
        for (int s = 0; s < 16; ++s)
#pragma unroll
            for (int t = 0; t < 2; ++t)
#pragma unroll
                for (int i = 0; i < 4; ++i) { const float a = bflo(xv[s][t][i]), c = bfhi(xv[s][t][i]); ss += a * a + c * c; }
        ss += sx<16>(ss); ss += sx32(ss, lane >= 32);
        const float r = 1.0f / sqrtf(ss * (1.0f / DM) + EPS);
        f32x4 acc0 = (f32x4){0.f, 0.f, 0.f, 0.f}, acc1 = acc0, acc2 = acc0;
        unsigned char* hrow = H + (size_t)row * DM + 16 * fq;
#pragma unroll
        for (int s = 0; s < 16; ++s) {
            asm volatile("" ::: "memory");
            float h[16];
#pragma unroll
            for (int q = 0; q < 4; ++q) { const f32x4 m = *(const LAS f32x4*)(mulc + 64 * s + 16 * fq + 4 * q), a = *(const LAS f32x4*)(addc + 64 * s + 16 * fq + 4 * q);
                unsigned w0 = xv[s][q >> 1][(q & 1) * 2], w1 = xv[s][q >> 1][(q & 1) * 2 + 1]; asm volatile("" : "+v"(w0), "+v"(w1));
                h[4 * q] = bflo(w0) * r * m[0] + a[0]; h[4 * q + 1] = bfhi(w0) * r * m[1] + a[1]; h[4 * q + 2] = bflo(w1) * r * m[2] + a[2]; h[4 * q + 3] = bfhi(w1) * r * m[3] + a[3]; }
            u32x4 o; o.x = cvt4_fp8(h[0] * S8_H, h[1] * S8_H, h[2] * S8_H, h[3] * S8_H); o.y = cvt4_fp8(h[4] * S8_H, h[5] * S8_H, h[6] * S8_H, h[7] * S8_H);
            o.z = cvt4_fp8(h[8] * S8_H, h[9] * S8_H, h[10] * S8_H, h[11] * S8_H); o.w = cvt4_fp8(h[12] * S8_H, h[13] * S8_H, h[14] * S8_H, h[15] * S8_H);
            *(u32x4*)(hrow + 64 * s) = o;
#pragma unroll
            for (int t = 0; t < 2; ++t) { u32x4 hi, lo;
#pragma unroll
                for (int i = 0; i < 4; ++i) { const float a = h[8 * t + 2 * i], c = h[8 * t + 2 * i + 1]; const unsigned u = cvtpk(a, c); hi[i] = u; lo[i] = cvtpk(a - bflo(u), c - bfhi(u)); }
                const int ks = 2 * s + t;
                const bf16x8 whi = __builtin_bit_cast(bf16x8, Wf[ks * 64 + lane]), wlo = __builtin_bit_cast(bf16x8, Wf[2048 + ks * 64 + lane]);
                const bf16x8 hh = __builtin_bit_cast(bf16x8, hi), hl = __builtin_bit_cast(bf16x8, lo);
                acc0 = __builtin_amdgcn_mfma_f32_16x16x32_bf16(whi, hh, acc0, 0, 0, 0);
                acc1 = __builtin_amdgcn_mfma_f32_16x16x32_bf16(wlo, hh, acc1, 0, 0, 0);
                acc2 = __builtin_amdgcn_mfma_f32_16x16x32_bf16(whi, hl, acc2, 0, 0, 0); }
        }
        { const f32x4 tot = acc0 + (acc1 + acc2);
#pragma unroll
          for (int rr = 0; rr < 4; ++rr) lgs[(F.wave * 16 + fr) * 17 + 4 * fq + rr] = tot[rr]; }
        __syncthreads();
        if (F.tid < 128) {
            const int row = chunk * 128 + F.tid;
            float sc[16], bs[16];
#pragma unroll
            for (int e = 0; e < 16; ++e) { sc[e] = 1.0f / (1.0f + expf(-lgs[F.tid * 17 + e])); bs[e] = sc[e] + rb[e]; }
            int gsel = 0; float gbest = -INFINITY;
#pragma unroll
            for (int gI = 0; gI < 4; ++gI) { const float a = bs[4 * gI], b2 = bs[4 * gI + 1], c2 = bs[4 * gI + 2], d2 = bs[4 * gI + 3];
                const float hi1 = fmaxf(a, b2), lo1 = fminf(a, b2), hi2 = fmaxf(c2, d2), lo2 = fminf(c2, d2);
                const float top = fmaxf(hi1, hi2), sec = fmaxf(fminf(hi1, hi2), fmaxf(lo1, lo2)); const float gs = top + sec;
                if (gs > gbest) { gbest = gs; gsel = gI; } }
            float v0 = 0.f, v1 = 0.f, v2 = 0.f, v3 = 0.f, s0 = 0.f, s1 = 0.f, s2 = 0.f, s3 = 0.f;
#pragma unroll
            for (int gI = 0; gI < 4; ++gI) if (gI == gsel) { v0 = bs[4 * gI]; v1 = bs[4 * gI + 1]; v2 = bs[4 * gI + 2]; v3 = bs[4 * gI + 3]; s0 = sc[4 * gI]; s1 = sc[4 * gI + 1]; s2 = sc[4 * gI + 2]; s3 = sc[4 * gI + 3]; }
            int i1 = 0; float b1 = v0; if (v1 > b1) { b1 = v1; i1 = 1; } if (v2 > b1) { b1 = v2; i1 = 2; } if (v3 > b1) { b1 = v3; i1 = 3; }
            int i2 = -1; float bb = -INFINITY;
            if (i1 != 0 && v0 > bb) { bb = v0; i2 = 0; } if (i1 != 1 && v1 > bb) { bb = v1; i2 = 1; } if (i1 != 2 && v2 > bb) { bb = v2; i2 = 2; } if (i1 != 3 && v3 > bb) { bb = v3; i2 = 3; }
            const float sa = (i1 == 0) ? s0 : (i1 == 1) ? s1 : (i1 == 2) ? s2 : s3;
            const float sb = (i2 == 0) ? s0 : (i2 == 1) ? s1 : (i2 == 2) ? s2 : s3;
            const int e0 = gsel * 4 + i1, e1 = gsel * 4 + i2;
            const int r0 = __hip_atomic_fetch_add(&cnt[e0], 1, __ATOMIC_RELAXED, __HIP_MEMORY_SCOPE_WORKGROUP); const int r1 = __hip_atomic_fetch_add(&cnt[e1], 1, __ATOMIC_RELAXED, __HIP_MEMORY_SCOPE_WORKGROUP);
            info[row] = e0 | (e1 << 4) | (r0 << 8) | (r1 << 16); const float inv = 1.0f / (sa + sb); *(f32x2*)(tw + (size_t)row * 2) = (f32x2){sa * inv, sb * inv};
        }
        __syncthreads();
        if (F.tid < 16) blkcnt[chunk * 16 + F.tid] = cnt[F.tid];
        __syncthreads();
    }
}

__device__ __forceinline__ void phase_layout(unsigned char* lds_, int wv, const Params& p) {
    const Frame F = make_frame(lds_, wv);
    LAS int* lc = (LAS int*)F.lds;
    LAS int* tot = lc + 4096;
    LAS int* sst = tot + 16;
    LAS int* tst = sst + 16;
    const int* blkcnt = (const int*)(p.ws + RT_BLKCNT); const int* info = (const int*)(p.ws + RT_INFO);
    int* dest = (int*)(p.ws + RT_DEST); int* buftok = (int*)(p.ws + RT_BUFTOK); int* meta = (int*)(p.ws + RT_META);
    for (int i = F.tid; i < 4096; i += NTHREADS) lc[i] = blkcnt[i];
    __syncthreads();
    { const int e = F.tid >> 5, li = F.tid & 31; int v[8]; int s = 0;
      LAS int* part = tst + 32;
#pragma unroll
      for (int k = 0; k < 8; ++k) { v[k] = lc[(8 * li + k) * 16 + e]; s += v[k]; }
      part[e * 32 + li] = s;
      __syncthreads();
      int run = 0, all = 0;
      for (int k = 0; k < 32; ++k) { const int t = part[e * 32 + k]; all += t; if (k < li) run += t; }
#pragma unroll
      for (int k = 0; k < 8; ++k) { lc[(8 * li + k) * 16 + e] = run; run += v[k]; }
      if (li == 31) tot[e] = all; }
    __syncthreads();
    if (F.tid == 0) { int ts = 0; for (int e = 0; e < 16; ++e) { tst[e] = ts; sst[e] = ts * 256; ts += (tot[e] + 255) >> 8; } tst[16] = ts;
        if (F.bid == 0) { meta[0] = ts; for (int e = 0; e <= 16; ++e) meta[1 + e] = tst[e]; } }
    __syncthreads();
    for (int chunk = F.bid; chunk < 256; chunk += F.G) {
        if (F.tid < 128) { const int tok = chunk * 128 + F.tid; const int inf = info[tok]; const int e0 = inf & 15, e1 = (inf >> 4) & 15, r0 = (inf >> 8) & 255, r1 = (inf >> 16) & 255;
            const int d0 = sst[e0] + lc[chunk * 16 + e0] + r0, d1 = sst[e1] + lc[chunk * 16 + e1] + r1;
            buftok[d0] = tok; buftok[d1] = tok; dest[tok * 2] = d0; dest[tok * 2 + 1] = d1; }
    }
    for (int e = F.bid; e < 16; e += F.G) { const int beg = sst[e] + tot[e], end = tst[e + 1] * 256; for (int s = beg + F.tid; s < end; s += NTHREADS) buftok[s] = NTOK; }
}

__device__ __forceinline__ void phase_combine(unsigned char* lds_, int wv, const Params& p, int layer, bool next_prep) {
    const Frame F = make_frame(lds_, wv);
    const float* mod = (const float*)(p.ws + WS_MOD) + (size_t)layer * 16 * 6144;
    const float* modn = (const float*)(p.ws + WS_MOD) + (size_t)(layer + 1) * 16 * 6144;
    const unsigned char* Y = p.ws + WS_PROJ; unsigned char* H = p.ws + WS_H;
    bf16_t* XB = (bf16_t*)(p.ws + WS_XB);
    const int* dest = (const int*)(p.ws + RT_DEST); const float* tw = (const float*)(p.ws + RT_W);
    for (int chunk = F.bid; chunk < 256; chunk += F.G) {
        const int row0 = chunk * 128 + F.wave * 16; const int b = row0 / SEQ;
        f32x4 g2[4];
#pragma unroll
        for (int j = 0; j < 4; ++j) g2[j] = *(const f32x4*)(mod + (size_t)b * 6144 + 5120 + 256 * j + 4 * F.lane) * (1.0f / S8_Y);
        RowConst rc;
        if (next_prep) rc = load_rowconst(p.norm1 + (size_t)(layer + 1) * DM, modn + (size_t)b * 6144, 0, 1024, F.lane);
        for (int rb = 0; rb < 16; rb += 4) {
            int d0[4], d1[4]; float w0[4], w1[4];
#pragma unroll
            for (int rr = 0; rr < 4; ++rr) { const int row = row0 + rb + rr; d0[rr] = dest[row * 2]; d1[rr] = dest[row * 2 + 1]; w0[rr] = tw[row * 2]; w1[rr] = tw[row * 2 + 1]; }
            u32x2 xr[4][4]; unsigned ya[4][4], yb[4][4];
#pragma unroll
            for (int rr = 0; rr < 4; ++rr)
#pragma unroll
                for (int j = 0; j < 4; ++j) { xr[rr][j] = *(const u32x2*)(XB + (size_t)(row0 + rb + rr) * DM + 256 * j + 4 * F.lane);
                    ya[rr][j] = *(const unsigned*)(Y + (size_t)d0[rr] * DM + 256 * j + 4 * F.lane); yb[rr][j] = *(const unsigned*)(Y + (size_t)d1[rr] * DM + 256 * j + 4 * F.lane); }
#pragma unroll
            for (int rr = 0; rr < 4; ++rr) { const int row = row0 + rb + rr;
                f32x4 v[4];
#pragma unroll
                for (int j = 0; j < 4; ++j) { const unsigned a = ya[rr][j], bq = yb[rr][j]; f32x4 yy;
                    const f32x2 a01 = __builtin_amdgcn_cvt_pk_f32_fp8((int)a, false), a23 = __builtin_amdgcn_cvt_pk_f32_fp8((int)a, true), b01 = __builtin_amdgcn_cvt_pk_f32_fp8((int)bq, false), b23 = __builtin_amdgcn_cvt_pk_f32_fp8((int)bq, true);
                    yy[0] = w0[rr] * a01[0] + w1[rr] * b01[0]; yy[1] = w0[rr] * a01[1] + w1[rr] * b01[1]; yy[2] = w0[rr] * a23[0] + w1[rr] * b23[0]; yy[3] = w0[rr] * a23[1] + w1[rr] * b23[1];
                    const f32x4 xv = (f32x4){bflo(xr[rr][j].x), bfhi(xr[rr][j].x), bflo(xr[rr][j].y), bfhi(xr[rr][j].y)};
                    v[j] = xv + g2[j] * yy;
                    if (next_prep) { u32x2 w; w.x = cvtpk(v[j][0], v[j][1]); w.y = cvtpk(v[j][2], v[j][3]); *(u32x2*)(XB + (size_t)row * DM + 256 * j + 4 * F.lane) = w; }
                    else *(f32x4*)(p.out + (size_t)row * DM + 256 * j + 4 * F.lane) = v[j]; }
                if (next_prep) { f32x4 h[4]; row_norm_store8(v, rc, h, H + (size_t)row * DM, F.lane); }
            }
        }
    }
}

__device__ __forceinline__ void phase_qkprep(unsigned char* lds_, int wv, const Params& p) {
    const Frame F = make_frame(lds_, wv);
    bf16_t* PR = (bf16_t*)(p.ws + WS_PROJ);
    const int lane = F.lane, half = lane & 1, sh = lane >> 1;
    float nw[32];
    { const float* nsrc = (sh < 16) ? p.b_q_norm : p.b_k_norm;
#pragma unroll
      for (int i = 0; i < 32; ++i) nw[i] = nsrc[half * 32 + i]; }
    const float qscale = (sh < 16) ? 0.125f * 1.4426950408889634f : 1.0f;
    const float invf_tab[8] = {1.0f, 0.19391788f, 0.037604144f, 0.0072920943f, 0.0014140673f, 0.00027421273f, 5.3174683e-05f, 1.0311522e-05f};
    float invf = 0.f;
#pragma unroll
    for (int i = 0; i < 8; ++i) if ((lane & 7) == i) invf = invf_tab[i];
    const int gw = F.bid * NWAVES + F.wave, NGW = F.G * NWAVES;
    for (int rowb = gw; rowb < NTOK; rowb += 4 * NGW) {
        u32x4 raw[4][4]; int posi[4];
#pragma unroll
        for (int rr = 0; rr < 4; ++rr) { const int row = rowb + rr * NGW; if (row < NTOK) { posi[rr] = p.positions[row]; const bf16_t* ptr = PR + (size_t)row * 3072 + sh * 64 + half * 32;
#pragma unroll
            for (int k = 0; k < 4; ++k) raw[rr][k] = *(const u32x4*)(ptr + 8 * k); } }
#pragma unroll
        for (int rr = 0; rr < 4; ++rr) { const int row = rowb + rr * NGW; if (row < NTOK) {
            const float ang = (float)posi[rr] * invf;
            const double rev = (double)ang * 0.15915494309189535; const float fr = (float)(rev - rint(rev));
            const float cs = __builtin_amdgcn_cosf(fr), sn = __builtin_amdgcn_sinf(fr);
            bf16_t* ptr = PR + (size_t)row * 3072 + sh * 64 + half * 32;
            float v[32];
#pragma unroll
            for (int k = 0; k < 4; ++k)
#pragma unroll
                for (int i = 0; i < 4; ++i) { v[8 * k + 2 * i] = bflo(raw[rr][k][i]); v[8 * k + 2 * i + 1] = bfhi(raw[rr][k][i]); }
            float ss = 0.f;
#pragma unroll
            for (int i = 0; i < 32; ++i) ss += v[i] * v[i];
            ss += sx<1>(ss);
            const float r = 1.0f / sqrtf(ss * (1.0f / 64.0f) + EPS);
#pragma unroll
            for (int i = 0; i < 32; ++i) v[i] = v[i] * r * nw[i];
            float y1[8], y2[8];
#pragma unroll
            for (int i = 0; i < 8; ++i) { const float ci = rdlane(cs, i), si = rdlane(sn, i); y1[i] = v[i] * ci - v[8 + i] * si; y2[i] = v[8 + i] * ci + v[i] * si; }
            if (half == 0) {
#pragma unroll
                for (int i = 0; i < 8; ++i) { v[i] = y1[i]; v[8 + i] = y2[i]; } }
#pragma unroll
            for (int k = 0; k < 4; ++k) { u32x4 o;
#pragma unroll
                for (int i = 0; i < 4; ++i) o[i] = cvtpk(v[8 * k + 2 * i] * qscale, v[8 * k + 2 * i + 1] * qscale);
                *(u32x4*)(ptr + 8 * k) = o; } } }
    }
}

__device__ __forceinline__ void phase_attn(unsigned char* lds_, int wv, const Params& p) {
    const Frame F = make_frame(lds_, wv);
    const bf16_t* PR = (const bf16_t*)(p.ws + WS_PROJ); bf16_t* O4 = (bf16_t*)(p.ws + WS_HOUT) + (size_t)F.bid * 256 * 256;
    unsigned char* A2 = p.ws + WS_H;
    const float lam_init = 0.8f - 0.6f * 0.7408182206817179f;
    const float s1 = wave_sum(p.b_lam_q1[F.lane] * p.b_lam_k1[F.lane]), s2 = wave_sum(p.b_lam_q2[F.lane] * p.b_lam_k2[F.lane]);
    const float lam = expf(s1) - expf(s2) + lam_init;
    const float osc = (WQ_OUT1 == 2) ? A2Q : (1.0f - lam_init) * (OUTPROJ_FP8 ? S8_A2 : 1.0f);
    for (int item = F.vcu; item < 256; item += F.G) {
        const int bh = item >> 1, set = item & 1, b = bh >> 3, h = bh & 7;
        const int qlist = set ? 0x1256 : 0x0347;
#define AT2_REF(R, u) do { const int qb_ = (qlist >> (4 * ((u) >> 1))) & 15, c_ = (u) & 1; const size_t r0_ = (size_t)b * SEQ + qb_ * 256; \
        R.Q = PR + r0_ * 3072 + (h * 2 + c_) * 64; R.K = PR + (size_t)b * SEQ * 3072 + 1024 + (h * 2 + c_) * 64; R.V = PR + (size_t)b * SEQ * 3072 + 2048 + h * 128; \
        R.P0 = qb_ * 256; R.to_lds = c_; R.lam = lam; } while (0)
        at2::Seam S; at2::BlockRef cur, nxt;
        AT2_REF(cur, 0);
        __syncthreads();
        at2::prime(cur, (char*)lds_, S, F.tid, wv);
        for (int u = 0; u < 8; ++u) {
            const int un = (u < 7) ? u + 1 : 7;
            AT2_REF(nxt, un);
            at2::block(cur, nxt, (char*)lds_, S, F.tid, wv);
            if (u & 1) {
                asm volatile("s_waitcnt vmcnt(0)" ::: "memory");
                int lane = F.lane; asm volatile("" : "+v"(lane));
                const int half = lane & 1; const int qb = (qlist >> (4 * (u >> 1))) & 15; const size_t row = (size_t)b * SEQ + qb * 256 + wv * 32 + (lane >> 1);
                const LAS unsigned char* pb = F.lds + at2::OFF_OL + wv * at2::OL_WAVE + (lane >> 1) * at2::OL_RS + half * 128;
                u32x4 bq[8];
#pragma unroll
                for (int i = 0; i < 8; ++i) bq[i] = *(const LAS u32x4*)(pb + 16 * i);
                float d[64]; float ss = 0.f;
#pragma unroll
                for (int i = 0; i < 8; ++i)
#pragma unroll
                    for (int j = 0; j < 4; ++j) { d[8 * i + 2 * j] = bflo(bq[i][j]); d[8 * i + 2 * j + 1] = bfhi(bq[i][j]); }
#pragma unroll
                for (int i = 0; i < 64; ++i) ss += d[i] * d[i];
                ss += sx<1>(ss);
                const float r = osc / sqrtf(ss * (1.0f / 128.0f) + EPS);
                if (WQ_OUT1 == 2) { unsigned char* po = A2 + row * DM + h * 128 + half * 64;
#pragma unroll
                    for (int i = 0; i < 4; ++i) { const f32x4 n0 = *(const f32x4*)(p.b_o_norm + half * 64 + 16 * i), n1 = *(const f32x4*)(p.b_o_norm + half * 64 + 16 * i + 4), n2 = *(const f32x4*)(p.b_o_norm + half * 64 + 16 * i + 8), n3 = *(const f32x4*)(p.b_o_norm + half * 64 + 16 * i + 12);
                        u32x4 w; w.x = pack4_i8(d[16 * i] * r * n0[0], d[16 * i + 1] * r * n0[1], d[16 * i + 2] * r * n0[2], d[16 * i + 3] * r * n0[3]);
                        w.y = pack4_i8(d[16 * i + 4] * r * n1[0], d[16 * i + 5] * r * n1[1], d[16 * i + 6] * r * n1[2], d[16 * i + 7] * r * n1[3]);
                        w.z = pack4_i8(d[16 * i + 8] * r * n2[0], d[16 * i + 9] * r * n2[1], d[16 * i + 10] * r * n2[2], d[16 * i + 11] * r * n2[3]);
                        w.w = pack4_i8(d[16 * i + 12] * r * n3[0], d[16 * i + 13] * r * n3[1], d[16 * i + 14] * r * n3[2], d[16 * i + 15] * r * n3[3]);
                        *(u32x4*)(po + 16 * i) = w; } }
                else if (OUTPROJ_FP8) { unsigned char* po = A2 + row * DM + h * 128 + half * 64;
#pragma unroll
                    for (int i = 0; i < 4; ++i) { const f32x4 n0 = *(const f32x4*)(p.b_o_norm + half * 64 + 16 * i), n1 = *(const f32x4*)(p.b_o_norm + half * 64 + 16 * i + 4), n2 = *(const f32x4*)(p.b_o_norm + half * 64 + 16 * i + 8), n3 = *(const f32x4*)(p.b_o_norm + half * 64 + 16 * i + 12);
                        u32x4 w; w.x = cvt4_fp8(d[16 * i] * r * n0[0], d[16 * i + 1] * r * n0[1], d[16 * i + 2] * r * n0[2], d[16 * i + 3] * r * n0[3]);
                        w.y = cvt4_fp8(d[16 * i + 4] * r * n1[0], d[16 * i + 5] * r * n1[1], d[16 * i + 6] * r * n1[2], d[16 * i + 7] * r * n1[3]);
                        w.z = cvt4_fp8(d[16 * i + 8] * r * n2[0], d[16 * i + 9] * r * n2[1], d[16 * i + 10] * r * n2[2], d[16 * i + 11] * r * n2[3]);
                        w.w = cvt4_fp8(d[16 * i + 12] * r * n3[0], d[16 * i + 13] * r * n3[1], d[16 * i + 14] * r * n3[2], d[16 * i + 15] * r * n3[3]);
                        *(u32x4*)(po + 16 * i) = w; } }
                else { bf16_t* po = (bf16_t*)(p.ws + WS_A2B) + row * DM + h * 128 + half * 64;
#pragma unroll
                    for (int i = 0; i < 8; ++i) { const f32x4 n0 = *(const f32x4*)(p.b_o_norm + half * 64 + 8 * i), n1 = *(const f32x4*)(p.b_o_norm + half * 64 + 8 * i + 4);
                        u32x4 w; w.x = cvtpk(d[8 * i] * r * n0[0], d[8 * i + 1] * r * n0[1]); w.y = cvtpk(d[8 * i + 2] * r * n0[2], d[8 * i + 3] * r * n0[3]);
                        w.z = cvtpk(d[8 * i + 4] * r * n1[0], d[8 * i + 5] * r * n1[1]); w.w = cvtpk(d[8 * i + 6] * r * n1[2], d[8 * i + 7] * r * n1[3]);
                        *(u32x4*)(po + 8 * i) = w; } }
            }
            cur = nxt;
        }
#undef AT2_REF
    }
}

__device__ __forceinline__ void phase_ocombine(unsigned char* lds_, int wv, const Params& p) {
    const Frame F = make_frame(lds_, wv);
    const bf16_t* O4 = (const bf16_t*)(p.ws + WS_HOUT); unsigned char* A2 = p.ws + WS_H;
    const float lam_init = 0.8f - 0.6f * 0.7408182206817179f;
    const float s1 = wave_sum(p.b_lam_q1[F.lane] * p.b_lam_k1[F.lane]), s2 = wave_sum(p.b_lam_q2[F.lane] * p.b_lam_k2[F.lane]);
    const float lam = expf(s1) - expf(s2) + lam_init;
    const int lane = F.lane, hh = lane >> 3, sub = lane & 7, half = sub >> 2, j0 = (sub & 3) * 16;
    float on[16];
#pragma unroll
    for (int i = 0; i < 16; ++i) on[i] = p.b_o_norm[half * 64 + j0 + i] * (1.0f - lam_init) * S8_A2;
    const int gw = F.bid * NWAVES + F.wave, NGW = F.G * NWAVES;
    for (int rowb = gw; rowb < NTOK; rowb += 4 * NGW) {
        u32x4 a0[4], a1[4], b0[4], b1[4];
#pragma unroll
        for (int rr = 0; rr < 4; ++rr) { const int row = rowb + rr * NGW; if (row < NTOK) {
            const bf16_t* pa = O4 + (size_t)row * 2048 + ((hh * 2 + 0) * 2 + half) * 64 + j0; const bf16_t* pb = O4 + (size_t)row * 2048 + ((hh * 2 + 1) * 2 + half) * 64 + j0;
            a0[rr] = *(const u32x4*)pa; a1[rr] = *(const u32x4*)(pa + 8); b0[rr] = *(const u32x4*)pb; b1[rr] = *(const u32x4*)(pb + 8); } }
#pragma unroll
        for (int rr = 0; rr < 4; ++rr) { const int row = rowb + rr * NGW; if (row < NTOK) {
            float d[16];
#pragma unroll
            for (int i = 0; i < 4; ++i) { d[2 * i] = bflo(a0[rr][i]) - lam * bflo(b0[rr][i]); d[2 * i + 1] = bfhi(a0[rr][i]) - lam * bfhi(b0[rr][i]); d[8 + 2 * i] = bflo(a1[rr][i]) - lam * bflo(b1[rr][i]); d[8 + 2 * i + 1] = bfhi(a1[rr][i]) - lam * bfhi(b1[rr][i]); }
            float ss = 0.f;
#pragma unroll
            for (int i = 0; i < 16; ++i) ss += d[i] * d[i];
            ss += sx<1>(ss); ss += sx<2>(ss); ss += sx<4>(ss);
            const float r = 1.0f / sqrtf(ss * (1.0f / 128.0f) + EPS);
            float y[16];
#pragma unroll
            for (int i = 0; i < 16; ++i) y[i] = d[i] * r * on[i];
            u32x4 w; w.x = cvt4_fp8(y[0], y[1], y[2], y[3]); w.y = cvt4_fp8(y[4], y[5], y[6], y[7]); w.z = cvt4_fp8(y[8], y[9], y[10], y[11]); w.w = cvt4_fp8(y[12], y[13], y[14], y[15]);
            *(u32x4*)(A2 + (size_t)row * DM + hh * 128 + half * 64 + j0) = w; } }
    }
}


#ifndef PHASE_MASK
#define PHASE_MASK 0xFFFFFFFFu
#endif
#ifndef PROBE_A
#define PROBE_A (-1)
#endif
#ifndef PROBE_B
#define PROBE_B (0)
#endif
constexpr int STAMP_OFF = LDS_BYTES - 2048;
#define STAMP(k) do { if (PROBE_A >= 0 && blockIdx.x == 0 && STAMP_WAVE == 0 && lane_id() == 0) ((volatile LAS unsigned*)((LAS unsigned char*)lds + STAMP_OFF))[k] = (unsigned)__builtin_amdgcn_s_memrealtime(); } while (0)
#define PH(n) ((PHASE_MASK >> (n)) & 1u)

template <int LAYER>
__device__ __forceinline__ void layer_body(const Params& p, const XcdBarrier& bar, unsigned char* lds) {
    const int STAMP_WAVE = bar.wave; (void)STAMP_WAVE;
    constexpr int SB = (LAYER == 0) ? 4 : 13;
    const int G_ = gridDim.x, bid_ = blockIdx.x; LAS unsigned char* ldsl = (LAS unsigned char*)lds;
#define SEAM() xcd_barrier(bar)
    const float* mod = (const float*)(p.ws + WS_MOD);
    LAS int* tab = (LAS int*)(ldsl + TAB_OFF);
    if (PH(2)) { pg8::StaticOrder S; S.init(NTOK, 3072, G_, bid_);
      if (LAYER == 0) {
        if (WQ_IN0 == 2) { pg8::EpiProjI8 E{(bf16_t*)(p.ws + WS_PROJ), (const float*)(p.ws + SC_RS_H), (const float*)(p.ws + SC_CW) + CW_AIN, 0.08838834764831845f};
          pg8::gemm_phase<pg8::EpiProjI8, pg8::StaticOrder, false, true>(ldsl, bar.wave, (const bf16_t*)(p.ws + WS_H), (const bf16_t*)(p.ws + WS_WAIN), 0, 512, S, E, nullptr); }
        else { pg8::EpiBf16 E{(bf16_t*)(p.ws + WS_PROJ), 3072, 2, 4, 0.08838834764831845f, WQ_IN0 == 1 ? 1.0f / (S8_H * S8_WIN) : 1.0f};
          if (WQ_IN0 == 1) pg8::gemm_phase8<pg8::EpiBf16, pg8::StaticOrder, false>(ldsl, bar.wave, p.ws + WS_H, p.ws + WS_WAIN, 0, 1024, S, E, nullptr);
          else pg8::gemm_phase<pg8::EpiBf16, pg8::StaticOrder, false>(ldsl, bar.wave, (const bf16_t*)(p.ws + WS_H), (const bf16_t*)(p.ws + WS_WAIN_BF), 0, 1024, S, E, nullptr); } }
      else { pg8::EpiQKV E{(bf16_t*)(p.ws + WS_PROJ), p.b_q_norm, p.b_k_norm, (const float*)(p.ws + WS_CS), 1.0f / (S8_H * S8_WIN)};
        pg8::gemm_phase8<pg8::EpiQKV, pg8::StaticOrder, false>(ldsl, bar.wave, p.ws + WS_H, p.ws + WS_WBIN, 0, 1024, S, E, nullptr); } }
    SEAM(); STAMP(SB + 0);
    if (LAYER == 0) {
        if (PH(3)) phase_mlstm(lds, bar.wave, p);
        SEAM(); STAMP(SB + 1);
        if (PH(4)) phase_aprep(lds, bar.wave, p);
    } else {
        STAMP(SB + 1);
        if (PH(6)) phase_attn(lds, bar.wave, p);
        STAMP(SB + 2);
    }
    SEAM(); STAMP(SB + 2 + LAYER);
    if (PH(8)) { pg8::StaticOrder S; S.init(NTOK, 1024, G_, bid_);
      if (LAYER == 0 && WQ_OUT0 == 2) { pg8::EpiResidB<true, true> E{(const void*)p.x, (bf16_t*)(p.ws + WS_XB), mod + 2048, 1.0f, (const float*)(p.ws + WS_SCALES)};
        pg8::gemm_phase<pg8::EpiResidB<true, true>, pg8::StaticOrder, false, true>(ldsl, bar.wave, (const bf16_t*)(p.ws + WS_H), (const bf16_t*)(p.ws + WS_WAOUT), 0, 512, S, E, nullptr); }
      else if (LAYER == 1 && WQ_OUT1 == 2) { pg8::EpiResidB<false, true, true> E{(const void*)(p.ws + WS_XB), (bf16_t*)(p.ws + WS_XB), mod + (size_t)16 * 6144 + 2048, (1.0f - (0.8f - 0.6f * 0.7408182206817179f)) / A2Q, (const float*)(p.ws + WS_SCALES)};
        pg8::gemm_phase<pg8::EpiResidB<false, true, true>, pg8::StaticOrder, false, true>(ldsl, bar.wave, (const bf16_t*)(p.ws + WS_H), (const bf16_t*)(p.ws + WS_WBOUT), 0, 512, S, E, nullptr); }
      else { pg8::EpiResidB<LAYER == 0> E{LAYER == 0 ? (const void*)p.x : (const void*)(p.ws + WS_XB), (bf16_t*)(p.ws + WS_XB), mod + (size_t)LAYER * 16 * 6144 + 2048, OUTPROJ_FP8 ? 1.0f / (S8_A2 * S8_WOUT) : 1.0f, nullptr};
        if (OUTPROJ_FP8) pg8::gemm_phase8<pg8::EpiResidB<LAYER == 0>, pg8::StaticOrder, false>(ldsl, bar.wave, p.ws + WS_H, p.ws + (LAYER == 0 ? WS_WAOUT : WS_WBOUT), 0, 1024, S, E, nullptr);
        else pg8::gemm_phase<pg8::EpiResidB<LAYER == 0>, pg8::StaticOrder, false>(ldsl, bar.wave, (const bf16_t*)(p.ws + WS_A2B), (const bf16_t*)(p.ws + (LAYER == 0 ? WS_WAOUT_BF : WS_WBOUT_BF)), 0, 1024, S, E, nullptr); } }
    SEAM(); STAMP(SB + 3 + LAYER);
    if (PH(9)) phase_hprep_router(lds, bar.wave, p, LAYER);
    SEAM(); STAMP(SB + 4 + LAYER);
    if (PH(10)) phase_layout(lds, bar.wave, p);
    SEAM(); STAMP(SB + 5 + LAYER);
    if (PH(11)) { const int* meta = (const int*)(p.ws + RT_META);
      __syncthreads();
      { const int t_ = bar.wave * 64 + lane_id(); if (t_ < 17) tab[t_] = meta[1 + t_]; }
      __syncthreads();
      unsigned* flags = (unsigned*)p.ws + CW_FLAGS + LAYER * 512;
      const int xper = (int)bar.st[0], xnx = (int)bar.st[1], xdx = (int)bar.st[2], xj = (int)bar.st[3];
      pg8::MoeOrder S{xnx, xdx, xper, xj, tab[16], tab, flags};
      pg8::EpiSwiGLU8 E1{p.ws + WS_HOUT, 1.0f / (S8_H * S8_WGU), flags};
      pg8::gemm_phase8<pg8::EpiSwiGLU8, pg8::MoeOrder, true>(ldsl, bar.wave, p.ws + WS_H, p.ws + WS_WGU + (size_t)LAYER * 16 * 1024 * 1024, (size_t)1024 * 1024, 1024, S, E1, (const int*)(p.ws + RT_BUFTOK));
      STAMP(SB + 6 + LAYER);
      pg8::MoeOrderWait S2{xnx, xdx, xper, xj, tab[16], tab, flags};
      pg8::EpiFp8 E2{p.ws + WS_PROJ, 1024, S8_Y / (S8_ACT * S8_WDN)};
      pg8::gemm_phase8<pg8::EpiFp8, pg8::MoeOrderWait, false>(ldsl, bar.wave, p.ws + WS_HOUT, p.ws + WS_WDN + (size_t)LAYER * 16 * 1024 * 512, (size_t)1024 * 512, 512, S2, E2, nullptr); }
    SEAM(); STAMP(SB + 7 + LAYER);
    if (PH(12)) phase_combine(lds, bar.wave, p, LAYER, LAYER == 0);
#undef SEAM
}
__global__ void __launch_bounds__(NTHREADS, 2) mk_fwd(Params p) {
    extern __shared__ __attribute__((aligned(16))) unsigned char lds[];
    cg::grid_group grid = cg::this_grid();
    volatile LAS unsigned* misc = (volatile LAS unsigned*)((LAS unsigned char*)lds + MISC_OFF);
    const int wv0 = __builtin_amdgcn_readfirstlane((int)threadIdx.x >> 6);
    if (threadIdx.x < 32) misc[threadIdx.x] = 0u;
    __syncthreads();
    unsigned* ctl = (unsigned*)p.ws;
    XcdBarrier bar = xcd_barrier_post(ctl + CW_BAR, misc + 8, wv0);
    const int STAMP_WAVE = wv0; (void)STAMP_WAVE;
    STAMP(0);
    if (PH(0)) phase_mod(lds, bar.wave, p);
    __syncthreads();
    STAMP(1);
    if (PH(0)) { phase_wconv(lds, bar.wave, p); __syncthreads(); phase_wconv_pw(lds, bar.wave, p); }
    grid.sync(); STAMP(2);
    if (PH(1)) phase_hprep0(lds, bar.wave, p);
    xcd_barrier(bar); STAMP(3);
    layer_body<0>(p, bar, lds);
    xcd_barrier(bar); STAMP(12);
    layer_body<1>(p, bar, lds);
    STAMP(22);
    if (PROBE_A >= 0 && blockIdx.x == 0 && STAMP_WAVE == 0 && lane_id() == 0) {
        volatile LAS unsigned* ts = (volatile LAS unsigned*)((LAS unsigned char*)lds + STAMP_OFF);
        const unsigned dA = ts[PROBE_A + 1] - ts[PROBE_A], dB = ts[PROBE_B + 1] - ts[PROBE_B];
        const unsigned long long extra = 100ull * ((unsigned long long)(dA / 100u) + 1024ull * (dB / 100u)), t0 = __builtin_amdgcn_s_memrealtime();
        while (__builtin_amdgcn_s_memrealtime() - t0 < extra) __builtin_amdgcn_s_sleep(32);
    }
    if (xb_ld(ctl + CW_BAR + XB_TMO) != 0u) { __syncthreads(); for (size_t i = (size_t)blockIdx.x * NTHREADS + (wv0 * 64 + lane_id()); i < (size_t)NTOK * DM / 4; i += (size_t)gridDim.x * NTHREADS) ((f32x4*)p.out)[i] = (f32x4){1e30f, 1e30f, 1e30f, 1e30f}; }
}

extern "C" void kernel_launch(void* const* d_in, const int* in_sizes, int n_in, void* d_out, int out_size, void* d_ws, size_t ws_size, hipStream_t stream) {
    static int grid_blocks = 0;
    if (!grid_blocks) {
        int dev = 0, cus = 0, per_cu = 0;
        (void)hipGetDevice(&dev);
        (void)hipDeviceGetAttribute(&cus, hipDeviceAttributeMultiprocessorCount, dev);
        (void)hipFuncSetAttribute((const void*)mk_fwd, hipFuncAttributeMaxDynamicSharedMemorySize, LDS_BYTES);
        (void)hipOccupancyMaxActiveBlocksPerMultiprocessor(&per_cu, (const void*)mk_fwd, NTHREADS, LDS_BYTES);
        if (per_cu < 1) { fprintf(stderr, "kernel_launch: occupancy query reports %d blocks/CU\n", per_cu); per_cu = 1; }
        grid_blocks = cus;
        if (ws_size < WS_END || n_in != 24) fprintf(stderr, "kernel_launch: unexpected ws_size %zu (need %zu) or n_in %d\n", ws_size, (size_t)WS_END, n_in);
    }
    (void)hipMemsetAsync(d_ws, 0, CTL_BYTES, stream);
    Params p{};
    const float** pf = (const float**)&p;
    p.x = (const float*)d_in[0]; p.c = (const float*)d_in[1]; p.positions = (const int*)d_in[2]; p.norm1 = (const float*)d_in[3]; p.norm2 = (const float*)d_in[4];
    p.w_ada = (const float*)d_in[5]; p.b_ada = (const float*)d_in[6]; p.a_w_in = (const float*)d_in[7]; p.a_b_if = (const float*)d_in[8]; p.a_h_norm = (const float*)d_in[9];
    p.a_w_out = (const float*)d_in[10]; p.b_w_in = (const float*)d_in[11]; p.b_q_norm = (const float*)d_in[12]; p.b_k_norm = (const float*)d_in[13];
    p.b_lam_q1 = (const float*)d_in[14]; p.b_lam_k1 = (const float*)d_in[15]; p.b_lam_q2 = (const float*)d_in[16]; p.b_lam_k2 = (const float*)d_in[17];
    p.b_o_norm = (const float*)d_in[18]; p.b_w_out = (const float*)d_in[19]; p.w_router = (const float*)d_in[20]; p.router_bias = (const float*)d_in[21];
    p.moe_w_gu = (const float*)d_in[22]; p.moe_w_down = (const float*)d_in[23];
    p.out = (float*)d_out; p.ws = (unsigned char*)d_ws; (void)pf;
    void* args[] = {&p};
    hipError_t e = hipLaunchCooperativeKernel((const void*)mk_fwd, dim3(grid_blocks), dim3(NTHREADS), args, LDS_BYTES, stream);
    if (e != hipSuccess) fprintf(stderr, "cooperative launch failed: %s (grid %d)\n", hipGetErrorString(e), grid_blocks);
}
```

```cpp
#include <hip/hip_runtime.h>
#include <hip/hip_cooperative_groups.h>
#include <hip/hip_bf16.h>
#include <cstdio>
#include <cstdint>
#include <cmath>
namespace cg = cooperative_groups;

#define GAS __attribute__((address_space(1)))
#define LAS __attribute__((address_space(3)))
typedef unsigned short bf16_t;
typedef float f32x4 __attribute__((ext_vector_type(4)));
typedef float f32x2 __attribute__((ext_vector_type(2)));
typedef short bf16x8 __attribute__((ext_vector_type(8)));
typedef short s16x4 __attribute__((ext_vector_type(4)));
typedef unsigned u32x4 __attribute__((ext_vector_type(4)));
typedef unsigned u32x2 __attribute__((ext_vector_type(2)));
typedef __bf16 bf16x2_t __attribute__((ext_vector_type(2)));
typedef int i32x8 __attribute__((ext_vector_type(8)));
typedef int i32x4 __attribute__((ext_vector_type(4)));

constexpr int NTOK = 32768, DM = 1024, SEQ = 2048, NB = 16;
constexpr int NEXP = 16, DEXP = 512;
constexpr int NTHREADS = 512, NWAVES = 8;
constexpr int LDS_BYTES = 147456;
constexpr int MISC_OFF = LDS_BYTES - 128;
constexpr int TAB_OFF = 131072;
constexpr float EPS = 1e-6f;
constexpr int MAXTILES = 272, CAP = MAXTILES * 256;
constexpr float S8_H = 8.0f, S8_WGU = 256.0f, S8_ACT = 4.0f, S8_WDN = 128.0f, S8_WIN = 256.0f, S8_A2 = 16.0f, S8_WOUT = 256.0f, S8_Y = 16.0f;

constexpr size_t MiB = 1u << 20;
constexpr size_t WS_CTL = 0, CTL_BYTES = 1 * MiB;
constexpr int CW_BAR = 4096;
constexpr int CW_OFLAGS = 9216;
constexpr int CW_FLAGS = 8192;
constexpr size_t WS_MOD = 1 * MiB;
constexpr size_t WS_ROUTE = 2 * MiB;
constexpr size_t RT_BLKCNT = WS_ROUTE;
constexpr size_t RT_INFO = WS_ROUTE + 64 * 1024;
constexpr size_t RT_W = RT_INFO + 128 * 1024;
constexpr size_t RT_DEST = RT_W + 256 * 1024;
constexpr size_t RT_BUFTOK = RT_DEST + 256 * 1024;
constexpr size_t RT_META = RT_BUFTOK + 320 * 1024;
constexpr size_t WS_GATES = 4 * MiB;
constexpr size_t WS_SCALES = 5 * MiB;
constexpr size_t SC_RS_H = WS_SCALES;
constexpr size_t SC_RS_A = WS_SCALES + 128 * 1024;
constexpr size_t SC_RS_TOK = WS_SCALES + 256 * 1024;
constexpr size_t SC_RS_SLOT = WS_SCALES + 384 * 1024;
constexpr size_t SC_CW = WS_SCALES + 704 * 1024;
constexpr int CW_AIN = 0, CW_AOUT = 3072, CW_BIN = 4096, CW_GU = 7168, CW_BOUT = 7168 + 32 * 1024;
constexpr int WQ_OUT1 = 2;
constexpr float A2Q = 127.0f / 6.0f;
constexpr int WQ_IN0 = 2, WQ_IN1 = 1, WQ_OUT0 = 2, WQ_GU = 1;
constexpr size_t WS_WAIN = 6 * MiB, WS_WAOUT = 10 * MiB, WS_WBIN = 12 * MiB, WS_WBOUT = 16 * MiB;
constexpr size_t WS_WGU = 18 * MiB;
constexpr size_t WS_WDN = 50 * MiB;
constexpr size_t WS_H = 66 * MiB;
constexpr size_t WS_XB = 100 * MiB;
constexpr size_t WS_PROJ = 164 * MiB;
constexpr size_t WS_HOUT = 356 * MiB;
constexpr size_t WS_CS = 484 * MiB;
constexpr size_t WS_WAIN_BF = 488 * MiB;
constexpr size_t WS_WAOUT_BF = 506 * MiB, WS_WBOUT_BF = 508 * MiB;
constexpr size_t WS_A2B = 420 * MiB;
constexpr bool OUTPROJ_FP8 = false;
constexpr size_t WS_END = 510 * MiB;
constexpr bool INPROJ0_FP8 = false;

__device__ __forceinline__ unsigned cvtpk(float lo, float hi) { f32x2 v = {lo, hi}; bf16x2_t b = __builtin_convertvector(v, bf16x2_t); return __builtin_bit_cast(unsigned, b); }
__device__ __forceinline__ float clamp448(float v) { return fminf(fmaxf(v, -448.0f), 448.0f); }
__device__ __forceinline__ unsigned cvt4_fp8(float a, float b, float c, float d) {
    int w = __builtin_amdgcn_cvt_pk_fp8_f32(clamp448(a), clamp448(b), 0, false); w = __builtin_amdgcn_cvt_pk_fp8_f32(clamp448(c), clamp448(d), w, true); return (unsigned)w; }
__device__ __forceinline__ float bf2f(unsigned short h) { return __uint_as_float(((unsigned)h) << 16); }
__device__ __forceinline__ float bflo(unsigned w) { return __uint_as_float(w << 16); }
__device__ __forceinline__ float bfhi(unsigned w) { return __uint_as_float(w & 0xffff0000u); }
__device__ __forceinline__ int lane_id() { int l; asm volatile("v_mbcnt_lo_u32_b32 %0, -1, 0\n\tv_mbcnt_hi_u32_b32 %0, -1, %0" : "=v"(l)); return l; }
template <int M> __device__ __forceinline__ float sx(float v) {
    const int i = __float_as_int(v);
    if constexpr (M == 1) return __int_as_float(__builtin_amdgcn_mov_dpp(i, 0xB1, 0xF, 0xF, true));
    else if constexpr (M == 2) return __int_as_float(__builtin_amdgcn_mov_dpp(i, 0x4E, 0xF, 0xF, true));
    else if constexpr (M == 4) return __int_as_float(__builtin_amdgcn_ds_swizzle(i, 0x101F));
    else if constexpr (M == 8) return __int_as_float(__builtin_amdgcn_ds_swizzle(i, 0x201F));
    else if constexpr (M == 16) return __int_as_float(__builtin_amdgcn_ds_swizzle(i, 0x401F));
    else { static_assert(M == 1, "sx: mask"); return v; }
}
__device__ __forceinline__ float sx16p(float v, bool odd_row) {
    auto rr = __builtin_amdgcn_permlane16_swap(__float_as_uint(v), __float_as_uint(v), false, false);
    return __uint_as_float(odd_row ? rr[0] : rr[1]);
}
__device__ __forceinline__ float sx32(float v, bool upper) {
    auto rr = __builtin_amdgcn_permlane32_swap(__float_as_uint(v), __float_as_uint(v), false, false);
    return __uint_as_float(upper ? rr[0] : rr[1]);
}
__device__ __forceinline__ float bperm(float v, int src_lane) { return __int_as_float(__builtin_amdgcn_ds_bpermute(src_lane << 2, __float_as_int(v))); }
__device__ __forceinline__ float rdlane(float v, int l) { return __int_as_float(__builtin_amdgcn_readlane(__float_as_int(v), l)); }
__device__ __forceinline__ float wave_sum(float v) {
    v += sx<1>(v); v += sx<2>(v); v += sx<4>(v); v += sx<8>(v); v += sx<16>(v);
    { auto rr = __builtin_amdgcn_permlane32_swap(__float_as_uint(v), __float_as_uint(v), false, false); v = __uint_as_float(rr[0]) + __uint_as_float(rr[1]); }
    return v;
}
__device__ __forceinline__ float wave_max(float v) {
    v = fmaxf(v, sx<1>(v)); v = fmaxf(v, sx<2>(v)); v = fmaxf(v, sx<4>(v)); v = fmaxf(v, sx<8>(v)); v = fmaxf(v, sx<16>(v));
    { auto rr = __builtin_amdgcn_permlane32_swap(__float_as_uint(v), __float_as_uint(v), false, false); v = fmaxf(__uint_as_float(rr[0]), __uint_as_float(rr[1])); }
    return v;
}
__device__ __forceinline__ unsigned pack4_i8(float a, float b, float c, float d) {
    unsigned w = __builtin_amdgcn_cvt_pk_u8_f32(fminf(fmaxf(rintf(a), -127.f), 127.f) + 128.f, 0, 0u);
    w = __builtin_amdgcn_cvt_pk_u8_f32(fminf(fmaxf(rintf(b), -127.f), 127.f) + 128.f, 1, w);
    w = __builtin_amdgcn_cvt_pk_u8_f32(fminf(fmaxf(rintf(c), -127.f), 127.f) + 128.f, 2, w);
    w = __builtin_amdgcn_cvt_pk_u8_f32(fminf(fmaxf(rintf(d), -127.f), 127.f) + 128.f, 3, w);
    return w ^ 0x80808080u;
}
__device__ __forceinline__ f32x4 i2f4(f32x4 a) { return (f32x4){(float)__float_as_int(a[0]), (float)__float_as_int(a[1]), (float)__float_as_int(a[2]), (float)__float_as_int(a[3])}; }
__device__ __forceinline__ float sigmoidf_(float x) { return 1.0f / (1.0f + __expf(-x)); }

#define XB_TMO      128
#define XB_XCNT(j)  (256  + 64 * (j))
#define XB_XSUB(j)  (1280 + 64 * (j))
#define XB_XGEN(j)  (2304 + 64 * (j))
#define XB_TOP      3328
#define XB_TOPGEN   3392
#define XCD_BAR_WORDS 3456
#define XB_SPIN_CAP (1u << 18)
__device__ __forceinline__ unsigned xb_ld(unsigned* p)              { return __hip_atomic_load(p, __ATOMIC_RELAXED, __HIP_MEMORY_SCOPE_AGENT); }
__device__ __forceinline__ unsigned xb_add(unsigned* p, unsigned v) { return __hip_atomic_fetch_add(p, v, __ATOMIC_RELAXED, __HIP_MEMORY_SCOPE_AGENT); }
__device__ __forceinline__ unsigned xb_xcc_id() { return (unsigned)__builtin_amdgcn_s_getreg((3 << 11) | 20) & 0xFu; }
#define XB_SPIN(cond, bar) do { unsigned _sp = 0; while (cond) { __builtin_amdgcn_s_sleep(1); \
    if ((++_sp & 255u) == 0u) { if (xb_ld(&(bar)[XB_TMO])) break; if (_sp > XB_SPIN_CAP) { atomicAdd(&(bar)[XB_TMO], 1u); break; } } } } while (0)
struct XcdBarrier { unsigned* bar; unsigned x; volatile LAS unsigned* st; int wave; };
__device__ __forceinline__ XcdBarrier xcd_barrier_post(unsigned* bar, volatile LAS unsigned* st, int wave) {
    XcdBarrier b; b.bar = bar; b.x = xb_xcc_id(); b.st = st; b.wave = wave;
    if (wave == 0 && lane_id() == 0) st[3] = xb_add(&bar[XB_XCNT(b.x)], 1u);
    return b;
}
__device__ __forceinline__ void xcd_barrier_complete(unsigned* bar, unsigned x, unsigned& nloc, unsigned& nx, unsigned& dx) {
    const unsigned G = gridDim.x * gridDim.y * gridDim.z;
    unsigned sum, cnt, mine, below, sp = 0u;
    for (;;) {
        sum = 0u; cnt = 0u; mine = 0u; below = 0u;
#pragma unroll
        for (unsigned j = 0; j < 16; ++j) { const unsigned c = xb_ld(&bar[XB_XCNT(j)]); sum += c; cnt += (c > 0u) ? 1u : 0u; mine = (j == x) ? c : mine; below += (j < x && c > 0u) ? 1u : 0u; }
        if (sum == G) break;
        __builtin_amdgcn_s_sleep(1);
        if ((++sp & 255u) == 0u) { if (xb_ld(&bar[XB_TMO])) break; if (sp > XB_SPIN_CAP) { atomicAdd(&bar[XB_TMO], 1u); break; } }
    }
    nloc = mine > 0u ? mine : 1u; nx = cnt > 0u ? cnt : 1u; dx = below;
}
__device__ __forceinline__ void xcd_barrier(const XcdBarrier& b) {
    asm volatile("s_waitcnt vmcnt(0)" ::: "memory");
    __syncthreads();
    if (b.wave == 0 && lane_id() == 0) {
        unsigned* bar = b.bar;
        __builtin_amdgcn_s_waitcnt(0);
        unsigned nloc = b.st[0], nx = b.st[1];
        if (nloc == 0u) { unsigned dx; xcd_barrier_complete(bar, b.x, nloc, nx, dx); b.st[0] = nloc; b.st[1] = nx; b.st[2] = dx; }
        const unsigned old = xb_add(&bar[XB_XSUB(b.x)], 1u);
        const unsigned gen = old / nloc;
        if (old + 1u == (gen + 1u) * nloc) {
            __builtin_amdgcn_fence(__ATOMIC_RELEASE, "agent");
            asm volatile("s_waitcnt vmcnt(0)" ::: "memory");
            const unsigned og = xb_add(&bar[XB_TOP], 1u);
            const unsigned target = (og / nx + 1u) * nx;
            if (og + 1u != target) XB_SPIN(xb_ld(&bar[XB_TOP]) < target, bar);
            __builtin_amdgcn_fence(__ATOMIC_ACQUIRE, "agent");
            xb_add(&bar[XB_XGEN(b.x)], 1u);
            asm volatile("s_waitcnt vmcnt(0)" ::: "memory");
        } else {
            XB_SPIN(xb_ld(&bar[XB_XGEN(b.x)]) == gen, bar);
            __builtin_amdgcn_fence(__ATOMIC_ACQUIRE, "agent");
            asm volatile("s_waitcnt vmcnt(0)" ::: "memory");
        }
    }
    __syncthreads();
}

namespace pg8 {
constexpr int BM = 256, BK = 64, HALF = 128, HTB = HALF * BK * 2, STAGE_BYTES = 8 * HTB, NXCD = 8, WGM = 8;
__device__ __forceinline__ int lds_byte(int r, int c) { const int st = (r >> 4) * 2 + (c >> 5), rr = r & 15, cc = c & 31, ob = rr * 64 + cc * 2; return st * 1024 + (ob ^ (((ob >> 9) & 1) << 5)); }
__device__ __forceinline__ void stage_rc(int b, int& R, int& C) { const int st = b / 1024, sb = b % 1024, swz = sb ^ (((sb >> 9) & 1) << 5); R = (st >> 1) * 16 + swz / 64; C = (st & 1) * 32 + (swz % 64) / 2; }
__device__ __forceinline__ int perm32(int rho) { const int n = rho >> 4, i = rho & 15; return 8 * (i >> 2) + 4 * n + (i & 3); }

struct Unit { int pm, pn, e; };

struct StaticOrder {
    static constexpr bool SIGNAL = false;
    int nM, nN, nwg, G, c;
    __device__ void init(int M, int N, int G_, int c_) { nM = M / BM; nN = N / BM; nwg = nM * nN; G = G_; c = c_; }
    __device__ __forceinline__ bool next(int i, Unit& u) const {
        const long L = (long)i * G + c; if (L >= nwg) return false;
        int wgid = (int)L; { const int q = nwg / NXCD, r = nwg % NXCD, xcd = wgid % NXCD, off = wgid / NXCD; wgid = (xcd < r ? xcd * (q + 1) : r * (q + 1) + (xcd - r) * q) + off; }
        const int nig = WGM * nN, gid = wgid / nig, fm = gid * WGM, gsz = (nM - fm) < WGM ? (nM - fm) : WGM;
        u.pm = __builtin_amdgcn_readfirstlane(fm + ((wgid % nig) % gsz)); u.pn = __builtin_amdgcn_readfirstlane((wgid % nig) / gsz); u.e = 0; return true;
    }
};
struct XcdOrder {
    static constexpr bool SIGNAL = true;
    int nx, dx, per, j, nM, nN; unsigned* flags;
    __device__ __forceinline__ bool next(int i, Unit& u) const {
        const int tlo = (dx * nM) / nx, thi = ((dx + 1) * nM) / nx, n = (thi - tlo) * nN;
        const int q = j + i * per; if (q >= n) return false;
        u.pm = __builtin_amdgcn_readfirstlane(tlo + q / nN); u.pn = __builtin_amdgcn_readfirstlane(q % nN); u.e = 0; return true;
    }
    __device__ __forceinline__ void signal(const Unit& u, int lane) const { asm volatile("s_waitcnt vmcnt(0)" ::: "memory"); if (lane == 0) (void)xb_add(flags + u.pm, 1u); }
};
template <bool WAIT>
struct MoeOrderT {
    static constexpr bool SIGNAL = false;
    int nx, dx, per, j, ntiles; const LAS int* ts; unsigned* flags;
    __device__ __forceinline__ bool next(int i, Unit& u) const {
        const int tlo = (dx * ntiles) / nx, thi = ((dx + 1) * ntiles) / nx, n = 4 * (thi - tlo);
        int jj = j; if (WAIT) { jj = j - (n % per); if (jj < 0) jj += per; }
        const int q = jj + i * per; if (q >= n) return false;
        const int tile = tlo + (q >> 2), pn = q & 3;
        int e = 0;
#pragma unroll
        for (int k = 1; k < 16; ++k) e += (tile >= ts[k]) ? 1 : 0;
        u.pm = __builtin_amdgcn_readfirstlane(tile); u.pn = __builtin_amdgcn_readfirstlane(pn); u.e = __builtin_amdgcn_readfirstlane(e);
        if (WAIT) { unsigned sp = 0u;
            while (xb_ld(flags + u.pm) < 32u) { __builtin_amdgcn_s_sleep(2); if (++sp > (1u << 22)) break; }
            asm volatile("" ::: "memory"); }
        return true;
    }
};
typedef MoeOrderT<false> MoeOrder;
typedef MoeOrderT<true> MoeOrderWait;

struct EpiBf16 {
    static constexpr bool PERM = true, HP = false, SIGNAL = false;
    bf16_t* O; int ldc; int s_lo, s_hi; float scale; float base;
    __device__ __forceinline__ void operator()(const f32x4 (&acc)[2][2][4][2], const Unit& u, int wr, int wc, int fr, int fq) const {
        const int row0 = u.pm * BM + wr * 64 + fr; const int col0 = u.pn * BM + wc * 32 + 8 * fq;
        const float sc = ((u.pn >= s_lo && u.pn < s_hi) ? scale : 1.0f) * base;
#pragma unroll
        for (int ai = 0; ai < 2; ++ai)
#pragma unroll
            for (int m = 0; m < 4; ++m) { bf16_t* rowp = O + (size_t)(row0 + ai * HALF + m * 16) * ldc + col0;
#pragma unroll
                for (int bj = 0; bj < 2; ++bj) { const f32x4 v0 = acc[ai][bj][m][0] * sc, v1 = acc[ai][bj][m][1] * sc;
                    u32x4 w; w.x = cvtpk(v0[0], v0[1]); w.y = cvtpk(v0[2], v0[3]); w.z = cvtpk(v1[0], v1[1]); w.w = cvtpk(v1[2], v1[3]);
                    *(u32x4*)(rowp + bj * HALF) = w; } }
    }
};
struct EpiSwiGLU {
    static constexpr bool PERM = true;
    bf16_t* O;
    __device__ __forceinline__ void operator()(const f32x4 (&acc)[2][2][4][2], const Unit& u, int wr, int wc, int fr, int fq) const {
        const int row0 = u.pm * BM + wr * 64 + fr; const int col0 = u.pn * 128 + wc * 32 + 8 * fq;
#pragma unroll
        for (int ai = 0; ai < 2; ++ai)
#pragma unroll
            for (int m = 0; m < 4; ++m) { bf16_t* rowp = O + (size_t)(row0 + ai * HALF + m * 16) * DEXP + col0;
                float a[8];
#pragma unroll
                for (int n = 0; n < 2; ++n)
#pragma unroll
                    for (int j = 0; j < 4; ++j) { const float g = acc[ai][0][m][n][j], up = acc[ai][1][m][n][j]; a[n * 4 + j] = g * up / (1.0f + __expf(-g)); }
                u32x4 w; w.x = cvtpk(a[0], a[1]); w.y = cvtpk(a[2], a[3]); w.z = cvtpk(a[4], a[5]); w.w = cvtpk(a[6], a[7]);
                *(u32x4*)rowp = w; }
    }
};
struct EpiResid {
    static constexpr bool PERM = false;
    const float* base; float* out; const float* gate;
    __device__ __forceinline__ void operator()(const f32x4 (&acc)[2][2][4][2], const Unit& u, int wr, int wc, int fr, int fq) const {
        const int row0 = u.pm * BM + wr * 64 + fr, col0 = u.pn * BM + wc * 32 + 4 * fq;
        const int b = (u.pm * BM) / SEQ;
        f32x4 gv[2][2];
#pragma unroll
        for (int bj = 0; bj < 2; ++bj)
#pragma unroll
            for (int n = 0; n < 2; ++n) gv[bj][n] = *(const f32x4*)(gate + (size_t)b * 6144 + col0 + bj * HALF + n * 16);
#pragma unroll
        for (int ai = 0; ai < 2; ++ai)
#pragma unroll
            for (int m = 0; m < 4; ++m) { const size_t off = (size_t)(row0 + ai * HALF + m * 16) * DM + col0;
#pragma unroll
                for (int bj = 0; bj < 2; ++bj)
#pragma unroll
                    for (int n = 0; n < 2; ++n) { const f32x4 bs = *(const f32x4*)(base + off + bj * HALF + n * 16);
                        *(f32x4*)(out + off + bj * HALF + n * 16) = bs + gv[bj][n] * acc[ai][bj][m][n]; }
                asm volatile("" ::: "memory"); }
    }
};

struct EpiProjI8 {
    static constexpr bool PERM = true, HP = false;
    bf16_t* O; const float* ra; const float* cw; float kscale;
    __device__ __forceinline__ void operator()(const f32x4 (&acc)[2][2][4][2], const Unit& u, int wr, int wc, int fr, int fq) const {
        const int row0 = u.pm * BM + wr * 64 + fr; const int col0 = u.pn * BM + wc * 32 + 8 * fq;
        const float ks = (u.pn >= 2 && u.pn < 4) ? kscale : 1.0f;
        f32x4 c0[2], c1[2];
#pragma unroll
        for (int bj = 0; bj < 2; ++bj) { c0[bj] = *(const f32x4*)(cw + col0 + bj * HALF) * ks; c1[bj] = *(const f32x4*)(cw + col0 + bj * HALF + 4) * ks; }
#pragma unroll
        for (int ai = 0; ai < 2; ++ai)
#pragma unroll
            for (int m = 0; m < 4; ++m) { const int row = row0 + ai * HALF + m * 16; const float rs = ra[row]; bf16_t* rowp = O + (size_t)row * 3072 + col0;
#pragma unroll
                for (int bj = 0; bj < 2; ++bj) { const f32x4 v0 = i2f4(acc[ai][bj][m][0]) * c0[bj] * rs, v1 = i2f4(acc[ai][bj][m][1]) * c1[bj] * rs;
                    u32x4 w; w.x = cvtpk(v0[0], v0[1]); w.y = cvtpk(v0[2], v0[3]); w.z = cvtpk(v1[0], v1[1]); w.w = cvtpk(v1[2], v1[3]);
                    *(u32x4*)(rowp + bj * HALF) = w; } }
    }
};
struct EpiFp8 {
    static constexpr bool PERM = true, HP = false, SIGNAL = false;
    unsigned char* O; int ldc; float scale;
    __device__ __forceinline__ void operator()(const f32x4 (&acc)[2][2][4][2], const Unit& u, int wr, int wc, int fr, int fq) const {
        const int row0 = u.pm * BM + wr * 64 + fr; const int col0 = u.pn * BM + wc * 32 + 8 * fq;
#pragma unroll
        for (int ai = 0; ai < 2; ++ai)
#pragma unroll
            for (int m = 0; m < 4; ++m) { unsigned char* rowp = O + (size_t)(row0 + ai * HALF + m * 16) * ldc + col0;
#pragma unroll
                for (int bj = 0; bj < 2; ++bj) { const f32x4 v0 = acc[ai][bj][m][0] * scale, v1 = acc[ai][bj][m][1] * scale;
                    u32x2 w; w.x = cvt4_fp8(v0[0], v0[1], v0[2], v0[3]); w.y = cvt4_fp8(v1[0], v1[1], v1[2], v1[3]);
                    *(u32x2*)(rowp + bj * HALF) = w; } }
    }
};
struct EpiQKV {
    static constexpr bool PERM = true, HP = true, SIGNAL = false;
    bf16_t* O; const float* qn; const float* kn; const float* cs; float descale;
    __device__ __forceinline__ void operator()(const f32x4 (&acc)[2][2][4][2], const Unit& u, int wr, int wc, int fr, int fq) const {
        const int row0 = u.pm * BM + wr * 64 + fr; const int col0 = u.pn * BM + wc * 64 + 8 * fq;
        const bool isqk = u.pn < 8; const bool odd = (fq & 1) != 0;
        float w[2][2][4];
        if (isqk) { const float* nw = (u.pn < 4) ? qn : kn;
#pragma unroll
            for (int bj = 0; bj < 2; ++bj)
#pragma unroll
                for (int n = 0; n < 2; ++n) { const f32x4 t = *(const f32x4*)(nw + 32 * bj + 8 * fq + 4 * n); w[bj][n][0] = t[0]; w[bj][n][1] = t[1]; w[bj][n][2] = t[2]; w[bj][n][3] = t[3]; } }
        const float qs = (u.pn < 4) ? 0.125f * 1.4426950408889634f : 1.0f;
#pragma unroll
        for (int ai = 0; ai < 2; ++ai)
#pragma unroll
            for (int m = 0; m < 4; ++m) { const int row = row0 + ai * HALF + m * 16; bf16_t* rowp = O + (size_t)row * 3072 + col0;
                float v[2][2][4];
#pragma unroll
                for (int bj = 0; bj < 2; ++bj)
#pragma unroll
                    for (int n = 0; n < 2; ++n)
#pragma unroll
                        for (int j = 0; j < 4; ++j) v[bj][n][j] = acc[ai][bj][m][n][j] * descale;
                if (isqk) {
                    float ss = 0.f;
#pragma unroll
                    for (int bj = 0; bj < 2; ++bj)
#pragma unroll
                        for (int n = 0; n < 2; ++n)
#pragma unroll
                            for (int j = 0; j < 4; ++j) ss += v[bj][n][j] * v[bj][n][j];
                    ss += sx16p(ss, odd);
                    { auto rr = __builtin_amdgcn_permlane32_swap(__float_as_uint(ss), __float_as_uint(ss), false, false); ss = __uint_as_float(rr[0]) + __uint_as_float(rr[1]); }
                    const float rn = 1.0f / sqrtf(ss * (1.0f / 64.0f) + EPS);
#pragma unroll
                    for (int bj = 0; bj < 2; ++bj)
#pragma unroll
                        for (int n = 0; n < 2; ++n)
#pragma unroll
                            for (int j = 0; j < 4; ++j) v[bj][n][j] = v[bj][n][j] * rn * w[bj][n][j];
                    const f32x4 c0 = *(const f32x4*)(cs + (size_t)row * 16), c1 = *(const f32x4*)(cs + (size_t)row * 16 + 4), s0 = *(const f32x4*)(cs + (size_t)row * 16 + 8), s1 = *(const f32x4*)(cs + (size_t)row * 16 + 12);
#pragma unroll
                    for (int n = 0; n < 2; ++n)
#pragma unroll
                        for (int j = 0; j < 4; ++j) { const float x = v[0][n][j]; const float pr = sx16p(x, odd); const float c = n ? c1[j] : c0[j], sn = n ? s1[j] : s0[j];
                            const float r0 = x * c - pr * sn, r1 = x * c + pr * sn; v[0][n][j] = (fq == 0) ? r0 : (fq == 1) ? r1 : x; }
#pragma unroll
                    for (int bj = 0; bj < 2; ++bj)
#pragma unroll
                        for (int n = 0; n < 2; ++n)
#pragma unroll
                            for (int j = 0; j < 4; ++j) v[bj][n][j] *= qs;
                }
#pragma unroll
                for (int bj = 0; bj < 2; ++bj) { u32x4 wv; wv.x = cvtpk(v[bj][0][0], v[bj][0][1]); wv.y = cvtpk(v[bj][0][2], v[bj][0][3]); wv.z = cvtpk(v[bj][1][0], v[bj][1][1]); wv.w = cvtpk(v[bj][1][2], v[bj][1][3]);
                    *(u32x4*)(rowp + 32 * bj) = wv; } }
    }
};
template <bool BASE_F32, bool I8 = false, bool STATIC_A = false> struct EpiResidB {
    static constexpr bool PERM = true, HP = false, SIGNAL = false;
    const void* base; bf16_t* out; const float* gate; float descale; const float* sc;
    __device__ __forceinline__ void operator()(const f32x4 (&acc)[2][2][4][2], const Unit& u, int wr, int wc, int fr, int fq) const {
        const int row0 = u.pm * BM + wr * 64 + fr, col0 = u.pn * BM + wc * 32 + 8 * fq;
        const int b = (u.pm * BM) / SEQ;
        const float* ra = sc + (SC_RS_A - WS_SCALES) / 4; const float* cw = sc + (SC_CW - WS_SCALES) / 4 + (STATIC_A ? CW_BOUT : CW_AOUT);
        f32x4 gv[2][2];
#pragma unroll
        for (int bj = 0; bj < 2; ++bj)
#pragma unroll
            for (int n = 0; n < 2; ++n) { gv[bj][n] = *(const f32x4*)(gate + (size_t)b * 6144 + col0 + bj * HALF + n * 4); if (!I8) gv[bj][n] = gv[bj][n] * descale; if (I8) gv[bj][n] = gv[bj][n] * *(const f32x4*)(cw + col0 + bj * HALF + n * 4); }
#pragma unroll
        for (int ai = 0; ai < 2; ++ai)
#pragma unroll
            for (int m = 0; m < 4; ++m) { const size_t off = (size_t)(row0 + ai * HALF + m * 16) * DM + col0; const float rs = !I8 ? 1.0f : STATIC_A ? descale : ra[row0 + ai * HALF + m * 16];
#pragma unroll
                for (int bj = 0; bj < 2; ++bj) { f32x4 b0, b1;
                    if (BASE_F32) { b0 = *(const f32x4*)((const float*)base + off + bj * HALF); b1 = *(const f32x4*)((const float*)base + off + bj * HALF + 4); }
                    else { const u32x4 r = *(const u32x4*)((const bf16_t*)base + off + bj * HALF); b0 = (f32x4){bflo(r.x), bfhi(r.x), bflo(r.y), bfhi(r.y)}; b1 = (f32x4){bflo(r.z), bfhi(r.z), bflo(r.w), bfhi(r.w)}; }
                    const f32x4 a0 = I8 ? i2f4(acc[ai][bj][m][0]) * rs : acc[ai][bj][m][0], a1 = I8 ? i2f4(acc[ai][bj][m][1]) * rs : acc[ai][bj][m][1];
                    const f32x4 v0 = b0 + gv[bj][0] * a0, v1 = b1 + gv[bj][1] * a1;
                    u32x4 w; w.x = cvtpk(v0[0], v0[1]); w.y = cvtpk(v0[2], v0[3]); w.z = cvtpk(v1[0], v1[1]); w.w = cvtpk(v1[2], v1[3]);
                    *(u32x4*)(out + off + bj * HALF) = w; }
                asm volatile("" ::: "memory"); }
    }
};
template <class Epi, class Sched, bool GATHER, bool I8 = false>
__device__ __forceinline__ void gemm_phase(LAS unsigned char* lds, int wv, const bf16_t* A, const bf16_t* Bt, size_t bstride, int K, const Sched& S, const Epi& E, const int* aidx) {
    int tid = wv * 64 + lane_id(); asm volatile("" : "+v"(tid));
    const int wid = wv, lane = tid & 63, wr = wid >> 2, wc = wid & 3, fr = lane & 15, fq = lane >> 4;
    const int nt = K / BK;
    int RA[2], CA[2]; unsigned voffB[2];
#pragma unroll
    for (int i = 0; i < 2; ++i) { int R, C; stage_rc(tid * 16 + i * 8192, R, C); const int Rb = Epi::PERM ? ((R & ~31) + perm32(R & 31)) : R;
        RA[i] = R; CA[i] = C; voffB[i] = (unsigned)(Rb * K + C) * 2u; }
    const size_t kstep = (size_t)(BK * 2);
    const size_t hstep = (size_t)HALF * K * 2;
    const size_t tstep = 2 * hstep;
    const unsigned ldsw = (unsigned)wid * 1024u;
    const int aoff = lds_byte(wr * 64 + fr, fq * 8), boff = lds_byte(wc * 32 + fr, fq * 8);
#define PG8_SA(b, h) (((b) * 2 + (h)) * HTB)
#define PG8_SB(b, h) ((4 + (b) * 2 + (h)) * HTB)
#define PG8_STAGE(bufoff, gbase, voff) do { _Pragma("unroll") for (int _i = 0; _i < 2; ++_i) \
        __builtin_amdgcn_global_load_lds((const unsigned*)((const char*)(gbase) + (voff)[_i]), (LAS unsigned*)(lds + (bufoff) + ldsw + _i * 8192), 16, 0, 0); } while (0)
#define PG8_LDA(dst, b, h) do { _Pragma("unroll") for (int m = 0; m < 4; ++m) _Pragma("unroll") for (int k = 0; k < 2; ++k) dst[m][k] = *(const LAS bf16x8*)(lds + PG8_SA(b, h) + aoff + m * 2048 + k * 1024); } while (0)
#define PG8_LDB(dst, b, h) do { _Pragma("unroll") for (int n = 0; n < 2; ++n) _Pragma("unroll") for (int k = 0; k < 2; ++k) dst[n][k] = *(const LAS bf16x8*)(lds + PG8_SB(b, h) + boff + n * 2048 + k * 1024); } while (0)
#define PG8_MMA(ai, bj, At, Bt_) do { __builtin_amdgcn_s_setprio(1); _Pragma("unroll") for (int m = 0; m < 4; ++m) _Pragma("unroll") for (int n = 0; n < 2; ++n) _Pragma("unroll") for (int k = 0; k < 2; ++k) { \
        if constexpr (I8) acc[ai][bj][m][n] = __builtin_bit_cast(f32x4, __builtin_amdgcn_mfma_i32_16x16x64_i8(__builtin_bit_cast(i32x4, Bt_[n][k]), __builtin_bit_cast(i32x4, At[m][k]), __builtin_bit_cast(i32x4, acc[ai][bj][m][n]), 0, 0, 0)); \
        else acc[ai][bj][m][n] = __builtin_amdgcn_mfma_f32_16x16x32_bf16(Bt_[n][k], At[m][k], acc[ai][bj][m][n], 0, 0, 0); } __builtin_amdgcn_s_setprio(0); } while (0)
#define PG8_WAIT_V(n) asm volatile("s_waitcnt vmcnt(" #n ")" ::: "memory")
#define PG8_WAIT_L(n) asm volatile("s_waitcnt lgkmcnt(" #n ")" ::: "memory")
#define PG8_BAR __builtin_amdgcn_s_barrier()
#define PG8_SCHED __builtin_amdgcn_sched_barrier(0)
#define PG8_AOFF(dst, U) do { _Pragma("unroll") for (int _h = 0; _h < 2; ++_h) _Pragma("unroll") for (int _i = 0; _i < 2; ++_i) { \
        const int _row = (U).pm * BM + _h * HALF + RA[_i]; const int _src = GATHER ? aidx[_row] : _row; dst[_h][_i] = (unsigned)(_src * K + CA[_i]) * 2u; } } while (0)
#define PG8_STAGE_A(bufoff, kb, offs, h) do { _Pragma("unroll") for (int _i = 0; _i < 2; ++_i) \
        __builtin_amdgcn_global_load_lds((const unsigned*)((const char*)A + (kb) + (offs)[h][_i]), (LAS unsigned*)(lds + (bufoff) + ldsw + _i * 8192), 16, 0, 0); } while (0)
    Unit cur, nxt; int ui = 0;
    if (!S.next(0, cur)) return;
    f32x4 acc[2][2][4][2];
#pragma unroll
    for (int a = 0; a < 2; ++a)
#pragma unroll
        for (int b = 0; b < 2; ++b)
#pragma unroll
            for (int m = 0; m < 4; ++m)
#pragma unroll
                for (int n = 0; n < 2; ++n) acc[a][b][m][n] = (f32x4){0.f, 0.f, 0.f, 0.f};
    bf16x8 At[4][2], B0[2][2], B1[2][2];
    unsigned ac[2][2], an[2][2];
    PG8_AOFF(ac, cur);
    const char* cB = (const char*)Bt + ((size_t)cur.e * bstride) * 2 + (size_t)cur.pn * tstep;
    PG8_STAGE(PG8_SB(0, 0), cB, voffB); PG8_STAGE(PG8_SB(0, 1), cB + hstep, voffB); PG8_STAGE_A(PG8_SA(0, 0), 0, ac, 0); PG8_STAGE_A(PG8_SA(0, 1), 0, ac, 1);
    if (wr == 1) PG8_BAR;
    PG8_WAIT_V(2); PG8_BAR;
    PG8_STAGE(PG8_SB(1, 0), cB + kstep, voffB); PG8_STAGE_A(PG8_SA(1, 0), kstep, ac, 0); PG8_STAGE(PG8_SB(1, 1), cB + hstep + kstep, voffB);
    PG8_WAIT_V(6); PG8_BAR;
    for (;;) {
        const bool has_next = S.next(ui + 1, nxt);
        if (has_next) { PG8_AOFF(an, nxt); } else {
#pragma unroll
            for (int h = 0; h < 2; ++h)
#pragma unroll
                for (int i = 0; i < 2; ++i) an[h][i] = ac[h][i]; }
        const char* nB = has_next ? (const char*)Bt + ((size_t)nxt.e * bstride) * 2 + (size_t)nxt.pn * tstep : cB;
#pragma unroll 1
        for (int t = 0; t < nt; t += 2) {
            const bool last = (t == nt - 2);
            const size_t k1 = (size_t)(t + 1) * kstep;
            const size_t k2 = last ? 0 : (size_t)(t + 2) * kstep;
            const size_t k3 = k2 + kstep;
            const char* b2 = last ? nB : cB + (size_t)(t + 2) * kstep; const char* b3 = b2 + kstep;
            unsigned a2[2][2];
#pragma unroll
            for (int h = 0; h < 2; ++h)
#pragma unroll
                for (int i = 0; i < 2; ++i) a2[h][i] = last ? an[h][i] : ac[h][i];
            PG8_LDB(B0, 0, 0); PG8_LDB(B1, 0, 1); PG8_SCHED; PG8_LDA(At, 0, 0); PG8_STAGE_A(PG8_SA(1, 1), k1, ac, 1);
            PG8_WAIT_V(8); PG8_WAIT_L(0); PG8_BAR; PG8_MMA(0, 0, At, B0); PG8_MMA(0, 1, At, B1); PG8_BAR; PG8_SCHED;
            PG8_LDA(At, 0, 1); PG8_STAGE(PG8_SB(0, 0), b2, voffB); PG8_STAGE(PG8_SB(0, 1), b2 + hstep, voffB); PG8_STAGE_A(PG8_SA(0, 0), k2, a2, 0);
            PG8_WAIT_V(8); PG8_WAIT_L(0); PG8_BAR; PG8_MMA(1, 0, At, B0); PG8_MMA(1, 1, At, B1); PG8_BAR; PG8_SCHED;
            PG8_LDB(B0, 1, 0); PG8_LDB(B1, 1, 1); PG8_SCHED; PG8_LDA(At, 1, 0); PG8_STAGE_A(PG8_SA(0, 1), k2, a2, 1);
            PG8_WAIT_V(8); PG8_WAIT_L(0); PG8_BAR; PG8_MMA(0, 0, At, B0); PG8_MMA(0, 1, At, B1); PG8_BAR; PG8_SCHED;
            PG8_LDA(At, 1, 1); PG8_STAGE(PG8_SB(1, 0), b3, voffB); PG8_STAGE(PG8_SB(1, 1), b3 + hstep, voffB); PG8_STAGE_A(PG8_SA(1, 0), k3, a2, 0);
            PG8_WAIT_V(8); PG8_WAIT_L(0); PG8_BAR; PG8_MMA(1, 0, At, B0); PG8_MMA(1, 1, At, B1); PG8_BAR; PG8_SCHED;
        }
        if (wr == 0) PG8_BAR;
        E(acc, cur, wr, wc, fr, fq);
        if constexpr (Sched::SIGNAL) S.signal(cur, lane);
        if (!has_next) break;
#pragma unroll
        for (int a = 0; a < 2; ++a)
#pragma unroll
            for (int b = 0; b < 2; ++b)
#pragma unroll
                for (int m = 0; m < 4; ++m)
#pragma unroll
                    for (int n = 0; n < 2; ++n) acc[a][b][m][n] = (f32x4){0.f, 0.f, 0.f, 0.f};
        cur = nxt; cB = nB; ++ui;
#pragma unroll
        for (int h = 0; h < 2; ++h)
#pragma unroll
            for (int i = 0; i < 2; ++i) ac[h][i] = an[h][i];
        if (wr == 1) PG8_BAR;
    }
    PG8_WAIT_V(0);
    PG8_BAR;
#undef PG8_SA
#undef PG8_SB
#undef PG8_STAGE
#undef PG8_LDA
#undef PG8_LDB
#undef PG8_MMA
#undef PG8_WAIT_V
#undef PG8_WAIT_L
#undef PG8_BAR
#undef PG8_SCHED
#undef PG8_AOFF
#undef PG8_STAGE_A
}

__device__ __forceinline__ int x8(int e) { return e ^ ((((e >> 1) ^ (e >> 2)) & 1) << 1); }
struct EpiSwiGLU8 {
    static constexpr bool PERM = true, HP = false, SIGNAL = true;
    unsigned char* O; float descale; unsigned* flags;
    __device__ __forceinline__ void operator()(const f32x4 (&acc)[2][2][4][2], const Unit& u, int wr, int wc, int fr, int fq) const {
        const int row0 = u.pm * BM + wr * 64 + fr; const int col0 = u.pn * 128 + wc * 32 + 8 * fq;
#pragma unroll
        for (int ai = 0; ai < 2; ++ai)
#pragma unroll
            for (int m = 0; m < 4; ++m) { unsigned char* rowp = O + (size_t)(row0 + ai * HALF + m * 16) * DEXP + col0;
                float a[8];
#pragma unroll
                for (int n = 0; n < 2; ++n)
#pragma unroll
                    for (int j = 0; j < 4; ++j) { const float g = acc[ai][0][m][n][j] * descale, up = acc[ai][1][m][n][j] * descale; a[n * 4 + j] = S8_ACT * g * up / (1.0f + __expf(-g)); }
                u32x2 w; w.x = cvt4_fp8(a[0], a[1], a[2], a[3]); w.y = cvt4_fp8(a[4], a[5], a[6], a[7]);
                *(u32x2*)rowp = w; }
    }
};
template <class Epi, class Sched, bool GATHER>
__device__ __forceinline__ void gemm_phase8(LAS unsigned char* lds, int wv, const unsigned char* A, const unsigned char* Bt, size_t bstride, int Kb, const Sched& S, const Epi& E, const int* aidx) {
    int tid = wv * 64 + lane_id(); asm volatile("" : "+v"(tid));
    const int wid = wv, lane = tid & 63, wr = wid >> 2, wc = wid & 3, fr = lane & 15, fq = lane >> 4;
    const int nt = Kb / 128;
    int RA[2], CA[2]; unsigned voffB[2], voffB1[2];
#pragma unroll
    for (int i = 0; i < 2; ++i) { const int b = tid * 16 + i * 8192; const int R = b >> 7, pc = (b >> 4) & 7; const int C = (pc ^ x8((R >> 1) & 7)) * 16;
        const int Rb = Epi::PERM ? ((R & ~31) + perm32(R & 31)) : R;
        RA[i] = R; CA[i] = C;
        if (Epi::HP) { const int g0 = 64 * (R >> 5) + perm32(R & 31); voffB[i] = (unsigned)(g0 * Kb + C); voffB1[i] = (unsigned)((g0 + 32) * Kb + C); }
        else { voffB[i] = (unsigned)(Rb * Kb + C); voffB1[i] = voffB[i] + (unsigned)(HALF * Kb); } }
    const size_t kstep = 128;
    const size_t hstep = (size_t)HALF * Kb;
    const size_t tstep = 2 * hstep;
    const unsigned ldsw = (unsigned)wid * 1024u;
    const int xa = x8((fr >> 1) & 7);
    const int aoff = (wr * 64 + fr) * 128 + (((2 * fq) ^ xa) << 4), boff = (wc * 32 + fr) * 128 + (((2 * fq) ^ xa) << 4);
    const int aoff1 = aoff ^ 16, boff1 = boff ^ 16;
#define PG8_SA(b, h) (((b) * 2 + (h)) * HTB)
#define PG8_SB(b, h) ((4 + (b) * 2 + (h)) * HTB)
#define PG8_STAGE(bufoff, gbase, voff) do { _Pragma("unroll") for (int _i = 0; _i < 2; ++_i) \
        __builtin_amdgcn_global_load_lds((const unsigned*)((const char*)(gbase) + (voff)[_i]), (LAS unsigned*)(lds + (bufoff) + ldsw + _i * 8192), 16, 0, 0); } while (0)
#define PG8_RD32(dst, off, off1) do { const u32x4 _lo = *(const LAS u32x4*)(lds + (off)), _hi = *(const LAS u32x4*)(lds + (off1)); \
        dst = (i32x8){(int)_lo.x, (int)_lo.y, (int)_lo.z, (int)_lo.w, (int)_hi.x, (int)_hi.y, (int)_hi.z, (int)_hi.w}; } while (0)
#define PG8_LDA(dst, b, h) do { _Pragma("unroll") for (int m = 0; m < 4; ++m) PG8_RD32(dst[m], PG8_SA(b, h) + aoff + m * 2048, PG8_SA(b, h) + aoff1 + m * 2048); } while (0)
#define PG8_LDB(dst, b, h) do { _Pragma("unroll") for (int n = 0; n < 2; ++n) PG8_RD32(dst[n], PG8_SB(b, h) + boff + n * 2048, PG8_SB(b, h) + boff1 + n * 2048); } while (0)
#define PG8_MMA(ai, bj, At, Bt_) do { __builtin_amdgcn_s_setprio(1); _Pragma("unroll") for (int m = 0; m < 4; ++m) _Pragma("unroll") for (int n = 0; n < 2; ++n) \
        asm volatile("v_mfma_scale_f32_16x16x128_f8f6f4 %0, %1, %2, %0, %3, %3 op_sel_hi:[0,0,0]" : "+v"(acc[ai][bj][m][n]) : "v"(Bt_[n]), "v"(At[m]), "v"(sc1)); __builtin_amdgcn_s_setprio(0); } while (0)
#define PG8_WAIT_V(n) asm volatile("s_waitcnt vmcnt(" #n ")" ::: "memory")
#define PG8_WAIT_L(n) asm volatile("s_waitcnt lgkmcnt(" #n ")" ::: "memory")
#define PG8_BAR __builtin_amdgcn_s_barrier()
#define PG8_SCHED __builtin_amdgcn_sched_barrier(0)
#define PG8_AOFF(dst, U) do { _Pragma("unroll") for (int _h = 0; _h < 2; ++_h) _Pragma("unroll") for (int _i = 0; _i < 2; ++_i) { \
        const int _row = (U).pm * BM + _h * HALF + RA[_i]; const int _src = GATHER ? aidx[_row] : _row; dst[_h][_i] = (unsigned)(_src * Kb + CA[_i]); } } while (0)
#define PG8_STAGE_A(bufoff, kb, offs, h) do { _Pragma("unroll") for (int _i = 0; _i < 2; ++_i) \
        __builtin_amdgcn_global_load_lds((const unsigned*)((const char*)A + (kb) + (offs)[h][_i]), (LAS unsigned*)(lds + (bufoff) + ldsw + _i * 8192), 16, 0, 0); } while (0)
    Unit cur, nxt; int ui = 0;
    if (!S.next(0, cur)) return;
    f32x4 acc[2][2][4][2];
#pragma unroll
    for (int a = 0; a < 2; ++a)
#pragma unroll
        for (int b = 0; b < 2; ++b)
#pragma unroll
            for (int m = 0; m < 4; ++m)
#pragma unroll
                for (int n = 0; n < 2; ++n) acc[a][b][m][n] = (f32x4){0.f, 0.f, 0.f, 0.f};
    i32x8 At[4], B0[2], B1[2];
    int sc1 = 0x7F7F7F7F; asm volatile("" : "+v"(sc1));
    unsigned ac[2][2], an[2][2];
    PG8_AOFF(ac, cur);
    const char* cB = (const char*)Bt + (size_t)cur.e * bstride + (size_t)cur.pn * tstep;
    PG8_STAGE(PG8_SB(0, 0), cB, voffB); PG8_STAGE(PG8_SB(0, 1), cB, voffB1); PG8_STAGE_A(PG8_SA(0, 0), 0, ac, 0); PG8_STAGE_A(PG8_SA(0, 1), 0, ac, 1);
    if (wr == 1) PG8_BAR;
    PG8_WAIT_V(2); PG8_BAR;
    PG8_STAGE(PG8_SB(1, 0), cB + kstep, voffB); PG8_STAGE_A(PG8_SA(1, 0), kstep, ac, 0); PG8_STAGE(PG8_SB(1, 1), cB + kstep, voffB1);
    PG8_WAIT_V(6); PG8_BAR;
    for (;;) {
        const bool has_next = S.next(ui + 1, nxt);
        if (has_next) { PG8_AOFF(an, nxt); } else {
#pragma unroll
            for (int h = 0; h < 2; ++h)
#pragma unroll
                for (int i = 0; i < 2; ++i) an[h][i] = ac[h][i]; }
        const char* nB = has_next ? (const char*)Bt + (size_t)nxt.e * bstride + (size_t)nxt.pn * tstep : cB;
#pragma unroll 1
        for (int t = 0; t < nt; t += 2) {
            const bool last = (t == nt - 2);
            const size_t k1 = (size_t)(t + 1) * kstep;
            const size_t k2 = last ? 0 : (size_t)(t + 2) * kstep;
            const size_t k3 = k2 + kstep;
            const char* b2 = last ? nB : cB + (size_t)(t + 2) * kstep; const char* b3 = b2 + kstep;
            unsigned a2[2][2];
#pragma unroll
            for (int h = 0; h < 2; ++h)
#pragma unroll
                for (int i = 0; i < 2; ++i) a2[h][i] = last ? an[h][i] : ac[h][i];
            PG8_LDB(B0, 0, 0); PG8_LDB(B1, 0, 1); PG8_SCHED; PG8_LDA(At, 0, 0); PG8_STAGE_A(PG8_SA(1, 1), k1, ac, 1);
            PG8_WAIT_V(8); PG8_WAIT_L(0); PG8_BAR; PG8_MMA(0, 0, At, B0); PG8_MMA(0, 1, At, B1); PG8_BAR; PG8_SCHED;
            PG8_LDA(At, 0, 1); PG8_STAGE(PG8_SB(0, 0), b2, voffB); PG8_STAGE(PG8_SB(0, 1), b2, voffB1); PG8_STAGE_A(PG8_SA(0, 0), k2, a2, 0);
            PG8_WAIT_V(8); PG8_WAIT_L(0); PG8_BAR; PG8_MMA(1, 0, At, B0); PG8_MMA(1, 1, At, B1); PG8_BAR; PG8_SCHED;
            PG8_LDB(B0, 1, 0); PG8_LDB(B1, 1, 1); PG8_SCHED; PG8_LDA(At, 1, 0); PG8_STAGE_A(PG8_SA(0, 1), k2, a2, 1);
            PG8_WAIT_V(8); PG8_WAIT_L(0); PG8_BAR; PG8_MMA(0, 0, At, B0); PG8_MMA(0, 1, At, B1); PG8_BAR; PG8_SCHED;
            PG8_LDA(At, 1, 1); PG8_STAGE(PG8_SB(1, 0), b3, voffB); PG8_STAGE(PG8_SB(1, 1), b3, voffB1); PG8_STAGE_A(PG8_SA(1, 0), k3, a2, 0);
            PG8_WAIT_V(8); PG8_WAIT_L(0); PG8_BAR; PG8_MMA(1, 0, At, B0); PG8_MMA(1, 1, At, B1); PG8_BAR; PG8_SCHED;
        }
        if (wr == 0) PG8_BAR;
        asm volatile("s_nop 15\n\ts_nop 15" ::: "memory");
        E(acc, cur, wr, wc, fr, fq);
        if constexpr (Epi::SIGNAL) { asm volatile("s_waitcnt vmcnt(0)" ::: "memory"); if (lane == 0) (void)xb_add(E.flags + cur.pm, 1u); }
        if (!has_next) break;
#pragma unroll
        for (int a = 0; a < 2; ++a)
#pragma unroll
            for (int b = 0; b < 2; ++b)
#pragma unroll
                for (int m = 0; m < 4; ++m)
#pragma unroll
                    for (int n = 0; n < 2; ++n) acc[a][b][m][n] = (f32x4){0.f, 0.f, 0.f, 0.f};
        cur = nxt; cB = nB; ++ui;
#pragma unroll
        for (int h = 0; h < 2; ++h)
#pragma unroll
            for (int i = 0; i < 2; ++i) ac[h][i] = an[h][i];
        if (wr == 1) PG8_BAR;
    }
    PG8_WAIT_V(0);
    PG8_BAR;
#undef PG8_SA
#undef PG8_SB
#undef PG8_STAGE
#undef PG8_RD32
#undef PG8_LDA
#undef PG8_LDB
#undef PG8_MMA
#undef PG8_WAIT_V
#undef PG8_WAIT_L
#undef PG8_BAR
#undef PG8_SCHED
#undef PG8_AOFF
#undef PG8_STAGE_A
}
}

namespace attn_body {
using bf16 = __hip_bfloat16;
using f32x16 = __attribute__((ext_vector_type(16))) float;
constexpr int D = 64, PQ = 3072, PO = 2048;
constexpr int NW = 8, QBLK = 32, QB = QBLK * NW, KVBLK = 64, NQB = SEQ / QB;
__device__ __forceinline__ int crow(int r, int hi) { return (r & 3) + 8 * (r >> 2) + 4 * hi; }
#define SBAR() __builtin_amdgcn_sched_barrier(0)
__device__ __forceinline__ void cmask(f32x16& p0, f32x16& p1, int jb, int qrel, int hi) {
    const float NEG = -INFINITY; int kb = 64 * jb + 4 * hi;
#pragma unroll
    for (int r = 0; r < 16; ++r) { int kv = kb + (r & 3) + 8 * (r >> 2); if (kv > qrel) p0[r] = NEG; if (kv + 32 > qrel) p1[r] = NEG; }
}
constexpr int NSLOT = 3, SLOTB = 8192;
constexpr int LDS_K = 0, LDS_V = NSLOT * SLOTB, LDS_WS = 2 * NSLOT * SLOTB, LDS_OST = LDS_WS + NW * 64 * 4, ATT_LDS_BYTES = LDS_OST + NW * 4096;
__device__ __forceinline__ void glds16(const void* gsrc, unsigned lds_dst) { unsigned keep;
    asm volatile("s_mov_b32 %0, m0\n\ts_mov_b32 m0, %2\n\ts_nop 0\n\tglobal_load_lds_dwordx4 %1, off\n\ts_mov_b32 m0, %0" : "=&s"(keep) : "v"(gsrc), "s"(lds_dst) : "memory"); }
__device__ __forceinline__ float max3f(float a, float b, float c) { float r; asm("v_max3_f32 %0, %1, %2, %3" : "=v"(r) : "v"(a), "v"(b), "v"(c)); return r; }
__device__ __forceinline__ float max2f(float a, float b) { float r; asm("v_max_f32_e32 %0, %1, %2" : "=v"(r) : "v"(a), "v"(b)); return r; }
__device__ __forceinline__ float fadd_s(float a, float b) { float r; asm("v_add_f32_e32 %0, %1, %2" : "=v"(r) : "v"(a), "v"(b)); return r; }
__device__ __forceinline__ float fsub_s(float a, float b) { float r; asm("v_sub_f32_e32 %0, %1, %2" : "=v"(r) : "v"(a), "v"(b)); return r; }
__device__ __forceinline__ unsigned cvtpk_s(float lo, float hi) { f32x2 v = {lo, hi}; bf16x2_t b = __builtin_convertvector(v, bf16x2_t); return __builtin_bit_cast(unsigned, b); }
#define WAIT_BAR(N) asm volatile("s_waitcnt vmcnt(" #N ") lgkmcnt(0)\n\ts_barrier" ::: "memory")
__device__ __forceinline__ void qkt(f32x16& p0, f32x16& p1, const char* Kslot, const bf16x8* qr, const f32x16& negm, int r32, int hi) {
    const char* kb = Kslot + hi * 1024 + r32 * 16;
#pragma unroll
    for (int d0 = 0; d0 < 4; ++d0) {
        const bf16x8 b0 = *reinterpret_cast<const bf16x8*>(kb + d0 * 2048);
        const bf16x8 b1 = *reinterpret_cast<const bf16x8*>(kb + d0 * 2048 + 512);
        if (d0 == 0) { p0 = __builtin_amdgcn_mfma_f32_32x32x16_bf16(b0, qr[0], negm, 0, 0, 0); p1 = __builtin_amdgcn_mfma_f32_32x32x16_bf16(b1, qr[0], negm, 0, 0, 0); }
        else { p0 = __builtin_amdgcn_mfma_f32_32x32x16_bf16(b0, qr[d0], p0, 0, 0, 0); p1 = __builtin_amdgcn_mfma_f32_32x32x16_bf16(b1, qr[d0], p1, 0, 0, 0); } }
}
typedef __attribute__((address_space(3))) const char* lds_cptr;
typedef short v4i16_t __attribute__((ext_vector_type(4)));
__device__ __forceinline__ void kload8(bf16x8* kf, lds_cptr kp) {
    kf[0] = *(const LAS bf16x8*)(kp);        kf[1] = *(const LAS bf16x8*)(kp + 512);
    kf[2] = *(const LAS bf16x8*)(kp + 2048); kf[3] = *(const LAS bf16x8*)(kp + 2560);
    kf[4] = *(const LAS bf16x8*)(kp + 4096); kf[5] = *(const LAS bf16x8*)(kp + 4608);
    kf[6] = *(const LAS bf16x8*)(kp + 6144); kf[7] = *(const LAS bf16x8*)(kp + 6656);
}
__device__ __forceinline__ void kload2(bf16x8* kf, lds_cptr kp, int j) { kf[2 * j] = *(const LAS bf16x8*)(kp + j * 2048); kf[2 * j + 1] = *(const LAS bf16x8*)(kp + j * 2048 + 512); }
__device__ __forceinline__ s16x4 vtr(lds_cptr p) { return __builtin_bit_cast(s16x4, __builtin_amdgcn_ds_read_tr16_b64_v4i16((LAS v4i16_t*)p)); }
__device__ __forceinline__ float rowmax(const f32x16& p0, const f32x16& p1) {
    float a = max3f(p0[0], p0[1], p1[0]), b = max3f(p0[2], p0[3], p1[1]); a = max3f(a, p1[2], p1[3]);
#pragma unroll
    for (int r = 4; r < 16; r += 4) { a = max3f(a, p0[r], p0[r + 1]); b = max3f(b, p0[r + 2], p0[r + 3]); a = max3f(a, p1[r], p1[r + 1]); b = max3f(b, p1[r + 2], p1[r + 3]); }
    const float m = max2f(a, b);
    auto rr = __builtin_amdgcn_permlane32_swap(__float_as_uint(m), __float_as_uint(m), false, false);
    return max2f(__uint_as_float(rr[0]), __uint_as_float(rr[1]));
}
__device__ __forceinline__ void pv(f32x16* o, int vb, bf16x8 pa0, bf16x8 pa1, bf16x8 pa2, bf16x8 pa3) {
#pragma unroll
    for (int d0 = 0; d0 < 2; ++d0) { s16x4 lo[4], hi[4];
#pragma unroll
        for (int ks = 0; ks < 4; ++ks) {
            asm volatile("ds_read_b64_tr_b16 %0,%1 offset:%c2" : "=&v"(lo[ks]) : "v"(vb), "i"(d0 * 4096 + ks * 1024) : "memory");
            asm volatile("ds_read_b64_tr_b16 %0,%1 offset:%c2" : "=&v"(hi[ks]) : "v"(vb), "i"(d0 * 4096 + ks * 1024 + 512) : "memory"); }
        asm volatile("s_waitcnt lgkmcnt(0)" ::: "memory"); SBAR();
#define PK(k) (bf16x8){lo[k][0], lo[k][1], lo[k][2], lo[k][3], hi[k][0], hi[k][1], hi[k][2], hi[k][3]}
        o[d0] = __builtin_amdgcn_mfma_f32_32x32x16_bf16(pa0, PK(0), o[d0], 0, 0, 0);
        o[d0] = __builtin_amdgcn_mfma_f32_32x32x16_bf16(pa1, PK(1), o[d0], 0, 0, 0);
        o[d0] = __builtin_amdgcn_mfma_f32_32x32x16_bf16(pa2, PK(2), o[d0], 0, 0, 0);
        o[d0] = __builtin_amdgcn_mfma_f32_32x32x16_bf16(pa3, PK(3), o[d0], 0, 0, 0);
#undef PK
    }
}
#define ATTN_STORE16(p, v) (*(u32x4*)(p) = (v))
template <int THRL> __device__ __forceinline__ void attn_unit(int wv, int pair, int qb, const bf16* Pb, bf16* Obuf, char* shm) {
    const int b = pair >> 5, v5 = pair & 31, hc = v5 >> 1; const int qc = hc * 64, kc = 1024 + hc * 64, vc = 2048 + (v5 >> 2) * 128 + (v5 & 1) * 64, oc = v5 * 64;
    int tid = wv * 64 + lane_id(); asm volatile("" : "+v"(tid));
    const int lane = tid & 63, r32 = lane & 31, hi = lane >> 5; const int wid = wv;
    const long rowbase = (long)b * SEQ; const int q0 = qb * QB;
    const bf16* Qw = Pb + (rowbase + q0 + wid * QBLK) * PQ + qc;
    const bf16* Kh = Pb + rowbase * PQ + kc, *Vh = Pb + rowbase * PQ + vc;
    const unsigned lds0 = (unsigned)(uintptr_t)shm;
    float* wsf = (float*)(shm + LDS_WS) + wid * 64;
    const bf16* ksrc = Kh + (long)lane * PQ + wid * 8;
    const bf16* vsrc = Vh + (long)(16 * (wid & 3) + (lane >> 2)) * PQ + (wid >> 2) * 32 + (lane & 3) * 8;
    const unsigned kdst = lds0 + LDS_K + wid * 1024, vdst = lds0 + LDS_V + wid * 1024;
#define DMA_K(t, slot) glds16(ksrc + (long)(t) * KVBLK * PQ, (unsigned)__builtin_amdgcn_readfirstlane(kdst + (slot)))
#define DMA_V(t, slot) glds16(vsrc + (long)(t) * KVBLK * PQ, (unsigned)__builtin_amdgcn_readfirstlane(vdst + (slot)))
    const int vb0 = (int)(lds0 + LDS_V) + ((lane >> 4) & 1) * 32 + (lane & 3) * 8 + (4 * hi + ((lane & 15) >> 2)) * 64;
    const char* Kbase = shm + LDS_K; bf16x8 kf[8];
    const lds_cptr shm3 = (lds_cptr)shm; const lds_cptr kp0 = shm3 + LDS_K + hi * 1024 + r32 * 16; const lds_cptr vp0 = shm3 + LDS_V + ((lane >> 4) & 1) * 32 + (lane & 3) * 8 + (4 * hi + ((lane & 15) >> 2)) * 64;
    const int NT = (q0 + QB) / KVBLK;
    DMA_K(0, 0); DMA_V(0, 0); DMA_K(1, SLOTB);
    bf16x8 qr[4];
#pragma unroll
    for (int d0 = 0; d0 < 4; ++d0) qr[d0] = *reinterpret_cast<const bf16x8*>(&Qw[(long)r32 * PQ + d0 * 16 + hi * 8]);
    float mhat = 0.f, l_reg = 0.f; f32x16 o[2]; o[0] = f32x16{}; o[1] = f32x16{}; f32x16 negm = f32x16{}; asm volatile("" : "+v"(negm));
    const int qrel = wid * QBLK + r32;
#define CMASK(P0, P1, t) do { int jb_ = (t) - (NT - 4); if (jb_ >= 0) cmask(P0, P1, jb_, qrel, hi); } while (0)
    bool resc = false;
#define START(P0, P1) do { const float rm = rowmax(P0, P1); resc = false; \
    { const float dl = rm; mhat = fadd_s(mhat, dl); \
      _Pragma("unroll") for (int r = 0; r < 16; ++r) { P0[r] = fsub_s(P0[r], dl); P1[r] = fsub_s(P1[r], dl); } \
      _Pragma("unroll") for (int r = 0; r < 16; ++r) negm[r] = -mhat; asm volatile("" : "+v"(negm)); } \
    _Pragma("unroll") for (int r = 0; r < 16; ++r) P0[r] = __builtin_amdgcn_exp2f(P0[r]); } while (0)
#define RESC() do { if (resc) { asm volatile("s_waitcnt lgkmcnt(0)" ::: "memory"); \
      _Pragma("unroll") for (int d_ = 0; d_ < 2; ++d_) _Pragma("unroll") for (int r = 0; r < 16; ++r) o[d_][r] *= wsf[crow(r, hi)]; } } while (0)
    f32x16 pA0, pA1, pB0, pB1;
    int sl_prev = 0, sl_cur = 0, sl_next = SLOTB;
#define ROT() do { sl_prev = sl_cur; sl_cur = sl_next; sl_next = (sl_next == (NSLOT - 1) * SLOTB) ? 0 : sl_next + SLOTB; } while (0)
    DMA_K(2, 2 * SLOTB);
    WAIT_BAR(3);
    qkt(pA0, pA1, Kbase, qr, negm, r32, hi); asm volatile("s_nop 15\n\ts_nop 7" : "+v"(pA0), "+v"(pA1)); CMASK(pA0, pA1, 0);
    START(pA0, pA1);
    _Pragma("unroll") for (int r = 0; r < 16; ++r) pA1[r] = __builtin_amdgcn_exp2f(pA1[r]);
    WAIT_BAR(0);
    DMA_K(3, 0); DMA_V(1, SLOTB);
    ROT();
    kload8(kf, kp0 + sl_cur);
    WAIT_BAR(2);
    s16x4 vlo[8], vhi[8]; u32x4 pw0, pw1, pw2, pw3;
#define PKW(P, B) cvtpk_s(P[B], P[B + 1])
#define PAF(k) __builtin_bit_cast(bf16x8, pw##k)
#define VFR(i) (bf16x8){vlo[i][0], vlo[i][1], vlo[i][2], vlo[i][3], vhi[i][0], vhi[i][1], vhi[i][2], vhi[i][3]}
#define PIN(x) asm volatile("" : "+v"(x))
#define MX3(a, b, c) __builtin_fmaxf(__builtin_fmaxf((a), (b)), (c))
#define GAPA(MF, A0, A1, A2, A3, W0, W1, PW) do { MF; sacc += A0; sacc += A1; sacc += A2; sacc += A3; PIN(sacc); W0; W1; PIN(PW); SBAR(); } while (0)
#define EX(v) __builtin_amdgcn_exp2f(v)
#define GAPB(MF, X, B) do { MF; X[B] = EX(X[B]); X[B + 1] = EX(X[B + 1]); X[B + 2] = EX(X[B + 2]); X[B + 3] = EX(X[B + 3]); PIN(X); SBAR(); } while (0)
#define VRD(i) do { vlo[i] = vtr(vp_ + (((i) >> 2) * 4096 + ((i) & 3) * 1024)); vhi[i] = vtr(vp_ + (((i) >> 2) * 4096 + ((i) & 3) * 1024 + 512)); } while (0)
#define KRD(G, j) do { if (G) { kload2(kf, kp0 + sl_next, j); SBAR(); } } while (0)
#define STEP(C0, C1, P0, P1, t, GK, GV, GL) do { SBAR(); \
    const lds_cptr vp_ = vp0 + sl_prev; \
    VRD(0); SBAR(); float sacc = (P0[0] + P0[1]); \
    GAPA(C0 = __builtin_amdgcn_mfma_f32_32x32x16_bf16(kf[0], qr[0], negm, 0, 0, 0), P0[2], P0[3], P0[4], P0[5],     pw0[0] = PKW(P0, 0), pw0[1] = PKW(P0, 2), pw0); \
    VRD(4); SBAR(); GAPA(C1 = __builtin_amdgcn_mfma_f32_32x32x16_bf16(kf[1], qr[0], negm, 0, 0, 0), P0[6], P0[7], P0[8], P0[9],     pw0[2] = PKW(P0, 4), pw0[3] = PKW(P0, 6), pw0); \
    VRD(1); SBAR(); GAPA(C0 = __builtin_amdgcn_mfma_f32_32x32x16_bf16(kf[2], qr[1], C0, 0, 0, 0),   P0[10], P0[11], P0[12], P0[13], pw1[0] = PKW(P0, 8), pw1[1] = PKW(P0, 10), pw1); \
    VRD(5); SBAR(); GAPA(C1 = __builtin_amdgcn_mfma_f32_32x32x16_bf16(kf[3], qr[1], C1, 0, 0, 0),   P0[14], P0[15], P1[0], P1[1],   pw1[2] = PKW(P0, 12), pw1[3] = PKW(P0, 14), pw1); \
    VRD(2); SBAR(); GAPA(C0 = __builtin_amdgcn_mfma_f32_32x32x16_bf16(kf[4], qr[2], C0, 0, 0, 0),   P1[2], P1[3], P1[4], P1[5],     pw2[0] = PKW(P1, 0), pw2[1] = PKW(P1, 2), pw2); \
    VRD(6); SBAR(); GAPA(C1 = __builtin_amdgcn_mfma_f32_32x32x16_bf16(kf[5], qr[2], C1, 0, 0, 0),   P1[6], P1[7], P1[8], P1[9],     pw2[2] = PKW(P1, 4), pw2[3] = PKW(P1, 6), pw2); \
    VRD(3); SBAR(); GAPA(C0 = __builtin_amdgcn_mfma_f32_32x32x16_bf16(kf[6], qr[3], C0, 0, 0, 0),   P1[10], P1[11], P1[12], P1[13], pw3[0] = PKW(P1, 8), pw3[1] = PKW(P1, 10), pw3); \
    VRD(7); SBAR(); GAPA(C1 = __builtin_amdgcn_mfma_f32_32x32x16_bf16(kf[7], qr[3], C1, 0, 0, 0),   P1[14], P1[15], 0.f, 0.f,       pw3[2] = PKW(P1, 12), pw3[3] = PKW(P1, 14), pw3); \
    l_reg += sacc; \
    if (GK) { DMA_K((t) + 3, sl_cur); } if (GV) { DMA_V((t) + 1, sl_next); } \
    CMASK(C0, C1, t); \
    { float a = MX3(C0[0], C0[1], C1[0]), b = MX3(C0[2], C0[3], C1[1]); a = MX3(a, C1[2], C1[3]); \
      _Pragma("unroll") for (int r = 4; r < 16; r += 4) { a = MX3(a, C0[r], C0[r + 1]); b = MX3(b, C0[r + 2], C0[r + 3]); a = MX3(a, C1[r], C1[r + 1]); b = MX3(b, C1[r + 2], C1[r + 3]); } \
      float rm = __builtin_fmaxf(a, b); { auto rr = __builtin_amdgcn_permlane32_swap(__float_as_uint(rm), __float_as_uint(rm), false, false); rm = __builtin_fmaxf(__uint_as_float(rr[0]), __uint_as_float(rr[1])); } \
      resc = false; \
      if (__builtin_expect(__any(rm > (float)THRL), 0)) { const float dl = __builtin_fmaxf(rm, 0.f); mhat += dl; \
        _Pragma("unroll") for (int r = 0; r < 16; ++r) { C0[r] -= dl; C1[r] -= dl; } \
        _Pragma("unroll") for (int r = 0; r < 16; ++r) negm[r] = -mhat; asm volatile("" : "+v"(negm)); \
        const float f = __builtin_amdgcn_exp2f(-dl); l_reg *= f; if (hi == 0) wsf[r32] = f; resc = true; } } \
    SBAR(); \
    GAPB(o[0] = __builtin_amdgcn_mfma_f32_32x32x16_bf16(PAF(0), VFR(0), o[0], 0, 0, 0), C0, 0); \
    GAPB(o[1] = __builtin_amdgcn_mfma_f32_32x32x16_bf16(PAF(0), VFR(4), o[1], 0, 0, 0), C0, 4); \
    KRD(GL, 0); GAPB(o[0] = __builtin_amdgcn_mfma_f32_32x32x16_bf16(PAF(1), VFR(1), o[0], 0, 0, 0), C0, 8); \
    KRD(GL, 1); GAPB(o[1] = __builtin_amdgcn_mfma_f32_32x32x16_bf16(PAF(1), VFR(5), o[1], 0, 0, 0), C0, 12); \
    KRD(GL, 2); GAPB(o[0] = __builtin_amdgcn_mfma_f32_32x32x16_bf16(PAF(2), VFR(2), o[0], 0, 0, 0), C1, 0); \
    KRD(GL, 3); GAPB(o[1] = __builtin_amdgcn_mfma_f32_32x32x16_bf16(PAF(2), VFR(6), o[1], 0, 0, 0), C1, 4); \
    GAPB(o[0] = __builtin_amdgcn_mfma_f32_32x32x16_bf16(PAF(3), VFR(3), o[0], 0, 0, 0), C1, 8); \
    GAPB(o[1] = __builtin_amdgcn_mfma_f32_32x32x16_bf16(PAF(3), VFR(7), o[1], 0, 0, 0), C1, 12); \
    } while (0)
    int t = 1;
#undef CMASK
#define CMASK(P0, P1, t) do {} while (0)
    for (; t + 5 < NT; t += 2) {
        STEP(pB0, pB1, pA0, pA1, t, true, true, true);     WAIT_BAR(2); RESC(); ROT();
        STEP(pA0, pA1, pB0, pB1, t + 1, true, true, true); WAIT_BAR(2); RESC(); ROT();
    }
#undef CMASK
#define CMASK(P0, P1, t) do { int jb_ = (t) - (NT - 4); if (jb_ >= 0) cmask(P0, P1, jb_, qrel, hi); } while (0)
#define ENDW(tt) do { if ((tt) + 3 < NT) { WAIT_BAR(2); } else if ((tt) + 2 < NT) { WAIT_BAR(1); } else { WAIT_BAR(0); } } while (0)
    for (; t + 1 < NT; t += 2) {
        STEP(pB0, pB1, pA0, pA1, t, (t + 3 < NT), (t + 1 < NT), (t + 1 < NT));         ENDW(t);     RESC(); ROT();
        STEP(pA0, pA1, pB0, pB1, t + 1, (t + 4 < NT), (t + 2 < NT), (t + 2 < NT));     ENDW(t + 1); RESC(); ROT();
    }
    STEP(pB0, pB1, pA0, pA1, NT - 1, false, false, false); RESC();
    { float sacc = pB0[0] + pB0[1]; _Pragma("unroll") for (int r = 2; r < 16; ++r) sacc += pB0[r]; _Pragma("unroll") for (int r = 0; r < 16; ++r) sacc += pB1[r]; l_reg += sacc;
      pw0 = (u32x4){PKW(pB0, 0), PKW(pB0, 2), PKW(pB0, 4), PKW(pB0, 6)}; pw1 = (u32x4){PKW(pB0, 8), PKW(pB0, 10), PKW(pB0, 12), PKW(pB0, 14)}; pw2 = (u32x4){PKW(pB1, 0), PKW(pB1, 2), PKW(pB1, 4), PKW(pB1, 6)}; pw3 = (u32x4){PKW(pB1, 8), PKW(pB1, 10), PKW(pB1, 12), PKW(pB1, 14)};
      SBAR(); pv(o, vb0 + sl_cur, PAF(0), PAF(1), PAF(2), PAF(3)); }
#undef PKW
#undef PAF
#undef VFR
#undef PIN
#undef MX3
#undef GAPA
#undef GAPB
#undef EX
#undef VRD
#undef KRD
#undef STEP
#undef ENDW
    { auto rr = __builtin_amdgcn_permlane32_swap(__float_as_uint(l_reg), __float_as_uint(l_reg), false, false); l_reg = __uint_as_float(rr[0]) + __uint_as_float(rr[1]); }
    if (hi == 0) wsf[32 + r32] = l_reg; asm volatile("s_waitcnt lgkmcnt(0)" ::: "memory");
    float rli[16];
#pragma unroll
    for (int r = 0; r < 16; ++r) rli[r] = __builtin_amdgcn_rcpf(wsf[32 + crow(r, hi)]);
    bf16* Ow = Obuf + (rowbase + q0 + wid * QBLK) * PO + oc;
    { bf16* stg = (bf16*)(shm + LDS_OST) + wid * 2048;
#pragma unroll
      for (int r = 0; r < 16; ++r) { const int orow = crow(r, hi);
#pragma unroll
        for (int d0 = 0; d0 < 2; ++d0) stg[orow * 64 + d0 * 32 + r32] = __float2bfloat16(o[d0][r] * rli[r]); }
      asm volatile("s_waitcnt lgkmcnt(0)" ::: "memory");
#pragma unroll
      for (int i = 0; i < 4; ++i) { const int row = i * 8 + (lane >> 3), ch = lane & 7; const u32x4 v = *(const u32x4*)(stg + row * 64 + ch * 8); ATTN_STORE16(Ow + (long)row * PO + ch * 8, v); } }
    asm volatile("s_waitcnt lgkmcnt(0)\n\ts_barrier" ::: "memory");
#undef DMA_K
#undef DMA_V
#undef CMASK
#undef START
#undef RESC
#undef ROT
}
#undef SBAR
#undef WAIT_BAR
}


namespace at2 {
using f32x16 = __attribute__((ext_vector_type(16))) float;
constexpr int PQ = 3072, PO = 256, DV = 128, DQ = 64;
constexpr int NW = 8, QBLK = 32, KVBLK = 64, QB = NW * QBLK;
constexpr int SHM_V = KVBLK * DV * 2, SHM_K = KVBLK * DQ * 2;
constexpr int OFF_VL = 0, OFF_KL = 2 * SHM_V, OFF_WS = 2 * SHM_V + 2 * SHM_K;
constexpr int OFF_OL = OFF_WS + 2048, OL_RS = 272, OL_WAVE = QBLK * OL_RS;
constexpr float THR2 = 8.f;
#define KSWZ64(row, colB) ((row) * 128 + ((colB) ^ (((row) & 7) << 4)))
#define SBAR() __builtin_amdgcn_sched_barrier(0)
__device__ __forceinline__ int v_st(int k, int c) { const int kk = (k & ~0xC) | ((k & 4) << 1) | ((k & 8) >> 1); return ((kk >> 3) * 4 + (c >> 5)) * 512 + ((kk & 7) * 32 + (c & 31)) * 2; }
__device__ __forceinline__ int v_rd_base(int lane) { return ((lane & 3) << 3) | (((lane >> 2) & 3) << 6) | (((lane >> 4) & 1) << 5) | (((lane >> 5) & 1) << 8); }
constexpr int v_rd_off(int d0, int ks, int half) { return d0 * 512 + ks * 4096 + half * 2048; }
__device__ __forceinline__ int crow(int r, int hi) { return (r & 3) + 8 * (r >> 2) + 4 * hi; }
__device__ __forceinline__ bf16x8 load8(const bf16_t* p) { return *reinterpret_cast<const bf16x8*>(p); }
__device__ __forceinline__ void mask_tile(f32x16& p0, f32x16& p1, int dq) {
    const float NEG = -__builtin_inff();
#pragma unroll
    for (int r = 0; r < 16; ++r) { const int c = (r & 3) + 8 * (r >> 2); if (dq - c < 0) p0[r] = NEG; if (dq - c - 32 < 0) p1[r] = NEG; }
}
__device__ __forceinline__ void partialSM(f32x16& p0, f32x16& p1, float& m_reg, float& mn, float& alpha) {
    float pmax = p0[0];
#pragma unroll
    for (int r = 1; r < 16; ++r) pmax = fmaxf(pmax, p0[r]);
#pragma unroll
    for (int r = 0; r < 16; ++r) pmax = fmaxf(pmax, p1[r]);
    { auto rr = __builtin_amdgcn_permlane32_swap(__float_as_uint(pmax), __float_as_uint(pmax), false, false); pmax = fmaxf(__uint_as_float(rr[0]), __uint_as_float(rr[1])); }
    if (__builtin_expect(__all((pmax - m_reg) <= THR2), 1)) { mn = m_reg; alpha = 1.f; }
    else { mn = fmaxf(m_reg, pmax); alpha = __builtin_amdgcn_exp2f(m_reg - mn); m_reg = mn; }
#pragma unroll
    for (int r = 0; r < 16; ++r) { p0[r] = p0[r] - mn; p1[r] = p1[r] - mn; }
#pragma unroll
    for (int r = 0; r < 16; ++r) p0[r] = __builtin_amdgcn_exp2f(p0[r]);
}
__device__ __forceinline__ void finishSM(f32x16& p0, f32x16& p1, float alpha, float& l_reg, bf16x8& pa0, bf16x8& pa1, bf16x8& pa2, bf16x8& pa3) {
#pragma unroll
    for (int r = 0; r < 16; ++r) p1[r] = __builtin_amdgcn_exp2f(p1[r]);
    float ps = 0;
#pragma unroll
    for (int r = 0; r < 16; ++r) ps += p0[r];
#pragma unroll
    for (int r = 0; r < 16; ++r) ps += p1[r];
    { auto rr = __builtin_amdgcn_permlane32_swap(__float_as_uint(ps), __float_as_uint(ps), false, false); ps = __uint_as_float(rr[0]) + __uint_as_float(rr[1]); }
    l_reg = l_reg * alpha + ps;
#define PK4(P, B_, OUT) do { unsigned a0 = cvtpk(P[B_+0], P[B_+1]), a1 = cvtpk(P[B_+2], P[B_+3]);                          \
        unsigned b0 = cvtpk(P[B_+4], P[B_+5]), b1 = cvtpk(P[B_+6], P[B_+7]);                                             \
        auto r0 = __builtin_amdgcn_permlane32_swap(a0, b0, false, false); auto r1 = __builtin_amdgcn_permlane32_swap(a1, b1, false, false); \
        u32x4 w = {r0[0], r1[0], r0[1], r1[1]}; OUT = *reinterpret_cast<bf16x8*>(&w); } while (0)
    PK4(p0, 0, pa0); PK4(p0, 8, pa1); PK4(p1, 0, pa2); PK4(p1, 8, pa3);
#undef PK4
}
template <int KB>
__device__ __forceinline__ void qkt(f32x16& p0, f32x16& p1, const char* K_lds, int r32, int hi, const bf16x8* qr) {
    p0 = f32x16{}; p1 = f32x16{};
#pragma unroll
    for (int d0 = 0; d0 < 4; ++d0) { const char* a = K_lds + KB * SHM_K + KSWZ64(r32, (d0 * 16 + hi * 8) * 2);
        bf16x8 b0 = *reinterpret_cast<const bf16x8*>(a);
        bf16x8 b1 = *reinterpret_cast<const bf16x8*>(a + 32 * 128);
        p0 = __builtin_amdgcn_mfma_f32_32x32x16_bf16(b0, qr[d0], p0, 0, 0, 0);
        p1 = __builtin_amdgcn_mfma_f32_32x32x16_bf16(b1, qr[d0], p1, 0, 0, 0); }
}
template <int VB>
__device__ __forceinline__ void pv_tile(f32x16* o, int vb0, bf16x8 pa0, bf16x8 pa1, bf16x8 pa2, bf16x8 pa3) {
#define TRRD(dst, off) asm volatile("ds_read_b64_tr_b16 %0, %1 offset:%2" : "=&v"(dst) : "v"(vb0), "i"(off) : "memory")
#define PV_D0(d0) do { s16x4 l0, l1, l2, l3, h0, h1, h2, h3; constexpr int b_ = VB * SHM_V + v_rd_off(d0, 0, 0); \
        TRRD(l0, b_); TRRD(h0, b_ + 2048); TRRD(l1, b_ + 4096); TRRD(h1, b_ + 6144); TRRD(l2, b_ + 8192); TRRD(h2, b_ + 10240); TRRD(l3, b_ + 12288); TRRD(h3, b_ + 14336); \
        asm volatile("s_waitcnt lgkmcnt(0)" ::: "memory"); SBAR();   \
        o[d0] = __builtin_amdgcn_mfma_f32_32x32x16_bf16(pa0, (bf16x8){l0[0], l0[1], l0[2], l0[3], h0[0], h0[1], h0[2], h0[3]}, o[d0], 0, 0, 0);   \
        o[d0] = __builtin_amdgcn_mfma_f32_32x32x16_bf16(pa1, (bf16x8){l1[0], l1[1], l1[2], l1[3], h1[0], h1[1], h1[2], h1[3]}, o[d0], 0, 0, 0);   \
        o[d0] = __builtin_amdgcn_mfma_f32_32x32x16_bf16(pa2, (bf16x8){l2[0], l2[1], l2[2], l2[3], h2[0], h2[1], h2[2], h2[3]}, o[d0], 0, 0, 0);   \
        o[d0] = __builtin_amdgcn_mfma_f32_32x32x16_bf16(pa3, (bf16x8){l3[0], l3[1], l3[2], l3[3], h3[0], h3[1], h3[2], h3[3]}, o[d0], 0, 0, 0); } while (0)
    PV_D0(0); PV_D0(1); PV_D0(2); PV_D0(3);
#undef PV_D0
#undef TRRD
}
struct BlockRef { const bf16_t* Q; const bf16_t* K; const bf16_t* V; int P0; int to_lds; float lam; };
struct Seam { bf16x8 qr[4]; bf16x8 st_v0, st_v1, st_k0; };
#define VMW() asm volatile("s_waitcnt vmcnt(0)" ::: "memory")
#define VMWN(n) asm volatile("s_waitcnt vmcnt(%0)" :: "i"(n) : "memory")
#define SLOAD_H(Kp, Vp, k0) do { S.st_v0 = load8((Vp) + (size_t)((k0) + sr) * PQ + sc); S.st_v1 = load8((Vp) + (size_t)((k0) + 32 + sr) * PQ + sc); \
                                 S.st_k0 = load8((Kp) + (size_t)((k0) + kr) * PQ + kc); } while (0)
#define SWRITE_HK(bf) do { *(bf16x8*)(K_lds + (bf) * SHM_K + kws) = S.st_k0; } while (0)
#define SWRITE_HV(bf) do { *(bf16x8*)(V_lds + (bf) * SHM_V + vst0) = S.st_v0; *(bf16x8*)(V_lds + (bf) * SHM_V + vst1) = S.st_v1; } while (0)
#define SWRITE_H(bf) do { SWRITE_HV(bf); SWRITE_HK(bf); } while (0)
__device__ __forceinline__ void prime(const BlockRef& cur, char* lds, Seam& S, int tid, int wid) {
    const int lane = tid & 63, r32 = lane & 31, hi = lane >> 5;
    const int sr = tid >> 4, sc = (tid & 15) * 8, kr = tid >> 3, kc = (tid & 7) * 8, kws = KSWZ64(kr, kc * 2); char* K_lds = lds + OFF_KL;
#pragma unroll
    for (int d0 = 0; d0 < 4; ++d0) S.qr[d0] = load8(cur.Q + (size_t)(wid * QBLK + r32) * PQ + d0 * 16 + hi * 8);
    SLOAD_H(cur.K, cur.V, 0); VMW(); SWRITE_HK(0);
    __syncthreads();
}
__device__ __forceinline__ void block(const BlockRef& cur, const BlockRef& nxt, char* lds, Seam& S, int tid, int wid) {
    asm volatile("" : "+v"(tid));
    const int lane = tid & 63, r32 = lane & 31, hi = lane >> 5;
    const int NT = (cur.P0 + QB - 1) / KVBLK + 1;
    const int qlo = cur.P0 + wid * QBLK, qm = qlo + r32 - 4 * hi;
    char* V_lds = lds + OFF_VL; char* K_lds = lds + OFF_KL;
    float* ws = (float*)(lds + OFF_WS) + wid * 64; float* li_l = ws, * al_l = ws + 32;
    float m_reg = -1e30f, l_reg = 0; f32x16 o[4] = {};
    const int sr = tid >> 4, sc = (tid & 15) * 8, vst0 = v_st(sr, sc), vst1 = v_st(32 + sr, sc), kr = tid >> 3, kc = (tid & 7) * 8, kws = KSWZ64(kr, kc * 2);
    const int vb0 = (int)(uintptr_t)V_lds + v_rd_base(lane);
    const bf16_t* Kh = cur.K; const bf16_t* Vh = cur.V;
#define RESC(a) do { if (__any((a) < 1.f)) { if (hi == 0) al_l[r32] = (a); asm volatile("s_waitcnt lgkmcnt(0)" ::: "memory");              \
                     _Pragma("unroll") for (int d_ = 0; d_ < 4; ++d_) _Pragma("unroll") for (int r = 0; r < 16; ++r) o[d_][r] *= al_l[crow(r, hi)]; } } while (0)
#define KBASE(t) ((t) * KVBLK)
#define MASKT(P0_, P1_, t) do { const int kb_ = KBASE(t); if (kb_ + KVBLK - 1 > qlo) mask_tile(P0_, P1_, qm - kb_); } while (0)
#define SEAM_K0() do { VMWN(4); SWRITE_HK(0); SBAR(); } while (0)
    f32x16 pA0, pA1, pB0, pB1; float mnA, mnB, alA, alB; bf16x8 pa0, pa1, pa2, pa3;
    SWRITE_HV(0); SBAR();
    if (NT > 1) SLOAD_H(Kh, Vh, KBASE(1));
    SBAR(); qkt<0>(pA0, pA1, K_lds, r32, hi, S.qr);
    MASKT(pA0, pA1, 0); partialSM(pA0, pA1, m_reg, mnA, alA);
    if (NT > 1) { VMW(); SWRITE_H(1); }
    __syncthreads();
#define HALF_STEP(PX0, PX1, mnX, alX, PY0, PY1, alY, t, KB, VB, SB) do {                                                      \
        SBAR(); qkt<KB>(PX0, PX1, K_lds, r32, hi, S.qr);                                                                      \
        finishSM(PY0, PY1, alY, l_reg, pa0, pa1, pa2, pa3); SBAR();                                                           \
        if ((t) + 1 < NT) { SLOAD_H(Kh, Vh, KBASE((t) + 1)); SBAR(); }                                                        \
        pv_tile<VB>(o, vb0, pa0, pa1, pa2, pa3); MASKT(PX0, PX1, (t)); partialSM(PX0, PX1, m_reg, mnX, alX);                 \
        __syncthreads();                                                                                                      \
        if ((t) + 1 < NT) { VMW(); SWRITE_H(SB); }                                                                            \
        RESC(alX); __syncthreads(); } while (0)
    for (int t = 1; t + 1 < NT; t += 2) {
        HALF_STEP(pB0, pB1, mnB, alB, pA0, pA1, alA, t, 1, 0, 0);
        HALF_STEP(pA0, pA1, mnA, alA, pB0, pB1, alB, t + 1, 0, 1, 1);
    }
    const bool even = wid >= 6;
    if (even) { SBAR(); qkt<1>(pB0, pB1, K_lds, r32, hi, S.qr); SBAR(); }
    SLOAD_H(nxt.K, nxt.V, 0); SBAR();
#pragma unroll
    for (int d0 = 0; d0 < 4; ++d0) S.qr[d0] = load8(nxt.Q + (size_t)(wid * QBLK + r32) * PQ + d0 * 16 + hi * 8);
    SBAR();
    finishSM(pA0, pA1, alA, l_reg, pa0, pa1, pa2, pa3); SBAR();
    pv_tile<0>(o, vb0, pa0, pa1, pa2, pa3);
    if (even) { MASKT(pB0, pB1, NT - 1); partialSM(pB0, pB1, m_reg, mnB, alB); __syncthreads(); RESC(alB);
        finishSM(pB0, pB1, alB, l_reg, pa0, pa1, pa2, pa3); SBAR(); pv_tile<1>(o, vb0, pa0, pa1, pa2, pa3); }
    else __syncthreads();
    SBAR(); SEAM_K0();
    if (hi == 0) li_l[r32] = l_reg; asm volatile("s_waitcnt lgkmcnt(0)" ::: "memory");
    float rli[16];
#pragma unroll
    for (int r = 0; r < 16; ++r) rli[r] = __builtin_amdgcn_rcpf(li_l[crow(r, hi)]);
    { char* Ol = lds + OFF_OL + wid * OL_WAVE;
      if (!cur.to_lds) {
#pragma unroll
          for (int d0 = 0; d0 < 4; ++d0)
#pragma unroll
              for (int hq = 0; hq < 2; ++hq) { u32x4 wv_;
#pragma unroll
                  for (int q = 0; q < 4; ++q) { const int r = hq * 8 + q * 2; wv_[q] = cvtpk(o[d0][r] * rli[r], o[d0][r + 1] * rli[r + 1]); }
                  *(u32x4*)(Ol + ((d0 * 2 + hq) * 64 + lane) * 16) = wv_; }
      } else {
          u32x4 o1w[8];
#pragma unroll
          for (int i = 0; i < 8; ++i) o1w[i] = *(const u32x4*)(Ol + (i * 64 + lane) * 16);
          asm volatile("s_waitcnt lgkmcnt(0)" ::: "memory");
#pragma unroll
          for (int r = 0; r < 16; ++r) { const int orow = crow(r, hi);
#pragma unroll
              for (int d0 = 0; d0 < 4; ++d0) { const unsigned w1 = o1w[d0 * 2 + (r >> 3)][(r & 7) >> 1]; const float o1v = (r & 1) ? bfhi(w1) : bflo(w1);
                  const float v = o1v - cur.lam * (o[d0][r] * rli[r]); const float vn = sx<1>(v);
                  if ((r32 & 1) == 0) *(unsigned*)(Ol + orow * OL_RS + (d0 * 32 + r32) * 2) = cvtpk(v, vn); } } } }
    asm volatile("s_waitcnt lgkmcnt(0)\n\ts_barrier" ::: "memory");
#undef RESC
#undef KBASE
#undef MASKT
#undef SEAM_K0
#undef HALF_STEP
}
#undef VMW
#undef VMWN
#undef SLOAD_H
#undef SWRITE_HK
#undef SWRITE_HV
#undef SWRITE_H
#undef SBAR
#undef KSWZ64
}

struct Params {
    const float* x; const float* c; const int* positions; const float* norm1; const float* norm2; const float* w_ada; const float* b_ada;
    const float* a_w_in; const float* a_b_if; const float* a_h_norm; const float* a_w_out;
    const float* b_w_in; const float* b_q_norm; const float* b_k_norm; const float* b_lam_q1; const float* b_lam_k1; const float* b_lam_q2; const float* b_lam_k2;
    const float* b_o_norm; const float* b_w_out; const float* w_router; const float* router_bias; const float* moe_w_gu; const float* moe_w_down;
    float* out; unsigned char* ws;
};
struct Frame { LAS unsigned char* lds; int tid, lane, wave, G, bid, vcu; };
__device__ __forceinline__ Frame make_frame(unsigned char* lds, int wv) {
    Frame F; F.lds = (LAS unsigned char*)lds; int t = wv * 64 + lane_id(); asm volatile("" : "+v"(t)); F.tid = t; F.lane = t & 63; F.wave = wv;
    F.G = gridDim.x; F.bid = blockIdx.x; F.vcu = (F.G % 8 == 0) ? (F.bid % 8) * (F.G / 8) + F.bid / 8 : F.bid; return F;
}

struct WItem { const float* W; unsigned char* WT; float* cs; int ldw, Kr, drow0, n0, mode; float s8; };
constexpr int NW_ITEMS = ((WQ_IN0 == 2) ? 48 : 0) + ((WQ_OUT0 == 2) ? 16 : 0) + ((WQ_OUT1 == 2) ? 16 : 0);
__device__ __forceinline__ WItem decode_witem(int it, const Params& p) {
    float* cw = (float*)(p.ws + SC_CW);
    if (WQ_IN0 == 2) { if (it < 48) { const int nb = it; return WItem{p.a_w_in, p.ws + WS_WAIN, cw + CW_AIN, 3080, 1024, 64 * nb, 64 * nb, 2, 0.f}; } it -= 48; }
    if (WQ_OUT0 == 2) { if (it < 16) { const int nb = it; return WItem{p.a_w_out, p.ws + WS_WAOUT, cw + CW_AOUT, 1024, 1024, 64 * nb, 64 * nb, 2, 0.f}; } it -= 16; }
    { const int nb = it; return WItem{p.b_w_out, p.ws + WS_WBOUT, cw + CW_BOUT, 1024, 1024, 64 * nb, 64 * nb, 2, 0.f}; }
}
__device__ __forceinline__ int witem_owner(int it, int G) { return (G == 256) ? 192 + (it & 63) : it % G; }
struct TItem { const float* W; bf16_t* WT; int ldw, K, drow0, k0, n0; float s8; };
__device__ __forceinline__ TItem decode_item(int it, const Params& p) {
    constexpr int I0 = (WQ_IN0 == 2) ? 0 : 16 * 48, I1 = (WQ_OUT0 == 2) ? 0 : 16 * 16, I2 = 16 * 48, I3 = (WQ_OUT1 == 2) ? 0 : 16 * 16, I4 = 32 * 256;
    TItem t; int r = it;
    if (r < I0) { const int kb = r / 48, nb = r % 48; t = (WQ_IN0 == 1) ? TItem{p.a_w_in, (bf16_t*)(p.ws + WS_WAIN), 3080, 1024, 64 * nb, 64 * kb, 64 * nb, S8_WIN} : TItem{p.a_w_in, (bf16_t*)(p.ws + WS_WAIN_BF), 3080, 1024, 64 * nb, 64 * kb, 64 * nb, 0.f}; return t; } r -= I0;
    if (r < I1) { const int kb = r / 16, nb = r % 16; t = (WQ_OUT0 == 1) ? TItem{p.a_w_out, (bf16_t*)(p.ws + WS_WAOUT), 1024, 1024, 64 * nb, 64 * kb, 64 * nb, S8_WOUT} : TItem{p.a_w_out, (bf16_t*)(p.ws + WS_WAOUT_BF), 1024, 1024, 64 * nb, 64 * kb, 64 * nb, 0.f}; return t; } r -= I1;
    if (r < I2) { const int kb = r / 48, nb = r % 48; t = TItem{p.b_w_in, (bf16_t*)(p.ws + WS_WBIN), 3072, 1024, 64 * nb, 64 * kb, 64 * nb, S8_WIN}; return t; } r -= I2;
    if (r < I3) { const int kb = r / 16, nb = r % 16; t = OUTPROJ_FP8 ? TItem{p.b_w_out, (bf16_t*)(p.ws + WS_WBOUT), 1024, 1024, 64 * nb, 64 * kb, 64 * nb, S8_WOUT} : TItem{p.b_w_out, (bf16_t*)(p.ws + WS_WBOUT_BF), 1024, 1024, 64 * nb, 64 * kb, 64 * nb, 0.f}; return t; } r -= I3;
    if (r < I4) { const int mi = r / 256, q = r % 256, kb = q / 16, nb = q % 16; const int n0 = 64 * nb;
        const int drow = ((n0 & 511) >> 7) * 256 + (n0 >> 9) * 128 + (n0 & 127);
        t = TItem{p.moe_w_gu + (size_t)mi * 1024 * 1024, (bf16_t*)(p.ws + WS_WGU + (size_t)mi * 1024 * 1024), 1024, 1024, drow, 64 * kb, n0, S8_WGU}; return t; } r -= I4;
    { const int mi = r / 128, q = r % 128, kb = q / 16, nb = q % 16;
      t = TItem{p.moe_w_down + (size_t)mi * 512 * 1024, (bf16_t*)(p.ws + WS_WDN + (size_t)mi * 1024 * 512), 1024, 512, 64 * nb, 64 * kb, 64 * nb, S8_WDN}; return t; }
}
__device__ __forceinline__ void phase_mod(unsigned char* lds_, int wv, const Params& p) {
    const Frame F = make_frame(lds_, wv);
    LAS float* cact = (LAS float*)F.lds;
    LAS float* red = (LAS float*)(F.lds + 65536);
    float* mod = (float*)(p.ws + WS_MOD);
    for (int i = F.tid; i < NB * DM; i += NTHREADS) { const int b = i >> 10, k = i & 1023; const float v = p.c[i]; cact[k * 16 + b] = v / (1.0f + expf(-v)); }
    __syncthreads();
    for (int task = F.bid; task < 192; task += F.G) {
        const int l = task / 96, cb = task % 96;
        const float* W = p.w_ada + (size_t)l * DM * 6144 + cb * 64 + F.lane;
        float acc[16];
#pragma unroll
        for (int b = 0; b < 16; ++b) acc[b] = 0.f;
        const int kbeg = F.wave * 128;
        for (int kb = kbeg; kb < kbeg + 128; kb += 16) {
            float wv[16];
#pragma unroll
            for (int u = 0; u < 16; ++u) wv[u] = __builtin_nontemporal_load(W + (size_t)(kb + u) * 6144);
#pragma unroll
            for (int u = 0; u < 16; ++u) {
                const LAS f32x4* cc = (const LAS f32x4*)(cact + (kb + u) * 16);
                const f32x4 c0 = cc[0], c1 = cc[1], c2 = cc[2], c3 = cc[3]; const float w = wv[u];
                acc[0] += c0[0] * w; acc[1] += c0[1] * w; acc[2] += c0[2] * w; acc[3] += c0[3] * w;
                acc[4] += c1[0] * w; acc[5] += c1[1] * w; acc[6] += c1[2] * w; acc[7] += c1[3] * w;
                acc[8] += c2[0] * w; acc[9] += c2[1] * w; acc[10] += c2[2] * w; acc[11] += c2[3] * w;
                acc[12] += c3[0] * w; acc[13] += c3[1] * w; acc[14] += c3[2] * w; acc[15] += c3[3] * w;
            }
        }
#pragma unroll
        for (int b = 0; b < 16; ++b) red[(F.wave * 16 + b) * 64 + F.lane] = acc[b];
        __syncthreads();
        for (int o = F.tid; o < 1024; o += NTHREADS) { const int b = o >> 6, cl = o & 63; float s = 0.f;
#pragma unroll
            for (int w = 0; w < 8; ++w) s += red[(w * 16 + b) * 64 + cl];
            mod[((size_t)l * 16 + b) * 6144 + cb * 64 + cl] = s + p.b_ada[(size_t)l * 6144 + cb * 64 + cl]; }
        __syncthreads();
    }
}
__device__ __forceinline__ void phase_wconv(unsigned char* lds_, int wv, const Params& p) {
    const Frame F = make_frame(lds_, wv);
    LAS float* scr = (LAS float*)(F.lds + F.wave * 17408);
    LAS float* cmaxw = (LAS float*)(F.lds + 8 * 17408);
    const int lane = F.lane, lr = lane >> 4, c4 = (lane & 15) * 4, w = F.wave;
    for (int it = 0; it < NW_ITEMS; ++it) {
        if (witem_owner(it, F.G) != F.bid) continue;
        const WItem t = decode_witem(it, p);
        const int RW = t.Kr >> 3, NH = RW >> 6;
        f32x4 v[2][16];
#pragma unroll
        for (int hf = 0; hf < 2; ++hf) if (hf < NH) {
#pragma unroll
            for (int i = 0; i < 16; ++i) v[hf][i] = __builtin_nontemporal_load((const f32x4*)(t.W + (size_t)(w * RW + hf * 64 + 4 * i + lr) * t.ldw + t.n0 + c4)); }
        __syncthreads();
        float qs = t.s8;
        if (t.mode == 2) {
            float mx[4] = {0.f, 0.f, 0.f, 0.f};
#pragma unroll
            for (int hf = 0; hf < 2; ++hf) if (hf < NH) {
#pragma unroll
                for (int i = 0; i < 16; ++i)
#pragma unroll
                    for (int q = 0; q < 4; ++q) mx[q] = fmaxf(mx[q], fabsf(v[hf][i][q])); }
#pragma unroll
            for (int q = 0; q < 4; ++q) { mx[q] = fmaxf(mx[q], sx<16>(mx[q])); auto rr = __builtin_amdgcn_permlane32_swap(__float_as_uint(mx[q]), __float_as_uint(mx[q]), false, false); mx[q] = fmaxf(__uint_as_float(rr[0]), __uint_as_float(rr[1])); }
            if (lr == 0) *(LAS f32x4*)(cmaxw + w * 64 + c4) = (f32x4){mx[0], mx[1], mx[2], mx[3]};
            __syncthreads();
            float cm = 0.f;
#pragma unroll
            for (int ww = 0; ww < 8; ++ww) cm = fmaxf(cm, cmaxw[ww * 64 + lane]);
            qs = cm > 0.f ? 127.0f / cm : 0.f;
            if (w == 0) t.cs[t.drow0 + lane] = cm * (1.0f / 127.0f);
        }
#pragma unroll
        for (int hf = 0; hf < 2; ++hf) if (hf < NH) {
#pragma unroll
            for (int i = 0; i < 16; ++i) *(LAS f32x4*)(scr + (4 * i + lr) * 68 + c4) = v[hf][i];
            const int k0 = w * RW + hf * 64;
            if (t.mode == 0) { bf16_t* orow = (bf16_t*)t.WT + (size_t)(t.drow0 + lane) * t.Kr + k0;
#pragma unroll
                for (int c = 0; c < 8; ++c) { float f[8];
#pragma unroll
                    for (int q = 0; q < 8; ++q) f[q] = scr[(8 * c + q) * 68 + lane];
                    u32x4 o; o.x = cvtpk(f[0], f[1]); o.y = cvtpk(f[2], f[3]); o.z = cvtpk(f[4], f[5]); o.w = cvtpk(f[6], f[7]);
                    *(u32x4*)(orow + 8 * c) = o; } }
            else { unsigned char* orow8 = t.WT + (size_t)(t.drow0 + lane) * t.Kr + k0;
#pragma unroll
                for (int c = 0; c < 4; ++c) { float f[16];
#pragma unroll
                    for (int q = 0; q < 16; ++q) f[q] = scr[(16 * c + q) * 68 + lane] * qs;
                    u32x4 o;
                    if (t.mode == 1) { o.x = cvt4_fp8(f[0], f[1], f[2], f[3]); o.y = cvt4_fp8(f[4], f[5], f[6], f[7]); o.z = cvt4_fp8(f[8], f[9], f[10], f[11]); o.w = cvt4_fp8(f[12], f[13], f[14], f[15]); }
                    else { o.x = pack4_i8(f[0], f[1], f[2], f[3]); o.y = pack4_i8(f[4], f[5], f[6], f[7]); o.z = pack4_i8(f[8], f[9], f[10], f[11]); o.w = pack4_i8(f[12], f[13], f[14], f[15]); }
                    *(u32x4*)(orow8 + 16 * c) = o; } }
            asm volatile("s_waitcnt lgkmcnt(0)" ::: "memory");
        }
    }
}

__device__ __forceinline__ void phase_wconv_pw(unsigned char* lds_, int wv, const Params& p) {
    const Frame F = make_frame(lds_, wv);
    LAS float* scr = (LAS float*)(F.lds + F.wave * 17408);
    const int gw = F.vcu * NWAVES + F.wave, NGW = F.G * NWAVES;
    constexpr int NITEMS = ((WQ_IN0 == 2) ? 0 : 16 * 48) + ((WQ_OUT0 == 2) ? 0 : 16 * 16) + 16 * 48 + ((WQ_OUT1 == 2) ? 0 : 16 * 16) + 32 * 256 + 32 * 128;
    const int lane = F.lane, lr = lane >> 4, c4 = (lane & 15) * 4;
    f32x4 v[16];
    int it = gw;
    if (it < NITEMS) { const TItem t = decode_item(it, p);
#pragma unroll
        for (int i = 0; i < 16; ++i) v[i] = __builtin_nontemporal_load((const f32x4*)(t.W + (size_t)(t.k0 + 4 * i + lr) * t.ldw + t.n0 + c4)); }
    for (; it < NITEMS; it += NGW) {
        const TItem t = decode_item(it, p);
#pragma unroll
        for (int i = 0; i < 16; ++i) *(LAS f32x4*)(scr + (4 * i + lr) * 68 + c4) = v[i];
        const int itn = it + NGW;
        if (itn < NITEMS) { const TItem tn = decode_item(itn, p);
#pragma unroll
            for (int i = 0; i < 16; ++i) v[i] = __builtin_nontemporal_load((const f32x4*)(tn.W + (size_t)(tn.k0 + 4 * i + lr) * tn.ldw + tn.n0 + c4)); }
        if (t.s8 > 0.f) {
            unsigned char* orow8 = (unsigned char*)t.WT + (size_t)(t.drow0 + lane) * t.K + t.k0;
#pragma unroll
            for (int c = 0; c < 4; ++c) { float f[16];
#pragma unroll
                for (int q = 0; q < 16; ++q) f[q] = scr[(16 * c + q) * 68 + lane] * t.s8;
                u32x4 o; o.x = cvt4_fp8(f[0], f[1], f[2], f[3]); o.y = cvt4_fp8(f[4], f[5], f[6], f[7]); o.z = cvt4_fp8(f[8], f[9], f[10], f[11]); o.w = cvt4_fp8(f[12], f[13], f[14], f[15]);
                *(u32x4*)(orow8 + 16 * c) = o; }
        } else {
            bf16_t* orow = t.WT + (size_t)(t.drow0 + lane) * t.K + t.k0;
#pragma unroll
            for (int c = 0; c < 8; ++c) { float f[8];
#pragma unroll
                for (int q = 0; q < 8; ++q) f[q] = scr[(8 * c + q) * 68 + lane];
                u32x4 o; o.x = cvtpk(f[0], f[1]); o.y = cvtpk(f[2], f[3]); o.z = cvtpk(f[4], f[5]); o.w = cvtpk(f[6], f[7]);
                *(u32x4*)(orow + 8 * c) = o; }
        }
    }
}

struct RowConst { f32x4 a[4], b[4]; };
__device__ __forceinline__ RowConst load_rowconst(const float* norm, const float* modb, int sh_off, int sc_off, int lane) {
    RowConst rc;
#pragma unroll
    for (int j = 0; j < 4; ++j) { const int c = 256 * j + 4 * lane;
        const f32x4 nv = *(const f32x4*)(norm + c), sc = *(const f32x4*)(modb + sc_off + c); rc.b[j] = *(const f32x4*)(modb + sh_off + c);
        rc.a[j] = nv * (sc + 1.0f); }
    return rc;
}
__device__ __forceinline__ void row_norm_store(const f32x4 (&v)[4], const RowConst& rc, f32x4 (&h)[4], bf16_t* hrow, int lane) {
    float ss = 0.f;
#pragma unroll
    for (int j = 0; j < 4; ++j) ss += (v[j][0] * v[j][0] + v[j][1] * v[j][1]) + (v[j][2] * v[j][2] + v[j][3] * v[j][3]);
    const float r = 1.0f / sqrtf(wave_sum(ss) * (1.0f / DM) + EPS);
#pragma unroll
    for (int j = 0; j < 4; ++j) { h[j] = v[j] * r * rc.a[j] + rc.b[j];
        u32x2 w; w.x = cvtpk(h[j][0], h[j][1]); w.y = cvtpk(h[j][2], h[j][3]); *(u32x2*)(hrow + 256 * j + 4 * lane) = w; }
}


__device__ __forceinline__ float reduce16(const float (&v)[16], int lane) {
    float a[8], b[4], c[2];
    const bool b5 = (lane & 32) != 0, b4 = (lane & 16) != 0, b3 = (lane & 8) != 0, b2 = (lane & 4) != 0;
#pragma unroll
    for (int i = 0; i < 8; ++i) { const float send = b5 ? v[i] : v[8 + i], keep = b5 ? v[8 + i] : v[i]; a[i] = keep + sx32(send, b5); }
#pragma unroll
    for (int i = 0; i < 4; ++i) { const float send = b4 ? a[i] : a[4 + i], keep = b4 ? a[4 + i] : a[i]; b[i] = keep + sx<16>(send); }
#pragma unroll
    for (int i = 0; i < 2; ++i) { const float send = b3 ? b[i] : b[2 + i], keep = b3 ? b[2 + i] : b[i]; c[i] = keep + sx<8>(send); }
    const float send = b2 ? c[0] : c[1], keep = b2 ? c[1] : c[0];
    float d = keep + sx<4>(send);
    d += sx<1>(d); d += sx<2>(d);
    return d;
}
__device__ __forceinline__ float reduce8(const float (&v)[8], int lane) {
    float b[4], c[2];
    const bool b5 = (lane & 32) != 0, b4 = (lane & 16) != 0, b3 = (lane & 8) != 0;
#pragma unroll
    for (int i = 0; i < 4; ++i) { const float send = b5 ? v[i] : v[4 + i], keep = b5 ? v[4 + i] : v[i]; b[i] = keep + sx32(send, b5); }
#pragma unroll
    for (int i = 0; i < 2; ++i) { const float send = b4 ? b[i] : b[2 + i], keep = b4 ? b[2 + i] : b[i]; c[i] = keep + sx<16>(send); }
    const float send = b3 ? c[0] : c[1], keep = b3 ? c[1] : c[0];
    float d = keep + sx<8>(send);
    d += sx<1>(d); d += sx<2>(d); d += sx<4>(d);
    return d;
}

__device__ __forceinline__ void row_norm_store8(const f32x4 (&v)[4], const RowConst& rc, f32x4 (&h)[4], unsigned char* hrow, int lane) {
    float ss = 0.f;
#pragma unroll
    for (int j = 0; j < 4; ++j) ss += (v[j][0] * v[j][0] + v[j][1] * v[j][1]) + (v[j][2] * v[j][2] + v[j][3] * v[j][3]);
    const float r = 1.0f / sqrtf(wave_sum(ss) * (1.0f / DM) + EPS);
#pragma unroll
    for (int j = 0; j < 4; ++j) { h[j] = v[j] * r * rc.a[j] + rc.b[j];
        *(unsigned*)(hrow + 256 * j + 4 * lane) = cvt4_fp8(h[j][0] * S8_H, h[j][1] * S8_H, h[j][2] * S8_H, h[j][3] * S8_H); }
}
__device__ __forceinline__ void row_norm_store_i8(const f32x4 (&v)[4], const RowConst& rc, f32x4 (&h)[4], unsigned char* hrow, float* rs_out, int lane) {
    float ss = 0.f;
#pragma unroll
    for (int j = 0; j < 4; ++j) ss += (v[j][0] * v[j][0] + v[j][1] * v[j][1]) + (v[j][2] * v[j][2] + v[j][3] * v[j][3]);
    const float r = 1.0f / sqrtf(wave_sum(ss) * (1.0f / DM) + EPS);
    float mx = 0.f;
#pragma unroll
    for (int j = 0; j < 4; ++j) { h[j] = v[j] * r * rc.a[j] + rc.b[j]; mx = fmaxf(fmaxf(mx, fmaxf(fabsf(h[j][0]), fabsf(h[j][1]))), fmaxf(fabsf(h[j][2]), fabsf(h[j][3]))); }
    mx = fmaxf(wave_max(mx), 1e-20f);
    const float qs = 127.0f / mx;
#pragma unroll
    for (int j = 0; j < 4; ++j) *(unsigned*)(hrow + 256 * j + 4 * lane) = pack4_i8(h[j][0] * qs, h[j][1] * qs, h[j][2] * qs, h[j][3] * qs);
    if (lane == 0) *rs_out = mx * (1.0f / 127.0f);
}
__device__ __forceinline__ void phase_hprep0(unsigned char* lds_, int wv, const Params& p) {
    const Frame F = make_frame(lds_, wv);
    LAS f32x4* Wg = (LAS f32x4*)F.lds;
    for (int idx = F.tid; idx < 2048; idx += NTHREADS) { const int ln = idx & 63, half = (idx >> 6) & 1, i = (idx >> 7) & 3, j = idx >> 9; const int c = 256 * j + 4 * ln + i;
        Wg[idx] = *(const f32x4*)(p.a_w_in + (size_t)c * 3080 + 3072 + half * 4); }
    __syncthreads();
    const float* mod = (const float*)(p.ws + WS_MOD);
    unsigned char* H = p.ws + WS_H; float* gates = (float*)(p.ws + WS_GATES);
    const float bif = p.a_b_if[F.lane & 7];
    float* cst = (float*)(p.ws + WS_CS);
    const float invf_tab[8] = {1.0f, 0.19391788f, 0.037604144f, 0.0072920943f, 0.0014140673f, 0.00027421273f, 5.3174683e-05f, 1.0311522e-05f};
    float invf = 0.f;
#pragma unroll
    for (int i = 0; i < 8; ++i) if ((F.lane & 7) == i) invf = invf_tab[i];
    for (int chunk = F.bid; chunk < 256; chunk += F.G) {
        const int row0 = chunk * 128 + F.wave * 16; const int b = row0 / SEQ;
        const RowConst rc = load_rowconst(p.norm1, mod + (size_t)b * 6144, 0, 1024, F.lane);
        for (int rb = 0; rb < 16; rb += 4) {
            f32x4 v[4][4];
#pragma unroll
            for (int rr = 0; rr < 4; ++rr)
#pragma unroll
                for (int j = 0; j < 4; ++j) v[rr][j] = __builtin_nontemporal_load((const f32x4*)(p.x + (size_t)(row0 + rb + rr) * DM + 256 * j + 4 * F.lane));
            f32x4 h[4][4];
#pragma unroll
            for (int rr = 0; rr < 4; ++rr) { const size_t row_ = (size_t)(row0 + rb + rr);
                if (WQ_IN0 == 2) row_norm_store_i8(v[rr], rc, h[rr], H + row_ * DM, (float*)(p.ws + SC_RS_H) + row_, F.lane);
                else if (WQ_IN0 == 1) row_norm_store8(v[rr], rc, h[rr], H + row_ * DM, F.lane);
                else row_norm_store(v[rr], rc, h[rr], (bf16_t*)H + row_ * DM, F.lane); }
            float g[4][8];
#pragma unroll
            for (int rr = 0; rr < 4; ++rr)
#pragma unroll
                for (int q = 0; q < 8; ++q) g[rr][q] = 0.f;
#pragma unroll
            for (int j = 0; j < 4; ++j)
#pragma unroll
                for (int i = 0; i < 4; ++i) { if (i == 0 || i == 2) asm volatile("" ::: "memory");
                    const f32x4 w0 = Wg[((j * 4 + i) * 2 + 0) * 64 + F.lane], w1 = Wg[((j * 4 + i) * 2 + 1) * 64 + F.lane];
#pragma unroll
                    for (int rr = 0; rr < 4; ++rr) { const float hv = h[rr][j][i];
                        g[rr][0] += hv * w0[0]; g[rr][1] += hv * w0[1]; g[rr][2] += hv * w0[2]; g[rr][3] += hv * w0[3]; g[rr][4] += hv * w1[0]; g[rr][5] += hv * w1[1]; g[rr][6] += hv * w1[2]; g[rr][7] += hv * w1[3]; } }
#pragma unroll
            for (int rr = 0; rr < 4; ++rr) { const int row = row0 + rb + rr;
                const float d = reduce8(g[rr], F.lane);
                const float mine = bperm(d, 8 * (F.lane & 7));
                if (F.lane < 16) { const float ang = (float)p.positions[row] * invf; const double rev = (double)ang * 0.15915494309189535; const float frc = (float)(rev - rint(rev));
                    cst[(size_t)row * 16 + F.lane] = (F.lane < 8) ? __builtin_amdgcn_cosf(frc) : __builtin_amdgcn_sinf(frc); }
                if (F.lane < 8) { float val = mine + bif;
                    if (F.lane >= 4) val = fminf(val, 0.f) - log1pf(expf(-fabsf(val)));
                    gates[(size_t)row * 8 + F.lane] = val; }
            }
        }
    }
}

namespace mls {
constexpr int RSK = 272, RSV = 176, RSP = 272, RSC = 272;
constexpr int OFF_K = 0, OFF_V = 34816, OFF_P = OFF_V + 22528, OFF_C = OFF_P + 34816, OFF_G = OFF_C + 21760;
typedef short v4i16_t __attribute__((ext_vector_type(4)));
__device__ __forceinline__ bf16x8 tr2(const LAS unsigned char* base, int row, int col, int rs, int lane) {
    const int i = lane & 15, g = lane >> 4;
    const LAS unsigned char* p0 = base + (row + 8 * g + (i >> 2)) * rs + (col + 4 * (i & 3)) * 2;
    const s16x4 lo = __builtin_bit_cast(s16x4, __builtin_amdgcn_ds_read_tr16_b64_v4i16((LAS v4i16_t*)p0));
    const s16x4 hi = __builtin_bit_cast(s16x4, __builtin_amdgcn_ds_read_tr16_b64_v4i16((LAS v4i16_t*)(p0 + 4 * rs)));
    return (bf16x8){lo[0], lo[1], lo[2], lo[3], hi[0], hi[1], hi[2], hi[3]};
}
}
__device__ __forceinline__ void phase_mlstm(unsigned char* lds_, int wv, const Params& p) {
    const Frame F = make_frame(lds_, wv);
    using namespace mls;
    const bf16_t* PR = (const bf16_t*)(p.ws + WS_PROJ); const float* gates = (const float*)(p.ws + WS_GATES); bf16_t* HO = (bf16_t*)(p.ws + WS_HOUT);
    LAS unsigned char* Ks = F.lds + OFF_K; LAS unsigned char* Vs = F.lds + OFF_V; LAS unsigned char* Ps = F.lds + OFF_P; LAS unsigned char* Cs = F.lds + OFF_C;
    LAS float* gbase = (LAS float*)(F.lds + OFF_G);
    const int w = F.wave, lane = F.lane, c = lane & 15, g = lane >> 4, tid = F.tid;
    for (int item = F.vcu; item < 256; item += F.G) {
        const int bh = item >> 2, sl = item & 3, b = bh >> 2, h = bh & 3;
        const size_t tok0 = (size_t)b * SEQ;
        const bf16_t* Qg = PR + h * 128; const bf16_t* Kg = PR + 512 + h * 128; const bf16_t* Vg = PR + 1024 + h * 256 + sl * 64;
        __syncthreads();
        if (tid < 256) { const int row = tid >> 1, part = tid & 1; u32x4 z = {0u, 0u, 0u, 0u}; if (part == 0) z.x = 0x3F80u; *(LAS u32x4*)(Vs + row * RSV + 128 + part * 16) = z; }
        f32x4 cacc[5];
#pragma unroll
        for (int vt = 0; vt < 5; ++vt) cacc[vt] = (f32x4){0.f, 0.f, 0.f, 0.f};
        for (int i = tid; i < 80 * RSC / 16; i += NTHREADS) *(LAS u32x4*)(Cs + i * 16) = (u32x4){0u, 0u, 0u, 0u};
        float m_prev = 0.f;
        u32x4 kst[4], vst[2]; bf16x8 qf[4], qn[4]; float glf0 = 0.f, glf1 = 0.f, gi0 = 0.f, gi1 = 0.f;
        auto load_chunk = [&](int ch) {
            const size_t t0 = tok0 + (size_t)ch * 128;
#pragma unroll
            for (int k = 0; k < 4; ++k) { const int pc = tid + 512 * k, row = pc >> 4, c16 = pc & 15; kst[k] = *(const u32x4*)(Kg + (t0 + row) * 3072 + c16 * 8); }
#pragma unroll
            for (int k = 0; k < 2; ++k) { const int pc = tid + 512 * k, row = pc >> 3, c16 = pc & 7; vst[k] = *(const u32x4*)(Vg + (t0 + row) * 3072 + c16 * 8); }
#pragma unroll
            for (int ks = 0; ks < 4; ++ks) qn[ks] = *(const bf16x8*)(Qg + (t0 + 16 * w + c) * 3072 + 32 * ks + 8 * g);
            if (w == 0) { const float* gp = gates + (t0 + 2 * lane) * 8; gi0 = gp[h]; glf0 = gp[4 + h]; gi1 = gp[8 + h]; glf1 = gp[12 + h]; }
        };
        auto gate_scan = [&](LAS float* gs) {
            LAS float* gu = gs; LAS float* gwv = gs + 128; LAS float* gin = gs + 256; LAS float* gfl = gs + 384; LAS float* gwg = gs + 512;
            float s = glf0 + glf1;
#pragma unroll
            for (int d = 1; d < 64; d <<= 1) { const float t = bperm(s, (lane - d) & 63); if (lane >= d) s += t; }
            const float b1 = s, b0 = s - glf1;
            const float u0 = gi0 - b0, u1 = gi1 - b1;
            float m = fmaxf(u0, u1);
#pragma unroll
            for (int d = 1; d < 64; d <<= 1) { const float t = bperm(m, (lane - d) & 63); if (lane >= d) m = fmaxf(m, t); }
            float ex = bperm(m, (lane - 1) & 63); if (lane == 0) ex = -INFINITY;
            const float wv0 = fmaxf(fmaxf(ex, u0), m_prev), wv1 = fmaxf(m, m_prev);
            const float wlast = rdlane(wv1, 63), blast = rdlane(b1, 63);
            gu[2 * lane] = u0; gu[2 * lane + 1] = u1; gwv[2 * lane] = wv0; gwv[2 * lane + 1] = wv1;
            gin[2 * lane] = __expf(m_prev - wv0); gin[2 * lane + 1] = __expf(m_prev - wv1);
            gfl[2 * lane] = __expf(-(b0 + wv0)); gfl[2 * lane + 1] = __expf(-(b1 + wv1));
            gwg[2 * lane] = __expf(u0 - wlast); gwg[2 * lane + 1] = __expf(u1 - wlast);
            m_prev = blast + wlast;
        };
        auto store_chunk = [&]() {
#pragma unroll
            for (int k = 0; k < 4; ++k) { const int pc = tid + 512 * k, row = pc >> 4, c16 = pc & 15; *(LAS u32x4*)(Ks + row * RSK + c16 * 16) = kst[k]; }
#pragma unroll
            for (int k = 0; k < 2; ++k) { const int pc = tid + 512 * k, row = pc >> 3, c16 = pc & 7; *(LAS u32x4*)(Vs + row * RSV + c16 * 16) = vst[k]; }
#pragma unroll
            for (int ks = 0; ks < 4; ++ks) qf[ks] = qn[ks];
        };
        load_chunk(0);
        store_chunk();
        if (w == 0) gate_scan(gbase);
        __syncthreads();
        for (int ch = 0; ch < 16; ++ch) {
            LAS float* gs = gbase + (ch & 1) * 640;
            LAS float* gu = gs; LAS float* gwv = gs + 128; LAS float* gin = gs + 256; LAS float* gfl = gs + 384; LAS float* gwg = gs + 512;
            if (ch < 15) load_chunk(ch + 1);
            {
                const int t = 16 * w + c; const float wt = gwv[t];
#pragma unroll
                for (int jp = 0; jp < 4; ++jp) {
                    if (2 * jp <= w) {
                        f32x4 sa0 = (f32x4){0.f, 0.f, 0.f, 0.f}, sa1 = sa0;
#pragma unroll
                        for (int ks = 0; ks < 4; ++ks) { const bf16x8 kf0 = *(const LAS bf16x8*)(Ks + (32 * jp + c) * RSK + (32 * ks + 8 * g) * 2), kf1 = *(const LAS bf16x8*)(Ks + (32 * jp + 16 + c) * RSK + (32 * ks + 8 * g) * 2);
                            sa0 = __builtin_amdgcn_mfma_f32_16x16x32_bf16(kf0, qf[ks], sa0, 0, 0, 0); sa1 = __builtin_amdgcn_mfma_f32_16x16x32_bf16(kf1, qf[ks], sa1, 0, 0, 0); }
                        const f32x4 uv0 = *(const LAS f32x4*)(gu + 32 * jp + 4 * g), uv1 = *(const LAS f32x4*)(gu + 32 * jp + 16 + 4 * g);
                        float p0_[4], p1_[4];
#pragma unroll
                        for (int r = 0; r < 4; ++r) { const int s0 = 32 * jp + 4 * g + r, s1 = s0 + 16;
                            const float e0 = __expf(uv0[r] - wt), e1 = __expf(uv1[r] - wt); p0_[r] = (s0 <= t) ? sa0[r] * e0 : 0.f; p1_[r] = (s1 <= t) ? sa1[r] * e1 : 0.f; }
                        u32x2 pk0, pk1; pk0.x = cvtpk(p0_[0], p0_[1]); pk0.y = cvtpk(p0_[2], p0_[3]); pk1.x = cvtpk(p1_[0], p1_[1]); pk1.y = cvtpk(p1_[2], p1_[3]);
                        *(LAS u32x2*)(Ps + t * RSP + (32 * jp + 4 * g) * 2) = pk0; *(LAS u32x2*)(Ps + t * RSP + (32 * jp + 16 + 4 * g) * 2) = pk1;
                    }
                }
            }
            f32x4 nacc[5];
#pragma unroll
            for (int vt = 0; vt < 5; ++vt) { nacc[vt] = (f32x4){0.f, 0.f, 0.f, 0.f};
#pragma unroll
                for (int ks = 0; ks < 4; ++ks) { const bf16x8 cf = *(const LAS bf16x8*)(Cs + (16 * vt + c) * RSC + (32 * ks + 8 * g) * 2); nacc[vt] = __builtin_amdgcn_mfma_f32_16x16x32_bf16(cf, qf[ks], nacc[vt], 0, 0, 0); } }
            { const float iv = gin[16 * w + c];
#pragma unroll
              for (int vt = 0; vt < 5; ++vt) nacc[vt] = nacc[vt] * iv; }
            if (w == 0 && ch < 15) gate_scan(gbase + ((ch + 1) & 1) * 640);
            for (int ks = 0; ks <= (w >> 1); ++ks) {
                const bf16x8 pf = *(const LAS bf16x8*)(Ps + (16 * w + c) * RSP + (32 * ks + 8 * g) * 2);
#pragma unroll
                for (int vt = 0; vt < 5; ++vt) { const bf16x8 vf = tr2(Vs, 32 * ks, 16 * vt, RSV, lane); nacc[vt] = __builtin_amdgcn_mfma_f32_16x16x32_bf16(vf, pf, nacc[vt], 0, 0, 0); }
            }
            { const float den = bperm(nacc[4][0], lane & 15); const float inv = 1.0f / fmaxf(fabsf(den), gfl[16 * w + c]);
              bf16_t* orow = HO + (tok0 + (size_t)ch * 128 + 16 * w + c) * DM + h * 256 + sl * 64 + 4 * g;
#pragma unroll
              for (int vt = 0; vt < 4; ++vt) { u32x2 pk; pk.x = cvtpk(nacc[vt][0] * inv, nacc[vt][1] * inv); pk.y = cvtpk(nacc[vt][2] * inv, nacc[vt][3] * inv); *(u32x2*)(orow + 16 * vt) = pk; } }
            { const float decay = gin[127];
#pragma unroll
              for (int vt = 0; vt < 5; ++vt) cacc[vt] = cacc[vt] * decay;
#pragma unroll
              for (int ks = 0; ks < 4; ++ks) {
                  bf16x8 kf = tr2(Ks, 32 * ks, 16 * w, RSK, lane);
                  const f32x4 w0 = *(const LAS f32x4*)(gwg + 32 * ks + 8 * g), w1 = *(const LAS f32x4*)(gwg + 32 * ks + 8 * g + 4);
                  u32x4 kw = __builtin_bit_cast(u32x4, kf);
                  kw.x = cvtpk(bflo(kw.x) * w0[0], bfhi(kw.x) * w0[1]); kw.y = cvtpk(bflo(kw.y) * w0[2], bfhi(kw.y) * w0[3]);
                  kw.z = cvtpk(bflo(kw.z) * w1[0], bfhi(kw.z) * w1[1]); kw.w = cvtpk(bflo(kw.w) * w1[2], bfhi(kw.w) * w1[3]);
                  kf = __builtin_bit_cast(bf16x8, kw);
#pragma unroll
                  for (int vt = 0; vt < 5; ++vt) { const bf16x8 vf = tr2(Vs, 32 * ks, 16 * vt, RSV, lane); cacc[vt] = __builtin_amdgcn_mfma_f32_16x16x32_bf16(kf, vf, cacc[vt], 0, 0, 0); }
              } }
            asm volatile("s_waitcnt lgkmcnt(0)\n\ts_barrier" ::: "memory");
#pragma unroll
            for (int vt = 0; vt < 5; ++vt) { u32x2 pk; pk.x = cvtpk(cacc[vt][0], cacc[vt][1]); pk.y = cvtpk(cacc[vt][2], cacc[vt][3]); *(LAS u32x2*)(Cs + (16 * vt + c) * RSC + (16 * w + 4 * g) * 2) = pk; }
            if (ch < 15) store_chunk();
            __syncthreads();
        }
    }
}

__device__ __forceinline__ void phase_aprep(unsigned char* lds_, int wv, const Params& p) {
    const Frame F = make_frame(lds_, wv);
    const bf16_t* HO = (const bf16_t*)(p.ws + WS_HOUT); const bf16_t* PR = (const bf16_t*)(p.ws + WS_PROJ); unsigned char* A2 = p.ws + WS_H;
    float hn[16];
#pragma unroll
    for (int i = 0; i < 16; ++i) hn[i] = p.a_h_norm[16 * F.lane + i];
    const int gw = F.bid * NWAVES + F.wave, NGW = F.G * NWAVES;
    for (int rowb = gw; rowb < NTOK; rowb += 4 * NGW) {
        u32x4 h0[4], h1[4], o0[4], o1[4];
#pragma unroll
        for (int rr = 0; rr < 4; ++rr) { const int row = rowb + rr * NGW; if (row < NTOK) {
            h0[rr] = *(const u32x4*)(HO + (size_t)row * DM + 16 * F.lane); h1[rr] = *(const u32x4*)(HO + (size_t)row * DM + 16 * F.lane + 8);
            o0[rr] = *(const u32x4*)(PR + (size_t)row * 3072 + 2048 + 16 * F.lane); o1[rr] = *(const u32x4*)(PR + (size_t)row * 3072 + 2048 + 16 * F.lane + 8); } }
#pragma unroll
        for (int rr = 0; rr < 4; ++rr) { const int row = rowb + rr * NGW; if (row < NTOK) {
            float hv[16], ov[16];
#pragma unroll
            for (int i = 0; i < 4; ++i) { hv[2 * i] = bflo(h0[rr][i]); hv[2 * i + 1] = bfhi(h0[rr][i]); hv[8 + 2 * i] = bflo(h1[rr][i]); hv[8 + 2 * i + 1] = bfhi(h1[rr][i]);
                ov[2 * i] = bflo(o0[rr][i]); ov[2 * i + 1] = bfhi(o0[rr][i]); ov[8 + 2 * i] = bflo(o1[rr][i]); ov[8 + 2 * i + 1] = bfhi(o1[rr][i]); }
            float ss = 0.f;
#pragma unroll
            for (int i = 0; i < 16; ++i) ss += hv[i] * hv[i];
            ss += sx<1>(ss); ss += sx<2>(ss); ss += sx<4>(ss); ss += sx<8>(ss);
            const float r = 1.0f / sqrtf(ss * (1.0f / 256.0f) + EPS);
            float y[16];
#pragma unroll
            for (int i = 0; i < 16; ++i) y[i] = hv[i] * r * hn[i] * sigmoidf_(ov[i]);
            if (WQ_OUT0 == 2) { float mx = 0.f;
#pragma unroll
                for (int i = 0; i < 16; ++i) mx = fmaxf(mx, fabsf(y[i]));
                mx = fmaxf(wave_max(mx), 1e-20f); const float qs = 127.0f / mx;
                u32x4 w; w.x = pack4_i8(y[0] * qs, y[1] * qs, y[2] * qs, y[3] * qs); w.y = pack4_i8(y[4] * qs, y[5] * qs, y[6] * qs, y[7] * qs); w.z = pack4_i8(y[8] * qs, y[9] * qs, y[10] * qs, y[11] * qs); w.w = pack4_i8(y[12] * qs, y[13] * qs, y[14] * qs, y[15] * qs);
                *(u32x4*)(A2 + (size_t)row * DM + 16 * F.lane) = w; if (F.lane == 0) ((float*)(p.ws + SC_RS_A))[row] = mx * (1.0f / 127.0f); }
            else if (OUTPROJ_FP8) { u32x4 w; w.x = cvt4_fp8(y[0] * S8_A2, y[1] * S8_A2, y[2] * S8_A2, y[3] * S8_A2); w.y = cvt4_fp8(y[4] * S8_A2, y[5] * S8_A2, y[6] * S8_A2, y[7] * S8_A2);
                w.z = cvt4_fp8(y[8] * S8_A2, y[9] * S8_A2, y[10] * S8_A2, y[11] * S8_A2); w.w = cvt4_fp8(y[12] * S8_A2, y[13] * S8_A2, y[14] * S8_A2, y[15] * S8_A2);
                *(u32x4*)(A2 + (size_t)row * DM + 16 * F.lane) = w; }
            else { bf16_t* a2b = (bf16_t*)(p.ws + WS_A2B) + (size_t)row * DM + 16 * F.lane; u32x4 w0, w1;
                w0.x = cvtpk(y[0], y[1]); w0.y = cvtpk(y[2], y[3]); w0.z = cvtpk(y[4], y[5]); w0.w = cvtpk(y[6], y[7]); w1.x = cvtpk(y[8], y[9]); w1.y = cvtpk(y[10], y[11]); w1.z = cvtpk(y[12], y[13]); w1.w = cvtpk(y[14], y[15]);
                *(u32x4*)a2b = w0; *(u32x4*)(a2b + 8) = w1; }
            } }
    }
}

__device__ __forceinline__ void phase_hprep_router(unsigned char* lds_, int wv, const Params& p, int layer, int xnx, int xdx, int xper, int xj, const unsigned* oflags) {
    const Frame F = make_frame(lds_, wv);
    LAS u32x4* Wf = (LAS u32x4*)F.lds;
    LAS float* mulc = (LAS float*)(F.lds + 65536);
    LAS float* addc = (LAS float*)(F.lds + 65536 + 4096);
    LAS int* cnt = (LAS int*)(F.lds + 73728);
    LAS float* lgs = (LAS float*)(F.lds + 73728 + 64);
    const float* mod = (const float*)(p.ws + WS_MOD) + (size_t)layer * 16 * 6144;
    unsigned char* H = p.ws + WS_H;
    const bf16_t* XB = (const bf16_t*)(p.ws + WS_XB);
    int* blkcnt = (int*)(p.ws + RT_BLKCNT); int* info = (int*)(p.ws + RT_INFO); float* tw = (float*)(p.ws + RT_W);
    if (F.bid == 0) { for (int i = F.tid; i < 256 * DM / 16; i += NTHREADS) *(u32x4*)(H + (size_t)NTOK * DM + i * 16) = (u32x4){0u, 0u, 0u, 0u}; }
    float rb[16];
#pragma unroll
    for (int e = 0; e < 16; ++e) rb[e] = p.router_bias[e];
    const int ctlo = 2 * ((xdx * 128) / xnx), cthi = 2 * (((xdx + 1) * 128) / xnx);
    bool first = true;
    for (int chunk = ctlo + xj; chunk < cthi; chunk += xper) {
        int lane = F.lane; asm volatile("" : "+v"(lane));
        const int fr = lane & 15, fq = lane >> 4;
        const int row = chunk * 128 + F.wave * 16 + fr; const int b = (chunk * 128) / SEQ;
        if (first) { first = false;
            for (int idx = F.tid; idx < 2048; idx += NTHREADS) { const int ln = idx & 63, ks = idx >> 6; const int col0 = 64 * (ks >> 1) + 16 * (ln >> 4) + 8 * (ks & 1);
                const float* wp = p.w_router + (size_t)col0 * 16 + (ln & 15); u32x4 hi, lo;
#pragma unroll
                for (int i = 0; i < 4; ++i) { const float a = wp[(2 * i) * 16], c = wp[(2 * i + 1) * 16]; const unsigned u = cvtpk(a, c); hi[i] = u; lo[i] = cvtpk(a - bflo(u), c - bfhi(u)); }
                Wf[idx] = hi; Wf[2048 + idx] = lo; } }
        for (int c = F.tid; c < DM; c += NTHREADS) { mulc[c] = p.norm2[(size_t)layer * DM + c] * (1.0f + mod[(size_t)b * 6144 + 4096 + c]); addc[c] = mod[(size_t)b * 6144 + 3072 + c]; }
        if (oflags) { unsigned sp = 0u; while (xb_ld((unsigned*)oflags + (chunk >> 1)) < 32u) { __builtin_amdgcn_s_sleep(2); if (++sp > (1u << 22)) break; } asm volatile("" ::: "memory"); }
        u32x4 xv[16][2];
        { const bf16_t* xrow = XB + (size_t)row * DM + 16 * fq;
#pragma unroll
          for (int s = 0; s < 16; ++s) { xv[s][0] = *(const u32x4*)(xrow + 64 * s); xv[s][1] = *(const u32x4*)(xrow + 64 * s + 8); } }
        if (F.tid < 16) cnt[F.tid] = 0;
        __syncthreads();
        float ss = 0.f;
#pragma unroll
        for (int s = 0; s < 16; ++s)
#pragma unroll
            for (int t = 0; t < 2; ++t)
#pragma unroll
                for (int i = 0; i < 4; ++i) { const float a = bflo(xv[s][t][i]), c = bfhi(xv[s][t][i]); ss += a * a + c * c; }
        ss += sx<16>(ss); ss += sx32(ss, lane >= 32);
        const float r = 1.0f / sqrtf(ss * (1.0f / DM) + EPS);
        f32x4 acc0 = (f32x4){0.f, 0.f, 0.f, 0.f}, acc1 = acc0, acc2 = acc0;
        unsigned char* hrow = H + (size_t)row * DM + 16 * fq;
#pragma unroll
        for (int s = 0; s < 16; ++s) {
            asm volatile("" ::: "memory");
            float h[16];
#pragma unroll
            for (int q = 0; q < 4; ++q) { const f32x4 m = *(const LAS f32x4*)(mulc + 64 * s + 16 * fq + 4 * q), a = *(const LAS f32x4*)(addc + 64 * s + 16 * fq + 4 * q);
                unsigned w0 = xv[s][q >> 1][(q & 1) * 2], w1 = xv[s][q >> 1][(q & 1) * 2 + 1]; asm volatile("" : "+v"(w0), "+v"(w1));
                h[4 * q] = bflo(w0) * r * m[0] + a[0]; h[4 * q + 1] = bfhi(w0) * r * m[1] + a[1]; h[4 * q + 2] = bflo(w1) * r * m[2] + a[2]; h[4 * q + 3] = bfhi(w1) * r * m[3] + a[3]; }
            u32x4 o; o.x = cvt4_fp8(h[0] * S8_H, h[1] * S8_H, h[2] * S8_H, h[3] * S8_H); o.y = cvt4_fp8(h[4] * S8_H, h[5] * S8_H, h[6] * S8_H, h[7] * S8_H);
            o.z = cvt4_fp8(h[8] * S8_H, h[9] * S8_H, h[10] * S8_H, h[11] * S8_H); o.w = cvt4_fp8(h[12] * S8_H, h[13] * S8_H, h[14] * S8_H, h[15] * S8_H);
            *(u32x4*)(hrow + 64 * s) = o;
#pragma unroll
            for (int t = 0; t < 2; ++t) { u32x4 hi, lo;
#pragma unroll
                for (int i = 0; i < 4; ++i) { const float a = h[8 * t + 2 * i], c = h[8 * t + 2 * i + 1]; const unsigned u = cvtpk(a, c); hi[i] = u; lo[i] = cvtpk(a - bflo(u), c - bfhi(u)); }
                const int ks = 2 * s + t;
                const bf16x8 whi = __builtin_bit_cast(bf16x8, Wf[ks * 64 + lane]), wlo = __builtin_bit_cast(bf16x8, Wf[2048 + ks * 64 + lane]);
                const bf16x8 hh = __builtin_bit_cast(bf16x8, hi), hl = __builtin_bit_cast(bf16x8, lo);
                acc0 = __builtin_amdgcn_mfma_f32_16x16x32_bf16(whi, hh, acc0, 0, 0, 0);
                acc1 = __builtin_amdgcn_mfma_f32_16x16x32_bf16(wlo, hh, acc1, 0, 0, 0);
                acc2 = __builtin_amdgcn_mfma_f32_16x16x32_bf16(whi, hl, acc2, 0, 0, 0); }
        }
        { const f32x4 tot = acc0 + (acc1 + acc2);
#pragma unroll
          for (int rr = 0; rr < 4; ++rr) lgs[(F.wave * 16 + fr) * 17 + 4 * fq + rr] = tot[rr]; }
        __syncthreads();
        if (F.tid < 128) {
            const int row = chunk * 128 + F.tid;
            float sc[16], bs[16];
#pragma unroll
            for (int e = 0; e < 16; ++e) { sc[e] = 1.0f / (1.0f + expf(-lgs[F.tid * 17 + e])); bs[e] = sc[e] + rb[e]; }
            int gsel = 0; float gbest = -INFINITY;
#pragma unroll
            for (int gI = 0; gI < 4; ++gI) { const float a = bs[4 * gI], b2 = bs[4 * gI + 1], c2 = bs[4 * gI + 2], d2 = bs[4 * gI + 3];
                const float hi1 = fmaxf(a, b2), lo1 = fminf(a, b2), hi2 = fmaxf(c2, d2), lo2 = fminf(c2, d2);
                const float top = fmaxf(hi1, hi2), sec = fmaxf(fminf(hi1, hi2), fmaxf(lo1, lo2)); const float gs = top + sec;
                if (gs > gbest) { gbest = gs; gsel = gI; } }
            float v0 = 0.f, v1 = 0.f, v2 = 0.f, v3 = 0.f, s0 = 0.f, s1 = 0.f, s2 = 0.f, s3 = 0.f;
#pragma unroll
            for (int gI = 0; gI < 4; ++gI) if (gI == gsel) { v0 = bs[4 * gI]; v1 = bs[4 * gI + 1]; v2 = bs[4 * gI + 2]; v3 = bs[4 * gI + 3]; s0 = sc[4 * gI]; s1 = sc[4 * gI + 1]; s2 = sc[4 * gI + 2]; s3 = sc[4 * gI + 3]; }
            int i1 = 0; float b1 = v0; if (v1 > b1) { b1 = v1; i1 = 1; } if (v2 > b1) { b1 = v2; i1 = 2; } if (v3 > b1) { b1 = v3; i1 = 3; }
            int i2 = -1; float bb = -INFINITY;
            if (i1 != 0 && v0 > bb) { bb = v0; i2 = 0; } if (i1 != 1 && v1 > bb) { bb = v1; i2 = 1; } if (i1 != 2 && v2 > bb) { bb = v2; i2 = 2; } if (i1 != 3 && v3 > bb) { bb = v3; i2 = 3; }
            const float sa = (i1 == 0) ? s0 : (i1 == 1) ? s1 : (i1 == 2) ? s2 : s3;
            const float sb = (i2 == 0) ? s0 : (i2 == 1) ? s1 : (i2 == 2) ? s2 : s3;
            const int e0 = gsel * 4 + i1, e1 = gsel * 4 + i2;
            const int r0 = __hip_atomic_fetch_add(&cnt[e0], 1, __ATOMIC_RELAXED, __HIP_MEMORY_SCOPE_WORKGROUP); const int r1 = __hip_atomic_fetch_add(&cnt[e1], 1, __ATOMIC_RELAXED, __HIP_MEMORY_SCOPE_WORKGROUP);
            info[row] = e0 | (e1 << 4) | (r0 << 8) | (r1 << 16); const float inv = 1.0f / (sa + sb); *(f32x2*)(tw + (size_t)row * 2) = (f32x2){sa * inv, sb * inv};
        }
        __syncthreads();
        if (F.tid < 16) blkcnt[chunk * 16 + F.tid] = cnt[F.tid];
        __syncthreads();
    }
}

__device__ __forceinline__ void phase_layout(unsigned char* lds_, int wv, const Params& p) {
    const Frame F = make_frame(lds_, wv);
    LAS int* lc = (LAS int*)F.lds;
    LAS int* tot = lc + 4096;
    LAS int* sst = tot + 16;
    LAS int* tst = sst + 16;
    const int* blkcnt = (const int*)(p.ws + RT_BLKCNT); const int* info = (const int*)(p.ws + RT_INFO);
    int* dest = (int*)(p.ws + RT_DEST); int* buftok = (int*)(p.ws + RT_BUFTOK); int* meta = (int*)(p.ws + RT_META);
    for (int i = F.tid; i < 4096; i += NTHREADS) lc[i] = blkcnt[i];
    __syncthreads();
    { const int e = F.tid >> 5, li = F.tid & 31; int v[8]; int s = 0;
      LAS int* part = tst + 32;
#pragma unroll
      for (int k = 0; k < 8; ++k) { v[k] = lc[(8 * li + k) * 16 + e]; s += v[k]; }
      part[e * 32 + li] = s;
      __syncthreads();
      int run = 0, all = 0;
      for (int k = 0; k < 32; ++k) { const int t = part[e * 32 + k]; all += t; if (k < li) run += t; }
#pragma unroll
      for (int k = 0; k < 8; ++k) { lc[(8 * li + k) * 16 + e] = run; run += v[k]; }
      if (li == 31) tot[e] = all; }
    __syncthreads();
    if (F.tid == 0) { int ts = 0; for (int e = 0; e < 16; ++e) { tst[e] = ts; sst[e] = ts * 256; ts += (tot[e] + 255) >> 8; } tst[16] = ts;
        if (F.bid == 0) { meta[0] = ts; for (int e = 0; e <= 16; ++e) meta[1 + e] = tst[e]; } }
    __syncthreads();
    for (int chunk = F.bid; chunk < 256; chunk += F.G) {
        if (F.tid < 128) { const int tok = chunk * 128 + F.tid; const int inf = info[tok]; const int e0 = inf & 15, e1 = (inf >> 4) & 15, r0 = (inf >> 8) & 255, r1 = (inf >> 16) & 255;
            const int d0 = sst[e0] + lc[chunk * 16 + e0] + r0, d1 = sst[e1] + lc[chunk * 16 + e1] + r1;
            buftok[d0] = tok; buftok[d1] = tok; dest[tok * 2] = d0; dest[tok * 2 + 1] = d1; }
    }
    for (int e = F.bid; e < 16; e += F.G) { const int beg = sst[e] + tot[e], end = tst[e + 1] * 256; for (int s = beg + F.tid; s < end; s += NTHREADS) buftok[s] = NTOK; }
}

__device__ __forceinline__ void phase_combine(unsigned char* lds_, int wv, const Params& p, int layer, bool next_prep) {
    const Frame F = make_frame(lds_, wv);
    const float* mod = (const float*)(p.ws + WS_MOD) + (size_t)layer * 16 * 6144;
    const float* modn = (const float*)(p.ws + WS_MOD) + (size_t)(layer + 1) * 16 * 6144;
    const unsigned char* Y = p.ws + WS_PROJ; unsigned char* H = p.ws + WS_H;
    bf16_t* XB = (bf16_t*)(p.ws + WS_XB);
    const int* dest = (const int*)(p.ws + RT_DEST); const float* tw = (const float*)(p.ws + RT_W);
    for (int chunk = F.bid; chunk < 256; chunk += F.G) {
        const int row0 = chunk * 128 + F.wave * 16; const int b = row0 / SEQ;
        f32x4 g2[4];
#pragma unroll
        for (int j = 0; j < 4; ++j) g2[j] = *(const f32x4*)(mod + (size_t)b * 6144 + 5120 + 256 * j + 4 * F.lane) * (1.0f / S8_Y);
        RowConst rc;
        if (next_prep) rc = load_rowconst(p.norm1 + (size_t)(layer + 1) * DM, modn + (size_t)b * 6144, 0, 1024, F.lane);
        for (int rb = 0; rb < 16; rb += 4) {
            int d0[4], d1[4]; float w0[4], w1[4];
#pragma unroll
            for (int rr = 0; rr < 4; ++rr) { const int row = row0 + rb + rr; d0[rr] = dest[row * 2]; d1[rr] = dest[row * 2 + 1]; w0[rr] = tw[row * 2]; w1[rr] = tw[row * 2 + 1]; }
            u32x2 xr[4][4]; unsigned ya[4][4], yb[4][4];
#pragma unroll
            for (int rr = 0; rr < 4; ++rr)
#pragma unroll
                for (int j = 0; j < 4; ++j) { xr[rr][j] = *(const u32x2*)(XB + (size_t)(row0 + rb + rr) * DM + 256 * j + 4 * F.lane);
                    ya[rr][j] = *(const unsigned*)(Y + (size_t)d0[rr] * DM + 256 * j + 4 * F.lane); yb[rr][j] = *(const unsigned*)(Y + (size_t)d1[rr] * DM + 256 * j + 4 * F.lane); }
#pragma unroll
            for (int rr = 0; rr < 4; ++rr) { const int row = row0 + rb + rr;
                f32x4 v[4];
#pragma unroll
                for (int j = 0; j < 4; ++j) { const unsigned a = ya[rr][j], bq = yb[rr][j]; f32x4 yy;
                    const f32x2 a01 = __builtin_amdgcn_cvt_pk_f32_fp8((int)a, false), a23 = __builtin_amdgcn_cvt_pk_f32_fp8((int)a, true), b01 = __builtin_amdgcn_cvt_pk_f32_fp8((int)bq, false), b23 = __builtin_amdgcn_cvt_pk_f32_fp8((int)bq, true);
                    yy[0] = w0[rr] * a01[0] + w1[rr] * b01[0]; yy[1] = w0[rr] * a01[1] + w1[rr] * b01[1]; yy[2] = w0[rr] * a23[0] + w1[rr] * b23[0]; yy[3] = w0[rr] * a23[1] + w1[rr] * b23[1];
                    const f32x4 xv = (f32x4){bflo(xr[rr][j].x), bfhi(xr[rr][j].x), bflo(xr[rr][j].y), bfhi(xr[rr][j].y)};
                    v[j] = xv + g2[j] * yy;
                    if (next_prep) { u32x2 w; w.x = cvtpk(v[j][0], v[j][1]); w.y = cvtpk(v[j][2], v[j][3]); *(u32x2*)(XB + (size_t)row * DM + 256 * j + 4 * F.lane) = w; }
                    else *(f32x4*)(p.out + (size_t)row * DM + 256 * j + 4 * F.lane) = v[j]; }
                if (next_prep) { f32x4 h[4]; row_norm_store8(v, rc, h, H + (size_t)row * DM, F.lane); }
            }
        }
    }
}

__device__ __forceinline__ void phase_qkprep(unsigned char* lds_, int wv, const Params& p) {
    const Frame F = make_frame(lds_, wv);
    bf16_t* PR = (bf16_t*)(p.ws + WS_PROJ);
    const int lane = F.lane, half = lane & 1, sh = lane >> 1;
    float nw[32];
    { const float* nsrc = (sh < 16) ? p.b_q_norm : p.b_k_norm;
#pragma unroll
      for (int i = 0; i < 32; ++i) nw[i] = nsrc[half * 32 + i]; }
    const float qscale = (sh < 16) ? 0.125f * 1.4426950408889634f : 1.0f;
    const float invf_tab[8] = {1.0f, 0.19391788f, 0.037604144f, 0.0072920943f, 0.0014140673f, 0.00027421273f, 5.3174683e-05f, 1.0311522e-05f};
    float invf = 0.f;
#pragma unroll
    for (int i = 0; i < 8; ++i) if ((lane & 7) == i) invf = invf_tab[i];
    const int gw = F.bid * NWAVES + F.wave, NGW = F.G * NWAVES;
    for (int rowb = gw; rowb < NTOK; rowb += 4 * NGW) {
        u32x4 raw[4][4]; int posi[4];
#pragma unroll
        for (int rr = 0; rr < 4; ++rr) { const int row = rowb + rr * NGW; if (row < NTOK) { posi[rr] = p.positions[row]; const bf16_t* ptr = PR + (size_t)row * 3072 + sh * 64 + half * 32;
#pragma unroll
            for (int k = 0; k < 4; ++k) raw[rr][k] = *(const u32x4*)(ptr + 8 * k); } }
#pragma unroll
        for (int rr = 0; rr < 4; ++rr) { const int row = rowb + rr * NGW; if (row < NTOK) {
            const float ang = (float)posi[rr] * invf;
            const double rev = (double)ang * 0.15915494309189535; const float fr = (float)(rev - rint(rev));
            const float cs = __builtin_amdgcn_cosf(fr), sn = __builtin_amdgcn_sinf(fr);
            bf16_t* ptr = PR + (size_t)row * 3072 + sh * 64 + half * 32;
            float v[32];
#pragma unroll
            for (int k = 0; k < 4; ++k)
#pragma unroll
                for (int i = 0; i < 4; ++i) { v[8 * k + 2 * i] = bflo(raw[rr][k][i]); v[8 * k + 2 * i + 1] = bfhi(raw[rr][k][i]); }
            float ss = 0.f;
#pragma unroll
            for (int i = 0; i < 32; ++i) ss += v[i] * v[i];
            ss += sx<1>(ss);
            const float r = 1.0f / sqrtf(ss * (1.0f / 64.0f) + EPS);
#pragma unroll
            for (int i = 0; i < 32; ++i) v[i] = v[i] * r * nw[i];
            float y1[8], y2[8];
#pragma unroll
            for (int i = 0; i < 8; ++i) { const float ci = rdlane(cs, i), si = rdlane(sn, i); y1[i] = v[i] * ci - v[8 + i] * si; y2[i] = v[8 + i] * ci + v[i] * si; }
            if (half == 0) {
#pragma unroll
                for (int i = 0; i < 8; ++i) { v[i] = y1[i]; v[8 + i] = y2[i]; } }
#pragma unroll
            for (int k = 0; k < 4; ++k) { u32x4 o;
#pragma unroll
                for (int i = 0; i < 4; ++i) o[i] = cvtpk(v[8 * k + 2 * i] * qscale, v[8 * k + 2 * i + 1] * qscale);
                *(u32x4*)(ptr + 8 * k) = o; } } }
    }
}

__device__ __forceinline__ void phase_attn(unsigned char* lds_, int wv, const Params& p) {
    const Frame F = make_frame(lds_, wv);
    const bf16_t* PR = (const bf16_t*)(p.ws + WS_PROJ); bf16_t* O4 = (bf16_t*)(p.ws + WS_HOUT) + (size_t)F.bid * 256 * 256;
    unsigned char* A2 = p.ws + WS_H;
    const float lam_init = 0.8f - 0.6f * 0.7408182206817179f;
    const float s1 = wave_sum(p.b_lam_q1[F.lane] * p.b_lam_k1[F.lane]), s2 = wave_sum(p.b_lam_q2[F.lane] * p.b_lam_k2[F.lane]);
    const float lam = expf(s1) - expf(s2) + lam_init;
    const float osc = (WQ_OUT1 == 2) ? A2Q : (1.0f - lam_init) * (OUTPROJ_FP8 ? S8_A2 : 1.0f);
    for (int item = F.vcu; item < 256; item += F.G) {
        const int bh = item >> 1, set = item & 1, b = bh >> 3, h = bh & 7;
        const int qlist = set ? 0x1256 : 0x0347;
#define AT2_REF(R, u) do { const int qb_ = (qlist >> (4 * ((u) >> 1))) & 15, c_ = (u) & 1; const size_t r0_ = (size_t)b * SEQ + qb_ * 256; \
        R.Q = PR + r0_ * 3072 + (h * 2 + c_) * 64; R.K = PR + (size_t)b * SEQ * 3072 + 1024 + (h * 2 + c_) * 64; R.V = PR + (size_t)b * SEQ * 3072 + 2048 + h * 128; \
        R.P0 = qb_ * 256; R.to_lds = c_; R.lam = lam; } while (0)
        at2::Seam S; at2::BlockRef cur, nxt;
        AT2_REF(cur, 0);
        __syncthreads();
        at2::prime(cur, (char*)lds_, S, F.tid, wv);
        for (int u = 0; u < 8; ++u) {
            const int un = (u < 7) ? u + 1 : 7;
            AT2_REF(nxt, un);
            at2::block(cur, nxt, (char*)lds_, S, F.tid, wv);
            if (u & 1) {
                asm volatile("s_waitcnt vmcnt(0)" ::: "memory");
                int lane = F.lane; asm volatile("" : "+v"(lane));
                const int half = lane & 1; const int qb = (qlist >> (4 * (u >> 1))) & 15; const size_t row = (size_t)b * SEQ + qb * 256 + wv * 32 + (lane >> 1);
                const LAS unsigned char* pb = F.lds + at2::OFF_OL + wv * at2::OL_WAVE + (lane >> 1) * at2::OL_RS + half * 128;
                u32x4 bq[8];
#pragma unroll
                for (int i = 0; i < 8; ++i) bq[i] = *(const LAS u32x4*)(pb + 16 * i);
                float d[64]; float ss = 0.f;
#pragma unroll
                for (int i = 0; i < 8; ++i)
#pragma unroll
                    for (int j = 0; j < 4; ++j) { d[8 * i + 2 * j] = bflo(bq[i][j]); d[8 * i + 2 * j + 1] = bfhi(bq[i][j]); }
#pragma unroll
                for (int i = 0; i < 64; ++i) ss += d[i] * d[i];
                ss += sx<1>(ss);
                const float r = osc / sqrtf(ss * (1.0f / 128.0f) + EPS);
                if (WQ_OUT1 == 2) { unsigned char* po = A2 + row * DM + h * 128 + half * 64;
#pragma unroll
                    for (int i = 0; i < 4; ++i) { const f32x4 n0 = *(const f32x4*)(p.b_o_norm + half * 64 + 16 * i), n1 = *(const f32x4*)(p.b_o_norm + half * 64 + 16 * i + 4), n2 = *(const f32x4*)(p.b_o_norm + half * 64 + 16 * i + 8), n3 = *(const f32x4*)(p.b_o_norm + half * 64 + 16 * i + 12);
                        u32x4 w; w.x = pack4_i8(d[16 * i] * r * n0[0], d[16 * i + 1] * r * n0[1], d[16 * i + 2] * r * n0[2], d[16 * i + 3] * r * n0[3]);
                        w.y = pack4_i8(d[16 * i + 4] * r * n1[0], d[16 * i + 5] * r * n1[1], d[16 * i + 6] * r * n1[2], d[16 * i + 7] * r * n1[3]);
                        w.z = pack4_i8(d[16 * i + 8] * r * n2[0], d[16 * i + 9] * r * n2[1], d[16 * i + 10] * r * n2[2], d[16 * i + 11] * r * n2[3]);
                        w.w = pack4_i8(d[16 * i + 12] * r * n3[0], d[16 * i + 13] * r * n3[1], d[16 * i + 14] * r * n3[2], d[16 * i + 15] * r * n3[3]);
                        *(u32x4*)(po + 16 * i) = w; } }
                else if (OUTPROJ_FP8) { unsigned char* po = A2 + row * DM + h * 128 + half * 64;
#pragma unroll
                    for (int i = 0; i < 4; ++i) { const f32x4 n0 = *(const f32x4*)(p.b_o_norm + half * 64 + 16 * i), n1 = *(const f32x4*)(p.b_o_norm + half * 64 + 16 * i + 4), n2 = *(const f32x4*)(p.b_o_norm + half * 64 + 16 * i + 8), n3 = *(const f32x4*)(p.b_o_norm + half * 64 + 16 * i + 12);
                        u32x4 w; w.x = cvt4_fp8(d[16 * i] * r * n0[0], d[16 * i + 1] * r * n0[1], d[16 * i + 2] * r * n0[2], d[16 * i + 3] * r * n0[3]);
                        w.y = cvt4_fp8(d[16 * i + 4] * r * n1[0], d[16 * i + 5] * r * n1[1], d[16 * i + 6] * r * n1[2], d[16 * i + 7] * r * n1[3]);
                        w.z = cvt4_fp8(d[16 * i + 8] * r * n2[0], d[16 * i + 9] * r * n2[1], d[16 * i + 10] * r * n2[2], d[16 * i + 11] * r * n2[3]);
                        w.w = cvt4_fp8(d[16 * i + 12] * r * n3[0], d[16 * i + 13] * r * n3[1], d[16 * i + 14] * r * n3[2], d[16 * i + 15] * r * n3[3]);
                        *(u32x4*)(po + 16 * i) = w; } }
                else { bf16_t* po = (bf16_t*)(p.ws + WS_A2B) + row * DM + h * 128 + half * 64;
#pragma unroll
                    for (int i = 0; i < 8; ++i) { const f32x4 n0 = *(const f32x4*)(p.b_o_norm + half * 64 + 8 * i), n1 = *(const f32x4*)(p.b_o_norm + half * 64 + 8 * i + 4);
                        u32x4 w; w.x = cvtpk(d[8 * i] * r * n0[0], d[8 * i + 1] * r * n0[1]); w.y = cvtpk(d[8 * i + 2] * r * n0[2], d[8 * i + 3] * r * n0[3]);
                        w.z = cvtpk(d[8 * i + 4] * r * n1[0], d[8 * i + 5] * r * n1[1]); w.w = cvtpk(d[8 * i + 6] * r * n1[2], d[8 * i + 7] * r * n1[3]);
                        *(u32x4*)(po + 8 * i) = w; } }
            }
            cur = nxt;
        }
#undef AT2_REF
    }
}

__device__ __forceinline__ void phase_ocombine(unsigned char* lds_, int wv, const Params& p) {
    const Frame F = make_frame(lds_, wv);
    const bf16_t* O4 = (const bf16_t*)(p.ws + WS_HOUT); unsigned char* A2 = p.ws + WS_H;
    const float lam_init = 0.8f - 0.6f * 0.7408182206817179f;
    const float s1 = wave_sum(p.b_lam_q1[F.lane] * p.b_lam_k1[F.lane]), s2 = wave_sum(p.b_lam_q2[F.lane] * p.b_lam_k2[F.lane]);
    const float lam = expf(s1) - expf(s2) + lam_init;
    const int lane = F.lane, hh = lane >> 3, sub = lane & 7, half = sub >> 2, j0 = (sub & 3) * 16;
    float on[16];
#pragma unroll
    for (int i = 0; i < 16; ++i) on[i] = p.b_o_norm[half * 64 + j0 + i] * (1.0f - lam_init) * S8_A2;
    const int gw = F.bid * NWAVES + F.wave, NGW = F.G * NWAVES;
    for (int rowb = gw; rowb < NTOK; rowb += 4 * NGW) {
        u32x4 a0[4], a1[4], b0[4], b1[4];
#pragma unroll
        for (int rr = 0; rr < 4; ++rr) { const int row = rowb + rr * NGW; if (row < NTOK) {
            const bf16_t* pa = O4 + (size_t)row * 2048 + ((hh * 2 + 0) * 2 + half) * 64 + j0; const bf16_t* pb = O4 + (size_t)row * 2048 + ((hh * 2 + 1) * 2 + half) * 64 + j0;
            a0[rr] = *(const u32x4*)pa; a1[rr] = *(const u32x4*)(pa + 8); b0[rr] = *(const u32x4*)pb; b1[rr] = *(const u32x4*)(pb + 8); } }
#pragma unroll
        for (int rr = 0; rr < 4; ++rr) { const int row = rowb + rr * NGW; if (row < NTOK) {
            float d[16];
#pragma unroll
            for (int i = 0; i < 4; ++i) { d[2 * i] = bflo(a0[rr][i]) - lam * bflo(b0[rr][i]); d[2 * i + 1] = bfhi(a0[rr][i]) - lam * bfhi(b0[rr][i]); d[8 + 2 * i] = bflo(a1[rr][i]) - lam * bflo(b1[rr][i]); d[8 + 2 * i + 1] = bfhi(a1[rr][i]) - lam * bfhi(b1[rr][i]); }
            float ss = 0.f;
#pragma unroll
            for (int i = 0; i < 16; ++i) ss += d[i] * d[i];
            ss += sx<1>(ss); ss += sx<2>(ss); ss += sx<4>(ss);
            const float r = 1.0f / sqrtf(ss * (1.0f / 128.0f) + EPS);
            float y[16];
#pragma unroll
            for (int i = 0; i < 16; ++i) y[i] = d[i] * r * on[i];
            u32x4 w; w.x = cvt4_fp8(y[0], y[1], y[2], y[3]); w.y = cvt4_fp8(y[4], y[5], y[6], y[7]); w.z = cvt4_fp8(y[8], y[9], y[10], y[11]); w.w = cvt4_fp8(y[12], y[13], y[14], y[15]);
            *(u32x4*)(A2 + (size_t)row * DM + hh * 128 + half * 64 + j0) = w; } }
    }
}


#ifndef PHASE_MASK
#define PHASE_MASK 0xFFFFFFFFu
#endif
#ifndef PROBE_A
#define PROBE_A (-1)
#endif
#ifndef PROBE_B
#define PROBE_B (0)
#endif
constexpr int STAMP_OFF = LDS_BYTES - 2048;
#define STAMP(k) do { if (PROBE_A >= 0 && blockIdx.x == 0 && STAMP_WAVE == 0 && lane_id() == 0) ((volatile LAS unsigned*)((LAS unsigned char*)lds + STAMP_OFF))[k] = (unsigned)__builtin_amdgcn_s_memrealtime(); } while (0)
#define PH(n) ((PHASE_MASK >> (n)) & 1u)

template <int LAYER>
__device__ __forceinline__ void layer_body(const Params& p, const XcdBarrier& bar, unsigned char* lds) {
    const int STAMP_WAVE = bar.wave; (void)STAMP_WAVE;
    constexpr int SB = (LAYER == 0) ? 4 : 13;
    const int G_ = gridDim.x, bid_ = blockIdx.x; LAS unsigned char* ldsl = (LAS unsigned char*)lds;
#define SEAM() xcd_barrier(bar)
    const float* mod = (const float*)(p.ws + WS_MOD);
    LAS int* tab = (LAS int*)(ldsl + TAB_OFF);
    if (PH(2)) { pg8::StaticOrder S; S.init(NTOK, 3072, G_, bid_);
      if (LAYER == 0) {
        if (WQ_IN0 == 2) { pg8::EpiProjI8 E{(bf16_t*)(p.ws + WS_PROJ), (const float*)(p.ws + SC_RS_H), (const float*)(p.ws + SC_CW) + CW_AIN, 0.08838834764831845f};
          pg8::gemm_phase<pg8::EpiProjI8, pg8::StaticOrder, false, true>(ldsl, bar.wave, (const bf16_t*)(p.ws + WS_H), (const bf16_t*)(p.ws + WS_WAIN), 0, 512, S, E, nullptr); }
        else { pg8::EpiBf16 E{(bf16_t*)(p.ws + WS_PROJ), 3072, 2, 4, 0.08838834764831845f, WQ_IN0 == 1 ? 1.0f / (S8_H * S8_WIN) : 1.0f};
          if (WQ_IN0 == 1) pg8::gemm_phase8<pg8::EpiBf16, pg8::StaticOrder, false>(ldsl, bar.wave, p.ws + WS_H, p.ws + WS_WAIN, 0, 1024, S, E, nullptr);
          else pg8::gemm_phase<pg8::EpiBf16, pg8::StaticOrder, false>(ldsl, bar.wave, (const bf16_t*)(p.ws + WS_H), (const bf16_t*)(p.ws + WS_WAIN_BF), 0, 1024, S, E, nullptr); } }
      else { pg8::EpiQKV E{(bf16_t*)(p.ws + WS_PROJ), p.b_q_norm, p.b_k_norm, (const float*)(p.ws + WS_CS), 1.0f / (S8_H * S8_WIN)};
        pg8::gemm_phase8<pg8::EpiQKV, pg8::StaticOrder, false>(ldsl, bar.wave, p.ws + WS_H, p.ws + WS_WBIN, 0, 1024, S, E, nullptr); } }
    SEAM(); STAMP(SB + 0);
    if (LAYER == 0) {
        if (PH(3)) phase_mlstm(lds, bar.wave, p);
        SEAM(); STAMP(SB + 1);
        if (PH(4)) phase_aprep(lds, bar.wave, p);
    } else {
        STAMP(SB + 1);
        if (PH(6)) phase_attn(lds, bar.wave, p);
        STAMP(SB + 2);
    }
    SEAM(); STAMP(SB + 2 + LAYER);
    unsigned* oflags = (unsigned*)p.ws + CW_OFLAGS + LAYER * 128;
    const int xper = (int)bar.st[0], xnx = (int)bar.st[1], xdx = (int)bar.st[2], xj = (int)bar.st[3];
    constexpr bool OCHAIN = (LAYER == 0) ? (WQ_OUT0 == 2) : (WQ_OUT1 == 2);
    if (PH(8)) { pg8::StaticOrder S; S.init(NTOK, 1024, G_, bid_);
      pg8::XcdOrder SX{xnx, xdx, xper, xj, NTOK / 256, 4, oflags};
      if (LAYER == 0 && WQ_OUT0 == 2) { pg8::EpiResidB<true, true> E{(const void*)p.x, (bf16_t*)(p.ws + WS_XB), mod + 2048, 1.0f, (const float*)(p.ws + WS_SCALES)};
        pg8::gemm_phase<pg8::EpiResidB<true, true>, pg8::XcdOrder, false, true>(ldsl, bar.wave, (const bf16_t*)(p.ws + WS_H), (const bf16_t*)(p.ws + WS_WAOUT), 0, 512, SX, E, nullptr); }
      else if (LAYER == 1 && WQ_OUT1 == 2) { pg8::EpiResidB<false, true, true> E{(const void*)(p.ws + WS_XB), (bf16_t*)(p.ws + WS_XB), mod + (size_t)16 * 6144 + 2048, (1.0f - (0.8f - 0.6f * 0.7408182206817179f)) / A2Q, (const float*)(p.ws + WS_SCALES)};
        pg8::gemm_phase<pg8::EpiResidB<false, true, true>, pg8::XcdOrder, false, true>(ldsl, bar.wave, (const bf16_t*)(p.ws + WS_H), (const bf16_t*)(p.ws + WS_WBOUT), 0, 512, SX, E, nullptr); }
      else { pg8::EpiResidB<LAYER == 0> E{LAYER == 0 ? (const void*)p.x : (const void*)(p.ws + WS_XB), (bf16_t*)(p.ws + WS_XB), mod + (size_t)LAYER * 16 * 6144 + 2048, OUTPROJ_FP8 ? 1.0f / (S8_A2 * S8_WOUT) : 1.0f, nullptr};
        if (OUTPROJ_FP8) pg8::gemm_phase8<pg8::EpiResidB<LAYER == 0>, pg8::StaticOrder, false>(ldsl, bar.wave, p.ws + WS_H, p.ws + (LAYER == 0 ? WS_WAOUT : WS_WBOUT), 0, 1024, S, E, nullptr);
        else pg8::gemm_phase<pg8::EpiResidB<LAYER == 0>, pg8::StaticOrder, false>(ldsl, bar.wave, (const bf16_t*)(p.ws + WS_A2B), (const bf16_t*)(p.ws + (LAYER == 0 ? WS_WAOUT_BF : WS_WBOUT_BF)), 0, 1024, S, E, nullptr); } }
    if (!OCHAIN) SEAM();
    STAMP(SB + 3 + LAYER);
    if (PH(9)) phase_hprep_router(lds, bar.wave, p, LAYER, xnx, xdx, xper, xj, OCHAIN ? oflags : nullptr);
    SEAM(); STAMP(SB + 4 + LAYER);
    if (PH(10)) phase_layout(lds, bar.wave, p);
    SEAM(); STAMP(SB + 5 + LAYER);
    if (PH(11)) { const int* meta = (const int*)(p.ws + RT_META);
      __syncthreads();
      { const int t_ = bar.wave * 64 + lane_id(); if (t_ < 17) tab[t_] = meta[1 + t_]; }
      __syncthreads();
      unsigned* flags = (unsigned*)p.ws + CW_FLAGS + LAYER * 512;
      const int xper = (int)bar.st[0], xnx = (int)bar.st[1], xdx = (int)bar.st[2], xj = (int)bar.st[3];
      pg8::MoeOrder S{xnx, xdx, xper, xj, tab[16], tab, flags};
      pg8::EpiSwiGLU8 E1{p.ws + WS_HOUT, 1.0f / (S8_H * S8_WGU), flags};
      pg8::gemm_phase8<pg8::EpiSwiGLU8, pg8::MoeOrder, true>(ldsl, bar.wave, p.ws + WS_H, p.ws + WS_WGU + (size_t)LAYER * 16 * 1024 * 1024, (size_t)1024 * 1024, 1024, S, E1, (const int*)(p.ws + RT_BUFTOK));
      STAMP(SB + 6 + LAYER);
      pg8::MoeOrderWait S2{xnx, xdx, xper, xj, tab[16], tab, flags};
      pg8::EpiFp8 E2{p.ws + WS_PROJ, 1024, S8_Y / (S8_ACT * S8_WDN)};
      pg8::gemm_phase8<pg8::EpiFp8, pg8::MoeOrderWait, false>(ldsl, bar.wave, p.ws + WS_HOUT, p.ws + WS_WDN + (size_t)LAYER * 16 * 1024 * 512, (size_t)1024 * 512, 512, S2, E2, nullptr); }
    SEAM(); STAMP(SB + 7 + LAYER);
    if (PH(12)) phase_combine(lds, bar.wave, p, LAYER, LAYER == 0);
#undef SEAM
}
__global__ void __launch_bounds__(NTHREADS, 2) mk_fwd(Params p) {
    extern __shared__ __attribute__((aligned(16))) unsigned char lds[];
    cg::grid_group grid = cg::this_grid();
    volatile LAS unsigned* misc = (volatile LAS unsigned*)((LAS unsigned char*)lds + MISC_OFF);
    const int wv0 = __builtin_amdgcn_readfirstlane((int)threadIdx.x >> 6);
    if (threadIdx.x < 32) misc[threadIdx.x] = 0u;
    __syncthreads();
    unsigned* ctl = (unsigned*)p.ws;
    XcdBarrier bar = xcd_barrier_post(ctl + CW_BAR, misc + 8, wv0);
    const int STAMP_WAVE = wv0; (void)STAMP_WAVE;
    STAMP(0);
    if (PH(0)) phase_mod(lds, bar.wave, p);
    __syncthreads();
    STAMP(1);
    if (PH(0)) { phase_wconv(lds, bar.wave, p); __syncthreads(); phase_wconv_pw(lds, bar.wave, p); }
    grid.sync(); STAMP(2);
    if (PH(1)) phase_hprep0(lds, bar.wave, p);
    xcd_barrier(bar); STAMP(3);
    layer_body<0>(p, bar, lds);
    xcd_barrier(bar); STAMP(12);
    layer_body<1>(p, bar, lds);
    STAMP(22);
    if (PROBE_A >= 0 && blockIdx.x == 0 && STAMP_WAVE == 0 && lane_id() == 0) {
        volatile LAS unsigned* ts = (volatile LAS unsigned*)((LAS unsigned char*)lds + STAMP_OFF);
        const unsigned dA = ts[PROBE_A + 1] - ts[PROBE_A], dB = ts[PROBE_B + 1] - ts[PROBE_B];
        const unsigned long long extra = 100ull * ((unsigned long long)(dA / 100u) + 1024ull * (dB / 100u)), t0 = __builtin_amdgcn_s_memrealtime();
        while (__builtin_amdgcn_s_memrealtime() - t0 < extra) __builtin_amdgcn_s_sleep(32);
    }
    if (xb_ld(ctl + CW_BAR + XB_TMO) != 0u) { __syncthreads(); for (size_t i = (size_t)blockIdx.x * NTHREADS + (wv0 * 64 + lane_id()); i < (size_t)NTOK * DM / 4; i += (size_t)gridDim.x * NTHREADS) ((f32x4*)p.out)[i] = (f32x4){1e30f, 1e30f, 1e30f, 1e30f}; }
}

extern "C" void kernel_launch(void* const* d_in, const int* in_sizes, int n_in, void* d_out, int out_size, void* d_ws, size_t ws_size, hipStream_t stream) {
    static int grid_blocks = 0;
    if (!grid_blocks) {
        int dev = 0, cus = 0, per_cu = 0;
        (void)hipGetDevice(&dev);
        (void)hipDeviceGetAttribute(&cus, hipDeviceAttributeMultiprocessorCount, dev);
        (void)hipFuncSetAttribute((const void*)mk_fwd, hipFuncAttributeMaxDynamicSharedMemorySize, LDS_BYTES);
        (void)hipOccupancyMaxActiveBlocksPerMultiprocessor(&per_cu, (const void*)mk_fwd, NTHREADS, LDS_BYTES);
        if (per_cu < 1) { fprintf(stderr, "kernel_launch: occupancy query reports %d blocks/CU\n", per_cu); per_cu = 1; }
        grid_blocks = cus;
        if (ws_size < WS_END || n_in != 24) fprintf(stderr, "kernel_launch: unexpected ws_size %zu (need %zu) or n_in %d\n", ws_size, (size_t)WS_END, n_in);
    }
    (void)hipMemsetAsync(d_ws, 0, CTL_BYTES, stream);
    Params p{};
    const float** pf = (const float**)&p;
    p.x = (const float*)d_in[0]; p.c = (const float*)d_in[1]; p.positions = (const int*)d_in[2]; p.norm1 = (const float*)d_in[3]; p.norm2 = (const float*)d_in[4];
    p.w_ada = (const float*)d_in[5]; p.b_ada = (const float*)d_in[6]; p.a_w_in = (const float*)d_in[7]; p.a_b_if = (const float*)d_in[8]; p.a_h_norm = (const float*)d_in[9];
    p.a_w_out = (const float*)d_in[10]; p.b_w_in = (const float*)d_in[11]; p.b_q_norm = (const float*)d_in[12]; p.b_k_norm = (const float*)d_in[13];
    p.b_lam_q1 = (const float*)d_in[14]; p.b_lam_k1 = (const float*)d_in[15]; p.b_lam_q2 = (const float*)d_in[16]; p.b_lam_k2 = (const float*)d_in[17];
    p.b_o_norm = (const float*)d_in[18]; p.b_w_out = (const float*)d_in[19]; p.w_router = (const float*)d_in[20]; p.router_bias = (const float*)d_in[21];
    p.moe_w_gu = (const float*)d_in[22]; p.moe_w_down = (const float*)d_in[23];
    p.out = (float*)d_out; p.ws = (unsigned char*)d_ws; (void)pf;
    void* args[] = {&p};
    hipError_t e = hipLaunchCooperativeKernel((const void*)mk_fwd, dim3(grid_blocks), dim3(NTHREADS), args, LDS_BYTES, stream);
    if (e != hipSuccess) fprintf(stderr, "cooperative launch failed: %s (grid %d)\n", hipGetErrorString(e), grid_blocks);
}
```

```cpp
#include <hip/hip_runtime.h>
#include <hip/hip_cooperative_groups.h>
#include <hip/hip_bf16.h>
#include <cstdio>
#include <cstdint>
#include <cmath>
namespace cg = cooperative_groups;

#define GAS __attribute__((address_space(1)))
#define LAS __attribute__((address_space(3)))
typedef unsigned short bf16_t;
typedef float f32x4 __attribute__((ext_vector_type(4)));
typedef float f32x2 __attribute__((ext_vector_type(2)));
typedef short bf16x8 __attribute__((ext_vector_type(8)));
typedef short s16x4 __attribute__((ext_vector_type(4)));
typedef unsigned u32x4 __attribute__((ext_vector_type(4)));
typedef unsigned u32x2 __attribute__((ext_vector_type(2)));
typedef __bf16 bf16x2_t __attribute__((ext_vector_type(2)));
typedef int i32x8 __attribute__((ext_vector_type(8)));
typedef int i32x4 __attribute__((ext_vector_type(4)));

constexpr int NTOK = 32768, DM = 1024, SEQ = 2048, NB = 16;
constexpr int NEXP = 16, DEXP = 512;
constexpr int NTHREADS = 512, NWAVES = 8;
constexpr int LDS_BYTES = 147456;
constexpr int MISC_OFF = LDS_BYTES - 128;
constexpr int TAB_OFF = 131072;
constexpr float EPS = 1e-6f;
constexpr int MAXTILES = 272, CAP = MAXTILES * 256;
constexpr float S8_H = 8.0f, S8_WGU = 256.0f, S8_ACT = 4.0f, S8_WDN = 128.0f, S8_WIN = 256.0f, S8_A2 = 16.0f, S8_WOUT = 256.0f, S8_Y = 16.0f;

constexpr size_t MiB = 1u << 20;
constexpr size_t WS_CTL = 0, CTL_BYTES = 1 * MiB;
constexpr int CW_BAR = 4096;
constexpr int CW_MODCNT = 9728;
constexpr int CW_OFLAGS = 9216;
constexpr int CW_FLAGS = 8192;
constexpr size_t WS_MOD = 1 * MiB;
constexpr size_t WS_ROUTE = 2 * MiB;
constexpr size_t RT_BLKCNT = WS_ROUTE;
constexpr size_t RT_INFO = WS_ROUTE + 64 * 1024;
constexpr size_t RT_W = RT_INFO + 128 * 1024;
constexpr size_t RT_DEST = RT_W + 256 * 1024;
constexpr size_t RT_BUFTOK = RT_DEST + 256 * 1024;
constexpr size_t RT_META = RT_BUFTOK + 320 * 1024;
constexpr size_t WS_GATES = 4 * MiB;
constexpr size_t WS_SCALES = 5 * MiB;
constexpr size_t SC_RS_H = WS_SCALES;
constexpr size_t SC_RS_A = WS_SCALES + 128 * 1024;
constexpr size_t SC_RS_TOK = WS_SCALES + 256 * 1024;
constexpr size_t SC_RS_SLOT = WS_SCALES + 384 * 1024;
constexpr size_t SC_CW = WS_SCALES + 704 * 1024;
constexpr int CW_AIN = 0, CW_AOUT = 3072, CW_BIN = 4096, CW_GU = 7168, CW_BOUT = 7168 + 32 * 1024;
constexpr int WQ_OUT1 = 2;
constexpr float A2Q = 127.0f / 6.0f;
constexpr int WQ_IN0 = 2, WQ_IN1 = 1, WQ_OUT0 = 2, WQ_GU = 1;
constexpr size_t WS_WAIN = 6 * MiB, WS_WAOUT = 10 * MiB, WS_WBIN = 12 * MiB, WS_WBOUT = 16 * MiB;
constexpr size_t WS_WGU = 18 * MiB;
constexpr size_t WS_WDN = 50 * MiB;
constexpr size_t WS_H = 66 * MiB;
constexpr size_t WS_XB = 100 * MiB;
constexpr size_t WS_PROJ = 164 * MiB;
constexpr size_t WS_HOUT = 356 * MiB;
constexpr size_t WS_CS = 484 * MiB;
constexpr size_t WS_WAIN_BF = 488 * MiB;
constexpr size_t WS_WAOUT_BF = 506 * MiB, WS_WBOUT_BF = 508 * MiB;
constexpr size_t WS_A2B = 420 * MiB;
constexpr bool OUTPROJ_FP8 = false;
constexpr size_t WS_END = 510 * MiB;
constexpr bool INPROJ0_FP8 = false;

__device__ __forceinline__ unsigned cvtpk(float lo, float hi) { f32x2 v = {lo, hi}; bf16x2_t b = __builtin_convertvector(v, bf16x2_t); return __builtin_bit_cast(unsigned, b); }
__device__ __forceinline__ float clamp448(float v) { return fminf(fmaxf(v, -448.0f), 448.0f); }
__device__ __forceinline__ unsigned cvt4_fp8(float a, float b, float c, float d) {
    int w = __builtin_amdgcn_cvt_pk_fp8_f32(clamp448(a), clamp448(b), 0, false); w = __builtin_amdgcn_cvt_pk_fp8_f32(clamp448(c), clamp448(d), w, true); return (unsigned)w; }
__device__ __forceinline__ float bf2f(unsigned short h) { return __uint_as_float(((unsigned)h) << 16); }
__device__ __forceinline__ float bflo(unsigned w) { return __uint_as_float(w << 16); }
__device__ __forceinline__ float bfhi(unsigned w) { return __uint_as_float(w & 0xffff0000u); }
__device__ __forceinline__ int lane_id() { int l; asm volatile("v_mbcnt_lo_u32_b32 %0, -1, 0\n\tv_mbcnt_hi_u32_b32 %0, -1, %0" : "=v"(l)); return l; }
template <int M> __device__ __forceinline__ float sx(float v) {
    const int i = __float_as_int(v);
    if constexpr (M == 1) return __int_as_float(__builtin_amdgcn_mov_dpp(i, 0xB1, 0xF, 0xF, true));
    else if constexpr (M == 2) return __int_as_float(__builtin_amdgcn_mov_dpp(i, 0x4E, 0xF, 0xF, true));
    else if constexpr (M == 4) return __int_as_float(__builtin_amdgcn_ds_swizzle(i, 0x101F));
    else if constexpr (M == 8) return __int_as_float(__builtin_amdgcn_ds_swizzle(i, 0x201F));
    else if constexpr (M == 16) return __int_as_float(__builtin_amdgcn_ds_swizzle(i, 0x401F));
    else { static_assert(M == 1, "sx: mask"); return v; }
}
__device__ __forceinline__ float sx16p(float v, bool odd_row) {
    auto rr = __builtin_amdgcn_permlane16_swap(__float_as_uint(v), __float_as_uint(v), false, false);
    return __uint_as_float(odd_row ? rr[0] : rr[1]);
}
__device__ __forceinline__ float sx32(float v, bool upper) {
    auto rr = __builtin_amdgcn_permlane32_swap(__float_as_uint(v), __float_as_uint(v), false, false);
    return __uint_as_float(upper ? rr[0] : rr[1]);
}
__device__ __forceinline__ float bperm(float v, int src_lane) { return __int_as_float(__builtin_amdgcn_ds_bpermute(src_lane << 2, __float_as_int(v))); }
__device__ __forceinline__ float rdlane(float v, int l) { return __int_as_float(__builtin_amdgcn_readlane(__float_as_int(v), l)); }
__device__ __forceinline__ float wave_sum(float v) {
    v += sx<1>(v); v += sx<2>(v); v += sx<4>(v); v += sx<8>(v); v += sx<16>(v);
    { auto rr = __builtin_amdgcn_permlane32_swap(__float_as_uint(v), __float_as_uint(v), false, false); v = __uint_as_float(rr[0]) + __uint_as_float(rr[1]); }
    return v;
}
__device__ __forceinline__ float wave_max(float v) {
    v = fmaxf(v, sx<1>(v)); v = fmaxf(v, sx<2>(v)); v = fmaxf(v, sx<4>(v)); v = fmaxf(v, sx<8>(v)); v = fmaxf(v, sx<16>(v));
    { auto rr = __builtin_amdgcn_permlane32_swap(__float_as_uint(v), __float_as_uint(v), false, false); v = fmaxf(__uint_as_float(rr[0]), __uint_as_float(rr[1])); }
    return v;
}
__device__ __forceinline__ unsigned pack4_i8(float a, float b, float c, float d) {
    unsigned w = __builtin_amdgcn_cvt_pk_u8_f32(fminf(fmaxf(rintf(a), -127.f), 127.f) + 128.f, 0, 0u);
    w = __builtin_amdgcn_cvt_pk_u8_f32(fminf(fmaxf(rintf(b), -127.f), 127.f) + 128.f, 1, w);
    w = __builtin_amdgcn_cvt_pk_u8_f32(fminf(fmaxf(rintf(c), -127.f), 127.f) + 128.f, 2, w);
    w = __builtin_amdgcn_cvt_pk_u8_f32(fminf(fmaxf(rintf(d), -127.f), 127.f) + 128.f, 3, w);
    return w ^ 0x80808080u;
}
__device__ __forceinline__ f32x4 i2f4(f32x4 a) { return (f32x4){(float)__float_as_int(a[0]), (float)__float_as_int(a[1]), (float)__float_as_int(a[2]), (float)__float_as_int(a[3])}; }
__device__ __forceinline__ float sigmoidf_(float x) { return 1.0f / (1.0f + __expf(-x)); }

#define XB_TMO      128
#define XB_XCNT(j)  (256  + 64 * (j))
#define XB_XSUB(j)  (1280 + 64 * (j))
#define XB_XGEN(j)  (2304 + 64 * (j))
#define XB_TOP      3328
#define XB_TOPGEN   3392
#define XCD_BAR_WORDS 3456
#define XB_SPIN_CAP (1u << 18)
__device__ __forceinline__ unsigned xb_ld(unsigned* p)              { return __hip_atomic_load(p, __ATOMIC_RELAXED, __HIP_MEMORY_SCOPE_AGENT); }
__device__ __forceinline__ unsigned xb_add(unsigned* p, unsigned v) { return __hip_atomic_fetch_add(p, v, __ATOMIC_RELAXED, __HIP_MEMORY_SCOPE_AGENT); }
__device__ __forceinline__ unsigned xb_xcc_id() { return (unsigned)__builtin_amdgcn_s_getreg((3 << 11) | 20) & 0xFu; }
#define XB_SPIN(cond, bar) do { unsigned _sp = 0; while (cond) { __builtin_amdgcn_s_sleep(1); \
    if ((++_sp & 255u) == 0u) { if (xb_ld(&(bar)[XB_TMO])) break; if (_sp > XB_SPIN_CAP) { atomicAdd(&(bar)[XB_TMO], 1u); break; } } } } while (0)
struct XcdBarrier { unsigned* bar; unsigned x; volatile LAS unsigned* st; int wave; };
__device__ __forceinline__ XcdBarrier xcd_barrier_post(unsigned* bar, volatile LAS unsigned* st, int wave) {
    XcdBarrier b; b.bar = bar; b.x = xb_xcc_id(); b.st = st; b.wave = wave;
    if (wave == 0 && lane_id() == 0) st[3] = xb_add(&bar[XB_XCNT(b.x)], 1u);
    return b;
}
__device__ __forceinline__ void xcd_barrier_complete(unsigned* bar, unsigned x, unsigned& nloc, unsigned& nx, unsigned& dx) {
    const unsigned G = gridDim.x * gridDim.y * gridDim.z;
    unsigned sum, cnt, mine, below, sp = 0u;
    for (;;) {
        sum = 0u; cnt = 0u; mine = 0u; below = 0u;
#pragma unroll
        for (unsigned j = 0; j < 16; ++j) { const unsigned c = xb_ld(&bar[XB_XCNT(j)]); sum += c; cnt += (c > 0u) ? 1u : 0u; mine = (j == x) ? c : mine; below += (j < x && c > 0u) ? 1u : 0u; }
        if (sum == G) break;
        __builtin_amdgcn_s_sleep(1);
        if ((++sp & 255u) == 0u) { if (xb_ld(&bar[XB_TMO])) break; if (sp > XB_SPIN_CAP) { atomicAdd(&bar[XB_TMO], 1u); break; } }
    }
    nloc = mine > 0u ? mine : 1u; nx = cnt > 0u ? cnt : 1u; dx = below;
}
__device__ __forceinline__ void xcd_barrier(const XcdBarrier& b) {
    asm volatile("s_waitcnt vmcnt(0)" ::: "memory");
    __syncthreads();
    if (b.wave == 0 && lane_id() == 0) {
        unsigned* bar = b.bar;
        __builtin_amdgcn_s_waitcnt(0);
        unsigned nloc = b.st[0], nx = b.st[1];
        if (nloc == 0u) { unsigned dx; xcd_barrier_complete(bar, b.x, nloc, nx, dx); b.st[0] = nloc; b.st[1] = nx; b.st[2] = dx; }
        const unsigned old = xb_add(&bar[XB_XSUB(b.x)], 1u);
        const unsigned gen = old / nloc;
        if (old + 1u == (gen + 1u) * nloc) {
            __builtin_amdgcn_fence(__ATOMIC_RELEASE, "agent");
            asm volatile("s_waitcnt vmcnt(0)" ::: "memory");
            const unsigned og = xb_add(&bar[XB_TOP], 1u);
            const unsigned target = (og / nx + 1u) * nx;
            if (og + 1u != target) XB_SPIN(xb_ld(&bar[XB_TOP]) < target, bar);
            __builtin_amdgcn_fence(__ATOMIC_ACQUIRE, "agent");
            xb_add(&bar[XB_XGEN(b.x)], 1u);
            asm volatile("s_waitcnt vmcnt(0)" ::: "memory");
        } else {
            XB_SPIN(xb_ld(&bar[XB_XGEN(b.x)]) == gen, bar);
            __builtin_amdgcn_fence(__ATOMIC_ACQUIRE, "agent");
            asm volatile("s_waitcnt vmcnt(0)" ::: "memory");
        }
    }
    __syncthreads();
}

namespace pg8 {
constexpr int BM = 256, BK = 64, HALF = 128, HTB = HALF * BK * 2, STAGE_BYTES = 8 * HTB, NXCD = 8, WGM = 8;
__device__ __forceinline__ int lds_byte(int r, int c) { const int st = (r >> 4) * 2 + (c >> 5), rr = r & 15, cc = c & 31, ob = rr * 64 + cc * 2; return st * 1024 + (ob ^ (((ob >> 9) & 1) << 5)); }
__device__ __forceinline__ void stage_rc(int b, int& R, int& C) { const int st = b / 1024, sb = b % 1024, swz = sb ^ (((sb >> 9) & 1) << 5); R = (st >> 1) * 16 + swz / 64; C = (st & 1) * 32 + (swz % 64) / 2; }
__device__ __forceinline__ int perm32(int rho) { const int n = rho >> 4, i = rho & 15; return 8 * (i >> 2) + 4 * n + (i & 3); }

struct Unit { int pm, pn, e; };

struct StaticOrder {
    static constexpr bool SIGNAL = false;
    int nM, nN, nwg, G, c;
    __device__ void init(int M, int N, int G_, int c_) { nM = M / BM; nN = N / BM; nwg = nM * nN; G = G_; c = c_; }
    __device__ __forceinline__ bool next(int i, Unit& u) const {
        const long L = (long)i * G + c; if (L >= nwg) return false;
        int wgid = (int)L; { const int q = nwg / NXCD, r = nwg % NXCD, xcd = wgid % NXCD, off = wgid / NXCD; wgid = (xcd < r ? xcd * (q + 1) : r * (q + 1) + (xcd - r) * q) + off; }
        const int nig = WGM * nN, gid = wgid / nig, fm = gid * WGM, gsz = (nM - fm) < WGM ? (nM - fm) : WGM;
        u.pm = __builtin_amdgcn_readfirstlane(fm + ((wgid % nig) % gsz)); u.pn = __builtin_amdgcn_readfirstlane((wgid % nig) / gsz); u.e = 0; return true;
    }
};
struct XcdOrder {
    static constexpr bool SIGNAL = true;
    int nx, dx, per, j, nM, nN; unsigned* flags;
    __device__ __forceinline__ bool next(int i, Unit& u) const {
        const int tlo = (dx * nM) / nx, thi = ((dx + 1) * nM) / nx, n = (thi - tlo) * nN;
        const int q = j + i * per; if (q >= n) return false;
        u.pm = __builtin_amdgcn_readfirstlane(tlo + q / nN); u.pn = __builtin_amdgcn_readfirstlane(q % nN); u.e = 0; return true;
    }
    __device__ __forceinline__ void signal(const Unit& u, int lane) const { asm volatile("s_waitcnt vmcnt(0)" ::: "memory"); if (lane == 0) (void)xb_add(flags + u.pm, 1u); }
};
template <bool WAIT>
struct MoeOrderT {
    static constexpr bool SIGNAL = false;
    int nx, dx, per, j, ntiles; const LAS int* ts; unsigned* flags;
    __device__ __forceinline__ bool next(int i, Unit& u) const {
        const int tlo = (dx * ntiles) / nx, thi = ((dx + 1) * ntiles) / nx, n = 4 * (thi - tlo);
        int jj = j; if (WAIT) { jj = j - (n % per); if (jj < 0) jj += per; }
        const int q = jj + i * per; if (q >= n) return false;
        const int tile = tlo + (q >> 2), pn = q & 3;
        int e = 0;
#pragma unroll
        for (int k = 1; k < 16; ++k) e += (tile >= ts[k]) ? 1 : 0;
        u.pm = __builtin_amdgcn_readfirstlane(tile); u.pn = __builtin_amdgcn_readfirstlane(pn); u.e = __builtin_amdgcn_readfirstlane(e);
        if (WAIT) { unsigned sp = 0u;
            while (xb_ld(flags + u.pm) < 32u) { __builtin_amdgcn_s_sleep(2); if (++sp > (1u << 22)) break; }
            asm volatile("" ::: "memory"); }
        return true;
    }
};
typedef MoeOrderT<false> MoeOrder;
typedef MoeOrderT<true> MoeOrderWait;

struct EpiBf16 {
    static constexpr bool PERM = true, HP = false, SIGNAL = false;
    bf16_t* O; int ldc; int s_lo, s_hi; float scale; float base;
    __device__ __forceinline__ void operator()(const f32x4 (&acc)[2][2][4][2], const Unit& u, int wr, int wc, int fr, int fq) const {
        const int row0 = u.pm * BM + wr * 64 + fr; const int col0 = u.pn * BM + wc * 32 + 8 * fq;
        const float sc = ((u.pn >= s_lo && u.pn < s_hi) ? scale : 1.0f) * base;
#pragma unroll
        for (int ai = 0; ai < 2; ++ai)
#pragma unroll
            for (int m = 0; m < 4; ++m) { bf16_t* rowp = O + (size_t)(row0 + ai * HALF + m * 16) * ldc + col0;
#pragma unroll
                for (int bj = 0; bj < 2; ++bj) { const f32x4 v0 = acc[ai][bj][m][0] * sc, v1 = acc[ai][bj][m][1] * sc;
                    u32x4 w; w.x = cvtpk(v0[0], v0[1]); w.y = cvtpk(v0[2], v0[3]); w.z = cvtpk(v1[0], v1[1]); w.w = cvtpk(v1[2], v1[3]);
                    *(u32x4*)(rowp + bj * HALF) = w; } }
    }
};
struct EpiSwiGLU {
    static constexpr bool PERM = true;
    bf16_t* O;
    __device__ __forceinline__ void operator()(const f32x4 (&acc)[2][2][4][2], const Unit& u, int wr, int wc, int fr, int fq) const {
        const int row0 = u.pm * BM + wr * 64 + fr; const int col0 = u.pn * 128 + wc * 32 + 8 * fq;
#pragma unroll
        for (int ai = 0; ai < 2; ++ai)
#pragma unroll
            for (int m = 0; m < 4; ++m) { bf16_t* rowp = O + (size_t)(row0 + ai * HALF + m * 16) * DEXP + col0;
                float a[8];
#pragma unroll
                for (int n = 0; n < 2; ++n)
#pragma unroll
                    for (int j = 0; j < 4; ++j) { const float g = acc[ai][0][m][n][j], up = acc[ai][1][m][n][j]; a[n * 4 + j] = g * up / (1.0f + __expf(-g)); }
                u32x4 w; w.x = cvtpk(a[0], a[1]); w.y = cvtpk(a[2], a[3]); w.z = cvtpk(a[4], a[5]); w.w = cvtpk(a[6], a[7]);
                *(u32x4*)rowp = w; }
    }
};
struct EpiResid {
    static constexpr bool PERM = false;
    const float* base; float* out; const float* gate;
    __device__ __forceinline__ void operator()(const f32x4 (&acc)[2][2][4][2], const Unit& u, int wr, int wc, int fr, int fq) const {
        const int row0 = u.pm * BM + wr * 64 + fr, col0 = u.pn * BM + wc * 32 + 4 * fq;
        const int b = (u.pm * BM) / SEQ;
        f32x4 gv[2][2];
#pragma unroll
        for (int bj = 0; bj < 2; ++bj)
#pragma unroll
            for (int n = 0; n < 2; ++n) gv[bj][n] = *(const f32x4*)(gate + (size_t)b * 6144 + col0 + bj * HALF + n * 16);
#pragma unroll
        for (int ai = 0; ai < 2; ++ai)
#pragma unroll
            for (int m = 0; m < 4; ++m) { const size_t off = (size_t)(row0 + ai * HALF + m * 16) * DM + col0;
#pragma unroll
                for (int bj = 0; bj < 2; ++bj)
#pragma unroll
                    for (int n = 0; n < 2; ++n) { const f32x4 bs = *(const f32x4*)(base + off + bj * HALF + n * 16);
                        *(f32x4*)(out + off + bj * HALF + n * 16) = bs + gv[bj][n] * acc[ai][bj][m][n]; }
                asm volatile("" ::: "memory"); }
    }
};

struct EpiProjI8 {
    static constexpr bool PERM = true, HP = false;
    bf16_t* O; const float* ra; const float* cw; float kscale;
    __device__ __forceinline__ void operator()(const f32x4 (&acc)[2][2][4][2], const Unit& u, int wr, int wc, int fr, int fq) const {
        const int row0 = u.pm * BM + wr * 64 + fr; const int col0 = u.pn * BM + wc * 32 + 8 * fq;
        const float ks = (u.pn >= 2 && u.pn < 4) ? kscale : 1.0f;
        f32x4 c0[2], c1[2];
#pragma unroll
        for (int bj = 0; bj < 2; ++bj) { c0[bj] = *(const f32x4*)(cw + col0 + bj * HALF) * ks; c1[bj] = *(const f32x4*)(cw + col0 + bj * HALF + 4) * ks; }
#pragma unroll
        for (int ai = 0; ai < 2; ++ai)
#pragma unroll
            for (int m = 0; m < 4; ++m) { const int row = row0 + ai * HALF + m * 16; const float rs = ra[row]; bf16_t* rowp = O + (size_t)row * 3072 + col0;
#pragma unroll
                for (int bj = 0; bj < 2; ++bj) { const f32x4 v0 = i2f4(acc[ai][bj][m][0]) * c0[bj] * rs, v1 = i2f4(acc[ai][bj][m][1]) * c1[bj] * rs;
                    u32x4 w; w.x = cvtpk(v0[0], v0[1]); w.y = cvtpk(v0[2], v0[3]); w.z = cvtpk(v1[0], v1[1]); w.w = cvtpk(v1[2], v1[3]);
                    *(u32x4*)(rowp + bj * HALF) = w; } }
    }
};
struct EpiFp8 {
    static constexpr bool PERM = true, HP = false, SIGNAL = false;
    unsigned char* O; int ldc; float scale;
    __device__ __forceinline__ void operator()(const f32x4 (&acc)[2][2][4][2], const Unit& u, int wr, int wc, int fr, int fq) const {
        const int row0 = u.pm * BM + wr * 64 + fr; const int col0 = u.pn * BM + wc * 32 + 8 * fq;
#pragma unroll
        for (int ai = 0; ai < 2; ++ai)
#pragma unroll
            for (int m = 0; m < 4; ++m) { unsigned char* rowp = O + (size_t)(row0 + ai * HALF + m * 16) * ldc + col0;
#pragma unroll
                for (int bj = 0; bj < 2; ++bj) { const f32x4 v0 = acc[ai][bj][m][0] * scale, v1 = acc[ai][bj][m][1] * scale;
                    u32x2 w; w.x = cvt4_fp8(v0[0], v0[1], v0[2], v0[3]); w.y = cvt4_fp8(v1[0], v1[1], v1[2], v1[3]);
                    *(u32x2*)(rowp + bj * HALF) = w; } }
    }
};
struct EpiQKV {
    static constexpr bool PERM = true, HP = true, SIGNAL = false;
    bf16_t* O; const float* qn; const float* kn; const float* cs; float descale;
    __device__ __forceinline__ void operator()(const f32x4 (&acc)[2][2][4][2], const Unit& u, int wr, int wc, int fr, int fq) const {
        const int row0 = u.pm * BM + wr * 64 + fr; const int col0 = u.pn * BM + wc * 64 + 8 * fq;
        const bool isqk = u.pn < 8; const bool odd = (fq & 1) != 0;
        float w[2][2][4];
        if (isqk) { const float* nw = (u.pn < 4) ? qn : kn;
#pragma unroll
            for (int bj = 0; bj < 2; ++bj)
#pragma unroll
                for (int n = 0; n < 2; ++n) { const f32x4 t = *(const f32x4*)(nw + 32 * bj + 8 * fq + 4 * n); w[bj][n][0] = t[0]; w[bj][n][1] = t[1]; w[bj][n][2] = t[2]; w[bj][n][3] = t[3]; } }
        const float qs = (u.pn < 4) ? 0.125f * 1.4426950408889634f : 1.0f;
#pragma unroll
        for (int ai = 0; ai < 2; ++ai)
#pragma unroll
            for (int m = 0; m < 4; ++m) { const int row = row0 + ai * HALF + m * 16; bf16_t* rowp = O + (size_t)row * 3072 + col0;
                float v[2][2][4];
#pragma unroll
                for (int bj = 0; bj < 2; ++bj)
#pragma unroll
                    for (int n = 0; n < 2; ++n)
#pragma unroll
                        for (int j = 0; j < 4; ++j) v[bj][n][j] = acc[ai][bj][m][n][j] * descale;
                if (isqk) {
                    float ss = 0.f;
#pragma unroll
                    for (int bj = 0; bj < 2; ++bj)
#pragma unroll
                        for (int n = 0; n < 2; ++n)
#pragma unroll
                            for (int j = 0; j < 4; ++j) ss += v[bj][n][j] * v[bj][n][j];
                    ss += sx16p(ss, odd);
                    { auto rr = __builtin_amdgcn_permlane32_swap(__float_as_uint(ss), __float_as_uint(ss), false, false); ss = __uint_as_float(rr[0]) + __uint_as_float(rr[1]); }
                    const float rn = 1.0f / sqrtf(ss * (1.0f / 64.0f) + EPS);
#pragma unroll
                    for (int bj = 0; bj < 2; ++bj)
#pragma unroll
                        for (int n = 0; n < 2; ++n)
#pragma unroll
                            for (int j = 0; j < 4; ++j) v[bj][n][j] = v[bj][n][j] * rn * w[bj][n][j];
                    const f32x4 c0 = *(const f32x4*)(cs + (size_t)row * 16), c1 = *(const f32x4*)(cs + (size_t)row * 16 + 4), s0 = *(const f32x4*)(cs + (size_t)row * 16 + 8), s1 = *(const f32x4*)(cs + (size_t)row * 16 + 12);
#pragma unroll
                    for (int n = 0; n < 2; ++n)
#pragma unroll
                        for (int j = 0; j < 4; ++j) { const float x = v[0][n][j]; const float pr = sx16p(x, odd); const float c = n ? c1[j] : c0[j], sn = n ? s1[j] : s0[j];
                            const float r0 = x * c - pr * sn, r1 = x * c + pr * sn; v[0][n][j] = (fq == 0) ? r0 : (fq == 1) ? r1 : x; }
#pragma unroll
                    for (int bj = 0; bj < 2; ++bj)
#pragma unroll
                        for (int n = 0; n < 2; ++n)
#pragma unroll
                            for (int j = 0; j < 4; ++j) v[bj][n][j] *= qs;
                }
#pragma unroll
                for (int bj = 0; bj < 2; ++bj) { u32x4 wv; wv.x = cvtpk(v[bj][0][0], v[bj][0][1]); wv.y = cvtpk(v[bj][0][2], v[bj][0][3]); wv.z = cvtpk(v[bj][1][0], v[bj][1][1]); wv.w = cvtpk(v[bj][1][2], v[bj][1][3]);
                    *(u32x4*)(rowp + 32 * bj) = wv; } }
    }
};
template <bool BASE_F32, bool I8 = false, bool STATIC_A = false> struct EpiResidB {
    static constexpr bool PERM = true, HP = false, SIGNAL = false;
    const void* base; bf16_t* out; const float* gate; float descale; const float* sc;
    __device__ __forceinline__ void operator()(const f32x4 (&acc)[2][2][4][2], const Unit& u, int wr, int wc, int fr, int fq) const {
        const int row0 = u.pm * BM + wr * 64 + fr, col0 = u.pn * BM + wc * 32 + 8 * fq;
        const int b = (u.pm * BM) / SEQ;
        const float* ra = sc + (SC_RS_A - WS_SCALES) / 4; const float* cw = sc + (SC_CW - WS_SCALES) / 4 + (STATIC_A ? CW_BOUT : CW_AOUT);
        f32x4 gv[2][2];
#pragma unroll
        for (int bj = 0; bj < 2; ++bj)
#pragma unroll
            for (int n = 0; n < 2; ++n) { gv[bj][n] = *(const f32x4*)(gate + (size_t)b * 6144 + col0 + bj * HALF + n * 4); if (!I8) gv[bj][n] = gv[bj][n] * descale; if (I8) gv[bj][n] = gv[bj][n] * *(const f32x4*)(cw + col0 + bj * HALF + n * 4); }
#pragma unroll
        for (int ai = 0; ai < 2; ++ai)
#pragma unroll
            for (int m = 0; m < 4; ++m) { const size_t off = (size_t)(row0 + ai * HALF + m * 16) * DM + col0; const float rs = !I8 ? 1.0f : STATIC_A ? descale : ra[row0 + ai * HALF + m * 16];
#pragma unroll
                for (int bj = 0; bj < 2; ++bj) { f32x4 b0, b1;
                    if (BASE_F32) { b0 = *(const f32x4*)((const float*)base + off + bj * HALF); b1 = *(const f32x4*)((const float*)base + off + bj * HALF + 4); }
                    else { const u32x4 r = *(const u32x4*)((const bf16_t*)base + off + bj * HALF); b0 = (f32x4){bflo(r.x), bfhi(r.x), bflo(r.y), bfhi(r.y)}; b1 = (f32x4){bflo(r.z), bfhi(r.z), bflo(r.w), bfhi(r.w)}; }
                    const f32x4 a0 = I8 ? i2f4(acc[ai][bj][m][0]) * rs : acc[ai][bj][m][0], a1 = I8 ? i2f4(acc[ai][bj][m][1]) * rs : acc[ai][bj][m][1];
                    const f32x4 v0 = b0 + gv[bj][0] * a0, v1 = b1 + gv[bj][1] * a1;
                    u32x4 w; w.x = cvtpk(v0[0], v0[1]); w.y = cvtpk(v0[2], v0[3]); w.z = cvtpk(v1[0], v1[1]); w.w = cvtpk(v1[2], v1[3]);
                    *(u32x4*)(out + off + bj * HALF) = w; }
                asm volatile("" ::: "memory"); }
    }
};
template <class Epi, class Sched, bool GATHER, bool I8 = false>
__device__ __forceinline__ void gemm_phase(LAS unsigned char* lds, int wv, const bf16_t* A, const bf16_t* Bt, size_t bstride, int K, const Sched& S, const Epi& E, const int* aidx) {
    int tid = wv * 64 + lane_id(); asm volatile("" : "+v"(tid));
    const int wid = wv, lane = tid & 63, wr = wid >> 2, wc = wid & 3, fr = lane & 15, fq = lane >> 4;
    const int nt = K / BK;
    int RA[2], CA[2]; unsigned voffB[2];
#pragma unroll
    for (int i = 0; i < 2; ++i) { int R, C; stage_rc(tid * 16 + i * 8192, R, C); const int Rb = Epi::PERM ? ((R & ~31) + perm32(R & 31)) : R;
        RA[i] = R; CA[i] = C; voffB[i] = (unsigned)(Rb * K + C) * 2u; }
    const size_t kstep = (size_t)(BK * 2);
    const size_t hstep = (size_t)HALF * K * 2;
    const size_t tstep = 2 * hstep;
    const unsigned ldsw = (unsigned)wid * 1024u;
    const int aoff = lds_byte(wr * 64 + fr, fq * 8), boff = lds_byte(wc * 32 + fr, fq * 8);
#define PG8_SA(b, h) (((b) * 2 + (h)) * HTB)
#define PG8_SB(b, h) ((4 + (b) * 2 + (h)) * HTB)
#define PG8_STAGE(bufoff, gbase, voff) do { _Pragma("unroll") for (int _i = 0; _i < 2; ++_i) \
        __builtin_amdgcn_global_load_lds((const unsigned*)((const char*)(gbase) + (voff)[_i]), (LAS unsigned*)(lds + (bufoff) + ldsw + _i * 8192), 16, 0, 0); } while (0)
#define PG8_LDA(dst, b, h) do { _Pragma("unroll") for (int m = 0; m < 4; ++m) _Pragma("unroll") for (int k = 0; k < 2; ++k) dst[m][k] = *(const LAS bf16x8*)(lds + PG8_SA(b, h) + aoff + m * 2048 + k * 1024); } while (0)
#define PG8_LDB(dst, b, h) do { _Pragma("unroll") for (int n = 0; n < 2; ++n) _Pragma("unroll") for (int k = 0; k < 2; ++k) dst[n][k] = *(const LAS bf16x8*)(lds + PG8_SB(b, h) + boff + n * 2048 + k * 1024); } while (0)
#define PG8_MMA(ai, bj, At, Bt_) do { __builtin_amdgcn_s_setprio(1); _Pragma("unroll") for (int m = 0; m < 4; ++m) _Pragma("unroll") for (int n = 0; n < 2; ++n) _Pragma("unroll") for (int k = 0; k < 2; ++k) { \
        if constexpr (I8) acc[ai][bj][m][n] = __builtin_bit_cast(f32x4, __builtin_amdgcn_mfma_i32_16x16x64_i8(__builtin_bit_cast(i32x4, Bt_[n][k]), __builtin_bit_cast(i32x4, At[m][k]), __builtin_bit_cast(i32x4, acc[ai][bj][m][n]), 0, 0, 0)); \
        else acc[ai][bj][m][n] = __builtin_amdgcn_mfma_f32_16x16x32_bf16(Bt_[n][k], At[m][k], acc[ai][bj][m][n], 0, 0, 0); } __builtin_amdgcn_s_setprio(0); } while (0)
#define PG8_WAIT_V(n) asm volatile("s_waitcnt vmcnt(" #n ")" ::: "memory")
#define PG8_WAIT_L(n) asm volatile("s_waitcnt lgkmcnt(" #n ")" ::: "memory")
#define PG8_BAR __builtin_amdgcn_s_barrier()
#define PG8_SCHED __builtin_amdgcn_sched_barrier(0)
#define PG8_AOFF(dst, U) do { _Pragma("unroll") for (int _h = 0; _h < 2; ++_h) _Pragma("unroll") for (int _i = 0; _i < 2; ++_i) { \
        const int _row = (U).pm * BM + _h * HALF + RA[_i]; const int _src = GATHER ? aidx[_row] : _row; dst[_h][_i] = (unsigned)(_src * K + CA[_i]) * 2u; } } while (0)
#define PG8_STAGE_A(bufoff, kb, offs, h) do { _Pragma("unroll") for (int _i = 0; _i < 2; ++_i) \
        __builtin_amdgcn_global_load_lds((const unsigned*)((const char*)A + (kb) + (offs)[h][_i]), (LAS unsigned*)(lds + (bufoff) + ldsw + _i * 8192), 16, 0, 0); } while (0)
    Unit cur, nxt; int ui = 0;
    if (!S.next(0, cur)) return;
    f32x4 acc[2][2][4][2];
#pragma unroll
    for (int a = 0; a < 2; ++a)
#pragma unroll
        for (int b = 0; b < 2; ++b)
#pragma unroll
            for (int m = 0; m < 4; ++m)
#pragma unroll
                for (int n = 0; n < 2; ++n) acc[a][b][m][n] = (f32x4){0.f, 0.f, 0.f, 0.f};
    bf16x8 At[4][2], B0[2][2], B1[2][2];
    unsigned ac[2][2], an[2][2];
    PG8_AOFF(ac, cur);
    const char* cB = (const char*)Bt + ((size_t)cur.e * bstride) * 2 + (size_t)cur.pn * tstep;
    PG8_STAGE(PG8_SB(0, 0), cB, voffB); PG8_STAGE(PG8_SB(0, 1), cB + hstep, voffB); PG8_STAGE_A(PG8_SA(0, 0), 0, ac, 0); PG8_STAGE_A(PG8_SA(0, 1), 0, ac, 1);
    if (wr == 1) PG8_BAR;
    PG8_WAIT_V(2); PG8_BAR;
    PG8_STAGE(PG8_SB(1, 0), cB + kstep, voffB); PG8_STAGE_A(PG8_SA(1, 0), kstep, ac, 0); PG8_STAGE(PG8_SB(1, 1), cB + hstep + kstep, voffB);
    PG8_WAIT_V(6); PG8_BAR;
    for (;;) {
        const bool has_next = S.next(ui + 1, nxt);
        if (has_next) { PG8_AOFF(an, nxt); } else {
#pragma unroll
            for (int h = 0; h < 2; ++h)
#pragma unroll
                for (int i = 0; i < 2; ++i) an[h][i] = ac[h][i]; }
        const char* nB = has_next ? (const char*)Bt + ((size_t)nxt.e * bstride) * 2 + (size_t)nxt.pn * tstep : cB;
#pragma unroll 1
        for (int t = 0; t < nt; t += 2) {
            const bool last = (t == nt - 2);
            const size_t k1 = (size_t)(t + 1) * kstep;
            const size_t k2 = last ? 0 : (size_t)(t + 2) * kstep;
            const size_t k3 = k2 + kstep;
            const char* b2 = last ? nB : cB + (size_t)(t + 2) * kstep; const char* b3 = b2 + kstep;
            unsigned a2[2][2];
#pragma unroll
            for (int h = 0; h < 2; ++h)
#pragma unroll
                for (int i = 0; i < 2; ++i) a2[h][i] = last ? an[h][i] : ac[h][i];
            PG8_LDB(B0, 0, 0); PG8_LDB(B1, 0, 1); PG8_SCHED; PG8_LDA(At, 0, 0); PG8_STAGE_A(PG8_SA(1, 1), k1, ac, 1);
            PG8_WAIT_V(8); PG8_WAIT_L(0); PG8_BAR; PG8_MMA(0, 0, At, B0); PG8_MMA(0, 1, At, B1); PG8_BAR; PG8_SCHED;
            PG8_LDA(At, 0, 1); PG8_STAGE(PG8_SB(0, 0), b2, voffB); PG8_STAGE(PG8_SB(0, 1), b2 + hstep, voffB); PG8_STAGE_A(PG8_SA(0, 0), k2, a2, 0);
            PG8_WAIT_V(8); PG8_WAIT_L(0); PG8_BAR; PG8_MMA(1, 0, At, B0); PG8_MMA(1, 1, At, B1); PG8_BAR; PG8_SCHED;
            PG8_LDB(B0, 1, 0); PG8_LDB(B1, 1, 1); PG8_SCHED; PG8_LDA(At, 1, 0); PG8_STAGE_A(PG8_SA(0, 1), k2, a2, 1);
            PG8_WAIT_V(8); PG8_WAIT_L(0); PG8_BAR; PG8_MMA(0, 0, At, B0); PG8_MMA(0, 1, At, B1); PG8_BAR; PG8_SCHED;
            PG8_LDA(At, 1, 1); PG8_STAGE(PG8_SB(1, 0), b3, voffB); PG8_STAGE(PG8_SB(1, 1), b3 + hstep, voffB); PG8_STAGE_A(PG8_SA(1, 0), k3, a2, 0);
            PG8_WAIT_V(8); PG8_WAIT_L(0); PG8_BAR; PG8_MMA(1, 0, At, B0); PG8_MMA(1, 1, At, B1); PG8_BAR; PG8_SCHED;
        }
        if (wr == 0) PG8_BAR;
        E(acc, cur, wr, wc, fr, fq);
        if constexpr (Sched::SIGNAL) S.signal(cur, lane);
        if (!has_next) break;
#pragma unroll
        for (int a = 0; a < 2; ++a)
#pragma unroll
            for (int b = 0; b < 2; ++b)
#pragma unroll
                for (int m = 0; m < 4; ++m)
#pragma unroll
                    for (int n = 0; n < 2; ++n) acc[a][b][m][n] = (f32x4){0.f, 0.f, 0.f, 0.f};
        cur = nxt; cB = nB; ++ui;
#pragma unroll
        for (int h = 0; h < 2; ++h)
#pragma unroll
            for (int i = 0; i < 2; ++i) ac[h][i] = an[h][i];
        if (wr == 1) PG8_BAR;
    }
    PG8_WAIT_V(0);
    PG8_BAR;
#undef PG8_SA
#undef PG8_SB
#undef PG8_STAGE
#undef PG8_LDA
#undef PG8_LDB
#undef PG8_MMA
#undef PG8_WAIT_V
#undef PG8_WAIT_L
#undef PG8_BAR
#undef PG8_SCHED
#undef PG8_AOFF
#undef PG8_STAGE_A
}

__device__ __forceinline__ int x8(int e) { return e ^ ((((e >> 1) ^ (e >> 2)) & 1) << 1); }
struct EpiSwiGLU8 {
    static constexpr bool PERM = true, HP = false, SIGNAL = true;
    unsigned char* O; float descale; unsigned* flags;
    __device__ __forceinline__ void operator()(const f32x4 (&acc)[2][2][4][2], const Unit& u, int wr, int wc, int fr, int fq) const {
        const int row0 = u.pm * BM + wr * 64 + fr; const int col0 = u.pn * 128 + wc * 32 + 8 * fq;
#pragma unroll
        for (int ai = 0; ai < 2; ++ai)
#pragma unroll
            for (int m = 0; m < 4; ++m) { unsigned char* rowp = O + (size_t)(row0 + ai * HALF + m * 16) * DEXP + col0;
                float a[8];
#pragma unroll
                for (int n = 0; n < 2; ++n)
#pragma unroll
                    for (int j = 0; j < 4; ++j) { const float g = acc[ai][0][m][n][j] * descale, up = acc[ai][1][m][n][j] * descale; a[n * 4 + j] = S8_ACT * g * up / (1.0f + __expf(-g)); }
                u32x2 w; w.x = cvt4_fp8(a[0], a[1], a[2], a[3]); w.y = cvt4_fp8(a[4], a[5], a[6], a[7]);
                *(u32x2*)rowp = w; }
    }
};
template <class Epi, class Sched, bool GATHER>
__device__ __forceinline__ void gemm_phase8(LAS unsigned char* lds, int wv, const unsigned char* A, const unsigned char* Bt, size_t bstride, int Kb, const Sched& S, const Epi& E, const int* aidx) {
    int tid = wv * 64 + lane_id(); asm volatile("" : "+v"(tid));
    const int wid = wv, lane = tid & 63, wr = wid >> 2, wc = wid & 3, fr = lane & 15, fq = lane >> 4;
    const int nt = Kb / 128;
    int RA[2], CA[2]; unsigned voffB[2], voffB1[2];
#pragma unroll
    for (int i = 0; i < 2; ++i) { const int b = tid * 16 + i * 8192; const int R = b >> 7, pc = (b >> 4) & 7; const int C = (pc ^ x8((R >> 1) & 7)) * 16;
        const int Rb = Epi::PERM ? ((R & ~31) + perm32(R & 31)) : R;
        RA[i] = R; CA[i] = C;
        if (Epi::HP) { const int g0 = 64 * (R >> 5) + perm32(R & 31); voffB[i] = (unsigned)(g0 * Kb + C); voffB1[i] = (unsigned)((g0 + 32) * Kb + C); }
        else { voffB[i] = (unsigned)(Rb * Kb + C); voffB1[i] = voffB[i] + (unsigned)(HALF * Kb); } }
    const size_t kstep = 128;
    const size_t hstep = (size_t)HALF * Kb;
    const size_t tstep = 2 * hstep;
    const unsigned ldsw = (unsigned)wid * 1024u;
    const int xa = x8((fr >> 1) & 7);
    const int aoff = (wr * 64 + fr) * 128 + (((2 * fq) ^ xa) << 4), boff = (wc * 32 + fr) * 128 + (((2 * fq) ^ xa) << 4);
    const int aoff1 = aoff ^ 16, boff1 = boff ^ 16;
#define PG8_SA(b, h) (((b) * 2 + (h)) * HTB)
#define PG8_SB(b, h) ((4 + (b) * 2 + (h)) * HTB)
#define PG8_STAGE(bufoff, gbase, voff) do { _Pragma("unroll") for (int _i = 0; _i < 2; ++_i) \
        __builtin_amdgcn_global_load_lds((const unsigned*)((const char*)(gbase) + (voff)[_i]), (LAS unsigned*)(lds + (bufoff) + ldsw + _i * 8192), 16, 0, 0); } while (0)
#define PG8_RD32(dst, off, off1) do { const u32x4 _lo = *(const LAS u32x4*)(lds + (off)), _hi = *(const LAS u32x4*)(lds + (off1)); \
        dst = (i32x8){(int)_lo.x, (int)_lo.y, (int)_lo.z, (int)_lo.w, (int)_hi.x, (int)_hi.y, (int)_hi.z, (int)_hi.w}; } while (0)
#define PG8_LDA(dst, b, h) do { _Pragma("unroll") for (int m = 0; m < 4; ++m) PG8_RD32(dst[m], PG8_SA(b, h) + aoff + m * 2048, PG8_SA(b, h) + aoff1 + m * 2048); } while (0)
#define PG8_LDB(dst, b, h) do { _Pragma("unroll") for (int n = 0; n < 2; ++n) PG8_RD32(dst[n], PG8_SB(b, h) + boff + n * 2048, PG8_SB(b, h) + boff1 + n * 2048); } while (0)
#define PG8_MMA(ai, bj, At, Bt_) do { __builtin_amdgcn_s_setprio(1); _Pragma("unroll") for (int m = 0; m < 4; ++m) _Pragma("unroll") for (int n = 0; n < 2; ++n) \
        asm volatile("v_mfma_scale_f32_16x16x128_f8f6f4 %0, %1, %2, %0, %3, %3 op_sel_hi:[0,0,0]" : "+v"(acc[ai][bj][m][n]) : "v"(Bt_[n]), "v"(At[m]), "v"(sc1)); __builtin_amdgcn_s_setprio(0); } while (0)
#define PG8_WAIT_V(n) asm volatile("s_waitcnt vmcnt(" #n ")" ::: "memory")
#define PG8_WAIT_L(n) asm volatile("s_waitcnt lgkmcnt(" #n ")" ::: "memory")
#define PG8_BAR __builtin_amdgcn_s_barrier()
#define PG8_SCHED __builtin_amdgcn_sched_barrier(0)
#define PG8_AOFF(dst, U) do { _Pragma("unroll") for (int _h = 0; _h < 2; ++_h) _Pragma("unroll") for (int _i = 0; _i < 2; ++_i) { \
        const int _row = (U).pm * BM + _h * HALF + RA[_i]; const int _src = GATHER ? aidx[_row] : _row; dst[_h][_i] = (unsigned)(_src * Kb + CA[_i]); } } while (0)
#define PG8_STAGE_A(bufoff, kb, offs, h) do { _Pragma("unroll") for (int _i = 0; _i < 2; ++_i) \
        __builtin_amdgcn_global_load_lds((const unsigned*)((const char*)A + (kb) + (offs)[h][_i]), (LAS unsigned*)(lds + (bufoff) + ldsw + _i * 8192), 16, 0, 0); } while (0)
    Unit cur, nxt; int ui = 0;
    if (!S.next(0, cur)) return;
    f32x4 acc[2][2][4][2];
#pragma unroll
    for (int a = 0; a < 2; ++a)
#pragma unroll
        for (int b = 0; b < 2; ++b)
#pragma unroll
            for (int m = 0; m < 4; ++m)
#pragma unroll
                for (int n = 0; n < 2; ++n) acc[a][b][m][n] = (f32x4){0.f, 0.f, 0.f, 0.f};
    i32x8 At[4], B0[2], B1[2];
    int sc1 = 0x7F7F7F7F; asm volatile("" : "+v"(sc1));
    unsigned ac[2][2], an[2][2];
    PG8_AOFF(ac, cur);
    const char* cB = (const char*)Bt + (size_t)cur.e * bstride + (size_t)cur.pn * tstep;
    PG8_STAGE(PG8_SB(0, 0), cB, voffB); PG8_STAGE(PG8_SB(0, 1), cB, voffB1); PG8_STAGE_A(PG8_SA(0, 0), 0, ac, 0); PG8_STAGE_A(PG8_SA(0, 1), 0, ac, 1);
    if (wr == 1) PG8_BAR;
    PG8_WAIT_V(2); PG8_BAR;
    PG8_STAGE(PG8_SB(1, 0), cB + kstep, voffB); PG8_STAGE_A(PG8_SA(1, 0), kstep, ac, 0); PG8_STAGE(PG8_SB(1, 1), cB + kstep, voffB1);
    PG8_WAIT_V(6); PG8_BAR;
    for (;;) {
        const bool has_next = S.next(ui + 1, nxt);
        if (has_next) { PG8_AOFF(an, nxt); } else {
#pragma unroll
            for (int h = 0; h < 2; ++h)
#pragma unroll
                for (int i = 0; i < 2; ++i) an[h][i] = ac[h][i]; }
        const char* nB = has_next ? (const char*)Bt + (size_t)nxt.e * bstride + (size_t)nxt.pn * tstep : cB;
#pragma unroll 1
        for (int t = 0; t < nt; t += 2) {
            const bool last = (t == nt - 2);
            const size_t k1 = (size_t)(t + 1) * kstep;
            const size_t k2 = last ? 0 : (size_t)(t + 2) * kstep;
            const size_t k3 = k2 + kstep;
            const char* b2 = last ? nB : cB + (size_t)(t + 2) * kstep; const char* b3 = b2 + kstep;
            unsigned a2[2][2];
#pragma unroll
            for (int h = 0; h < 2; ++h)
#pragma unroll
                for (int i = 0; i < 2; ++i) a2[h][i] = last ? an[h][i] : ac[h][i];
            PG8_LDB(B0, 0, 0); PG8_LDB(B1, 0, 1); PG8_SCHED; PG8_LDA(At, 0, 0); PG8_STAGE_A(PG8_SA(1, 1), k1, ac, 1);
            PG8_WAIT_V(8); PG8_WAIT_L(0); PG8_BAR; PG8_MMA(0, 0, At, B0); PG8_MMA(0, 1, At, B1); PG8_BAR; PG8_SCHED;
            PG8_LDA(At, 0, 1); PG8_STAGE(PG8_SB(0, 0), b2, voffB); PG8_STAGE(PG8_SB(0, 1), b2, voffB1); PG8_STAGE_A(PG8_SA(0, 0), k2, a2, 0);
            PG8_WAIT_V(8); PG8_WAIT_L(0); PG8_BAR; PG8_MMA(1, 0, At, B0); PG8_MMA(1, 1, At, B1); PG8_BAR; PG8_SCHED;
            PG8_LDB(B0, 1, 0); PG8_LDB(B1, 1, 1); PG8_SCHED; PG8_LDA(At, 1, 0); PG8_STAGE_A(PG8_SA(0, 1), k2, a2, 1);
            PG8_WAIT_V(8); PG8_WAIT_L(0); PG8_BAR; PG8_MMA(0, 0, At, B0); PG8_MMA(0, 1, At, B1); PG8_BAR; PG8_SCHED;
            PG8_LDA(At, 1, 1); PG8_STAGE(PG8_SB(1, 0), b3, voffB); PG8_STAGE(PG8_SB(1, 1), b3, voffB1); PG8_STAGE_A(PG8_SA(1, 0), k3, a2, 0);
            PG8_WAIT_V(8); PG8_WAIT_L(0); PG8_BAR; PG8_MMA(1, 0, At, B0); PG8_MMA(1, 1, At, B1); PG8_BAR; PG8_SCHED;
        }
        if (wr == 0) PG8_BAR;
        asm volatile("s_nop 15\n\ts_nop 15" ::: "memory");
        E(acc, cur, wr, wc, fr, fq);
        if constexpr (Epi::SIGNAL) { asm volatile("s_waitcnt vmcnt(0)" ::: "memory"); if (lane == 0) (void)xb_add(E.flags + cur.pm, 1u); }
        if (!has_next) break;
#pragma unroll
        for (int a = 0; a < 2; ++a)
#pragma unroll
            for (int b = 0; b < 2; ++b)
#pragma unroll
                for (int m = 0; m < 4; ++m)
#pragma unroll
                    for (int n = 0; n < 2; ++n) acc[a][b][m][n] = (f32x4){0.f, 0.f, 0.f, 0.f};
        cur = nxt; cB = nB; ++ui;
#pragma unroll
        for (int h = 0; h < 2; ++h)
#pragma unroll
            for (int i = 0; i < 2; ++i) ac[h][i] = an[h][i];
        if (wr == 1) PG8_BAR;
    }
    PG8_WAIT_V(0);
    PG8_BAR;
#undef PG8_SA
#undef PG8_SB
#undef PG8_STAGE
#undef PG8_RD32
#undef PG8_LDA
#undef PG8_LDB
#undef PG8_MMA
#undef PG8_WAIT_V
#undef PG8_WAIT_L
#undef PG8_BAR
#undef PG8_SCHED
#undef PG8_AOFF
#undef PG8_STAGE_A
}
}

namespace attn_body {
using bf16 = __hip_bfloat16;
using f32x16 = __attribute__((ext_vector_type(16))) float;
constexpr int D = 64, PQ = 3072, PO = 2048;
constexpr int NW = 8, QBLK = 32, QB = QBLK * NW, KVBLK = 64, NQB = SEQ / QB;
__device__ __forceinline__ int crow(int r, int hi) { return (r & 3) + 8 * (r >> 2) + 4 * hi; }
#define SBAR() __builtin_amdgcn_sched_barrier(0)
__device__ __forceinline__ void cmask(f32x16& p0, f32x16& p1, int jb, int qrel, int hi) {
    const float NEG = -INFINITY; int kb = 64 * jb + 4 * hi;
#pragma unroll
    for (int r = 0; r < 16; ++r) { int kv = kb + (r & 3) + 8 * (r >> 2); if (kv > qrel) p0[r] = NEG; if (kv + 32 > qrel) p1[r] = NEG; }
}
constexpr int NSLOT = 3, SLOTB = 8192;
constexpr int LDS_K = 0, LDS_V = NSLOT * SLOTB, LDS_WS = 2 * NSLOT * SLOTB, LDS_OST = LDS_WS + NW * 64 * 4, ATT_LDS_BYTES = LDS_OST + NW * 4096;
__device__ __forceinline__ void glds16(const void* gsrc, unsigned lds_dst) { unsigned keep;
    asm volatile("s_mov_b32 %0, m0\n\ts_mov_b32 m0, %2\n\ts_nop 0\n\tglobal_load_lds_dwordx4 %1, off\n\ts_mov_b32 m0, %0" : "=&s"(keep) : "v"(gsrc), "s"(lds_dst) : "memory"); }
__device__ __forceinline__ float max3f(float a, float b, float c) { float r; asm("v_max3_f32 %0, %1, %2, %3" : "=v"(r) : "v"(a), "v"(b), "v"(c)); return r; }
__device__ __forceinline__ float max2f(float a, float b) { float r; asm("v_max_f32_e32 %0, %1, %2" : "=v"(r) : "v"(a), "v"(b)); return r; }
__device__ __forceinline__ float fadd_s(float a, float b) { float r; asm("v_add_f32_e32 %0, %1, %2" : "=v"(r) : "v"(a), "v"(b)); return r; }
__device__ __forceinline__ float fsub_s(float a, float b) { float r; asm("v_sub_f32_e32 %0, %1, %2" : "=v"(r) : "v"(a), "v"(b)); return r; }
__device__ __forceinline__ unsigned cvtpk_s(float lo, float hi) { f32x2 v = {lo, hi}; bf16x2_t b = __builtin_convertvector(v, bf16x2_t); return __builtin_bit_cast(unsigned, b); }
#define WAIT_BAR(N) asm volatile("s_waitcnt vmcnt(" #N ") lgkmcnt(0)\n\ts_barrier" ::: "memory")
__device__ __forceinline__ void qkt(f32x16& p0, f32x16& p1, const char* Kslot, const bf16x8* qr, const f32x16& negm, int r32, int hi) {
    const char* kb = Kslot + hi * 1024 + r32 * 16;
#pragma unroll
    for (int d0 = 0; d0 < 4; ++d0) {
        const bf16x8 b0 = *reinterpret_cast<const bf16x8*>(kb + d0 * 2048);
        const bf16x8 b1 = *reinterpret_cast<const bf16x8*>(kb + d0 * 2048 + 512);
        if (d0 == 0) { p0 = __builtin_amdgcn_mfma_f32_32x32x16_bf16(b0, qr[0], negm, 0, 0, 0); p1 = __builtin_amdgcn_mfma_f32_32x32x16_bf16(b1, qr[0], negm, 0, 0, 0); }
        else { p0 = __builtin_amdgcn_mfma_f32_32x32x16_bf16(b0, qr[d0], p0, 0, 0, 0); p1 = __builtin_amdgcn_mfma_f32_32x32x16_bf16(b1, qr[d0], p1, 0, 0, 0); } }
}
typedef __attribute__((address_space(3))) const char* lds_cptr;
typedef short v4i16_t __attribute__((ext_vector_type(4)));
__device__ __forceinline__ void kload8(bf16x8* kf, lds_cptr kp) {
    kf[0] = *(const LAS bf16x8*)(kp);        kf[1] = *(const LAS bf16x8*)(kp + 512);
    kf[2] = *(const LAS bf16x8*)(kp + 2048); kf[3] = *(const LAS bf16x8*)(kp + 2560);
    kf[4] = *(const LAS bf16x8*)(kp + 4096); kf[5] = *(const LAS bf16x8*)(kp + 4608);
    kf[6] = *(const LAS bf16x8*)(kp + 6144); kf[7] = *(const LAS bf16x8*)(kp + 6656);
}
__device__ __forceinline__ void kload2(bf16x8* kf, lds_cptr kp, int j) { kf[2 * j] = *(const LAS bf16x8*)(kp + j * 2048); kf[2 * j + 1] = *(const LAS bf16x8*)(kp + j * 2048 + 512); }
__device__ __forceinline__ s16x4 vtr(lds_cptr p) { return __builtin_bit_cast(s16x4, __builtin_amdgcn_ds_read_tr16_b64_v4i16((LAS v4i16_t*)p)); }
__device__ __forceinline__ float rowmax(const f32x16& p0, const f32x16& p1) {
    float a = max3f(p0[0], p0[1], p1[0]), b = max3f(p0[2], p0[3], p1[1]); a = max3f(a, p1[2], p1[3]);
#pragma unroll
    for (int r = 4; r < 16; r += 4) { a = max3f(a, p0[r], p0[r + 1]); b = max3f(b, p0[r + 2], p0[r + 3]); a = max3f(a, p1[r], p1[r + 1]); b = max3f(b, p1[r + 2], p1[r + 3]); }
    const float m = max2f(a, b);
    auto rr = __builtin_amdgcn_permlane32_swap(__float_as_uint(m), __float_as_uint(m), false, false);
    return max2f(__uint_as_float(rr[0]), __uint_as_float(rr[1]));
}
__device__ __forceinline__ void pv(f32x16* o, int vb, bf16x8 pa0, bf16x8 pa1, bf16x8 pa2, bf16x8 pa3) {
#pragma unroll
    for (int d0 = 0; d0 < 2; ++d0) { s16x4 lo[4], hi[4];
#pragma unroll
        for (int ks = 0; ks < 4; ++ks) {
            asm volatile("ds_read_b64_tr_b16 %0,%1 offset:%c2" : "=&v"(lo[ks]) : "v"(vb), "i"(d0 * 4096 + ks * 1024) : "memory");
            asm volatile("ds_read_b64_tr_b16 %0,%1 offset:%c2" : "=&v"(hi[ks]) : "v"(vb), "i"(d0 * 4096 + ks * 1024 + 512) : "memory"); }
        asm volatile("s_waitcnt lgkmcnt(0)" ::: "memory"); SBAR();
#define PK(k) (bf16x8){lo[k][0], lo[k][1], lo[k][2], lo[k][3], hi[k][0], hi[k][1], hi[k][2], hi[k][3]}
        o[d0] = __builtin_amdgcn_mfma_f32_32x32x16_bf16(pa0, PK(0), o[d0], 0, 0, 0);
        o[d0] = __builtin_amdgcn_mfma_f32_32x32x16_bf16(pa1, PK(1), o[d0], 0, 0, 0);
        o[d0] = __builtin_amdgcn_mfma_f32_32x32x16_bf16(pa2, PK(2), o[d0], 0, 0, 0);
        o[d0] = __builtin_amdgcn_mfma_f32_32x32x16_bf16(pa3, PK(3), o[d0], 0, 0, 0);
#undef PK
    }
}
#define ATTN_STORE16(p, v) (*(u32x4*)(p) = (v))
template <int THRL> __device__ __forceinline__ void attn_unit(int wv, int pair, int qb, const bf16* Pb, bf16* Obuf, char* shm) {
    const int b = pair >> 5, v5 = pair & 31, hc = v5 >> 1; const int qc = hc * 64, kc = 1024 + hc * 64, vc = 2048 + (v5 >> 2) * 128 + (v5 & 1) * 64, oc = v5 * 64;
    int tid = wv * 64 + lane_id(); asm volatile("" : "+v"(tid));
    const int lane = tid & 63, r32 = lane & 31, hi = lane >> 5; const int wid = wv;
    const long rowbase = (long)b * SEQ; const int q0 = qb * QB;
    const bf16* Qw = Pb + (rowbase + q0 + wid * QBLK) * PQ + qc;
    const bf16* Kh = Pb + rowbase * PQ + kc, *Vh = Pb + rowbase * PQ + vc;
    const unsigned lds0 = (unsigned)(uintptr_t)shm;
    float* wsf = (float*)(shm + LDS_WS) + wid * 64;
    const bf16* ksrc = Kh + (long)lane * PQ + wid * 8;
    const bf16* vsrc = Vh + (long)(16 * (wid & 3) + (lane >> 2)) * PQ + (wid >> 2) * 32 + (lane & 3) * 8;
    const unsigned kdst = lds0 + LDS_K + wid * 1024, vdst = lds0 + LDS_V + wid * 1024;
#define DMA_K(t, slot) glds16(ksrc + (long)(t) * KVBLK * PQ, (unsigned)__builtin_amdgcn_readfirstlane(kdst + (slot)))
#define DMA_V(t, slot) glds16(vsrc + (long)(t) * KVBLK * PQ, (unsigned)__builtin_amdgcn_readfirstlane(vdst + (slot)))
    const int vb0 = (int)(lds0 + LDS_V) + ((lane >> 4) & 1) * 32 + (lane & 3) * 8 + (4 * hi + ((lane & 15) >> 2)) * 64;
    const char* Kbase = shm + LDS_K; bf16x8 kf[8];
    const lds_cptr shm3 = (lds_cptr)shm; const lds_cptr kp0 = shm3 + LDS_K + hi * 1024 + r32 * 16; const lds_cptr vp0 = shm3 + LDS_V + ((lane >> 4) & 1) * 32 + (lane & 3) * 8 + (4 * hi + ((lane & 15) >> 2)) * 64;
    const int NT = (q0 + QB) / KVBLK;
    DMA_K(0, 0); DMA_V(0, 0); DMA_K(1, SLOTB);
    bf16x8 qr[4];
#pragma unroll
    for (int d0 = 0; d0 < 4; ++d0) qr[d0] = *reinterpret_cast<const bf16x8*>(&Qw[(long)r32 * PQ + d0 * 16 + hi * 8]);
    float mhat = 0.f, l_reg = 0.f; f32x16 o[2]; o[0] = f32x16{}; o[1] = f32x16{}; f32x16 negm = f32x16{}; asm volatile("" : "+v"(negm));
    const int qrel = wid * QBLK + r32;
#define CMASK(P0, P1, t) do { int jb_ = (t) - (NT - 4); if (jb_ >= 0) cmask(P0, P1, jb_, qrel, hi); } while (0)
    bool resc = false;
#define START(P0, P1) do { const float rm = rowmax(P0, P1); resc = false; \
    { const float dl = rm; mhat = fadd_s(mhat, dl); \
      _Pragma("unroll") for (int r = 0; r < 16; ++r) { P0[r] = fsub_s(P0[r], dl); P1[r] = fsub_s(P1[r], dl); } \
      _Pragma("unroll") for (int r = 0; r < 16; ++r) negm[r] = -mhat; asm volatile("" : "+v"(negm)); } \
    _Pragma("unroll") for (int r = 0; r < 16; ++r) P0[r] = __builtin_amdgcn_exp2f(P0[r]); } while (0)
#define RESC() do { if (resc) { asm volatile("s_waitcnt lgkmcnt(0)" ::: "memory"); \
      _Pragma("unroll") for (int d_ = 0; d_ < 2; ++d_) _Pragma("unroll") for (int r = 0; r < 16; ++r) o[d_][r] *= wsf[crow(r, hi)]; } } while (0)
    f32x16 pA0, pA1, pB0, pB1;
    int sl_prev = 0, sl_cur = 0, sl_next = SLOTB;
#define ROT() do { sl_prev = sl_cur; sl_cur = sl_next; sl_next = (sl_next == (NSLOT - 1) * SLOTB) ? 0 : sl_next + SLOTB; } while (0)
    DMA_K(2, 2 * SLOTB);
    WAIT_BAR(3);
    qkt(pA0, pA1, Kbase, qr, negm, r32, hi); asm volatile("s_nop 15\n\ts_nop 7" : "+v"(pA0), "+v"(pA1)); CMASK(pA0, pA1, 0);
    START(pA0, pA1);
    _Pragma("unroll") for (int r = 0; r < 16; ++r) pA1[r] = __builtin_amdgcn_exp2f(pA1[r]);
    WAIT_BAR(0);
    DMA_K(3, 0); DMA_V(1, SLOTB);
    ROT();
    kload8(kf, kp0 + sl_cur);
    WAIT_BAR(2);
    s16x4 vlo[8], vhi[8]; u32x4 pw0, pw1, pw2, pw3;
#define PKW(P, B) cvtpk_s(P[B], P[B + 1])
#define PAF(k) __builtin_bit_cast(bf16x8, pw##k)
#define VFR(i) (bf16x8){vlo[i][0], vlo[i][1], vlo[i][2], vlo[i][3], vhi[i][0], vhi[i][1], vhi[i][2], vhi[i][3]}
#define PIN(x) asm volatile("" : "+v"(x))
#define MX3(a, b, c) __builtin_fmaxf(__builtin_fmaxf((a), (b)), (c))
#define GAPA(MF, A0, A1, A2, A3, W0, W1, PW) do { MF; sacc += A0; sacc += A1; sacc += A2; sacc += A3; PIN(sacc); W0; W1; PIN(PW); SBAR(); } while (0)
#define EX(v) __builtin_amdgcn_exp2f(v)
#define GAPB(MF, X, B) do { MF; X[B] = EX(X[B]); X[B + 1] = EX(X[B + 1]); X[B + 2] = EX(X[B + 2]); X[B + 3] = EX(X[B + 3]); PIN(X); SBAR(); } while (0)
#define VRD(i) do { vlo[i] = vtr(vp_ + (((i) >> 2) * 4096 + ((i) & 3) * 1024)); vhi[i] = vtr(vp_ + (((i) >> 2) * 4096 + ((i) & 3) * 1024 + 512)); } while (0)
#define KRD(G, j) do { if (G) { kload2(kf, kp0 + sl_next, j); SBAR(); } } while (0)
#define STEP(C0, C1, P0, P1, t, GK, GV, GL) do { SBAR(); \
    const lds_cptr vp_ = vp0 + sl_prev; \
    VRD(0); SBAR(); float sacc = (P0[0] + P0[1]); \
    GAPA(C0 = __builtin_amdgcn_mfma_f32_32x32x16_bf16(kf[0], qr[0], negm, 0, 0, 0), P0[2], P0[3], P0[4], P0[5],     pw0[0] = PKW(P0, 0), pw0[1] = PKW(P0, 2), pw0); \
    VRD(4); SBAR(); GAPA(C1 = __builtin_amdgcn_mfma_f32_32x32x16_bf16(kf[1], qr[0], negm, 0, 0, 0), P0[6], P0[7], P0[8], P0[9],     pw0[2] = PKW(P0, 4), pw0[3] = PKW(P0, 6), pw0); \
    VRD(1); SBAR(); GAPA(C0 = __builtin_amdgcn_mfma_f32_32x32x16_bf16(kf[2], qr[1], C0, 0, 0, 0),   P0[10], P0[11], P0[12], P0[13], pw1[0] = PKW(P0, 8), pw1[1] = PKW(P0, 10), pw1); \
    VRD(5); SBAR(); GAPA(C1 = __builtin_amdgcn_mfma_f32_32x32x16_bf16(kf[3], qr[1], C1, 0, 0, 0),   P0[14], P0[15], P1[0], P1[1],   pw1[2] = PKW(P0, 12), pw1[3] = PKW(P0, 14), pw1); \
    VRD(2); SBAR(); GAPA(C0 = __builtin_amdgcn_mfma_f32_32x32x16_bf16(kf[4], qr[2], C0, 0, 0, 0),   P1[2], P1[3], P1[4], P1[5],     pw2[0] = PKW(P1, 0), pw2[1] = PKW(P1, 2), pw2); \
    VRD(6); SBAR(); GAPA(C1 = __builtin_amdgcn_mfma_f32_32x32x16_bf16(kf[5], qr[2], C1, 0, 0, 0),   P1[6], P1[7], P1[8], P1[9],     pw2[2] = PKW(P1, 4), pw2[3] = PKW(P1, 6), pw2); \
    VRD(3); SBAR(); GAPA(C0 = __builtin_amdgcn_mfma_f32_32x32x16_bf16(kf[6], qr[3], C0, 0, 0, 0),   P1[10], P1[11], P1[12], P1[13], pw3[0] = PKW(P1, 8), pw3[1] = PKW(P1, 10), pw3); \
    VRD(7); SBAR(); GAPA(C1 = __builtin_amdgcn_mfma_f32_32x32x16_bf16(kf[7], qr[3], C1, 0, 0, 0),   P1[14], P1[15], 0.f, 0.f,       pw3[2] = PKW(P1, 12), pw3[3] = PKW(P1, 14), pw3); \
    l_reg += sacc; \
    if (GK) { DMA_K((t) + 3, sl_cur); } if (GV) { DMA_V((t) + 1, sl_next); } \
    CMASK(C0, C1, t); \
    { float a = MX3(C0[0], C0[1], C1[0]), b = MX3(C0[2], C0[3], C1[1]); a = MX3(a, C1[2], C1[3]); \
      _Pragma("unroll") for (int r = 4; r < 16; r += 4) { a = MX3(a, C0[r], C0[r + 1]); b = MX3(b, C0[r + 2], C0[r + 3]); a = MX3(a, C1[r], C1[r + 1]); b = MX3(b, C1[r + 2], C1[r + 3]); } \
      float rm = __builtin_fmaxf(a, b); { auto rr = __builtin_amdgcn_permlane32_swap(__float_as_uint(rm), __float_as_uint(rm), false, false); rm = __builtin_fmaxf(__uint_as_float(rr[0]), __uint_as_float(rr[1])); } \
      resc = false; \
      if (__builtin_expect(__any(rm > (float)THRL), 0)) { const float dl = __builtin_fmaxf(rm, 0.f); mhat += dl; \
        _Pragma("unroll") for (int r = 0; r < 16; ++r) { C0[r] -= dl; C1[r] -= dl; } \
        _Pragma("unroll") for (int r = 0; r < 16; ++r) negm[r] = -mhat; asm volatile("" : "+v"(negm)); \
        const float f = __builtin_amdgcn_exp2f(-dl); l_reg *= f; if (hi == 0) wsf[r32] = f; resc = true; } } \
    SBAR(); \
    GAPB(o[0] = __builtin_amdgcn_mfma_f32_32x32x16_bf16(PAF(0), VFR(0), o[0], 0, 0, 0), C0, 0); \
    GAPB(o[1] = __builtin_amdgcn_mfma_f32_32x32x16_bf16(PAF(0), VFR(4), o[1], 0, 0, 0), C0, 4); \
    KRD(GL, 0); GAPB(o[0] = __builtin_amdgcn_mfma_f32_32x32x16_bf16(PAF(1), VFR(1), o[0], 0, 0, 0), C0, 8); \
    KRD(GL, 1); GAPB(o[1] = __builtin_amdgcn_mfma_f32_32x32x16_bf16(PAF(1), VFR(5), o[1], 0, 0, 0), C0, 12); \
    KRD(GL, 2); GAPB(o[0] = __builtin_amdgcn_mfma_f32_32x32x16_bf16(PAF(2), VFR(2), o[0], 0, 0, 0), C1, 0); \
    KRD(GL, 3); GAPB(o[1] = __builtin_amdgcn_mfma_f32_32x32x16_bf16(PAF(2), VFR(6), o[1], 0, 0, 0), C1, 4); \
    GAPB(o[0] = __builtin_amdgcn_mfma_f32_32x32x16_bf16(PAF(3), VFR(3), o[0], 0, 0, 0), C1, 8); \
    GAPB(o[1] = __builtin_amdgcn_mfma_f32_32x32x16_bf16(PAF(3), VFR(7), o[1], 0, 0, 0), C1, 12); \
    } while (0)
    int t = 1;
#undef CMASK
#define CMASK(P0, P1, t) do {} while (0)
    for (; t + 5 < NT; t += 2) {
        STEP(pB0, pB1, pA0, pA1, t, true, true, true);     WAIT_BAR(2); RESC(); ROT();
        STEP(pA0, pA1, pB0, pB1, t + 1, true, true, true); WAIT_BAR(2); RESC(); ROT();
    }
#undef CMASK
#define CMASK(P0, P1, t) do { int jb_ = (t) - (NT - 4); if (jb_ >= 0) cmask(P0, P1, jb_, qrel, hi); } while (0)
#define ENDW(tt) do { if ((tt) + 3 < NT) { WAIT_BAR(2); } else if ((tt) + 2 < NT) { WAIT_BAR(1); } else { WAIT_BAR(0); } } while (0)
    for (; t + 1 < NT; t += 2) {
        STEP(pB0, pB1, pA0, pA1, t, (t + 3 < NT), (t + 1 < NT), (t + 1 < NT));         ENDW(t);     RESC(); ROT();
        STEP(pA0, pA1, pB0, pB1, t + 1, (t + 4 < NT), (t + 2 < NT), (t + 2 < NT));     ENDW(t + 1); RESC(); ROT();
    }
    STEP(pB0, pB1, pA0, pA1, NT - 1, false, false, false); RESC();
    { float sacc = pB0[0] + pB0[1]; _Pragma("unroll") for (int r = 2; r < 16; ++r) sacc += pB0[r]; _Pragma("unroll") for (int r = 0; r < 16; ++r) sacc += pB1[r]; l_reg += sacc;
      pw0 = (u32x4){PKW(pB0, 0), PKW(pB0, 2), PKW(pB0, 4), PKW(pB0, 6)}; pw1 = (u32x4){PKW(pB0, 8), PKW(pB0, 10), PKW(pB0, 12), PKW(pB0, 14)}; pw2 = (u32x4){PKW(pB1, 0), PKW(pB1, 2), PKW(pB1, 4), PKW(pB1, 6)}; pw3 = (u32x4){PKW(pB1, 8), PKW(pB1, 10), PKW(pB1, 12), PKW(pB1, 14)};
      SBAR(); pv(o, vb0 + sl_cur, PAF(0), PAF(1), PAF(2), PAF(3)); }
#undef PKW
#undef PAF
#undef VFR
#undef PIN
#undef MX3
#undef GAPA
#undef GAPB
#undef EX
#undef VRD
#undef KRD
#undef STEP
#undef ENDW
    { auto rr = __builtin_amdgcn_permlane32_swap(__float_as_uint(l_reg), __float_as_uint(l_reg), false, false); l_reg = __uint_as_float(rr[0]) + __uint_as_float(rr[1]); }
    if (hi == 0) wsf[32 + r32] = l_reg; asm volatile("s_waitcnt lgkmcnt(0)" ::: "memory");
    float rli[16];
#pragma unroll
    for (int r = 0; r < 16; ++r) rli[r] = __builtin_amdgcn_rcpf(wsf[32 + crow(r, hi)]);
    bf16* Ow = Obuf + (rowbase + q0 + wid * QBLK) * PO + oc;
    { bf16* stg = (bf16*)(shm + LDS_OST) + wid * 2048;
#pragma unroll
      for (int r = 0; r < 16; ++r) { const int orow = crow(r, hi);
#pragma unroll
        for (int d0 = 0; d0 < 2; ++d0) stg[orow * 64 + d0 * 32 + r32] = __float2bfloat16(o[d0][r] * rli[r]); }
      asm volatile("s_waitcnt lgkmcnt(0)" ::: "memory");
#pragma unroll
      for (int i = 0; i < 4; ++i) { const int row = i * 8 + (lane >> 3), ch = lane & 7; const u32x4 v = *(const u32x4*)(stg + row * 64 + ch * 8); ATTN_STORE16(Ow + (long)row * PO + ch * 8, v); } }
    asm volatile("s_waitcnt lgkmcnt(0)\n\ts_barrier" ::: "memory");
#undef DMA_K
#undef DMA_V
#undef CMASK
#undef START
#undef RESC
#undef ROT
}
#undef SBAR
#undef WAIT_BAR
}


namespace at2 {
using f32x16 = __attribute__((ext_vector_type(16))) float;
constexpr int PQ = 3072, PO = 256, DV = 128, DQ = 64;
constexpr int NW = 8, QBLK = 32, KVBLK = 64, QB = NW * QBLK;
constexpr int SHM_V = KVBLK * DV * 2, SHM_K = KVBLK * DQ * 2;
constexpr int OFF_VL = 0, OFF_KL = 2 * SHM_V, OFF_WS = 2 * SHM_V + 2 * SHM_K;
constexpr int OFF_OL = OFF_WS + 2048, OL_RS = 272, OL_WAVE = QBLK * OL_RS;
constexpr float THR2 = 8.f;
#define KSWZ64(row, colB) ((row) * 128 + ((colB) ^ (((row) & 7) << 4)))
#define SBAR() __builtin_amdgcn_sched_barrier(0)
__device__ __forceinline__ int v_st(int k, int c) { const int kk = (k & ~0xC) | ((k & 4) << 1) | ((k & 8) >> 1); return ((kk >> 3) * 4 + (c >> 5)) * 512 + ((kk & 7) * 32 + (c & 31)) * 2; }
__device__ __forceinline__ int v_rd_base(int lane) { return ((lane & 3) << 3) | (((lane >> 2) & 3) << 6) | (((lane >> 4) & 1) << 5) | (((lane >> 5) & 1) << 8); }
constexpr int v_rd_off(int d0, int ks, int half) { return d0 * 512 + ks * 4096 + half * 2048; }
__device__ __forceinline__ int crow(int r, int hi) { return (r & 3) + 8 * (r >> 2) + 4 * hi; }
__device__ __forceinline__ bf16x8 load8(const bf16_t* p) { return *reinterpret_cast<const bf16x8*>(p); }
__device__ __forceinline__ void mask_tile(f32x16& p0, f32x16& p1, int dq) {
    const float NEG = -__builtin_inff();
#pragma unroll
    for (int r = 0; r < 16; ++r) { const int c = (r & 3) + 8 * (r >> 2); if (dq - c < 0) p0[r] = NEG; if (dq - c - 32 < 0) p1[r] = NEG; }
}
__device__ __forceinline__ void partialSM(f32x16& p0, f32x16& p1, float& m_reg, float& mn, float& alpha) {
    float pmax = p0[0];
#pragma unroll
    for (int r = 1; r < 16; ++r) pmax = fmaxf(pmax, p0[r]);
#pragma unroll
    for (int r = 0; r < 16; ++r) pmax = fmaxf(pmax, p1[r]);
    { auto rr = __builtin_amdgcn_permlane32_swap(__float_as_uint(pmax), __float_as_uint(pmax), false, false); pmax = fmaxf(__uint_as_float(rr[0]), __uint_as_float(rr[1])); }
    if (__builtin_expect(__all((pmax - m_reg) <= THR2), 1)) { mn = m_reg; alpha = 1.f; }
    else { mn = fmaxf(m_reg, pmax); alpha = __builtin_amdgcn_exp2f(m_reg - mn); m_reg = mn; }
#pragma unroll
    for (int r = 0; r < 16; ++r) { p0[r] = p0[r] - mn; p1[r] = p1[r] - mn; }
#pragma unroll
    for (int r = 0; r < 16; ++r) p0[r] = __builtin_amdgcn_exp2f(p0[r]);
}
__device__ __forceinline__ void finishSM(f32x16& p0, f32x16& p1, float alpha, float& l_reg, bf16x8& pa0, bf16x8& pa1, bf16x8& pa2, bf16x8& pa3) {
#pragma unroll
    for (int r = 0; r < 16; ++r) p1[r] = __builtin_amdgcn_exp2f(p1[r]);
    float ps = 0;
#pragma unroll
    for (int r = 0; r < 16; ++r) ps += p0[r];
#pragma unroll
    for (int r = 0; r < 16; ++r) ps += p1[r];
    { auto rr = __builtin_amdgcn_permlane32_swap(__float_as_uint(ps), __float_as_uint(ps), false, false); ps = __uint_as_float(rr[0]) + __uint_as_float(rr[1]); }
    l_reg = l_reg * alpha + ps;
#define PK4(P, B_, OUT) do { unsigned a0 = cvtpk(P[B_+0], P[B_+1]), a1 = cvtpk(P[B_+2], P[B_+3]);                          \
        unsigned b0 = cvtpk(P[B_+4], P[B_+5]), b1 = cvtpk(P[B_+6], P[B_+7]);                                             \
        auto r0 = __builtin_amdgcn_permlane32_swap(a0, b0, false, false); auto r1 = __builtin_amdgcn_permlane32_swap(a1, b1, false, false); \
        u32x4 w = {r0[0], r1[0], r0[1], r1[1]}; OUT = *reinterpret_cast<bf16x8*>(&w); } while (0)
    PK4(p0, 0, pa0); PK4(p0, 8, pa1); PK4(p1, 0, pa2); PK4(p1, 8, pa3);
#undef PK4
}
template <int KB>
__device__ __forceinline__ void qkt(f32x16& p0, f32x16& p1, const char* K_lds, int r32, int hi, const bf16x8* qr) {
    p0 = f32x16{}; p1 = f32x16{};
#pragma unroll
    for (int d0 = 0; d0 < 4; ++d0) { const char* a = K_lds + KB * SHM_K + KSWZ64(r32, (d0 * 16 + hi * 8) * 2);
        bf16x8 b0 = *reinterpret_cast<const bf16x8*>(a);
        bf16x8 b1 = *reinterpret_cast<const bf16x8*>(a + 32 * 128);
        p0 = __builtin_amdgcn_mfma_f32_32x32x16_bf16(b0, qr[d0], p0, 0, 0, 0);
        p1 = __builtin_amdgcn_mfma_f32_32x32x16_bf16(b1, qr[d0], p1, 0, 0, 0); }
}
template <int VB>
__device__ __forceinline__ void pv_tile(f32x16* o, int vb0, bf16x8 pa0, bf16x8 pa1, bf16x8 pa2, bf16x8 pa3) {
#define TRRD(dst, off) asm volatile("ds_read_b64_tr_b16 %0, %1 offset:%2" : "=&v"(dst) : "v"(vb0), "i"(off) : "memory")
#define PV_D0(d0) do { s16x4 l0, l1, l2, l3, h0, h1, h2, h3; constexpr int b_ = VB * SHM_V + v_rd_off(d0, 0, 0); \
        TRRD(l0, b_); TRRD(h0, b_ + 2048); TRRD(l1, b_ + 4096); TRRD(h1, b_ + 6144); TRRD(l2, b_ + 8192); TRRD(h2, b_ + 10240); TRRD(l3, b_ + 12288); TRRD(h3, b_ + 14336); \
        asm volatile("s_waitcnt lgkmcnt(0)" ::: "memory"); SBAR();   \
        o[d0] = __builtin_amdgcn_mfma_f32_32x32x16_bf16(pa0, (bf16x8){l0[0], l0[1], l0[2], l0[3], h0[0], h0[1], h0[2], h0[3]}, o[d0], 0, 0, 0);   \
        o[d0] = __builtin_amdgcn_mfma_f32_32x32x16_bf16(pa1, (bf16x8){l1[0], l1[1], l1[2], l1[3], h1[0], h1[1], h1[2], h1[3]}, o[d0], 0, 0, 0);   \
        o[d0] = __builtin_amdgcn_mfma_f32_32x32x16_bf16(pa2, (bf16x8){l2[0], l2[1], l2[2], l2[3], h2[0], h2[1], h2[2], h2[3]}, o[d0], 0, 0, 0);   \
        o[d0] = __builtin_amdgcn_mfma_f32_32x32x16_bf16(pa3, (bf16x8){l3[0], l3[1], l3[2], l3[3], h3[0], h3[1], h3[2], h3[3]}, o[d0], 0, 0, 0); } while (0)
    PV_D0(0); PV_D0(1); PV_D0(2); PV_D0(3);
#undef PV_D0
#undef TRRD
}
struct BlockRef { const bf16_t* Q; const bf16_t* K; const bf16_t* V; int P0; int to_lds; float lam; };
struct Seam { bf16x8 qr[4]; bf16x8 st_v0, st_v1, st_k0; };
#define VMW() asm volatile("s_waitcnt vmcnt(0)" ::: "memory")
#define VMWN(n) asm volatile("s_waitcnt vmcnt(%0)" :: "i"(n) : "memory")
#define SLOAD_H(Kp, Vp, k0) do { S.st_v0 = load8((Vp) + (size_t)((k0) + sr) * PQ + sc); S.st_v1 = load8((Vp) + (size_t)((k0) + 32 + sr) * PQ + sc); \
                                 S.st_k0 = load8((Kp) + (size_t)((k0) + kr) * PQ + kc); } while (0)
#define SWRITE_HK(bf) do { *(bf16x8*)(K_lds + (bf) * SHM_K + kws) = S.st_k0; } while (0)
#define SWRITE_HV(bf) do { *(bf16x8*)(V_lds + (bf) * SHM_V + vst0) = S.st_v0; *(bf16x8*)(V_lds + (bf) * SHM_V + vst1) = S.st_v1; } while (0)
#define SWRITE_H(bf) do { SWRITE_HV(bf); SWRITE_HK(bf); } while (0)
__device__ __forceinline__ void prime(const BlockRef& cur, char* lds, Seam& S, int tid, int wid) {
    const int lane = tid & 63, r32 = lane & 31, hi = lane >> 5;
    const int sr = tid >> 4, sc = (tid & 15) * 8, kr = tid >> 3, kc = (tid & 7) * 8, kws = KSWZ64(kr, kc * 2); char* K_lds = lds + OFF_KL;
#pragma unroll
    for (int d0 = 0; d0 < 4; ++d0) S.qr[d0] = load8(cur.Q + (size_t)(wid * QBLK + r32) * PQ + d0 * 16 + hi * 8);
    SLOAD_H(cur.K, cur.V, 0); VMW(); SWRITE_HK(0);
    __syncthreads();
}
__device__ __forceinline__ void block(const BlockRef& cur, const BlockRef& nxt, char* lds, Seam& S, int tid, int wid) {
    asm volatile("" : "+v"(tid));
    const int lane = tid & 63, r32 = lane & 31, hi = lane >> 5;
    const int NT = (cur.P0 + QB - 1) / KVBLK + 1;
    const int qlo = cur.P0 + wid * QBLK, qm = qlo + r32 - 4 * hi;
    char* V_lds = lds + OFF_VL; char* K_lds = lds + OFF_KL;
    float* ws = (float*)(lds + OFF_WS) + wid * 64; float* li_l = ws, * al_l = ws + 32;
    float m_reg = -1e30f, l_reg = 0; f32x16 o[4] = {};
    const int sr = tid >> 4, sc = (tid & 15) * 8, vst0 = v_st(sr, sc), vst1 = v_st(32 + sr, sc), kr = tid >> 3, kc = (tid & 7) * 8, kws = KSWZ64(kr, kc * 2);
    const int vb0 = (int)(uintptr_t)V_lds + v_rd_base(lane);
    const bf16_t* Kh = cur.K; const bf16_t* Vh = cur.V;
#define RESC(a) do { if (__any((a) < 1.f)) { if (hi == 0) al_l[r32] = (a); asm volatile("s_waitcnt lgkmcnt(0)" ::: "memory");              \
                     _Pragma("unroll") for (int d_ = 0; d_ < 4; ++d_) _Pragma("unroll") for (int r = 0; r < 16; ++r) o[d_][r] *= al_l[crow(r, hi)]; } } while (0)
#define KBASE(t) ((t) * KVBLK)
#define MASKT(P0_, P1_, t) do { const int kb_ = KBASE(t); if (kb_ + KVBLK - 1 > qlo) mask_tile(P0_, P1_, qm - kb_); } while (0)
#define SEAM_K0() do { VMWN(4); SWRITE_HK(0); SBAR(); } while (0)
    f32x16 pA0, pA1, pB0, pB1; float mnA, mnB, alA, alB; bf16x8 pa0, pa1, pa2, pa3;
    SWRITE_HV(0); SBAR();
    if (NT > 1) SLOAD_H(Kh, Vh, KBASE(1));
    SBAR(); qkt<0>(pA0, pA1, K_lds, r32, hi, S.qr);
    MASKT(pA0, pA1, 0); partialSM(pA0, pA1, m_reg, mnA, alA);
    if (NT > 1) { VMW(); SWRITE_H(1); }
    __syncthreads();
#define HALF_STEP(PX0, PX1, mnX, alX, PY0, PY1, alY, t, KB, VB, SB) do {                                                      \
        SBAR(); qkt<KB>(PX0, PX1, K_lds, r32, hi, S.qr);                                                                      \
        finishSM(PY0, PY1, alY, l_reg, pa0, pa1, pa2, pa3); SBAR();                                                           \
        if ((t) + 1 < NT) { SLOAD_H(Kh, Vh, KBASE((t) + 1)); SBAR(); }                                                        \
        pv_tile<VB>(o, vb0, pa0, pa1, pa2, pa3); MASKT(PX0, PX1, (t)); partialSM(PX0, PX1, m_reg, mnX, alX);                 \
        __syncthreads();                                                                                                      \
        if ((t) + 1 < NT) { VMW(); SWRITE_H(SB); }                                                                            \
        RESC(alX); __syncthreads(); } while (0)
    for (int t = 1; t + 1 < NT; t += 2) {
        HALF_STEP(pB0, pB1, mnB, alB, pA0, pA1, alA, t, 1, 0, 0);
        HALF_STEP(pA0, pA1, mnA, alA, pB0, pB1, alB, t + 1, 0, 1, 1);
    }
    const bool even = wid >= 6;
    if (even) { SBAR(); qkt<1>(pB0, pB1, K_lds, r32, hi, S.qr); SBAR(); }
    SLOAD_H(nxt.K, nxt.V, 0); SBAR();
#pragma unroll
    for (int d0 = 0; d0 < 4; ++d0) S.qr[d0] = load8(nxt.Q + (size_t)(wid * QBLK + r32) * PQ + d0 * 16 + hi * 8);
    SBAR();
    finishSM(pA0, pA1, alA, l_reg, pa0, pa1, pa2, pa3); SBAR();
    pv_tile<0>(o, vb0, pa0, pa1, pa2, pa3);
    if (even) { MASKT(pB0, pB1, NT - 1); partialSM(pB0, pB1, m_reg, mnB, alB); __syncthreads(); RESC(alB);
        finishSM(pB0, pB1, alB, l_reg, pa0, pa1, pa2, pa3); SBAR(); pv_tile<1>(o, vb0, pa0, pa1, pa2, pa3); }
    else __syncthreads();
    SBAR(); SEAM_K0();
    if (hi == 0) li_l[r32] = l_reg; asm volatile("s_waitcnt lgkmcnt(0)" ::: "memory");
    float rli[16];
#pragma unroll
    for (int r = 0; r < 16; ++r) rli[r] = __builtin_amdgcn_rcpf(li_l[crow(r, hi)]);
    { char* Ol = lds + OFF_OL + wid * OL_WAVE;
      if (!cur.to_lds) {
#pragma unroll
          for (int d0 = 0; d0 < 4; ++d0)
#pragma unroll
              for (int hq = 0; hq < 2; ++hq) { u32x4 wv_;
#pragma unroll
                  for (int q = 0; q < 4; ++q) { const int r = hq * 8 + q * 2; wv_[q] = cvtpk(o[d0][r] * rli[r], o[d0][r + 1] * rli[r + 1]); }
                  *(u32x4*)(Ol + ((d0 * 2 + hq) * 64 + lane) * 16) = wv_; }
      } else {
          u32x4 o1w[8];
#pragma unroll
          for (int i = 0; i < 8; ++i) o1w[i] = *(const u32x4*)(Ol + (i * 64 + lane) * 16);
          asm volatile("s_waitcnt lgkmcnt(0)" ::: "memory");
#pragma unroll
          for (int r = 0; r < 16; ++r) { const int orow = crow(r, hi);
#pragma unroll
              for (int d0 = 0; d0 < 4; ++d0) { const unsigned w1 = o1w[d0 * 2 + (r >> 3)][(r & 7) >> 1]; const float o1v = (r & 1) ? bfhi(w1) : bflo(w1);
                  const float v = o1v - cur.lam * (o[d0][r] * rli[r]); const float vn = sx<1>(v);
                  if ((r32 & 1) == 0) *(unsigned*)(Ol + orow * OL_RS + (d0 * 32 + r32) * 2) = cvtpk(v, vn); } } } }
    asm volatile("s_waitcnt lgkmcnt(0)\n\ts_barrier" ::: "memory");
#undef RESC
#undef KBASE
#undef MASKT
#undef SEAM_K0
#undef HALF_STEP
}
#undef VMW
#undef VMWN
#undef SLOAD_H
#undef SWRITE_HK
#undef SWRITE_HV
#undef SWRITE_H
#undef SBAR
#undef KSWZ64
}

struct Params {
    const float* x; const float* c; const int* positions; const float* norm1; const float* norm2; const float* w_ada; const float* b_ada;
    const float* a_w_in; const float* a_b_if; const float* a_h_norm; const float* a_w_out;
    const float* b_w_in; const float* b_q_norm; const float* b_k_norm; const float* b_lam_q1; const float* b_lam_k1; const float* b_lam_q2; const float* b_lam_k2;
    const float* b_o_norm; const float* b_w_out; const float* w_router; const float* router_bias; const float* moe_w_gu; const float* moe_w_down;
    float* out; unsigned char* ws;
};
struct Frame { LAS unsigned char* lds; int tid, lane, wave, G, bid, vcu; };
__device__ __forceinline__ Frame make_frame(unsigned char* lds, int wv) {
    Frame F; F.lds = (LAS unsigned char*)lds; int t = wv * 64 + lane_id(); asm volatile("" : "+v"(t)); F.tid = t; F.lane = t & 63; F.wave = wv;
    F.G = gridDim.x; F.bid = blockIdx.x; F.vcu = (F.G % 8 == 0) ? (F.bid % 8) * (F.G / 8) + F.bid / 8 : F.bid; return F;
}

struct WItem { const float* W; unsigned char* WT; float* cs; int ldw, Kr, drow0, n0, mode; float s8; };
constexpr int NW_ITEMS = ((WQ_IN0 == 2) ? 48 : 0) + ((WQ_OUT0 == 2) ? 16 : 0) + ((WQ_OUT1 == 2) ? 16 : 0);
__device__ __forceinline__ WItem decode_witem(int it, const Params& p) {
    float* cw = (float*)(p.ws + SC_CW);
    if (WQ_IN0 == 2) { if (it < 48) { const int nb = it; return WItem{p.a_w_in, p.ws + WS_WAIN, cw + CW_AIN, 3080, 1024, 64 * nb, 64 * nb, 2, 0.f}; } it -= 48; }
    if (WQ_OUT0 == 2) { if (it < 16) { const int nb = it; return WItem{p.a_w_out, p.ws + WS_WAOUT, cw + CW_AOUT, 1024, 1024, 64 * nb, 64 * nb, 2, 0.f}; } it -= 16; }
    { const int nb = it; return WItem{p.b_w_out, p.ws + WS_WBOUT, cw + CW_BOUT, 1024, 1024, 64 * nb, 64 * nb, 2, 0.f}; }
}
__device__ __forceinline__ int witem_owner(int it, int G) { return (G == 256) ? 192 + (it & 63) : it % G; }
struct TItem { const float* W; bf16_t* WT; int ldw, K, drow0, k0, n0; float s8; };
__device__ __forceinline__ TItem decode_item(int it, const Params& p) {
    constexpr int I0 = (WQ_IN0 == 2) ? 0 : 16 * 48, I1 = (WQ_OUT0 == 2) ? 0 : 16 * 16, I2 = 16 * 48, I3 = (WQ_OUT1 == 2) ? 0 : 16 * 16, I4 = 32 * 256;
    TItem t; int r = it;
    if (r < I0) { const int kb = r / 48, nb = r % 48; t = (WQ_IN0 == 1) ? TItem{p.a_w_in, (bf16_t*)(p.ws + WS_WAIN), 3080, 1024, 64 * nb, 64 * kb, 64 * nb, S8_WIN} : TItem{p.a_w_in, (bf16_t*)(p.ws + WS_WAIN_BF), 3080, 1024, 64 * nb, 64 * kb, 64 * nb, 0.f}; return t; } r -= I0;
    if (r < I1) { const int kb = r / 16, nb = r % 16; t = (WQ_OUT0 == 1) ? TItem{p.a_w_out, (bf16_t*)(p.ws + WS_WAOUT), 1024, 1024, 64 * nb, 64 * kb, 64 * nb, S8_WOUT} : TItem{p.a_w_out, (bf16_t*)(p.ws + WS_WAOUT_BF), 1024, 1024, 64 * nb, 64 * kb, 64 * nb, 0.f}; return t; } r -= I1;
    if (r < I2) { const int kb = r / 48, nb = r % 48; t = TItem{p.b_w_in, (bf16_t*)(p.ws + WS_WBIN), 3072, 1024, 64 * nb, 64 * kb, 64 * nb, S8_WIN}; return t; } r -= I2;
    if (r < I3) { const int kb = r / 16, nb = r % 16; t = OUTPROJ_FP8 ? TItem{p.b_w_out, (bf16_t*)(p.ws + WS_WBOUT), 1024, 1024, 64 * nb, 64 * kb, 64 * nb, S8_WOUT} : TItem{p.b_w_out, (bf16_t*)(p.ws + WS_WBOUT_BF), 1024, 1024, 64 * nb, 64 * kb, 64 * nb, 0.f}; return t; } r -= I3;
    if (r < I4) { const int mi = r / 256, q = r % 256, kb = q / 16, nb = q % 16; const int n0 = 64 * nb;
        const int drow = ((n0 & 511) >> 7) * 256 + (n0 >> 9) * 128 + (n0 & 127);
        t = TItem{p.moe_w_gu + (size_t)mi * 1024 * 1024, (bf16_t*)(p.ws + WS_WGU + (size_t)mi * 1024 * 1024), 1024, 1024, drow, 64 * kb, n0, S8_WGU}; return t; } r -= I4;
    { const int mi = r / 128, q = r % 128, kb = q / 16, nb = q % 16;
      t = TItem{p.moe_w_down + (size_t)mi * 512 * 1024, (bf16_t*)(p.ws + WS_WDN + (size_t)mi * 1024 * 512), 1024, 512, 64 * nb, 64 * kb, 64 * nb, S8_WDN}; return t; }
}
__device__ __forceinline__ void phase_mod(unsigned char* lds_, int wv, const Params& p) {
    const Frame F = make_frame(lds_, wv);
    LAS float* cact = (LAS float*)F.lds;
    LAS float* red = (LAS float*)(F.lds + 65536);
    float* mod = (float*)(p.ws + WS_MOD);
    for (int i = F.tid; i < NB * DM; i += NTHREADS) { const int b = i >> 10, k = i & 1023; const float v = p.c[i]; cact[k * 16 + b] = v / (1.0f + expf(-v)); }
    __syncthreads();
    for (int task = F.bid; task < 192; task += F.G) {
        const int l = task / 96, cb = task % 96;
        const float* W = p.w_ada + (size_t)l * DM * 6144 + cb * 64 + F.lane;
        float acc[16];
#pragma unroll
        for (int b = 0; b < 16; ++b) acc[b] = 0.f;
        const int kbeg = F.wave * 128;
        for (int kb = kbeg; kb < kbeg + 128; kb += 16) {
            float wv[16];
#pragma unroll
            for (int u = 0; u < 16; ++u) wv[u] = __builtin_nontemporal_load(W + (size_t)(kb + u) * 6144);
#pragma unroll
            for (int u = 0; u < 16; ++u) {
                const LAS f32x4* cc = (const LAS f32x4*)(cact + (kb + u) * 16);
                const f32x4 c0 = cc[0], c1 = cc[1], c2 = cc[2], c3 = cc[3]; const float w = wv[u];
                acc[0] += c0[0] * w; acc[1] += c0[1] * w; acc[2] += c0[2] * w; acc[3] += c0[3] * w;
                acc[4] += c1[0] * w; acc[5] += c1[1] * w; acc[6] += c1[2] * w; acc[7] += c1[3] * w;
                acc[8] += c2[0] * w; acc[9] += c2[1] * w; acc[10] += c2[2] * w; acc[11] += c2[3] * w;
                acc[12] += c3[0] * w; acc[13] += c3[1] * w; acc[14] += c3[2] * w; acc[15] += c3[3] * w;
            }
        }
#pragma unroll
        for (int b = 0; b < 16; ++b) red[(F.wave * 16 + b) * 64 + F.lane] = acc[b];
        __syncthreads();
        for (int o = F.tid; o < 1024; o += NTHREADS) { const int b = o >> 6, cl = o & 63; float s = 0.f;
#pragma unroll
            for (int w = 0; w < 8; ++w) s += red[(w * 16 + b) * 64 + cl];
            mod[((size_t)l * 16 + b) * 6144 + cb * 64 + cl] = s + p.b_ada[(size_t)l * 6144 + cb * 64 + cl]; }
        asm volatile("s_waitcnt vmcnt(0)" ::: "memory");
        __syncthreads();
        if (F.tid == 0) { __builtin_amdgcn_fence(__ATOMIC_RELEASE, "agent"); asm volatile("s_waitcnt vmcnt(0)" ::: "memory"); (void)xb_add((unsigned*)p.ws + CW_MODCNT, 1u); }
    }
}
__device__ __forceinline__ void phase_wconv(unsigned char* lds_, int wv, const Params& p) {
    const Frame F = make_frame(lds_, wv);
    LAS float* scr = (LAS float*)(F.lds + F.wave * 17408);
    LAS float* cmaxw = (LAS float*)(F.lds + 8 * 17408);
    const int lane = F.lane, lr = lane >> 4, c4 = (lane & 15) * 4, w = F.wave;
    for (int it = 0; it < NW_ITEMS; ++it) {
        if (witem_owner(it, F.G) != F.bid) continue;
        const WItem t = decode_witem(it, p);
        const int RW = t.Kr >> 3, NH = RW >> 6;
        f32x4 v[2][16];
#pragma unroll
        for (int hf = 0; hf < 2; ++hf) if (hf < NH) {
#pragma unroll
            for (int i = 0; i < 16; ++i) v[hf][i] = __builtin_nontemporal_load((const f32x4*)(t.W + (size_t)(w * RW + hf * 64 + 4 * i + lr) * t.ldw + t.n0 + c4)); }
        __syncthreads();
        float qs = t.s8;
        if (t.mode == 2) {
            float mx[4] = {0.f, 0.f, 0.f, 0.f};
#pragma unroll
            for (int hf = 0; hf < 2; ++hf) if (hf < NH) {
#pragma unroll
                for (int i = 0; i < 16; ++i)
#pragma unroll
                    for (int q = 0; q < 4; ++q) mx[q] = fmaxf(mx[q], fabsf(v[hf][i][q])); }
#pragma unroll
            for (int q = 0; q < 4; ++q) { mx[q] = fmaxf(mx[q], sx<16>(mx[q])); auto rr = __builtin_amdgcn_permlane32_swap(__float_as_uint(mx[q]), __float_as_uint(mx[q]), false, false); mx[q] = fmaxf(__uint_as_float(rr[0]), __uint_as_float(rr[1])); }
            if (lr == 0) *(LAS f32x4*)(cmaxw + w * 64 + c4) = (f32x4){mx[0], mx[1], mx[2], mx[3]};
            __syncthreads();
            float cm = 0.f;
#pragma unroll
            for (int ww = 0; ww < 8; ++ww) cm = fmaxf(cm, cmaxw[ww * 64 + lane]);
            qs = cm > 0.f ? 127.0f / cm : 0.f;
            if (w == 0) t.cs[t.drow0 + lane] = cm * (1.0f / 127.0f);
        }
#pragma unroll
        for (int hf = 0; hf < 2; ++hf) if (hf < NH) {
#pragma unroll
            for (int i = 0; i < 16; ++i) *(LAS f32x4*)(scr + (4 * i + lr) * 68 + c4) = v[hf][i];
            const int k0 = w * RW + hf * 64;
            if (t.mode == 0) { bf16_t* orow = (bf16_t*)t.WT + (size_t)(t.drow0 + lane) * t.Kr + k0;
#pragma unroll
                for (int c = 0; c < 8; ++c) { float f[8];
#pragma unroll
                    for (int q = 0; q < 8; ++q) f[q] = scr[(8 * c + q) * 68 + lane];
                    u32x4 o; o.x = cvtpk(f[0], f[1]); o.y = cvtpk(f[2], f[3]); o.z = cvtpk(f[4], f[5]); o.w = cvtpk(f[6], f[7]);
                    *(u32x4*)(orow + 8 * c) = o; } }
            else { unsigned char* orow8 = t.WT + (size_t)(t.drow0 + lane) * t.Kr + k0;
#pragma unroll
                for (int c = 0; c < 4; ++c) { float f[16];
#pragma unroll
                    for (int q = 0; q < 16; ++q) f[q] = scr[(16 * c + q) * 68 + lane] * qs;
                    u32x4 o;
                    if (t.mode == 1) { o.x = cvt4_fp8(f[0], f[1], f[2], f[3]); o.y = cvt4_fp8(f[4], f[5], f[6], f[7]); o.z = cvt4_fp8(f[8], f[9], f[10], f[11]); o.w = cvt4_fp8(f[12], f[13], f[14], f[15]); }
                    else { o.x = pack4_i8(f[0], f[1], f[2], f[3]); o.y = pack4_i8(f[4], f[5], f[6], f[7]); o.z = pack4_i8(f[8], f[9], f[10], f[11]); o.w = pack4_i8(f[12], f[13], f[14], f[15]); }
                    *(u32x4*)(orow8 + 16 * c) = o; } }
            asm volatile("s_waitcnt lgkmcnt(0)" ::: "memory");
        }
    }
}

__device__ __forceinline__ void phase_wconv_pw(unsigned char* lds_, int wv, const Params& p) {
    const Frame F = make_frame(lds_, wv);
    LAS float* scr = (LAS float*)(F.lds + F.wave * 17408);
    const int gw = F.vcu * NWAVES + F.wave, NGW = F.G * NWAVES;
    constexpr int NITEMS = ((WQ_IN0 == 2) ? 0 : 16 * 48) + ((WQ_OUT0 == 2) ? 0 : 16 * 16) + 16 * 48 + ((WQ_OUT1 == 2) ? 0 : 16 * 16) + 32 * 256 + 32 * 128;
    const int lane = F.lane, lr = lane >> 4, c4 = (lane & 15) * 4;
    f32x4 v[16];
    int it = gw;
    if (it < NITEMS) { const TItem t = decode_item(it, p);
#pragma unroll
        for (int i = 0; i < 16; ++i) v[i] = __builtin_nontemporal_load((const f32x4*)(t.W + (size_t)(t.k0 + 4 * i + lr) * t.ldw + t.n0 + c4)); }
    for (; it < NITEMS; it += NGW) {
        const TItem t = decode_item(it, p);
#pragma unroll
        for (int i = 0; i < 16; ++i) *(LAS f32x4*)(scr + (4 * i + lr) * 68 + c4) = v[i];
        const int itn = it + NGW;
        if (itn < NITEMS) { const TItem tn = decode_item(itn, p);
#pragma unroll
            for (int i = 0; i < 16; ++i) v[i] = __builtin_nontemporal_load((const f32x4*)(tn.W + (size_t)(tn.k0 + 4 * i + lr) * tn.ldw + tn.n0 + c4)); }
        if (t.s8 > 0.f) {
            unsigned char* orow8 = (unsigned char*)t.WT + (size_t)(t.drow0 + lane) * t.K + t.k0;
#pragma unroll
            for (int c = 0; c < 4; ++c) { float f[16];
#pragma unroll
                for (int q = 0; q < 16; ++q) f[q] = scr[(16 * c + q) * 68 + lane] * t.s8;
                u32x4 o; o.x = cvt4_fp8(f[0], f[1], f[2], f[3]); o.y = cvt4_fp8(f[4], f[5], f[6], f[7]); o.z = cvt4_fp8(f[8], f[9], f[10], f[11]); o.w = cvt4_fp8(f[12], f[13], f[14], f[15]);
                *(u32x4*)(orow8 + 16 * c) = o; }
        } else {
            bf16_t* orow = t.WT + (size_t)(t.drow0 + lane) * t.K + t.k0;
#pragma unroll
            for (int c = 0; c < 8; ++c) { float f[8];
#pragma unroll
                for (int q = 0; q < 8; ++q) f[q] = scr[(8 * c + q) * 68 + lane];
                u32x4 o; o.x = cvtpk(f[0], f[1]); o.y = cvtpk(f[2], f[3]); o.z = cvtpk(f[4], f[5]); o.w = cvtpk(f[6], f[7]);
                *(u32x4*)(orow + 8 * c) = o; }
        }
    }
}

struct RowConst { f32x4 a[4], b[4]; };
__device__ __forceinline__ RowConst load_rowconst(const float* norm, const float* modb, int sh_off, int sc_off, int lane) {
    RowConst rc;
#pragma unroll
    for (int j = 0; j < 4; ++j) { const int c = 256 * j + 4 * lane;
        const f32x4 nv = *(const f32x4*)(norm + c), sc = *(const f32x4*)(modb + sc_off + c); rc.b[j] = *(const f32x4*)(modb + sh_off + c);
        rc.a[j] = nv * (sc + 1.0f); }
    return rc;
}
__device__ __forceinline__ void row_norm_store(const f32x4 (&v)[4], const RowConst& rc, f32x4 (&h)[4], bf16_t* hrow, int lane) {
    float ss = 0.f;
#pragma unroll
    for (int j = 0; j < 4; ++j) ss += (v[j][0] * v[j][0] + v[j][1] * v[j][1]) + (v[j][2] * v[j][2] + v[j][3] * v[j][3]);
    const float r = 1.0f / sqrtf(wave_sum(ss) * (1.0f / DM) + EPS);
#pragma unroll
    for (int j = 0; j < 4; ++j) { h[j] = v[j] * r * rc.a[j] + rc.b[j];
        u32x2 w; w.x = cvtpk(h[j][0], h[j][1]); w.y = cvtpk(h[j][2], h[j][3]); *(u32x2*)(hrow + 256 * j + 4 * lane) = w; }
}


__device__ __forceinline__ float reduce16(const float (&v)[16], int lane) {
    float a[8], b[4], c[2];
    const bool b5 = (lane & 32) != 0, b4 = (lane & 16) != 0, b3 = (lane & 8) != 0, b2 = (lane & 4) != 0;
#pragma unroll
    for (int i = 0; i < 8; ++i) { const float send = b5 ? v[i] : v[8 + i], keep = b5 ? v[8 + i] : v[i]; a[i] = keep + sx32(send, b5); }
#pragma unroll
    for (int i = 0; i < 4; ++i) { const float send = b4 ? a[i] : a[4 + i], keep = b4 ? a[4 + i] : a[i]; b[i] = keep + sx<16>(send); }
#pragma unroll
    for (int i = 0; i < 2; ++i) { const float send = b3 ? b[i] : b[2 + i], keep = b3 ? b[2 + i] : b[i]; c[i] = keep + sx<8>(send); }
    const float send = b2 ? c[0] : c[1], keep = b2 ? c[1] : c[0];
    float d = keep + sx<4>(send);
    d += sx<1>(d); d += sx<2>(d);
    return d;
}
__device__ __forceinline__ float reduce8(const float (&v)[8], int lane) {
    float b[4], c[2];
    const bool b5 = (lane & 32) != 0, b4 = (lane & 16) != 0, b3 = (lane & 8) != 0;
#pragma unroll
    for (int i = 0; i < 4; ++i) { const float send = b5 ? v[i] : v[4 + i], keep = b5 ? v[4 + i] : v[i]; b[i] = keep + sx32(send, b5); }
#pragma unroll
    for (int i = 0; i < 2; ++i) { const float send = b4 ? b[i] : b[2 + i], keep = b4 ? b[2 + i] : b[i]; c[i] = keep + sx<16>(send); }
    const float send = b3 ? c[0] : c[1], keep = b3 ? c[1] : c[0];
    float d = keep + sx<8>(send);
    d += sx<1>(d); d += sx<2>(d); d += sx<4>(d);
    return d;
}

__device__ __forceinline__ void row_norm_store8(const f32x4 (&v)[4], const RowConst& rc, f32x4 (&h)[4], unsigned char* hrow, int lane) {
    float ss = 0.f;
#pragma unroll
    for (int j = 0; j < 4; ++j) ss += (v[j][0] * v[j][0] + v[j][1] * v[j][1]) + (v[j][2] * v[j][2] + v[j][3] * v[j][3]);
    const float r = 1.0f / sqrtf(wave_sum(ss) * (1.0f / DM) + EPS);
#pragma unroll
    for (int j = 0; j < 4; ++j) { h[j] = v[j] * r * rc.a[j] + rc.b[j];
        *(unsigned*)(hrow + 256 * j + 4 * lane) = cvt4_fp8(h[j][0] * S8_H, h[j][1] * S8_H, h[j][2] * S8_H, h[j][3] * S8_H); }
}
__device__ __forceinline__ void row_norm_store_i8(const f32x4 (&v)[4], const RowConst& rc, f32x4 (&h)[4], unsigned char* hrow, float* rs_out, int lane) {
    float ss = 0.f;
#pragma unroll
    for (int j = 0; j < 4; ++j) ss += (v[j][0] * v[j][0] + v[j][1] * v[j][1]) + (v[j][2] * v[j][2] + v[j][3] * v[j][3]);
    const float r = 1.0f / sqrtf(wave_sum(ss) * (1.0f / DM) + EPS);
    float mx = 0.f;
#pragma unroll
    for (int j = 0; j < 4; ++j) { h[j] = v[j] * r * rc.a[j] + rc.b[j]; mx = fmaxf(fmaxf(mx, fmaxf(fabsf(h[j][0]), fabsf(h[j][1]))), fmaxf(fabsf(h[j][2]), fabsf(h[j][3]))); }
    mx = fmaxf(wave_max(mx), 1e-20f);
    const float qs = 127.0f / mx;
#pragma unroll
    for (int j = 0; j < 4; ++j) *(unsigned*)(hrow + 256 * j + 4 * lane) = pack4_i8(h[j][0] * qs, h[j][1] * qs, h[j][2] * qs, h[j][3] * qs);
    if (lane == 0) *rs_out = mx * (1.0f / 127.0f);
}
__device__ __forceinline__ void phase_hprep0(unsigned char* lds_, int wv, const Params& p) {
    const Frame F = make_frame(lds_, wv);
    LAS f32x4* Wg = (LAS f32x4*)F.lds;
    for (int idx = F.tid; idx < 2048; idx += NTHREADS) { const int ln = idx & 63, half = (idx >> 6) & 1, i = (idx >> 7) & 3, j = idx >> 9; const int c = 256 * j + 4 * ln + i;
        Wg[idx] = *(const f32x4*)(p.a_w_in + (size_t)c * 3080 + 3072 + half * 4); }
    __syncthreads();
    const float* mod = (const float*)(p.ws + WS_MOD);
    unsigned char* H = p.ws + WS_H; float* gates = (float*)(p.ws + WS_GATES);
    const float bif = p.a_b_if[F.lane & 7];
    float* cst = (float*)(p.ws + WS_CS);
    const float invf_tab[8] = {1.0f, 0.19391788f, 0.037604144f, 0.0072920943f, 0.0014140673f, 0.00027421273f, 5.3174683e-05f, 1.0311522e-05f};
    float invf = 0.f;
#pragma unroll
    for (int i = 0; i < 8; ++i) if ((F.lane & 7) == i) invf = invf_tab[i];
    for (int chunk = F.bid; chunk < 256; chunk += F.G) {
        const int row0 = chunk * 128 + F.wave * 16; const int b = row0 / SEQ;
        const RowConst rc = load_rowconst(p.norm1, mod + (size_t)b * 6144, 0, 1024, F.lane);
        for (int rb = 0; rb < 16; rb += 4) {
            f32x4 v[4][4];
#pragma unroll
            for (int rr = 0; rr < 4; ++rr)
#pragma unroll
                for (int j = 0; j < 4; ++j) v[rr][j] = __builtin_nontemporal_load((const f32x4*)(p.x + (size_t)(row0 + rb + rr) * DM + 256 * j + 4 * F.lane));
            f32x4 h[4][4];
#pragma unroll
            for (int rr = 0; rr < 4; ++rr) { const size_t row_ = (size_t)(row0 + rb + rr);
                if (WQ_IN0 == 2) row_norm_store_i8(v[rr], rc, h[rr], H + row_ * DM, (float*)(p.ws + SC_RS_H) + row_, F.lane);
                else if (WQ_IN0 == 1) row_norm_store8(v[rr], rc, h[rr], H + row_ * DM, F.lane);
                else row_norm_store(v[rr], rc, h[rr], (bf16_t*)H + row_ * DM, F.lane); }
            float g[4][8];
#pragma unroll
            for (int rr = 0; rr < 4; ++rr)
#pragma unroll
                for (int q = 0; q < 8; ++q) g[rr][q] = 0.f;
#pragma unroll
            for (int j = 0; j < 4; ++j)
#pragma unroll
                for (int i = 0; i < 4; ++i) { if (i == 0 || i == 2) asm volatile("" ::: "memory");
                    const f32x4 w0 = Wg[((j * 4 + i) * 2 + 0) * 64 + F.lane], w1 = Wg[((j * 4 + i) * 2 + 1) * 64 + F.lane];
#pragma unroll
                    for (int rr = 0; rr < 4; ++rr) { const float hv = h[rr][j][i];
                        g[rr][0] += hv * w0[0]; g[rr][1] += hv * w0[1]; g[rr][2] += hv * w0[2]; g[rr][3] += hv * w0[3]; g[rr][4] += hv * w1[0]; g[rr][5] += hv * w1[1]; g[rr][6] += hv * w1[2]; g[rr][7] += hv * w1[3]; } }
#pragma unroll
            for (int rr = 0; rr < 4; ++rr) { const int row = row0 + rb + rr;
                const float d = reduce8(g[rr], F.lane);
                const float mine = bperm(d, 8 * (F.lane & 7));
                if (F.lane < 16) { const float ang = (float)p.positions[row] * invf; const double rev = (double)ang * 0.15915494309189535; const float frc = (float)(rev - rint(rev));
                    cst[(size_t)row * 16 + F.lane] = (F.lane < 8) ? __builtin_amdgcn_cosf(frc) : __builtin_amdgcn_sinf(frc); }
                if (F.lane < 8) { float val = mine + bif;
                    if (F.lane >= 4) val = fminf(val, 0.f) - log1pf(expf(-fabsf(val)));
                    gates[(size_t)row * 8 + F.lane] = val; }
            }
        }
    }
}

namespace mls {
constexpr int RSK = 272, RSV = 176, RSP = 272, RSC = 272;
constexpr int OFF_K = 0, OFF_V = 34816, OFF_P = OFF_V + 22528, OFF_C = OFF_P + 34816, OFF_G = OFF_C + 21760;
typedef short v4i16_t __attribute__((ext_vector_type(4)));
__device__ __forceinline__ bf16x8 tr2(const LAS unsigned char* base, int row, int col, int rs, int lane) {
    const int i = lane & 15, g = lane >> 4;
    const LAS unsigned char* p0 = base + (row + 8 * g + (i >> 2)) * rs + (col + 4 * (i & 3)) * 2;
    const s16x4 lo = __builtin_bit_cast(s16x4, __builtin_amdgcn_ds_read_tr16_b64_v4i16((LAS v4i16_t*)p0));
    const s16x4 hi = __builtin_bit_cast(s16x4, __builtin_amdgcn_ds_read_tr16_b64_v4i16((LAS v4i16_t*)(p0 + 4 * rs)));
    return (bf16x8){lo[0], lo[1], lo[2], lo[3], hi[0], hi[1], hi[2], hi[3]};
}
}
__device__ __forceinline__ void phase_mlstm(unsigned char* lds_, int wv, const Params& p) {
    const Frame F = make_frame(lds_, wv);
    using namespace mls;
    const bf16_t* PR = (const bf16_t*)(p.ws + WS_PROJ); const float* gates = (const float*)(p.ws + WS_GATES); bf16_t* HO = (bf16_t*)(p.ws + WS_HOUT);
    LAS unsigned char* Ks = F.lds + OFF_K; LAS unsigned char* Vs = F.lds + OFF_V; LAS unsigned char* Ps = F.lds + OFF_P; LAS unsigned char* Cs = F.lds + OFF_C;
    LAS float* gbase = (LAS float*)(F.lds + OFF_G);
    const int w = F.wave, lane = F.lane, c = lane & 15, g = lane >> 4, tid = F.tid;
    for (int item = F.vcu; item < 256; item += F.G) {
        const int bh = item >> 2, sl = item & 3, b = bh >> 2, h = bh & 3;
        const size_t tok0 = (size_t)b * SEQ;
        const bf16_t* Qg = PR + h * 128; const bf16_t* Kg = PR + 512 + h * 128; const bf16_t* Vg = PR + 1024 + h * 256 + sl * 64;
        __syncthreads();
        if (tid < 256) { const int row = tid >> 1, part = tid & 1; u32x4 z = {0u, 0u, 0u, 0u}; if (part == 0) z.x = 0x3F80u; *(LAS u32x4*)(Vs + row * RSV + 128 + part * 16) = z; }
        f32x4 cacc[5];
#pragma unroll
        for (int vt = 0; vt < 5; ++vt) cacc[vt] = (f32x4){0.f, 0.f, 0.f, 0.f};
        for (int i = tid; i < 80 * RSC / 16; i += NTHREADS) *(LAS u32x4*)(Cs + i * 16) = (u32x4){0u, 0u, 0u, 0u};
        float m_prev = 0.f;
        u32x4 kst[4], vst[2]; bf16x8 qf[4], qn[4]; float glf0 = 0.f, glf1 = 0.f, gi0 = 0.f, gi1 = 0.f;
        auto load_chunk = [&](int ch) {
            const size_t t0 = tok0 + (size_t)ch * 128;
#pragma unroll
            for (int k = 0; k < 4; ++k) { const int pc = tid + 512 * k, row = pc >> 4, c16 = pc & 15; kst[k] = *(const u32x4*)(Kg + (t0 + row) * 3072 + c16 * 8); }
#pragma unroll
            for (int k = 0; k < 2; ++k) { const int pc = tid + 512 * k, row = pc >> 3, c16 = pc & 7; vst[k] = *(const u32x4*)(Vg + (t0 + row) * 3072 + c16 * 8); }
#pragma unroll
            for (int ks = 0; ks < 4; ++ks) qn[ks] = *(const bf16x8*)(Qg + (t0 + 16 * w + c) * 3072 + 32 * ks + 8 * g);
            if (w == 0) { const float* gp = gates + (t0 + 2 * lane) * 8; gi0 = gp[h]; glf0 = gp[4 + h]; gi1 = gp[8 + h]; glf1 = gp[12 + h]; }
        };
        auto gate_scan = [&](LAS float* gs) {
            LAS float* gu = gs; LAS float* gwv = gs + 128; LAS float* gin = gs + 256; LAS float* gfl = gs + 384; LAS float* gwg = gs + 512;
            float s = glf0 + glf1;
#pragma unroll
            for (int d = 1; d < 64; d <<= 1) { const float t = bperm(s, (lane - d) & 63); if (lane >= d) s += t; }
            const float b1 = s, b0 = s - glf1;
            const float u0 = gi0 - b0, u1 = gi1 - b1;
            float m = fmaxf(u0, u1);
#pragma unroll
            for (int d = 1; d < 64; d <<= 1) { const float t = bperm(m, (lane - d) & 63); if (lane >= d) m = fmaxf(m, t); }
            float ex = bperm(m, (lane - 1) & 63); if (lane == 0) ex = -INFINITY;
            const float wv0 = fmaxf(fmaxf(ex, u0), m_prev), wv1 = fmaxf(m, m_prev);
            const float wlast = rdlane(wv1, 63), blast = rdlane(b1, 63);
            gu[2 * lane] = u0; gu[2 * lane + 1] = u1; gwv[2 * lane] = wv0; gwv[2 * lane + 1] = wv1;
            gin[2 * lane] = __expf(m_prev - wv0); gin[2 * lane + 1] = __expf(m_prev - wv1);
            gfl[2 * lane] = __expf(-(b0 + wv0)); gfl[2 * lane + 1] = __expf(-(b1 + wv1));
            gwg[2 * lane] = __expf(u0 - wlast); gwg[2 * lane + 1] = __expf(u1 - wlast);
            m_prev = blast + wlast;
        };
        auto store_chunk = [&]() {
#pragma unroll
            for (int k = 0; k < 4; ++k) { const int pc = tid + 512 * k, row = pc >> 4, c16 = pc & 15; *(LAS u32x4*)(Ks + row * RSK + c16 * 16) = kst[k]; }
#pragma unroll
            for (int k = 0; k < 2; ++k) { const int pc = tid + 512 * k, row = pc >> 3, c16 = pc & 7; *(LAS u32x4*)(Vs + row * RSV + c16 * 16) = vst[k]; }
#pragma unroll
            for (int ks = 0; ks < 4; ++ks) qf[ks] = qn[ks];
        };
        load_chunk(0);
        store_chunk();
        if (w == 0) gate_scan(gbase);
        __syncthreads();
        for (int ch = 0; ch < 16; ++ch) {
            LAS float* gs = gbase + (ch & 1) * 640;
            LAS float* gu = gs; LAS float* gwv = gs + 128; LAS float* gin = gs + 256; LAS float* gfl = gs + 384; LAS float* gwg = gs + 512;
            if (ch < 15) load_chunk(ch + 1);
            {
                const int t = 16 * w + c; const float wt = gwv[t];
#pragma unroll
                for (int jp = 0; jp < 4; ++jp) {
                    if (2 * jp <= w) {
                        f32x4 sa0 = (f32x4){0.f, 0.f, 0.f, 0.f}, sa1 = sa0;
#pragma unroll
                        for (int ks = 0; ks < 4; ++ks) { const bf16x8 kf0 = *(const LAS bf16x8*)(Ks + (32 * jp + c) * RSK + (32 * ks + 8 * g) * 2), kf1 = *(const LAS bf16x8*)(Ks + (32 * jp + 16 + c) * RSK + (32 * ks + 8 * g) * 2);
                            sa0 = __builtin_amdgcn_mfma_f32_16x16x32_bf16(kf0, qf[ks], sa0, 0, 0, 0); sa1 = __builtin_amdgcn_mfma_f32_16x16x32_bf16(kf1, qf[ks], sa1, 0, 0, 0); }
                        const f32x4 uv0 = *(const LAS f32x4*)(gu + 32 * jp + 4 * g), uv1 = *(const LAS f32x4*)(gu + 32 * jp + 16 + 4 * g);
                        float p0_[4], p1_[4];
#pragma unroll
                        for (int r = 0; r < 4; ++r) { const int s0 = 32 * jp + 4 * g + r, s1 = s0 + 16;
                            const float e0 = __expf(uv0[r] - wt), e1 = __expf(uv1[r] - wt); p0_[r] = (s0 <= t) ? sa0[r] * e0 : 0.f; p1_[r] = (s1 <= t) ? sa1[r] * e1 : 0.f; }
                        u32x2 pk0, pk1; pk0.x = cvtpk(p0_[0], p0_[1]); pk0.y = cvtpk(p0_[2], p0_[3]); pk1.x = cvtpk(p1_[0], p1_[1]); pk1.y = cvtpk(p1_[2], p1_[3]);
                        *(LAS u32x2*)(Ps + t * RSP + (32 * jp + 4 * g) * 2) = pk0; *(LAS u32x2*)(Ps + t * RSP + (32 * jp + 16 + 4 * g) * 2) = pk1;
                    }
                }
            }
            f32x4 nacc[5];
#pragma unroll
            for (int vt = 0; vt < 5; ++vt) { nacc[vt] = (f32x4){0.f, 0.f, 0.f, 0.f};
#pragma unroll
                for (int ks = 0; ks < 4; ++ks) { const bf16x8 cf = *(const LAS bf16x8*)(Cs + (16 * vt + c) * RSC + (32 * ks + 8 * g) * 2); nacc[vt] = __builtin_amdgcn_mfma_f32_16x16x32_bf16(cf, qf[ks], nacc[vt], 0, 0, 0); } }
            { const float iv = gin[16 * w + c];
#pragma unroll
              for (int vt = 0; vt < 5; ++vt) nacc[vt] = nacc[vt] * iv; }
            if (w == 0 && ch < 15) gate_scan(gbase + ((ch + 1) & 1) * 640);
            for (int ks = 0; ks <= (w >> 1); ++ks) {
                const bf16x8 pf = *(const LAS bf16x8*)(Ps + (16 * w + c) * RSP + (32 * ks + 8 * g) * 2);
#pragma unroll
                for (int vt = 0; vt < 5; ++vt) { const bf16x8 vf = tr2(Vs, 32 * ks, 16 * vt, RSV, lane); nacc[vt] = __builtin_amdgcn_mfma_f32_16x16x32_bf16(vf, pf, nacc[vt], 0, 0, 0); }
            }
            { const float den = bperm(nacc[4][0], lane & 15); const float inv = 1.0f / fmaxf(fabsf(den), gfl[16 * w + c]);
              bf16_t* orow = HO + (tok0 + (size_t)ch * 128 + 16 * w + c) * DM + h * 256 + sl * 64 + 4 * g;
#pragma unroll
              for (int vt = 0; vt < 4; ++vt) { u32x2 pk; pk.x = cvtpk(nacc[vt][0] * inv, nacc[vt][1] * inv); pk.y = cvtpk(nacc[vt][2] * inv, nacc[vt][3] * inv); *(u32x2*)(orow + 16 * vt) = pk; } }
            { const float decay = gin[127];
#pragma unroll
              for (int vt = 0; vt < 5; ++vt) cacc[vt] = cacc[vt] * decay;
#pragma unroll
              for (int ks = 0; ks < 4; ++ks) {
                  bf16x8 kf = tr2(Ks, 32 * ks, 16 * w, RSK, lane);
                  const f32x4 w0 = *(const LAS f32x4*)(gwg + 32 * ks + 8 * g), w1 = *(const LAS f32x4*)(gwg + 32 * ks + 8 * g + 4);
                  u32x4 kw = __builtin_bit_cast(u32x4, kf);
                  kw.x = cvtpk(bflo(kw.x) * w0[0], bfhi(kw.x) * w0[1]); kw.y = cvtpk(bflo(kw.y) * w0[2], bfhi(kw.y) * w0[3]);
                  kw.z = cvtpk(bflo(kw.z) * w1[0], bfhi(kw.z) * w1[1]); kw.w = cvtpk(bflo(kw.w) * w1[2], bfhi(kw.w) * w1[3]);
                  kf = __builtin_bit_cast(bf16x8, kw);
#pragma unroll
                  for (int vt = 0; vt < 5; ++vt) { const bf16x8 vf = tr2(Vs, 32 * ks, 16 * vt, RSV, lane); cacc[vt] = __builtin_amdgcn_mfma_f32_16x16x32_bf16(kf, vf, cacc[vt], 0, 0, 0); }
              } }
            asm volatile("s_waitcnt lgkmcnt(0)\n\ts_barrier" ::: "memory");
#pragma unroll
            for (int vt = 0; vt < 5; ++vt) { u32x2 pk; pk.x = cvtpk(cacc[vt][0], cacc[vt][1]); pk.y = cvtpk(cacc[vt][2], cacc[vt][3]); *(LAS u32x2*)(Cs + (16 * vt + c) * RSC + (16 * w + 4 * g) * 2) = pk; }
            if (ch < 15) store_chunk();
            __syncthreads();
        }
    }
}

__device__ __forceinline__ void phase_aprep(unsigned char* lds_, int wv, const Params& p) {
    const Frame F = make_frame(lds_, wv);
    const bf16_t* HO = (const bf16_t*)(p.ws + WS_HOUT); const bf16_t* PR = (const bf16_t*)(p.ws + WS_PROJ); unsigned char* A2 = p.ws + WS_H;
    float hn[16];
#pragma unroll
    for (int i = 0; i < 16; ++i) hn[i] = p.a_h_norm[16 * F.lane + i];
    const int gw = F.bid * NWAVES + F.wave, NGW = F.G * NWAVES;
    for (int rowb = gw; rowb < NTOK; rowb += 4 * NGW) {
        u32x4 h0[4], h1[4], o0[4], o1[4];
#pragma unroll
        for (int rr = 0; rr < 4; ++rr) { const int row = rowb + rr * NGW; if (row < NTOK) {
            h0[rr] = *(const u32x4*)(HO + (size_t)row * DM + 16 * F.lane); h1[rr] = *(const u32x4*)(HO + (size_t)row * DM + 16 * F.lane + 8);
            o0[rr] = *(const u32x4*)(PR + (size_t)row * 3072 + 2048 + 16 * F.lane); o1[rr] = *(const u32x4*)(PR + (size_t)row * 3072 + 2048 + 16 * F.lane + 8); } }
#pragma unroll
        for (int rr = 0; rr < 4; ++rr) { const int row = rowb + rr * NGW; if (row < NTOK) {
            float hv[16], ov[16];
#pragma unroll
            for (int i = 0; i < 4; ++i) { hv[2 * i] = bflo(h0[rr][i]); hv[2 * i + 1] = bfhi(h0[rr][i]); hv[8 + 2 * i] = bflo(h1[rr][i]); hv[8 + 2 * i + 1] = bfhi(h1[rr][i]);
                ov[2 * i] = bflo(o0[rr][i]); ov[2 * i + 1] = bfhi(o0[rr][i]); ov[8 + 2 * i] = bflo(o1[rr][i]); ov[8 + 2 * i + 1] = bfhi(o1[rr][i]); }
            float ss = 0.f;
#pragma unroll
            for (int i = 0; i < 16; ++i) ss += hv[i] * hv[i];
            ss += sx<1>(ss); ss += sx<2>(ss); ss += sx<4>(ss); ss += sx<8>(ss);
            const float r = 1.0f / sqrtf(ss * (1.0f / 256.0f) + EPS);
            float y[16];
#pragma unroll
            for (int i = 0; i < 16; ++i) y[i] = hv[i] * r * hn[i] * sigmoidf_(ov[i]);
            if (WQ_OUT0 == 2) { float mx = 0.f;
#pragma unroll
                for (int i = 0; i < 16; ++i) mx = fmaxf(mx, fabsf(y[i]));
                mx = fmaxf(wave_max(mx), 1e-20f); const float qs = 127.0f / mx;
                u32x4 w; w.x = pack4_i8(y[0] * qs, y[1] * qs, y[2] * qs, y[3] * qs); w.y = pack4_i8(y[4] * qs, y[5] * qs, y[6] * qs, y[7] * qs); w.z = pack4_i8(y[8] * qs, y[9] * qs, y[10] * qs, y[11] * qs); w.w = pack4_i8(y[12] * qs, y[13] * qs, y[14] * qs, y[15] * qs);
                *(u32x4*)(A2 + (size_t)row * DM + 16 * F.lane) = w; if (F.lane == 0) ((float*)(p.ws + SC_RS_A))[row] = mx * (1.0f / 127.0f); }
            else if (OUTPROJ_FP8) { u32x4 w; w.x = cvt4_fp8(y[0] * S8_A2, y[1] * S8_A2, y[2] * S8_A2, y[3] * S8_A2); w.y = cvt4_fp8(y[4] * S8_A2, y[5] * S8_A2, y[6] * S8_A2, y[7] * S8_A2);
                w.z = cvt4_fp8(y[8] * S8_A2, y[9] * S8_A2, y[10] * S8_A2, y[11] * S8_A2); w.w = cvt4_fp8(y[12] * S8_A2, y[13] * S8_A2, y[14] * S8_A2, y[15] * S8_A2);
                *(u32x4*)(A2 + (size_t)row * DM + 16 * F.lane) = w; }
            else { bf16_t* a2b = (bf16_t*)(p.ws + WS_A2B) + (size_t)row * DM + 16 * F.lane; u32x4 w0, w1;
                w0.x = cvtpk(y[0], y[1]); w0.y = cvtpk(y[2], y[3]); w0.z = cvtpk(y[4], y[5]); w0.w = cvtpk(y[6], y[7]); w1.x = cvtpk(y[8], y[9]); w1.y = cvtpk(y[10], y[11]); w1.z = cvtpk(y[12], y[13]); w1.w = cvtpk(y[14], y[15]);
                *(u32x4*)a2b = w0; *(u32x4*)(a2b + 8) = w1; }
            } }
    }
}

__device__ __forceinline__ void phase_hprep_router(unsigned char* lds_, int wv, const Params& p, int layer, int xnx, int xdx, int xper, int xj, const unsigned* oflags) {
    const Frame F = make_frame(lds_, wv);
    LAS u32x4* Wf = (LAS u32x4*)F.lds;
    LAS float* mulc = (LAS float*)(F.lds + 65536);
    LAS float* addc = (LAS float*)(F.lds + 65536 + 4096);
    LAS int* cnt = (LAS int*)(F.lds + 73728);
    LAS float* lgs = (LAS float*)(F.lds + 73728 + 64);
    const float* mod = (const float*)(p.ws + WS_MOD) + (size_t)layer * 16 * 6144;
    unsigned char* H = p.ws + WS_H;
    const bf16_t* XB = (const bf16_t*)(p.ws + WS_XB);
    int* blkcnt = (int*)(p.ws + RT_BLKCNT); int* info = (int*)(p.ws + RT_INFO); float* tw = (float*)(p.ws + RT_W);
    if (F.bid == 0) { for (int i = F.tid; i < 256 * DM / 16; i += NTHREADS) *(u32x4*)(H + (size_t)NTOK * DM + i * 16) = (u32x4){0u, 0u, 0u, 0u}; }
    float rb[16];
#pragma unroll
    for (int e = 0; e < 16; ++e) rb[e] = p.router_bias[e];
    const int ctlo = 2 * ((xdx * 128) / xnx), cthi = 2 * (((xdx + 1) * 128) / xnx);
    bool first = true;
    for (int chunk = ctlo + xj; chunk < cthi; chunk += xper) {
        int lane = F.lane; asm volatile("" : "+v"(lane));
        const int fr = lane & 15, fq = lane >> 4;
        const int row = chunk * 128 + F.wave * 16 + fr; const int b = (chunk * 128) / SEQ;
        if (first) { first = false;
            for (int idx = F.tid; idx < 2048; idx += NTHREADS) { const int ln = idx & 63, ks = idx >> 6; const int col0 = 64 * (ks >> 1) + 16 * (ln >> 4) + 8 * (ks & 1);
                const float* wp = p.w_router + (size_t)col0 * 16 + (ln & 15); u32x4 hi, lo;
#pragma unroll
                for (int i = 0; i < 4; ++i) { const float a = wp[(2 * i) * 16], c = wp[(2 * i + 1) * 16]; const unsigned u = cvtpk(a, c); hi[i] = u; lo[i] = cvtpk(a - bflo(u), c - bfhi(u)); }
                Wf[idx] = hi; Wf[2048 + idx] = lo; } }
        for (int c = F.tid; c < DM; c += NTHREADS) { mulc[c] = p.norm2[(size_t)layer * DM + c] * (1.0f + mod[(size_t)b * 6144 + 4096 + c]); addc[c] = mod[(size_t)b * 6144 + 3072 + c]; }
        if (oflags) { unsigned sp = 0u; while (xb_ld((unsigned*)oflags + (chunk >> 1)) < 32u) { __builtin_amdgcn_s_sleep(2); if (++sp > (1u << 22)) break; } asm volatile("" ::: "memory"); }
        u32x4 xv[16][2];
        { const bf16_t* xrow = XB + (size_t)row * DM + 16 * fq;
#pragma unroll
          for (int s = 0; s < 16; ++s) { xv[s][0] = *(const u32x4*)(xrow + 64 * s); xv[s][1] = *(const u32x4*)(xrow + 64 * s + 8); } }
        if (F.tid < 16) cnt[F.tid] = 0;
        __syncthreads();
        float ss = 0.f;
#pragma unroll
        for (int s = 0; s < 16; ++s)
#pragma unroll
            for (int t = 0; t < 2; ++t)
#pragma unroll
                for (int i = 0; i < 4; ++i) { const float a = bflo(xv[s][t][i]), c = bfhi(xv[s][t][i]); ss += a * a + c * c; }
        ss += sx<16>(ss); ss += sx32(ss, lane >= 32);
        const float r = 1.0f / sqrtf(ss * (1.0f / DM) + EPS);
        f32x4 acc0 = (f32x4){0.f, 0.f, 0.f, 0.f}, acc1 = acc0, acc2 = acc0;
        unsigned char* hrow = H + (size_t)row * DM + 16 * fq;
#pragma unroll
        for (int s = 0; s < 16; ++s) {
            asm volatile("" ::: "memory");
            float h[16];
#pragma unroll
            for (int q = 0; q < 4; ++q) { const f32x4 m = *(const LAS f32x4*)(mulc + 64 * s + 16 * fq + 4 * q), a = *(const LAS f32x4*)(addc + 64 * s + 16 * fq + 4 * q);
                unsigned w0 = xv[s][q >> 1][(q & 1) * 2], w1 = xv[s][q >> 1][(q & 1) * 2 + 1]; asm volatile("" : "+v"(w0), "+v"(w1));
                h[4 * q] = bflo(w0) * r * m[0] + a[0]; h[4 * q + 1] = bfhi(w0) * r * m[1] + a[1]; h[4 * q + 2] = bflo(w1) * r * m[2] + a[2]; h[4 * q + 3] = bfhi(w1) * r * m[3] + a[3]; }
            u32x4 o; o.x = cvt4_fp8(h[0] * S8_H, h[1] * S8_H, h[2] * S8_H, h[3] * S8_H); o.y = cvt4_fp8(h[4] * S8_H, h[5] * S8_H, h[6] * S8_H, h[7] * S8_H);
            o.z = cvt4_fp8(h[8] * S8_H, h[9] * S8_H, h[10] * S8_H, h[11] * S8_H); o.w = cvt4_fp8(h[12] * S8_H, h[13] * S8_H, h[14] * S8_H, h[15] * S8_H);
            *(u32x4*)(hrow + 64 * s) = o;
#pragma unroll
            for (int t = 0; t < 2; ++t) { u32x4 hi, lo;
#pragma unroll
                for (int i = 0; i < 4; ++i) { const float a = h[8 * t + 2 * i], c = h[8 * t + 2 * i + 1]; const unsigned u = cvtpk(a, c); hi[i] = u; lo[i] = cvtpk(a - bflo(u), c - bfhi(u)); }
                const int ks = 2 * s + t;
                const bf16x8 whi = __builtin_bit_cast(bf16x8, Wf[ks * 64 + lane]), wlo = __builtin_bit_cast(bf16x8, Wf[2048 + ks * 64 + lane]);
                const bf16x8 hh = __builtin_bit_cast(bf16x8, hi), hl = __builtin_bit_cast(bf16x8, lo);
                acc0 = __builtin_amdgcn_mfma_f32_16x16x32_bf16(whi, hh, acc0, 0, 0, 0);
                acc1 = __builtin_amdgcn_mfma_f32_16x16x32_bf16(wlo, hh, acc1, 0, 0, 0);
                acc2 = __builtin_amdgcn_mfma_f32_16x16x32_bf16(whi, hl, acc2, 0, 0, 0); }
        }
        { const f32x4 tot = acc0 + (acc1 + acc2);
#pragma unroll
          for (int rr = 0; rr < 4; ++rr) lgs[(F.wave * 16 + fr) * 17 + 4 * fq + rr] = tot[rr]; }
        __syncthreads();
        if (F.tid < 128) {
            const int row = chunk * 128 + F.tid;
            float sc[16], bs[16];
#pragma unroll
            for (int e = 0; e < 16; ++e) { sc[e] = 1.0f / (1.0f + expf(-lgs[F.tid * 17 + e])); bs[e] = sc[e] + rb[e]; }
            int gsel = 0; float gbest = -INFINITY;
#pragma unroll
            for (int gI = 0; gI < 4; ++gI) { const float a = bs[4 * gI], b2 = bs[4 * gI + 1], c2 = bs[4 * gI + 2], d2 = bs[4 * gI + 3];
                const float hi1 = fmaxf(a, b2), lo1 = fminf(a, b2), hi2 = fmaxf(c2, d2), lo2 = fminf(c2, d2);
                const float top = fmaxf(hi1, hi2), sec = fmaxf(fminf(hi1, hi2), fmaxf(lo1, lo2)); const float gs = top + sec;
                if (gs > gbest) { gbest = gs; gsel = gI; } }
            float v0 = 0.f, v1 = 0.f, v2 = 0.f, v3 = 0.f, s0 = 0.f, s1 = 0.f, s2 = 0.f, s3 = 0.f;
#pragma unroll
            for (int gI = 0; gI < 4; ++gI) if (gI == gsel) { v0 = bs[4 * gI]; v1 = bs[4 * gI + 1]; v2 = bs[4 * gI + 2]; v3 = bs[4 * gI + 3]; s0 = sc[4 * gI]; s1 = sc[4 * gI + 1]; s2 = sc[4 * gI + 2]; s3 = sc[4 * gI + 3]; }
            int i1 = 0; float b1 = v0; if (v1 > b1) { b1 = v1; i1 = 1; } if (v2 > b1) { b1 = v2; i1 = 2; } if (v3 > b1) { b1 = v3; i1 = 3; }
            int i2 = -1; float bb = -INFINITY;
            if (i1 != 0 && v0 > bb) { bb = v0; i2 = 0; } if (i1 != 1 && v1 > bb) { bb = v1; i2 = 1; } if (i1 != 2 && v2 > bb) { bb = v2; i2 = 2; } if (i1 != 3 && v3 > bb) { bb = v3; i2 = 3; }
            const float sa = (i1 == 0) ? s0 : (i1 == 1) ? s1 : (i1 == 2) ? s2 : s3;
            const float sb = (i2 == 0) ? s0 : (i2 == 1) ? s1 : (i2 == 2) ? s2 : s3;
            const int e0 = gsel * 4 + i1, e1 = gsel * 4 + i2;
            const int r0 = __hip_atomic_fetch_add(&cnt[e0], 1, __ATOMIC_RELAXED, __HIP_MEMORY_SCOPE_WORKGROUP); const int r1 = __hip_atomic_fetch_add(&cnt[e1], 1, __ATOMIC_RELAXED, __HIP_MEMORY_SCOPE_WORKGROUP);
            info[row] = e0 | (e1 << 4) | (r0 << 8) | (r1 << 16); const float inv = 1.0f / (sa + sb); *(f32x2*)(tw + (size_t)row * 2) = (f32x2){sa * inv, sb * inv};
        }
        __syncthreads();
        if (F.tid < 16) blkcnt[chunk * 16 + F.tid] = cnt[F.tid];
        __syncthreads();
    }
}

__device__ __forceinline__ void phase_layout(unsigned char* lds_, int wv, const Params& p) {
    const Frame F = make_frame(lds_, wv);
    LAS int* lc = (LAS int*)F.lds;
    LAS int* tot = lc + 4096;
    LAS int* sst = tot + 16;
    LAS int* tst = sst + 16;
    const int* blkcnt = (const int*)(p.ws + RT_BLKCNT); const int* info = (const int*)(p.ws + RT_INFO);
    int* dest = (int*)(p.ws + RT_DEST); int* buftok = (int*)(p.ws + RT_BUFTOK); int* meta = (int*)(p.ws + RT_META);
    for (int i = F.tid; i < 4096; i += NTHREADS) lc[i] = blkcnt[i];
    __syncthreads();
    { const int e = F.tid >> 5, li = F.tid & 31; int v[8]; int s = 0;
      LAS int* part = tst + 32;
#pragma unroll
      for (int k = 0; k < 8; ++k) { v[k] = lc[(8 * li + k) * 16 + e]; s += v[k]; }
      part[e * 32 + li] = s;
      __syncthreads();
      int run = 0, all = 0;
      for (int k = 0; k < 32; ++k) { const int t = part[e * 32 + k]; all += t; if (k < li) run += t; }
#pragma unroll
      for (int k = 0; k < 8; ++k) { lc[(8 * li + k) * 16 + e] = run; run += v[k]; }
      if (li == 31) tot[e] = all; }
    __syncthreads();
    if (F.tid == 0) { int ts = 0; for (int e = 0; e < 16; ++e) { tst[e] = ts; sst[e] = ts * 256; ts += (tot[e] + 255) >> 8; } tst[16] = ts;
        if (F.bid == 0) { meta[0] = ts; for (int e = 0; e <= 16; ++e) meta[1 + e] = tst[e]; } }
    __syncthreads();
    for (int chunk = F.bid; chunk < 256; chunk += F.G) {
        if (F.tid < 128) { const int tok = chunk * 128 + F.tid; const int inf = info[tok]; const int e0 = inf & 15, e1 = (inf >> 4) & 15, r0 = (inf >> 8) & 255, r1 = (inf >> 16) & 255;
            const int d0 = sst[e0] + lc[chunk * 16 + e0] + r0, d1 = sst[e1] + lc[chunk * 16 + e1] + r1;
            buftok[d0] = tok; buftok[d1] = tok; dest[tok * 2] = d0; dest[tok * 2 + 1] = d1; }
    }
    for (int e = F.bid; e < 16; e += F.G) { const int beg = sst[e] + tot[e], end = tst[e + 1] * 256; for (int s = beg + F.tid; s < end; s += NTHREADS) buftok[s] = NTOK; }
}

__device__ __forceinline__ void phase_combine(unsigned char* lds_, int wv, const Params& p, int layer, bool next_prep) {
    const Frame F = make_frame(lds_, wv);
    const float* mod = (const float*)(p.ws + WS_MOD) + (size_t)layer * 16 * 6144;
    const float* modn = (const float*)(p.ws + WS_MOD) + (size_t)(layer + 1) * 16 * 6144;
    const unsigned char* Y = p.ws + WS_PROJ; unsigned char* H = p.ws + WS_H;
    bf16_t* XB = (bf16_t*)(p.ws + WS_XB);
    const int* dest = (const int*)(p.ws + RT_DEST); const float* tw = (const float*)(p.ws + RT_W);
    for (int chunk = F.bid; chunk < 256; chunk += F.G) {
        const int row0 = chunk * 128 + F.wave * 16; const int b = row0 / SEQ;
        f32x4 g2[4];
#pragma unroll
        for (int j = 0; j < 4; ++j) g2[j] = *(const f32x4*)(mod + (size_t)b * 6144 + 5120 + 256 * j + 4 * F.lane) * (1.0f / S8_Y);
        RowConst rc;
        if (next_prep) rc = load_rowconst(p.norm1 + (size_t)(layer + 1) * DM, modn + (size_t)b * 6144, 0, 1024, F.lane);
        for (int rb = 0; rb < 16; rb += 4) {
            int d0[4], d1[4]; float w0[4], w1[4];
#pragma unroll
            for (int rr = 0; rr < 4; ++rr) { const int row = row0 + rb + rr; d0[rr] = dest[row * 2]; d1[rr] = dest[row * 2 + 1]; w0[rr] = tw[row * 2]; w1[rr] = tw[row * 2 + 1]; }
            u32x2 xr[4][4]; unsigned ya[4][4], yb[4][4];
#pragma unroll
            for (int rr = 0; rr < 4; ++rr)
#pragma unroll
                for (int j = 0; j < 4; ++j) { xr[rr][j] = *(const u32x2*)(XB + (size_t)(row0 + rb + rr) * DM + 256 * j + 4 * F.lane);
                    ya[rr][j] = *(const unsigned*)(Y + (size_t)d0[rr] * DM + 256 * j + 4 * F.lane); yb[rr][j] = *(const unsigned*)(Y + (size_t)d1[rr] * DM + 256 * j + 4 * F.lane); }
#pragma unroll
            for (int rr = 0; rr < 4; ++rr) { const int row = row0 + rb + rr;
                f32x4 v[4];
#pragma unroll
                for (int j = 0; j < 4; ++j) { const unsigned a = ya[rr][j], bq = yb[rr][j]; f32x4 yy;
                    const f32x2 a01 = __builtin_amdgcn_cvt_pk_f32_fp8((int)a, false), a23 = __builtin_amdgcn_cvt_pk_f32_fp8((int)a, true), b01 = __builtin_amdgcn_cvt_pk_f32_fp8((int)bq, false), b23 = __builtin_amdgcn_cvt_pk_f32_fp8((int)bq, true);
                    yy[0] = w0[rr] * a01[0] + w1[rr] * b01[0]; yy[1] = w0[rr] * a01[1] + w1[rr] * b01[1]; yy[2] = w0[rr] * a23[0] + w1[rr] * b23[0]; yy[3] = w0[rr] * a23[1] + w1[rr] * b23[1];
                    const f32x4 xv = (f32x4){bflo(xr[rr][j].x), bfhi(xr[rr][j].x), bflo(xr[rr][j].y), bfhi(xr[rr][j].y)};
                    v[j] = xv + g2[j] * yy;
                    if (next_prep) { u32x2 w; w.x = cvtpk(v[j][0], v[j][1]); w.y = cvtpk(v[j][2], v[j][3]); *(u32x2*)(XB + (size_t)row * DM + 256 * j + 4 * F.lane) = w; }
                    else *(f32x4*)(p.out + (size_t)row * DM + 256 * j + 4 * F.lane) = v[j]; }
                if (next_prep) { f32x4 h[4]; row_norm_store8(v, rc, h, H + (size_t)row * DM, F.lane); }
            }
        }
    }
}

__device__ __forceinline__ void phase_qkprep(unsigned char* lds_, int wv, const Params& p) {
    const Frame F = make_frame(lds_, wv);
    bf16_t* PR = (bf16_t*)(p.ws + WS_PROJ);
    const int lane = F.lane, half = lane & 1, sh = lane >> 1;
    float nw[32];
    { const float* nsrc = (sh < 16) ? p.b_q_norm : p.b_k_norm;
#pragma unroll
      for (int i = 0; i < 32; ++i) nw[i] = nsrc[half * 32 + i]; }
    const float qscale = (sh < 16) ? 0.125f * 1.4426950408889634f : 1.0f;
    const float invf_tab[8] = {1.0f, 0.19391788f, 0.037604144f, 0.0072920943f, 0.0014140673f, 0.00027421273f, 5.3174683e-05f, 1.0311522e-05f};
    float invf = 0.f;
#pragma unroll
    for (int i = 0; i < 8; ++i) if ((lane & 7) == i) invf = invf_tab[i];
    const int gw = F.bid * NWAVES + F.wave, NGW = F.G * NWAVES;
    for (int rowb = gw; rowb < NTOK; rowb += 4 * NGW) {
        u32x4 raw[4][4]; int posi[4];
#pragma unroll
        for (int rr = 0; rr < 4; ++rr) { const int row = rowb + rr * NGW; if (row < NTOK) { posi[rr] = p.positions[row]; const bf16_t* ptr = PR + (size_t)row * 3072 + sh * 64 + half * 32;
#pragma unroll
            for (int k = 0; k < 4; ++k) raw[rr][k] = *(const u32x4*)(ptr + 8 * k); } }
#pragma unroll
        for (int rr = 0; rr < 4; ++rr) { const int row = rowb + rr * NGW; if (row < NTOK) {
            const float ang = (float)posi[rr] * invf;
            const double rev = (double)ang * 0.15915494309189535; const float fr = (float)(rev - rint(rev));
            const float cs = __builtin_amdgcn_cosf(fr), sn = __builtin_amdgcn_sinf(fr);
            bf16_t* ptr = PR + (size_t)row * 3072 + sh * 64 + half * 32;
            float v[32];
#pragma unroll
            for (int k = 0; k < 4; ++k)
#pragma unroll
                for (int i = 0; i < 4; ++i) { v[8 * k + 2 * i] = bflo(raw[rr][k][i]); v[8 * k + 2 * i + 1] = bfhi(raw[rr][k][i]); }
            float ss = 0.f;
#pragma unroll
            for (int i = 0; i < 32; ++i) ss += v[i] * v[i];
            ss += sx<1>(ss);
            const float r = 1.0f / sqrtf(ss * (1.0f / 64.0f) + EPS);
#pragma unroll
            for (int i = 0; i < 32; ++i) v[i] = v[i] * r * nw[i];
            float y1[8], y2[8];
#pragma unroll
            for (int i = 0; i < 8; ++i) { const float ci = rdlane(cs, i), si = rdlane(sn, i); y1[i] = v[i] * ci - v[8 + i] * si; y2[i] = v[8 + i] * ci + v[i] * si; }
            if (half == 0) {
#pragma unroll
                for (int i = 0; i < 8; ++i) { v[i] = y1[i]; v[8 + i] = y2[i]; } }
#pragma unroll
            for (int k = 0; k < 4; ++k) { u32x4 o;
#pragma unroll
                for (int i = 0; i < 4; ++i) o[i] = cvtpk(v[8 * k + 2 * i] * qscale, v[8 * k + 2 * i + 1] * qscale);
                *(u32x4*)(ptr + 8 * k) = o; } } }
    }
}

__device__ __forceinline__ void phase_attn(unsigned char* lds_, int wv, const Params& p) {
    const Frame F = make_frame(lds_, wv);
    const bf16_t* PR = (const bf16_t*)(p.ws + WS_PROJ); bf16_t* O4 = (bf16_t*)(p.ws + WS_HOUT) + (size_t)F.bid * 256 * 256;
    unsigned char* A2 = p.ws + WS_H;
    const float lam_init = 0.8f - 0.6f * 0.7408182206817179f;
    const float s1 = wave_sum(p.b_lam_q1[F.lane] * p.b_lam_k1[F.lane]), s2 = wave_sum(p.b_lam_q2[F.lane] * p.b_lam_k2[F.lane]);
    const float lam = expf(s1) - expf(s2) + lam_init;
    const float osc = (WQ_OUT1 == 2) ? A2Q : (1.0f - lam_init) * (OUTPROJ_FP8 ? S8_A2 : 1.0f);
    for (int item = F.vcu; item < 256; item += F.G) {
        const int bh = item >> 1, set = item & 1, b = bh >> 3, h = bh & 7;
        const int qlist = set ? 0x1256 : 0x0347;
#define AT2_REF(R, u) do { const int qb_ = (qlist >> (4 * ((u) >> 1))) & 15, c_ = (u) & 1; const size_t r0_ = (size_t)b * SEQ + qb_ * 256; \
        R.Q = PR + r0_ * 3072 + (h * 2 + c_) * 64; R.K = PR + (size_t)b * SEQ * 3072 + 1024 + (h * 2 + c_) * 64; R.V = PR + (size_t)b * SEQ * 3072 + 2048 + h * 128; \
        R.P0 = qb_ * 256; R.to_lds = c_; R.lam = lam; } while (0)
        at2::Seam S; at2::BlockRef cur, nxt;
        AT2_REF(cur, 0);
        __syncthreads();
        at2::prime(cur, (char*)lds_, S, F.tid, wv);
        for (int u = 0; u < 8; ++u) {
            const int un = (u < 7) ? u + 1 : 7;
            AT2_REF(nxt, un);
            at2::block(cur, nxt, (char*)lds_, S, F.tid, wv);
            if (u & 1) {
                asm volatile("s_waitcnt vmcnt(0)" ::: "memory");
                int lane = F.lane; asm volatile("" : "+v"(lane));
                const int half = lane & 1; const int qb = (qlist >> (4 * (u >> 1))) & 15; const size_t row = (size_t)b * SEQ + qb * 256 + wv * 32 + (lane >> 1);
                const LAS unsigned char* pb = F.lds + at2::OFF_OL + wv * at2::OL_WAVE + (lane >> 1) * at2::OL_RS + half * 128;
                u32x4 bq[8];
#pragma unroll
                for (int i = 0; i < 8; ++i) bq[i] = *(const LAS u32x4*)(pb + 16 * i);
                float d[64]; float ss = 0.f;
#pragma unroll
                for (int i = 0; i < 8; ++i)
#pragma unroll
                    for (int j = 0; j < 4; ++j) { d[8 * i + 2 * j] = bflo(bq[i][j]); d[8 * i + 2 * j + 1] = bfhi(bq[i][j]); }
#pragma unroll
                for (int i = 0; i < 64; ++i) ss += d[i] * d[i];
                ss += sx<1>(ss);
                const float r = osc / sqrtf(ss * (1.0f / 128.0f) + EPS);
                if (WQ_OUT1 == 2) { unsigned char* po = A2 + row * DM + h * 128 + half * 64;
#pragma unroll
                    for (int i = 0; i < 4; ++i) { const f32x4 n0 = *(const f32x4*)(p.b_o_norm + half * 64 + 16 * i), n1 = *(const f32x4*)(p.b_o_norm + half * 64 + 16 * i + 4), n2 = *(const f32x4*)(p.b_o_norm + half * 64 + 16 * i + 8), n3 = *(const f32x4*)(p.b_o_norm + half * 64 + 16 * i + 12);
                        u32x4 w; w.x = pack4_i8(d[16 * i] * r * n0[0], d[16 * i + 1] * r * n0[1], d[16 * i + 2] * r * n0[2], d[16 * i + 3] * r * n0[3]);
                        w.y = pack4_i8(d[16 * i + 4] * r * n1[0], d[16 * i + 5] * r * n1[1], d[16 * i + 6] * r * n1[2], d[16 * i + 7] * r * n1[3]);
                        w.z = pack4_i8(d[16 * i + 8] * r * n2[0], d[16 * i + 9] * r * n2[1], d[16 * i + 10] * r * n2[2], d[16 * i + 11] * r * n2[3]);
                        w.w = pack4_i8(d[16 * i + 12] * r * n3[0], d[16 * i + 13] * r * n3[1], d[16 * i + 14] * r * n3[2], d[16 * i + 15] * r * n3[3]);
                        *(u32x4*)(po + 16 * i) = w; } }
                else if (OUTPROJ_FP8) { unsigned char* po = A2 + row * DM + h * 128 + half * 64;
#pragma unroll
                    for (int i = 0; i < 4; ++i) { const f32x4 n0 = *(const f32x4*)(p.b_o_norm + half * 64 + 16 * i), n1 = *(const f32x4*)(p.b_o_norm + half * 64 + 16 * i + 4), n2 = *(const f32x4*)(p.b_o_norm + half * 64 + 16 * i + 8), n3 = *(const f32x4*)(p.b_o_norm + half * 64 + 16 * i + 12);
                        u32x4 w; w.x = cvt4_fp8(d[16 * i] * r * n0[0], d[16 * i + 1] * r * n0[1], d[16 * i + 2] * r * n0[2], d[16 * i + 3] * r * n0[3]);
                        w.y = cvt4_fp8(d[16 * i + 4] * r * n1[0], d[16 * i + 5] * r * n1[1], d[16 * i + 6] * r * n1[2], d[16 * i + 7] * r * n1[3]);
                        w.z = cvt4_fp8(d[16 * i + 8] * r * n2[0], d[16 * i + 9] * r * n2[1], d[16 * i + 10] * r * n2[2], d[16 * i + 11] * r * n2[3]);
                        w.w = cvt4_fp8(d[16 * i + 12] * r * n3[0], d[16 * i + 13] * r * n3[1], d[16 * i + 14] * r * n3[2], d[16 * i + 15] * r * n3[3]);
                        *(u32x4*)(po + 16 * i) = w; } }
                else { bf16_t* po = (bf16_t*)(p.ws + WS_A2B) + row * DM + h * 128 + half * 64;
#pragma unroll
                    for (int i = 0; i < 8; ++i) { const f32x4 n0 = *(const f32x4*)(p.b_o_norm + half * 64 + 8 * i), n1 = *(const f32x4*)(p.b_o_norm + half * 64 + 8 * i + 4);
                        u32x4 w; w.x = cvtpk(d[8 * i] * r * n0[0], d[8 * i + 1] * r * n0[1]); w.y = cvtpk(d[8 * i + 2] * r * n0[2], d[8 * i + 3] * r * n0[3]);
                        w.z = cvtpk(d[8 * i + 4] * r * n1[0], d[8 * i + 5] * r * n1[1]); w.w = cvtpk(d[8 * i + 6] * r * n1[2], d[8 * i + 7] * r * n1[3]);
                        *(u32x4*)(po + 8 * i) = w; } }
            }
            cur = nxt;
        }
#undef AT2_REF
    }
}

__device__ __forceinline__ void phase_ocombine(unsigned char* lds_, int wv, const Params& p) {
    const Frame F = make_frame(lds_, wv);
    const bf16_t* O4 = (const bf16_t*)(p.ws + WS_HOUT); unsigned char* A2 = p.ws + WS_H;
    const float lam_init = 0.8f - 0.6f * 0.7408182206817179f;
    const float s1 = wave_sum(p.b_lam_q1[F.lane] * p.b_lam_k1[F.lane]), s2 = wave_sum(p.b_lam_q2[F.lane] * p.b_lam_k2[F.lane]);
    const float lam = expf(s1) - expf(s2) + lam_init;
    const int lane = F.lane, hh = lane >> 3, sub = lane & 7, half = sub >> 2, j0 = (sub & 3) * 16;
    float on[16];
#pragma unroll
    for (int i = 0; i < 16; ++i) on[i] = p.b_o_norm[half * 64 + j0 + i] * (1.0f - lam_init) * S8_A2;
    const int gw = F.bid * NWAVES + F.wave, NGW = F.G * NWAVES;
    for (int rowb = gw; rowb < NTOK; rowb += 4 * NGW) {
        u32x4 a0[4], a1[4], b0[4], b1[4];
#pragma unroll
        for (int rr = 0; rr < 4; ++rr) { const int row = rowb + rr * NGW; if (row < NTOK) {
            const bf16_t* pa = O4 + (size_t)row * 2048 + ((hh * 2 + 0) * 2 + half) * 64 + j0; const bf16_t* pb = O4 + (size_t)row * 2048 + ((hh * 2 + 1) * 2 + half) * 64 + j0;
            a0[rr] = *(const u32x4*)pa; a1[rr] = *(const u32x4*)(pa + 8); b0[rr] = *(const u32x4*)pb; b1[rr] = *(const u32x4*)(pb + 8); } }
#pragma unroll
        for (int rr = 0; rr < 4; ++rr) { const int row = rowb + rr * NGW; if (row < NTOK) {
            float d[16];
#pragma unroll
            for (int i = 0; i < 4; ++i) { d[2 * i] = bflo(a0[rr][i]) - lam * bflo(b0[rr][i]); d[2 * i + 1] = bfhi(a0[rr][i]) - lam * bfhi(b0[rr][i]); d[8 + 2 * i] = bflo(a1[rr][i]) - lam * bflo(b1[rr][i]); d[8 + 2 * i + 1] = bfhi(a1[rr][i]) - lam * bfhi(b1[rr][i]); }
            float ss = 0.f;
#pragma unroll
            for (int i = 0; i < 16; ++i) ss += d[i] * d[i];
            ss += sx<1>(ss); ss += sx<2>(ss); ss += sx<4>(ss);
            const float r = 1.0f / sqrtf(ss * (1.0f / 128.0f) + EPS);
            float y[16];
#pragma unroll
            for (int i = 0; i < 16; ++i) y[i] = d[i] * r * on[i];
            u32x4 w; w.x = cvt4_fp8(y[0], y[1], y[2], y[3]); w.y = cvt4_fp8(y[4], y[5], y[6], y[7]); w.z = cvt4_fp8(y[8], y[9], y[10], y[11]); w.w = cvt4_fp8(y[12], y[13], y[14], y[15]);
            *(u32x4*)(A2 + (size_t)row * DM + hh * 128 + half * 64 + j0) = w; } }
    }
}


#ifndef PHASE_MASK
#define PHASE_MASK 0xFFFFFFFFu
#endif
#ifndef PROBE_A
#define PROBE_A (-1)
#endif
#ifndef PROBE_B
#define PROBE_B (0)
#endif
constexpr int STAMP_OFF = LDS_BYTES - 2048;
#define STAMP(k) do { if (PROBE_A >= 0 && blockIdx.x == 0 && STAMP_WAVE == 0 && lane_id() == 0) ((volatile LAS unsigned*)((LAS unsigned char*)lds + STAMP_OFF))[k] = (unsigned)__builtin_amdgcn_s_memrealtime(); } while (0)
#define PH(n) ((PHASE_MASK >> (n)) & 1u)

template <int LAYER>
__device__ __forceinline__ void layer_body(const Params& p, const XcdBarrier& bar, unsigned char* lds) {
    const int STAMP_WAVE = bar.wave; (void)STAMP_WAVE;
    constexpr int SB = (LAYER == 0) ? 4 : 13;
    const int G_ = gridDim.x, bid_ = blockIdx.x; LAS unsigned char* ldsl = (LAS unsigned char*)lds;
#define SEAM() xcd_barrier(bar)
    const float* mod = (const float*)(p.ws + WS_MOD);
    LAS int* tab = (LAS int*)(ldsl + TAB_OFF);
    if (PH(2)) { pg8::StaticOrder S; S.init(NTOK, 3072, G_, bid_);
      if (LAYER == 0) {
        if (WQ_IN0 == 2) { pg8::EpiProjI8 E{(bf16_t*)(p.ws + WS_PROJ), (const float*)(p.ws + SC_RS_H), (const float*)(p.ws + SC_CW) + CW_AIN, 0.08838834764831845f};
          pg8::gemm_phase<pg8::EpiProjI8, pg8::StaticOrder, false, true>(ldsl, bar.wave, (const bf16_t*)(p.ws + WS_H), (const bf16_t*)(p.ws + WS_WAIN), 0, 512, S, E, nullptr); }
        else { pg8::EpiBf16 E{(bf16_t*)(p.ws + WS_PROJ), 3072, 2, 4, 0.08838834764831845f, WQ_IN0 == 1 ? 1.0f / (S8_H * S8_WIN) : 1.0f};
          if (WQ_IN0 == 1) pg8::gemm_phase8<pg8::EpiBf16, pg8::StaticOrder, false>(ldsl, bar.wave, p.ws + WS_H, p.ws + WS_WAIN, 0, 1024, S, E, nullptr);
          else pg8::gemm_phase<pg8::EpiBf16, pg8::StaticOrder, false>(ldsl, bar.wave, (const bf16_t*)(p.ws + WS_H), (const bf16_t*)(p.ws + WS_WAIN_BF), 0, 1024, S, E, nullptr); } }
      else { pg8::EpiQKV E{(bf16_t*)(p.ws + WS_PROJ), p.b_q_norm, p.b_k_norm, (const float*)(p.ws + WS_CS), 1.0f / (S8_H * S8_WIN)};
        pg8::gemm_phase8<pg8::EpiQKV, pg8::StaticOrder, false>(ldsl, bar.wave, p.ws + WS_H, p.ws + WS_WBIN, 0, 1024, S, E, nullptr); } }
    SEAM(); STAMP(SB + 0);
    if (LAYER == 0) {
        if (PH(3)) phase_mlstm(lds, bar.wave, p);
        SEAM(); STAMP(SB + 1);
        if (PH(4)) phase_aprep(lds, bar.wave, p);
    } else {
        STAMP(SB + 1);
        if (PH(6)) phase_attn(lds, bar.wave, p);
        STAMP(SB + 2);
    }
    SEAM(); STAMP(SB + 2 + LAYER);
    unsigned* oflags = (unsigned*)p.ws + CW_OFLAGS + LAYER * 128;
    const int xper = (int)bar.st[0], xnx = (int)bar.st[1], xdx = (int)bar.st[2], xj = (int)bar.st[3];
    constexpr bool OCHAIN = (LAYER == 0) ? (WQ_OUT0 == 2) : (WQ_OUT1 == 2);
    if (PH(8)) { pg8::StaticOrder S; S.init(NTOK, 1024, G_, bid_);
      pg8::XcdOrder SX{xnx, xdx, xper, xj, NTOK / 256, 4, oflags};
      if (LAYER == 0 && WQ_OUT0 == 2) { pg8::EpiResidB<true, true> E{(const void*)p.x, (bf16_t*)(p.ws + WS_XB), mod + 2048, 1.0f, (const float*)(p.ws + WS_SCALES)};
        pg8::gemm_phase<pg8::EpiResidB<true, true>, pg8::XcdOrder, false, true>(ldsl, bar.wave, (const bf16_t*)(p.ws + WS_H), (const bf16_t*)(p.ws + WS_WAOUT), 0, 512, SX, E, nullptr); }
      else if (LAYER == 1 && WQ_OUT1 == 2) { pg8::EpiResidB<false, true, true> E{(const void*)(p.ws + WS_XB), (bf16_t*)(p.ws + WS_XB), mod + (size_t)16 * 6144 + 2048, (1.0f - (0.8f - 0.6f * 0.7408182206817179f)) / A2Q, (const float*)(p.ws + WS_SCALES)};
        pg8::gemm_phase<pg8::EpiResidB<false, true, true>, pg8::XcdOrder, false, true>(ldsl, bar.wave, (const bf16_t*)(p.ws + WS_H), (const bf16_t*)(p.ws + WS_WBOUT), 0, 512, SX, E, nullptr); }
      else { pg8::EpiResidB<LAYER == 0> E{LAYER == 0 ? (const void*)p.x : (const void*)(p.ws + WS_XB), (bf16_t*)(p.ws + WS_XB), mod + (size_t)LAYER * 16 * 6144 + 2048, OUTPROJ_FP8 ? 1.0f / (S8_A2 * S8_WOUT) : 1.0f, nullptr};
        if (OUTPROJ_FP8) pg8::gemm_phase8<pg8::EpiResidB<LAYER == 0>, pg8::StaticOrder, false>(ldsl, bar.wave, p.ws + WS_H, p.ws + (LAYER == 0 ? WS_WAOUT : WS_WBOUT), 0, 1024, S, E, nullptr);
        else pg8::gemm_phase<pg8::EpiResidB<LAYER == 0>, pg8::StaticOrder, false>(ldsl, bar.wave, (const bf16_t*)(p.ws + WS_A2B), (const bf16_t*)(p.ws + (LAYER == 0 ? WS_WAOUT_BF : WS_WBOUT_BF)), 0, 1024, S, E, nullptr); } }
    if (!OCHAIN) SEAM();
    STAMP(SB + 3 + LAYER);
    if (PH(9)) phase_hprep_router(lds, bar.wave, p, LAYER, xnx, xdx, xper, xj, OCHAIN ? oflags : nullptr);
    SEAM(); STAMP(SB + 4 + LAYER);
    if (PH(10)) phase_layout(lds, bar.wave, p);
    SEAM(); STAMP(SB + 5 + LAYER);
    if (PH(11)) { const int* meta = (const int*)(p.ws + RT_META);
      __syncthreads();
      { const int t_ = bar.wave * 64 + lane_id(); if (t_ < 17) tab[t_] = meta[1 + t_]; }
      __syncthreads();
      unsigned* flags = (unsigned*)p.ws + CW_FLAGS + LAYER * 512;
      const int xper = (int)bar.st[0], xnx = (int)bar.st[1], xdx = (int)bar.st[2], xj = (int)bar.st[3];
      pg8::MoeOrder S{xnx, xdx, xper, xj, tab[16], tab, flags};
      pg8::EpiSwiGLU8 E1{p.ws + WS_HOUT, 1.0f / (S8_H * S8_WGU), flags};
      pg8::gemm_phase8<pg8::EpiSwiGLU8, pg8::MoeOrder, true>(ldsl, bar.wave, p.ws + WS_H, p.ws + WS_WGU + (size_t)LAYER * 16 * 1024 * 1024, (size_t)1024 * 1024, 1024, S, E1, (const int*)(p.ws + RT_BUFTOK));
      STAMP(SB + 6 + LAYER);
      pg8::MoeOrderWait S2{xnx, xdx, xper, xj, tab[16], tab, flags};
      pg8::EpiFp8 E2{p.ws + WS_PROJ, 1024, S8_Y / (S8_ACT * S8_WDN)};
      pg8::gemm_phase8<pg8::EpiFp8, pg8::MoeOrderWait, false>(ldsl, bar.wave, p.ws + WS_HOUT, p.ws + WS_WDN + (size_t)LAYER * 16 * 1024 * 512, (size_t)1024 * 512, 512, S2, E2, nullptr); }
    SEAM(); STAMP(SB + 7 + LAYER);
    if (PH(12)) phase_combine(lds, bar.wave, p, LAYER, LAYER == 0);
#undef SEAM
}
__global__ void __launch_bounds__(NTHREADS, 2) mk_fwd(Params p) {
    extern __shared__ __attribute__((aligned(16))) unsigned char lds[];
    cg::grid_group grid = cg::this_grid();
    volatile LAS unsigned* misc = (volatile LAS unsigned*)((LAS unsigned char*)lds + MISC_OFF);
    const int wv0 = __builtin_amdgcn_readfirstlane((int)threadIdx.x >> 6);
    if (threadIdx.x < 32) misc[threadIdx.x] = 0u;
    __syncthreads();
    unsigned* ctl = (unsigned*)p.ws;
    XcdBarrier bar = xcd_barrier_post(ctl + CW_BAR, misc + 8, wv0);
    const int STAMP_WAVE = wv0; (void)STAMP_WAVE;
    STAMP(0);
    if (PH(0)) phase_mod(lds, bar.wave, p);
    __syncthreads();
    STAMP(1);
    if (PH(0)) { phase_wconv(lds, bar.wave, p); __syncthreads(); phase_wconv_pw(lds, bar.wave, p); }
    __syncthreads();
    if (wv0 == 0 && lane_id() == 0) { unsigned sp = 0u; while (xb_ld(ctl + CW_MODCNT) < 192u) { __builtin_amdgcn_s_sleep(4); if (++sp > (1u << 22)) break; }
        __builtin_amdgcn_fence(__ATOMIC_ACQUIRE, "agent"); asm volatile("s_waitcnt vmcnt(0)" ::: "memory"); }
    __syncthreads(); STAMP(2);
    if (PH(1)) phase_hprep0(lds, bar.wave, p);
    grid.sync(); STAMP(3);
    layer_body<0>(p, bar, lds);
    xcd_barrier(bar); STAMP(12);
    layer_body<1>(p, bar, lds);
    STAMP(22);
    if (PROBE_A >= 0 && blockIdx.x == 0 && STAMP_WAVE == 0 && lane_id() == 0) {
        volatile LAS unsigned* ts = (volatile LAS unsigned*)((LAS unsigned char*)lds + STAMP_OFF);
        const unsigned dA = ts[PROBE_A + 1] - ts[PROBE_A], dB = ts[PROBE_B + 1] - ts[PROBE_B];
        const unsigned long long extra = 100ull * ((unsigned long long)(dA / 100u) + 1024ull * (dB / 100u)), t0 = __builtin_amdgcn_s_memrealtime();
        while (__builtin_amdgcn_s_memrealtime() - t0 < extra) __builtin_amdgcn_s_sleep(32);
    }
    if (xb_ld(ctl + CW_BAR + XB_TMO) != 0u) { __syncthreads(); for (size_t i = (size_t)blockIdx.x * NTHREADS + (wv0 * 64 + lane_id()); i < (size_t)NTOK * DM / 4; i += (size_t)gridDim.x * NTHREADS) ((f32x4*)p.out)[i] = (f32x4){1e30f, 1e30f, 1e30f, 1e30f}; }
}

extern "C" void kernel_launch(void* const* d_in, const int* in_sizes, int n_in, void* d_out, int out_size, void* d_ws, size_t ws_size, hipStream_t stream) {
    static int grid_blocks = 0;
    if (!grid_blocks) {
        int dev = 0, cus = 0, per_cu = 0;
        (void)hipGetDevice(&dev);
        (void)hipDeviceGetAttribute(&cus, hipDeviceAttributeMultiprocessorCount, dev);
        (void)hipFuncSetAttribute((const void*)mk_fwd, hipFuncAttributeMaxDynamicSharedMemorySize, LDS_BYTES);
        (void)hipOccupancyMaxActiveBlocksPerMultiprocessor(&per_cu, (const void*)mk_fwd, NTHREADS, LDS_BYTES);
        if (per_cu < 1) { fprintf(stderr, "kernel_launch: occupancy query reports %d blocks/CU\n", per_cu); per_cu = 1; }
        grid_blocks = cus;
        if (ws_size < WS_END || n_in != 24) fprintf(stderr, "kernel_launch: unexpected ws_size %zu (need %zu) or n_in %d\n", ws_size, (size_t)WS_END, n_in);
    }
    (void)hipMemsetAsync(d_ws, 0, CTL_BYTES, stream);
    Params p{};
    const float** pf = (const float**)&p;
    p.x = (const float*)d_in[0]; p.c = (const float*)d_in[1]; p.positions = (const int*)d_in[2]; p.norm1 = (const float*)d_in[3]; p.norm2 = (const float*)d_in[4];
    p.w_ada = (const float*)d_in[5]; p.b_ada = (const float*)d_in[6]; p.a_w_in = (const float*)d_in[7]; p.a_b_if = (const float*)d_in[8]; p.a_h_norm = (const float*)d_in[9];
    p.a_w_out = (const float*)d_in[10]; p.b_w_in = (const float*)d_in[11]; p.b_q_norm = (const float*)d_in[12]; p.b_k_norm = (const float*)d_in[13];
    p.b_lam_q1 = (const float*)d_in[14]; p.b_lam_k1 = (const float*)d_in[15]; p.b_lam_q2 = (const float*)d_in[16]; p.b_lam_k2 = (const float*)d_in[17];
    p.b_o_norm = (const float*)d_in[18]; p.b_w_out = (const float*)d_in[19]; p.w_router = (const float*)d_in[20]; p.router_bias = (const float*)d_in[21];
    p.moe_w_gu = (const float*)d_in[22]; p.moe_w_down = (const float*)d_in[23];
    p.out = (float*)d_out; p.ws = (unsigned char*)d_ws; (void)pf;
    void* args[] = {&p};
    hipError_t e = hipLaunchCooperativeKernel((const void*)mk_fwd, dim3(grid_blocks), dim3(NTHREADS), args, LDS_BYTES, stream);
    if (e != hipSuccess) fprintf(stderr, "cooperative launch failed: %s (grid %d)\n", hipGetErrorString(e), grid_blocks);
}
```

```cpp
#include <hip/hip_runtime.h>
#include <hip/hip_cooperative_groups.h>
#include <hip/hip_bf16.h>
#include <cstdio>
#include <cstdint>
#include <cmath>
namespace cg = cooperative_groups;

#define GAS __attribute__((address_space(1)))
#define LAS __attribute__((address_space(3)))
typedef unsigned short bf16_t;
typedef float f32x4 __attribute__((ext_vector_type(4)));
typedef float f32x2 __attribute__((ext_vector_type(2)));
typedef short bf16x8 __attribute__((ext_vector_type(8)));
typedef short s16x4 __attribute__((ext_vector_type(4)));
typedef unsigned u32x4 __attribute__((ext_vector_type(4)));
typedef unsigned u32x2 __attribute__((ext_vector_type(2)));
typedef __bf16 bf16x2_t __attribute__((ext_vector_type(2)));
typedef int i32x8 __attribute__((ext_vector_type(8)));
typedef int i32x4 __attribute__((ext_vector_type(4)));

constexpr int NTOK = 32768, DM = 1024, SEQ = 2048, NB = 16;
constexpr int NEXP = 16, DEXP = 512;
constexpr int NTHREADS = 512, NWAVES = 8;
constexpr int LDS_BYTES = 147456;
constexpr int MISC_OFF = LDS_BYTES - 128;
constexpr int TAB_OFF = 131072;
constexpr float EPS = 1e-6f;
constexpr int MAXTILES = 272, CAP = MAXTILES * 256;
constexpr float S8_H = 8.0f, S8_WGU = 256.0f, S8_ACT = 4.0f, S8_WDN = 128.0f, S8_WIN = 256.0f, S8_A2 = 16.0f, S8_WOUT = 256.0f, S8_Y = 16.0f;

constexpr size_t MiB = 1u << 20;
constexpr size_t WS_CTL = 0, CTL_BYTES = 1 * MiB;
constexpr int CW_BAR = 4096;
constexpr int CW_MODCNT = 9728;
constexpr int CW_OFLAGS = 9216;
constexpr int CW_FLAGS = 8192;
constexpr size_t WS_MOD = 1 * MiB;
constexpr size_t WS_ROUTE = 2 * MiB;
constexpr size_t RT_BLKCNT = WS_ROUTE;
constexpr size_t RT_INFO = WS_ROUTE + 64 * 1024;
constexpr size_t RT_W = RT_INFO + 128 * 1024;
constexpr size_t RT_DEST = RT_W + 256 * 1024;
constexpr size_t RT_BUFTOK = RT_DEST + 256 * 1024;
constexpr size_t RT_META = RT_BUFTOK + 320 * 1024;
constexpr size_t WS_GATES = 4 * MiB;
constexpr size_t WS_SCALES = 5 * MiB;
constexpr size_t SC_RS_H = WS_SCALES;
constexpr size_t SC_RS_A = WS_SCALES + 128 * 1024;
constexpr size_t SC_RS_TOK = WS_SCALES + 256 * 1024;
constexpr size_t SC_RS_SLOT = WS_SCALES + 384 * 1024;
constexpr size_t SC_CW = WS_SCALES + 704 * 1024;
constexpr int CW_AIN = 0, CW_AOUT = 3072, CW_BIN = 4096, CW_GU = 7168, CW_BOUT = 7168 + 32 * 1024;
constexpr int WQ_OUT1 = 2;
constexpr float A2Q = 127.0f / 6.0f;
constexpr int WQ_IN0 = 2, WQ_IN1 = 1, WQ_OUT0 = 2, WQ_GU = 1;
constexpr size_t WS_WAIN = 6 * MiB, WS_WAOUT = 10 * MiB, WS_WBIN = 12 * MiB, WS_WBOUT = 16 * MiB;
constexpr size_t WS_WGU = 18 * MiB;
constexpr size_t WS_WDN = 50 * MiB;
constexpr size_t WS_H = 66 * MiB;
constexpr size_t WS_XB = 100 * MiB;
constexpr size_t WS_PROJ = 164 * MiB;
constexpr size_t WS_HOUT = 356 * MiB;
constexpr size_t WS_CS = 484 * MiB;
constexpr size_t WS_WAIN_BF = 488 * MiB;
constexpr size_t WS_WAOUT_BF = 506 * MiB, WS_WBOUT_BF = 508 * MiB;
constexpr size_t WS_A2B = 420 * MiB;
constexpr bool OUTPROJ_FP8 = false;
constexpr size_t WS_END = 510 * MiB;
constexpr bool INPROJ0_FP8 = false;

__device__ __forceinline__ unsigned cvtpk(float lo, float hi) { f32x2 v = {lo, hi}; bf16x2_t b = __builtin_convertvector(v, bf16x2_t); return __builtin_bit_cast(unsigned, b); }
__device__ __forceinline__ float clamp448(float v) { return fminf(fmaxf(v, -448.0f), 448.0f); }
__device__ __forceinline__ unsigned cvt4_fp8(float a, float b, float c, float d) {
    int w = __builtin_amdgcn_cvt_pk_fp8_f32(clamp448(a), clamp448(b), 0, false); w = __builtin_amdgcn_cvt_pk_fp8_f32(clamp448(c), clamp448(d), w, true); return (unsigned)w; }
__device__ __forceinline__ float bf2f(unsigned short h) { return __uint_as_float(((unsigned)h) << 16); }
__device__ __forceinline__ float bflo(unsigned w) { return __uint_as_float(w << 16); }
__device__ __forceinline__ float bfhi(unsigned w) { return __uint_as_float(w & 0xffff0000u); }
__device__ __forceinline__ int lane_id() { int l; asm volatile("v_mbcnt_lo_u32_b32 %0, -1, 0\n\tv_mbcnt_hi_u32_b32 %0, -1, %0" : "=v"(l)); return l; }
template <int M> __device__ __forceinline__ float sx(float v) {
    const int i = __float_as_int(v);
    if constexpr (M == 1) return __int_as_float(__builtin_amdgcn_mov_dpp(i, 0xB1, 0xF, 0xF, true));
    else if constexpr (M == 2) return __int_as_float(__builtin_amdgcn_mov_dpp(i, 0x4E, 0xF, 0xF, true));
    else if constexpr (M == 4) return __int_as_float(__builtin_amdgcn_ds_swizzle(i, 0x101F));
    else if constexpr (M == 8) return __int_as_float(__builtin_amdgcn_ds_swizzle(i, 0x201F));
    else if constexpr (M == 16) return __int_as_float(__builtin_amdgcn_ds_swizzle(i, 0x401F));
    else { static_assert(M == 1, "sx: mask"); return v; }
}
__device__ __forceinline__ float sx16p(float v, bool odd_row) {
    auto rr = __builtin_amdgcn_permlane16_swap(__float_as_uint(v), __float_as_uint(v), false, false);
    return __uint_as_float(odd_row ? rr[0] : rr[1]);
}
__device__ __forceinline__ float sx32(float v, bool upper) {
    auto rr = __builtin_amdgcn_permlane32_swap(__float_as_uint(v), __float_as_uint(v), false, false);
    return __uint_as_float(upper ? rr[0] : rr[1]);
}
__device__ __forceinline__ float bperm(float v, int src_lane) { return __int_as_float(__builtin_amdgcn_ds_bpermute(src_lane << 2, __float_as_int(v))); }
__device__ __forceinline__ float rdlane(float v, int l) { return __int_as_float(__builtin_amdgcn_readlane(__float_as_int(v), l)); }
__device__ __forceinline__ float wave_sum(float v) {
    v += sx<1>(v); v += sx<2>(v); v += sx<4>(v); v += sx<8>(v); v += sx<16>(v);
    { auto rr = __builtin_amdgcn_permlane32_swap(__float_as_uint(v), __float_as_uint(v), false, false); v = __uint_as_float(rr[0]) + __uint_as_float(rr[1]); }
    return v;
}
__device__ __forceinline__ float wave_max(float v) {
    v = fmaxf(v, sx<1>(v)); v = fmaxf(v, sx<2>(v)); v = fmaxf(v, sx<4>(v)); v = fmaxf(v, sx<8>(v)); v = fmaxf(v, sx<16>(v));
    { auto rr = __builtin_amdgcn_permlane32_swap(__float_as_uint(v), __float_as_uint(v), false, false); v = fmaxf(__uint_as_float(rr[0]), __uint_as_float(rr[1])); }
    return v;
}
__device__ __forceinline__ unsigned pack4_i8(float a, float b, float c, float d) {
    unsigned w = __builtin_amdgcn_cvt_pk_u8_f32(fminf(fmaxf(rintf(a), -127.f), 127.f) + 128.f, 0, 0u);
    w = __builtin_amdgcn_cvt_pk_u8_f32(fminf(fmaxf(rintf(b), -127.f), 127.f) + 128.f, 1, w);
    w = __builtin_amdgcn_cvt_pk_u8_f32(fminf(fmaxf(rintf(c), -127.f), 127.f) + 128.f, 2, w);
    w = __builtin_amdgcn_cvt_pk_u8_f32(fminf(fmaxf(rintf(d), -127.f), 127.f) + 128.f, 3, w);
    return w ^ 0x80808080u;
}
__device__ __forceinline__ f32x4 i2f4(f32x4 a) { return (f32x4){(float)__float_as_int(a[0]), (float)__float_as_int(a[1]), (float)__float_as_int(a[2]), (float)__float_as_int(a[3])}; }
__device__ __forceinline__ float sigmoidf_(float x) { return __builtin_amdgcn_rcpf(1.0f + __expf(-x)); }

#define XB_TMO      128
#define XB_XCNT(j)  (256  + 64 * (j))
#define XB_XSUB(j)  (1280 + 64 * (j))
#define XB_XGEN(j)  (2304 + 64 * (j))
#define XB_TOP      3328
#define XB_TOPGEN   3392
#define XCD_BAR_WORDS 3456
#define XB_SPIN_CAP (1u << 18)
__device__ __forceinline__ unsigned xb_ld(unsigned* p)              { return __hip_atomic_load(p, __ATOMIC_RELAXED, __HIP_MEMORY_SCOPE_AGENT); }
__device__ __forceinline__ unsigned xb_add(unsigned* p, unsigned v) { return __hip_atomic_fetch_add(p, v, __ATOMIC_RELAXED, __HIP_MEMORY_SCOPE_AGENT); }
__device__ __forceinline__ unsigned xb_xcc_id() { return (unsigned)__builtin_amdgcn_s_getreg((3 << 11) | 20) & 0xFu; }
#define XB_SPIN(cond, bar) do { unsigned _sp = 0; while (cond) { __builtin_amdgcn_s_sleep(1); \
    if ((++_sp & 255u) == 0u) { if (xb_ld(&(bar)[XB_TMO])) break; if (_sp > XB_SPIN_CAP) { atomicAdd(&(bar)[XB_TMO], 1u); break; } } } } while (0)
struct XcdBarrier { unsigned* bar; unsigned x; volatile LAS unsigned* st; int wave; };
__device__ __forceinline__ XcdBarrier xcd_barrier_post(unsigned* bar, volatile LAS unsigned* st, int wave) {
    XcdBarrier b; b.bar = bar; b.x = xb_xcc_id(); b.st = st; b.wave = wave;
    if (wave == 0 && lane_id() == 0) st[3] = xb_add(&bar[XB_XCNT(b.x)], 1u);
    return b;
}
__device__ __forceinline__ void xcd_barrier_complete(unsigned* bar, unsigned x, unsigned& nloc, unsigned& nx, unsigned& dx) {
    const unsigned G = gridDim.x * gridDim.y * gridDim.z;
    unsigned sum, cnt, mine, below, sp = 0u;
    for (;;) {
        sum = 0u; cnt = 0u; mine = 0u; below = 0u;
#pragma unroll
        for (unsigned j = 0; j < 16; ++j) { const unsigned c = xb_ld(&bar[XB_XCNT(j)]); sum += c; cnt += (c > 0u) ? 1u : 0u; mine = (j == x) ? c : mine; below += (j < x && c > 0u) ? 1u : 0u; }
        if (sum == G) break;
        __builtin_amdgcn_s_sleep(1);
        if ((++sp & 255u) == 0u) { if (xb_ld(&bar[XB_TMO])) break; if (sp > XB_SPIN_CAP) { atomicAdd(&bar[XB_TMO], 1u); break; } }
    }
    nloc = mine > 0u ? mine : 1u; nx = cnt > 0u ? cnt : 1u; dx = below;
}
__device__ __forceinline__ void xcd_barrier(const XcdBarrier& b) {
    asm volatile("s_waitcnt vmcnt(0)" ::: "memory");
    __syncthreads();
    if (b.wave == 0 && lane_id() == 0) {
        unsigned* bar = b.bar;
        __builtin_amdgcn_s_waitcnt(0);
        unsigned nloc = b.st[0], nx = b.st[1];
        if (nloc == 0u) { unsigned dx; xcd_barrier_complete(bar, b.x, nloc, nx, dx); b.st[0] = nloc; b.st[1] = nx; b.st[2] = dx; }
        const unsigned old = xb_add(&bar[XB_XSUB(b.x)], 1u);
        const unsigned gen = old / nloc;
        if (old + 1u == (gen + 1u) * nloc) {
            __builtin_amdgcn_fence(__ATOMIC_RELEASE, "agent");
            asm volatile("s_waitcnt vmcnt(0)" ::: "memory");
            const unsigned og = xb_add(&bar[XB_TOP], 1u);
            const unsigned target = (og / nx + 1u) * nx;
            if (og + 1u != target) XB_SPIN(xb_ld(&bar[XB_TOP]) < target, bar);
            __builtin_amdgcn_fence(__ATOMIC_ACQUIRE, "agent");
            xb_add(&bar[XB_XGEN(b.x)], 1u);
            asm volatile("s_waitcnt vmcnt(0)" ::: "memory");
        } else {
            XB_SPIN(xb_ld(&bar[XB_XGEN(b.x)]) == gen, bar);
            __builtin_amdgcn_fence(__ATOMIC_ACQUIRE, "agent");
            asm volatile("s_waitcnt vmcnt(0)" ::: "memory");
        }
    }
    __syncthreads();
}

namespace pg8 {
constexpr int BM = 256, BK = 64, HALF = 128, HTB = HALF * BK * 2, STAGE_BYTES = 8 * HTB, NXCD = 8, WGM = 8;
__device__ __forceinline__ int lds_byte(int r, int c) { const int st = (r >> 4) * 2 + (c >> 5), rr = r & 15, cc = c & 31, ob = rr * 64 + cc * 2; return st * 1024 + (ob ^ (((ob >> 9) & 1) << 5)); }
__device__ __forceinline__ void stage_rc(int b, int& R, int& C) { const int st = b / 1024, sb = b % 1024, swz = sb ^ (((sb >> 9) & 1) << 5); R = (st >> 1) * 16 + swz / 64; C = (st & 1) * 32 + (swz % 64) / 2; }
__device__ __forceinline__ int perm32(int rho) { const int n = rho >> 4, i = rho & 15; return 8 * (i >> 2) + 4 * n + (i & 3); }

struct Unit { int pm, pn, e; };

struct StaticOrder {
    static constexpr bool SIGNAL = false;
    int nM, nN, nwg, G, c;
    __device__ void init(int M, int N, int G_, int c_) { nM = M / BM; nN = N / BM; nwg = nM * nN; G = G_; c = c_; }
    __device__ __forceinline__ bool next(int i, Unit& u) const {
        const long L = (long)i * G + c; if (L >= nwg) return false;
        int wgid = (int)L; { const int q = nwg / NXCD, r = nwg % NXCD, xcd = wgid % NXCD, off = wgid / NXCD; wgid = (xcd < r ? xcd * (q + 1) : r * (q + 1) + (xcd - r) * q) + off; }
        const int nig = WGM * nN, gid = wgid / nig, fm = gid * WGM, gsz = (nM - fm) < WGM ? (nM - fm) : WGM;
        u.pm = __builtin_amdgcn_readfirstlane(fm + ((wgid % nig) % gsz)); u.pn = __builtin_amdgcn_readfirstlane((wgid % nig) / gsz); u.e = 0; return true;
    }
};
struct XcdOrder {
    static constexpr bool SIGNAL = true;
    int nx, dx, per, j, nM, nN; unsigned* flags;
    __device__ __forceinline__ bool next(int i, Unit& u) const {
        const int tlo = (dx * nM) / nx, thi = ((dx + 1) * nM) / nx, n = (thi - tlo) * nN;
        const int q = j + i * per; if (q >= n) return false;
        u.pm = __builtin_amdgcn_readfirstlane(tlo + q / nN); u.pn = __builtin_amdgcn_readfirstlane(q % nN); u.e = 0; return true;
    }
    __device__ __forceinline__ void signal(const Unit& u, int lane) const { asm volatile("s_waitcnt vmcnt(0)" ::: "memory"); if (lane == 0) (void)xb_add(flags + u.pm, 1u); }
};
template <bool WAIT>
struct MoeOrderT {
    static constexpr bool SIGNAL = false;
    int nx, dx, per, j, ntiles; const LAS int* ts; unsigned* flags;
    __device__ __forceinline__ bool next(int i, Unit& u) const {
        const int tlo = (dx * ntiles) / nx, thi = ((dx + 1) * ntiles) / nx, n = 4 * (thi - tlo);
        int jj = j; if (WAIT) { jj = j - (n % per); if (jj < 0) jj += per; }
        const int q = jj + i * per; if (q >= n) return false;
        const int tile = tlo + (q >> 2), pn = q & 3;
        int e = 0;
#pragma unroll
        for (int k = 1; k < 16; ++k) e += (tile >= ts[k]) ? 1 : 0;
        u.pm = __builtin_amdgcn_readfirstlane(tile); u.pn = __builtin_amdgcn_readfirstlane(pn); u.e = __builtin_amdgcn_readfirstlane(e);
        if (WAIT) { unsigned sp = 0u;
            while (xb_ld(flags + u.pm) < 32u) { __builtin_amdgcn_s_sleep(2); if (++sp > (1u << 22)) break; }
            asm volatile("" ::: "memory"); }
        return true;
    }
};
typedef MoeOrderT<false> MoeOrder;
typedef MoeOrderT<true> MoeOrderWait;

struct EpiBf16 {
    static constexpr bool PERM = true, HP = false, SIGNAL = false;
    bf16_t* O; int ldc; int s_lo, s_hi; float scale; float base;
    __device__ __forceinline__ void operator()(const f32x4 (&acc)[2][2][4][2], const Unit& u, int wr, int wc, int fr, int fq) const {
        const int row0 = u.pm * BM + wr * 64 + fr; const int col0 = u.pn * BM + wc * 32 + 8 * fq;
        const float sc = ((u.pn >= s_lo && u.pn < s_hi) ? scale : 1.0f) * base;
#pragma unroll
        for (int ai = 0; ai < 2; ++ai)
#pragma unroll
            for (int m = 0; m < 4; ++m) { bf16_t* rowp = O + (size_t)(row0 + ai * HALF + m * 16) * ldc + col0;
#pragma unroll
                for (int bj = 0; bj < 2; ++bj) { const f32x4 v0 = acc[ai][bj][m][0] * sc, v1 = acc[ai][bj][m][1] * sc;
                    u32x4 w; w.x = cvtpk(v0[0], v0[1]); w.y = cvtpk(v0[2], v0[3]); w.z = cvtpk(v1[0], v1[1]); w.w = cvtpk(v1[2], v1[3]);
                    *(u32x4*)(rowp + bj * HALF) = w; } }
    }
};
struct EpiSwiGLU {
    static constexpr bool PERM = true;
    bf16_t* O;
    __device__ __forceinline__ void operator()(const f32x4 (&acc)[2][2][4][2], const Unit& u, int wr, int wc, int fr, int fq) const {
        const int row0 = u.pm * BM + wr * 64 + fr; const int col0 = u.pn * 128 + wc * 32 + 8 * fq;
#pragma unroll
        for (int ai = 0; ai < 2; ++ai)
#pragma unroll
            for (int m = 0; m < 4; ++m) { bf16_t* rowp = O + (size_t)(row0 + ai * HALF + m * 16) * DEXP + col0;
                float a[8];
#pragma unroll
                for (int n = 0; n < 2; ++n)
#pragma unroll
                    for (int j = 0; j < 4; ++j) { const float g = acc[ai][0][m][n][j], up = acc[ai][1][m][n][j]; a[n * 4 + j] = g * up / (1.0f + __expf(-g)); }
                u32x4 w; w.x = cvtpk(a[0], a[1]); w.y = cvtpk(a[2], a[3]); w.z = cvtpk(a[4], a[5]); w.w = cvtpk(a[6], a[7]);
                *(u32x4*)rowp = w; }
    }
};
struct EpiResid {
    static constexpr bool PERM = false;
    const float* base; float* out; const float* gate;
    __device__ __forceinline__ void operator()(const f32x4 (&acc)[2][2][4][2], const Unit& u, int wr, int wc, int fr, int fq) const {
        const int row0 = u.pm * BM + wr * 64 + fr, col0 = u.pn * BM + wc * 32 + 4 * fq;
        const int b = (u.pm * BM) / SEQ;
        f32x4 gv[2][2];
#pragma unroll
        for (int bj = 0; bj < 2; ++bj)
#pragma unroll
            for (int n = 0; n < 2; ++n) gv[bj][n] = *(const f32x4*)(gate + (size_t)b * 6144 + col0 + bj * HALF + n * 16);
#pragma unroll
        for (int ai = 0; ai < 2; ++ai)
#pragma unroll
            for (int m = 0; m < 4; ++m) { const size_t off = (size_t)(row0 + ai * HALF + m * 16) * DM + col0;
#pragma unroll
                for (int bj = 0; bj < 2; ++bj)
#pragma unroll
                    for (int n = 0; n < 2; ++n) { const f32x4 bs = *(const f32x4*)(base + off + bj * HALF + n * 16);
                        *(f32x4*)(out + off + bj * HALF + n * 16) = bs + gv[bj][n] * acc[ai][bj][m][n]; }
                asm volatile("" ::: "memory"); }
    }
};

struct EpiProjI8 {
    static constexpr bool PERM = true, HP = false;
    bf16_t* O; const float* ra; const float* cw; float kscale;
    __device__ __forceinline__ void operator()(const f32x4 (&acc)[2][2][4][2], const Unit& u, int wr, int wc, int fr, int fq) const {
        const int row0 = u.pm * BM + wr * 64 + fr; const int col0 = u.pn * BM + wc * 32 + 8 * fq;
        const float ks = (u.pn >= 2 && u.pn < 4) ? kscale : 1.0f;
        f32x4 c0[2], c1[2];
#pragma unroll
        for (int bj = 0; bj < 2; ++bj) { c0[bj] = *(const f32x4*)(cw + col0 + bj * HALF) * ks; c1[bj] = *(const f32x4*)(cw + col0 + bj * HALF + 4) * ks; }
#pragma unroll
        for (int ai = 0; ai < 2; ++ai)
#pragma unroll
            for (int m = 0; m < 4; ++m) { const int row = row0 + ai * HALF + m * 16; const float rs = ra[row]; bf16_t* rowp = O + (size_t)row * 3072 + col0;
#pragma unroll
                for (int bj = 0; bj < 2; ++bj) { const f32x4 v0 = i2f4(acc[ai][bj][m][0]) * c0[bj] * rs, v1 = i2f4(acc[ai][bj][m][1]) * c1[bj] * rs;
                    u32x4 w; w.x = cvtpk(v0[0], v0[1]); w.y = cvtpk(v0[2], v0[3]); w.z = cvtpk(v1[0], v1[1]); w.w = cvtpk(v1[2], v1[3]);
                    *(u32x4*)(rowp + bj * HALF) = w; } }
    }
};
struct EpiFp8 {
    static constexpr bool PERM = true, HP = false, SIGNAL = false;
    unsigned char* O; int ldc; float scale;
    __device__ __forceinline__ void operator()(const f32x4 (&acc)[2][2][4][2], const Unit& u, int wr, int wc, int fr, int fq) const {
        const int row0 = u.pm * BM + wr * 64 + fr; const int col0 = u.pn * BM + wc * 32 + 8 * fq;
#pragma unroll
        for (int ai = 0; ai < 2; ++ai)
#pragma unroll
            for (int m = 0; m < 4; ++m) { unsigned char* rowp = O + (size_t)(row0 + ai * HALF + m * 16) * ldc + col0;
#pragma unroll
                for (int bj = 0; bj < 2; ++bj) { const f32x4 v0 = acc[ai][bj][m][0] * scale, v1 = acc[ai][bj][m][1] * scale;
                    u32x2 w; w.x = cvt4_fp8(v0[0], v0[1], v0[2], v0[3]); w.y = cvt4_fp8(v1[0], v1[1], v1[2], v1[3]);
                    *(u32x2*)(rowp + bj * HALF) = w; } }
    }
};
struct EpiQKV {
    static constexpr bool PERM = true, HP = true, SIGNAL = false;
    bf16_t* O; const float* qn; const float* kn; const float* cs; float descale;
    __device__ __forceinline__ void operator()(const f32x4 (&acc)[2][2][4][2], const Unit& u, int wr, int wc, int fr, int fq) const {
        const int row0 = u.pm * BM + wr * 64 + fr; const int col0 = u.pn * BM + wc * 64 + 8 * fq;
        const bool isqk = u.pn < 8; const bool odd = (fq & 1) != 0;
        float w[2][2][4];
        if (isqk) { const float* nw = (u.pn < 4) ? qn : kn;
#pragma unroll
            for (int bj = 0; bj < 2; ++bj)
#pragma unroll
                for (int n = 0; n < 2; ++n) { const f32x4 t = *(const f32x4*)(nw + 32 * bj + 8 * fq + 4 * n); w[bj][n][0] = t[0]; w[bj][n][1] = t[1]; w[bj][n][2] = t[2]; w[bj][n][3] = t[3]; } }
        const float qs = (u.pn < 4) ? 0.125f * 1.4426950408889634f : 1.0f;
#pragma unroll
        for (int ai = 0; ai < 2; ++ai)
#pragma unroll
            for (int m = 0; m < 4; ++m) { const int row = row0 + ai * HALF + m * 16; bf16_t* rowp = O + (size_t)row * 3072 + col0;
                float v[2][2][4];
#pragma unroll
                for (int bj = 0; bj < 2; ++bj)
#pragma unroll
                    for (int n = 0; n < 2; ++n)
#pragma unroll
                        for (int j = 0; j < 4; ++j) v[bj][n][j] = acc[ai][bj][m][n][j] * descale;
                if (isqk) {
                    float ss = 0.f;
#pragma unroll
                    for (int bj = 0; bj < 2; ++bj)
#pragma unroll
                        for (int n = 0; n < 2; ++n)
#pragma unroll
                            for (int j = 0; j < 4; ++j) ss += v[bj][n][j] * v[bj][n][j];
                    ss += sx16p(ss, odd);
                    { auto rr = __builtin_amdgcn_permlane32_swap(__float_as_uint(ss), __float_as_uint(ss), false, false); ss = __uint_as_float(rr[0]) + __uint_as_float(rr[1]); }
                    const float rn = 1.0f / sqrtf(ss * (1.0f / 64.0f) + EPS);
#pragma unroll
                    for (int bj = 0; bj < 2; ++bj)
#pragma unroll
                        for (int n = 0; n < 2; ++n)
#pragma unroll
                            for (int j = 0; j < 4; ++j) v[bj][n][j] = v[bj][n][j] * rn * w[bj][n][j];
                    const f32x4 c0 = *(const f32x4*)(cs + (size_t)row * 16), c1 = *(const f32x4*)(cs + (size_t)row * 16 + 4), s0 = *(const f32x4*)(cs + (size_t)row * 16 + 8), s1 = *(const f32x4*)(cs + (size_t)row * 16 + 12);
#pragma unroll
                    for (int n = 0; n < 2; ++n)
#pragma unroll
                        for (int j = 0; j < 4; ++j) { const float x = v[0][n][j]; const float pr = sx16p(x, odd); const float c = n ? c1[j] : c0[j], sn = n ? s1[j] : s0[j];
                            const float r0 = x * c - pr * sn, r1 = x * c + pr * sn; v[0][n][j] = (fq == 0) ? r0 : (fq == 1) ? r1 : x; }
#pragma unroll
                    for (int bj = 0; bj < 2; ++bj)
#pragma unroll
                        for (int n = 0; n < 2; ++n)
#pragma unroll
                            for (int j = 0; j < 4; ++j) v[bj][n][j] *= qs;
                }
#pragma unroll
                for (int bj = 0; bj < 2; ++bj) { u32x4 wv; wv.x = cvtpk(v[bj][0][0], v[bj][0][1]); wv.y = cvtpk(v[bj][0][2], v[bj][0][3]); wv.z = cvtpk(v[bj][1][0], v[bj][1][1]); wv.w = cvtpk(v[bj][1][2], v[bj][1][3]);
                    *(u32x4*)(rowp + 32 * bj) = wv; } }
    }
};
template <bool BASE_F32, bool I8 = false, bool STATIC_A = false> struct EpiResidB {
    static constexpr bool PERM = true, HP = false, SIGNAL = false;
    const void* base; bf16_t* out; const float* gate; float descale; const float* sc;
    __device__ __forceinline__ void operator()(const f32x4 (&acc)[2][2][4][2], const Unit& u, int wr, int wc, int fr, int fq) const {
        const int row0 = u.pm * BM + wr * 64 + fr, col0 = u.pn * BM + wc * 32 + 8 * fq;
        const int b = (u.pm * BM) / SEQ;
        const float* ra = sc + (SC_RS_A - WS_SCALES) / 4; const float* cw = sc + (SC_CW - WS_SCALES) / 4 + (STATIC_A ? CW_BOUT : CW_AOUT);
        f32x4 gv[2][2];
#pragma unroll
        for (int bj = 0; bj < 2; ++bj)
#pragma unroll
            for (int n = 0; n < 2; ++n) { gv[bj][n] = *(const f32x4*)(gate + (size_t)b * 6144 + col0 + bj * HALF + n * 4); if (!I8) gv[bj][n] = gv[bj][n] * descale; if (I8) gv[bj][n] = gv[bj][n] * *(const f32x4*)(cw + col0 + bj * HALF + n * 4); }
#pragma unroll
        for (int ai = 0; ai < 2; ++ai)
#pragma unroll
            for (int m = 0; m < 4; ++m) { const size_t off = (size_t)(row0 + ai * HALF + m * 16) * DM + col0; const float rs = !I8 ? 1.0f : STATIC_A ? descale : ra[row0 + ai * HALF + m * 16];
#pragma unroll
                for (int bj = 0; bj < 2; ++bj) { f32x4 b0, b1;
                    if (BASE_F32) { b0 = *(const f32x4*)((const float*)base + off + bj * HALF); b1 = *(const f32x4*)((const float*)base + off + bj * HALF + 4); }
                    else { const u32x4 r = *(const u32x4*)((const bf16_t*)base + off + bj * HALF); b0 = (f32x4){bflo(r.x), bfhi(r.x), bflo(r.y), bfhi(r.y)}; b1 = (f32x4){bflo(r.z), bfhi(r.z), bflo(r.w), bfhi(r.w)}; }
                    const f32x4 a0 = I8 ? i2f4(acc[ai][bj][m][0]) * rs : acc[ai][bj][m][0], a1 = I8 ? i2f4(acc[ai][bj][m][1]) * rs : acc[ai][bj][m][1];
                    const f32x4 v0 = b0 + gv[bj][0] * a0, v1 = b1 + gv[bj][1] * a1;
                    u32x4 w; w.x = cvtpk(v0[0], v0[1]); w.y = cvtpk(v0[2], v0[3]); w.z = cvtpk(v1[0], v1[1]); w.w = cvtpk(v1[2], v1[3]);
                    *(u32x4*)(out + off + bj * HALF) = w; }
                asm volatile("" ::: "memory"); }
    }
};
template <class Epi, class Sched, bool GATHER, bool I8 = false>
__device__ __forceinline__ void gemm_phase(LAS unsigned char* lds, int wv, const bf16_t* A, const bf16_t* Bt, size_t bstride, int K, const Sched& S, const Epi& E, const int* aidx) {
    int tid = wv * 64 + lane_id(); asm volatile("" : "+v"(tid));
    const int wid = wv, lane = tid & 63, wr = wid >> 2, wc = wid & 3, fr = lane & 15, fq = lane >> 4;
    const int nt = K / BK;
    int RA[2], CA[2]; unsigned voffB[2];
#pragma unroll
    for (int i = 0; i < 2; ++i) { int R, C; stage_rc(tid * 16 + i * 8192, R, C); const int Rb = Epi::PERM ? ((R & ~31) + perm32(R & 31)) : R;
        RA[i] = R; CA[i] = C; voffB[i] = (unsigned)(Rb * K + C) * 2u; }
    const size_t kstep = (size_t)(BK * 2);
    const size_t hstep = (size_t)HALF * K * 2;
    const size_t tstep = 2 * hstep;
    const unsigned ldsw = (unsigned)wid * 1024u;
    const int aoff = lds_byte(wr * 64 + fr, fq * 8), boff = lds_byte(wc * 32 + fr, fq * 8);
#define PG8_SA(b, h) (((b) * 2 + (h)) * HTB)
#define PG8_SB(b, h) ((4 + (b) * 2 + (h)) * HTB)
#define PG8_STAGE(bufoff, gbase, voff) do { _Pragma("unroll") for (int _i = 0; _i < 2; ++_i) \
        __builtin_amdgcn_global_load_lds((const unsigned*)((const char*)(gbase) + (voff)[_i]), (LAS unsigned*)(lds + (bufoff) + ldsw + _i * 8192), 16, 0, 0); } while (0)
#define PG8_LDA(dst, b, h) do { _Pragma("unroll") for (int m = 0; m < 4; ++m) _Pragma("unroll") for (int k = 0; k < 2; ++k) dst[m][k] = *(const LAS bf16x8*)(lds + PG8_SA(b, h) + aoff + m * 2048 + k * 1024); } while (0)
#define PG8_LDB(dst, b, h) do { _Pragma("unroll") for (int n = 0; n < 2; ++n) _Pragma("unroll") for (int k = 0; k < 2; ++k) dst[n][k] = *(const LAS bf16x8*)(lds + PG8_SB(b, h) + boff + n * 2048 + k * 1024); } while (0)
#define PG8_MMA(ai, bj, At, Bt_) do { __builtin_amdgcn_s_setprio(1); _Pragma("unroll") for (int m = 0; m < 4; ++m) _Pragma("unroll") for (int n = 0; n < 2; ++n) _Pragma("unroll") for (int k = 0; k < 2; ++k) { \
        if constexpr (I8) acc[ai][bj][m][n] = __builtin_bit_cast(f32x4, __builtin_amdgcn_mfma_i32_16x16x64_i8(__builtin_bit_cast(i32x4, Bt_[n][k]), __builtin_bit_cast(i32x4, At[m][k]), __builtin_bit_cast(i32x4, acc[ai][bj][m][n]), 0, 0, 0)); \
        else acc[ai][bj][m][n] = __builtin_amdgcn_mfma_f32_16x16x32_bf16(Bt_[n][k], At[m][k], acc[ai][bj][m][n], 0, 0, 0); } __builtin_amdgcn_s_setprio(0); } while (0)
#define PG8_WAIT_V(n) asm volatile("s_waitcnt vmcnt(" #n ")" ::: "memory")
#define PG8_WAIT_L(n) asm volatile("s_waitcnt lgkmcnt(" #n ")" ::: "memory")
#define PG8_BAR __builtin_amdgcn_s_barrier()
#define PG8_SCHED __builtin_amdgcn_sched_barrier(0)
#define PG8_AOFF(dst, U) do { _Pragma("unroll") for (int _h = 0; _h < 2; ++_h) _Pragma("unroll") for (int _i = 0; _i < 2; ++_i) { \
        const int _row = (U).pm * BM + _h * HALF + RA[_i]; const int _src = GATHER ? aidx[_row] : _row; dst[_h][_i] = (unsigned)(_src * K + CA[_i]) * 2u; } } while (0)
#define PG8_STAGE_A(bufoff, kb, offs, h) do { _Pragma("unroll") for (int _i = 0; _i < 2; ++_i) \
        __builtin_amdgcn_global_load_lds((const unsigned*)((const char*)A + (kb) + (offs)[h][_i]), (LAS unsigned*)(lds + (bufoff) + ldsw + _i * 8192), 16, 0, 0); } while (0)
    Unit cur, nxt; int ui = 0;
    if (!S.next(0, cur)) return;
    f32x4 acc[2][2][4][2];
#pragma unroll
    for (int a = 0; a < 2; ++a)
#pragma unroll
        for (int b = 0; b < 2; ++b)
#pragma unroll
            for (int m = 0; m < 4; ++m)
#pragma unroll
                for (int n = 0; n < 2; ++n) acc[a][b][m][n] = (f32x4){0.f, 0.f, 0.f, 0.f};
    bf16x8 At[4][2], B0[2][2], B1[2][2];
    unsigned ac[2][2], an[2][2];
    PG8_AOFF(ac, cur);
    const char* cB = (const char*)Bt + ((size_t)cur.e * bstride) * 2 + (size_t)cur.pn * tstep;
    PG8_STAGE(PG8_SB(0, 0), cB, voffB); PG8_STAGE(PG8_SB(0, 1), cB + hstep, voffB); PG8_STAGE_A(PG8_SA(0, 0), 0, ac, 0); PG8_STAGE_A(PG8_SA(0, 1), 0, ac, 1);
    if (wr == 1) PG8_BAR;
    PG8_WAIT_V(2); PG8_BAR;
    PG8_STAGE(PG8_SB(1, 0), cB + kstep, voffB); PG8_STAGE_A(PG8_SA(1, 0), kstep, ac, 0); PG8_STAGE(PG8_SB(1, 1), cB + hstep + kstep, voffB);
    PG8_WAIT_V(6); PG8_BAR;
    for (;;) {
        const bool has_next = S.next(ui + 1, nxt);
        if (has_next) { PG8_AOFF(an, nxt); } else {
#pragma unroll
            for (int h = 0; h < 2; ++h)
#pragma unroll
                for (int i = 0; i < 2; ++i) an[h][i] = ac[h][i]; }
        const char* nB = has_next ? (const char*)Bt + ((size_t)nxt.e * bstride) * 2 + (size_t)nxt.pn * tstep : cB;
#pragma unroll 1
        for (int t = 0; t < nt; t += 2) {
            const bool last = (t == nt - 2);
            const size_t k1 = (size_t)(t + 1) * kstep;
            const size_t k2 = last ? 0 : (size_t)(t + 2) * kstep;
            const size_t k3 = k2 + kstep;
            const char* b2 = last ? nB : cB + (size_t)(t + 2) * kstep; const char* b3 = b2 + kstep;
            unsigned a2[2][2];
#pragma unroll
            for (int h = 0; h < 2; ++h)
#pragma unroll
                for (int i = 0; i < 2; ++i) a2[h][i] = last ? an[h][i] : ac[h][i];
            PG8_LDB(B0, 0, 0); PG8_LDB(B1, 0, 1); PG8_SCHED; PG8_LDA(At, 0, 0); PG8_STAGE_A(PG8_SA(1, 1), k1, ac, 1);
            PG8_WAIT_V(8); PG8_WAIT_L(0); PG8_BAR; PG8_MMA(0, 0, At, B0); PG8_MMA(0, 1, At, B1); PG8_BAR; PG8_SCHED;
            PG8_LDA(At, 0, 1); PG8_STAGE(PG8_SB(0, 0), b2, voffB); PG8_STAGE(PG8_SB(0, 1), b2 + hstep, voffB); PG8_STAGE_A(PG8_SA(0, 0), k2, a2, 0);
            PG8_WAIT_V(8); PG8_WAIT_L(0); PG8_BAR; PG8_MMA(1, 0, At, B0); PG8_MMA(1, 1, At, B1); PG8_BAR; PG8_SCHED;
            PG8_LDB(B0, 1, 0); PG8_LDB(B1, 1, 1); PG8_SCHED; PG8_LDA(At, 1, 0); PG8_STAGE_A(PG8_SA(0, 1), k2, a2, 1);
            PG8_WAIT_V(8); PG8_WAIT_L(0); PG8_BAR; PG8_MMA(0, 0, At, B0); PG8_MMA(0, 1, At, B1); PG8_BAR; PG8_SCHED;
            PG8_LDA(At, 1, 1); PG8_STAGE(PG8_SB(1, 0), b3, voffB); PG8_STAGE(PG8_SB(1, 1), b3 + hstep, voffB); PG8_STAGE_A(PG8_SA(1, 0), k3, a2, 0);
            PG8_WAIT_V(8); PG8_WAIT_L(0); PG8_BAR; PG8_MMA(1, 0, At, B0); PG8_MMA(1, 1, At, B1); PG8_BAR; PG8_SCHED;
        }
        if (wr == 0) PG8_BAR;
        E(acc, cur, wr, wc, fr, fq);
        if constexpr (Sched::SIGNAL) S.signal(cur, lane);
        if (!has_next) break;
#pragma unroll
        for (int a = 0; a < 2; ++a)
#pragma unroll
            for (int b = 0; b < 2; ++b)
#pragma unroll
                for (int m = 0; m < 4; ++m)
#pragma unroll
                    for (int n = 0; n < 2; ++n) acc[a][b][m][n] = (f32x4){0.f, 0.f, 0.f, 0.f};
        cur = nxt; cB = nB; ++ui;
#pragma unroll
        for (int h = 0; h < 2; ++h)
#pragma unroll
            for (int i = 0; i < 2; ++i) ac[h][i] = an[h][i];
        if (wr == 1) PG8_BAR;
    }
    PG8_WAIT_V(0);
    PG8_BAR;
#undef PG8_SA
#undef PG8_SB
#undef PG8_STAGE
#undef PG8_LDA
#undef PG8_LDB
#undef PG8_MMA
#undef PG8_WAIT_V
#undef PG8_WAIT_L
#undef PG8_BAR
#undef PG8_SCHED
#undef PG8_AOFF
#undef PG8_STAGE_A
}

__device__ __forceinline__ int x8(int e) { return e ^ ((((e >> 1) ^ (e >> 2)) & 1) << 1); }
struct EpiSwiGLU8 {
    static constexpr bool PERM = true, HP = false, SIGNAL = true;
    unsigned char* O; float descale; unsigned* flags;
    __device__ __forceinline__ void operator()(const f32x4 (&acc)[2][2][4][2], const Unit& u, int wr, int wc, int fr, int fq) const {
        const int row0 = u.pm * BM + wr * 64 + fr; const int col0 = u.pn * 128 + wc * 32 + 8 * fq;
#pragma unroll
        for (int ai = 0; ai < 2; ++ai)
#pragma unroll
            for (int m = 0; m < 4; ++m) { unsigned char* rowp = O + (size_t)(row0 + ai * HALF + m * 16) * DEXP + col0;
                float a[8];
#pragma unroll
                for (int n = 0; n < 2; ++n)
#pragma unroll
                    for (int j = 0; j < 4; ++j) { const float g = acc[ai][0][m][n][j] * descale, up = acc[ai][1][m][n][j] * descale; a[n * 4 + j] = S8_ACT * g * up * __builtin_amdgcn_rcpf(1.0f + __expf(-g)); }
                u32x2 w; w.x = cvt4_fp8(a[0], a[1], a[2], a[3]); w.y = cvt4_fp8(a[4], a[5], a[6], a[7]);
                *(u32x2*)rowp = w; }
    }
};
template <class Epi, class Sched, bool GATHER>
__device__ __forceinline__ void gemm_phase8(LAS unsigned char* lds, int wv, const unsigned char* A, const unsigned char* Bt, size_t bstride, int Kb, const Sched& S, const Epi& E, const int* aidx) {
    int tid = wv * 64 + lane_id(); asm volatile("" : "+v"(tid));
    const int wid = wv, lane = tid & 63, wr = wid >> 2, wc = wid & 3, fr = lane & 15, fq = lane >> 4;
    const int nt = Kb / 128;
    int RA[2], CA[2]; unsigned voffB[2], voffB1[2];
#pragma unroll
    for (int i = 0; i < 2; ++i) { const int b = tid * 16 + i * 8192; const int R = b >> 7, pc = (b >> 4) & 7; const int C = (pc ^ x8((R >> 1) & 7)) * 16;
        const int Rb = Epi::PERM ? ((R & ~31) + perm32(R & 31)) : R;
        RA[i] = R; CA[i] = C;
        if (Epi::HP) { const int g0 = 64 * (R >> 5) + perm32(R & 31); voffB[i] = (unsigned)(g0 * Kb + C); voffB1[i] = (unsigned)((g0 + 32) * Kb + C); }
        else { voffB[i] = (unsigned)(Rb * Kb + C); voffB1[i] = voffB[i] + (unsigned)(HALF * Kb); } }
    const size_t kstep = 128;
    const size_t hstep = (size_t)HALF * Kb;
    const size_t tstep = 2 * hstep;
    const unsigned ldsw = (unsigned)wid * 1024u;
    const int xa = x8((fr >> 1) & 7);
    const int aoff = (wr * 64 + fr) * 128 + (((2 * fq) ^ xa) << 4), boff = (wc * 32 + fr) * 128 + (((2 * fq) ^ xa) << 4);
    const int aoff1 = aoff ^ 16, boff1 = boff ^ 16;
#define PG8_SA(b, h) (((b) * 2 + (h)) * HTB)
#define PG8_SB(b, h) ((4 + (b) * 2 + (h)) * HTB)
#define PG8_STAGE(bufoff, gbase, voff) do { _Pragma("unroll") for (int _i = 0; _i < 2; ++_i) \
        __builtin_amdgcn_global_load_lds((const unsigned*)((const char*)(gbase) + (voff)[_i]), (LAS unsigned*)(lds + (bufoff) + ldsw + _i * 8192), 16, 0, 0); } while (0)
#define PG8_RD32(dst, off, off1) do { const u32x4 _lo = *(const LAS u32x4*)(lds + (off)), _hi = *(const LAS u32x4*)(lds + (off1)); \
        dst = (i32x8){(int)_lo.x, (int)_lo.y, (int)_lo.z, (int)_lo.w, (int)_hi.x, (int)_hi.y, (int)_hi.z, (int)_hi.w}; } while (0)
#define PG8_LDA(dst, b, h) do { _Pragma("unroll") for (int m = 0; m < 4; ++m) PG8_RD32(dst[m], PG8_SA(b, h) + aoff + m * 2048, PG8_SA(b, h) + aoff1 + m * 2048); } while (0)
#define PG8_LDB(dst, b, h) do { _Pragma("unroll") for (int n = 0; n < 2; ++n) PG8_RD32(dst[n], PG8_SB(b, h) + boff + n * 2048, PG8_SB(b, h) + boff1 + n * 2048); } while (0)
#define PG8_MMA(ai, bj, At, Bt_) do { __builtin_amdgcn_s_setprio(1); _Pragma("unroll") for (int m = 0; m < 4; ++m) _Pragma("unroll") for (int n = 0; n < 2; ++n) \
        asm volatile("v_mfma_scale_f32_16x16x128_f8f6f4 %0, %1, %2, %0, %3, %3 op_sel_hi:[0,0,0]" : "+v"(acc[ai][bj][m][n]) : "v"(Bt_[n]), "v"(At[m]), "v"(sc1)); __builtin_amdgcn_s_setprio(0); } while (0)
#define PG8_WAIT_V(n) asm volatile("s_waitcnt vmcnt(" #n ")" ::: "memory")
#define PG8_WAIT_L(n) asm volatile("s_waitcnt lgkmcnt(" #n ")" ::: "memory")
#define PG8_BAR __builtin_amdgcn_s_barrier()
#define PG8_SCHED __builtin_amdgcn_sched_barrier(0)
#define PG8_AOFF(dst, U) do { _Pragma("unroll") for (int _h = 0; _h < 2; ++_h) _Pragma("unroll") for (int _i = 0; _i < 2; ++_i) { \
        const int _row = (U).pm * BM + _h * HALF + RA[_i]; const int _src = GATHER ? aidx[_row] : _row; dst[_h][_i] = (unsigned)(_src * Kb + CA[_i]); } } while (0)
#define PG8_STAGE_A(bufoff, kb, offs, h) do { _Pragma("unroll") for (int _i = 0; _i < 2; ++_i) \
        __builtin_amdgcn_global_load_lds((const unsigned*)((const char*)A + (kb) + (offs)[h][_i]), (LAS unsigned*)(lds + (bufoff) + ldsw + _i * 8192), 16, 0, 0); } while (0)
    Unit cur, nxt; int ui = 0;
    if (!S.next(0, cur)) return;
    f32x4 acc[2][2][4][2];
#pragma unroll
    for (int a = 0; a < 2; ++a)
#pragma unroll
        for (int b = 0; b < 2; ++b)
#pragma unroll
            for (int m = 0; m < 4; ++m)
#pragma unroll
                for (int n = 0; n < 2; ++n) acc[a][b][m][n] = (f32x4){0.f, 0.f, 0.f, 0.f};
    i32x8 At[4], B0[2], B1[2];
    int sc1 = 0x7F7F7F7F; asm volatile("" : "+v"(sc1));
    unsigned ac[2][2], an[2][2];
    PG8_AOFF(ac, cur);
    const char* cB = (const char*)Bt + (size_t)cur.e * bstride + (size_t)cur.pn * tstep;
    PG8_STAGE(PG8_SB(0, 0), cB, voffB); PG8_STAGE(PG8_SB(0, 1), cB, voffB1); PG8_STAGE_A(PG8_SA(0, 0), 0, ac, 0); PG8_STAGE_A(PG8_SA(0, 1), 0, ac, 1);
    if (wr == 1) PG8_BAR;
    PG8_WAIT_V(2); PG8_BAR;
    PG8_STAGE(PG8_SB(1, 0), cB + kstep, voffB); PG8_STAGE_A(PG8_SA(1, 0), kstep, ac, 0); PG8_STAGE(PG8_SB(1, 1), cB + kstep, voffB1);
    PG8_WAIT_V(6); PG8_BAR;
    for (;;) {
        const bool has_next = S.next(ui + 1, nxt);
        if (has_next) { PG8_AOFF(an, nxt); } else {
#pragma unroll
            for (int h = 0; h < 2; ++h)
#pragma unroll
                for (int i = 0; i < 2; ++i) an[h][i] = ac[h][i]; }
        const char* nB = has_next ? (const char*)Bt + (size_t)nxt.e * bstride + (size_t)nxt.pn * tstep : cB;
#pragma unroll 1
        for (int t = 0; t < nt; t += 2) {
            const bool last = (t == nt - 2);
            const size_t k1 = (size_t)(t + 1) * kstep;
            const size_t k2 = last ? 0 : (size_t)(t + 2) * kstep;
            const size_t k3 = k2 + kstep;
            const char* b2 = last ? nB : cB + (size_t)(t + 2) * kstep; const char* b3 = b2 + kstep;
            unsigned a2[2][2];
#pragma unroll
            for (int h = 0; h < 2; ++h)
#pragma unroll
                for (int i = 0; i < 2; ++i) a2[h][i] = last ? an[h][i] : ac[h][i];
            PG8_LDB(B0, 0, 0); PG8_LDB(B1, 0, 1); PG8_SCHED; PG8_LDA(At, 0, 0); PG8_STAGE_A(PG8_SA(1, 1), k1, ac, 1);
            PG8_WAIT_V(8); PG8_WAIT_L(0); PG8_BAR; PG8_MMA(0, 0, At, B0); PG8_MMA(0, 1, At, B1); PG8_BAR; PG8_SCHED;
            PG8_LDA(At, 0, 1); PG8_STAGE(PG8_SB(0, 0), b2, voffB); PG8_STAGE(PG8_SB(0, 1), b2, voffB1); PG8_STAGE_A(PG8_SA(0, 0), k2, a2, 0);
            PG8_WAIT_V(8); PG8_WAIT_L(0); PG8_BAR; PG8_MMA(1, 0, At, B0); PG8_MMA(1, 1, At, B1); PG8_BAR; PG8_SCHED;
            PG8_LDB(B0, 1, 0); PG8_LDB(B1, 1, 1); PG8_SCHED; PG8_LDA(At, 1, 0); PG8_STAGE_A(PG8_SA(0, 1), k2, a2, 1);
            PG8_WAIT_V(8); PG8_WAIT_L(0); PG8_BAR; PG8_MMA(0, 0, At, B0); PG8_MMA(0, 1, At, B1); PG8_BAR; PG8_SCHED;
            PG8_LDA(At, 1, 1); PG8_STAGE(PG8_SB(1, 0), b3, voffB); PG8_STAGE(PG8_SB(1, 1), b3, voffB1); PG8_STAGE_A(PG8_SA(1, 0), k3, a2, 0);
            PG8_WAIT_V(8); PG8_WAIT_L(0); PG8_BAR; PG8_MMA(1, 0, At, B0); PG8_MMA(1, 1, At, B1); PG8_BAR; PG8_SCHED;
        }
        if (wr == 0) PG8_BAR;
        asm volatile("s_nop 15\n\ts_nop 15" ::: "memory");
        E(acc, cur, wr, wc, fr, fq);
        if constexpr (Epi::SIGNAL) { asm volatile("s_waitcnt vmcnt(0)" ::: "memory"); if (lane == 0) (void)xb_add(E.flags + cur.pm, 1u); }
        if (!has_next) break;
#pragma unroll
        for (int a = 0; a < 2; ++a)
#pragma unroll
            for (int b = 0; b < 2; ++b)
#pragma unroll
                for (int m = 0; m < 4; ++m)
#pragma unroll
                    for (int n = 0; n < 2; ++n) acc[a][b][m][n] = (f32x4){0.f, 0.f, 0.f, 0.f};
        cur = nxt; cB = nB; ++ui;
#pragma unroll
        for (int h = 0; h < 2; ++h)
#pragma unroll
            for (int i = 0; i < 2; ++i) ac[h][i] = an[h][i];
        if (wr == 1) PG8_BAR;
    }
    PG8_WAIT_V(0);
    PG8_BAR;
#undef PG8_SA
#undef PG8_SB
#undef PG8_STAGE
#undef PG8_RD32
#undef PG8_LDA
#undef PG8_LDB
#undef PG8_MMA
#undef PG8_WAIT_V
#undef PG8_WAIT_L
#undef PG8_BAR
#undef PG8_SCHED
#undef PG8_AOFF
#undef PG8_STAGE_A
}
}

namespace attn_body {
using bf16 = __hip_bfloat16;
using f32x16 = __attribute__((ext_vector_type(16))) float;
constexpr int D = 64, PQ = 3072, PO = 2048;
constexpr int NW = 8, QBLK = 32, QB = QBLK * NW, KVBLK = 64, NQB = SEQ / QB;
__device__ __forceinline__ int crow(int r, int hi) { return (r & 3) + 8 * (r >> 2) + 4 * hi; }
#define SBAR() __builtin_amdgcn_sched_barrier(0)
__device__ __forceinline__ void cmask(f32x16& p0, f32x16& p1, int jb, int qrel, int hi) {
    const float NEG = -INFINITY; int kb = 64 * jb + 4 * hi;
#pragma unroll
    for (int r = 0; r < 16; ++r) { int kv = kb + (r & 3) + 8 * (r >> 2); if (kv > qrel) p0[r] = NEG; if (kv + 32 > qrel) p1[r] = NEG; }
}
constexpr int NSLOT = 3, SLOTB = 8192;
constexpr int LDS_K = 0, LDS_V = NSLOT * SLOTB, LDS_WS = 2 * NSLOT * SLOTB, LDS_OST = LDS_WS + NW * 64 * 4, ATT_LDS_BYTES = LDS_OST + NW * 4096;
__device__ __forceinline__ void glds16(const void* gsrc, unsigned lds_dst) { unsigned keep;
    asm volatile("s_mov_b32 %0, m0\n\ts_mov_b32 m0, %2\n\ts_nop 0\n\tglobal_load_lds_dwordx4 %1, off\n\ts_mov_b32 m0, %0" : "=&s"(keep) : "v"(gsrc), "s"(lds_dst) : "memory"); }
__device__ __forceinline__ float max3f(float a, float b, float c) { float r; asm("v_max3_f32 %0, %1, %2, %3" : "=v"(r) : "v"(a), "v"(b), "v"(c)); return r; }
__device__ __forceinline__ float max2f(float a, float b) { float r; asm("v_max_f32_e32 %0, %1, %2" : "=v"(r) : "v"(a), "v"(b)); return r; }
__device__ __forceinline__ float fadd_s(float a, float b) { float r; asm("v_add_f32_e32 %0, %1, %2" : "=v"(r) : "v"(a), "v"(b)); return r; }
__device__ __forceinline__ float fsub_s(float a, float b) { float r; asm("v_sub_f32_e32 %0, %1, %2" : "=v"(r) : "v"(a), "v"(b)); return r; }
__device__ __forceinline__ unsigned cvtpk_s(float lo, float hi) { f32x2 v = {lo, hi}; bf16x2_t b = __builtin_convertvector(v, bf16x2_t); return __builtin_bit_cast(unsigned, b); }
#define WAIT_BAR(N) asm volatile("s_waitcnt vmcnt(" #N ") lgkmcnt(0)\n\ts_barrier" ::: "memory")
__device__ __forceinline__ void qkt(f32x16& p0, f32x16& p1, const char* Kslot, const bf16x8* qr, const f32x16& negm, int r32, int hi) {
    const char* kb = Kslot + hi * 1024 + r32 * 16;
#pragma unroll
    for (int d0 = 0; d0 < 4; ++d0) {
        const bf16x8 b0 = *reinterpret_cast<const bf16x8*>(kb + d0 * 2048);
        const bf16x8 b1 = *reinterpret_cast<const bf16x8*>(kb + d0 * 2048 + 512);
        if (d0 == 0) { p0 = __builtin_amdgcn_mfma_f32_32x32x16_bf16(b0, qr[0], negm, 0, 0, 0); p1 = __builtin_amdgcn_mfma_f32_32x32x16_bf16(b1, qr[0], negm, 0, 0, 0); }
        else { p0 = __builtin_amdgcn_mfma_f32_32x32x16_bf16(b0, qr[d0], p0, 0, 0, 0); p1 = __builtin_amdgcn_mfma_f32_32x32x16_bf16(b1, qr[d0], p1, 0, 0, 0); } }
}
typedef __attribute__((address_space(3))) const char* lds_cptr;
typedef short v4i16_t __attribute__((ext_vector_type(4)));
__device__ __forceinline__ void kload8(bf16x8* kf, lds_cptr kp) {
    kf[0] = *(const LAS bf16x8*)(kp);        kf[1] = *(const LAS bf16x8*)(kp + 512);
    kf[2] = *(const LAS bf16x8*)(kp + 2048); kf[3] = *(const LAS bf16x8*)(kp + 2560);
    kf[4] = *(const LAS bf16x8*)(kp + 4096); kf[5] = *(const LAS bf16x8*)(kp + 4608);
    kf[6] = *(const LAS bf16x8*)(kp + 6144); kf[7] = *(const LAS bf16x8*)(kp + 6656);
}
__device__ __forceinline__ void kload2(bf16x8* kf, lds_cptr kp, int j) { kf[2 * j] = *(const LAS bf16x8*)(kp + j * 2048); kf[2 * j + 1] = *(const LAS bf16x8*)(kp + j * 2048 + 512); }
__device__ __forceinline__ s16x4 vtr(lds_cptr p) { return __builtin_bit_cast(s16x4, __builtin_amdgcn_ds_read_tr16_b64_v4i16((LAS v4i16_t*)p)); }
__device__ __forceinline__ float rowmax(const f32x16& p0, const f32x16& p1) {
    float a = max3f(p0[0], p0[1], p1[0]), b = max3f(p0[2], p0[3], p1[1]); a = max3f(a, p1[2], p1[3]);
#pragma unroll
    for (int r = 4; r < 16; r += 4) { a = max3f(a, p0[r], p0[r + 1]); b = max3f(b, p0[r + 2], p0[r + 3]); a = max3f(a, p1[r], p1[r + 1]); b = max3f(b, p1[r + 2], p1[r + 3]); }
    const float m = max2f(a, b);
    auto rr = __builtin_amdgcn_permlane32_swap(__float_as_uint(m), __float_as_uint(m), false, false);
    return max2f(__uint_as_float(rr[0]), __uint_as_float(rr[1]));
}
__device__ __forceinline__ void pv(f32x16* o, int vb, bf16x8 pa0, bf16x8 pa1, bf16x8 pa2, bf16x8 pa3) {
#pragma unroll
    for (int d0 = 0; d0 < 2; ++d0) { s16x4 lo[4], hi[4];
#pragma unroll
        for (int ks = 0; ks < 4; ++ks) {
            asm volatile("ds_read_b64_tr_b16 %0,%1 offset:%c2" : "=&v"(lo[ks]) : "v"(vb), "i"(d0 * 4096 + ks * 1024) : "memory");
            asm volatile("ds_read_b64_tr_b16 %0,%1 offset:%c2" : "=&v"(hi[ks]) : "v"(vb), "i"(d0 * 4096 + ks * 1024 + 512) : "memory"); }
        asm volatile("s_waitcnt lgkmcnt(0)" ::: "memory"); SBAR();
#define PK(k) (bf16x8){lo[k][0], lo[k][1], lo[k][2], lo[k][3], hi[k][0], hi[k][1], hi[k][2], hi[k][3]}
        o[d0] = __builtin_amdgcn_mfma_f32_32x32x16_bf16(pa0, PK(0), o[d0], 0, 0, 0);
        o[d0] = __builtin_amdgcn_mfma_f32_32x32x16_bf16(pa1, PK(1), o[d0], 0, 0, 0);
        o[d0] = __builtin_amdgcn_mfma_f32_32x32x16_bf16(pa2, PK(2), o[d0], 0, 0, 0);
        o[d0] = __builtin_amdgcn_mfma_f32_32x32x16_bf16(pa3, PK(3), o[d0], 0, 0, 0);
#undef PK
    }
}
#define ATTN_STORE16(p, v) (*(u32x4*)(p) = (v))
template <int THRL> __device__ __forceinline__ void attn_unit(int wv, int pair, int qb, const bf16* Pb, bf16* Obuf, char* shm) {
    const int b = pair >> 5, v5 = pair & 31, hc = v5 >> 1; const int qc = hc * 64, kc = 1024 + hc * 64, vc = 2048 + (v5 >> 2) * 128 + (v5 & 1) * 64, oc = v5 * 64;
    int tid = wv * 64 + lane_id(); asm volatile("" : "+v"(tid));
    const int lane = tid & 63, r32 = lane & 31, hi = lane >> 5; const int wid = wv;
    const long rowbase = (long)b * SEQ; const int q0 = qb * QB;
    const bf16* Qw = Pb + (rowbase + q0 + wid * QBLK) * PQ + qc;
    const bf16* Kh = Pb + rowbase * PQ + kc, *Vh = Pb + rowbase * PQ + vc;
    const unsigned lds0 = (unsigned)(uintptr_t)shm;
    float* wsf = (float*)(shm + LDS_WS) + wid * 64;
    const bf16* ksrc = Kh + (long)lane * PQ + wid * 8;
    const bf16* vsrc = Vh + (long)(16 * (wid & 3) + (lane >> 2)) * PQ + (wid >> 2) * 32 + (lane & 3) * 8;
    const unsigned kdst = lds0 + LDS_K + wid * 1024, vdst = lds0 + LDS_V + wid * 1024;
#define DMA_K(t, slot) glds16(ksrc + (long)(t) * KVBLK * PQ, (unsigned)__builtin_amdgcn_readfirstlane(kdst + (slot)))
#define DMA_V(t, slot) glds16(vsrc + (long)(t) * KVBLK * PQ, (unsigned)__builtin_amdgcn_readfirstlane(vdst + (slot)))
    const int vb0 = (int)(lds0 + LDS_V) + ((lane >> 4) & 1) * 32 + (lane & 3) * 8 + (4 * hi + ((lane & 15) >> 2)) * 64;
    const char* Kbase = shm + LDS_K; bf16x8 kf[8];
    const lds_cptr shm3 = (lds_cptr)shm; const lds_cptr kp0 = shm3 + LDS_K + hi * 1024 + r32 * 16; const lds_cptr vp0 = shm3 + LDS_V + ((lane >> 4) & 1) * 32 + (lane & 3) * 8 + (4 * hi + ((lane & 15) >> 2)) * 64;
    const int NT = (q0 + QB) / KVBLK;
    DMA_K(0, 0); DMA_V(0, 0); DMA_K(1, SLOTB);
    bf16x8 qr[4];
#pragma unroll
    for (int d0 = 0; d0 < 4; ++d0) qr[d0] = *reinterpret_cast<const bf16x8*>(&Qw[(long)r32 * PQ + d0 * 16 + hi * 8]);
    float mhat = 0.f, l_reg = 0.f; f32x16 o[2]; o[0] = f32x16{}; o[1] = f32x16{}; f32x16 negm = f32x16{}; asm volatile("" : "+v"(negm));
    const int qrel = wid * QBLK + r32;
#define CMASK(P0, P1, t) do { int jb_ = (t) - (NT - 4); if (jb_ >= 0) cmask(P0, P1, jb_, qrel, hi); } while (0)
    bool resc = false;
#define START(P0, P1) do { const float rm = rowmax(P0, P1); resc = false; \
    { const float dl = rm; mhat = fadd_s(mhat, dl); \
      _Pragma("unroll") for (int r = 0; r < 16; ++r) { P0[r] = fsub_s(P0[r], dl); P1[r] = fsub_s(P1[r], dl); } \
      _Pragma("unroll") for (int r = 0; r < 16; ++r) negm[r] = -mhat; asm volatile("" : "+v"(negm)); } \
    _Pragma("unroll") for (int r = 0; r < 16; ++r) P0[r] = __builtin_amdgcn_exp2f(P0[r]); } while (0)
#define RESC() do { if (resc) { asm volatile("s_waitcnt lgkmcnt(0)" ::: "memory"); \
      _Pragma("unroll") for (int d_ = 0; d_ < 2; ++d_) _Pragma("unroll") for (int r = 0; r < 16; ++r) o[d_][r] *= wsf[crow(r, hi)]; } } while (0)
    f32x16 pA0, pA1, pB0, pB1;
    int sl_prev = 0, sl_cur = 0, sl_next = SLOTB;
#define ROT() do { sl_prev = sl_cur; sl_cur = sl_next; sl_next = (sl_next == (NSLOT - 1) * SLOTB) ? 0 : sl_next + SLOTB; } while (0)
    DMA_K(2, 2 * SLOTB);
    WAIT_BAR(3);
    qkt(pA0, pA1, Kbase, qr, negm, r32, hi); asm volatile("s_nop 15\n\ts_nop 7" : "+v"(pA0), "+v"(pA1)); CMASK(pA0, pA1, 0);
    START(pA0, pA1);
    _Pragma("unroll") for (int r = 0; r < 16; ++r) pA1[r] = __builtin_amdgcn_exp2f(pA1[r]);
    WAIT_BAR(0);
    DMA_K(3, 0); DMA_V(1, SLOTB);
    ROT();
    kload8(kf, kp0 + sl_cur);
    WAIT_BAR(2);
    s16x4 vlo[8], vhi[8]; u32x4 pw0, pw1, pw2, pw3;
#define PKW(P, B) cvtpk_s(P[B], P[B + 1])
#define PAF(k) __builtin_bit_cast(bf16x8, pw##k)
#define VFR(i) (bf16x8){vlo[i][0], vlo[i][1], vlo[i][2], vlo[i][3], vhi[i][0], vhi[i][1], vhi[i][2], vhi[i][3]}
#define PIN(x) asm volatile("" : "+v"(x))
#define MX3(a, b, c) __builtin_fmaxf(__builtin_fmaxf((a), (b)), (c))
#define GAPA(MF, A0, A1, A2, A3, W0, W1, PW) do { MF; sacc += A0; sacc += A1; sacc += A2; sacc += A3; PIN(sacc); W0; W1; PIN(PW); SBAR(); } while (0)
#define EX(v) __builtin_amdgcn_exp2f(v)
#define GAPB(MF, X, B) do { MF; X[B] = EX(X[B]); X[B + 1] = EX(X[B + 1]); X[B + 2] = EX(X[B + 2]); X[B + 3] = EX(X[B + 3]); PIN(X); SBAR(); } while (0)
#define VRD(i) do { vlo[i] = vtr(vp_ + (((i) >> 2) * 4096 + ((i) & 3) * 1024)); vhi[i] = vtr(vp_ + (((i) >> 2) * 4096 + ((i) & 3) * 1024 + 512)); } while (0)
#define KRD(G, j) do { if (G) { kload2(kf, kp0 + sl_next, j); SBAR(); } } while (0)
#define STEP(C0, C1, P0, P1, t, GK, GV, GL) do { SBAR(); \
    const lds_cptr vp_ = vp0 + sl_prev; \
    VRD(0); SBAR(); float sacc = (P0[0] + P0[1]); \
    GAPA(C0 = __builtin_amdgcn_mfma_f32_32x32x16_bf16(kf[0], qr[0], negm, 0, 0, 0), P0[2], P0[3], P0[4], P0[5],     pw0[0] = PKW(P0, 0), pw0[1] = PKW(P0, 2), pw0); \
    VRD(4); SBAR(); GAPA(C1 = __builtin_amdgcn_mfma_f32_32x32x16_bf16(kf[1], qr[0], negm, 0, 0, 0), P0[6], P0[7], P0[8], P0[9],     pw0[2] = PKW(P0, 4), pw0[3] = PKW(P0, 6), pw0); \
    VRD(1); SBAR(); GAPA(C0 = __builtin_amdgcn_mfma_f32_32x32x16_bf16(kf[2], qr[1], C0, 0, 0, 0),   P0[10], P0[11], P0[12], P0[13], pw1[0] = PKW(P0, 8), pw1[1] = PKW(P0, 10), pw1); \
    VRD(5); SBAR(); GAPA(C1 = __builtin_amdgcn_mfma_f32_32x32x16_bf16(kf[3], qr[1], C1, 0, 0, 0),   P0[14], P0[15], P1[0], P1[1],   pw1[2] = PKW(P0, 12), pw1[3] = PKW(P0, 14), pw1); \
    VRD(2); SBAR(); GAPA(C0 = __builtin_amdgcn_mfma_f32_32x32x16_bf16(kf[4], qr[2], C0, 0, 0, 0),   P1[2], P1[3], P1[4], P1[5],     pw2[0] = PKW(P1, 0), pw2[1] = PKW(P1, 2), pw2); \
    VRD(6); SBAR(); GAPA(C1 = __builtin_amdgcn_mfma_f32_32x32x16_bf16(kf[5], qr[2], C1, 0, 0, 0),   P1[6], P1[7], P1[8], P1[9],     pw2[2] = PKW(P1, 4), pw2[3] = PKW(P1, 6), pw2); \
    VRD(3); SBAR(); GAPA(C0 = __builtin_amdgcn_mfma_f32_32x32x16_bf16(kf[6], qr[3], C0, 0, 0, 0),   P1[10], P1[11], P1[12], P1[13], pw3[0] = PKW(P1, 8), pw3[1] = PKW(P1, 10), pw3); \
    VRD(7); SBAR(); GAPA(C1 = __builtin_amdgcn_mfma_f32_32x32x16_bf16(kf[7], qr[3], C1, 0, 0, 0),   P1[14], P1[15], 0.f, 0.f,       pw3[2] = PKW(P1, 12), pw3[3] = PKW(P1, 14), pw3); \
    l_reg += sacc; \
    if (GK) { DMA_K((t) + 3, sl_cur); } if (GV) { DMA_V((t) + 1, sl_next); } \
    CMASK(C0, C1, t); \
    { float a = MX3(C0[0], C0[1], C1[0]), b = MX3(C0[2], C0[3], C1[1]); a = MX3(a, C1[2], C1[3]); \
      _Pragma("unroll") for (int r = 4; r < 16; r += 4) { a = MX3(a, C0[r], C0[r + 1]); b = MX3(b, C0[r + 2], C0[r + 3]); a = MX3(a, C1[r], C1[r + 1]); b = MX3(b, C1[r + 2], C1[r + 3]); } \
      float rm = __builtin_fmaxf(a, b); { auto rr = __builtin_amdgcn_permlane32_swap(__float_as_uint(rm), __float_as_uint(rm), false, false); rm = __builtin_fmaxf(__uint_as_float(rr[0]), __uint_as_float(rr[1])); } \
      resc = false; \
      if (__builtin_expect(__any(rm > (float)THRL), 0)) { const float dl = __builtin_fmaxf(rm, 0.f); mhat += dl; \
        _Pragma("unroll") for (int r = 0; r < 16; ++r) { C0[r] -= dl; C1[r] -= dl; } \
        _Pragma("unroll") for (int r = 0; r < 16; ++r) negm[r] = -mhat; asm volatile("" : "+v"(negm)); \
        const float f = __builtin_amdgcn_exp2f(-dl); l_reg *= f; if (hi == 0) wsf[r32] = f; resc = true; } } \
    SBAR(); \
    GAPB(o[0] = __builtin_amdgcn_mfma_f32_32x32x16_bf16(PAF(0), VFR(0), o[0], 0, 0, 0), C0, 0); \
    GAPB(o[1] = __builtin_amdgcn_mfma_f32_32x32x16_bf16(PAF(0), VFR(4), o[1], 0, 0, 0), C0, 4); \
    KRD(GL, 0); GAPB(o[0] = __builtin_amdgcn_mfma_f32_32x32x16_bf16(PAF(1), VFR(1), o[0], 0, 0, 0), C0, 8); \
    KRD(GL, 1); GAPB(o[1] = __builtin_amdgcn_mfma_f32_32x32x16_bf16(PAF(1), VFR(5), o[1], 0, 0, 0), C0, 12); \
    KRD(GL, 2); GAPB(o[0] = __builtin_amdgcn_mfma_f32_32x32x16_bf16(PAF(2), VFR(2), o[0], 0, 0, 0), C1, 0); \
    KRD(GL, 3); GAPB(o[1] = __builtin_amdgcn_mfma_f32_32x32x16_bf16(PAF(2), VFR(6), o[1], 0, 0, 0), C1, 4); \
    GAPB(o[0] = __builtin_amdgcn_mfma_f32_32x32x16_bf16(PAF(3), VFR(3), o[0], 0, 0, 0), C1, 8); \
    GAPB(o[1] = __builtin_amdgcn_mfma_f32_32x32x16_bf16(PAF(3), VFR(7), o[1], 0, 0, 0), C1, 12); \
    } while (0)
    int t = 1;
#undef CMASK
#define CMASK(P0, P1, t) do {} while (0)
    for (; t + 5 < NT; t += 2) {
        STEP(pB0, pB1, pA0, pA1, t, true, true, true);     WAIT_BAR(2); RESC(); ROT();
        STEP(pA0, pA1, pB0, pB1, t + 1, true, true, true); WAIT_BAR(2); RESC(); ROT();
    }
#undef CMASK
#define CMASK(P0, P1, t) do { int jb_ = (t) - (NT - 4); if (jb_ >= 0) cmask(P0, P1, jb_, qrel, hi); } while (0)
#define ENDW(tt) do { if ((tt) + 3 < NT) { WAIT_BAR(2); } else if ((tt) + 2 < NT) { WAIT_BAR(1); } else { WAIT_BAR(0); } } while (0)
    for (; t + 1 < NT; t += 2) {
        STEP(pB0, pB1, pA0, pA1, t, (t + 3 < NT), (t + 1 < NT), (t + 1 < NT));         ENDW(t);     RESC(); ROT();
        STEP(pA0, pA1, pB0, pB1, t + 1, (t + 4 < NT), (t + 2 < NT), (t + 2 < NT));     ENDW(t + 1); RESC(); ROT();
    }
    STEP(pB0, pB1, pA0, pA1, NT - 1, false, false, false); RESC();
    { float sacc = pB0[0] + pB0[1]; _Pragma("unroll") for (int r = 2; r < 16; ++r) sacc += pB0[r]; _Pragma("unroll") for (int r = 0; r < 16; ++r) sacc += pB1[r]; l_reg += sacc;
      pw0 = (u32x4){PKW(pB0, 0), PKW(pB0, 2), PKW(pB0, 4), PKW(pB0, 6)}; pw1 = (u32x4){PKW(pB0, 8), PKW(pB0, 10), PKW(pB0, 12), PKW(pB0, 14)}; pw2 = (u32x4){PKW(pB1, 0), PKW(pB1, 2), PKW(pB1, 4), PKW(pB1, 6)}; pw3 = (u32x4){PKW(pB1, 8), PKW(pB1, 10), PKW(pB1, 12), PKW(pB1, 14)};
      SBAR(); pv(o, vb0 + sl_cur, PAF(0), PAF(1), PAF(2), PAF(3)); }
#undef PKW
#undef PAF
#undef VFR
#undef PIN
#undef MX3
#undef GAPA
#undef GAPB
#undef EX
#undef VRD
#undef KRD
#undef STEP
#undef ENDW
    { auto rr = __builtin_amdgcn_permlane32_swap(__float_as_uint(l_reg), __float_as_uint(l_reg), false, false); l_reg = __uint_as_float(rr[0]) + __uint_as_float(rr[1]); }
    if (hi == 0) wsf[32 + r32] = l_reg; asm volatile("s_waitcnt lgkmcnt(0)" ::: "memory");
    float rli[16];
#pragma unroll
    for (int r = 0; r < 16; ++r) rli[r] = __builtin_amdgcn_rcpf(wsf[32 + crow(r, hi)]);
    bf16* Ow = Obuf + (rowbase + q0 + wid * QBLK) * PO + oc;
    { bf16* stg = (bf16*)(shm + LDS_OST) + wid * 2048;
#pragma unroll
      for (int r = 0; r < 16; ++r) { const int orow = crow(r, hi);
#pragma unroll
        for (int d0 = 0; d0 < 2; ++d0) stg[orow * 64 + d0 * 32 + r32] = __float2bfloat16(o[d0][r] * rli[r]); }
      asm volatile("s_waitcnt lgkmcnt(0)" ::: "memory");
#pragma unroll
      for (int i = 0; i < 4; ++i) { const int row = i * 8 + (lane >> 3), ch = lane & 7; const u32x4 v = *(const u32x4*)(stg + row * 64 + ch * 8); ATTN_STORE16(Ow + (long)row * PO + ch * 8, v); } }
    asm volatile("s_waitcnt lgkmcnt(0)\n\ts_barrier" ::: "memory");
#undef DMA_K
#undef DMA_V
#undef CMASK
#undef START
#undef RESC
#undef ROT
}
#undef SBAR
#undef WAIT_BAR
}


namespace at2 {
using f32x16 = __attribute__((ext_vector_type(16))) float;
constexpr int PQ = 3072, PO = 256, DV = 128, DQ = 64;
constexpr int NW = 8, QBLK = 32, KVBLK = 64, QB = NW * QBLK;
constexpr int SHM_V = KVBLK * DV * 2, SHM_K = KVBLK * DQ * 2;
constexpr int OFF_VL = 0, OFF_KL = 2 * SHM_V, OFF_WS = 2 * SHM_V + 2 * SHM_K;
constexpr int OFF_OL = OFF_WS + 2048, OL_RS = 272, OL_WAVE = QBLK * OL_RS;
constexpr float THR2 = 8.f;
#define KSWZ64(row, colB) ((row) * 128 + ((colB) ^ (((row) & 7) << 4)))
#define SBAR() __builtin_amdgcn_sched_barrier(0)
__device__ __forceinline__ int v_st(int k, int c) { const int kk = (k & ~0xC) | ((k & 4) << 1) | ((k & 8) >> 1); return ((kk >> 3) * 4 + (c >> 5)) * 512 + ((kk & 7) * 32 + (c & 31)) * 2; }
__device__ __forceinline__ int v_rd_base(int lane) { return ((lane & 3) << 3) | (((lane >> 2) & 3) << 6) | (((lane >> 4) & 1) << 5) | (((lane >> 5) & 1) << 8); }
constexpr int v_rd_off(int d0, int ks, int half) { return d0 * 512 + ks * 4096 + half * 2048; }
__device__ __forceinline__ int crow(int r, int hi) { return (r & 3) + 8 * (r >> 2) + 4 * hi; }
__device__ __forceinline__ bf16x8 load8(const bf16_t* p) { return *reinterpret_cast<const bf16x8*>(p); }
__device__ __forceinline__ void mask_tile(f32x16& p0, f32x16& p1, int dq) {
    const float NEG = -__builtin_inff();
#pragma unroll
    for (int r = 0; r < 16; ++r) { const int c = (r & 3) + 8 * (r >> 2); if (dq - c < 0) p0[r] = NEG; if (dq - c - 32 < 0) p1[r] = NEG; }
}
__device__ __forceinline__ void partialSM(f32x16& p0, f32x16& p1, float& m_reg, float& mn, float& alpha) {
    float pmax = p0[0];
#pragma unroll
    for (int r = 1; r < 16; ++r) pmax = fmaxf(pmax, p0[r]);
#pragma unroll
    for (int r = 0; r < 16; ++r) pmax = fmaxf(pmax, p1[r]);
    { auto rr = __builtin_amdgcn_permlane32_swap(__float_as_uint(pmax), __float_as_uint(pmax), false, false); pmax = fmaxf(__uint_as_float(rr[0]), __uint_as_float(rr[1])); }
    if (__builtin_expect(__all((pmax - m_reg) <= THR2), 1)) { mn = m_reg; alpha = 1.f; }
    else { mn = fmaxf(m_reg, pmax); alpha = __builtin_amdgcn_exp2f(m_reg - mn); m_reg = mn; }
#pragma unroll
    for (int r = 0; r < 16; ++r) { p0[r] = p0[r] - mn; p1[r] = p1[r] - mn; }
#pragma unroll
    for (int r = 0; r < 16; ++r) p0[r] = __builtin_amdgcn_exp2f(p0[r]);
}
__device__ __forceinline__ void finishSM(f32x16& p0, f32x16& p1, float alpha, float& l_reg, bf16x8& pa0, bf16x8& pa1, bf16x8& pa2, bf16x8& pa3) {
#pragma unroll
    for (int r = 0; r < 16; ++r) p1[r] = __builtin_amdgcn_exp2f(p1[r]);
    float ps = 0;
#pragma unroll
    for (int r = 0; r < 16; ++r) ps += p0[r];
#pragma unroll
    for (int r = 0; r < 16; ++r) ps += p1[r];
    { auto rr = __builtin_amdgcn_permlane32_swap(__float_as_uint(ps), __float_as_uint(ps), false, false); ps = __uint_as_float(rr[0]) + __uint_as_float(rr[1]); }
    l_reg = l_reg * alpha + ps;
#define PK4(P, B_, OUT) do { unsigned a0 = cvtpk(P[B_+0], P[B_+1]), a1 = cvtpk(P[B_+2], P[B_+3]);                          \
        unsigned b0 = cvtpk(P[B_+4], P[B_+5]), b1 = cvtpk(P[B_+6], P[B_+7]);                                             \
        auto r0 = __builtin_amdgcn_permlane32_swap(a0, b0, false, false); auto r1 = __builtin_amdgcn_permlane32_swap(a1, b1, false, false); \
        u32x4 w = {r0[0], r1[0], r0[1], r1[1]}; OUT = *reinterpret_cast<bf16x8*>(&w); } while (0)
    PK4(p0, 0, pa0); PK4(p0, 8, pa1); PK4(p1, 0, pa2); PK4(p1, 8, pa3);
#undef PK4
}
template <int KB>
__device__ __forceinline__ void qkt(f32x16& p0, f32x16& p1, const char* K_lds, int r32, int hi, const bf16x8* qr) {
    p0 = f32x16{}; p1 = f32x16{};
#pragma unroll
    for (int d0 = 0; d0 < 4; ++d0) { const char* a = K_lds + KB * SHM_K + KSWZ64(r32, (d0 * 16 + hi * 8) * 2);
        bf16x8 b0 = *reinterpret_cast<const bf16x8*>(a);
        bf16x8 b1 = *reinterpret_cast<const bf16x8*>(a + 32 * 128);
        p0 = __builtin_amdgcn_mfma_f32_32x32x16_bf16(b0, qr[d0], p0, 0, 0, 0);
        p1 = __builtin_amdgcn_mfma_f32_32x32x16_bf16(b1, qr[d0], p1, 0, 0, 0); }
}
template <int VB>
__device__ __forceinline__ void pv_tile(f32x16* o, int vb0, bf16x8 pa0, bf16x8 pa1, bf16x8 pa2, bf16x8 pa3) {
#define TRRD(dst, off) asm volatile("ds_read_b64_tr_b16 %0, %1 offset:%2" : "=&v"(dst) : "v"(vb0), "i"(off) : "memory")
#define PV_D0(d0) do { s16x4 l0, l1, l2, l3, h0, h1, h2, h3; constexpr int b_ = VB * SHM_V + v_rd_off(d0, 0, 0); \
        TRRD(l0, b_); TRRD(h0, b_ + 2048); TRRD(l1, b_ + 4096); TRRD(h1, b_ + 6144); TRRD(l2, b_ + 8192); TRRD(h2, b_ + 10240); TRRD(l3, b_ + 12288); TRRD(h3, b_ + 14336); \
        asm volatile("s_waitcnt lgkmcnt(0)" ::: "memory"); SBAR();   \
        o[d0] = __builtin_amdgcn_mfma_f32_32x32x16_bf16(pa0, (bf16x8){l0[0], l0[1], l0[2], l0[3], h0[0], h0[1], h0[2], h0[3]}, o[d0], 0, 0, 0);   \
        o[d0] = __builtin_amdgcn_mfma_f32_32x32x16_bf16(pa1, (bf16x8){l1[0], l1[1], l1[2], l1[3], h1[0], h1[1], h1[2], h1[3]}, o[d0], 0, 0, 0);   \
        o[d0] = __builtin_amdgcn_mfma_f32_32x32x16_bf16(pa2, (bf16x8){l2[0], l2[1], l2[2], l2[3], h2[0], h2[1], h2[2], h2[3]}, o[d0], 0, 0, 0);   \
        o[d0] = __builtin_amdgcn_mfma_f32_32x32x16_bf16(pa3, (bf16x8){l3[0], l3[1], l3[2], l3[3], h3[0], h3[1], h3[2], h3[3]}, o[d0], 0, 0, 0); } while (0)
    PV_D0(0); PV_D0(1); PV_D0(2); PV_D0(3);
#undef PV_D0
#undef TRRD
}
struct BlockRef { const bf16_t* Q; const bf16_t* K; const bf16_t* V; int P0; int to_lds; float lam; };
struct Seam { bf16x8 qr[4]; bf16x8 st_v0, st_v1, st_k0; };
#define VMW() asm volatile("s_waitcnt vmcnt(0)" ::: "memory")
#define VMWN(n) asm volatile("s_waitcnt vmcnt(%0)" :: "i"(n) : "memory")
#define SLOAD_H(Kp, Vp, k0) do { S.st_v0 = load8((Vp) + (size_t)((k0) + sr) * PQ + sc); S.st_v1 = load8((Vp) + (size_t)((k0) + 32 + sr) * PQ + sc); \
                                 S.st_k0 = load8((Kp) + (size_t)((k0) + kr) * PQ + kc); } while (0)
#define SWRITE_HK(bf) do { *(bf16x8*)(K_lds + (bf) * SHM_K + kws) = S.st_k0; } while (0)
#define SWRITE_HV(bf) do { *(bf16x8*)(V_lds + (bf) * SHM_V + vst0) = S.st_v0; *(bf16x8*)(V_lds + (bf) * SHM_V + vst1) = S.st_v1; } while (0)
#define SWRITE_H(bf) do { SWRITE_HV(bf); SWRITE_HK(bf); } while (0)
__device__ __forceinline__ void prime(const BlockRef& cur, char* lds, Seam& S, int tid, int wid) {
    const int lane = tid & 63, r32 = lane & 31, hi = lane >> 5;
    const int sr = tid >> 4, sc = (tid & 15) * 8, kr = tid >> 3, kc = (tid & 7) * 8, kws = KSWZ64(kr, kc * 2); char* K_lds = lds + OFF_KL;
#pragma unroll
    for (int d0 = 0; d0 < 4; ++d0) S.qr[d0] = load8(cur.Q + (size_t)(wid * QBLK + r32) * PQ + d0 * 16 + hi * 8);
    SLOAD_H(cur.K, cur.V, 0); VMW(); SWRITE_HK(0);
    __syncthreads();
}
__device__ __forceinline__ void block(const BlockRef& cur, const BlockRef& nxt, char* lds, Seam& S, int tid, int wid) {
    asm volatile("" : "+v"(tid));
    const int lane = tid & 63, r32 = lane & 31, hi = lane >> 5;
    const int NT = (cur.P0 + QB - 1) / KVBLK + 1;
    const int qlo = cur.P0 + wid * QBLK, qm = qlo + r32 - 4 * hi;
    char* V_lds = lds + OFF_VL; char* K_lds = lds + OFF_KL;
    float* ws = (float*)(lds + OFF_WS) + wid * 64; float* li_l = ws, * al_l = ws + 32;
    float m_reg = -1e30f, l_reg = 0; f32x16 o[4] = {};
    const int sr = tid >> 4, sc = (tid & 15) * 8, vst0 = v_st(sr, sc), vst1 = v_st(32 + sr, sc), kr = tid >> 3, kc = (tid & 7) * 8, kws = KSWZ64(kr, kc * 2);
    const int vb0 = (int)(uintptr_t)V_lds + v_rd_base(lane);
    const bf16_t* Kh = cur.K; const bf16_t* Vh = cur.V;
#define RESC(a) do { if (__any((a) < 1.f)) { if (hi == 0) al_l[r32] = (a); asm volatile("s_waitcnt lgkmcnt(0)" ::: "memory");              \
                     _Pragma("unroll") for (int d_ = 0; d_ < 4; ++d_) _Pragma("unroll") for (int r = 0; r < 16; ++r) o[d_][r] *= al_l[crow(r, hi)]; } } while (0)
#define KBASE(t) ((t) * KVBLK)
#define MASKT(P0_, P1_, t) do { const int kb_ = KBASE(t); if (kb_ + KVBLK - 1 > qlo) mask_tile(P0_, P1_, qm - kb_); } while (0)
#define SEAM_K0() do { VMWN(4); SWRITE_HK(0); SBAR(); } while (0)
    f32x16 pA0, pA1, pB0, pB1; float mnA, mnB, alA, alB; bf16x8 pa0, pa1, pa2, pa3;
    SWRITE_HV(0); SBAR();
    if (NT > 1) SLOAD_H(Kh, Vh, KBASE(1));
    SBAR(); qkt<0>(pA0, pA1, K_lds, r32, hi, S.qr);
    MASKT(pA0, pA1, 0); partialSM(pA0, pA1, m_reg, mnA, alA);
    if (NT > 1) { VMW(); SWRITE_H(1); }
    __syncthreads();
#define HALF_STEP(PX0, PX1, mnX, alX, PY0, PY1, alY, t, KB, VB, SB) do {                                                      \
        SBAR(); qkt<KB>(PX0, PX1, K_lds, r32, hi, S.qr);                                                                      \
        finishSM(PY0, PY1, alY, l_reg, pa0, pa1, pa2, pa3); SBAR();                                                           \
        if ((t) + 1 < NT) { SLOAD_H(Kh, Vh, KBASE((t) + 1)); SBAR(); }                                                        \
        pv_tile<VB>(o, vb0, pa0, pa1, pa2, pa3); MASKT(PX0, PX1, (t)); partialSM(PX0, PX1, m_reg, mnX, alX);                 \
        __syncthreads();                                                                                                      \
        if ((t) + 1 < NT) { VMW(); SWRITE_H(SB); }                                                                            \
        RESC(alX); __syncthreads(); } while (0)
    for (int t = 1; t + 1 < NT; t += 2) {
        HALF_STEP(pB0, pB1, mnB, alB, pA0, pA1, alA, t, 1, 0, 0);
        HALF_STEP(pA0, pA1, mnA, alA, pB0, pB1, alB, t + 1, 0, 1, 1);
    }
    const bool even = wid >= 6;
    if (even) { SBAR(); qkt<1>(pB0, pB1, K_lds, r32, hi, S.qr); SBAR(); }
    SLOAD_H(nxt.K, nxt.V, 0); SBAR();
#pragma unroll
    for (int d0 = 0; d0 < 4; ++d0) S.qr[d0] = load8(nxt.Q + (size_t)(wid * QBLK + r32) * PQ + d0 * 16 + hi * 8);
    SBAR();
    finishSM(pA0, pA1, alA, l_reg, pa0, pa1, pa2, pa3); SBAR();
    pv_tile<0>(o, vb0, pa0, pa1, pa2, pa3);
    if (even) { MASKT(pB0, pB1, NT - 1); partialSM(pB0, pB1, m_reg, mnB, alB); __syncthreads(); RESC(alB);
        finishSM(pB0, pB1, alB, l_reg, pa0, pa1, pa2, pa3); SBAR(); pv_tile<1>(o, vb0, pa0, pa1, pa2, pa3); }
    else __syncthreads();
    SBAR(); SEAM_K0();
    if (hi == 0) li_l[r32] = l_reg; asm volatile("s_waitcnt lgkmcnt(0)" ::: "memory");
    float rli[16];
#pragma unroll
    for (int r = 0; r < 16; ++r) rli[r] = __builtin_amdgcn_rcpf(li_l[crow(r, hi)]);
    { char* Ol = lds + OFF_OL + wid * OL_WAVE;
      if (!cur.to_lds) {
#pragma unroll
          for (int d0 = 0; d0 < 4; ++d0)
#pragma unroll
              for (int hq = 0; hq < 2; ++hq) { u32x4 wv_;
#pragma unroll
                  for (int q = 0; q < 4; ++q) { const int r = hq * 8 + q * 2; wv_[q] = cvtpk(o[d0][r] * rli[r], o[d0][r + 1] * rli[r + 1]); }
                  *(u32x4*)(Ol + ((d0 * 2 + hq) * 64 + lane) * 16) = wv_; }
      } else {
          u32x4 o1w[8];
#pragma unroll
          for (int i = 0; i < 8; ++i) o1w[i] = *(const u32x4*)(Ol + (i * 64 + lane) * 16);
          asm volatile("s_waitcnt lgkmcnt(0)" ::: "memory");
#pragma unroll
          for (int r = 0; r < 16; ++r) { const int orow = crow(r, hi);
#pragma unroll
              for (int d0 = 0; d0 < 4; ++d0) { const unsigned w1 = o1w[d0 * 2 + (r >> 3)][(r & 7) >> 1]; const float o1v = (r & 1) ? bfhi(w1) : bflo(w1);
                  const float v = o1v - cur.lam * (o[d0][r] * rli[r]); const float vn = sx<1>(v);
                  if ((r32 & 1) == 0) *(unsigned*)(Ol + orow * OL_RS + (d0 * 32 + r32) * 2) = cvtpk(v, vn); } } } }
    asm volatile("s_waitcnt lgkmcnt(0)\n\ts_barrier" ::: "memory");
#undef RESC
#undef KBASE
#undef MASKT
#undef SEAM_K0
#undef HALF_STEP
}
#undef VMW
#undef VMWN
#undef SLOAD_H
#undef SWRITE_HK
#undef SWRITE_HV
#undef SWRITE_H
#undef SBAR
#undef KSWZ64
}

struct Params {
    const float* x; const float* c; const int* positions; const float* norm1; const float* norm2; const float* w_ada; const float* b_ada;
    const float* a_w_in; const float* a_b_if; const float* a_h_norm; const float* a_w_out;
    const float* b_w_in; const float* b_q_norm; const float* b_k_norm; const float* b_lam_q1; const float* b_lam_k1; const float* b_lam_q2; const float* b_lam_k2;
    const float* b_o_norm; const float* b_w_out; const float* w_router; const float* router_bias; const float* moe_w_gu; const float* moe_w_down;
    float* out; unsigned char* ws;
};
struct Frame { LAS unsigned char* lds; int tid, lane, wave, G, bid, vcu; };
__device__ __forceinline__ Frame make_frame(unsigned char* lds, int wv) {
    Frame F; F.lds = (LAS unsigned char*)lds; int t = wv * 64 + lane_id(); asm volatile("" : "+v"(t)); F.tid = t; F.lane = t & 63; F.wave = wv;
    F.G = gridDim.x; F.bid = blockIdx.x; F.vcu = (F.G % 8 == 0) ? (F.bid % 8) * (F.G / 8) + F.bid / 8 : F.bid; return F;
}

struct WItem { const float* W; unsigned char* WT; float* cs; int ldw, Kr, drow0, n0, mode; float s8; };
constexpr int NW_ITEMS = ((WQ_IN0 == 2) ? 48 : 0) + ((WQ_OUT0 == 2) ? 16 : 0) + ((WQ_OUT1 == 2) ? 16 : 0);
__device__ __forceinline__ WItem decode_witem(int it, const Params& p) {
    float* cw = (float*)(p.ws + SC_CW);
    if (WQ_IN0 == 2) { if (it < 48) { const int nb = it; return WItem{p.a_w_in, p.ws + WS_WAIN, cw + CW_AIN, 3080, 1024, 64 * nb, 64 * nb, 2, 0.f}; } it -= 48; }
    if (WQ_OUT0 == 2) { if (it < 16) { const int nb = it; return WItem{p.a_w_out, p.ws + WS_WAOUT, cw + CW_AOUT, 1024, 1024, 64 * nb, 64 * nb, 2, 0.f}; } it -= 16; }
    { const int nb = it; return WItem{p.b_w_out, p.ws + WS_WBOUT, cw + CW_BOUT, 1024, 1024, 64 * nb, 64 * nb, 2, 0.f}; }
}
__device__ __forceinline__ int witem_owner(int it, int G) { return (G == 256) ? 192 + (it & 63) : it % G; }
struct TItem { const float* W; bf16_t* WT; int ldw, K, drow0, k0, n0; float s8; };
__device__ __forceinline__ TItem decode_item(int it, const Params& p) {
    constexpr int I0 = (WQ_IN0 == 2) ? 0 : 16 * 48, I1 = (WQ_OUT0 == 2) ? 0 : 16 * 16, I2 = 16 * 48, I3 = (WQ_OUT1 == 2) ? 0 : 16 * 16, I4 = 32 * 256;
    TItem t; int r = it;
    if (r < I0) { const int kb = r / 48, nb = r % 48; t = (WQ_IN0 == 1) ? TItem{p.a_w_in, (bf16_t*)(p.ws + WS_WAIN), 3080, 1024, 64 * nb, 64 * kb, 64 * nb, S8_WIN} : TItem{p.a_w_in, (bf16_t*)(p.ws + WS_WAIN_BF), 3080, 1024, 64 * nb, 64 * kb, 64 * nb, 0.f}; return t; } r -= I0;
    if (r < I1) { const int kb = r / 16, nb = r % 16; t = (WQ_OUT0 == 1) ? TItem{p.a_w_out, (bf16_t*)(p.ws + WS_WAOUT), 1024, 1024, 64 * nb, 64 * kb, 64 * nb, S8_WOUT} : TItem{p.a_w_out, (bf16_t*)(p.ws + WS_WAOUT_BF), 1024, 1024, 64 * nb, 64 * kb, 64 * nb, 0.f}; return t; } r -= I1;
    if (r < I2) { const int kb = r / 48, nb = r % 48; t = TItem{p.b_w_in, (bf16_t*)(p.ws + WS_WBIN), 3072, 1024, 64 * nb, 64 * kb, 64 * nb, S8_WIN}; return t; } r -= I2;
    if (r < I3) { const int kb = r / 16, nb = r % 16; t = OUTPROJ_FP8 ? TItem{p.b_w_out, (bf16_t*)(p.ws + WS_WBOUT), 1024, 1024, 64 * nb, 64 * kb, 64 * nb, S8_WOUT} : TItem{p.b_w_out, (bf16_t*)(p.ws + WS_WBOUT_BF), 1024, 1024, 64 * nb, 64 * kb, 64 * nb, 0.f}; return t; } r -= I3;
    if (r < I4) { const int mi = r / 256, q = r % 256, kb = q / 16, nb = q % 16; const int n0 = 64 * nb;
        const int drow = ((n0 & 511) >> 7) * 256 + (n0 >> 9) * 128 + (n0 & 127);
        t = TItem{p.moe_w_gu + (size_t)mi * 1024 * 1024, (bf16_t*)(p.ws + WS_WGU + (size_t)mi * 1024 * 1024), 1024, 1024, drow, 64 * kb, n0, S8_WGU}; return t; } r -= I4;
    { const int mi = r / 128, q = r % 128, kb = q / 16, nb = q % 16;
      t = TItem{p.moe_w_down + (size_t)mi * 512 * 1024, (bf16_t*)(p.ws + WS_WDN + (size_t)mi * 1024 * 512), 1024, 512, 64 * nb, 64 * kb, 64 * nb, S8_WDN}; return t; }
}
__device__ __forceinline__ void phase_mod(unsigned char* lds_, int wv, const Params& p) {
    const Frame F = make_frame(lds_, wv);
    LAS float* cact = (LAS float*)F.lds;
    LAS float* red = (LAS float*)(F.lds + 65536);
    float* mod = (float*)(p.ws + WS_MOD);
    for (int i = F.tid; i < NB * DM; i += NTHREADS) { const int b = i >> 10, k = i & 1023; const float v = p.c[i]; cact[k * 16 + b] = v / (1.0f + expf(-v)); }
    __syncthreads();
    for (int task = F.bid; task < 192; task += F.G) {
        const int l = task / 96, cb = task % 96;
        const float* W = p.w_ada + (size_t)l * DM * 6144 + cb * 64 + F.lane;
        float acc[16];
#pragma unroll
        for (int b = 0; b < 16; ++b) acc[b] = 0.f;
        const int kbeg = F.wave * 128;
        for (int kb = kbeg; kb < kbeg + 128; kb += 16) {
            float wv[16];
#pragma unroll
            for (int u = 0; u < 16; ++u) wv[u] = __builtin_nontemporal_load(W + (size_t)(kb + u) * 6144);
#pragma unroll
            for (int u = 0; u < 16; ++u) {
                const LAS f32x4* cc = (const LAS f32x4*)(cact + (kb + u) * 16);
                const f32x4 c0 = cc[0], c1 = cc[1], c2 = cc[2], c3 = cc[3]; const float w = wv[u];
                acc[0] += c0[0] * w; acc[1] += c0[1] * w; acc[2] += c0[2] * w; acc[3] += c0[3] * w;
                acc[4] += c1[0] * w; acc[5] += c1[1] * w; acc[6] += c1[2] * w; acc[7] += c1[3] * w;
                acc[8] += c2[0] * w; acc[9] += c2[1] * w; acc[10] += c2[2] * w; acc[11] += c2[3] * w;
                acc[12] += c3[0] * w; acc[13] += c3[1] * w; acc[14] += c3[2] * w; acc[15] += c3[3] * w;
            }
        }
#pragma unroll
        for (int b = 0; b < 16; ++b) red[(F.wave * 16 + b) * 64 + F.lane] = acc[b];
        __syncthreads();
        for (int o = F.tid; o < 1024; o += NTHREADS) { const int b = o >> 6, cl = o & 63; float s = 0.f;
#pragma unroll
            for (int w = 0; w < 8; ++w) s += red[(w * 16 + b) * 64 + cl];
            mod[((size_t)l * 16 + b) * 6144 + cb * 64 + cl] = s + p.b_ada[(size_t)l * 6144 + cb * 64 + cl]; }
        asm volatile("s_waitcnt vmcnt(0)" ::: "memory");
        __syncthreads();
        if (F.tid == 0) { __builtin_amdgcn_fence(__ATOMIC_RELEASE, "agent"); asm volatile("s_waitcnt vmcnt(0)" ::: "memory"); (void)xb_add((unsigned*)p.ws + CW_MODCNT, 1u); }
    }
}
__device__ __forceinline__ void phase_wconv(unsigned char* lds_, int wv, const Params& p) {
    const Frame F = make_frame(lds_, wv);
    LAS float* scr = (LAS float*)(F.lds + F.wave * 17408);
    LAS float* cmaxw = (LAS float*)(F.lds + 8 * 17408);
    const int lane = F.lane, lr = lane >> 4, c4 = (lane & 15) * 4, w = F.wave;
    for (int it = 0; it < NW_ITEMS; ++it) {
        if (witem_owner(it, F.G) != F.bid) continue;
        const WItem t = decode_witem(it, p);
        const int RW = t.Kr >> 3, NH = RW >> 6;
        f32x4 v[2][16];
#pragma unroll
        for (int hf = 0; hf < 2; ++hf) if (hf < NH) {
#pragma unroll
            for (int i = 0; i < 16; ++i) v[hf][i] = __builtin_nontemporal_load((const f32x4*)(t.W + (size_t)(w * RW + hf * 64 + 4 * i + lr) * t.ldw + t.n0 + c4)); }
        __syncthreads();
        float qs = t.s8;
        if (t.mode == 2) {
            float mx[4] = {0.f, 0.f, 0.f, 0.f};
#pragma unroll
            for (int hf = 0; hf < 2; ++hf) if (hf < NH) {
#pragma unroll
                for (int i = 0; i < 16; ++i)
#pragma unroll
                    for (int q = 0; q < 4; ++q) mx[q] = fmaxf(mx[q], fabsf(v[hf][i][q])); }
#pragma unroll
            for (int q = 0; q < 4; ++q) { mx[q] = fmaxf(mx[q], sx<16>(mx[q])); auto rr = __builtin_amdgcn_permlane32_swap(__float_as_uint(mx[q]), __float_as_uint(mx[q]), false, false); mx[q] = fmaxf(__uint_as_float(rr[0]), __uint_as_float(rr[1])); }
            if (lr == 0) *(LAS f32x4*)(cmaxw + w * 64 + c4) = (f32x4){mx[0], mx[1], mx[2], mx[3]};
            __syncthreads();
            float cm = 0.f;
#pragma unroll
            for (int ww = 0; ww < 8; ++ww) cm = fmaxf(cm, cmaxw[ww * 64 + lane]);
            qs = cm > 0.f ? 127.0f / cm : 0.f;
            if (w == 0) t.cs[t.drow0 + lane] = cm * (1.0f / 127.0f);
        }
#pragma unroll
        for (int hf = 0; hf < 2; ++hf) if (hf < NH) {
#pragma unroll
            for (int i = 0; i < 16; ++i) *(LAS f32x4*)(scr + (4 * i + lr) * 68 + c4) = v[hf][i];
            const int k0 = w * RW + hf * 64;
            if (t.mode == 0) { bf16_t* orow = (bf16_t*)t.WT + (size_t)(t.drow0 + lane) * t.Kr + k0;
#pragma unroll
                for (int c = 0; c < 8; ++c) { float f[8];
#pragma unroll
                    for (int q = 0; q < 8; ++q) f[q] = scr[(8 * c + q) * 68 + lane];
                    u32x4 o; o.x = cvtpk(f[0], f[1]); o.y = cvtpk(f[2], f[3]); o.z = cvtpk(f[4], f[5]); o.w = cvtpk(f[6], f[7]);
                    *(u32x4*)(orow + 8 * c) = o; } }
            else { unsigned char* orow8 = t.WT + (size_t)(t.drow0 + lane) * t.Kr + k0;
#pragma unroll
                for (int c = 0; c < 4; ++c) { float f[16];
#pragma unroll
                    for (int q = 0; q < 16; ++q) f[q] = scr[(16 * c + q) * 68 + lane] * qs;
                    u32x4 o;
                    if (t.mode == 1) { o.x = cvt4_fp8(f[0], f[1], f[2], f[3]); o.y = cvt4_fp8(f[4], f[5], f[6], f[7]); o.z = cvt4_fp8(f[8], f[9], f[10], f[11]); o.w = cvt4_fp8(f[12], f[13], f[14], f[15]); }
                    else { o.x = pack4_i8(f[0], f[1], f[2], f[3]); o.y = pack4_i8(f[4], f[5], f[6], f[7]); o.z = pack4_i8(f[8], f[9], f[10], f[11]); o.w = pack4_i8(f[12], f[13], f[14], f[15]); }
                    *(u32x4*)(orow8 + 16 * c) = o; } }
            asm volatile("s_waitcnt lgkmcnt(0)" ::: "memory");
        }
    }
}

__device__ __forceinline__ void phase_wconv_pw(unsigned char* lds_, int wv, const Params& p) {
    const Frame F = make_frame(lds_, wv);
    LAS float* scr = (LAS float*)(F.lds + F.wave * 17408);
    const int gw = F.vcu * NWAVES + F.wave, NGW = F.G * NWAVES;
    constexpr int NITEMS = ((WQ_IN0 == 2) ? 0 : 16 * 48) + ((WQ_OUT0 == 2) ? 0 : 16 * 16) + 16 * 48 + ((WQ_OUT1 == 2) ? 0 : 16 * 16) + 32 * 256 + 32 * 128;
    const int lane = F.lane, lr = lane >> 4, c4 = (lane & 15) * 4;
    f32x4 v[16];
    int it = gw;
    if (it < NITEMS) { const TItem t = decode_item(it, p);
#pragma unroll
        for (int i = 0; i < 16; ++i) v[i] = __builtin_nontemporal_load((const f32x4*)(t.W + (size_t)(t.k0 + 4 * i + lr) * t.ldw + t.n0 + c4)); }
    for (; it < NITEMS; it += NGW) {
        const TItem t = decode_item(it, p);
#pragma unroll
        for (int i = 0; i < 16; ++i) *(LAS f32x4*)(scr + (4 * i + lr) * 68 + c4) = v[i];
        const int itn = it + NGW;
        if (itn < NITEMS) { const TItem tn = decode_item(itn, p);
#pragma unroll
            for (int i = 0; i < 16; ++i) v[i] = __builtin_nontemporal_load((const f32x4*)(tn.W + (size_t)(tn.k0 + 4 * i + lr) * tn.ldw + tn.n0 + c4)); }
        if (t.s8 > 0.f) {
            unsigned char* orow8 = (unsigned char*)t.WT + (size_t)(t.drow0 + lane) * t.K + t.k0;
#pragma unroll
            for (int c = 0; c < 4; ++c) { float f[16];
#pragma unroll
                for (int q = 0; q < 16; ++q) f[q] = scr[(16 * c + q) * 68 + lane] * t.s8;
                u32x4 o; o.x = cvt4_fp8(f[0], f[1], f[2], f[3]); o.y = cvt4_fp8(f[4], f[5], f[6], f[7]); o.z = cvt4_fp8(f[8], f[9], f[10], f[11]); o.w = cvt4_fp8(f[12], f[13], f[14], f[15]);
                *(u32x4*)(orow8 + 16 * c) = o; }
        } else {
            bf16_t* orow = t.WT + (size_t)(t.drow0 + lane) * t.K + t.k0;
#pragma unroll
            for (int c = 0; c < 8; ++c) { float f[8];
#pragma unroll
                for (int q = 0; q < 8; ++q) f[q] = scr[(8 * c + q) * 68 + lane];
                u32x4 o; o.x = cvtpk(f[0], f[1]); o.y = cvtpk(f[2], f[3]); o.z = cvtpk(f[4], f[5]); o.w = cvtpk(f[6], f[7]);
                *(u32x4*)(orow + 8 * c) = o; }
        }
    }
}

struct RowConst { f32x4 a[4], b[4]; };
__device__ __forceinline__ RowConst load_rowconst(const float* norm, const float* modb, int sh_off, int sc_off, int lane) {
    RowConst rc;
#pragma unroll
    for (int j = 0; j < 4; ++j) { const int c = 256 * j + 4 * lane;
        const f32x4 nv = *(const f32x4*)(norm + c), sc = *(const f32x4*)(modb + sc_off + c); rc.b[j] = *(const f32x4*)(modb + sh_off + c);
        rc.a[j] = nv * (sc + 1.0f); }
    return rc;
}
__device__ __forceinline__ void row_norm_store(const f32x4 (&v)[4], const RowConst& rc, f32x4 (&h)[4], bf16_t* hrow, int lane) {
    float ss = 0.f;
#pragma unroll
    for (int j = 0; j < 4; ++j) ss += (v[j][0] * v[j][0] + v[j][1] * v[j][1]) + (v[j][2] * v[j][2] + v[j][3] * v[j][3]);
    const float r = 1.0f / sqrtf(wave_sum(ss) * (1.0f / DM) + EPS);
#pragma unroll
    for (int j = 0; j < 4; ++j) { h[j] = v[j] * r * rc.a[j] + rc.b[j];
        u32x2 w; w.x = cvtpk(h[j][0], h[j][1]); w.y = cvtpk(h[j][2], h[j][3]); *(u32x2*)(hrow + 256 * j + 4 * lane) = w; }
}


__device__ __forceinline__ float reduce16(const float (&v)[16], int lane) {
    float a[8], b[4], c[2];
    const bool b5 = (lane & 32) != 0, b4 = (lane & 16) != 0, b3 = (lane & 8) != 0, b2 = (lane & 4) != 0;
#pragma unroll
    for (int i = 0; i < 8; ++i) { const float send = b5 ? v[i] : v[8 + i], keep = b5 ? v[8 + i] : v[i]; a[i] = keep + sx32(send, b5); }
#pragma unroll
    for (int i = 0; i < 4; ++i) { const float send = b4 ? a[i] : a[4 + i], keep = b4 ? a[4 + i] : a[i]; b[i] = keep + sx<16>(send); }
#pragma unroll
    for (int i = 0; i < 2; ++i) { const float send = b3 ? b[i] : b[2 + i], keep = b3 ? b[2 + i] : b[i]; c[i] = keep + sx<8>(send); }
    const float send = b2 ? c[0] : c[1], keep = b2 ? c[1] : c[0];
    float d = keep + sx<4>(send);
    d += sx<1>(d); d += sx<2>(d);
    return d;
}
__device__ __forceinline__ float reduce8(const float (&v)[8], int lane) {
    float b[4], c[2];
    const bool b5 = (lane & 32) != 0, b4 = (lane & 16) != 0, b3 = (lane & 8) != 0;
#pragma unroll
    for (int i = 0; i < 4; ++i) { const float send = b5 ? v[i] : v[4 + i], keep = b5 ? v[4 + i] : v[i]; b[i] = keep + sx32(send, b5); }
#pragma unroll
    for (int i = 0; i < 2; ++i) { const float send = b4 ? b[i] : b[2 + i], keep = b4 ? b[2 + i] : b[i]; c[i] = keep + sx<16>(send); }
    const float send = b3 ? c[0] : c[1], keep = b3 ? c[1] : c[0];
    float d = keep + sx<8>(send);
    d += sx<1>(d); d += sx<2>(d); d += sx<4>(d);
    return d;
}

__device__ __forceinline__ void row_norm_store8(const f32x4 (&v)[4], const RowConst& rc, f32x4 (&h)[4], unsigned char* hrow, int lane) {
    float ss = 0.f;
#pragma unroll
    for (int j = 0; j < 4; ++j) ss += (v[j][0] * v[j][0] + v[j][1] * v[j][1]) + (v[j][2] * v[j][2] + v[j][3] * v[j][3]);
    const float r = 1.0f / sqrtf(wave_sum(ss) * (1.0f / DM) + EPS);
#pragma unroll
    for (int j = 0; j < 4; ++j) { h[j] = v[j] * r * rc.a[j] + rc.b[j];
        *(unsigned*)(hrow + 256 * j + 4 * lane) = cvt4_fp8(h[j][0] * S8_H, h[j][1] * S8_H, h[j][2] * S8_H, h[j][3] * S8_H); }
}
__device__ __forceinline__ void row_norm_store_i8(const f32x4 (&v)[4], const RowConst& rc, f32x4 (&h)[4], unsigned char* hrow, float* rs_out, int lane) {
    float ss = 0.f;
#pragma unroll
    for (int j = 0; j < 4; ++j) ss += (v[j][0] * v[j][0] + v[j][1] * v[j][1]) + (v[j][2] * v[j][2] + v[j][3] * v[j][3]);
    const float r = 1.0f / sqrtf(wave_sum(ss) * (1.0f / DM) + EPS);
    float mx = 0.f;
#pragma unroll
    for (int j = 0; j < 4; ++j) { h[j] = v[j] * r * rc.a[j] + rc.b[j]; mx = fmaxf(fmaxf(mx, fmaxf(fabsf(h[j][0]), fabsf(h[j][1]))), fmaxf(fabsf(h[j][2]), fabsf(h[j][3]))); }
    mx = fmaxf(wave_max(mx), 1e-20f);
    const float qs = 127.0f / mx;
#pragma unroll
    for (int j = 0; j < 4; ++j) *(unsigned*)(hrow + 256 * j + 4 * lane) = pack4_i8(h[j][0] * qs, h[j][1] * qs, h[j][2] * qs, h[j][3] * qs);
    if (lane == 0) *rs_out = mx * (1.0f / 127.0f);
}
__device__ __forceinline__ void phase_hprep0(unsigned char* lds_, int wv, const Params& p) {
    const Frame F = make_frame(lds_, wv);
    LAS f32x4* Wg = (LAS f32x4*)F.lds;
    for (int idx = F.tid; idx < 2048; idx += NTHREADS) { const int ln = idx & 63, half = (idx >> 6) & 1, i = (idx >> 7) & 3, j = idx >> 9; const int c = 256 * j + 4 * ln + i;
        Wg[idx] = *(const f32x4*)(p.a_w_in + (size_t)c * 3080 + 3072 + half * 4); }
    __syncthreads();
    const float* mod = (const float*)(p.ws + WS_MOD);
    unsigned char* H = p.ws + WS_H; float* gates = (float*)(p.ws + WS_GATES);
    const float bif = p.a_b_if[F.lane & 7];
    float* cst = (float*)(p.ws + WS_CS);
    const float invf_tab[8] = {1.0f, 0.19391788f, 0.037604144f, 0.0072920943f, 0.0014140673f, 0.00027421273f, 5.3174683e-05f, 1.0311522e-05f};
    float invf = 0.f;
#pragma unroll
    for (int i = 0; i < 8; ++i) if ((F.lane & 7) == i) invf = invf_tab[i];
    for (int chunk = F.bid; chunk < 256; chunk += F.G) {
        const int row0 = chunk * 128 + F.wave * 16; const int b = row0 / SEQ;
        const RowConst rc = load_rowconst(p.norm1, mod + (size_t)b * 6144, 0, 1024, F.lane);
        for (int rb = 0; rb < 16; rb += 4) {
            f32x4 v[4][4];
#pragma unroll
            for (int rr = 0; rr < 4; ++rr)
#pragma unroll
                for (int j = 0; j < 4; ++j) v[rr][j] = __builtin_nontemporal_load((const f32x4*)(p.x + (size_t)(row0 + rb + rr) * DM + 256 * j + 4 * F.lane));
            f32x4 h[4][4];
#pragma unroll
            for (int rr = 0; rr < 4; ++rr) { const size_t row_ = (size_t)(row0 + rb + rr);
                if (WQ_IN0 == 2) row_norm_store_i8(v[rr], rc, h[rr], H + row_ * DM, (float*)(p.ws + SC_RS_H) + row_, F.lane);
                else if (WQ_IN0 == 1) row_norm_store8(v[rr], rc, h[rr], H + row_ * DM, F.lane);
                else row_norm_store(v[rr], rc, h[rr], (bf16_t*)H + row_ * DM, F.lane); }
            float g[4][8];
#pragma unroll
            for (int rr = 0; rr < 4; ++rr)
#pragma unroll
                for (int q = 0; q < 8; ++q) g[rr][q] = 0.f;
#pragma unroll
            for (int j = 0; j < 4; ++j)
#pragma unroll
                for (int i = 0; i < 4; ++i) { if (i == 0 || i == 2) asm volatile("" ::: "memory");
                    const f32x4 w0 = Wg[((j * 4 + i) * 2 + 0) * 64 + F.lane], w1 = Wg[((j * 4 + i) * 2 + 1) * 64 + F.lane];
#pragma unroll
                    for (int rr = 0; rr < 4; ++rr) { const float hv = h[rr][j][i];
                        g[rr][0] += hv * w0[0]; g[rr][1] += hv * w0[1]; g[rr][2] += hv * w0[2]; g[rr][3] += hv * w0[3]; g[rr][4] += hv * w1[0]; g[rr][5] += hv * w1[1]; g[rr][6] += hv * w1[2]; g[rr][7] += hv * w1[3]; } }
#pragma unroll
            for (int rr = 0; rr < 4; ++rr) { const int row = row0 + rb + rr;
                const float d = reduce8(g[rr], F.lane);
                const float mine = bperm(d, 8 * (F.lane & 7));
                if (F.lane < 16) { const float ang = (float)p.positions[row] * invf; const double rev = (double)ang * 0.15915494309189535; const float frc = (float)(rev - rint(rev));
                    cst[(size_t)row * 16 + F.lane] = (F.lane < 8) ? __builtin_amdgcn_cosf(frc) : __builtin_amdgcn_sinf(frc); }
                if (F.lane < 8) { float val = mine + bif;
                    if (F.lane >= 4) val = fminf(val, 0.f) - log1pf(expf(-fabsf(val)));
                    gates[(size_t)row * 8 + F.lane] = val; }
            }
        }
    }
}

namespace mls {
constexpr int RSK = 272, RSV = 176, RSP = 272, RSC = 272;
constexpr int OFF_K = 0, OFF_V = 34816, OFF_P = OFF_V + 22528, OFF_C = OFF_P + 34816, OFF_G = OFF_C + 21760;
typedef short v4i16_t __attribute__((ext_vector_type(4)));
__device__ __forceinline__ bf16x8 tr2(const LAS unsigned char* base, int row, int col, int rs, int lane) {
    const int i = lane & 15, g = lane >> 4;
    const LAS unsigned char* p0 = base + (row + 8 * g + (i >> 2)) * rs + (col + 4 * (i & 3)) * 2;
    const s16x4 lo = __builtin_bit_cast(s16x4, __builtin_amdgcn_ds_read_tr16_b64_v4i16((LAS v4i16_t*)p0));
    const s16x4 hi = __builtin_bit_cast(s16x4, __builtin_amdgcn_ds_read_tr16_b64_v4i16((LAS v4i16_t*)(p0 + 4 * rs)));
    return (bf16x8){lo[0], lo[1], lo[2], lo[3], hi[0], hi[1], hi[2], hi[3]};
}
}
__device__ __forceinline__ void phase_mlstm(unsigned char* lds_, int wv, const Params& p) {
    const Frame F = make_frame(lds_, wv);
    using namespace mls;
    const bf16_t* PR = (const bf16_t*)(p.ws + WS_PROJ); const float* gates = (const float*)(p.ws + WS_GATES); bf16_t* HO = (bf16_t*)(p.ws + WS_HOUT);
    LAS unsigned char* Ks = F.lds + OFF_K; LAS unsigned char* Vs = F.lds + OFF_V; LAS unsigned char* Ps = F.lds + OFF_P; LAS unsigned char* Cs = F.lds + OFF_C;
    LAS float* gbase = (LAS float*)(F.lds + OFF_G);
    const int w = F.wave, lane = F.lane, c = lane & 15, g = lane >> 4, tid = F.tid;
    for (int item = F.vcu; item < 256; item += F.G) {
        const int bh = item >> 2, sl = item & 3, b = bh >> 2, h = bh & 3;
        const size_t tok0 = (size_t)b * SEQ;
        const bf16_t* Qg = PR + h * 128; const bf16_t* Kg = PR + 512 + h * 128; const bf16_t* Vg = PR + 1024 + h * 256 + sl * 64;
        __syncthreads();
        if (tid < 256) { const int row = tid >> 1, part = tid & 1; u32x4 z = {0u, 0u, 0u, 0u}; if (part == 0) z.x = 0x3F80u; *(LAS u32x4*)(Vs + row * RSV + 128 + part * 16) = z; }
        f32x4 cacc[5];
#pragma unroll
        for (int vt = 0; vt < 5; ++vt) cacc[vt] = (f32x4){0.f, 0.f, 0.f, 0.f};
        for (int i = tid; i < 80 * RSC / 16; i += NTHREADS) *(LAS u32x4*)(Cs + i * 16) = (u32x4){0u, 0u, 0u, 0u};
        float m_prev = 0.f;
        u32x4 kst[4], vst[2]; bf16x8 qf[4], qn[4]; float glf0 = 0.f, glf1 = 0.f, gi0 = 0.f, gi1 = 0.f;
        auto load_chunk = [&](int ch) {
            const size_t t0 = tok0 + (size_t)ch * 128;
#pragma unroll
            for (int k = 0; k < 4; ++k) { const int pc = tid + 512 * k, row = pc >> 4, c16 = pc & 15; kst[k] = *(const u32x4*)(Kg + (t0 + row) * 3072 + c16 * 8); }
#pragma unroll
            for (int k = 0; k < 2; ++k) { const int pc = tid + 512 * k, row = pc >> 3, c16 = pc & 7; vst[k] = *(const u32x4*)(Vg + (t0 + row) * 3072 + c16 * 8); }
#pragma unroll
            for (int ks = 0; ks < 4; ++ks) qn[ks] = *(const bf16x8*)(Qg + (t0 + 16 * w + c) * 3072 + 32 * ks + 8 * g);
            if (w == 0) { const float* gp = gates + (t0 + 2 * lane) * 8; gi0 = gp[h]; glf0 = gp[4 + h]; gi1 = gp[8 + h]; glf1 = gp[12 + h]; }
        };
        auto gate_scan = [&](LAS float* gs) {
            LAS float* gu = gs; LAS float* gwv = gs + 128; LAS float* gin = gs + 256; LAS float* gfl = gs + 384; LAS float* gwg = gs + 512;
            float s = glf0 + glf1;
#pragma unroll
            for (int d = 1; d < 64; d <<= 1) { const float t = bperm(s, (lane - d) & 63); if (lane >= d) s += t; }
            const float b1 = s, b0 = s - glf1;
            const float u0 = gi0 - b0, u1 = gi1 - b1;
            float m = fmaxf(u0, u1);
#pragma unroll
            for (int d = 1; d < 64; d <<= 1) { const float t = bperm(m, (lane - d) & 63); if (lane >= d) m = fmaxf(m, t); }
            float ex = bperm(m, (lane - 1) & 63); if (lane == 0) ex = -INFINITY;
            const float wv0 = fmaxf(fmaxf(ex, u0), m_prev), wv1 = fmaxf(m, m_prev);
            const float wlast = rdlane(wv1, 63), blast = rdlane(b1, 63);
            gu[2 * lane] = u0; gu[2 * lane + 1] = u1; gwv[2 * lane] = wv0; gwv[2 * lane + 1] = wv1;
            gin[2 * lane] = __expf(m_prev - wv0); gin[2 * lane + 1] = __expf(m_prev - wv1);
            gfl[2 * lane] = __expf(-(b0 + wv0)); gfl[2 * lane + 1] = __expf(-(b1 + wv1));
            gwg[2 * lane] = __expf(u0 - wlast); gwg[2 * lane + 1] = __expf(u1 - wlast);
            m_prev = blast + wlast;
        };
        auto store_chunk = [&]() {
#pragma unroll
            for (int k = 0; k < 4; ++k) { const int pc = tid + 512 * k, row = pc >> 4, c16 = pc & 15; *(LAS u32x4*)(Ks + row * RSK + c16 * 16) = kst[k]; }
#pragma unroll
            for (int k = 0; k < 2; ++k) { const int pc = tid + 512 * k, row = pc >> 3, c16 = pc & 7; *(LAS u32x4*)(Vs + row * RSV + c16 * 16) = vst[k]; }
#pragma unroll
            for (int ks = 0; ks < 4; ++ks) qf[ks] = qn[ks];
        };
        load_chunk(0);
        store_chunk();
        if (w == 0) gate_scan(gbase);
        __syncthreads();
        for (int ch = 0; ch < 16; ++ch) {
            LAS float* gs = gbase + (ch & 1) * 640;
            LAS float* gu = gs; LAS float* gwv = gs + 128; LAS float* gin = gs + 256; LAS float* gfl = gs + 384; LAS float* gwg = gs + 512;
            if (ch < 15) load_chunk(ch + 1);
            {
                const int t = 16 * w + c; const float wt = gwv[t];
#pragma unroll
                for (int jp = 0; jp < 4; ++jp) {
                    if (2 * jp <= w) {
                        f32x4 sa0 = (f32x4){0.f, 0.f, 0.f, 0.f}, sa1 = sa0;
#pragma unroll
                        for (int ks = 0; ks < 4; ++ks) { const bf16x8 kf0 = *(const LAS bf16x8*)(Ks + (32 * jp + c) * RSK + (32 * ks + 8 * g) * 2), kf1 = *(const LAS bf16x8*)(Ks + (32 * jp + 16 + c) * RSK + (32 * ks + 8 * g) * 2);
                            sa0 = __builtin_amdgcn_mfma_f32_16x16x32_bf16(kf0, qf[ks], sa0, 0, 0, 0); sa1 = __builtin_amdgcn_mfma_f32_16x16x32_bf16(kf1, qf[ks], sa1, 0, 0, 0); }
                        const f32x4 uv0 = *(const LAS f32x4*)(gu + 32 * jp + 4 * g), uv1 = *(const LAS f32x4*)(gu + 32 * jp + 16 + 4 * g);
                        float p0_[4], p1_[4];
#pragma unroll
                        for (int r = 0; r < 4; ++r) { const int s0 = 32 * jp + 4 * g + r, s1 = s0 + 16;
                            const float e0 = __expf(uv0[r] - wt), e1 = __expf(uv1[r] - wt); p0_[r] = (s0 <= t) ? sa0[r] * e0 : 0.f; p1_[r] = (s1 <= t) ? sa1[r] * e1 : 0.f; }
                        u32x2 pk0, pk1; pk0.x = cvtpk(p0_[0], p0_[1]); pk0.y = cvtpk(p0_[2], p0_[3]); pk1.x = cvtpk(p1_[0], p1_[1]); pk1.y = cvtpk(p1_[2], p1_[3]);
                        *(LAS u32x2*)(Ps + t * RSP + (32 * jp + 4 * g) * 2) = pk0; *(LAS u32x2*)(Ps + t * RSP + (32 * jp + 16 + 4 * g) * 2) = pk1;
                    }
                }
            }
            f32x4 nacc[5];
#pragma unroll
            for (int vt = 0; vt < 5; ++vt) { nacc[vt] = (f32x4){0.f, 0.f, 0.f, 0.f};
#pragma unroll
                for (int ks = 0; ks < 4; ++ks) { const bf16x8 cf = *(const LAS bf16x8*)(Cs + (16 * vt + c) * RSC + (32 * ks + 8 * g) * 2); nacc[vt] = __builtin_amdgcn_mfma_f32_16x16x32_bf16(cf, qf[ks], nacc[vt], 0, 0, 0); } }
            { const float iv = gin[16 * w + c];
#pragma unroll
              for (int vt = 0; vt < 5; ++vt) nacc[vt] = nacc[vt] * iv; }
            if (w == 0 && ch < 15) gate_scan(gbase + ((ch + 1) & 1) * 640);
            for (int ks = 0; ks <= (w >> 1); ++ks) {
                const bf16x8 pf = *(const LAS bf16x8*)(Ps + (16 * w + c) * RSP + (32 * ks + 8 * g) * 2);
#pragma unroll
                for (int vt = 0; vt < 5; ++vt) { const bf16x8 vf = tr2(Vs, 32 * ks, 16 * vt, RSV, lane); nacc[vt] = __builtin_amdgcn_mfma_f32_16x16x32_bf16(vf, pf, nacc[vt], 0, 0, 0); }
            }
            { const float den = bperm(nacc[4][0], lane & 15); const float inv = 1.0f / fmaxf(fabsf(den), gfl[16 * w + c]);
              bf16_t* orow = HO + (tok0 + (size_t)ch * 128 + 16 * w + c) * DM + h * 256 + sl * 64 + 4 * g;
#pragma unroll
              for (int vt = 0; vt < 4; ++vt) { u32x2 pk; pk.x = cvtpk(nacc[vt][0] * inv, nacc[vt][1] * inv); pk.y = cvtpk(nacc[vt][2] * inv, nacc[vt][3] * inv); *(u32x2*)(orow + 16 * vt) = pk; } }
            { const float decay = gin[127];
#pragma unroll
              for (int vt = 0; vt < 5; ++vt) cacc[vt] = cacc[vt] * decay;
#pragma unroll
              for (int ks = 0; ks < 4; ++ks) {
                  bf16x8 kf = tr2(Ks, 32 * ks, 16 * w, RSK, lane);
                  const f32x4 w0 = *(const LAS f32x4*)(gwg + 32 * ks + 8 * g), w1 = *(const LAS f32x4*)(gwg + 32 * ks + 8 * g + 4);
                  u32x4 kw = __builtin_bit_cast(u32x4, kf);
                  kw.x = cvtpk(bflo(kw.x) * w0[0], bfhi(kw.x) * w0[1]); kw.y = cvtpk(bflo(kw.y) * w0[2], bfhi(kw.y) * w0[3]);
                  kw.z = cvtpk(bflo(kw.z) * w1[0], bfhi(kw.z) * w1[1]); kw.w = cvtpk(bflo(kw.w) * w1[2], bfhi(kw.w) * w1[3]);
                  kf = __builtin_bit_cast(bf16x8, kw);
#pragma unroll
                  for (int vt = 0; vt < 5; ++vt) { const bf16x8 vf = tr2(Vs, 32 * ks, 16 * vt, RSV, lane); cacc[vt] = __builtin_amdgcn_mfma_f32_16x16x32_bf16(kf, vf, cacc[vt], 0, 0, 0); }
              } }
            asm volatile("s_waitcnt lgkmcnt(0)\n\ts_barrier" ::: "memory");
#pragma unroll
            for (int vt = 0; vt < 5; ++vt) { u32x2 pk; pk.x = cvtpk(cacc[vt][0], cacc[vt][1]); pk.y = cvtpk(cacc[vt][2], cacc[vt][3]); *(LAS u32x2*)(Cs + (16 * vt + c) * RSC + (16 * w + 4 * g) * 2) = pk; }
            if (ch < 15) store_chunk();
            __syncthreads();
        }
    }
}

__device__ __forceinline__ void phase_aprep(unsigned char* lds_, int wv, const Params& p) {
    const Frame F = make_frame(lds_, wv);
    const bf16_t* HO = (const bf16_t*)(p.ws + WS_HOUT); const bf16_t* PR = (const bf16_t*)(p.ws + WS_PROJ); unsigned char* A2 = p.ws + WS_H;
    float hn[16];
#pragma unroll
    for (int i = 0; i < 16; ++i) hn[i] = p.a_h_norm[16 * F.lane + i];
    const int gw = F.bid * NWAVES + F.wave, NGW = F.G * NWAVES;
    for (int rowb = gw; rowb < NTOK; rowb += 4 * NGW) {
        u32x4 h0[4], h1[4], o0[4], o1[4];
#pragma unroll
        for (int rr = 0; rr < 4; ++rr) { const int row = rowb + rr * NGW; if (row < NTOK) {
            h0[rr] = *(const u32x4*)(HO + (size_t)row * DM + 16 * F.lane); h1[rr] = *(const u32x4*)(HO + (size_t)row * DM + 16 * F.lane + 8);
            o0[rr] = *(const u32x4*)(PR + (size_t)row * 3072 + 2048 + 16 * F.lane); o1[rr] = *(const u32x4*)(PR + (size_t)row * 3072 + 2048 + 16 * F.lane + 8); } }
#pragma unroll
        for (int rr = 0; rr < 4; ++rr) { const int row = rowb + rr * NGW; if (row < NTOK) {
            float hv[16], ov[16];
#pragma unroll
            for (int i = 0; i < 4; ++i) { hv[2 * i] = bflo(h0[rr][i]); hv[2 * i + 1] = bfhi(h0[rr][i]); hv[8 + 2 * i] = bflo(h1[rr][i]); hv[8 + 2 * i + 1] = bfhi(h1[rr][i]);
                ov[2 * i] = bflo(o0[rr][i]); ov[2 * i + 1] = bfhi(o0[rr][i]); ov[8 + 2 * i] = bflo(o1[rr][i]); ov[8 + 2 * i + 1] = bfhi(o1[rr][i]); }
            float ss = 0.f;
#pragma unroll
            for (int i = 0; i < 16; ++i) ss += hv[i] * hv[i];
            ss += sx<1>(ss); ss += sx<2>(ss); ss += sx<4>(ss); ss += sx<8>(ss);
            const float r = 1.0f / sqrtf(ss * (1.0f / 256.0f) + EPS);
            float y[16];
#pragma unroll
            for (int i = 0; i < 16; ++i) y[i] = hv[i] * r * hn[i] * sigmoidf_(ov[i]);
            if (WQ_OUT0 == 2) { float mx = 0.f;
#pragma unroll
                for (int i = 0; i < 16; ++i) mx = fmaxf(mx, fabsf(y[i]));
                mx = fmaxf(wave_max(mx), 1e-20f); const float qs = 127.0f / mx;
                u32x4 w; w.x = pack4_i8(y[0] * qs, y[1] * qs, y[2] * qs, y[3] * qs); w.y = pack4_i8(y[4] * qs, y[5] * qs, y[6] * qs, y[7] * qs); w.z = pack4_i8(y[8] * qs, y[9] * qs, y[10] * qs, y[11] * qs); w.w = pack4_i8(y[12] * qs, y[13] * qs, y[14] * qs, y[15] * qs);
                *(u32x4*)(A2 + (size_t)row * DM + 16 * F.lane) = w; if (F.lane == 0) ((float*)(p.ws + SC_RS_A))[row] = mx * (1.0f / 127.0f); }
            else if (OUTPROJ_FP8) { u32x4 w; w.x = cvt4_fp8(y[0] * S8_A2, y[1] * S8_A2, y[2] * S8_A2, y[3] * S8_A2); w.y = cvt4_fp8(y[4] * S8_A2, y[5] * S8_A2, y[6] * S8_A2, y[7] * S8_A2);
                w.z = cvt4_fp8(y[8] * S8_A2, y[9] * S8_A2, y[10] * S8_A2, y[11] * S8_A2); w.w = cvt4_fp8(y[12] * S8_A2, y[13] * S8_A2, y[14] * S8_A2, y[15] * S8_A2);
                *(u32x4*)(A2 + (size_t)row * DM + 16 * F.lane) = w; }
            else { bf16_t* a2b = (bf16_t*)(p.ws + WS_A2B) + (size_t)row * DM + 16 * F.lane; u32x4 w0, w1;
                w0.x = cvtpk(y[0], y[1]); w0.y = cvtpk(y[2], y[3]); w0.z = cvtpk(y[4], y[5]); w0.w = cvtpk(y[6], y[7]); w1.x = cvtpk(y[8], y[9]); w1.y = cvtpk(y[10], y[11]); w1.z = cvtpk(y[12], y[13]); w1.w = cvtpk(y[14], y[15]);
                *(u32x4*)a2b = w0; *(u32x4*)(a2b + 8) = w1; }
            } }
    }
}

__device__ __forceinline__ void phase_hprep_router(unsigned char* lds_, int wv, const Params& p, int layer, int xnx, int xdx, int xper, int xj, const unsigned* oflags) {
    const Frame F = make_frame(lds_, wv);
    LAS u32x4* Wf = (LAS u32x4*)F.lds;
    LAS float* mulc = (LAS float*)(F.lds + 65536);
    LAS float* addc = (LAS float*)(F.lds + 65536 + 4096);
    LAS int* cnt = (LAS int*)(F.lds + 73728);
    LAS float* lgs = (LAS float*)(F.lds + 73728 + 64);
    const float* mod = (const float*)(p.ws + WS_MOD) + (size_t)layer * 16 * 6144;
    unsigned char* H = p.ws + WS_H;
    const bf16_t* XB = (const bf16_t*)(p.ws + WS_XB);
    int* blkcnt = (int*)(p.ws + RT_BLKCNT); int* info = (int*)(p.ws + RT_INFO); float* tw = (float*)(p.ws + RT_W);
    if (F.bid == 0) { for (int i = F.tid; i < 256 * DM / 16; i += NTHREADS) *(u32x4*)(H + (size_t)NTOK * DM + i * 16) = (u32x4){0u, 0u, 0u, 0u}; }
    float rb[16];
#pragma unroll
    for (int e = 0; e < 16; ++e) rb[e] = p.router_bias[e];
    const int ctlo = 2 * ((xdx * 128) / xnx), cthi = 2 * (((xdx + 1) * 128) / xnx);
    bool first = true;
    for (int chunk = ctlo + xj; chunk < cthi; chunk += xper) {
        int lane = F.lane; asm volatile("" : "+v"(lane));
        const int fr = lane & 15, fq = lane >> 4;
        const int row = chunk * 128 + F.wave * 16 + fr; const int b = (chunk * 128) / SEQ;
        if (first) { first = false;
            for (int idx = F.tid; idx < 2048; idx += NTHREADS) { const int ln = idx & 63, ks = idx >> 6; const int col0 = 64 * (ks >> 1) + 16 * (ln >> 4) + 8 * (ks & 1);
                const float* wp = p.w_router + (size_t)col0 * 16 + (ln & 15); u32x4 hi, lo;
#pragma unroll
                for (int i = 0; i < 4; ++i) { const float a = wp[(2 * i) * 16], c = wp[(2 * i + 1) * 16]; const unsigned u = cvtpk(a, c); hi[i] = u; lo[i] = cvtpk(a - bflo(u), c - bfhi(u)); }
                Wf[idx] = hi; Wf[2048 + idx] = lo; } }
        for (int c = F.tid; c < DM; c += NTHREADS) { mulc[c] = p.norm2[(size_t)layer * DM + c] * (1.0f + mod[(size_t)b * 6144 + 4096 + c]); addc[c] = mod[(size_t)b * 6144 + 3072 + c]; }
        if (oflags) { unsigned sp = 0u; while (xb_ld((unsigned*)oflags + (chunk >> 1)) < 32u) { __builtin_amdgcn_s_sleep(2); if (++sp > (1u << 22)) break; } asm volatile("" ::: "memory"); }
        u32x4 xv[16][2];
        { const bf16_t* xrow = XB + (size_t)row * DM + 16 * fq;
#pragma unroll
          for (int s = 0; s < 16; ++s) { xv[s][0] = *(const u32x4*)(xrow + 64 * s); xv[s][1] = *(const u32x4*)(xrow + 64 * s + 8); } }
        if (F.tid < 16) cnt[F.tid] = 0;
        __syncthreads();
        float ss = 0.f;
#pragma unroll
        for (int s = 0; s < 16; ++s)
#pragma unroll
            for (int t = 0; t < 2; ++t)
#pragma unroll
                for (int i = 0; i < 4; ++i) { const float a = bflo(xv[s][t][i]), c = bfhi(xv[s][t][i]); ss += a * a + c * c; }
        ss += sx<16>(ss); ss += sx32(ss, lane >= 32);
        const float r = 1.0f / sqrtf(ss * (1.0f / DM) + EPS);
        f32x4 acc0 = (f32x4){0.f, 0.f, 0.f, 0.f}, acc1 = acc0, acc2 = acc0;
        unsigned char* hrow = H + (size_t)row * DM + 16 * fq;
#pragma unroll
        for (int s = 0; s < 16; ++s) {
            asm volatile("" ::: "memory");
            float h[16];
#pragma unroll
            for (int q = 0; q < 4; ++q) { const f32x4 m = *(const LAS f32x4*)(mulc + 64 * s + 16 * fq + 4 * q), a = *(const LAS f32x4*)(addc + 64 * s + 16 * fq + 4 * q);
                unsigned w0 = xv[s][q >> 1][(q & 1) * 2], w1 = xv[s][q >> 1][(q & 1) * 2 + 1]; asm volatile("" : "+v"(w0), "+v"(w1));
                h[4 * q] = bflo(w0) * r * m[0] + a[0]; h[4 * q + 1] = bfhi(w0) * r * m[1] + a[1]; h[4 * q + 2] = bflo(w1) * r * m[2] + a[2]; h[4 * q + 3] = bfhi(w1) * r * m[3] + a[3]; }
            u32x4 o; o.x = cvt4_fp8(h[0] * S8_H, h[1] * S8_H, h[2] * S8_H, h[3] * S8_H); o.y = cvt4_fp8(h[4] * S8_H, h[5] * S8_H, h[6] * S8_H, h[7] * S8_H);
            o.z = cvt4_fp8(h[8] * S8_H, h[9] * S8_H, h[10] * S8_H, h[11] * S8_H); o.w = cvt4_fp8(h[12] * S8_H, h[13] * S8_H, h[14] * S8_H, h[15] * S8_H);
            *(u32x4*)(hrow + 64 * s) = o;
#pragma unroll
            for (int t = 0; t < 2; ++t) { u32x4 hi, lo;
#pragma unroll
                for (int i = 0; i < 4; ++i) { const float a = h[8 * t + 2 * i], c = h[8 * t + 2 * i + 1]; const unsigned u = cvtpk(a, c); hi[i] = u; lo[i] = cvtpk(a - bflo(u), c - bfhi(u)); }
                const int ks = 2 * s + t;
                const bf16x8 whi = __builtin_bit_cast(bf16x8, Wf[ks * 64 + lane]), wlo = __builtin_bit_cast(bf16x8, Wf[2048 + ks * 64 + lane]);
                const bf16x8 hh = __builtin_bit_cast(bf16x8, hi), hl = __builtin_bit_cast(bf16x8, lo);
                acc0 = __builtin_amdgcn_mfma_f32_16x16x32_bf16(whi, hh, acc0, 0, 0, 0);
                acc1 = __builtin_amdgcn_mfma_f32_16x16x32_bf16(wlo, hh, acc1, 0, 0, 0);
                acc2 = __builtin_amdgcn_mfma_f32_16x16x32_bf16(whi, hl, acc2, 0, 0, 0); }
        }
        { const f32x4 tot = acc0 + (acc1 + acc2);
#pragma unroll
          for (int rr = 0; rr < 4; ++rr) lgs[(F.wave * 16 + fr) * 17 + 4 * fq + rr] = tot[rr]; }
        __syncthreads();
        if (F.tid < 128) {
            const int row = chunk * 128 + F.tid;
            float sc[16], bs[16];
#pragma unroll
            for (int e = 0; e < 16; ++e) { sc[e] = 1.0f / (1.0f + expf(-lgs[F.tid * 17 + e])); bs[e] = sc[e] + rb[e]; }
            int gsel = 0; float gbest = -INFINITY;
#pragma unroll
            for (int gI = 0; gI < 4; ++gI) { const float a = bs[4 * gI], b2 = bs[4 * gI + 1], c2 = bs[4 * gI + 2], d2 = bs[4 * gI + 3];
                const float hi1 = fmaxf(a, b2), lo1 = fminf(a, b2), hi2 = fmaxf(c2, d2), lo2 = fminf(c2, d2);
                const float top = fmaxf(hi1, hi2), sec = fmaxf(fminf(hi1, hi2), fmaxf(lo1, lo2)); const float gs = top + sec;
                if (gs > gbest) { gbest = gs; gsel = gI; } }
            float v0 = 0.f, v1 = 0.f, v2 = 0.f, v3 = 0.f, s0 = 0.f, s1 = 0.f, s2 = 0.f, s3 = 0.f;
#pragma unroll
            for (int gI = 0; gI < 4; ++gI) if (gI == gsel) { v0 = bs[4 * gI]; v1 = bs[4 * gI + 1]; v2 = bs[4 * gI + 2]; v3 = bs[4 * gI + 3]; s0 = sc[4 * gI]; s1 = sc[4 * gI + 1]; s2 = sc[4 * gI + 2]; s3 = sc[4 * gI + 3]; }
            int i1 = 0; float b1 = v0; if (v1 > b1) { b1 = v1; i1 = 1; } if (v2 > b1) { b1 = v2; i1 = 2; } if (v3 > b1) { b1 = v3; i1 = 3; }
            int i2 = -1; float bb = -INFINITY;
            if (i1 != 0 && v0 > bb) { bb = v0; i2 = 0; } if (i1 != 1 && v1 > bb) { bb = v1; i2 = 1; } if (i1 != 2 && v2 > bb) { bb = v2; i2 = 2; } if (i1 != 3 && v3 > bb) { bb = v3; i2 = 3; }
            const float sa = (i1 == 0) ? s0 : (i1 == 1) ? s1 : (i1 == 2) ? s2 : s3;
            const float sb = (i2 == 0) ? s0 : (i2 == 1) ? s1 : (i2 == 2) ? s2 : s3;
            const int e0 = gsel * 4 + i1, e1 = gsel * 4 + i2;
            const int r0 = __hip_atomic_fetch_add(&cnt[e0], 1, __ATOMIC_RELAXED, __HIP_MEMORY_SCOPE_WORKGROUP); const int r1 = __hip_atomic_fetch_add(&cnt[e1], 1, __ATOMIC_RELAXED, __HIP_MEMORY_SCOPE_WORKGROUP);
            info[row] = e0 | (e1 << 4) | (r0 << 8) | (r1 << 16); const float inv = 1.0f / (sa + sb); *(f32x2*)(tw + (size_t)row * 2) = (f32x2){sa * inv, sb * inv};
        }
        __syncthreads();
        if (F.tid < 16) blkcnt[chunk * 16 + F.tid] = cnt[F.tid];
        __syncthreads();
    }
}

__device__ __forceinline__ void phase_layout(unsigned char* lds_, int wv, const Params& p) {
    const Frame F = make_frame(lds_, wv);
    LAS int* lc = (LAS int*)F.lds;
    LAS int* tot = lc + 4096;
    LAS int* sst = tot + 16;
    LAS int* tst = sst + 16;
    const int* blkcnt = (const int*)(p.ws + RT_BLKCNT); const int* info = (const int*)(p.ws + RT_INFO);
    int* dest = (int*)(p.ws + RT_DEST); int* buftok = (int*)(p.ws + RT_BUFTOK); int* meta = (int*)(p.ws + RT_META);
    for (int i = F.tid; i < 4096; i += NTHREADS) lc[i] = blkcnt[i];
    __syncthreads();
    { const int e = F.tid >> 5, li = F.tid & 31; int v[8]; int s = 0;
      LAS int* part = tst + 32;
#pragma unroll
      for (int k = 0; k < 8; ++k) { v[k] = lc[(8 * li + k) * 16 + e]; s += v[k]; }
      part[e * 32 + li] = s;
      __syncthreads();
      int run = 0, all = 0;
      for (int k = 0; k < 32; ++k) { const int t = part[e * 32 + k]; all += t; if (k < li) run += t; }
#pragma unroll
      for (int k = 0; k < 8; ++k) { lc[(8 * li + k) * 16 + e] = run; run += v[k]; }
      if (li == 31) tot[e] = all; }
    __syncthreads();
    if (F.tid == 0) { int ts = 0; for (int e = 0; e < 16; ++e) { tst[e] = ts; sst[e] = ts * 256; ts += (tot[e] + 255) >> 8; } tst[16] = ts;
        if (F.bid == 0) { meta[0] = ts; for (int e = 0; e <= 16; ++e) meta[1 + e] = tst[e]; } }
    __syncthreads();
    for (int chunk = F.bid; chunk < 256; chunk += F.G) {
        if (F.tid < 128) { const int tok = chunk * 128 + F.tid; const int inf = info[tok]; const int e0 = inf & 15, e1 = (inf >> 4) & 15, r0 = (inf >> 8) & 255, r1 = (inf >> 16) & 255;
            const int d0 = sst[e0] + lc[chunk * 16 + e0] + r0, d1 = sst[e1] + lc[chunk * 16 + e1] + r1;
            buftok[d0] = tok; buftok[d1] = tok; dest[tok * 2] = d0; dest[tok * 2 + 1] = d1; }
    }
    for (int e = F.bid; e < 16; e += F.G) { const int beg = sst[e] + tot[e], end = tst[e + 1] * 256; for (int s = beg + F.tid; s < end; s += NTHREADS) buftok[s] = NTOK; }
}

__device__ __forceinline__ void phase_combine(unsigned char* lds_, int wv, const Params& p, int layer, bool next_prep) {
    const Frame F = make_frame(lds_, wv);
    const float* mod = (const float*)(p.ws + WS_MOD) + (size_t)layer * 16 * 6144;
    const float* modn = (const float*)(p.ws + WS_MOD) + (size_t)(layer + 1) * 16 * 6144;
    const unsigned char* Y = p.ws + WS_PROJ; unsigned char* H = p.ws + WS_H;
    bf16_t* XB = (bf16_t*)(p.ws + WS_XB);
    const int* dest = (const int*)(p.ws + RT_DEST); const float* tw = (const float*)(p.ws + RT_W);
    for (int chunk = F.bid; chunk < 256; chunk += F.G) {
        const int row0 = chunk * 128 + F.wave * 16; const int b = row0 / SEQ;
        f32x4 g2[4];
#pragma unroll
        for (int j = 0; j < 4; ++j) g2[j] = *(const f32x4*)(mod + (size_t)b * 6144 + 5120 + 256 * j + 4 * F.lane) * (1.0f / S8_Y);
        RowConst rc;
        if (next_prep) rc = load_rowconst(p.norm1 + (size_t)(layer + 1) * DM, modn + (size_t)b * 6144, 0, 1024, F.lane);
        for (int rb = 0; rb < 16; rb += 4) {
            int d0[4], d1[4]; float w0[4], w1[4];
#pragma unroll
            for (int rr = 0; rr < 4; ++rr) { const int row = row0 + rb + rr; d0[rr] = dest[row * 2]; d1[rr] = dest[row * 2 + 1]; w0[rr] = tw[row * 2]; w1[rr] = tw[row * 2 + 1]; }
            u32x2 xr[4][4]; unsigned ya[4][4], yb[4][4];
#pragma unroll
            for (int rr = 0; rr < 4; ++rr)
#pragma unroll
                for (int j = 0; j < 4; ++j) { xr[rr][j] = *(const u32x2*)(XB + (size_t)(row0 + rb + rr) * DM + 256 * j + 4 * F.lane);
                    ya[rr][j] = *(const unsigned*)(Y + (size_t)d0[rr] * DM + 256 * j + 4 * F.lane); yb[rr][j] = *(const unsigned*)(Y + (size_t)d1[rr] * DM + 256 * j + 4 * F.lane); }
#pragma unroll
            for (int rr = 0; rr < 4; ++rr) { const int row = row0 + rb + rr;
                f32x4 v[4];
#pragma unroll
                for (int j = 0; j < 4; ++j) { const unsigned a = ya[rr][j], bq = yb[rr][j]; f32x4 yy;
                    const f32x2 a01 = __builtin_amdgcn_cvt_pk_f32_fp8((int)a, false), a23 = __builtin_amdgcn_cvt_pk_f32_fp8((int)a, true), b01 = __builtin_amdgcn_cvt_pk_f32_fp8((int)bq, false), b23 = __builtin_amdgcn_cvt_pk_f32_fp8((int)bq, true);
                    yy[0] = w0[rr] * a01[0] + w1[rr] * b01[0]; yy[1] = w0[rr] * a01[1] + w1[rr] * b01[1]; yy[2] = w0[rr] * a23[0] + w1[rr] * b23[0]; yy[3] = w0[rr] * a23[1] + w1[rr] * b23[1];
                    const f32x4 xv = (f32x4){bflo(xr[rr][j].x), bfhi(xr[rr][j].x), bflo(xr[rr][j].y), bfhi(xr[rr][j].y)};
                    v[j] = xv + g2[j] * yy;
                    if (next_prep) { u32x2 w; w.x = cvtpk(v[j][0], v[j][1]); w.y = cvtpk(v[j][2], v[j][3]); *(u32x2*)(XB + (size_t)row * DM + 256 * j + 4 * F.lane) = w; }
                    else *(f32x4*)(p.out + (size_t)row * DM + 256 * j + 4 * F.lane) = v[j]; }
                if (next_prep) { f32x4 h[4]; row_norm_store8(v, rc, h, H + (size_t)row * DM, F.lane); }
            }
        }
    }
}

__device__ __forceinline__ void phase_qkprep(unsigned char* lds_, int wv, const Params& p) {
    const Frame F = make_frame(lds_, wv);
    bf16_t* PR = (bf16_t*)(p.ws + WS_PROJ);
    const int lane = F.lane, half = lane & 1, sh = lane >> 1;
    float nw[32];
    { const float* nsrc = (sh < 16) ? p.b_q_norm : p.b_k_norm;
#pragma unroll
      for (int i = 0; i < 32; ++i) nw[i] = nsrc[half * 32 + i]; }
    const float qscale = (sh < 16) ? 0.125f * 1.4426950408889634f : 1.0f;
    const float invf_tab[8] = {1.0f, 0.19391788f, 0.037604144f, 0.0072920943f, 0.0014140673f, 0.00027421273f, 5.3174683e-05f, 1.0311522e-05f};
    float invf = 0.f;
#pragma unroll
    for (int i = 0; i < 8; ++i) if ((lane & 7) == i) invf = invf_tab[i];
    const int gw = F.bid * NWAVES + F.wave, NGW = F.G * NWAVES;
    for (int rowb = gw; rowb < NTOK; rowb += 4 * NGW) {
        u32x4 raw[4][4]; int posi[4];
#pragma unroll
        for (int rr = 0; rr < 4; ++rr) { const int row = rowb + rr * NGW; if (row < NTOK) { posi[rr] = p.positions[row]; const bf16_t* ptr = PR + (size_t)row * 3072 + sh * 64 + half * 32;
#pragma unroll
            for (int k = 0; k < 4; ++k) raw[rr][k] = *(const u32x4*)(ptr + 8 * k); } }
#pragma unroll
        for (int rr = 0; rr < 4; ++rr) { const int row = rowb + rr * NGW; if (row < NTOK) {
            const float ang = (float)posi[rr] * invf;
            const double rev = (double)ang * 0.15915494309189535; const float fr = (float)(rev - rint(rev));
            const float cs = __builtin_amdgcn_cosf(fr), sn = __builtin_amdgcn_sinf(fr);
            bf16_t* ptr = PR + (size_t)row * 3072 + sh * 64 + half * 32;
            float v[32];
#pragma unroll
            for (int k = 0; k < 4; ++k)
#pragma unroll
                for (int i = 0; i < 4; ++i) { v[8 * k + 2 * i] = bflo(raw[rr][k][i]); v[8 * k + 2 * i + 1] = bfhi(raw[rr][k][i]); }
            float ss = 0.f;
#pragma unroll
            for (int i = 0; i < 32; ++i) ss += v[i] * v[i];
            ss += sx<1>(ss);
            const float r = 1.0f / sqrtf(ss * (1.0f / 64.0f) + EPS);
#pragma unroll
            for (int i = 0; i < 32; ++i) v[i] = v[i] * r * nw[i];
            float y1[8], y2[8];
#pragma unroll
            for (int i = 0; i < 8; ++i) { const float ci = rdlane(cs, i), si = rdlane(sn, i); y1[i] = v[i] * ci - v[8 + i] * si; y2[i] = v[8 + i] * ci + v[i] * si; }
            if (half == 0) {
#pragma unroll
                for (int i = 0; i < 8; ++i) { v[i] = y1[i]; v[8 + i] = y2[i]; } }
#pragma unroll
            for (int k = 0; k < 4; ++k) { u32x4 o;
#pragma unroll
                for (int i = 0; i < 4; ++i) o[i] = cvtpk(v[8 * k + 2 * i] * qscale, v[8 * k + 2 * i + 1] * qscale);
                *(u32x4*)(ptr + 8 * k) = o; } } }
    }
}

__device__ __forceinline__ void phase_attn(unsigned char* lds_, int wv, const Params& p) {
    const Frame F = make_frame(lds_, wv);
    const bf16_t* PR = (const bf16_t*)(p.ws + WS_PROJ); bf16_t* O4 = (bf16_t*)(p.ws + WS_HOUT) + (size_t)F.bid * 256 * 256;
    unsigned char* A2 = p.ws + WS_H;
    const float lam_init = 0.8f - 0.6f * 0.7408182206817179f;
    const float s1 = wave_sum(p.b_lam_q1[F.lane] * p.b_lam_k1[F.lane]), s2 = wave_sum(p.b_lam_q2[F.lane] * p.b_lam_k2[F.lane]);
    const float lam = expf(s1) - expf(s2) + lam_init;
    const float osc = (WQ_OUT1 == 2) ? A2Q : (1.0f - lam_init) * (OUTPROJ_FP8 ? S8_A2 : 1.0f);
    for (int item = F.vcu; item < 256; item += F.G) {
        const int bh = item >> 1, set = item & 1, b = bh >> 3, h = bh & 7;
        const int qlist = set ? 0x1256 : 0x0347;
#define AT2_REF(R, u) do { const int qb_ = (qlist >> (4 * ((u) >> 1))) & 15, c_ = (u) & 1; const size_t r0_ = (size_t)b * SEQ + qb_ * 256; \
        R.Q = PR + r0_ * 3072 + (h * 2 + c_) * 64; R.K = PR + (size_t)b * SEQ * 3072 + 1024 + (h * 2 + c_) * 64; R.V = PR + (size_t)b * SEQ * 3072 + 2048 + h * 128; \
        R.P0 = qb_ * 256; R.to_lds = c_; R.lam = lam; } while (0)
        at2::Seam S; at2::BlockRef cur, nxt;
        AT2_REF(cur, 0);
        __syncthreads();
        at2::prime(cur, (char*)lds_, S, F.tid, wv);
        for (int u = 0; u < 8; ++u) {
            const int un = (u < 7) ? u + 1 : 7;
            AT2_REF(nxt, un);
            at2::block(cur, nxt, (char*)lds_, S, F.tid, wv);
            if (u & 1) {
                asm volatile("s_waitcnt vmcnt(0)" ::: "memory");
                int lane = F.lane; asm volatile("" : "+v"(lane));
                const int half = lane & 1; const int qb = (qlist >> (4 * (u >> 1))) & 15; const size_t row = (size_t)b * SEQ + qb * 256 + wv * 32 + (lane >> 1);
                const LAS unsigned char* pb = F.lds + at2::OFF_OL + wv * at2::OL_WAVE + (lane >> 1) * at2::OL_RS + half * 128;
                u32x4 bq[8];
#pragma unroll
                for (int i = 0; i < 8; ++i) bq[i] = *(const LAS u32x4*)(pb + 16 * i);
                float d[64]; float ss = 0.f;
#pragma unroll
                for (int i = 0; i < 8; ++i)
#pragma unroll
                    for (int j = 0; j < 4; ++j) { d[8 * i + 2 * j] = bflo(bq[i][j]); d[8 * i + 2 * j + 1] = bfhi(bq[i][j]); }
#pragma unroll
                for (int i = 0; i < 64; ++i) ss += d[i] * d[i];
                ss += sx<1>(ss);
                const float r = osc / sqrtf(ss * (1.0f / 128.0f) + EPS);
                if (WQ_OUT1 == 2) { unsigned char* po = A2 + row * DM + h * 128 + half * 64;
#pragma unroll
                    for (int i = 0; i < 4; ++i) { const f32x4 n0 = *(const f32x4*)(p.b_o_norm + half * 64 + 16 * i), n1 = *(const f32x4*)(p.b_o_norm + half * 64 + 16 * i + 4), n2 = *(const f32x4*)(p.b_o_norm + half * 64 + 16 * i + 8), n3 = *(const f32x4*)(p.b_o_norm + half * 64 + 16 * i + 12);
                        u32x4 w; w.x = pack4_i8(d[16 * i] * r * n0[0], d[16 * i + 1] * r * n0[1], d[16 * i + 2] * r * n0[2], d[16 * i + 3] * r * n0[3]);
                        w.y = pack4_i8(d[16 * i + 4] * r * n1[0], d[16 * i + 5] * r * n1[1], d[16 * i + 6] * r * n1[2], d[16 * i + 7] * r * n1[3]);
                        w.z = pack4_i8(d[16 * i + 8] * r * n2[0], d[16 * i + 9] * r * n2[1], d[16 * i + 10] * r * n2[2], d[16 * i + 11] * r * n2[3]);
                        w.w = pack4_i8(d[16 * i + 12] * r * n3[0], d[16 * i + 13] * r * n3[1], d[16 * i + 14] * r * n3[2], d[16 * i + 15] * r * n3[3]);
                        *(u32x4*)(po + 16 * i) = w; } }
                else if (OUTPROJ_FP8) { unsigned char* po = A2 + row * DM + h * 128 + half * 64;
#pragma unroll
                    for (int i = 0; i < 4; ++i) { const f32x4 n0 = *(const f32x4*)(p.b_o_norm + half * 64 + 16 * i), n1 = *(const f32x4*)(p.b_o_norm + half * 64 + 16 * i + 4), n2 = *(const f32x4*)(p.b_o_norm + half * 64 + 16 * i + 8), n3 = *(const f32x4*)(p.b_o_norm + half * 64 + 16 * i + 12);
                        u32x4 w; w.x = cvt4_fp8(d[16 * i] * r * n0[0], d[16 * i + 1] * r * n0[1], d[16 * i + 2] * r * n0[2], d[16 * i + 3] * r * n0[3]);
                        w.y = cvt4_fp8(d[16 * i + 4] * r * n1[0], d[16 * i + 5] * r * n1[1], d[16 * i + 6] * r * n1[2], d[16 * i + 7] * r * n1[3]);
                        w.z = cvt4_fp8(d[16 * i + 8] * r * n2[0], d[16 * i + 9] * r * n2[1], d[16 * i + 10] * r * n2[2], d[16 * i + 11] * r * n2[3]);
                        w.w = cvt4_fp8(d[16 * i + 12] * r * n3[0], d[16 * i + 13] * r * n3[1], d[16 * i + 14] * r * n3[2], d[16 * i + 15] * r * n3[3]);
                        *(u32x4*)(po + 16 * i) = w; } }
                else { bf16_t* po = (bf16_t*)(p.ws + WS_A2B) + row * DM + h * 128 + half * 64;
#pragma unroll
                    for (int i = 0; i < 8; ++i) { const f32x4 n0 = *(const f32x4*)(p.b_o_norm + half * 64 + 8 * i), n1 = *(const f32x4*)(p.b_o_norm + half * 64 + 8 * i + 4);
                        u32x4 w; w.x = cvtpk(d[8 * i] * r * n0[0], d[8 * i + 1] * r * n0[1]); w.y = cvtpk(d[8 * i + 2] * r * n0[2], d[8 * i + 3] * r * n0[3]);
                        w.z = cvtpk(d[8 * i + 4] * r * n1[0], d[8 * i + 5] * r * n1[1]); w.w = cvtpk(d[8 * i + 6] * r * n1[2], d[8 * i + 7] * r * n1[3]);
                        *(u32x4*)(po + 8 * i) = w; } }
            }
            cur = nxt;
        }
#undef AT2_REF
    }
}

__device__ __forceinline__ void phase_ocombine(unsigned char* lds_, int wv, const Params& p) {
    const Frame F = make_frame(lds_, wv);
    const bf16_t* O4 = (const bf16_t*)(p.ws + WS_HOUT); unsigned char* A2 = p.ws + WS_H;
    const float lam_init = 0.8f - 0.6f * 0.7408182206817179f;
    const float s1 = wave_sum(p.b_lam_q1[F.lane] * p.b_lam_k1[F.lane]), s2 = wave_sum(p.b_lam_q2[F.lane] * p.b_lam_k2[F.lane]);
    const float lam = expf(s1) - expf(s2) + lam_init;
    const int lane = F.lane, hh = lane >> 3, sub = lane & 7, half = sub >> 2, j0 = (sub & 3) * 16;
    float on[16];
#pragma unroll
    for (int i = 0; i < 16; ++i) on[i] = p.b_o_norm[half * 64 + j0 + i] * (1.0f - lam_init) * S8_A2;
    const int gw = F.bid * NWAVES + F.wave, NGW = F.G * NWAVES;
    for (int rowb = gw; rowb < NTOK; rowb += 4 * NGW) {
        u32x4 a0[4], a1[4], b0[4], b1[4];
#pragma unroll
        for (int rr = 0; rr < 4; ++rr) { const int row = rowb + rr * NGW; if (row < NTOK) {
            const bf16_t* pa = O4 + (size_t)row * 2048 + ((hh * 2 + 0) * 2 + half) * 64 + j0; const bf16_t* pb = O4 + (size_t)row * 2048 + ((hh * 2 + 1) * 2 + half) * 64 + j0;
            a0[rr] = *(const u32x4*)pa; a1[rr] = *(const u32x4*)(pa + 8); b0[rr] = *(const u32x4*)pb; b1[rr] = *(const u32x4*)(pb + 8); } }
#pragma unroll
        for (int rr = 0; rr < 4; ++rr) { const int row = rowb + rr * NGW; if (row < NTOK) {
            float d[16];
#pragma unroll
            for (int i = 0; i < 4; ++i) { d[2 * i] = bflo(a0[rr][i]) - lam * bflo(b0[rr][i]); d[2 * i + 1] = bfhi(a0[rr][i]) - lam * bfhi(b0[rr][i]); d[8 + 2 * i] = bflo(a1[rr][i]) - lam * bflo(b1[rr][i]); d[8 + 2 * i + 1] = bfhi(a1[rr][i]) - lam * bfhi(b1[rr][i]); }
            float ss = 0.f;
#pragma unroll
            for (int i = 0; i < 16; ++i) ss += d[i] * d[i];
            ss += sx<1>(ss); ss += sx<2>(ss); ss += sx<4>(ss);
            const float r = 1.0f / sqrtf(ss * (1.0f / 128.0f) + EPS);
            float y[16];
#pragma unroll
            for (int i = 0; i < 16; ++i) y[i] = d[i] * r * on[i];
            u32x4 w; w.x = cvt4_fp8(y[0], y[1], y[2], y[3]); w.y = cvt4_fp8(y[4], y[5], y[6], y[7]); w.z = cvt4_fp8(y[8], y[9], y[10], y[11]); w.w = cvt4_fp8(y[12], y[13], y[14], y[15]);
            *(u32x4*)(A2 + (size_t)row * DM + hh * 128 + half * 64 + j0) = w; } }
    }
}


#ifndef PHASE_MASK
#define PHASE_MASK 0xFFFFFFFFu
#endif
#ifndef PROBE_A
#define PROBE_A (-1)
#endif
#ifndef PROBE_B
#define PROBE_B (0)
#endif
constexpr int STAMP_OFF = LDS_BYTES - 2048;
#define STAMP(k) do { if (PROBE_A >= 0 && blockIdx.x == 0 && STAMP_WAVE == 0 && lane_id() == 0) ((volatile LAS unsigned*)((LAS unsigned char*)lds + STAMP_OFF))[k] = (unsigned)__builtin_amdgcn_s_memrealtime(); } while (0)
#define PH(n) ((PHASE_MASK >> (n)) & 1u)

template <int LAYER>
__device__ __forceinline__ void layer_body(const Params& p, const XcdBarrier& bar, unsigned char* lds) {
    const int STAMP_WAVE = bar.wave; (void)STAMP_WAVE;
    constexpr int SB = (LAYER == 0) ? 4 : 13;
    const int G_ = gridDim.x, bid_ = blockIdx.x; LAS unsigned char* ldsl = (LAS unsigned char*)lds;
#define SEAM() xcd_barrier(bar)
    const float* mod = (const float*)(p.ws + WS_MOD);
    LAS int* tab = (LAS int*)(ldsl + TAB_OFF);
    if (PH(2)) { pg8::StaticOrder S; S.init(NTOK, 3072, G_, bid_);
      if (LAYER == 0) {
        if (WQ_IN0 == 2) { pg8::EpiProjI8 E{(bf16_t*)(p.ws + WS_PROJ), (const float*)(p.ws + SC_RS_H), (const float*)(p.ws + SC_CW) + CW_AIN, 0.08838834764831845f};
          pg8::gemm_phase<pg8::EpiProjI8, pg8::StaticOrder, false, true>(ldsl, bar.wave, (const bf16_t*)(p.ws + WS_H), (const bf16_t*)(p.ws + WS_WAIN), 0, 512, S, E, nullptr); }
        else { pg8::EpiBf16 E{(bf16_t*)(p.ws + WS_PROJ), 3072, 2, 4, 0.08838834764831845f, WQ_IN0 == 1 ? 1.0f / (S8_H * S8_WIN) : 1.0f};
          if (WQ_IN0 == 1) pg8::gemm_phase8<pg8::EpiBf16, pg8::StaticOrder, false>(ldsl, bar.wave, p.ws + WS_H, p.ws + WS_WAIN, 0, 1024, S, E, nullptr);
          else pg8::gemm_phase<pg8::EpiBf16, pg8::StaticOrder, false>(ldsl, bar.wave, (const bf16_t*)(p.ws + WS_H), (const bf16_t*)(p.ws + WS_WAIN_BF), 0, 1024, S, E, nullptr); } }
      else { pg8::EpiQKV E{(bf16_t*)(p.ws + WS_PROJ), p.b_q_norm, p.b_k_norm, (const float*)(p.ws + WS_CS), 1.0f / (S8_H * S8_WIN)};
        pg8::gemm_phase8<pg8::EpiQKV, pg8::StaticOrder, false>(ldsl, bar.wave, p.ws + WS_H, p.ws + WS_WBIN, 0, 1024, S, E, nullptr); } }
    SEAM(); STAMP(SB + 0);
    if (LAYER == 0) {
        if (PH(3)) phase_mlstm(lds, bar.wave, p);
        SEAM(); STAMP(SB + 1);
        if (PH(4)) phase_aprep(lds, bar.wave, p);
    } else {
        STAMP(SB + 1);
        if (PH(6)) phase_attn(lds, bar.wave, p);
        STAMP(SB + 2);
    }
    SEAM(); STAMP(SB + 2 + LAYER);
    unsigned* oflags = (unsigned*)p.ws + CW_OFLAGS + LAYER * 128;
    const int xper = (int)bar.st[0], xnx = (int)bar.st[1], xdx = (int)bar.st[2], xj = (int)bar.st[3];
    constexpr bool OCHAIN = (LAYER == 0) ? (WQ_OUT0 == 2) : (WQ_OUT1 == 2);
    if (PH(8)) { pg8::StaticOrder S; S.init(NTOK, 1024, G_, bid_);
      pg8::XcdOrder SX{xnx, xdx, xper, xj, NTOK / 256, 4, oflags};
      if (LAYER == 0 && WQ_OUT0 == 2) { pg8::EpiResidB<true, true> E{(const void*)p.x, (bf16_t*)(p.ws + WS_XB), mod + 2048, 1.0f, (const float*)(p.ws + WS_SCALES)};
        pg8::gemm_phase<pg8::EpiResidB<true, true>, pg8::XcdOrder, false, true>(ldsl, bar.wave, (const bf16_t*)(p.ws + WS_H), (const bf16_t*)(p.ws + WS_WAOUT), 0, 512, SX, E, nullptr); }
      else if (LAYER == 1 && WQ_OUT1 == 2) { pg8::EpiResidB<false, true, true> E{(const void*)(p.ws + WS_XB), (bf16_t*)(p.ws + WS_XB), mod + (size_t)16 * 6144 + 2048, (1.0f - (0.8f - 0.6f * 0.7408182206817179f)) / A2Q, (const float*)(p.ws + WS_SCALES)};
        pg8::gemm_phase<pg8::EpiResidB<false, true, true>, pg8::XcdOrder, false, true>(ldsl, bar.wave, (const bf16_t*)(p.ws + WS_H), (const bf16_t*)(p.ws + WS_WBOUT), 0, 512, SX, E, nullptr); }
      else { pg8::EpiResidB<LAYER == 0> E{LAYER == 0 ? (const void*)p.x : (const void*)(p.ws + WS_XB), (bf16_t*)(p.ws + WS_XB), mod + (size_t)LAYER * 16 * 6144 + 2048, OUTPROJ_FP8 ? 1.0f / (S8_A2 * S8_WOUT) : 1.0f, nullptr};
        if (OUTPROJ_FP8) pg8::gemm_phase8<pg8::EpiResidB<LAYER == 0>, pg8::StaticOrder, false>(ldsl, bar.wave, p.ws + WS_H, p.ws + (LAYER == 0 ? WS_WAOUT : WS_WBOUT), 0, 1024, S, E, nullptr);
        else pg8::gemm_phase<pg8::EpiResidB<LAYER == 0>, pg8::StaticOrder, false>(ldsl, bar.wave, (const bf16_t*)(p.ws + WS_A2B), (const bf16_t*)(p.ws + (LAYER == 0 ? WS_WAOUT_BF : WS_WBOUT_BF)), 0, 1024, S, E, nullptr); } }
    if (!OCHAIN) SEAM();
    STAMP(SB + 3 + LAYER);
    if (PH(9)) phase_hprep_router(lds, bar.wave, p, LAYER, xnx, xdx, xper, xj, OCHAIN ? oflags : nullptr);
    SEAM(); STAMP(SB + 4 + LAYER);
    if (PH(10)) phase_layout(lds, bar.wave, p);
    SEAM(); STAMP(SB + 5 + LAYER);
    if (PH(11)) { const int* meta = (const int*)(p.ws + RT_META);
      __syncthreads();
      { const int t_ = bar.wave * 64 + lane_id(); if (t_ < 17) tab[t_] = meta[1 + t_]; }
      __syncthreads();
      unsigned* flags = (unsigned*)p.ws + CW_FLAGS + LAYER * 512;
      const int xper = (int)bar.st[0], xnx = (int)bar.st[1], xdx = (int)bar.st[2], xj = (int)bar.st[3];
      pg8::MoeOrder S{xnx, xdx, xper, xj, tab[16], tab, flags};
      pg8::EpiSwiGLU8 E1{p.ws + WS_HOUT, 1.0f / (S8_H * S8_WGU), flags};
      pg8::gemm_phase8<pg8::EpiSwiGLU8, pg8::MoeOrder, true>(ldsl, bar.wave, p.ws + WS_H, p.ws + WS_WGU + (size_t)LAYER * 16 * 1024 * 1024, (size_t)1024 * 1024, 1024, S, E1, (const int*)(p.ws + RT_BUFTOK));
      STAMP(SB + 6 + LAYER);
      pg8::MoeOrderWait S2{xnx, xdx, xper, xj, tab[16], tab, flags};
      pg8::EpiFp8 E2{p.ws + WS_PROJ, 1024, S8_Y / (S8_ACT * S8_WDN)};
      pg8::gemm_phase8<pg8::EpiFp8, pg8::MoeOrderWait, false>(ldsl, bar.wave, p.ws + WS_HOUT, p.ws + WS_WDN + (size_t)LAYER * 16 * 1024 * 512, (size_t)1024 * 512, 512, S2, E2, nullptr); }
    SEAM(); STAMP(SB + 7 + LAYER);
    if (PH(12)) phase_combine(lds, bar.wave, p, LAYER, LAYER == 0);
#undef SEAM
}
__global__ void __launch_bounds__(NTHREADS, 2) mk_fwd(Params p) {
    extern __shared__ __attribute__((aligned(16))) unsigned char lds[];
    cg::grid_group grid = cg::this_grid();
    volatile LAS unsigned* misc = (volatile LAS unsigned*)((LAS unsigned char*)lds + MISC_OFF);
    const int wv0 = __builtin_amdgcn_readfirstlane((int)threadIdx.x >> 6);
    if (threadIdx.x < 32) misc[threadIdx.x] = 0u;
    __syncthreads();
    unsigned* ctl = (unsigned*)p.ws;
    XcdBarrier bar = xcd_barrier_post(ctl + CW_BAR, misc + 8, wv0);
    const int STAMP_WAVE = wv0; (void)STAMP_WAVE;
    STAMP(0);
    if (PH(0)) phase_mod(lds, bar.wave, p);
    __syncthreads();
    STAMP(1);
    if (PH(0)) { phase_wconv(lds, bar.wave, p); __syncthreads(); phase_wconv_pw(lds, bar.wave, p); }
    __syncthreads();
    if (wv0 == 0 && lane_id() == 0) { unsigned sp = 0u; while (xb_ld(ctl + CW_MODCNT) < 192u) { __builtin_amdgcn_s_sleep(4); if (++sp > (1u << 22)) break; }
        __builtin_amdgcn_fence(__ATOMIC_ACQUIRE, "agent"); asm volatile("s_waitcnt vmcnt(0)" ::: "memory"); }
    __syncthreads(); STAMP(2);
    if (PH(1)) phase_hprep0(lds, bar.wave, p);
    grid.sync(); STAMP(3);
    layer_body<0>(p, bar, lds);
    xcd_barrier(bar); STAMP(12);
    layer_body<1>(p, bar, lds);
    STAMP(22);
    if (PROBE_A >= 0 && blockIdx.x == 0 && STAMP_WAVE == 0 && lane_id() == 0) {
        volatile LAS unsigned* ts = (volatile LAS unsigned*)((LAS unsigned char*)lds + STAMP_OFF);
        const unsigned dA = ts[PROBE_A + 1] - ts[PROBE_A], dB = ts[PROBE_B + 1] - ts[PROBE_B];
        const unsigned long long extra = 100ull * ((unsigned long long)(dA / 100u) + 1024ull * (dB / 100u)), t0 = __builtin_amdgcn_s_memrealtime();
        while (__builtin_amdgcn_s_memrealtime() - t0 < extra) __builtin_amdgcn_s_sleep(32);
    }
    if (xb_ld(ctl + CW_BAR + XB_TMO) != 0u) { __syncthreads(); for (size_t i = (size_t)blockIdx.x * NTHREADS + (wv0 * 64 + lane_id()); i < (size_t)NTOK * DM / 4; i += (size_t)gridDim.x * NTHREADS) ((f32x4*)p.out)[i] = (f32x4){1e30f, 1e30f, 1e30f, 1e30f}; }
}

extern "C" void kernel_launch(void* const* d_in, const int* in_sizes, int n_in, void* d_out, int out_size, void* d_ws, size_t ws_size, hipStream_t stream) {
    static int grid_blocks = 0;
    if (!grid_blocks) {
        int dev = 0, cus = 0, per_cu = 0;
        (void)hipGetDevice(&dev);
        (void)hipDeviceGetAttribute(&cus, hipDeviceAttributeMultiprocessorCount, dev);
        (void)hipFuncSetAttribute((const void*)mk_fwd, hipFuncAttributeMaxDynamicSharedMemorySize, LDS_BYTES);
        (void)hipOccupancyMaxActiveBlocksPerMultiprocessor(&per_cu, (const void*)mk_fwd, NTHREADS, LDS_BYTES);
        if (per_cu < 1) { fprintf(stderr, "kernel_launch: occupancy query reports %d blocks/CU\n", per_cu); per_cu = 1; }
        grid_blocks = cus;
        if (ws_size < WS_END || n_in != 24) fprintf(stderr, "kernel_launch: unexpected ws_size %zu (need %zu) or n_in %d\n", ws_size, (size_t)WS_END, n_in);
    }
    (void)hipMemsetAsync(d_ws, 0, CTL_BYTES, stream);
    Params p{};
    const float** pf = (const float**)&p;
    p.x = (const float*)d_in[0]; p.c = (const float*)d_in[1]; p.positions = (const int*)d_in[2]; p.norm1 = (const float*)d_in[3]; p.norm2 = (const float*)d_in[4];
    p.w_ada = (const float*)d_in[5]; p.b_ada = (const float*)d_in[6]; p.a_w_in = (const float*)d_in[7]; p.a_b_if = (const float*)d_in[8]; p.a_h_norm = (const float*)d_in[9];
    p.a_w_out = (const float*)d_in[10]; p.b_w_in = (const float*)d_in[11]; p.b_q_norm = (const float*)d_in[12]; p.b_k_norm = (const float*)d_in[13];
    p.b_lam_q1 = (const float*)d_in[14]; p.b_lam_k1 = (const float*)d_in[15]; p.b_lam_q2 = (const float*)d_in[16]; p.b_lam_k2 = (const float*)d_in[17];
    p.b_o_norm = (const float*)d_in[18]; p.b_w_out = (const float*)d_in[19]; p.w_router = (const float*)d_in[20]; p.router_bias = (const float*)d_in[21];
    p.moe_w_gu = (const float*)d_in[22]; p.moe_w_down = (const float*)d_in[23];
    p.out = (float*)d_out; p.ws = (unsigned char*)d_ws; (void)pf;
    void* args[] = {&p};
    hipError_t e = hipLaunchCooperativeKernel((const void*)mk_fwd, dim3(grid_blocks), dim3(NTHREADS), args, LDS_BYTES, stream);
    if (e != hipSuccess) fprintf(stderr, "cooperative launch failed: %s (grid %d)\n", hipGetErrorString(e), grid_blocks);
}
```

```cpp
#include <hip/hip_runtime.h>
#include <hip/hip_cooperative_groups.h>
#include <hip/hip_bf16.h>
#include <cstdio>
#include <cstdint>
#include <cmath>
namespace cg = cooperative_groups;

#define GAS __attribute__((address_space(1)))
#define LAS __attribute__((address_space(3)))
typedef unsigned short bf16_t;
typedef float f32x4 __attribute__((ext_vector_type(4)));
typedef float f32x2 __attribute__((ext_vector_type(2)));
typedef short bf16x8 __attribute__((ext_vector_type(8)));
typedef short s16x4 __attribute__((ext_vector_type(4)));
typedef unsigned u32x4 __attribute__((ext_vector_type(4)));
typedef unsigned u32x2 __attribute__((ext_vector_type(2)));
typedef __bf16 bf16x2_t __attribute__((ext_vector_type(2)));
typedef int i32x8 __attribute__((ext_vector_type(8)));
typedef int i32x4 __attribute__((ext_vector_type(4)));

constexpr int NTOK = 32768, DM = 1024, SEQ = 2048, NB = 16;
constexpr int NEXP = 16, DEXP = 512;
constexpr int NTHREADS = 512, NWAVES = 8;
constexpr int LDS_BYTES = 147456;
constexpr int MISC_OFF = LDS_BYTES - 128;
constexpr int TAB_OFF = 131072;
constexpr float EPS = 1e-6f;
constexpr int MAXTILES = 272, CAP = MAXTILES * 256;
constexpr float S8_H = 8.0f, S8_WGU = 256.0f, S8_ACT = 4.0f, S8_WDN = 128.0f, S8_WIN = 256.0f, S8_A2 = 16.0f, S8_WOUT = 256.0f, S8_Y = 16.0f;

constexpr size_t MiB = 1u << 20;
constexpr size_t WS_CTL = 0, CTL_BYTES = 1 * MiB;
constexpr int CW_BAR = 4096;
constexpr int CW_MODCNT = 9728;
constexpr int CW_OFLAGS = 9216;
constexpr int CW_FLAGS = 8192;
constexpr size_t WS_MOD = 1 * MiB;
constexpr size_t WS_ROUTE = 2 * MiB;
constexpr size_t RT_BLKCNT = WS_ROUTE;
constexpr size_t RT_INFO = WS_ROUTE + 64 * 1024;
constexpr size_t RT_W = RT_INFO + 128 * 1024;
constexpr size_t RT_DEST = RT_W + 256 * 1024;
constexpr size_t RT_BUFTOK = RT_DEST + 256 * 1024;
constexpr size_t RT_META = RT_BUFTOK + 320 * 1024;
constexpr size_t WS_GATES = 4 * MiB;
constexpr size_t WS_SCALES = 5 * MiB;
constexpr size_t SC_RS_H = WS_SCALES;
constexpr size_t SC_RS_A = WS_SCALES + 128 * 1024;
constexpr size_t SC_RS_TOK = WS_SCALES + 256 * 1024;
constexpr size_t SC_RS_SLOT = WS_SCALES + 384 * 1024;
constexpr size_t SC_CW = WS_SCALES + 704 * 1024;
constexpr int CW_AIN = 0, CW_AOUT = 3072, CW_BIN = 4096, CW_GU = 7168, CW_BOUT = 7168 + 32 * 1024;
constexpr int WQ_OUT1 = 2;
constexpr float A2Q = 127.0f / 6.0f;
constexpr int WQ_IN0 = 2, WQ_IN1 = 1, WQ_OUT0 = 2, WQ_GU = 1;
constexpr size_t WS_WAIN = 6 * MiB, WS_WAOUT = 10 * MiB, WS_WBIN = 12 * MiB, WS_WBOUT = 16 * MiB;
constexpr size_t WS_WGU = 18 * MiB;
constexpr size_t WS_WDN = 50 * MiB;
constexpr size_t WS_H = 66 * MiB;
constexpr size_t WS_XB = 100 * MiB;
constexpr size_t WS_PROJ = 164 * MiB;
constexpr size_t WS_HOUT = 356 * MiB;
constexpr size_t WS_CS = 484 * MiB;
constexpr size_t WS_WAIN_BF = 488 * MiB;
constexpr size_t WS_WAOUT_BF = 506 * MiB, WS_WBOUT_BF = 508 * MiB;
constexpr size_t WS_A2B = 420 * MiB;
constexpr bool OUTPROJ_FP8 = false;
constexpr size_t WS_END = 510 * MiB;
constexpr bool INPROJ0_FP8 = false;

__device__ __forceinline__ unsigned cvtpk(float lo, float hi) { f32x2 v = {lo, hi}; bf16x2_t b = __builtin_convertvector(v, bf16x2_t); return __builtin_bit_cast(unsigned, b); }
__device__ __forceinline__ float clamp448(float v) { return fminf(fmaxf(v, -448.0f), 448.0f); }
__device__ __forceinline__ unsigned cvt4_fp8(float a, float b, float c, float d) {
    int w = __builtin_amdgcn_cvt_pk_fp8_f32(clamp448(a), clamp448(b), 0, false); w = __builtin_amdgcn_cvt_pk_fp8_f32(clamp448(c), clamp448(d), w, true); return (unsigned)w; }
__device__ __forceinline__ float bf2f(unsigned short h) { return __uint_as_float(((unsigned)h) << 16); }
__device__ __forceinline__ float bflo(unsigned w) { return __uint_as_float(w << 16); }
__device__ __forceinline__ float bfhi(unsigned w) { return __uint_as_float(w & 0xffff0000u); }
__device__ __forceinline__ int lane_id() { int l; asm volatile("v_mbcnt_lo_u32_b32 %0, -1, 0\n\tv_mbcnt_hi_u32_b32 %0, -1, %0" : "=v"(l)); return l; }
template <int M> __device__ __forceinline__ float sx(float v) {
    const int i = __float_as_int(v);
    if constexpr (M == 1) return __int_as_float(__builtin_amdgcn_mov_dpp(i, 0xB1, 0xF, 0xF, true));
    else if constexpr (M == 2) return __int_as_float(__builtin_amdgcn_mov_dpp(i, 0x4E, 0xF, 0xF, true));
    else if constexpr (M == 4) return __int_as_float(__builtin_amdgcn_ds_swizzle(i, 0x101F));
    else if constexpr (M == 8) return __int_as_float(__builtin_amdgcn_ds_swizzle(i, 0x201F));
    else if constexpr (M == 16) return __int_as_float(__builtin_amdgcn_ds_swizzle(i, 0x401F));
    else { static_assert(M == 1, "sx: mask"); return v; }
}
__device__ __forceinline__ float sx16p(float v, bool odd_row) {
    auto rr = __builtin_amdgcn_permlane16_swap(__float_as_uint(v), __float_as_uint(v), false, false);
    return __uint_as_float(odd_row ? rr[0] : rr[1]);
}
__device__ __forceinline__ float sx32(float v, bool upper) {
    auto rr = __builtin_amdgcn_permlane32_swap(__float_as_uint(v), __float_as_uint(v), false, false);
    return __uint_as_float(upper ? rr[0] : rr[1]);
}
__device__ __forceinline__ float bperm(float v, int src_lane) { return __int_as_float(__builtin_amdgcn_ds_bpermute(src_lane << 2, __float_as_int(v))); }
__device__ __forceinline__ float rdlane(float v, int l) { return __int_as_float(__builtin_amdgcn_readlane(__float_as_int(v), l)); }
__device__ __forceinline__ float wave_sum(float v) {
    v += sx<1>(v); v += sx<2>(v); v += sx<4>(v); v += sx<8>(v); v += sx<16>(v);
    { auto rr = __builtin_amdgcn_permlane32_swap(__float_as_uint(v), __float_as_uint(v), false, false); v = __uint_as_float(rr[0]) + __uint_as_float(rr[1]); }
    return v;
}
__device__ __forceinline__ float wave_max(float v) {
    v = fmaxf(v, sx<1>(v)); v = fmaxf(v, sx<2>(v)); v = fmaxf(v, sx<4>(v)); v = fmaxf(v, sx<8>(v)); v = fmaxf(v, sx<16>(v));
    { auto rr = __builtin_amdgcn_permlane32_swap(__float_as_uint(v), __float_as_uint(v), false, false); v = fmaxf(__uint_as_float(rr[0]), __uint_as_float(rr[1])); }
    return v;
}
__device__ __forceinline__ unsigned pack4_i8(float a, float b, float c, float d) {
    unsigned w = __builtin_amdgcn_cvt_pk_u8_f32(fminf(fmaxf(rintf(a), -127.f), 127.f) + 128.f, 0, 0u);
    w = __builtin_amdgcn_cvt_pk_u8_f32(fminf(fmaxf(rintf(b), -127.f), 127.f) + 128.f, 1, w);
    w = __builtin_amdgcn_cvt_pk_u8_f32(fminf(fmaxf(rintf(c), -127.f), 127.f) + 128.f, 2, w);
    w = __builtin_amdgcn_cvt_pk_u8_f32(fminf(fmaxf(rintf(d), -127.f), 127.f) + 128.f, 3, w);
    return w ^ 0x80808080u;
}
__device__ __forceinline__ f32x4 i2f4(f32x4 a) { return (f32x4){(float)__float_as_int(a[0]), (float)__float_as_int(a[1]), (float)__float_as_int(a[2]), (float)__float_as_int(a[3])}; }
__device__ __forceinline__ float sigmoidf_(float x) { return __builtin_amdgcn_rcpf(1.0f + __expf(-x)); }

#define XB_TMO      128
#define XB_XCNT(j)  (256  + 64 * (j))
#define XB_XSUB(j)  (1280 + 64 * (j))
#define XB_XGEN(j)  (2304 + 64 * (j))
#define XB_TOP      3328
#define XB_TOPGEN   3392
#define XCD_BAR_WORDS 3456
#define XB_SPIN_CAP (1u << 18)
__device__ __forceinline__ unsigned xb_ld(unsigned* p)              { return __hip_atomic_load(p, __ATOMIC_RELAXED, __HIP_MEMORY_SCOPE_AGENT); }
__device__ __forceinline__ unsigned xb_add(unsigned* p, unsigned v) { return __hip_atomic_fetch_add(p, v, __ATOMIC_RELAXED, __HIP_MEMORY_SCOPE_AGENT); }
__device__ __forceinline__ unsigned xb_xcc_id() { return (unsigned)__builtin_amdgcn_s_getreg((3 << 11) | 20) & 0xFu; }
#define XB_SPIN(cond, bar) do { unsigned _sp = 0; while (cond) { __builtin_amdgcn_s_sleep(1); \
    if ((++_sp & 255u) == 0u) { if (xb_ld(&(bar)[XB_TMO])) break; if (_sp > XB_SPIN_CAP) { atomicAdd(&(bar)[XB_TMO], 1u); break; } } } } while (0)
struct XcdBarrier { unsigned* bar; unsigned x; volatile LAS unsigned* st; int wave; };
__device__ __forceinline__ XcdBarrier xcd_barrier_post(unsigned* bar, volatile LAS unsigned* st, int wave) {
    XcdBarrier b; b.bar = bar; b.x = xb_xcc_id(); b.st = st; b.wave = wave;
    if (wave == 0 && lane_id() == 0) st[3] = xb_add(&bar[XB_XCNT(b.x)], 1u);
    return b;
}
__device__ __forceinline__ void xcd_barrier_complete(unsigned* bar, unsigned x, unsigned& nloc, unsigned& nx, unsigned& dx) {
    const unsigned G = gridDim.x * gridDim.y * gridDim.z;
    unsigned sum, cnt, mine, below, sp = 0u;
    for (;;) {
        sum = 0u; cnt = 0u; mine = 0u; below = 0u;
#pragma unroll
        for (unsigned j = 0; j < 16; ++j) { const unsigned c = xb_ld(&bar[XB_XCNT(j)]); sum += c; cnt += (c > 0u) ? 1u : 0u; mine = (j == x) ? c : mine; below += (j < x && c > 0u) ? 1u : 0u; }
        if (sum == G) break;
        __builtin_amdgcn_s_sleep(1);
        if ((++sp & 255u) == 0u) { if (xb_ld(&bar[XB_TMO])) break; if (sp > XB_SPIN_CAP) { atomicAdd(&bar[XB_TMO], 1u); break; } }
    }
    nloc = mine > 0u ? mine : 1u; nx = cnt > 0u ? cnt : 1u; dx = below;
}
__device__ __forceinline__ void xcd_barrier(const XcdBarrier& b) {
    asm volatile("s_waitcnt vmcnt(0)" ::: "memory");
    __syncthreads();
    if (b.wave == 0 && lane_id() == 0) {
        unsigned* bar = b.bar;
        __builtin_amdgcn_s_waitcnt(0);
        unsigned nloc = b.st[0], nx = b.st[1];
        if (nloc == 0u) { unsigned dx; xcd_barrier_complete(bar, b.x, nloc, nx, dx); b.st[0] = nloc; b.st[1] = nx; b.st[2] = dx; }
        const unsigned old = xb_add(&bar[XB_XSUB(b.x)], 1u);
        const unsigned gen = old / nloc;
        if (old + 1u == (gen + 1u) * nloc) {
            __builtin_amdgcn_fence(__ATOMIC_RELEASE, "agent");
            asm volatile("s_waitcnt vmcnt(0)" ::: "memory");
            const unsigned og = xb_add(&bar[XB_TOP], 1u);
            const unsigned target = (og / nx + 1u) * nx;
            if (og + 1u != target) XB_SPIN(xb_ld(&bar[XB_TOP]) < target, bar);
            __builtin_amdgcn_fence(__ATOMIC_ACQUIRE, "agent");
            xb_add(&bar[XB_XGEN(b.x)], 1u);
            asm volatile("s_waitcnt vmcnt(0)" ::: "memory");
        } else {
            XB_SPIN(xb_ld(&bar[XB_XGEN(b.x)]) == gen, bar);
            __builtin_amdgcn_fence(__ATOMIC_ACQUIRE, "agent");
            asm volatile("s_waitcnt vmcnt(0)" ::: "memory");
        }
    }
    __syncthreads();
}

namespace pg8 {
constexpr int BM = 256, BK = 64, HALF = 128, HTB = HALF * BK * 2, STAGE_BYTES = 8 * HTB, NXCD = 8, WGM = 8;
__device__ __forceinline__ int lds_byte(int r, int c) { const int st = (r >> 4) * 2 + (c >> 5), rr = r & 15, cc = c & 31, ob = rr * 64 + cc * 2; return st * 1024 + (ob ^ (((ob >> 9) & 1) << 5)); }
__device__ __forceinline__ void stage_rc(int b, int& R, int& C) { const int st = b / 1024, sb = b % 1024, swz = sb ^ (((sb >> 9) & 1) << 5); R = (st >> 1) * 16 + swz / 64; C = (st & 1) * 32 + (swz % 64) / 2; }
__device__ __forceinline__ int perm32(int rho) { const int n = rho >> 4, i = rho & 15; return 8 * (i >> 2) + 4 * n + (i & 3); }

struct Unit { int pm, pn, e; };

struct StaticOrder {
    static constexpr bool SIGNAL = false;
    int nM, nN, nwg, G, c;
    __device__ void init(int M, int N, int G_, int c_) { nM = M / BM; nN = N / BM; nwg = nM * nN; G = G_; c = c_; }
    __device__ __forceinline__ bool next(int i, Unit& u) const {
        const long L = (long)i * G + c; if (L >= nwg) return false;
        int wgid = (int)L; { const int q = nwg / NXCD, r = nwg % NXCD, xcd = wgid % NXCD, off = wgid / NXCD; wgid = (xcd < r ? xcd * (q + 1) : r * (q + 1) + (xcd - r) * q) + off; }
        const int nig = WGM * nN, gid = wgid / nig, fm = gid * WGM, gsz = (nM - fm) < WGM ? (nM - fm) : WGM;
        u.pm = __builtin_amdgcn_readfirstlane(fm + ((wgid % nig) % gsz)); u.pn = __builtin_amdgcn_readfirstlane((wgid % nig) / gsz); u.e = 0; return true;
    }
};
struct XcdOrder {
    static constexpr bool SIGNAL = true;
    int nx, dx, per, j, nM, nN; unsigned* flags;
    __device__ __forceinline__ bool next(int i, Unit& u) const {
        const int tlo = (dx * nM) / nx, thi = ((dx + 1) * nM) / nx, n = (thi - tlo) * nN;
        const int q = j + i * per; if (q >= n) return false;
        u.pm = __builtin_amdgcn_readfirstlane(tlo + q / nN); u.pn = __builtin_amdgcn_readfirstlane(q % nN); u.e = 0; return true;
    }
    __device__ __forceinline__ void signal(const Unit& u, int lane) const { asm volatile("s_waitcnt vmcnt(0)" ::: "memory"); if (lane == 0) (void)xb_add(flags + u.pm, 1u); }
};
template <bool WAIT>
struct MoeOrderT {
    static constexpr bool SIGNAL = false;
    int nx, dx, per, j, ntiles; const LAS int* ts; unsigned* flags;
    __device__ __forceinline__ bool next(int i, Unit& u) const {
        const int tlo = (dx * ntiles) / nx, thi = ((dx + 1) * ntiles) / nx, n = 4 * (thi - tlo);
        int jj = j; if (WAIT) { jj = j - (n % per); if (jj < 0) jj += per; }
        const int q = jj + i * per; if (q >= n) return false;
        const int tile = tlo + (q >> 2), pn = q & 3;
        int e = 0;
#pragma unroll
        for (int k = 1; k < 16; ++k) e += (tile >= ts[k]) ? 1 : 0;
        u.pm = __builtin_amdgcn_readfirstlane(tile); u.pn = __builtin_amdgcn_readfirstlane(pn); u.e = __builtin_amdgcn_readfirstlane(e);
        if (WAIT) { unsigned sp = 0u;
            while (xb_ld(flags + u.pm) < 32u) { __builtin_amdgcn_s_sleep(2); if (++sp > (1u << 22)) break; }
            asm volatile("" ::: "memory"); }
        return true;
    }
};
typedef MoeOrderT<false> MoeOrder;
typedef MoeOrderT<true> MoeOrderWait;

struct EpiBf16 {
    static constexpr bool PERM = true, HP = false, SIGNAL = false;
    bf16_t* O; int ldc; int s_lo, s_hi; float scale; float base;
    __device__ __forceinline__ void operator()(const f32x4 (&acc)[2][2][4][2], const Unit& u, int wr, int wc, int fr, int fq) const {
        const int row0 = u.pm * BM + wr * 64 + fr; const int col0 = u.pn * BM + wc * 32 + 8 * fq;
        const float sc = ((u.pn >= s_lo && u.pn < s_hi) ? scale : 1.0f) * base;
#pragma unroll
        for (int ai = 0; ai < 2; ++ai)
#pragma unroll
            for (int m = 0; m < 4; ++m) { bf16_t* rowp = O + (size_t)(row0 + ai * HALF + m * 16) * ldc + col0;
#pragma unroll
                for (int bj = 0; bj < 2; ++bj) { const f32x4 v0 = acc[ai][bj][m][0] * sc, v1 = acc[ai][bj][m][1] * sc;
                    u32x4 w; w.x = cvtpk(v0[0], v0[1]); w.y = cvtpk(v0[2], v0[3]); w.z = cvtpk(v1[0], v1[1]); w.w = cvtpk(v1[2], v1[3]);
                    *(u32x4*)(rowp + bj * HALF) = w; } }
    }
};
struct EpiSwiGLU {
    static constexpr bool PERM = true;
    bf16_t* O;
    __device__ __forceinline__ void operator()(const f32x4 (&acc)[2][2][4][2], const Unit& u, int wr, int wc, int fr, int fq) const {
        const int row0 = u.pm * BM + wr * 64 + fr; const int col0 = u.pn * 128 + wc * 32 + 8 * fq;
#pragma unroll
        for (int ai = 0; ai < 2; ++ai)
#pragma unroll
            for (int m = 0; m < 4; ++m) { bf16_t* rowp = O + (size_t)(row0 + ai * HALF + m * 16) * DEXP + col0;
                float a[8];
#pragma unroll
                for (int n = 0; n < 2; ++n)
#pragma unroll
                    for (int j = 0; j < 4; ++j) { const float g = acc[ai][0][m][n][j], up = acc[ai][1][m][n][j]; a[n * 4 + j] = g * up / (1.0f + __expf(-g)); }
                u32x4 w; w.x = cvtpk(a[0], a[1]); w.y = cvtpk(a[2], a[3]); w.z = cvtpk(a[4], a[5]); w.w = cvtpk(a[6], a[7]);
                *(u32x4*)rowp = w; }
    }
};
struct EpiResid {
    static constexpr bool PERM = false;
    const float* base; float* out; const float* gate;
    __device__ __forceinline__ void operator()(const f32x4 (&acc)[2][2][4][2], const Unit& u, int wr, int wc, int fr, int fq) const {
        const int row0 = u.pm * BM + wr * 64 + fr, col0 = u.pn * BM + wc * 32 + 4 * fq;
        const int b = (u.pm * BM) / SEQ;
        f32x4 gv[2][2];
#pragma unroll
        for (int bj = 0; bj < 2; ++bj)
#pragma unroll
            for (int n = 0; n < 2; ++n) gv[bj][n] = *(const f32x4*)(gate + (size_t)b * 6144 + col0 + bj * HALF + n * 16);
#pragma unroll
        for (int ai = 0; ai < 2; ++ai)
#pragma unroll
            for (int m = 0; m < 4; ++m) { const size_t off = (size_t)(row0 + ai * HALF + m * 16) * DM + col0;
#pragma unroll
                for (int bj = 0; bj < 2; ++bj)
#pragma unroll
                    for (int n = 0; n < 2; ++n) { const f32x4 bs = *(const f32x4*)(base + off + bj * HALF + n * 16);
                        *(f32x4*)(out + off + bj * HALF + n * 16) = bs + gv[bj][n] * acc[ai][bj][m][n]; }
                asm volatile("" ::: "memory"); }
    }
};

struct EpiProjI8 {
    static constexpr bool PERM = true, HP = false;
    bf16_t* O; const float* ra; const float* cw; float kscale;
    __device__ __forceinline__ void operator()(const f32x4 (&acc)[2][2][4][2], const Unit& u, int wr, int wc, int fr, int fq) const {
        const int row0 = u.pm * BM + wr * 64 + fr; const int col0 = u.pn * BM + wc * 32 + 8 * fq;
        const float ks = (u.pn >= 2 && u.pn < 4) ? kscale : 1.0f;
        f32x4 c0[2], c1[2];
#pragma unroll
        for (int bj = 0; bj < 2; ++bj) { c0[bj] = *(const f32x4*)(cw + col0 + bj * HALF) * ks; c1[bj] = *(const f32x4*)(cw + col0 + bj * HALF + 4) * ks; }
#pragma unroll
        for (int ai = 0; ai < 2; ++ai)
#pragma unroll
            for (int m = 0; m < 4; ++m) { const int row = row0 + ai * HALF + m * 16; const float rs = ra[row]; bf16_t* rowp = O + (size_t)row * 3072 + col0;
#pragma unroll
                for (int bj = 0; bj < 2; ++bj) { const f32x4 v0 = i2f4(acc[ai][bj][m][0]) * c0[bj] * rs, v1 = i2f4(acc[ai][bj][m][1]) * c1[bj] * rs;
                    u32x4 w; w.x = cvtpk(v0[0], v0[1]); w.y = cvtpk(v0[2], v0[3]); w.z = cvtpk(v1[0], v1[1]); w.w = cvtpk(v1[2], v1[3]);
                    *(u32x4*)(rowp + bj * HALF) = w; } }
    }
};
struct EpiFp8 {
    static constexpr bool PERM = true, HP = false, SIGNAL = false;
    unsigned char* O; int ldc; float scale;
    __device__ __forceinline__ void operator()(const f32x4 (&acc)[2][2][4][2], const Unit& u, int wr, int wc, int fr, int fq) const {
        const int row0 = u.pm * BM + wr * 64 + fr; const int col0 = u.pn * BM + wc * 32 + 8 * fq;
#pragma unroll
        for (int ai = 0; ai < 2; ++ai)
#pragma unroll
            for (int m = 0; m < 4; ++m) { unsigned char* rowp = O + (size_t)(row0 + ai * HALF + m * 16) * ldc + col0;
#pragma unroll
                for (int bj = 0; bj < 2; ++bj) { const f32x4 v0 = acc[ai][bj][m][0] * scale, v1 = acc[ai][bj][m][1] * scale;
                    u32x2 w; w.x = cvt4_fp8(v0[0], v0[1], v0[2], v0[3]); w.y = cvt4_fp8(v1[0], v1[1], v1[2], v1[3]);
                    *(u32x2*)(rowp + bj * HALF) = w; } }
    }
};
struct EpiQKV {
    static constexpr bool PERM = true, HP = true, SIGNAL = false;
    bf16_t* O; const float* qn; const float* kn; const float* cs; float descale;
    __device__ __forceinline__ void operator()(const f32x4 (&acc)[2][2][4][2], const Unit& u, int wr, int wc, int fr, int fq) const {
        const int row0 = u.pm * BM + wr * 64 + fr; const int col0 = u.pn * BM + wc * 64 + 8 * fq;
        const bool isqk = u.pn < 8; const bool odd = (fq & 1) != 0;
        float w[2][2][4];
        if (isqk) { const float* nw = (u.pn < 4) ? qn : kn;
#pragma unroll
            for (int bj = 0; bj < 2; ++bj)
#pragma unroll
                for (int n = 0; n < 2; ++n) { const f32x4 t = *(const f32x4*)(nw + 32 * bj + 8 * fq + 4 * n); w[bj][n][0] = t[0]; w[bj][n][1] = t[1]; w[bj][n][2] = t[2]; w[bj][n][3] = t[3]; } }
        const float qs = (u.pn < 4) ? 0.125f * 1.4426950408889634f : 1.0f;
#pragma unroll
        for (int ai = 0; ai < 2; ++ai)
#pragma unroll
            for (int m = 0; m < 4; ++m) { const int row = row0 + ai * HALF + m * 16; bf16_t* rowp = O + (size_t)row * 3072 + col0;
                float v[2][2][4];
#pragma unroll
                for (int bj = 0; bj < 2; ++bj)
#pragma unroll
                    for (int n = 0; n < 2; ++n)
#pragma unroll
                        for (int j = 0; j < 4; ++j) v[bj][n][j] = acc[ai][bj][m][n][j] * descale;
                if (isqk) {
                    float ss = 0.f;
#pragma unroll
                    for (int bj = 0; bj < 2; ++bj)
#pragma unroll
                        for (int n = 0; n < 2; ++n)
#pragma unroll
                            for (int j = 0; j < 4; ++j) ss += v[bj][n][j] * v[bj][n][j];
                    ss += sx16p(ss, odd);
                    { auto rr = __builtin_amdgcn_permlane32_swap(__float_as_uint(ss), __float_as_uint(ss), false, false); ss = __uint_as_float(rr[0]) + __uint_as_float(rr[1]); }
                    const float rn = __builtin_amdgcn_rsqf(ss * (1.0f / 64.0f) + EPS);
#pragma unroll
                    for (int bj = 0; bj < 2; ++bj)
#pragma unroll
                        for (int n = 0; n < 2; ++n)
#pragma unroll
                            for (int j = 0; j < 4; ++j) v[bj][n][j] = v[bj][n][j] * rn * w[bj][n][j];
                    const f32x4 c0 = *(const f32x4*)(cs + (size_t)row * 16), c1 = *(const f32x4*)(cs + (size_t)row * 16 + 4), s0 = *(const f32x4*)(cs + (size_t)row * 16 + 8), s1 = *(const f32x4*)(cs + (size_t)row * 16 + 12);
#pragma unroll
                    for (int n = 0; n < 2; ++n)
#pragma unroll
                        for (int j = 0; j < 4; ++j) { const float x = v[0][n][j]; const float pr = sx16p(x, odd); const float c = n ? c1[j] : c0[j], sn = n ? s1[j] : s0[j];
                            const float r0 = x * c - pr * sn, r1 = x * c + pr * sn; v[0][n][j] = (fq == 0) ? r0 : (fq == 1) ? r1 : x; }
#pragma unroll
                    for (int bj = 0; bj < 2; ++bj)
#pragma unroll
                        for (int n = 0; n < 2; ++n)
#pragma unroll
                            for (int j = 0; j < 4; ++j) v[bj][n][j] *= qs;
                }
#pragma unroll
                for (int bj = 0; bj < 2; ++bj) { u32x4 wv; wv.x = cvtpk(v[bj][0][0], v[bj][0][1]); wv.y = cvtpk(v[bj][0][2], v[bj][0][3]); wv.z = cvtpk(v[bj][1][0], v[bj][1][1]); wv.w = cvtpk(v[bj][1][2], v[bj][1][3]);
                    *(u32x4*)(rowp + 32 * bj) = wv; } }
    }
};
template <bool BASE_F32, bool I8 = false, bool STATIC_A = false> struct EpiResidB {
    static constexpr bool PERM = true, HP = false, SIGNAL = false;
    const void* base; bf16_t* out; const float* gate; float descale; const float* sc;
    __device__ __forceinline__ void operator()(const f32x4 (&acc)[2][2][4][2], const Unit& u, int wr, int wc, int fr, int fq) const {
        const int row0 = u.pm * BM + wr * 64 + fr, col0 = u.pn * BM + wc * 32 + 8 * fq;
        const int b = (u.pm * BM) / SEQ;
        const float* ra = sc + (SC_RS_A - WS_SCALES) / 4; const float* cw = sc + (SC_CW - WS_SCALES) / 4 + (STATIC_A ? CW_BOUT : CW_AOUT);
        f32x4 gv[2][2];
#pragma unroll
        for (int bj = 0; bj < 2; ++bj)
#pragma unroll
            for (int n = 0; n < 2; ++n) { gv[bj][n] = *(const f32x4*)(gate + (size_t)b * 6144 + col0 + bj * HALF + n * 4); if (!I8) gv[bj][n] = gv[bj][n] * descale; if (I8) gv[bj][n] = gv[bj][n] * *(const f32x4*)(cw + col0 + bj * HALF + n * 4); }
#pragma unroll
        for (int ai = 0; ai < 2; ++ai)
#pragma unroll
            for (int m = 0; m < 4; ++m) { const size_t off = (size_t)(row0 + ai * HALF + m * 16) * DM + col0; const float rs = !I8 ? 1.0f : STATIC_A ? descale : ra[row0 + ai * HALF + m * 16];
#pragma unroll
                for (int bj = 0; bj < 2; ++bj) { f32x4 b0, b1;
                    if (BASE_F32) { b0 = *(const f32x4*)((const float*)base + off + bj * HALF); b1 = *(const f32x4*)((const float*)base + off + bj * HALF + 4); }
                    else { const u32x4 r = *(const u32x4*)((const bf16_t*)base + off + bj * HALF); b0 = (f32x4){bflo(r.x), bfhi(r.x), bflo(r.y), bfhi(r.y)}; b1 = (f32x4){bflo(r.z), bfhi(r.z), bflo(r.w), bfhi(r.w)}; }
                    const f32x4 a0 = I8 ? i2f4(acc[ai][bj][m][0]) * rs : acc[ai][bj][m][0], a1 = I8 ? i2f4(acc[ai][bj][m][1]) * rs : acc[ai][bj][m][1];
                    const f32x4 v0 = b0 + gv[bj][0] * a0, v1 = b1 + gv[bj][1] * a1;
                    u32x4 w; w.x = cvtpk(v0[0], v0[1]); w.y = cvtpk(v0[2], v0[3]); w.z = cvtpk(v1[0], v1[1]); w.w = cvtpk(v1[2], v1[3]);
                    *(u32x4*)(out + off + bj * HALF) = w; }
                asm volatile("" ::: "memory"); }
    }
};
template <class Epi, class Sched, bool GATHER, bool I8 = false>
__device__ __forceinline__ void gemm_phase(LAS unsigned char* lds, int wv, const bf16_t* A, const bf16_t* Bt, size_t bstride, int K, const Sched& S, const Epi& E, const int* aidx) {
    int tid = wv * 64 + lane_id(); asm volatile("" : "+v"(tid));
    const int wid = wv, lane = tid & 63, wr = wid >> 2, wc = wid & 3, fr = lane & 15, fq = lane >> 4;
    const int nt = K / BK;
    int RA[2], CA[2]; unsigned voffB[2];
#pragma unroll
    for (int i = 0; i < 2; ++i) { int R, C; stage_rc(tid * 16 + i * 8192, R, C); const int Rb = Epi::PERM ? ((R & ~31) + perm32(R & 31)) : R;
        RA[i] = R; CA[i] = C; voffB[i] = (unsigned)(Rb * K + C) * 2u; }
    const size_t kstep = (size_t)(BK * 2);
    const size_t hstep = (size_t)HALF * K * 2;
    const size_t tstep = 2 * hstep;
    const unsigned ldsw = (unsigned)wid * 1024u;
    const int aoff = lds_byte(wr * 64 + fr, fq * 8), boff = lds_byte(wc * 32 + fr, fq * 8);
#define PG8_SA(b, h) (((b) * 2 + (h)) * HTB)
#define PG8_SB(b, h) ((4 + (b) * 2 + (h)) * HTB)
#define PG8_STAGE(bufoff, gbase, voff) do { _Pragma("unroll") for (int _i = 0; _i < 2; ++_i) \
        __builtin_amdgcn_global_load_lds((const unsigned*)((const char*)(gbase) + (voff)[_i]), (LAS unsigned*)(lds + (bufoff) + ldsw + _i * 8192), 16, 0, 0); } while (0)
#define PG8_LDA(dst, b, h) do { _Pragma("unroll") for (int m = 0; m < 4; ++m) _Pragma("unroll") for (int k = 0; k < 2; ++k) dst[m][k] = *(const LAS bf16x8*)(lds + PG8_SA(b, h) + aoff + m * 2048 + k * 1024); } while (0)
#define PG8_LDB(dst, b, h) do { _Pragma("unroll") for (int n = 0; n < 2; ++n) _Pragma("unroll") for (int k = 0; k < 2; ++k) dst[n][k] = *(const LAS bf16x8*)(lds + PG8_SB(b, h) + boff + n * 2048 + k * 1024); } while (0)
#define PG8_MMA(ai, bj, At, Bt_) do { __builtin_amdgcn_s_setprio(1); _Pragma("unroll") for (int m = 0; m < 4; ++m) _Pragma("unroll") for (int n = 0; n < 2; ++n) _Pragma("unroll") for (int k = 0; k < 2; ++k) { \
        if constexpr (I8) acc[ai][bj][m][n] = __builtin_bit_cast(f32x4, __builtin_amdgcn_mfma_i32_16x16x64_i8(__builtin_bit_cast(i32x4, Bt_[n][k]), __builtin_bit_cast(i32x4, At[m][k]), __builtin_bit_cast(i32x4, acc[ai][bj][m][n]), 0, 0, 0)); \
        else acc[ai][bj][m][n] = __builtin_amdgcn_mfma_f32_16x16x32_bf16(Bt_[n][k], At[m][k], acc[ai][bj][m][n], 0, 0, 0); } __builtin_amdgcn_s_setprio(0); } while (0)
#define PG8_WAIT_V(n) asm volatile("s_waitcnt vmcnt(" #n ")" ::: "memory")
#define PG8_WAIT_L(n) asm volatile("s_waitcnt lgkmcnt(" #n ")" ::: "memory")
#define PG8_BAR __builtin_amdgcn_s_barrier()
#define PG8_SCHED __builtin_amdgcn_sched_barrier(0)
#define PG8_AOFF(dst, U) do { _Pragma("unroll") for (int _h = 0; _h < 2; ++_h) _Pragma("unroll") for (int _i = 0; _i < 2; ++_i) { \
        const int _row = (U).pm * BM + _h * HALF + RA[_i]; const int _src = GATHER ? aidx[_row] : _row; dst[_h][_i] = (unsigned)(_src * K + CA[_i]) * 2u; } } while (0)
#define PG8_STAGE_A(bufoff, kb, offs, h) do { _Pragma("unroll") for (int _i = 0; _i < 2; ++_i) \
        __builtin_amdgcn_global_load_lds((const unsigned*)((const char*)A + (kb) + (offs)[h][_i]), (LAS unsigned*)(lds + (bufoff) + ldsw + _i * 8192), 16, 0, 0); } while (0)
    Unit cur, nxt; int ui = 0;
    if (!S.next(0, cur)) return;
    f32x4 acc[2][2][4][2];
#pragma unroll
    for (int a = 0; a < 2; ++a)
#pragma unroll
        for (int b = 0; b < 2; ++b)
#pragma unroll
            for (int m = 0; m < 4; ++m)
#pragma unroll
                for (int n = 0; n < 2; ++n) acc[a][b][m][n] = (f32x4){0.f, 0.f, 0.f, 0.f};
    bf16x8 At[4][2], B0[2][2], B1[2][2];
    unsigned ac[2][2], an[2][2];
    PG8_AOFF(ac, cur);
    const char* cB = (const char*)Bt + ((size_t)cur.e * bstride) * 2 + (size_t)cur.pn * tstep;
    PG8_STAGE(PG8_SB(0, 0), cB, voffB); PG8_STAGE(PG8_SB(0, 1), cB + hstep, voffB); PG8_STAGE_A(PG8_SA(0, 0), 0, ac, 0); PG8_STAGE_A(PG8_SA(0, 1), 0, ac, 1);
    if (wr == 1) PG8_BAR;
    PG8_WAIT_V(2); PG8_BAR;
    PG8_STAGE(PG8_SB(1, 0), cB + kstep, voffB); PG8_STAGE_A(PG8_SA(1, 0), kstep, ac, 0); PG8_STAGE(PG8_SB(1, 1), cB + hstep + kstep, voffB);
    PG8_WAIT_V(6); PG8_BAR;
    for (;;) {
        const bool has_next = S.next(ui + 1, nxt);
        if (has_next) { PG8_AOFF(an, nxt); } else {
#pragma unroll
            for (int h = 0; h < 2; ++h)
#pragma unroll
                for (int i = 0; i < 2; ++i) an[h][i] = ac[h][i]; }
        const char* nB = has_next ? (const char*)Bt + ((size_t)nxt.e * bstride) * 2 + (size_t)nxt.pn * tstep : cB;
#pragma unroll 1
        for (int t = 0; t < nt; t += 2) {
            const bool last = (t == nt - 2);
            const size_t k1 = (size_t)(t + 1) * kstep;
            const size_t k2 = last ? 0 : (size_t)(t + 2) * kstep;
            const size_t k3 = k2 + kstep;
            const char* b2 = last ? nB : cB + (size_t)(t + 2) * kstep; const char* b3 = b2 + kstep;
            unsigned a2[2][2];
#pragma unroll
            for (int h = 0; h < 2; ++h)
#pragma unroll
                for (int i = 0; i < 2; ++i) a2[h][i] = last ? an[h][i] : ac[h][i];
            PG8_LDB(B0, 0, 0); PG8_LDB(B1, 0, 1); PG8_SCHED; PG8_LDA(At, 0, 0); PG8_STAGE_A(PG8_SA(1, 1), k1, ac, 1);
            PG8_WAIT_V(8); PG8_WAIT_L(0); PG8_BAR; PG8_MMA(0, 0, At, B0); PG8_MMA(0, 1, At, B1); PG8_BAR; PG8_SCHED;
            PG8_LDA(At, 0, 1); PG8_STAGE(PG8_SB(0, 0), b2, voffB); PG8_STAGE(PG8_SB(0, 1), b2 + hstep, voffB); PG8_STAGE_A(PG8_SA(0, 0), k2, a2, 0);
            PG8_WAIT_V(8); PG8_WAIT_L(0); PG8_BAR; PG8_MMA(1, 0, At, B0); PG8_MMA(1, 1, At, B1); PG8_BAR; PG8_SCHED;
            PG8_LDB(B0, 1, 0); PG8_LDB(B1, 1, 1); PG8_SCHED; PG8_LDA(At, 1, 0); PG8_STAGE_A(PG8_SA(0, 1), k2, a2, 1);
            PG8_WAIT_V(8); PG8_WAIT_L(0); PG8_BAR; PG8_MMA(0, 0, At, B0); PG8_MMA(0, 1, At, B1); PG8_BAR; PG8_SCHED;
            PG8_LDA(At, 1, 1); PG8_STAGE(PG8_SB(1, 0), b3, voffB); PG8_STAGE(PG8_SB(1, 1), b3 + hstep, voffB); PG8_STAGE_A(PG8_SA(1, 0), k3, a2, 0);
            PG8_WAIT_V(8); PG8_WAIT_L(0); PG8_BAR; PG8_MMA(1, 0, At, B0); PG8_MMA(1, 1, At, B1); PG8_BAR; PG8_SCHED;
        }
        if (wr == 0) PG8_BAR;
        E(acc, cur, wr, wc, fr, fq);
        if constexpr (Sched::SIGNAL) S.signal(cur, lane);
        if (!has_next) break;
#pragma unroll
        for (int a = 0; a < 2; ++a)
#pragma unroll
            for (int b = 0; b < 2; ++b)
#pragma unroll
                for (int m = 0; m < 4; ++m)
#pragma unroll
                    for (int n = 0; n < 2; ++n) acc[a][b][m][n] = (f32x4){0.f, 0.f, 0.f, 0.f};
        cur = nxt; cB = nB; ++ui;
#pragma unroll
        for (int h = 0; h < 2; ++h)
#pragma unroll
            for (int i = 0; i < 2; ++i) ac[h][i] = an[h][i];
        if (wr == 1) PG8_BAR;
    }
    PG8_WAIT_V(0);
    PG8_BAR;
#undef PG8_SA
#undef PG8_SB
#undef PG8_STAGE
#undef PG8_LDA
#undef PG8_LDB
#undef PG8_MMA
#undef PG8_WAIT_V
#undef PG8_WAIT_L
#undef PG8_BAR
#undef PG8_SCHED
#undef PG8_AOFF
#undef PG8_STAGE_A
}

__device__ __forceinline__ int x8(int e) { return e ^ ((((e >> 1) ^ (e >> 2)) & 1) << 1); }
struct EpiSwiGLU8 {
    static constexpr bool PERM = true, HP = false, SIGNAL = true;
    unsigned char* O; float descale; unsigned* flags;
    __device__ __forceinline__ void operator()(const f32x4 (&acc)[2][2][4][2], const Unit& u, int wr, int wc, int fr, int fq) const {
        const int row0 = u.pm * BM + wr * 64 + fr; const int col0 = u.pn * 128 + wc * 32 + 8 * fq;
#pragma unroll
        for (int ai = 0; ai < 2; ++ai)
#pragma unroll
            for (int m = 0; m < 4; ++m) { unsigned char* rowp = O + (size_t)(row0 + ai * HALF + m * 16) * DEXP + col0;
                float a[8];
#pragma unroll
                for (int n = 0; n < 2; ++n)
#pragma unroll
                    for (int j = 0; j < 4; ++j) { const float g = acc[ai][0][m][n][j] * descale, up = acc[ai][1][m][n][j] * descale; a[n * 4 + j] = S8_ACT * g * up * __builtin_amdgcn_rcpf(1.0f + __expf(-g)); }
                u32x2 w; w.x = cvt4_fp8(a[0], a[1], a[2], a[3]); w.y = cvt4_fp8(a[4], a[5], a[6], a[7]);
                *(u32x2*)rowp = w; }
    }
};
template <class Epi, class Sched, bool GATHER>
__device__ __forceinline__ void gemm_phase8(LAS unsigned char* lds, int wv, const unsigned char* A, const unsigned char* Bt, size_t bstride, int Kb, const Sched& S, const Epi& E, const int* aidx) {
    int tid = wv * 64 + lane_id(); asm volatile("" : "+v"(tid));
    const int wid = wv, lane = tid & 63, wr = wid >> 2, wc = wid & 3, fr = lane & 15, fq = lane >> 4;
    const int nt = Kb / 128;
    int RA[2], CA[2]; unsigned voffB[2], voffB1[2];
#pragma unroll
    for (int i = 0; i < 2; ++i) { const int b = tid * 16 + i * 8192; const int R = b >> 7, pc = (b >> 4) & 7; const int C = (pc ^ x8((R >> 1) & 7)) * 16;
        const int Rb = Epi::PERM ? ((R & ~31) + perm32(R & 31)) : R;
        RA[i] = R; CA[i] = C;
        if (Epi::HP) { const int g0 = 64 * (R >> 5) + perm32(R & 31); voffB[i] = (unsigned)(g0 * Kb + C); voffB1[i] = (unsigned)((g0 + 32) * Kb + C); }
        else { voffB[i] = (unsigned)(Rb * Kb + C); voffB1[i] = voffB[i] + (unsigned)(HALF * Kb); } }
    const size_t kstep = 128;
    const size_t hstep = (size_t)HALF * Kb;
    const size_t tstep = 2 * hstep;
    const unsigned ldsw = (unsigned)wid * 1024u;
    const int xa = x8((fr >> 1) & 7);
    const int aoff = (wr * 64 + fr) * 128 + (((2 * fq) ^ xa) << 4), boff = (wc * 32 + fr) * 128 + (((2 * fq) ^ xa) << 4);
    const int aoff1 = aoff ^ 16, boff1 = boff ^ 16;
#define PG8_SA(b, h) (((b) * 2 + (h)) * HTB)
#define PG8_SB(b, h) ((4 + (b) * 2 + (h)) * HTB)
#define PG8_STAGE(bufoff, gbase, voff) do { _Pragma("unroll") for (int _i = 0; _i < 2; ++_i) \
        __builtin_amdgcn_global_load_lds((const unsigned*)((const char*)(gbase) + (voff)[_i]), (LAS unsigned*)(lds + (bufoff) + ldsw + _i * 8192), 16, 0, 0); } while (0)
#define PG8_RD32(dst, off, off1) do { const u32x4 _lo = *(const LAS u32x4*)(lds + (off)), _hi = *(const LAS u32x4*)(lds + (off1)); \
        dst = (i32x8){(int)_lo.x, (int)_lo.y, (int)_lo.z, (int)_lo.w, (int)_hi.x, (int)_hi.y, (int)_hi.z, (int)_hi.w}; } while (0)
#define PG8_LDA(dst, b, h) do { _Pragma("unroll") for (int m = 0; m < 4; ++m) PG8_RD32(dst[m], PG8_SA(b, h) + aoff + m * 2048, PG8_SA(b, h) + aoff1 + m * 2048); } while (0)
#define PG8_LDB(dst, b, h) do { _Pragma("unroll") for (int n = 0; n < 2; ++n) PG8_RD32(dst[n], PG8_SB(b, h) + boff + n * 2048, PG8_SB(b, h) + boff1 + n * 2048); } while (0)
#define PG8_MMA(ai, bj, At, Bt_) do { __builtin_amdgcn_s_setprio(1); _Pragma("unroll") for (int m = 0; m < 4; ++m) _Pragma("unroll") for (int n = 0; n < 2; ++n) \
        asm volatile("v_mfma_scale_f32_16x16x128_f8f6f4 %0, %1, %2, %0, %3, %3 op_sel_hi:[0,0,0]" : "+v"(acc[ai][bj][m][n]) : "v"(Bt_[n]), "v"(At[m]), "v"(sc1)); __builtin_amdgcn_s_setprio(0); } while (0)
#define PG8_WAIT_V(n) asm volatile("s_waitcnt vmcnt(" #n ")" ::: "memory")
#define PG8_WAIT_L(n) asm volatile("s_waitcnt lgkmcnt(" #n ")" ::: "memory")
#define PG8_BAR __builtin_amdgcn_s_barrier()
#define PG8_SCHED __builtin_amdgcn_sched_barrier(0)
#define PG8_AOFF(dst, U) do { _Pragma("unroll") for (int _h = 0; _h < 2; ++_h) _Pragma("unroll") for (int _i = 0; _i < 2; ++_i) { \
        const int _row = (U).pm * BM + _h * HALF + RA[_i]; const int _src = GATHER ? aidx[_row] : _row; dst[_h][_i] = (unsigned)(_src * Kb + CA[_i]); } } while (0)
#define PG8_STAGE_A(bufoff, kb, offs, h) do { _Pragma("unroll") for (int _i = 0; _i < 2; ++_i) \
        __builtin_amdgcn_global_load_lds((const unsigned*)((const char*)A + (kb) + (offs)[h][_i]), (LAS unsigned*)(lds + (bufoff) + ldsw + _i * 8192), 16, 0, 0); } while (0)
    Unit cur, nxt; int ui = 0;
    if (!S.next(0, cur)) return;
    f32x4 acc[2][2][4][2];
#pragma unroll
    for (int a = 0; a < 2; ++a)
#pragma unroll
        for (int b = 0; b < 2; ++b)
#pragma unroll
            for (int m = 0; m < 4; ++m)
#pragma unroll
                for (int n = 0; n < 2; ++n) acc[a][b][m][n] = (f32x4){0.f, 0.f, 0.f, 0.f};
    i32x8 At[4], B0[2], B1[2];
    int sc1 = 0x7F7F7F7F; asm volatile("" : "+v"(sc1));
    unsigned ac[2][2], an[2][2];
    PG8_AOFF(ac, cur);
    const char* cB = (const char*)Bt + (size_t)cur.e * bstride + (size_t)cur.pn * tstep;
    PG8_STAGE(PG8_SB(0, 0), cB, voffB); PG8_STAGE(PG8_SB(0, 1), cB, voffB1); PG8_STAGE_A(PG8_SA(0, 0), 0, ac, 0); PG8_STAGE_A(PG8_SA(0, 1), 0, ac, 1);
    if (wr == 1) PG8_BAR;
    PG8_WAIT_V(2); PG8_BAR;
    PG8_STAGE(PG8_SB(1, 0), cB + kstep, voffB); PG8_STAGE_A(PG8_SA(1, 0), kstep, ac, 0); PG8_STAGE(PG8_SB(1, 1), cB + kstep, voffB1);
    PG8_WAIT_V(6); PG8_BAR;
    for (;;) {
        const bool has_next = S.next(ui + 1, nxt);
        if (has_next) { PG8_AOFF(an, nxt); } else {
#pragma unroll
            for (int h = 0; h < 2; ++h)
#pragma unroll
                for (int i = 0; i < 2; ++i) an[h][i] = ac[h][i]; }
        const char* nB = has_next ? (const char*)Bt + (size_t)nxt.e * bstride + (size_t)nxt.pn * tstep : cB;
#pragma unroll 1
        for (int t = 0; t < nt; t += 2) {
            const bool last = (t == nt - 2);
            const size_t k1 = (size_t)(t + 1) * kstep;
            const size_t k2 = last ? 0 : (size_t)(t + 2) * kstep;
            const size_t k3 = k2 + kstep;
            const char* b2 = last ? nB : cB + (size_t)(t + 2) * kstep; const char* b3 = b2 + kstep;
            unsigned a2[2][2];
#pragma unroll
            for (int h = 0; h < 2; ++h)
#pragma unroll
                for (int i = 0; i < 2; ++i) a2[h][i] = last ? an[h][i] : ac[h][i];
            PG8_LDB(B0, 0, 0); PG8_LDB(B1, 0, 1); PG8_SCHED; PG8_LDA(At, 0, 0); PG8_STAGE_A(PG8_SA(1, 1), k1, ac, 1);
            PG8_WAIT_V(8); PG8_WAIT_L(0); PG8_BAR; PG8_MMA(0, 0, At, B0); PG8_MMA(0, 1, At, B1); PG8_BAR; PG8_SCHED;
            PG8_LDA(At, 0, 1); PG8_STAGE(PG8_SB(0, 0), b2, voffB); PG8_STAGE(PG8_SB(0, 1), b2, voffB1); PG8_STAGE_A(PG8_SA(0, 0), k2, a2, 0);
            PG8_WAIT_V(8); PG8_WAIT_L(0); PG8_BAR; PG8_MMA(1, 0, At, B0); PG8_MMA(1, 1, At, B1); PG8_BAR; PG8_SCHED;
            PG8_LDB(B0, 1, 0); PG8_LDB(B1, 1, 1); PG8_SCHED; PG8_LDA(At, 1, 0); PG8_STAGE_A(PG8_SA(0, 1), k2, a2, 1);
            PG8_WAIT_V(8); PG8_WAIT_L(0); PG8_BAR; PG8_MMA(0, 0, At, B0); PG8_MMA(0, 1, At, B1); PG8_BAR; PG8_SCHED;
            PG8_LDA(At, 1, 1); PG8_STAGE(PG8_SB(1, 0), b3, voffB); PG8_STAGE(PG8_SB(1, 1), b3, voffB1); PG8_STAGE_A(PG8_SA(1, 0), k3, a2, 0);
            PG8_WAIT_V(8); PG8_WAIT_L(0); PG8_BAR; PG8_MMA(1, 0, At, B0); PG8_MMA(1, 1, At, B1); PG8_BAR; PG8_SCHED;
        }
        if (wr == 0) PG8_BAR;
        asm volatile("s_nop 15\n\ts_nop 15" ::: "memory");
        E(acc, cur, wr, wc, fr, fq);
        if constexpr (Epi::SIGNAL) { asm volatile("s_waitcnt vmcnt(0)" ::: "memory"); if (lane == 0) (void)xb_add(E.flags + cur.pm, 1u); }
        if (!has_next) break;
#pragma unroll
        for (int a = 0; a < 2; ++a)
#pragma unroll
            for (int b = 0; b < 2; ++b)
#pragma unroll
                for (int m = 0; m < 4; ++m)
#pragma unroll
                    for (int n = 0; n < 2; ++n) acc[a][b][m][n] = (f32x4){0.f, 0.f, 0.f, 0.f};
        cur = nxt; cB = nB; ++ui;
#pragma unroll
        for (int h = 0; h < 2; ++h)
#pragma unroll
            for (int i = 0; i < 2; ++i) ac[h][i] = an[h][i];
        if (wr == 1) PG8_BAR;
    }
    PG8_WAIT_V(0);
    PG8_BAR;
#undef PG8_SA
#undef PG8_SB
#undef PG8_STAGE
#undef PG8_RD32
#undef PG8_LDA
#undef PG8_LDB
#undef PG8_MMA
#undef PG8_WAIT_V
#undef PG8_WAIT_L
#undef PG8_BAR
#undef PG8_SCHED
#undef PG8_AOFF
#undef PG8_STAGE_A
}
}

namespace attn_body {
using bf16 = __hip_bfloat16;
using f32x16 = __attribute__((ext_vector_type(16))) float;
constexpr int D = 64, PQ = 3072, PO = 2048;
constexpr int NW = 8, QBLK = 32, QB = QBLK * NW, KVBLK = 64, NQB = SEQ / QB;
__device__ __forceinline__ int crow(int r, int hi) { return (r & 3) + 8 * (r >> 2) + 4 * hi; }
#define SBAR() __builtin_amdgcn_sched_barrier(0)
__device__ __forceinline__ void cmask(f32x16& p0, f32x16& p1, int jb, int qrel, int hi) {
    const float NEG = -INFINITY; int kb = 64 * jb + 4 * hi;
#pragma unroll
    for (int r = 0; r < 16; ++r) { int kv = kb + (r & 3) + 8 * (r >> 2); if (kv > qrel) p0[r] = NEG; if (kv + 32 > qrel) p1[r] = NEG; }
}
constexpr int NSLOT = 3, SLOTB = 8192;
constexpr int LDS_K = 0, LDS_V = NSLOT * SLOTB, LDS_WS = 2 * NSLOT * SLOTB, LDS_OST = LDS_WS + NW * 64 * 4, ATT_LDS_BYTES = LDS_OST + NW * 4096;
__device__ __forceinline__ void glds16(const void* gsrc, unsigned lds_dst) { unsigned keep;
    asm volatile("s_mov_b32 %0, m0\n\ts_mov_b32 m0, %2\n\ts_nop 0\n\tglobal_load_lds_dwordx4 %1, off\n\ts_mov_b32 m0, %0" : "=&s"(keep) : "v"(gsrc), "s"(lds_dst) : "memory"); }
__device__ __forceinline__ float max3f(float a, float b, float c) { float r; asm("v_max3_f32 %0, %1, %2, %3" : "=v"(r) : "v"(a), "v"(b), "v"(c)); return r; }
__device__ __forceinline__ float max2f(float a, float b) { float r; asm("v_max_f32_e32 %0, %1, %2" : "=v"(r) : "v"(a), "v"(b)); return r; }
__device__ __forceinline__ float fadd_s(float a, float b) { float r; asm("v_add_f32_e32 %0, %1, %2" : "=v"(r) : "v"(a), "v"(b)); return r; }
__device__ __forceinline__ float fsub_s(float a, float b) { float r; asm("v_sub_f32_e32 %0, %1, %2" : "=v"(r) : "v"(a), "v"(b)); return r; }
__device__ __forceinline__ unsigned cvtpk_s(float lo, float hi) { f32x2 v = {lo, hi}; bf16x2_t b = __builtin_convertvector(v, bf16x2_t); return __builtin_bit_cast(unsigned, b); }
#define WAIT_BAR(N) asm volatile("s_waitcnt vmcnt(" #N ") lgkmcnt(0)\n\ts_barrier" ::: "memory")
__device__ __forceinline__ void qkt(f32x16& p0, f32x16& p1, const char* Kslot, const bf16x8* qr, const f32x16& negm, int r32, int hi) {
    const char* kb = Kslot + hi * 1024 + r32 * 16;
#pragma unroll
    for (int d0 = 0; d0 < 4; ++d0) {
        const bf16x8 b0 = *reinterpret_cast<const bf16x8*>(kb + d0 * 2048);
        const bf16x8 b1 = *reinterpret_cast<const bf16x8*>(kb + d0 * 2048 + 512);
        if (d0 == 0) { p0 = __builtin_amdgcn_mfma_f32_32x32x16_bf16(b0, qr[0], negm, 0, 0, 0); p1 = __builtin_amdgcn_mfma_f32_32x32x16_bf16(b1, qr[0], negm, 0, 0, 0); }
        else { p0 = __builtin_amdgcn_mfma_f32_32x32x16_bf16(b0, qr[d0], p0, 0, 0, 0); p1 = __builtin_amdgcn_mfma_f32_32x32x16_bf16(b1, qr[d0], p1, 0, 0, 0); } }
}
typedef __attribute__((address_space(3))) const char* lds_cptr;
typedef short v4i16_t __attribute__((ext_vector_type(4)));
__device__ __forceinline__ void kload8(bf16x8* kf, lds_cptr kp) {
    kf[0] = *(const LAS bf16x8*)(kp);        kf[1] = *(const LAS bf16x8*)(kp + 512);
    kf[2] = *(const LAS bf16x8*)(kp + 2048); kf[3] = *(const LAS bf16x8*)(kp + 2560);
    kf[4] = *(const LAS bf16x8*)(kp + 4096); kf[5] = *(const LAS bf16x8*)(kp + 4608);
    kf[6] = *(const LAS bf16x8*)(kp + 6144); kf[7] = *(const LAS bf16x8*)(kp + 6656);
}
__device__ __forceinline__ void kload2(bf16x8* kf, lds_cptr kp, int j) { kf[2 * j] = *(const LAS bf16x8*)(kp + j * 2048); kf[2 * j + 1] = *(const LAS bf16x8*)(kp + j * 2048 + 512); }
__device__ __forceinline__ s16x4 vtr(lds_cptr p) { return __builtin_bit_cast(s16x4, __builtin_amdgcn_ds_read_tr16_b64_v4i16((LAS v4i16_t*)p)); }
__device__ __forceinline__ float rowmax(const f32x16& p0, const f32x16& p1) {
    float a = max3f(p0[0], p0[1], p1[0]), b = max3f(p0[2], p0[3], p1[1]); a = max3f(a, p1[2], p1[3]);
#pragma unroll
    for (int r = 4; r < 16; r += 4) { a = max3f(a, p0[r], p0[r + 1]); b = max3f(b, p0[r + 2], p0[r + 3]); a = max3f(a, p1[r], p1[r + 1]); b = max3f(b, p1[r + 2], p1[r + 3]); }
    const float m = max2f(a, b);
    auto rr = __builtin_amdgcn_permlane32_swap(__float_as_uint(m), __float_as_uint(m), false, false);
    return max2f(__uint_as_float(rr[0]), __uint_as_float(rr[1]));
}
__device__ __forceinline__ void pv(f32x16* o, int vb, bf16x8 pa0, bf16x8 pa1, bf16x8 pa2, bf16x8 pa3) {
#pragma unroll
    for (int d0 = 0; d0 < 2; ++d0) { s16x4 lo[4], hi[4];
#pragma unroll
        for (int ks = 0; ks < 4; ++ks) {
            asm volatile("ds_read_b64_tr_b16 %0,%1 offset:%c2" : "=&v"(lo[ks]) : "v"(vb), "i"(d0 * 4096 + ks * 1024) : "memory");
            asm volatile("ds_read_b64_tr_b16 %0,%1 offset:%c2" : "=&v"(hi[ks]) : "v"(vb), "i"(d0 * 4096 + ks * 1024 + 512) : "memory"); }
        asm volatile("s_waitcnt lgkmcnt(0)" ::: "memory"); SBAR();
#define PK(k) (bf16x8){lo[k][0], lo[k][1], lo[k][2], lo[k][3], hi[k][0], hi[k][1], hi[k][2], hi[k][3]}
        o[d0] = __builtin_amdgcn_mfma_f32_32x32x16_bf16(pa0, PK(0), o[d0], 0, 0, 0);
        o[d0] = __builtin_amdgcn_mfma_f32_32x32x16_bf16(pa1, PK(1), o[d0], 0, 0, 0);
        o[d0] = __builtin_amdgcn_mfma_f32_32x32x16_bf16(pa2, PK(2), o[d0], 0, 0, 0);
        o[d0] = __builtin_amdgcn_mfma_f32_32x32x16_bf16(pa3, PK(3), o[d0], 0, 0, 0);
#undef PK
    }
}
#define ATTN_STORE16(p, v) (*(u32x4*)(p) = (v))
template <int THRL> __device__ __forceinline__ void attn_unit(int wv, int pair, int qb, const bf16* Pb, bf16* Obuf, char* shm) {
    const int b = pair >> 5, v5 = pair & 31, hc = v5 >> 1; const int qc = hc * 64, kc = 1024 + hc * 64, vc = 2048 + (v5 >> 2) * 128 + (v5 & 1) * 64, oc = v5 * 64;
    int tid = wv * 64 + lane_id(); asm volatile("" : "+v"(tid));
    const int lane = tid & 63, r32 = lane & 31, hi = lane >> 5; const int wid = wv;
    const long rowbase = (long)b * SEQ; const int q0 = qb * QB;
    const bf16* Qw = Pb + (rowbase + q0 + wid * QBLK) * PQ + qc;
    const bf16* Kh = Pb + rowbase * PQ + kc, *Vh = Pb + rowbase * PQ + vc;
    const unsigned lds0 = (unsigned)(uintptr_t)shm;
    float* wsf = (float*)(shm + LDS_WS) + wid * 64;
    const bf16* ksrc = Kh + (long)lane * PQ + wid * 8;
    const bf16* vsrc = Vh + (long)(16 * (wid & 3) + (lane >> 2)) * PQ + (wid >> 2) * 32 + (lane & 3) * 8;
    const unsigned kdst = lds0 + LDS_K + wid * 1024, vdst = lds0 + LDS_V + wid * 1024;
#define DMA_K(t, slot) glds16(ksrc + (long)(t) * KVBLK * PQ, (unsigned)__builtin_amdgcn_readfirstlane(kdst + (slot)))
#define DMA_V(t, slot) glds16(vsrc + (long)(t) * KVBLK * PQ, (unsigned)__builtin_amdgcn_readfirstlane(vdst + (slot)))
    const int vb0 = (int)(lds0 + LDS_V) + ((lane >> 4) & 1) * 32 + (lane & 3) * 8 + (4 * hi + ((lane & 15) >> 2)) * 64;
    const char* Kbase = shm + LDS_K; bf16x8 kf[8];
    const lds_cptr shm3 = (lds_cptr)shm; const lds_cptr kp0 = shm3 + LDS_K + hi * 1024 + r32 * 16; const lds_cptr vp0 = shm3 + LDS_V + ((lane >> 4) & 1) * 32 + (lane & 3) * 8 + (4 * hi + ((lane & 15) >> 2)) * 64;
    const int NT = (q0 + QB) / KVBLK;
    DMA_K(0, 0); DMA_V(0, 0); DMA_K(1, SLOTB);
    bf16x8 qr[4];
#pragma unroll
    for (int d0 = 0; d0 < 4; ++d0) qr[d0] = *reinterpret_cast<const bf16x8*>(&Qw[(long)r32 * PQ + d0 * 16 + hi * 8]);
    float mhat = 0.f, l_reg = 0.f; f32x16 o[2]; o[0] = f32x16{}; o[1] = f32x16{}; f32x16 negm = f32x16{}; asm volatile("" : "+v"(negm));
    const int qrel = wid * QBLK + r32;
#define CMASK(P0, P1, t) do { int jb_ = (t) - (NT - 4); if (jb_ >= 0) cmask(P0, P1, jb_, qrel, hi); } while (0)
    bool resc = false;
#define START(P0, P1) do { const float rm = rowmax(P0, P1); resc = false; \
    { const float dl = rm; mhat = fadd_s(mhat, dl); \
      _Pragma("unroll") for (int r = 0; r < 16; ++r) { P0[r] = fsub_s(P0[r], dl); P1[r] = fsub_s(P1[r], dl); } \
      _Pragma("unroll") for (int r = 0; r < 16; ++r) negm[r] = -mhat; asm volatile("" : "+v"(negm)); } \
    _Pragma("unroll") for (int r = 0; r < 16; ++r) P0[r] = __builtin_amdgcn_exp2f(P0[r]); } while (0)
#define RESC() do { if (resc) { asm volatile("s_waitcnt lgkmcnt(0)" ::: "memory"); \
      _Pragma("unroll") for (int d_ = 0; d_ < 2; ++d_) _Pragma("unroll") for (int r = 0; r < 16; ++r) o[d_][r] *= wsf[crow(r, hi)]; } } while (0)
    f32x16 pA0, pA1, pB0, pB1;
    int sl_prev = 0, sl_cur = 0, sl_next = SLOTB;
#define ROT() do { sl_prev = sl_cur; sl_cur = sl_next; sl_next = (sl_next == (NSLOT - 1) * SLOTB) ? 0 : sl_next + SLOTB; } while (0)
    DMA_K(2, 2 * SLOTB);
    WAIT_BAR(3);
    qkt(pA0, pA1, Kbase, qr, negm, r32, hi); asm volatile("s_nop 15\n\ts_nop 7" : "+v"(pA0), "+v"(pA1)); CMASK(pA0, pA1, 0);
    START(pA0, pA1);
    _Pragma("unroll") for (int r = 0; r < 16; ++r) pA1[r] = __builtin_amdgcn_exp2f(pA1[r]);
    WAIT_BAR(0);
    DMA_K(3, 0); DMA_V(1, SLOTB);
    ROT();
    kload8(kf, kp0 + sl_cur);
    WAIT_BAR(2);
    s16x4 vlo[8], vhi[8]; u32x4 pw0, pw1, pw2, pw3;
#define PKW(P, B) cvtpk_s(P[B], P[B + 1])
#define PAF(k) __builtin_bit_cast(bf16x8, pw##k)
#define VFR(i) (bf16x8){vlo[i][0], vlo[i][1], vlo[i][2], vlo[i][3], vhi[i][0], vhi[i][1], vhi[i][2], vhi[i][3]}
#define PIN(x) asm volatile("" : "+v"(x))
#define MX3(a, b, c) __builtin_fmaxf(__builtin_fmaxf((a), (b)), (c))
#define GAPA(MF, A0, A1, A2, A3, W0, W1, PW) do { MF; sacc += A0; sacc += A1; sacc += A2; sacc += A3; PIN(sacc); W0; W1; PIN(PW); SBAR(); } while (0)
#define EX(v) __builtin_amdgcn_exp2f(v)
#define GAPB(MF, X, B) do { MF; X[B] = EX(X[B]); X[B + 1] = EX(X[B + 1]); X[B + 2] = EX(X[B + 2]); X[B + 3] = EX(X[B + 3]); PIN(X); SBAR(); } while (0)
#define VRD(i) do { vlo[i] = vtr(vp_ + (((i) >> 2) * 4096 + ((i) & 3) * 1024)); vhi[i] = vtr(vp_ + (((i) >> 2) * 4096 + ((i) & 3) * 1024 + 512)); } while (0)
#define KRD(G, j) do { if (G) { kload2(kf, kp0 + sl_next, j); SBAR(); } } while (0)
#define STEP(C0, C1, P0, P1, t, GK, GV, GL) do { SBAR(); \
    const lds_cptr vp_ = vp0 + sl_prev; \
    VRD(0); SBAR(); float sacc = (P0[0] + P0[1]); \
    GAPA(C0 = __builtin_amdgcn_mfma_f32_32x32x16_bf16(kf[0], qr[0], negm, 0, 0, 0), P0[2], P0[3], P0[4], P0[5],     pw0[0] = PKW(P0, 0), pw0[1] = PKW(P0, 2), pw0); \
    VRD(4); SBAR(); GAPA(C1 = __builtin_amdgcn_mfma_f32_32x32x16_bf16(kf[1], qr[0], negm, 0, 0, 0), P0[6], P0[7], P0[8], P0[9],     pw0[2] = PKW(P0, 4), pw0[3] = PKW(P0, 6), pw0); \
    VRD(1); SBAR(); GAPA(C0 = __builtin_amdgcn_mfma_f32_32x32x16_bf16(kf[2], qr[1], C0, 0, 0, 0),   P0[10], P0[11], P0[12], P0[13], pw1[0] = PKW(P0, 8), pw1[1] = PKW(P0, 10), pw1); \
    VRD(5); SBAR(); GAPA(C1 = __builtin_amdgcn_mfma_f32_32x32x16_bf16(kf[3], qr[1], C1, 0, 0, 0),   P0[14], P0[15], P1[0], P1[1],   pw1[2] = PKW(P0, 12), pw1[3] = PKW(P0, 14), pw1); \
    VRD(2); SBAR(); GAPA(C0 = __builtin_amdgcn_mfma_f32_32x32x16_bf16(kf[4], qr[2], C0, 0, 0, 0),   P1[2], P1[3], P1[4], P1[5],     pw2[0] = PKW(P1, 0), pw2[1] = PKW(P1, 2), pw2); \
    VRD(6); SBAR(); GAPA(C1 = __builtin_amdgcn_mfma_f32_32x32x16_bf16(kf[5], qr[2], C1, 0, 0, 0),   P1[6], P1[7], P1[8], P1[9],     pw2[2] = PKW(P1, 4), pw2[3] = PKW(P1, 6), pw2); \
    VRD(3); SBAR(); GAPA(C0 = __builtin_amdgcn_mfma_f32_32x32x16_bf16(kf[6], qr[3], C0, 0, 0, 0),   P1[10], P1[11], P1[12], P1[13], pw3[0] = PKW(P1, 8), pw3[1] = PKW(P1, 10), pw3); \
    VRD(7); SBAR(); GAPA(C1 = __builtin_amdgcn_mfma_f32_32x32x16_bf16(kf[7], qr[3], C1, 0, 0, 0),   P1[14], P1[15], 0.f, 0.f,       pw3[2] = PKW(P1, 12), pw3[3] = PKW(P1, 14), pw3); \
    l_reg += sacc; \
    if (GK) { DMA_K((t) + 3, sl_cur); } if (GV) { DMA_V((t) + 1, sl_next); } \
    CMASK(C0, C1, t); \
    { float a = MX3(C0[0], C0[1], C1[0]), b = MX3(C0[2], C0[3], C1[1]); a = MX3(a, C1[2], C1[3]); \
      _Pragma("unroll") for (int r = 4; r < 16; r += 4) { a = MX3(a, C0[r], C0[r + 1]); b = MX3(b, C0[r + 2], C0[r + 3]); a = MX3(a, C1[r], C1[r + 1]); b = MX3(b, C1[r + 2], C1[r + 3]); } \
      float rm = __builtin_fmaxf(a, b); { auto rr = __builtin_amdgcn_permlane32_swap(__float_as_uint(rm), __float_as_uint(rm), false, false); rm = __builtin_fmaxf(__uint_as_float(rr[0]), __uint_as_float(rr[1])); } \
      resc = false; \
      if (__builtin_expect(__any(rm > (float)THRL), 0)) { const float dl = __builtin_fmaxf(rm, 0.f); mhat += dl; \
        _Pragma("unroll") for (int r = 0; r < 16; ++r) { C0[r] -= dl; C1[r] -= dl; } \
        _Pragma("unroll") for (int r = 0; r < 16; ++r) negm[r] = -mhat; asm volatile("" : "+v"(negm)); \
        const float f = __builtin_amdgcn_exp2f(-dl); l_reg *= f; if (hi == 0) wsf[r32] = f; resc = true; } } \
    SBAR(); \
    GAPB(o[0] = __builtin_amdgcn_mfma_f32_32x32x16_bf16(PAF(0), VFR(0), o[0], 0, 0, 0), C0, 0); \
    GAPB(o[1] = __builtin_amdgcn_mfma_f32_32x32x16_bf16(PAF(0), VFR(4), o[1], 0, 0, 0), C0, 4); \
    KRD(GL, 0); GAPB(o[0] = __builtin_amdgcn_mfma_f32_32x32x16_bf16(PAF(1), VFR(1), o[0], 0, 0, 0), C0, 8); \
    KRD(GL, 1); GAPB(o[1] = __builtin_amdgcn_mfma_f32_32x32x16_bf16(PAF(1), VFR(5), o[1], 0, 0, 0), C0, 12); \
    KRD(GL, 2); GAPB(o[0] = __builtin_amdgcn_mfma_f32_32x32x16_bf16(PAF(2), VFR(2), o[0], 0, 0, 0), C1, 0); \
    KRD(GL, 3); GAPB(o[1] = __builtin_amdgcn_mfma_f32_32x32x16_bf16(PAF(2), VFR(6), o[1], 0, 0, 0), C1, 4); \
    GAPB(o[0] = __builtin_amdgcn_mfma_f32_32x32x16_bf16(PAF(3), VFR(3), o[0], 0, 0, 0), C1, 8); \
    GAPB(o[1] = __builtin_amdgcn_mfma_f32_32x32x16_bf16(PAF(3), VFR(7), o[1], 0, 0, 0), C1, 12); \
    } while (0)
    int t = 1;
#undef CMASK
#define CMASK(P0, P1, t) do {} while (0)
    for (; t + 5 < NT; t += 2) {
        STEP(pB0, pB1, pA0, pA1, t, true, true, true);     WAIT_BAR(2); RESC(); ROT();
        STEP(pA0, pA1, pB0, pB1, t + 1, true, true, true); WAIT_BAR(2); RESC(); ROT();
    }
#undef CMASK
#define CMASK(P0, P1, t) do { int jb_ = (t) - (NT - 4); if (jb_ >= 0) cmask(P0, P1, jb_, qrel, hi); } while (0)
#define ENDW(tt) do { if ((tt) + 3 < NT) { WAIT_BAR(2); } else if ((tt) + 2 < NT) { WAIT_BAR(1); } else { WAIT_BAR(0); } } while (0)
    for (; t + 1 < NT; t += 2) {
        STEP(pB0, pB1, pA0, pA1, t, (t + 3 < NT), (t + 1 < NT), (t + 1 < NT));         ENDW(t);     RESC(); ROT();
        STEP(pA0, pA1, pB0, pB1, t + 1, (t + 4 < NT), (t + 2 < NT), (t + 2 < NT));     ENDW(t + 1); RESC(); ROT();
    }
    STEP(pB0, pB1, pA0, pA1, NT - 1, false, false, false); RESC();
    { float sacc = pB0[0] + pB0[1]; _Pragma("unroll") for (int r = 2; r < 16; ++r) sacc += pB0[r]; _Pragma("unroll") for (int r = 0; r < 16; ++r) sacc += pB1[r]; l_reg += sacc;
      pw0 = (u32x4){PKW(pB0, 0), PKW(pB0, 2), PKW(pB0, 4), PKW(pB0, 6)}; pw1 = (u32x4){PKW(pB0, 8), PKW(pB0, 10), PKW(pB0, 12), PKW(pB0, 14)}; pw2 = (u32x4){PKW(pB1, 0), PKW(pB1, 2), PKW(pB1, 4), PKW(pB1, 6)}; pw3 = (u32x4){PKW(pB1, 8), PKW(pB1, 10), PKW(pB1, 12), PKW(pB1, 14)};
      SBAR(); pv(o, vb0 + sl_cur, PAF(0), PAF(1), PAF(2), PAF(3)); }
#undef PKW
#undef PAF
#undef VFR
#undef PIN
#undef MX3
#undef GAPA
#undef GAPB
#undef EX
#undef VRD
#undef KRD
#undef STEP
#undef ENDW
    { auto rr = __builtin_amdgcn_permlane32_swap(__float_as_uint(l_reg), __float_as_uint(l_reg), false, false); l_reg = __uint_as_float(rr[0]) + __uint_as_float(rr[1]); }
    if (hi == 0) wsf[32 + r32] = l_reg; asm volatile("s_waitcnt lgkmcnt(0)" ::: "memory");
    float rli[16];
#pragma unroll
    for (int r = 0; r < 16; ++r) rli[r] = __builtin_amdgcn_rcpf(wsf[32 + crow(r, hi)]);
    bf16* Ow = Obuf + (rowbase + q0 + wid * QBLK) * PO + oc;
    { bf16* stg = (bf16*)(shm + LDS_OST) + wid * 2048;
#pragma unroll
      for (int r = 0; r < 16; ++r) { const int orow = crow(r, hi);
#pragma unroll
        for (int d0 = 0; d0 < 2; ++d0) stg[orow * 64 + d0 * 32 + r32] = __float2bfloat16(o[d0][r] * rli[r]); }
      asm volatile("s_waitcnt lgkmcnt(0)" ::: "memory");
#pragma unroll
      for (int i = 0; i < 4; ++i) { const int row = i * 8 + (lane >> 3), ch = lane & 7; const u32x4 v = *(const u32x4*)(stg + row * 64 + ch * 8); ATTN_STORE16(Ow + (long)row * PO + ch * 8, v); } }
    asm volatile("s_waitcnt lgkmcnt(0)\n\ts_barrier" ::: "memory");
#undef DMA_K
#undef DMA_V
#undef CMASK
#undef START
#undef RESC
#undef ROT
}
#undef SBAR
#undef WAIT_BAR
}


namespace at2 {
using f32x16 = __attribute__((ext_vector_type(16))) float;
constexpr int PQ = 3072, PO = 256, DV = 128, DQ = 64;
constexpr int NW = 8, QBLK = 32, KVBLK = 64, QB = NW * QBLK;
constexpr int SHM_V = KVBLK * DV * 2, SHM_K = KVBLK * DQ * 2;
constexpr int OFF_VL = 0, OFF_KL = 2 * SHM_V, OFF_WS = 2 * SHM_V + 2 * SHM_K;
constexpr int OFF_OL = OFF_WS + 2048, OL_RS = 272, OL_WAVE = QBLK * OL_RS;
constexpr float THR2 = 8.f;
#define KSWZ64(row, colB) ((row) * 128 + ((colB) ^ (((row) & 7) << 4)))
#define SBAR() __builtin_amdgcn_sched_barrier(0)
__device__ __forceinline__ int v_st(int k, int c) { const int kk = (k & ~0xC) | ((k & 4) << 1) | ((k & 8) >> 1); return ((kk >> 3) * 4 + (c >> 5)) * 512 + ((kk & 7) * 32 + (c & 31)) * 2; }
__device__ __forceinline__ int v_rd_base(int lane) { return ((lane & 3) << 3) | (((lane >> 2) & 3) << 6) | (((lane >> 4) & 1) << 5) | (((lane >> 5) & 1) << 8); }
constexpr int v_rd_off(int d0, int ks, int half) { return d0 * 512 + ks * 4096 + half * 2048; }
__device__ __forceinline__ int crow(int r, int hi) { return (r & 3) + 8 * (r >> 2) + 4 * hi; }
__device__ __forceinline__ bf16x8 load8(const bf16_t* p) { return *reinterpret_cast<const bf16x8*>(p); }
__device__ __forceinline__ void mask_tile(f32x16& p0, f32x16& p1, int dq) {
    const float NEG = -__builtin_inff();
#pragma unroll
    for (int r = 0; r < 16; ++r) { const int c = (r & 3) + 8 * (r >> 2); if (dq - c < 0) p0[r] = NEG; if (dq - c - 32 < 0) p1[r] = NEG; }
}
__device__ __forceinline__ void partialSM(f32x16& p0, f32x16& p1, float& m_reg, float& mn, float& alpha) {
    float pmax = p0[0];
#pragma unroll
    for (int r = 1; r < 16; ++r) pmax = fmaxf(pmax, p0[r]);
#pragma unroll
    for (int r = 0; r < 16; ++r) pmax = fmaxf(pmax, p1[r]);
    { auto rr = __builtin_amdgcn_permlane32_swap(__float_as_uint(pmax), __float_as_uint(pmax), false, false); pmax = fmaxf(__uint_as_float(rr[0]), __uint_as_float(rr[1])); }
    if (__builtin_expect(__all((pmax - m_reg) <= THR2), 1)) { mn = m_reg; alpha = 1.f; }
    else { mn = fmaxf(m_reg, pmax); alpha = __builtin_amdgcn_exp2f(m_reg - mn); m_reg = mn; }
#pragma unroll
    for (int r = 0; r < 16; ++r) { p0[r] = p0[r] - mn; p1[r] = p1[r] - mn; }
#pragma unroll
    for (int r = 0; r < 16; ++r) p0[r] = __builtin_amdgcn_exp2f(p0[r]);
}
__device__ __forceinline__ void finishSM(f32x16& p0, f32x16& p1, float alpha, float& l_reg, bf16x8& pa0, bf16x8& pa1, bf16x8& pa2, bf16x8& pa3) {
#pragma unroll
    for (int r = 0; r < 16; ++r) p1[r] = __builtin_amdgcn_exp2f(p1[r]);
    float ps = 0;
#pragma unroll
    for (int r = 0; r < 16; ++r) ps += p0[r];
#pragma unroll
    for (int r = 0; r < 16; ++r) ps += p1[r];
    { auto rr = __builtin_amdgcn_permlane32_swap(__float_as_uint(ps), __float_as_uint(ps), false, false); ps = __uint_as_float(rr[0]) + __uint_as_float(rr[1]); }
    l_reg = l_reg * alpha + ps;
#define PK4(P, B_, OUT) do { unsigned a0 = cvtpk(P[B_+0], P[B_+1]), a1 = cvtpk(P[B_+2], P[B_+3]);                          \
        unsigned b0 = cvtpk(P[B_+4], P[B_+5]), b1 = cvtpk(P[B_+6], P[B_+7]);                                             \
        auto r0 = __builtin_amdgcn_permlane32_swap(a0, b0, false, false); auto r1 = __builtin_amdgcn_permlane32_swap(a1, b1, false, false); \
        u32x4 w = {r0[0], r1[0], r0[1], r1[1]}; OUT = *reinterpret_cast<bf16x8*>(&w); } while (0)
    PK4(p0, 0, pa0); PK4(p0, 8, pa1); PK4(p1, 0, pa2); PK4(p1, 8, pa3);
#undef PK4
}
template <int KB>
__device__ __forceinline__ void qkt(f32x16& p0, f32x16& p1, const char* K_lds, int r32, int hi, const bf16x8* qr) {
    p0 = f32x16{}; p1 = f32x16{};
#pragma unroll
    for (int d0 = 0; d0 < 4; ++d0) { const char* a = K_lds + KB * SHM_K + KSWZ64(r32, (d0 * 16 + hi * 8) * 2);
        bf16x8 b0 = *reinterpret_cast<const bf16x8*>(a);
        bf16x8 b1 = *reinterpret_cast<const bf16x8*>(a + 32 * 128);
        p0 = __builtin_amdgcn_mfma_f32_32x32x16_bf16(b0, qr[d0], p0, 0, 0, 0);
        p1 = __builtin_amdgcn_mfma_f32_32x32x16_bf16(b1, qr[d0], p1, 0, 0, 0); }
}
template <int VB>
__device__ __forceinline__ void pv_tile(f32x16* o, int vb0, bf16x8 pa0, bf16x8 pa1, bf16x8 pa2, bf16x8 pa3) {
#define TRRD(dst, off) asm volatile("ds_read_b64_tr_b16 %0, %1 offset:%2" : "=&v"(dst) : "v"(vb0), "i"(off) : "memory")
#define PV_D0(d0) do { s16x4 l0, l1, l2, l3, h0, h1, h2, h3; constexpr int b_ = VB * SHM_V + v_rd_off(d0, 0, 0); \
        TRRD(l0, b_); TRRD(h0, b_ + 2048); TRRD(l1, b_ + 4096); TRRD(h1, b_ + 6144); TRRD(l2, b_ + 8192); TRRD(h2, b_ + 10240); TRRD(l3, b_ + 12288); TRRD(h3, b_ + 14336); \
        asm volatile("s_waitcnt lgkmcnt(0)" ::: "memory"); SBAR();   \
        o[d0] = __builtin_amdgcn_mfma_f32_32x32x16_bf16(pa0, (bf16x8){l0[0], l0[1], l0[2], l0[3], h0[0], h0[1], h0[2], h0[3]}, o[d0], 0, 0, 0);   \
        o[d0] = __builtin_amdgcn_mfma_f32_32x32x16_bf16(pa1, (bf16x8){l1[0], l1[1], l1[2], l1[3], h1[0], h1[1], h1[2], h1[3]}, o[d0], 0, 0, 0);   \
        o[d0] = __builtin_amdgcn_mfma_f32_32x32x16_bf16(pa2, (bf16x8){l2[0], l2[1], l2[2], l2[3], h2[0], h2[1], h2[2], h2[3]}, o[d0], 0, 0, 0);   \
        o[d0] = __builtin_amdgcn_mfma_f32_32x32x16_bf16(pa3, (bf16x8){l3[0], l3[1], l3[2], l3[3], h3[0], h3[1], h3[2], h3[3]}, o[d0], 0, 0, 0); } while (0)
    PV_D0(0); PV_D0(1); PV_D0(2); PV_D0(3);
#undef PV_D0
#undef TRRD
}
struct BlockRef { const bf16_t* Q; const bf16_t* K; const bf16_t* V; int P0; int to_lds; float lam; };
struct Seam { bf16x8 qr[4]; bf16x8 st_v0, st_v1, st_k0; };
#define VMW() asm volatile("s_waitcnt vmcnt(0)" ::: "memory")
#define VMWN(n) asm volatile("s_waitcnt vmcnt(%0)" :: "i"(n) : "memory")
#define SLOAD_H(Kp, Vp, k0) do { S.st_v0 = load8((Vp) + (size_t)((k0) + sr) * PQ + sc); S.st_v1 = load8((Vp) + (size_t)((k0) + 32 + sr) * PQ + sc); \
                                 S.st_k0 = load8((Kp) + (size_t)((k0) + kr) * PQ + kc); } while (0)
#define SWRITE_HK(bf) do { *(bf16x8*)(K_lds + (bf) * SHM_K + kws) = S.st_k0; } while (0)
#define SWRITE_HV(bf) do { *(bf16x8*)(V_lds + (bf) * SHM_V + vst0) = S.st_v0; *(bf16x8*)(V_lds + (bf) * SHM_V + vst1) = S.st_v1; } while (0)
#define SWRITE_H(bf) do { SWRITE_HV(bf); SWRITE_HK(bf); } while (0)
__device__ __forceinline__ void prime(const BlockRef& cur, char* lds, Seam& S, int tid, int wid) {
    const int lane = tid & 63, r32 = lane & 31, hi = lane >> 5;
    const int sr = tid >> 4, sc = (tid & 15) * 8, kr = tid >> 3, kc = (tid & 7) * 8, kws = KSWZ64(kr, kc * 2); char* K_lds = lds + OFF_KL;
#pragma unroll
    for (int d0 = 0; d0 < 4; ++d0) S.qr[d0] = load8(cur.Q + (size_t)(wid * QBLK + r32) * PQ + d0 * 16 + hi * 8);
    SLOAD_H(cur.K, cur.V, 0); VMW(); SWRITE_HK(0);
    __syncthreads();
}
__device__ __forceinline__ void block(const BlockRef& cur, const BlockRef& nxt, char* lds, Seam& S, int tid, int wid) {
    asm volatile("" : "+v"(tid));
    const int lane = tid & 63, r32 = lane & 31, hi = lane >> 5;
    const int NT = (cur.P0 + QB - 1) / KVBLK + 1;
    const int qlo = cur.P0 + wid * QBLK, qm = qlo + r32 - 4 * hi;
    char* V_lds = lds + OFF_VL; char* K_lds = lds + OFF_KL;
    float* ws = (float*)(lds + OFF_WS) + wid * 64; float* li_l = ws, * al_l = ws + 32;
    float m_reg = -1e30f, l_reg = 0; f32x16 o[4] = {};
    const int sr = tid >> 4, sc = (tid & 15) * 8, vst0 = v_st(sr, sc), vst1 = v_st(32 + sr, sc), kr = tid >> 3, kc = (tid & 7) * 8, kws = KSWZ64(kr, kc * 2);
    const int vb0 = (int)(uintptr_t)V_lds + v_rd_base(lane);
    const bf16_t* Kh = cur.K; const bf16_t* Vh = cur.V;
#define RESC(a) do { if (__any((a) < 1.f)) { if (hi == 0) al_l[r32] = (a); asm volatile("s_waitcnt lgkmcnt(0)" ::: "memory");              \
                     _Pragma("unroll") for (int d_ = 0; d_ < 4; ++d_) _Pragma("unroll") for (int r = 0; r < 16; ++r) o[d_][r] *= al_l[crow(r, hi)]; } } while (0)
#define KBASE(t) ((t) * KVBLK)
#define MASKT(P0_, P1_, t) do { const int kb_ = KBASE(t); if (kb_ + KVBLK - 1 > qlo) mask_tile(P0_, P1_, qm - kb_); } while (0)
#define SEAM_K0() do { VMWN(4); SWRITE_HK(0); SBAR(); } while (0)
    f32x16 pA0, pA1, pB0, pB1; float mnA, mnB, alA, alB; bf16x8 pa0, pa1, pa2, pa3;
    SWRITE_HV(0); SBAR();
    if (NT > 1) SLOAD_H(Kh, Vh, KBASE(1));
    SBAR(); qkt<0>(pA0, pA1, K_lds, r32, hi, S.qr);
    MASKT(pA0, pA1, 0); partialSM(pA0, pA1, m_reg, mnA, alA);
    if (NT > 1) { VMW(); SWRITE_H(1); }
    __syncthreads();
#define HALF_STEP(PX0, PX1, mnX, alX, PY0, PY1, alY, t, KB, VB, SB) do {                                                      \
        SBAR(); qkt<KB>(PX0, PX1, K_lds, r32, hi, S.qr);                                                                      \
        finishSM(PY0, PY1, alY, l_reg, pa0, pa1, pa2, pa3); SBAR();                                                           \
        if ((t) + 1 < NT) { SLOAD_H(Kh, Vh, KBASE((t) + 1)); SBAR(); }                                                        \
        pv_tile<VB>(o, vb0, pa0, pa1, pa2, pa3); MASKT(PX0, PX1, (t)); partialSM(PX0, PX1, m_reg, mnX, alX);                 \
        __syncthreads();                                                                                                      \
        if ((t) + 1 < NT) { VMW(); SWRITE_H(SB); }                                                                            \
        RESC(alX); __syncthreads(); } while (0)
    for (int t = 1; t + 1 < NT; t += 2) {
        HALF_STEP(pB0, pB1, mnB, alB, pA0, pA1, alA, t, 1, 0, 0);
        HALF_STEP(pA0, pA1, mnA, alA, pB0, pB1, alB, t + 1, 0, 1, 1);
    }
    const bool even = wid >= 6;
    if (even) { SBAR(); qkt<1>(pB0, pB1, K_lds, r32, hi, S.qr); SBAR(); }
    SLOAD_H(nxt.K, nxt.V, 0); SBAR();
#pragma unroll
    for (int d0 = 0; d0 < 4; ++d0) S.qr[d0] = load8(nxt.Q + (size_t)(wid * QBLK + r32) * PQ + d0 * 16 + hi * 8);
    SBAR();
    finishSM(pA0, pA1, alA, l_reg, pa0, pa1, pa2, pa3); SBAR();
    pv_tile<0>(o, vb0, pa0, pa1, pa2, pa3);
    if (even) { MASKT(pB0, pB1, NT - 1); partialSM(pB0, pB1, m_reg, mnB, alB); __syncthreads(); RESC(alB);
        finishSM(pB0, pB1, alB, l_reg, pa0, pa1, pa2, pa3); SBAR(); pv_tile<1>(o, vb0, pa0, pa1, pa2, pa3); }
    else __syncthreads();
    SBAR(); SEAM_K0();
    if (hi == 0) li_l[r32] = l_reg; asm volatile("s_waitcnt lgkmcnt(0)" ::: "memory");
    float rli[16];
#pragma unroll
    for (int r = 0; r < 16; ++r) rli[r] = __builtin_amdgcn_rcpf(li_l[crow(r, hi)]);
    { char* Ol = lds + OFF_OL + wid * OL_WAVE;
      if (!cur.to_lds) {
#pragma unroll
          for (int d0 = 0; d0 < 4; ++d0)
#pragma unroll
              for (int hq = 0; hq < 2; ++hq) { u32x4 wv_;
#pragma unroll
                  for (int q = 0; q < 4; ++q) { const int r = hq * 8 + q * 2; wv_[q] = cvtpk(o[d0][r] * rli[r], o[d0][r + 1] * rli[r + 1]); }
                  *(u32x4*)(Ol + ((d0 * 2 + hq) * 64 + lane) * 16) = wv_; }
      } else {
          u32x4 o1w[8];
#pragma unroll
          for (int i = 0; i < 8; ++i) o1w[i] = *(const u32x4*)(Ol + (i * 64 + lane) * 16);
          asm volatile("s_waitcnt lgkmcnt(0)" ::: "memory");
#pragma unroll
          for (int r = 0; r < 16; ++r) { const int orow = crow(r, hi);
#pragma unroll
              for (int d0 = 0; d0 < 4; ++d0) { const unsigned w1 = o1w[d0 * 2 + (r >> 3)][(r & 7) >> 1]; const float o1v = (r & 1) ? bfhi(w1) : bflo(w1);
                  const float v = o1v - cur.lam * (o[d0][r] * rli[r]); const float vn = sx<1>(v);
                  if ((r32 & 1) == 0) *(unsigned*)(Ol + orow * OL_RS + (d0 * 32 + r32) * 2) = cvtpk(v, vn); } } } }
    asm volatile("s_waitcnt lgkmcnt(0)\n\ts_barrier" ::: "memory");
#undef RESC
#undef KBASE
#undef MASKT
#undef SEAM_K0
#undef HALF_STEP
}
#undef VMW
#undef VMWN
#undef SLOAD_H
#undef SWRITE_HK
#undef SWRITE_HV
#undef SWRITE_H
#undef SBAR
#undef KSWZ64
}

struct Params {
    const float* x; const float* c; const int* positions; const float* norm1; const float* norm2; const float* w_ada; const float* b_ada;
    const float* a_w_in; const float* a_b_if; const float* a_h_norm; const float* a_w_out;
    const float* b_w_in; const float* b_q_norm; const float* b_k_norm; const float* b_lam_q1; const float* b_lam_k1; const float* b_lam_q2; const float* b_lam_k2;
    const float* b_o_norm; const float* b_w_out; const float* w_router; const float* router_bias; const float* moe_w_gu; const float* moe_w_down;
    float* out; unsigned char* ws;
};
struct Frame { LAS unsigned char* lds; int tid, lane, wave, G, bid, vcu; };
__device__ __forceinline__ Frame make_frame(unsigned char* lds, int wv) {
    Frame F; F.lds = (LAS unsigned char*)lds; int t = wv * 64 + lane_id(); asm volatile("" : "+v"(t)); F.tid = t; F.lane = t & 63; F.wave = wv;
    F.G = gridDim.x; F.bid = blockIdx.x; F.vcu = (F.G % 8 == 0) ? (F.bid % 8) * (F.G / 8) + F.bid / 8 : F.bid; return F;
}

struct WItem { const float* W; unsigned char* WT; float* cs; int ldw, Kr, drow0, n0, mode; float s8; };
constexpr int NW_ITEMS = ((WQ_IN0 == 2) ? 48 : 0) + ((WQ_OUT0 == 2) ? 16 : 0) + ((WQ_OUT1 == 2) ? 16 : 0);
__device__ __forceinline__ WItem decode_witem(int it, const Params& p) {
    float* cw = (float*)(p.ws + SC_CW);
    if (WQ_IN0 == 2) { if (it < 48) { const int nb = it; return WItem{p.a_w_in, p.ws + WS_WAIN, cw + CW_AIN, 3080, 1024, 64 * nb, 64 * nb, 2, 0.f}; } it -= 48; }
    if (WQ_OUT0 == 2) { if (it < 16) { const int nb = it; return WItem{p.a_w_out, p.ws + WS_WAOUT, cw + CW_AOUT, 1024, 1024, 64 * nb, 64 * nb, 2, 0.f}; } it -= 16; }
    { const int nb = it; return WItem{p.b_w_out, p.ws + WS_WBOUT, cw + CW_BOUT, 1024, 1024, 64 * nb, 64 * nb, 2, 0.f}; }
}
__device__ __forceinline__ int witem_owner(int it, int G) { return (G == 256) ? 192 + (it & 63) : it % G; }
struct TItem { const float* W; bf16_t* WT; int ldw, K, drow0, k0, n0; float s8; };
__device__ __forceinline__ TItem decode_item(int it, const Params& p) {
    constexpr int I0 = (WQ_IN0 == 2) ? 0 : 16 * 48, I1 = (WQ_OUT0 == 2) ? 0 : 16 * 16, I2 = 16 * 48, I3 = (WQ_OUT1 == 2) ? 0 : 16 * 16, I4 = 32 * 256;
    TItem t; int r = it;
    if (r < I0) { const int kb = r / 48, nb = r % 48; t = (WQ_IN0 == 1) ? TItem{p.a_w_in, (bf16_t*)(p.ws + WS_WAIN), 3080, 1024, 64 * nb, 64 * kb, 64 * nb, S8_WIN} : TItem{p.a_w_in, (bf16_t*)(p.ws + WS_WAIN_BF), 3080, 1024, 64 * nb, 64 * kb, 64 * nb, 0.f}; return t; } r -= I0;
    if (r < I1) { const int kb = r / 16, nb = r % 16; t = (WQ_OUT0 == 1) ? TItem{p.a_w_out, (bf16_t*)(p.ws + WS_WAOUT), 1024, 1024, 64 * nb, 64 * kb, 64 * nb, S8_WOUT} : TItem{p.a_w_out, (bf16_t*)(p.ws + WS_WAOUT_BF), 1024, 1024, 64 * nb, 64 * kb, 64 * nb, 0.f}; return t; } r -= I1;
    if (r < I2) { const int kb = r / 48, nb = r % 48; t = TItem{p.b_w_in, (bf16_t*)(p.ws + WS_WBIN), 3072, 1024, 64 * nb, 64 * kb, 64 * nb, S8_WIN}; return t; } r -= I2;
    if (r < I3) { const int kb = r / 16, nb = r % 16; t = OUTPROJ_FP8 ? TItem{p.b_w_out, (bf16_t*)(p.ws + WS_WBOUT), 1024, 1024, 64 * nb, 64 * kb, 64 * nb, S8_WOUT} : TItem{p.b_w_out, (bf16_t*)(p.ws + WS_WBOUT_BF), 1024, 1024, 64 * nb, 64 * kb, 64 * nb, 0.f}; return t; } r -= I3;
    if (r < I4) { const int mi = r / 256, q = r % 256, kb = q / 16, nb = q % 16; const int n0 = 64 * nb;
        const int drow = ((n0 & 511) >> 7) * 256 + (n0 >> 9) * 128 + (n0 & 127);
        t = TItem{p.moe_w_gu + (size_t)mi * 1024 * 1024, (bf16_t*)(p.ws + WS_WGU + (size_t)mi * 1024 * 1024), 1024, 1024, drow, 64 * kb, n0, S8_WGU}; return t; } r -= I4;
    { const int mi = r / 128, q = r % 128, kb = q / 16, nb = q % 16;
      t = TItem{p.moe_w_down + (size_t)mi * 512 * 1024, (bf16_t*)(p.ws + WS_WDN + (size_t)mi * 1024 * 512), 1024, 512, 64 * nb, 64 * kb, 64 * nb, S8_WDN}; return t; }
}
__device__ __forceinline__ void phase_mod(unsigned char* lds_, int wv, const Params& p) {
    const Frame F = make_frame(lds_, wv);
    LAS float* cact = (LAS float*)F.lds;
    LAS float* red = (LAS float*)(F.lds + 65536);
    float* mod = (float*)(p.ws + WS_MOD);
    for (int i = F.tid; i < NB * DM; i += NTHREADS) { const int b = i >> 10, k = i & 1023; const float v = p.c[i]; cact[k * 16 + b] = v / (1.0f + expf(-v)); }
    __syncthreads();
    for (int task = F.bid; task < 192; task += F.G) {
        const int l = task / 96, cb = task % 96;
        const float* W = p.w_ada + (size_t)l * DM * 6144 + cb * 64 + F.lane;
        float acc[16];
#pragma unroll
        for (int b = 0; b < 16; ++b) acc[b] = 0.f;
        const int kbeg = F.wave * 128;
        for (int kb = kbeg; kb < kbeg + 128; kb += 16) {
            float wv[16];
#pragma unroll
            for (int u = 0; u < 16; ++u) wv[u] = __builtin_nontemporal_load(W + (size_t)(kb + u) * 6144);
#pragma unroll
            for (int u = 0; u < 16; ++u) {
                const LAS f32x4* cc = (const LAS f32x4*)(cact + (kb + u) * 16);
                const f32x4 c0 = cc[0], c1 = cc[1], c2 = cc[2], c3 = cc[3]; const float w = wv[u];
                acc[0] += c0[0] * w; acc[1] += c0[1] * w; acc[2] += c0[2] * w; acc[3] += c0[3] * w;
                acc[4] += c1[0] * w; acc[5] += c1[1] * w; acc[6] += c1[2] * w; acc[7] += c1[3] * w;
                acc[8] += c2[0] * w; acc[9] += c2[1] * w; acc[10] += c2[2] * w; acc[11] += c2[3] * w;
                acc[12] += c3[0] * w; acc[13] += c3[1] * w; acc[14] += c3[2] * w; acc[15] += c3[3] * w;
            }
        }
#pragma unroll
        for (int b = 0; b < 16; ++b) red[(F.wave * 16 + b) * 64 + F.lane] = acc[b];
        __syncthreads();
        for (int o = F.tid; o < 1024; o += NTHREADS) { const int b = o >> 6, cl = o & 63; float s = 0.f;
#pragma unroll
            for (int w = 0; w < 8; ++w) s += red[(w * 16 + b) * 64 + cl];
            mod[((size_t)l * 16 + b) * 6144 + cb * 64 + cl] = s + p.b_ada[(size_t)l * 6144 + cb * 64 + cl]; }
        asm volatile("s_waitcnt vmcnt(0)" ::: "memory");
        __syncthreads();
        if (F.tid == 0) { __builtin_amdgcn_fence(__ATOMIC_RELEASE, "agent"); asm volatile("s_waitcnt vmcnt(0)" ::: "memory"); (void)xb_add((unsigned*)p.ws + CW_MODCNT, 1u); }
    }
}
__device__ __forceinline__ void phase_wconv(unsigned char* lds_, int wv, const Params& p) {
    const Frame F = make_frame(lds_, wv);
    LAS float* scr = (LAS float*)(F.lds + F.wave * 17408);
    LAS float* cmaxw = (LAS float*)(F.lds + 8 * 17408);
    const int lane = F.lane, lr = lane >> 4, c4 = (lane & 15) * 4, w = F.wave;
    for (int it = 0; it < NW_ITEMS; ++it) {
        if (witem_owner(it, F.G) != F.bid) continue;
        const WItem t = decode_witem(it, p);
        const int RW = t.Kr >> 3, NH = RW >> 6;
        f32x4 v[2][16];
#pragma unroll
        for (int hf = 0; hf < 2; ++hf) if (hf < NH) {
#pragma unroll
            for (int i = 0; i < 16; ++i) v[hf][i] = __builtin_nontemporal_load((const f32x4*)(t.W + (size_t)(w * RW + hf * 64 + 4 * i + lr) * t.ldw + t.n0 + c4)); }
        __syncthreads();
        float qs = t.s8;
        if (t.mode == 2) {
            float mx[4] = {0.f, 0.f, 0.f, 0.f};
#pragma unroll
            for (int hf = 0; hf < 2; ++hf) if (hf < NH) {
#pragma unroll
                for (int i = 0; i < 16; ++i)
#pragma unroll
                    for (int q = 0; q < 4; ++q) mx[q] = fmaxf(mx[q], fabsf(v[hf][i][q])); }
#pragma unroll
            for (int q = 0; q < 4; ++q) { mx[q] = fmaxf(mx[q], sx<16>(mx[q])); auto rr = __builtin_amdgcn_permlane32_swap(__float_as_uint(mx[q]), __float_as_uint(mx[q]), false, false); mx[q] = fmaxf(__uint_as_float(rr[0]), __uint_as_float(rr[1])); }
            if (lr == 0) *(LAS f32x4*)(cmaxw + w * 64 + c4) = (f32x4){mx[0], mx[1], mx[2], mx[3]};
            __syncthreads();
            float cm = 0.f;
#pragma unroll
            for (int ww = 0; ww < 8; ++ww) cm = fmaxf(cm, cmaxw[ww * 64 + lane]);
            qs = cm > 0.f ? 127.0f / cm : 0.f;
            if (w == 0) t.cs[t.drow0 + lane] = cm * (1.0f / 127.0f);
        }
#pragma unroll
        for (int hf = 0; hf < 2; ++hf) if (hf < NH) {
#pragma unroll
            for (int i = 0; i < 16; ++i) *(LAS f32x4*)(scr + (4 * i + lr) * 68 + c4) = v[hf][i];
            const int k0 = w * RW + hf * 64;
            if (t.mode == 0) { bf16_t* orow = (bf16_t*)t.WT + (size_t)(t.drow0 + lane) * t.Kr + k0;
#pragma unroll
                for (int c = 0; c < 8; ++c) { float f[8];
#pragma unroll
                    for (int q = 0; q < 8; ++q) f[q] = scr[(8 * c + q) * 68 + lane];
                    u32x4 o; o.x = cvtpk(f[0], f[1]); o.y = cvtpk(f[2], f[3]); o.z = cvtpk(f[4], f[5]); o.w = cvtpk(f[6], f[7]);
                    *(u32x4*)(orow + 8 * c) = o; } }
            else { unsigned char* orow8 = t.WT + (size_t)(t.drow0 + lane) * t.Kr + k0;
#pragma unroll
                for (int c = 0; c < 4; ++c) { float f[16];
#pragma unroll
                    for (int q = 0; q < 16; ++q) f[q] = scr[(16 * c + q) * 68 + lane] * qs;
                    u32x4 o;
                    if (t.mode == 1) { o.x = cvt4_fp8(f[0], f[1], f[2], f[3]); o.y = cvt4_fp8(f[4], f[5], f[6], f[7]); o.z = cvt4_fp8(f[8], f[9], f[10], f[11]); o.w = cvt4_fp8(f[12], f[13], f[14], f[15]); }
                    else { o.x = pack4_i8(f[0], f[1], f[2], f[3]); o.y = pack4_i8(f[4], f[5], f[6], f[7]); o.z = pack4_i8(f[8], f[9], f[10], f[11]); o.w = pack4_i8(f[12], f[13], f[14], f[15]); }
                    *(u32x4*)(orow8 + 16 * c) = o; } }
            asm volatile("s_waitcnt lgkmcnt(0)" ::: "memory");
        }
    }
}

__device__ __forceinline__ void phase_wconv_pw(unsigned char* lds_, int wv, const Params& p) {
    const Frame F = make_frame(lds_, wv);
    LAS float* scr = (LAS float*)(F.lds + F.wave * 17408);
    const int gw = F.vcu * NWAVES + F.wave, NGW = F.G * NWAVES;
    constexpr int NITEMS = ((WQ_IN0 == 2) ? 0 : 16 * 48) + ((WQ_OUT0 == 2) ? 0 : 16 * 16) + 16 * 48 + ((WQ_OUT1 == 2) ? 0 : 16 * 16) + 32 * 256 + 32 * 128;
    const int lane = F.lane, lr = lane >> 4, c4 = (lane & 15) * 4;
    f32x4 v[16];
    int it = gw;
    if (it < NITEMS) { const TItem t = decode_item(it, p);
#pragma unroll
        for (int i = 0; i < 16; ++i) v[i] = __builtin_nontemporal_load((const f32x4*)(t.W + (size_t)(t.k0 + 4 * i + lr) * t.ldw + t.n0 + c4)); }
    for (; it < NITEMS; it += NGW) {
        const TItem t = decode_item(it, p);
#pragma unroll
        for (int i = 0; i < 16; ++i) *(LAS f32x4*)(scr + (4 * i + lr) * 68 + c4) = v[i];
        const int itn = it + NGW;
        if (itn < NITEMS) { const TItem tn = decode_item(itn, p);
#pragma unroll
            for (int i = 0; i < 16; ++i) v[i] = __builtin_nontemporal_load((const f32x4*)(tn.W + (size_t)(tn.k0 + 4 * i + lr) * tn.ldw + tn.n0 + c4)); }
        if (t.s8 > 0.f) {
            unsigned char* orow8 = (unsigned char*)t.WT + (size_t)(t.drow0 + lane) * t.K + t.k0;
#pragma unroll
            for (int c = 0; c < 4; ++c) { float f[16];
#pragma unroll
                for (int q = 0; q < 16; ++q) f[q] = scr[(16 * c + q) * 68 + lane] * t.s8;
                u32x4 o; o.x = cvt4_fp8(f[0], f[1], f[2], f[3]); o.y = cvt4_fp8(f[4], f[5], f[6], f[7]); o.z = cvt4_fp8(f[8], f[9], f[10], f[11]); o.w = cvt4_fp8(f[12], f[13], f[14], f[15]);
                *(u32x4*)(orow8 + 16 * c) = o; }
        } else {
            bf16_t* orow = t.WT + (size_t)(t.drow0 + lane) * t.K + t.k0;
#pragma unroll
            for (int c = 0; c < 8; ++c) { float f[8];
#pragma unroll
                for (int q = 0; q < 8; ++q) f[q] = scr[(8 * c + q) * 68 + lane];
                u32x4 o; o.x = cvtpk(f[0], f[1]); o.y = cvtpk(f[2], f[3]); o.z = cvtpk(f[4], f[5]); o.w = cvtpk(f[6], f[7]);
                *(u32x4*)(orow + 8 * c) = o; }
        }
    }
}

struct RowConst { f32x4 a[4], b[4]; };
__device__ __forceinline__ RowConst load_rowconst(const float* norm, const float* modb, int sh_off, int sc_off, int lane) {
    RowConst rc;
#pragma unroll
    for (int j = 0; j < 4; ++j) { const int c = 256 * j + 4 * lane;
        const f32x4 nv = *(const f32x4*)(norm + c), sc = *(const f32x4*)(modb + sc_off + c); rc.b[j] = *(const f32x4*)(modb + sh_off + c);
        rc.a[j] = nv * (sc + 1.0f); }
    return rc;
}
__device__ __forceinline__ void row_norm_store(const f32x4 (&v)[4], const RowConst& rc, f32x4 (&h)[4], bf16_t* hrow, int lane) {
    float ss = 0.f;
#pragma unroll
    for (int j = 0; j < 4; ++j) ss += (v[j][0] * v[j][0] + v[j][1] * v[j][1]) + (v[j][2] * v[j][2] + v[j][3] * v[j][3]);
    const float r = __builtin_amdgcn_rsqf(wave_sum(ss) * (1.0f / DM) + EPS);
#pragma unroll
    for (int j = 0; j < 4; ++j) { h[j] = v[j] * r * rc.a[j] + rc.b[j];
        u32x2 w; w.x = cvtpk(h[j][0], h[j][1]); w.y = cvtpk(h[j][2], h[j][3]); *(u32x2*)(hrow + 256 * j + 4 * lane) = w; }
}


__device__ __forceinline__ float reduce16(const float (&v)[16], int lane) {
    float a[8], b[4], c[2];
    const bool b5 = (lane & 32) != 0, b4 = (lane & 16) != 0, b3 = (lane & 8) != 0, b2 = (lane & 4) != 0;
#pragma unroll
    for (int i = 0; i < 8; ++i) { const float send = b5 ? v[i] : v[8 + i], keep = b5 ? v[8 + i] : v[i]; a[i] = keep + sx32(send, b5); }
#pragma unroll
    for (int i = 0; i < 4; ++i) { const float send = b4 ? a[i] : a[4 + i], keep = b4 ? a[4 + i] : a[i]; b[i] = keep + sx<16>(send); }
#pragma unroll
    for (int i = 0; i < 2; ++i) { const float send = b3 ? b[i] : b[2 + i], keep = b3 ? b[2 + i] : b[i]; c[i] = keep + sx<8>(send); }
    const float send = b2 ? c[0] : c[1], keep = b2 ? c[1] : c[0];
    float d = keep + sx<4>(send);
    d += sx<1>(d); d += sx<2>(d);
    return d;
}
__device__ __forceinline__ float reduce8(const float (&v)[8], int lane) {
    float b[4], c[2];
    const bool b5 = (lane & 32) != 0, b4 = (lane & 16) != 0, b3 = (lane & 8) != 0;
#pragma unroll
    for (int i = 0; i < 4; ++i) { const float send = b5 ? v[i] : v[4 + i], keep = b5 ? v[4 + i] : v[i]; b[i] = keep + sx32(send, b5); }
#pragma unroll
    for (int i = 0; i < 2; ++i) { const float send = b4 ? b[i] : b[2 + i], keep = b4 ? b[2 + i] : b[i]; c[i] = keep + sx<16>(send); }
    const float send = b3 ? c[0] : c[1], keep = b3 ? c[1] : c[0];
    float d = keep + sx<8>(send);
    d += sx<1>(d); d += sx<2>(d); d += sx<4>(d);
    return d;
}

__device__ __forceinline__ void row_norm_store8(const f32x4 (&v)[4], const RowConst& rc, f32x4 (&h)[4], unsigned char* hrow, int lane) {
    float ss = 0.f;
#pragma unroll
    for (int j = 0; j < 4; ++j) ss += (v[j][0] * v[j][0] + v[j][1] * v[j][1]) + (v[j][2] * v[j][2] + v[j][3] * v[j][3]);
    const float r = __builtin_amdgcn_rsqf(wave_sum(ss) * (1.0f / DM) + EPS);
#pragma unroll
    for (int j = 0; j < 4; ++j) { h[j] = v[j] * r * rc.a[j] + rc.b[j];
        *(unsigned*)(hrow + 256 * j + 4 * lane) = cvt4_fp8(h[j][0] * S8_H, h[j][1] * S8_H, h[j][2] * S8_H, h[j][3] * S8_H); }
}
__device__ __forceinline__ void row_norm_store_i8(const f32x4 (&v)[4], const RowConst& rc, f32x4 (&h)[4], unsigned char* hrow, float* rs_out, int lane) {
    float ss = 0.f;
#pragma unroll
    for (int j = 0; j < 4; ++j) ss += (v[j][0] * v[j][0] + v[j][1] * v[j][1]) + (v[j][2] * v[j][2] + v[j][3] * v[j][3]);
    const float r = __builtin_amdgcn_rsqf(wave_sum(ss) * (1.0f / DM) + EPS);
    float mx = 0.f;
#pragma unroll
    for (int j = 0; j < 4; ++j) { h[j] = v[j] * r * rc.a[j] + rc.b[j]; mx = fmaxf(fmaxf(mx, fmaxf(fabsf(h[j][0]), fabsf(h[j][1]))), fmaxf(fabsf(h[j][2]), fabsf(h[j][3]))); }
    mx = fmaxf(wave_max(mx), 1e-20f);
    const float qs = 127.0f * __builtin_amdgcn_rcpf(mx);
#pragma unroll
    for (int j = 0; j < 4; ++j) *(unsigned*)(hrow + 256 * j + 4 * lane) = pack4_i8(h[j][0] * qs, h[j][1] * qs, h[j][2] * qs, h[j][3] * qs);
    if (lane == 0) *rs_out = mx * (1.0f / 127.0f);
}
__device__ __forceinline__ void phase_hprep0(unsigned char* lds_, int wv, const Params& p) {
    const Frame F = make_frame(lds_, wv);
    LAS f32x4* Wg = (LAS f32x4*)F.lds;
    for (int idx = F.tid; idx < 2048; idx += NTHREADS) { const int ln = idx & 63, half = (idx >> 6) & 1, i = (idx >> 7) & 3, j = idx >> 9; const int c = 256 * j + 4 * ln + i;
        Wg[idx] = *(const f32x4*)(p.a_w_in + (size_t)c * 3080 + 3072 + half * 4); }
    __syncthreads();
    const float* mod = (const float*)(p.ws + WS_MOD);
    unsigned char* H = p.ws + WS_H; float* gates = (float*)(p.ws + WS_GATES);
    const float bif = p.a_b_if[F.lane & 7];
    float* cst = (float*)(p.ws + WS_CS);
    const float invf_tab[8] = {1.0f, 0.19391788f, 0.037604144f, 0.0072920943f, 0.0014140673f, 0.00027421273f, 5.3174683e-05f, 1.0311522e-05f};
    float invf = 0.f;
#pragma unroll
    for (int i = 0; i < 8; ++i) if ((F.lane & 7) == i) invf = invf_tab[i];
    for (int chunk = F.bid; chunk < 256; chunk += F.G) {
        const int row0 = chunk * 128 + F.wave * 16; const int b = row0 / SEQ;
        const RowConst rc = load_rowconst(p.norm1, mod + (size_t)b * 6144, 0, 1024, F.lane);
        for (int rb = 0; rb < 16; rb += 4) {
            f32x4 v[4][4];
#pragma unroll
            for (int rr = 0; rr < 4; ++rr)
#pragma unroll
                for (int j = 0; j < 4; ++j) v[rr][j] = __builtin_nontemporal_load((const f32x4*)(p.x + (size_t)(row0 + rb + rr) * DM + 256 * j + 4 * F.lane));
            f32x4 h[4][4];
#pragma unroll
            for (int rr = 0; rr < 4; ++rr) { const size_t row_ = (size_t)(row0 + rb + rr);
                if (WQ_IN0 == 2) row_norm_store_i8(v[rr], rc, h[rr], H + row_ * DM, (float*)(p.ws + SC_RS_H) + row_, F.lane);
                else if (WQ_IN0 == 1) row_norm_store8(v[rr], rc, h[rr], H + row_ * DM, F.lane);
                else row_norm_store(v[rr], rc, h[rr], (bf16_t*)H + row_ * DM, F.lane); }
            float g[4][8];
#pragma unroll
            for (int rr = 0; rr < 4; ++rr)
#pragma unroll
                for (int q = 0; q < 8; ++q) g[rr][q] = 0.f;
#pragma unroll
            for (int j = 0; j < 4; ++j)
#pragma unroll
                for (int i = 0; i < 4; ++i) { if (i == 0 || i == 2) asm volatile("" ::: "memory");
                    const f32x4 w0 = Wg[((j * 4 + i) * 2 + 0) * 64 + F.lane], w1 = Wg[((j * 4 + i) * 2 + 1) * 64 + F.lane];
#pragma unroll
                    for (int rr = 0; rr < 4; ++rr) { const float hv = h[rr][j][i];
                        g[rr][0] += hv * w0[0]; g[rr][1] += hv * w0[1]; g[rr][2] += hv * w0[2]; g[rr][3] += hv * w0[3]; g[rr][4] += hv * w1[0]; g[rr][5] += hv * w1[1]; g[rr][6] += hv * w1[2]; g[rr][7] += hv * w1[3]; } }
#pragma unroll
            for (int rr = 0; rr < 4; ++rr) { const int row = row0 + rb + rr;
                const float d = reduce8(g[rr], F.lane);
                const float mine = bperm(d, 8 * (F.lane & 7));
                if (F.lane < 16) { const float ang = (float)p.positions[row] * invf; const double rev = (double)ang * 0.15915494309189535; const float frc = (float)(rev - rint(rev));
                    cst[(size_t)row * 16 + F.lane] = (F.lane < 8) ? __builtin_amdgcn_cosf(frc) : __builtin_amdgcn_sinf(frc); }
                if (F.lane < 8) { float val = mine + bif;
                    if (F.lane >= 4) { const float e_ = __expf(-fabsf(val)), u_ = 1.0f + e_;
                        const float l1p = (u_ == 1.0f) ? e_ : __logf(u_) * e_ * __builtin_amdgcn_rcpf(u_ - 1.0f); val = fminf(val, 0.f) - l1p; }
                    gates[(size_t)row * 8 + F.lane] = val; }
            }
        }
    }
}

namespace mls {
constexpr int RSK = 272, RSV = 176, RSP = 272, RSC = 272;
constexpr int OFF_K = 0, OFF_V = 34816, OFF_P = OFF_V + 22528, OFF_C = OFF_P + 34816, OFF_G = OFF_C + 21760;
typedef short v4i16_t __attribute__((ext_vector_type(4)));
__device__ __forceinline__ bf16x8 tr2(const LAS unsigned char* base, int row, int col, int rs, int lane) {
    const int i = lane & 15, g = lane >> 4;
    const LAS unsigned char* p0 = base + (row + 8 * g + (i >> 2)) * rs + (col + 4 * (i & 3)) * 2;
    const s16x4 lo = __builtin_bit_cast(s16x4, __builtin_amdgcn_ds_read_tr16_b64_v4i16((LAS v4i16_t*)p0));
    const s16x4 hi = __builtin_bit_cast(s16x4, __builtin_amdgcn_ds_read_tr16_b64_v4i16((LAS v4i16_t*)(p0 + 4 * rs)));
    return (bf16x8){lo[0], lo[1], lo[2], lo[3], hi[0], hi[1], hi[2], hi[3]};
}
}
__device__ __forceinline__ void phase_mlstm(unsigned char* lds_, int wv, const Params& p) {
    const Frame F = make_frame(lds_, wv);
    using namespace mls;
    const bf16_t* PR = (const bf16_t*)(p.ws + WS_PROJ); const float* gates = (const float*)(p.ws + WS_GATES); bf16_t* HO = (bf16_t*)(p.ws + WS_HOUT);
    LAS unsigned char* Ks = F.lds + OFF_K; LAS unsigned char* Vs = F.lds + OFF_V; LAS unsigned char* Ps = F.lds + OFF_P; LAS unsigned char* Cs = F.lds + OFF_C;
    LAS float* gbase = (LAS float*)(F.lds + OFF_G);
    const int w = F.wave, lane = F.lane, c = lane & 15, g = lane >> 4, tid = F.tid;
    for (int item = F.vcu; item < 256; item += F.G) {
        const int bh = item >> 2, sl = item & 3, b = bh >> 2, h = bh & 3;
        const size_t tok0 = (size_t)b * SEQ;
        const bf16_t* Qg = PR + h * 128; const bf16_t* Kg = PR + 512 + h * 128; const bf16_t* Vg = PR + 1024 + h * 256 + sl * 64;
        __syncthreads();
        if (tid < 256) { const int row = tid >> 1, part = tid & 1; u32x4 z = {0u, 0u, 0u, 0u}; if (part == 0) z.x = 0x3F80u; *(LAS u32x4*)(Vs + row * RSV + 128 + part * 16) = z; }
        f32x4 cacc[5];
#pragma unroll
        for (int vt = 0; vt < 5; ++vt) cacc[vt] = (f32x4){0.f, 0.f, 0.f, 0.f};
        for (int i = tid; i < 80 * RSC / 16; i += NTHREADS) *(LAS u32x4*)(Cs + i * 16) = (u32x4){0u, 0u, 0u, 0u};
        float m_prev = 0.f;
        u32x4 kst[4], vst[2]; bf16x8 qf[4], qn[4]; float glf0 = 0.f, glf1 = 0.f, gi0 = 0.f, gi1 = 0.f;
        auto load_chunk = [&](int ch) {
            const size_t t0 = tok0 + (size_t)ch * 128;
#pragma unroll
            for (int k = 0; k < 4; ++k) { const int pc = tid + 512 * k, row = pc >> 4, c16 = pc & 15; kst[k] = *(const u32x4*)(Kg + (t0 + row) * 3072 + c16 * 8); }
#pragma unroll
            for (int k = 0; k < 2; ++k) { const int pc = tid + 512 * k, row = pc >> 3, c16 = pc & 7; vst[k] = *(const u32x4*)(Vg + (t0 + row) * 3072 + c16 * 8); }
#pragma unroll
            for (int ks = 0; ks < 4; ++ks) qn[ks] = *(const bf16x8*)(Qg + (t0 + 16 * w + c) * 3072 + 32 * ks + 8 * g);
            if (w == 0) { const float* gp = gates + (t0 + 2 * lane) * 8; gi0 = gp[h]; glf0 = gp[4 + h]; gi1 = gp[8 + h]; glf1 = gp[12 + h]; }
        };
        auto gate_scan = [&](LAS float* gs) {
            LAS float* gu = gs; LAS float* gwv = gs + 128; LAS float* gin = gs + 256; LAS float* gfl = gs + 384; LAS float* gwg = gs + 512;
            float s = glf0 + glf1;
#pragma unroll
            for (int d = 1; d < 64; d <<= 1) { const float t = bperm(s, (lane - d) & 63); if (lane >= d) s += t; }
            const float b1 = s, b0 = s - glf1;
            const float u0 = gi0 - b0, u1 = gi1 - b1;
            float m = fmaxf(u0, u1);
#pragma unroll
            for (int d = 1; d < 64; d <<= 1) { const float t = bperm(m, (lane - d) & 63); if (lane >= d) m = fmaxf(m, t); }
            float ex = bperm(m, (lane - 1) & 63); if (lane == 0) ex = -INFINITY;
            const float wv0 = fmaxf(fmaxf(ex, u0), m_prev), wv1 = fmaxf(m, m_prev);
            const float wlast = rdlane(wv1, 63), blast = rdlane(b1, 63);
            gu[2 * lane] = u0; gu[2 * lane + 1] = u1; gwv[2 * lane] = wv0; gwv[2 * lane + 1] = wv1;
            gin[2 * lane] = __expf(m_prev - wv0); gin[2 * lane + 1] = __expf(m_prev - wv1);
            gfl[2 * lane] = __expf(-(b0 + wv0)); gfl[2 * lane + 1] = __expf(-(b1 + wv1));
            gwg[2 * lane] = __expf(u0 - wlast); gwg[2 * lane + 1] = __expf(u1 - wlast);
            m_prev = blast + wlast;
        };
        auto store_chunk = [&]() {
#pragma unroll
            for (int k = 0; k < 4; ++k) { const int pc = tid + 512 * k, row = pc >> 4, c16 = pc & 15; *(LAS u32x4*)(Ks + row * RSK + c16 * 16) = kst[k]; }
#pragma unroll
            for (int k = 0; k < 2; ++k) { const int pc = tid + 512 * k, row = pc >> 3, c16 = pc & 7; *(LAS u32x4*)(Vs + row * RSV + c16 * 16) = vst[k]; }
#pragma unroll
            for (int ks = 0; ks < 4; ++ks) qf[ks] = qn[ks];
        };
        load_chunk(0);
        store_chunk();
        if (w == 0) gate_scan(gbase);
        __syncthreads();
        for (int ch = 0; ch < 16; ++ch) {
            LAS float* gs = gbase + (ch & 1) * 640;
            LAS float* gu = gs; LAS float* gwv = gs + 128; LAS float* gin = gs + 256; LAS float* gfl = gs + 384; LAS float* gwg = gs + 512;
            if (ch < 15) load_chunk(ch + 1);
            {
                const int t = 16 * w + c; const float wt = gwv[t];
#pragma unroll
                for (int jp = 0; jp < 4; ++jp) {
                    if (2 * jp <= w) {
                        f32x4 sa0 = (f32x4){0.f, 0.f, 0.f, 0.f}, sa1 = sa0;
#pragma unroll
                        for (int ks = 0; ks < 4; ++ks) { const bf16x8 kf0 = *(const LAS bf16x8*)(Ks + (32 * jp + c) * RSK + (32 * ks + 8 * g) * 2), kf1 = *(const LAS bf16x8*)(Ks + (32 * jp + 16 + c) * RSK + (32 * ks + 8 * g) * 2);
                            sa0 = __builtin_amdgcn_mfma_f32_16x16x32_bf16(kf0, qf[ks], sa0, 0, 0, 0); sa1 = __builtin_amdgcn_mfma_f32_16x16x32_bf16(kf1, qf[ks], sa1, 0, 0, 0); }
                        const f32x4 uv0 = *(const LAS f32x4*)(gu + 32 * jp + 4 * g), uv1 = *(const LAS f32x4*)(gu + 32 * jp + 16 + 4 * g);
                        float p0_[4], p1_[4];
#pragma unroll
                        for (int r = 0; r < 4; ++r) { const int s0 = 32 * jp + 4 * g + r, s1 = s0 + 16;
                            const float e0 = __expf(uv0[r] - wt), e1 = __expf(uv1[r] - wt); p0_[r] = (s0 <= t) ? sa0[r] * e0 : 0.f; p1_[r] = (s1 <= t) ? sa1[r] * e1 : 0.f; }
                        u32x2 pk0, pk1; pk0.x = cvtpk(p0_[0], p0_[1]); pk0.y = cvtpk(p0_[2], p0_[3]); pk1.x = cvtpk(p1_[0], p1_[1]); pk1.y = cvtpk(p1_[2], p1_[3]);
                        *(LAS u32x2*)(Ps + t * RSP + (32 * jp + 4 * g) * 2) = pk0; *(LAS u32x2*)(Ps + t * RSP + (32 * jp + 16 + 4 * g) * 2) = pk1;
                    }
                }
            }
            f32x4 nacc[5];
#pragma unroll
            for (int vt = 0; vt < 5; ++vt) { nacc[vt] = (f32x4){0.f, 0.f, 0.f, 0.f};
#pragma unroll
                for (int ks = 0; ks < 4; ++ks) { const bf16x8 cf = *(const LAS bf16x8*)(Cs + (16 * vt + c) * RSC + (32 * ks + 8 * g) * 2); nacc[vt] = __builtin_amdgcn_mfma_f32_16x16x32_bf16(cf, qf[ks], nacc[vt], 0, 0, 0); } }
            { const float iv = gin[16 * w + c];
#pragma unroll
              for (int vt = 0; vt < 5; ++vt) nacc[vt] = nacc[vt] * iv; }
            if (w == 0 && ch < 15) gate_scan(gbase + ((ch + 1) & 1) * 640);
            for (int ks = 0; ks <= (w >> 1); ++ks) {
                const bf16x8 pf = *(const LAS bf16x8*)(Ps + (16 * w + c) * RSP + (32 * ks + 8 * g) * 2);
#pragma unroll
                for (int vt = 0; vt < 5; ++vt) { const bf16x8 vf = tr2(Vs, 32 * ks, 16 * vt, RSV, lane); nacc[vt] = __builtin_amdgcn_mfma_f32_16x16x32_bf16(vf, pf, nacc[vt], 0, 0, 0); }
            }
            { const float den = bperm(nacc[4][0], lane & 15); const float inv = 1.0f / fmaxf(fabsf(den), gfl[16 * w + c]);
              bf16_t* orow = HO + (tok0 + (size_t)ch * 128 + 16 * w + c) * DM + h * 256 + sl * 64 + 4 * g;
#pragma unroll
              for (int vt = 0; vt < 4; ++vt) { u32x2 pk; pk.x = cvtpk(nacc[vt][0] * inv, nacc[vt][1] * inv); pk.y = cvtpk(nacc[vt][2] * inv, nacc[vt][3] * inv); *(u32x2*)(orow + 16 * vt) = pk; } }
            { const float decay = gin[127];
#pragma unroll
              for (int vt = 0; vt < 5; ++vt) cacc[vt] = cacc[vt] * decay;
#pragma unroll
              for (int ks = 0; ks < 4; ++ks) {
                  bf16x8 kf = tr2(Ks, 32 * ks, 16 * w, RSK, lane);
                  const f32x4 w0 = *(const LAS f32x4*)(gwg + 32 * ks + 8 * g), w1 = *(const LAS f32x4*)(gwg + 32 * ks + 8 * g + 4);
                  u32x4 kw = __builtin_bit_cast(u32x4, kf);
                  kw.x = cvtpk(bflo(kw.x) * w0[0], bfhi(kw.x) * w0[1]); kw.y = cvtpk(bflo(kw.y) * w0[2], bfhi(kw.y) * w0[3]);
                  kw.z = cvtpk(bflo(kw.z) * w1[0], bfhi(kw.z) * w1[1]); kw.w = cvtpk(bflo(kw.w) * w1[2], bfhi(kw.w) * w1[3]);
                  kf = __builtin_bit_cast(bf16x8, kw);
#pragma unroll
                  for (int vt = 0; vt < 5; ++vt) { const bf16x8 vf = tr2(Vs, 32 * ks, 16 * vt, RSV, lane); cacc[vt] = __builtin_amdgcn_mfma_f32_16x16x32_bf16(kf, vf, cacc[vt], 0, 0, 0); }
              } }
            asm volatile("s_waitcnt lgkmcnt(0)\n\ts_barrier" ::: "memory");
#pragma unroll
            for (int vt = 0; vt < 5; ++vt) { u32x2 pk; pk.x = cvtpk(cacc[vt][0], cacc[vt][1]); pk.y = cvtpk(cacc[vt][2], cacc[vt][3]); *(LAS u32x2*)(Cs + (16 * vt + c) * RSC + (16 * w + 4 * g) * 2) = pk; }
            if (ch < 15) store_chunk();
            __syncthreads();
        }
    }
}

__device__ __forceinline__ void phase_aprep(unsigned char* lds_, int wv, const Params& p) {
    const Frame F = make_frame(lds_, wv);
    const bf16_t* HO = (const bf16_t*)(p.ws + WS_HOUT); const bf16_t* PR = (const bf16_t*)(p.ws + WS_PROJ); unsigned char* A2 = p.ws + WS_H;
    float hn[16];
#pragma unroll
    for (int i = 0; i < 16; ++i) hn[i] = p.a_h_norm[16 * F.lane + i];
    const int gw = F.bid * NWAVES + F.wave, NGW = F.G * NWAVES;
    for (int rowb = gw; rowb < NTOK; rowb += 4 * NGW) {
        u32x4 h0[4], h1[4], o0[4], o1[4];
#pragma unroll
        for (int rr = 0; rr < 4; ++rr) { const int row = rowb + rr * NGW; if (row < NTOK) {
            h0[rr] = *(const u32x4*)(HO + (size_t)row * DM + 16 * F.lane); h1[rr] = *(const u32x4*)(HO + (size_t)row * DM + 16 * F.lane + 8);
            o0[rr] = *(const u32x4*)(PR + (size_t)row * 3072 + 2048 + 16 * F.lane); o1[rr] = *(const u32x4*)(PR + (size_t)row * 3072 + 2048 + 16 * F.lane + 8); } }
#pragma unroll
        for (int rr = 0; rr < 4; ++rr) { const int row = rowb + rr * NGW; if (row < NTOK) {
            float hv[16], ov[16];
#pragma unroll
            for (int i = 0; i < 4; ++i) { hv[2 * i] = bflo(h0[rr][i]); hv[2 * i + 1] = bfhi(h0[rr][i]); hv[8 + 2 * i] = bflo(h1[rr][i]); hv[8 + 2 * i + 1] = bfhi(h1[rr][i]);
                ov[2 * i] = bflo(o0[rr][i]); ov[2 * i + 1] = bfhi(o0[rr][i]); ov[8 + 2 * i] = bflo(o1[rr][i]); ov[8 + 2 * i + 1] = bfhi(o1[rr][i]); }
            float ss = 0.f;
#pragma unroll
            for (int i = 0; i < 16; ++i) ss += hv[i] * hv[i];
            ss += sx<1>(ss); ss += sx<2>(ss); ss += sx<4>(ss); ss += sx<8>(ss);
            const float r = __builtin_amdgcn_rsqf(ss * (1.0f / 256.0f) + EPS);
            float y[16];
#pragma unroll
            for (int i = 0; i < 16; ++i) y[i] = hv[i] * r * hn[i] * sigmoidf_(ov[i]);
            if (WQ_OUT0 == 2) { float mx = 0.f;
#pragma unroll
                for (int i = 0; i < 16; ++i) mx = fmaxf(mx, fabsf(y[i]));
                mx = fmaxf(wave_max(mx), 1e-20f); const float qs = 127.0f * __builtin_amdgcn_rcpf(mx);
                u32x4 w; w.x = pack4_i8(y[0] * qs, y[1] * qs, y[2] * qs, y[3] * qs); w.y = pack4_i8(y[4] * qs, y[5] * qs, y[6] * qs, y[7] * qs); w.z = pack4_i8(y[8] * qs, y[9] * qs, y[10] * qs, y[11] * qs); w.w = pack4_i8(y[12] * qs, y[13] * qs, y[14] * qs, y[15] * qs);
                *(u32x4*)(A2 + (size_t)row * DM + 16 * F.lane) = w; if (F.lane == 0) ((float*)(p.ws + SC_RS_A))[row] = mx * (1.0f / 127.0f); }
            else if (OUTPROJ_FP8) { u32x4 w; w.x = cvt4_fp8(y[0] * S8_A2, y[1] * S8_A2, y[2] * S8_A2, y[3] * S8_A2); w.y = cvt4_fp8(y[4] * S8_A2, y[5] * S8_A2, y[6] * S8_A2, y[7] * S8_A2);
                w.z = cvt4_fp8(y[8] * S8_A2, y[9] * S8_A2, y[10] * S8_A2, y[11] * S8_A2); w.w = cvt4_fp8(y[12] * S8_A2, y[13] * S8_A2, y[14] * S8_A2, y[15] * S8_A2);
                *(u32x4*)(A2 + (size_t)row * DM + 16 * F.lane) = w; }
            else { bf16_t* a2b = (bf16_t*)(p.ws + WS_A2B) + (size_t)row * DM + 16 * F.lane; u32x4 w0, w1;
                w0.x = cvtpk(y[0], y[1]); w0.y = cvtpk(y[2], y[3]); w0.z = cvtpk(y[4], y[5]); w0.w = cvtpk(y[6], y[7]); w1.x = cvtpk(y[8], y[9]); w1.y = cvtpk(y[10], y[11]); w1.z = cvtpk(y[12], y[13]); w1.w = cvtpk(y[14], y[15]);
                *(u32x4*)a2b = w0; *(u32x4*)(a2b + 8) = w1; }
            } }
    }
}

__device__ __forceinline__ void phase_hprep_router(unsigned char* lds_, int wv, const Params& p, int layer, int xnx, int xdx, int xper, int xj, const unsigned* oflags) {
    const Frame F = make_frame(lds_, wv);
    LAS u32x4* Wf = (LAS u32x4*)F.lds;
    LAS float* mulc = (LAS float*)(F.lds + 65536);
    LAS float* addc = (LAS float*)(F.lds + 65536 + 4096);
    LAS int* cnt = (LAS int*)(F.lds + 73728);
    LAS float* lgs = (LAS float*)(F.lds + 73728 + 64);
    const float* mod = (const float*)(p.ws + WS_MOD) + (size_t)layer * 16 * 6144;
    unsigned char* H = p.ws + WS_H;
    const bf16_t* XB = (const bf16_t*)(p.ws + WS_XB);
    int* blkcnt = (int*)(p.ws + RT_BLKCNT); int* info = (int*)(p.ws + RT_INFO); float* tw = (float*)(p.ws + RT_W);
    if (F.bid == 0) { for (int i = F.tid; i < 256 * DM / 16; i += NTHREADS) *(u32x4*)(H + (size_t)NTOK * DM + i * 16) = (u32x4){0u, 0u, 0u, 0u}; }
    float rb[16];
#pragma unroll
    for (int e = 0; e < 16; ++e) rb[e] = p.router_bias[e];
    const int ctlo = 2 * ((xdx * 128) / xnx), cthi = 2 * (((xdx + 1) * 128) / xnx);
    bool first = true;
    for (int chunk = ctlo + xj; chunk < cthi; chunk += xper) {
        int lane = F.lane; asm volatile("" : "+v"(lane));
        const int fr = lane & 15, fq = lane >> 4;
        const int row = chunk * 128 + F.wave * 16 + fr; const int b = (chunk * 128) / SEQ;
        if (first) { first = false;
            for (int idx = F.tid; idx < 2048; idx += NTHREADS) { const int ln = idx & 63, ks = idx >> 6; const int col0 = 64 * (ks >> 1) + 16 * (ln >> 4) + 8 * (ks & 1);
                const float* wp = p.w_router + (size_t)col0 * 16 + (ln & 15); u32x4 hi, lo;
#pragma unroll
                for (int i = 0; i < 4; ++i) { const float a = wp[(2 * i) * 16], c = wp[(2 * i + 1) * 16]; const unsigned u = cvtpk(a, c); hi[i] = u; lo[i] = cvtpk(a - bflo(u), c - bfhi(u)); }
                Wf[idx] = hi; Wf[2048 + idx] = lo; } }
        for (int c = F.tid; c < DM; c += NTHREADS) { mulc[c] = p.norm2[(size_t)layer * DM + c] * (1.0f + mod[(size_t)b * 6144 + 4096 + c]); addc[c] = mod[(size_t)b * 6144 + 3072 + c]; }
        if (oflags) { unsigned sp = 0u; while (xb_ld((unsigned*)oflags + (chunk >> 1)) < 32u) { __builtin_amdgcn_s_sleep(2); if (++sp > (1u << 22)) break; } asm volatile("" ::: "memory"); }
        u32x4 xv[16][2];
        { const bf16_t* xrow = XB + (size_t)row * DM + 16 * fq;
#pragma unroll
          for (int s = 0; s < 16; ++s) { xv[s][0] = *(const u32x4*)(xrow + 64 * s); xv[s][1] = *(const u32x4*)(xrow + 64 * s + 8); } }
        if (F.tid < 16) cnt[F.tid] = 0;
        __syncthreads();
        float ss = 0.f;
#pragma unroll
        for (int s = 0; s < 16; ++s)
#pragma unroll
            for (int t = 0; t < 2; ++t)
#pragma unroll
                for (int i = 0; i < 4; ++i) { const float a = bflo(xv[s][t][i]), c = bfhi(xv[s][t][i]); ss += a * a + c * c; }
        ss += sx<16>(ss); ss += sx32(ss, lane >= 32);
        const float r = __builtin_amdgcn_rsqf(ss * (1.0f / DM) + EPS);
        f32x4 acc0 = (f32x4){0.f, 0.f, 0.f, 0.f}, acc1 = acc0, acc2 = acc0;
        unsigned char* hrow = H + (size_t)row * DM + 16 * fq;
#pragma unroll
        for (int s = 0; s < 16; ++s) {
            asm volatile("" ::: "memory");
            float h[16];
#pragma unroll
            for (int q = 0; q < 4; ++q) { const f32x4 m = *(const LAS f32x4*)(mulc + 64 * s + 16 * fq + 4 * q), a = *(const LAS f32x4*)(addc + 64 * s + 16 * fq + 4 * q);
                unsigned w0 = xv[s][q >> 1][(q & 1) * 2], w1 = xv[s][q >> 1][(q & 1) * 2 + 1]; asm volatile("" : "+v"(w0), "+v"(w1));
                h[4 * q] = bflo(w0) * r * m[0] + a[0]; h[4 * q + 1] = bfhi(w0) * r * m[1] + a[1]; h[4 * q + 2] = bflo(w1) * r * m[2] + a[2]; h[4 * q + 3] = bfhi(w1) * r * m[3] + a[3]; }
            u32x4 o; o.x = cvt4_fp8(h[0] * S8_H, h[1] * S8_H, h[2] * S8_H, h[3] * S8_H); o.y = cvt4_fp8(h[4] * S8_H, h[5] * S8_H, h[6] * S8_H, h[7] * S8_H);
            o.z = cvt4_fp8(h[8] * S8_H, h[9] * S8_H, h[10] * S8_H, h[11] * S8_H); o.w = cvt4_fp8(h[12] * S8_H, h[13] * S8_H, h[14] * S8_H, h[15] * S8_H);
            *(u32x4*)(hrow + 64 * s) = o;
#pragma unroll
            for (int t = 0; t < 2; ++t) { u32x4 hi, lo;
#pragma unroll
                for (int i = 0; i < 4; ++i) { const float a = h[8 * t + 2 * i], c = h[8 * t + 2 * i + 1]; const unsigned u = cvtpk(a, c); hi[i] = u; lo[i] = cvtpk(a - bflo(u), c - bfhi(u)); }
                const int ks = 2 * s + t;
                const bf16x8 whi = __builtin_bit_cast(bf16x8, Wf[ks * 64 + lane]), wlo = __builtin_bit_cast(bf16x8, Wf[2048 + ks * 64 + lane]);
                const bf16x8 hh = __builtin_bit_cast(bf16x8, hi), hl = __builtin_bit_cast(bf16x8, lo);
                acc0 = __builtin_amdgcn_mfma_f32_16x16x32_bf16(whi, hh, acc0, 0, 0, 0);
                acc1 = __builtin_amdgcn_mfma_f32_16x16x32_bf16(wlo, hh, acc1, 0, 0, 0);
                acc2 = __builtin_amdgcn_mfma_f32_16x16x32_bf16(whi, hl, acc2, 0, 0, 0); }
        }
        { const f32x4 tot = acc0 + (acc1 + acc2);
#pragma unroll
          for (int rr = 0; rr < 4; ++rr) lgs[(F.wave * 16 + fr) * 17 + 4 * fq + rr] = tot[rr]; }
        __syncthreads();
        if (F.tid < 128) {
            const int row = chunk * 128 + F.tid;
            float sc[16], bs[16];
#pragma unroll
            for (int e = 0; e < 16; ++e) { sc[e] = __builtin_amdgcn_rcpf(1.0f + __expf(-lgs[F.tid * 17 + e])); bs[e] = sc[e] + rb[e]; }
            int gsel = 0; float gbest = -INFINITY;
#pragma unroll
            for (int gI = 0; gI < 4; ++gI) { const float a = bs[4 * gI], b2 = bs[4 * gI + 1], c2 = bs[4 * gI + 2], d2 = bs[4 * gI + 3];
                const float hi1 = fmaxf(a, b2), lo1 = fminf(a, b2), hi2 = fmaxf(c2, d2), lo2 = fminf(c2, d2);
                const float top = fmaxf(hi1, hi2), sec = fmaxf(fminf(hi1, hi2), fmaxf(lo1, lo2)); const float gs = top + sec;
                if (gs > gbest) { gbest = gs; gsel = gI; } }
            float v0 = 0.f, v1 = 0.f, v2 = 0.f, v3 = 0.f, s0 = 0.f, s1 = 0.f, s2 = 0.f, s3 = 0.f;
#pragma unroll
            for (int gI = 0; gI < 4; ++gI) if (gI == gsel) { v0 = bs[4 * gI]; v1 = bs[4 * gI + 1]; v2 = bs[4 * gI + 2]; v3 = bs[4 * gI + 3]; s0 = sc[4 * gI]; s1 = sc[4 * gI + 1]; s2 = sc[4 * gI + 2]; s3 = sc[4 * gI + 3]; }
            int i1 = 0; float b1 = v0; if (v1 > b1) { b1 = v1; i1 = 1; } if (v2 > b1) { b1 = v2; i1 = 2; } if (v3 > b1) { b1 = v3; i1 = 3; }
            int i2 = -1; float bb = -INFINITY;
            if (i1 != 0 && v0 > bb) { bb = v0; i2 = 0; } if (i1 != 1 && v1 > bb) { bb = v1; i2 = 1; } if (i1 != 2 && v2 > bb) { bb = v2; i2 = 2; } if (i1 != 3 && v3 > bb) { bb = v3; i2 = 3; }
            const float sa = (i1 == 0) ? s0 : (i1 == 1) ? s1 : (i1 == 2) ? s2 : s3;
            const float sb = (i2 == 0) ? s0 : (i2 == 1) ? s1 : (i2 == 2) ? s2 : s3;
            const int e0 = gsel * 4 + i1, e1 = gsel * 4 + i2;
            const int r0 = __hip_atomic_fetch_add(&cnt[e0], 1, __ATOMIC_RELAXED, __HIP_MEMORY_SCOPE_WORKGROUP); const int r1 = __hip_atomic_fetch_add(&cnt[e1], 1, __ATOMIC_RELAXED, __HIP_MEMORY_SCOPE_WORKGROUP);
            info[row] = e0 | (e1 << 4) | (r0 << 8) | (r1 << 16); const float inv = 1.0f / (sa + sb); *(f32x2*)(tw + (size_t)row * 2) = (f32x2){sa * inv, sb * inv};
        }
        __syncthreads();
        if (F.tid < 16) blkcnt[chunk * 16 + F.tid] = cnt[F.tid];
        __syncthreads();
    }
}

__device__ __forceinline__ void phase_layout(unsigned char* lds_, int wv, const Params& p) {
    const Frame F = make_frame(lds_, wv);
    LAS int* lc = (LAS int*)F.lds;
    LAS int* tot = lc + 4096;
    LAS int* sst = tot + 16;
    LAS int* tst = sst + 16;
    const int* blkcnt = (const int*)(p.ws + RT_BLKCNT); const int* info = (const int*)(p.ws + RT_INFO);
    int* dest = (int*)(p.ws + RT_DEST); int* buftok = (int*)(p.ws + RT_BUFTOK); int* meta = (int*)(p.ws + RT_META);
    for (int i = F.tid; i < 4096; i += NTHREADS) lc[i] = blkcnt[i];
    __syncthreads();
    { const int e = F.tid >> 5, li = F.tid & 31; int v[8]; int s = 0;
      LAS int* part = tst + 32;
#pragma unroll
      for (int k = 0; k < 8; ++k) { v[k] = lc[(8 * li + k) * 16 + e]; s += v[k]; }
      part[e * 32 + li] = s;
      __syncthreads();
      int run = 0, all = 0;
      for (int k = 0; k < 32; ++k) { const int t = part[e * 32 + k]; all += t; if (k < li) run += t; }
#pragma unroll
      for (int k = 0; k < 8; ++k) { lc[(8 * li + k) * 16 + e] = run; run += v[k]; }
      if (li == 31) tot[e] = all; }
    __syncthreads();
    if (F.tid == 0) { int ts = 0; for (int e = 0; e < 16; ++e) { tst[e] = ts; sst[e] = ts * 256; ts += (tot[e] + 255) >> 8; } tst[16] = ts;
        if (F.bid == 0) { meta[0] = ts; for (int e = 0; e <= 16; ++e) meta[1 + e] = tst[e]; } }
    __syncthreads();
    for (int chunk = F.bid; chunk < 256; chunk += F.G) {
        if (F.tid < 128) { const int tok = chunk * 128 + F.tid; const int inf = info[tok]; const int e0 = inf & 15, e1 = (inf >> 4) & 15, r0 = (inf >> 8) & 255, r1 = (inf >> 16) & 255;
            const int d0 = sst[e0] + lc[chunk * 16 + e0] + r0, d1 = sst[e1] + lc[chunk * 16 + e1] + r1;
            buftok[d0] = tok; buftok[d1] = tok; dest[tok * 2] = d0; dest[tok * 2 + 1] = d1; }
    }
    for (int e = F.bid; e < 16; e += F.G) { const int beg = sst[e] + tot[e], end = tst[e + 1] * 256; for (int s = beg + F.tid; s < end; s += NTHREADS) buftok[s] = NTOK; }
}

__device__ __forceinline__ void phase_combine(unsigned char* lds_, int wv, const Params& p, int layer, bool next_prep) {
    const Frame F = make_frame(lds_, wv);
    const float* mod = (const float*)(p.ws + WS_MOD) + (size_t)layer * 16 * 6144;
    const float* modn = (const float*)(p.ws + WS_MOD) + (size_t)(layer + 1) * 16 * 6144;
    const unsigned char* Y = p.ws + WS_PROJ; unsigned char* H = p.ws + WS_H;
    bf16_t* XB = (bf16_t*)(p.ws + WS_XB);
    const int* dest = (const int*)(p.ws + RT_DEST); const float* tw = (const float*)(p.ws + RT_W);
    for (int chunk = F.bid; chunk < 256; chunk += F.G) {
        const int row0 = chunk * 128 + F.wave * 16; const int b = row0 / SEQ;
        f32x4 g2[4];
#pragma unroll
        for (int j = 0; j < 4; ++j) g2[j] = *(const f32x4*)(mod + (size_t)b * 6144 + 5120 + 256 * j + 4 * F.lane) * (1.0f / S8_Y);
        RowConst rc;
        if (next_prep) rc = load_rowconst(p.norm1 + (size_t)(layer + 1) * DM, modn + (size_t)b * 6144, 0, 1024, F.lane);
        for (int rb = 0; rb < 16; rb += 4) {
            int d0[4], d1[4]; float w0[4], w1[4];
#pragma unroll
            for (int rr = 0; rr < 4; ++rr) { const int row = row0 + rb + rr; d0[rr] = dest[row * 2]; d1[rr] = dest[row * 2 + 1]; w0[rr] = tw[row * 2]; w1[rr] = tw[row * 2 + 1]; }
            u32x2 xr[4][4]; unsigned ya[4][4], yb[4][4];
#pragma unroll
            for (int rr = 0; rr < 4; ++rr)
#pragma unroll
                for (int j = 0; j < 4; ++j) { xr[rr][j] = *(const u32x2*)(XB + (size_t)(row0 + rb + rr) * DM + 256 * j + 4 * F.lane);
                    ya[rr][j] = *(const unsigned*)(Y + (size_t)d0[rr] * DM + 256 * j + 4 * F.lane); yb[rr][j] = *(const unsigned*)(Y + (size_t)d1[rr] * DM + 256 * j + 4 * F.lane); }
#pragma unroll
            for (int rr = 0; rr < 4; ++rr) { const int row = row0 + rb + rr;
                f32x4 v[4];
#pragma unroll
                for (int j = 0; j < 4; ++j) { const unsigned a = ya[rr][j], bq = yb[rr][j]; f32x4 yy;
                    const f32x2 a01 = __builtin_amdgcn_cvt_pk_f32_fp8((int)a, false), a23 = __builtin_amdgcn_cvt_pk_f32_fp8((int)a, true), b01 = __builtin_amdgcn_cvt_pk_f32_fp8((int)bq, false), b23 = __builtin_amdgcn_cvt_pk_f32_fp8((int)bq, true);
                    yy[0] = w0[rr] * a01[0] + w1[rr] * b01[0]; yy[1] = w0[rr] * a01[1] + w1[rr] * b01[1]; yy[2] = w0[rr] * a23[0] + w1[rr] * b23[0]; yy[3] = w0[rr] * a23[1] + w1[rr] * b23[1];
                    const f32x4 xv = (f32x4){bflo(xr[rr][j].x), bfhi(xr[rr][j].x), bflo(xr[rr][j].y), bfhi(xr[rr][j].y)};
                    v[j] = xv + g2[j] * yy;
                    if (next_prep) { u32x2 w; w.x = cvtpk(v[j][0], v[j][1]); w.y = cvtpk(v[j][2], v[j][3]); *(u32x2*)(XB + (size_t)row * DM + 256 * j + 4 * F.lane) = w; }
                    else *(f32x4*)(p.out + (size_t)row * DM + 256 * j + 4 * F.lane) = v[j]; }
                if (next_prep) { f32x4 h[4]; row_norm_store8(v, rc, h, H + (size_t)row * DM, F.lane); }
            }
        }
    }
}

__device__ __forceinline__ void phase_qkprep(unsigned char* lds_, int wv, const Params& p) {
    const Frame F = make_frame(lds_, wv);
    bf16_t* PR = (bf16_t*)(p.ws + WS_PROJ);
    const int lane = F.lane, half = lane & 1, sh = lane >> 1;
    float nw[32];
    { const float* nsrc = (sh < 16) ? p.b_q_norm : p.b_k_norm;
#pragma unroll
      for (int i = 0; i < 32; ++i) nw[i] = nsrc[half * 32 + i]; }
    const float qscale = (sh < 16) ? 0.125f * 1.4426950408889634f : 1.0f;
    const float invf_tab[8] = {1.0f, 0.19391788f, 0.037604144f, 0.0072920943f, 0.0014140673f, 0.00027421273f, 5.3174683e-05f, 1.0311522e-05f};
    float invf = 0.f;
#pragma unroll
    for (int i = 0; i < 8; ++i) if ((lane & 7) == i) invf = invf_tab[i];
    const int gw = F.bid * NWAVES + F.wave, NGW = F.G * NWAVES;
    for (int rowb = gw; rowb < NTOK; rowb += 4 * NGW) {
        u32x4 raw[4][4]; int posi[4];
#pragma unroll
        for (int rr = 0; rr < 4; ++rr) { const int row = rowb + rr * NGW; if (row < NTOK) { posi[rr] = p.positions[row]; const bf16_t* ptr = PR + (size_t)row * 3072 + sh * 64 + half * 32;
#pragma unroll
            for (int k = 0; k < 4; ++k) raw[rr][k] = *(const u32x4*)(ptr + 8 * k); } }
#pragma unroll
        for (int rr = 0; rr < 4; ++rr) { const int row = rowb + rr * NGW; if (row < NTOK) {
            const float ang = (float)posi[rr] * invf;
            const double rev = (double)ang * 0.15915494309189535; const float fr = (float)(rev - rint(rev));
            const float cs = __builtin_amdgcn_cosf(fr), sn = __builtin_amdgcn_sinf(fr);
            bf16_t* ptr = PR + (size_t)row * 3072 + sh * 64 + half * 32;
            float v[32];
#pragma unroll
            for (int k = 0; k < 4; ++k)
#pragma unroll
                for (int i = 0; i < 4; ++i) { v[8 * k + 2 * i] = bflo(raw[rr][k][i]); v[8 * k + 2 * i + 1] = bfhi(raw[rr][k][i]); }
            float ss = 0.f;
#pragma unroll
            for (int i = 0; i < 32; ++i) ss += v[i] * v[i];
            ss += sx<1>(ss);
            const float r = 1.0f / sqrtf(ss * (1.0f / 64.0f) + EPS);
#pragma unroll
            for (int i = 0; i < 32; ++i) v[i] = v[i] * r * nw[i];
            float y1[8], y2[8];
#pragma unroll
            for (int i = 0; i < 8; ++i) { const float ci = rdlane(cs, i), si = rdlane(sn, i); y1[i] = v[i] * ci - v[8 + i] * si; y2[i] = v[8 + i] * ci + v[i] * si; }
            if (half == 0) {
#pragma unroll
                for (int i = 0; i < 8; ++i) { v[i] = y1[i]; v[8 + i] = y2[i]; } }
#pragma unroll
            for (int k = 0; k < 4; ++k) { u32x4 o;
#pragma unroll
                for (int i = 0; i < 4; ++i) o[i] = cvtpk(v[8 * k + 2 * i] * qscale, v[8 * k + 2 * i + 1] * qscale);
                *(u32x4*)(ptr + 8 * k) = o; } } }
    }
}

__device__ __forceinline__ void phase_attn(unsigned char* lds_, int wv, const Params& p) {
    const Frame F = make_frame(lds_, wv);
    const bf16_t* PR = (const bf16_t*)(p.ws + WS_PROJ); bf16_t* O4 = (bf16_t*)(p.ws + WS_HOUT) + (size_t)F.bid * 256 * 256;
    unsigned char* A2 = p.ws + WS_H;
    const float lam_init = 0.8f - 0.6f * 0.7408182206817179f;
    const float s1 = wave_sum(p.b_lam_q1[F.lane] * p.b_lam_k1[F.lane]), s2 = wave_sum(p.b_lam_q2[F.lane] * p.b_lam_k2[F.lane]);
    const float lam = expf(s1) - expf(s2) + lam_init;
    const float osc = (WQ_OUT1 == 2) ? A2Q : (1.0f - lam_init) * (OUTPROJ_FP8 ? S8_A2 : 1.0f);
    for (int item = F.vcu; item < 256; item += F.G) {
        const int bh = item >> 1, set = item & 1, b = bh >> 3, h = bh & 7;
        const int qlist = set ? 0x1256 : 0x0347;
#define AT2_REF(R, u) do { const int qb_ = (qlist >> (4 * ((u) >> 1))) & 15, c_ = (u) & 1; const size_t r0_ = (size_t)b * SEQ + qb_ * 256; \
        R.Q = PR + r0_ * 3072 + (h * 2 + c_) * 64; R.K = PR + (size_t)b * SEQ * 3072 + 1024 + (h * 2 + c_) * 64; R.V = PR + (size_t)b * SEQ * 3072 + 2048 + h * 128; \
        R.P0 = qb_ * 256; R.to_lds = c_; R.lam = lam; } while (0)
        at2::Seam S; at2::BlockRef cur, nxt;
        AT2_REF(cur, 0);
        __syncthreads();
        at2::prime(cur, (char*)lds_, S, F.tid, wv);
        for (int u = 0; u < 8; ++u) {
            const int un = (u < 7) ? u + 1 : 7;
            AT2_REF(nxt, un);
            at2::block(cur, nxt, (char*)lds_, S, F.tid, wv);
            if (u & 1) {
                asm volatile("s_waitcnt vmcnt(0)" ::: "memory");
                int lane = F.lane; asm volatile("" : "+v"(lane));
                const int half = lane & 1; const int qb = (qlist >> (4 * (u >> 1))) & 15; const size_t row = (size_t)b * SEQ + qb * 256 + wv * 32 + (lane >> 1);
                const LAS unsigned char* pb = F.lds + at2::OFF_OL + wv * at2::OL_WAVE + (lane >> 1) * at2::OL_RS + half * 128;
                u32x4 bq[8];
#pragma unroll
                for (int i = 0; i < 8; ++i) bq[i] = *(const LAS u32x4*)(pb + 16 * i);
                float d[64]; float ss = 0.f;
#pragma unroll
                for (int i = 0; i < 8; ++i)
#pragma unroll
                    for (int j = 0; j < 4; ++j) { d[8 * i + 2 * j] = bflo(bq[i][j]); d[8 * i + 2 * j + 1] = bfhi(bq[i][j]); }
#pragma unroll
                for (int i = 0; i < 64; ++i) ss += d[i] * d[i];
                ss += sx<1>(ss);
                const float r = osc * __builtin_amdgcn_rsqf(ss * (1.0f / 128.0f) + EPS);
                if (WQ_OUT1 == 2) { unsigned char* po = A2 + row * DM + h * 128 + half * 64;
#pragma unroll
                    for (int i = 0; i < 4; ++i) { const f32x4 n0 = *(const f32x4*)(p.b_o_norm + half * 64 + 16 * i), n1 = *(const f32x4*)(p.b_o_norm + half * 64 + 16 * i + 4), n2 = *(const f32x4*)(p.b_o_norm + half * 64 + 16 * i + 8), n3 = *(const f32x4*)(p.b_o_norm + half * 64 + 16 * i + 12);
                        u32x4 w; w.x = pack4_i8(d[16 * i] * r * n0[0], d[16 * i + 1] * r * n0[1], d[16 * i + 2] * r * n0[2], d[16 * i + 3] * r * n0[3]);
                        w.y = pack4_i8(d[16 * i + 4] * r * n1[0], d[16 * i + 5] * r * n1[1], d[16 * i + 6] * r * n1[2], d[16 * i + 7] * r * n1[3]);
                        w.z = pack4_i8(d[16 * i + 8] * r * n2[0], d[16 * i + 9] * r * n2[1], d[16 * i + 10] * r * n2[2], d[16 * i + 11] * r * n2[3]);
                        w.w = pack4_i8(d[16 * i + 12] * r * n3[0], d[16 * i + 13] * r * n3[1], d[16 * i + 14] * r * n3[2], d[16 * i + 15] * r * n3[3]);
                        *(u32x4*)(po + 16 * i) = w; } }
                else if (OUTPROJ_FP8) { unsigned char* po = A2 + row * DM + h * 128 + half * 64;
#pragma unroll
                    for (int i = 0; i < 4; ++i) { const f32x4 n0 = *(const f32x4*)(p.b_o_norm + half * 64 + 16 * i), n1 = *(const f32x4*)(p.b_o_norm + half * 64 + 16 * i + 4), n2 = *(const f32x4*)(p.b_o_norm + half * 64 + 16 * i + 8), n3 = *(const f32x4*)(p.b_o_norm + half * 64 + 16 * i + 12);
                        u32x4 w; w.x = cvt4_fp8(d[16 * i] * r * n0[0], d[16 * i + 1] * r * n0[1], d[16 * i + 2] * r * n0[2], d[16 * i + 3] * r * n0[3]);
                        w.y = cvt4_fp8(d[16 * i + 4] * r * n1[0], d[16 * i + 5] * r * n1[1], d[16 * i + 6] * r * n1[2], d[16 * i + 7] * r * n1[3]);
                        w.z = cvt4_fp8(d[16 * i + 8] * r * n2[0], d[16 * i + 9] * r * n2[1], d[16 * i + 10] * r * n2[2], d[16 * i + 11] * r * n2[3]);
                        w.w = cvt4_fp8(d[16 * i + 12] * r * n3[0], d[16 * i + 13] * r * n3[1], d[16 * i + 14] * r * n3[2], d[16 * i + 15] * r * n3[3]);
                        *(u32x4*)(po + 16 * i) = w; } }
                else { bf16_t* po = (bf16_t*)(p.ws + WS_A2B) + row * DM + h * 128 + half * 64;
#pragma unroll
                    for (int i = 0; i < 8; ++i) { const f32x4 n0 = *(const f32x4*)(p.b_o_norm + half * 64 + 8 * i), n1 = *(const f32x4*)(p.b_o_norm + half * 64 + 8 * i + 4);
                        u32x4 w; w.x = cvtpk(d[8 * i] * r * n0[0], d[8 * i + 1] * r * n0[1]); w.y = cvtpk(d[8 * i + 2] * r * n0[2], d[8 * i + 3] * r * n0[3]);
                        w.z = cvtpk(d[8 * i + 4] * r * n1[0], d[8 * i + 5] * r * n1[1]); w.w = cvtpk(d[8 * i + 6] * r * n1[2], d[8 * i + 7] * r * n1[3]);
                        *(u32x4*)(po + 8 * i) = w; } }
            }
            cur = nxt;
        }
#undef AT2_REF
    }
}

__device__ __forceinline__ void phase_ocombine(unsigned char* lds_, int wv, const Params& p) {
    const Frame F = make_frame(lds_, wv);
    const bf16_t* O4 = (const bf16_t*)(p.ws + WS_HOUT); unsigned char* A2 = p.ws + WS_H;
    const float lam_init = 0.8f - 0.6f * 0.7408182206817179f;
    const float s1 = wave_sum(p.b_lam_q1[F.lane] * p.b_lam_k1[F.lane]), s2 = wave_sum(p.b_lam_q2[F.lane] * p.b_lam_k2[F.lane]);
    const float lam = expf(s1) - expf(s2) + lam_init;
    const int lane = F.lane, hh = lane >> 3, sub = lane & 7, half = sub >> 2, j0 = (sub & 3) * 16;
    float on[16];
#pragma unroll
    for (int i = 0; i < 16; ++i) on[i] = p.b_o_norm[half * 64 + j0 + i] * (1.0f - lam_init) * S8_A2;
    const int gw = F.bid * NWAVES + F.wave, NGW = F.G * NWAVES;
    for (int rowb = gw; rowb < NTOK; rowb += 4 * NGW) {
        u32x4 a0[4], a1[4], b0[4], b1[4];
#pragma unroll
        for (int rr = 0; rr < 4; ++rr) { const int row = rowb + rr * NGW; if (row < NTOK) {
            const bf16_t* pa = O4 + (size_t)row * 2048 + ((hh * 2 + 0) * 2 + half) * 64 + j0; const bf16_t* pb = O4 + (size_t)row * 2048 + ((hh * 2 + 1) * 2 + half) * 64 + j0;
            a0[rr] = *(const u32x4*)pa; a1[rr] = *(const u32x4*)(pa + 8); b0[rr] = *(const u32x4*)pb; b1[rr] = *(const u32x4*)(pb + 8); } }
#pragma unroll
        for (int rr = 0; rr < 4; ++rr) { const int row = rowb + rr * NGW; if (row < NTOK) {
            float d[16];
#pragma unroll
            for (int i = 0; i < 4; ++i) { d[2 * i] = bflo(a0[rr][i]) - lam * bflo(b0[rr][i]); d[2 * i + 1] = bfhi(a0[rr][i]) - lam * bfhi(b0[rr][i]); d[8 + 2 * i] = bflo(a1[rr][i]) - lam * bflo(b1[rr][i]); d[8 + 2 * i + 1] = bfhi(a1[rr][i]) - lam * bfhi(b1[rr][i]); }
            float ss = 0.f;
#pragma unroll
            for (int i = 0; i < 16; ++i) ss += d[i] * d[i];
            ss += sx<1>(ss); ss += sx<2>(ss); ss += sx<4>(ss);
            const float r = 1.0f / sqrtf(ss * (1.0f / 128.0f) + EPS);
            float y[16];
#pragma unroll
            for (int i = 0; i < 16; ++i) y[i] = d[i] * r * on[i];
            u32x4 w; w.x = cvt4_fp8(y[0], y[1], y[2], y[3]); w.y = cvt4_fp8(y[4], y[5], y[6], y[7]); w.z = cvt4_fp8(y[8], y[9], y[10], y[11]); w.w = cvt4_fp8(y[12], y[13], y[14], y[15]);
            *(u32x4*)(A2 + (size_t)row * DM + hh * 128 + half * 64 + j0) = w; } }
    }
}


#ifndef PHASE_MASK
#define PHASE_MASK 0xFFFFFFFFu
#endif
#ifndef PROBE_A
#define PROBE_A (-1)
#endif
#ifndef PROBE_B
#define PROBE_B (0)
#endif
constexpr int STAMP_OFF = LDS_BYTES - 2048;
#define STAMP(k) do { if (PROBE_A >= 0 && blockIdx.x == 0 && STAMP_WAVE == 0 && lane_id() == 0) ((volatile LAS unsigned*)((LAS unsigned char*)lds + STAMP_OFF))[k] = (unsigned)__builtin_amdgcn_s_memrealtime(); } while (0)
#define PH(n) ((PHASE_MASK >> (n)) & 1u)

template <int LAYER>
__device__ __forceinline__ void layer_body(const Params& p, const XcdBarrier& bar, unsigned char* lds) {
    const int STAMP_WAVE = bar.wave; (void)STAMP_WAVE;
    constexpr int SB = (LAYER == 0) ? 4 : 13;
    const int G_ = gridDim.x, bid_ = blockIdx.x; LAS unsigned char* ldsl = (LAS unsigned char*)lds;
#define SEAM() xcd_barrier(bar)
    const float* mod = (const float*)(p.ws + WS_MOD);
    LAS int* tab = (LAS int*)(ldsl + TAB_OFF);
    if (PH(2)) { pg8::StaticOrder S; S.init(NTOK, 3072, G_, bid_);
      if (LAYER == 0) {
        if (WQ_IN0 == 2) { pg8::EpiProjI8 E{(bf16_t*)(p.ws + WS_PROJ), (const float*)(p.ws + SC_RS_H), (const float*)(p.ws + SC_CW) + CW_AIN, 0.08838834764831845f};
          pg8::gemm_phase<pg8::EpiProjI8, pg8::StaticOrder, false, true>(ldsl, bar.wave, (const bf16_t*)(p.ws + WS_H), (const bf16_t*)(p.ws + WS_WAIN), 0, 512, S, E, nullptr); }
        else { pg8::EpiBf16 E{(bf16_t*)(p.ws + WS_PROJ), 3072, 2, 4, 0.08838834764831845f, WQ_IN0 == 1 ? 1.0f / (S8_H * S8_WIN) : 1.0f};
          if (WQ_IN0 == 1) pg8::gemm_phase8<pg8::EpiBf16, pg8::StaticOrder, false>(ldsl, bar.wave, p.ws + WS_H, p.ws + WS_WAIN, 0, 1024, S, E, nullptr);
          else pg8::gemm_phase<pg8::EpiBf16, pg8::StaticOrder, false>(ldsl, bar.wave, (const bf16_t*)(p.ws + WS_H), (const bf16_t*)(p.ws + WS_WAIN_BF), 0, 1024, S, E, nullptr); } }
      else { pg8::EpiQKV E{(bf16_t*)(p.ws + WS_PROJ), p.b_q_norm, p.b_k_norm, (const float*)(p.ws + WS_CS), 1.0f / (S8_H * S8_WIN)};
        pg8::gemm_phase8<pg8::EpiQKV, pg8::StaticOrder, false>(ldsl, bar.wave, p.ws + WS_H, p.ws + WS_WBIN, 0, 1024, S, E, nullptr); } }
    SEAM(); STAMP(SB + 0);
    if (LAYER == 0) {
        if (PH(3)) phase_mlstm(lds, bar.wave, p);
        SEAM(); STAMP(SB + 1);
        if (PH(4)) phase_aprep(lds, bar.wave, p);
    } else {
        STAMP(SB + 1);
        if (PH(6)) phase_attn(lds, bar.wave, p);
        STAMP(SB + 2);
    }
    SEAM(); STAMP(SB + 2 + LAYER);
    unsigned* oflags = (unsigned*)p.ws + CW_OFLAGS + LAYER * 128;
    const int xper = (int)bar.st[0], xnx = (int)bar.st[1], xdx = (int)bar.st[2], xj = (int)bar.st[3];
    constexpr bool OCHAIN = (LAYER == 0) ? (WQ_OUT0 == 2) : (WQ_OUT1 == 2);
    if (PH(8)) { pg8::StaticOrder S; S.init(NTOK, 1024, G_, bid_);
      pg8::XcdOrder SX{xnx, xdx, xper, xj, NTOK / 256, 4, oflags};
      if (LAYER == 0 && WQ_OUT0 == 2) { pg8::EpiResidB<true, true> E{(const void*)p.x, (bf16_t*)(p.ws + WS_XB), mod + 2048, 1.0f, (const float*)(p.ws + WS_SCALES)};
        pg8::gemm_phase<pg8::EpiResidB<true, true>, pg8::XcdOrder, false, true>(ldsl, bar.wave, (const bf16_t*)(p.ws + WS_H), (const bf16_t*)(p.ws + WS_WAOUT), 0, 512, SX, E, nullptr); }
      else if (LAYER == 1 && WQ_OUT1 == 2) { pg8::EpiResidB<false, true, true> E{(const void*)(p.ws + WS_XB), (bf16_t*)(p.ws + WS_XB), mod + (size_t)16 * 6144 + 2048, (1.0f - (0.8f - 0.6f * 0.7408182206817179f)) / A2Q, (const float*)(p.ws + WS_SCALES)};
        pg8::gemm_phase<pg8::EpiResidB<false, true, true>, pg8::XcdOrder, false, true>(ldsl, bar.wave, (const bf16_t*)(p.ws + WS_H), (const bf16_t*)(p.ws + WS_WBOUT), 0, 512, SX, E, nullptr); }
      else { pg8::EpiResidB<LAYER == 0> E{LAYER == 0 ? (const void*)p.x : (const void*)(p.ws + WS_XB), (bf16_t*)(p.ws + WS_XB), mod + (size_t)LAYER * 16 * 6144 + 2048, OUTPROJ_FP8 ? 1.0f / (S8_A2 * S8_WOUT) : 1.0f, nullptr};
        if (OUTPROJ_FP8) pg8::gemm_phase8<pg8::EpiResidB<LAYER == 0>, pg8::StaticOrder, false>(ldsl, bar.wave, p.ws + WS_H, p.ws + (LAYER == 0 ? WS_WAOUT : WS_WBOUT), 0, 1024, S, E, nullptr);
        else pg8::gemm_phase<pg8::EpiResidB<LAYER == 0>, pg8::StaticOrder, false>(ldsl, bar.wave, (const bf16_t*)(p.ws + WS_A2B), (const bf16_t*)(p.ws + (LAYER == 0 ? WS_WAOUT_BF : WS_WBOUT_BF)), 0, 1024, S, E, nullptr); } }
    if (!OCHAIN) SEAM();
    STAMP(SB + 3 + LAYER);
    if (PH(9)) phase_hprep_router(lds, bar.wave, p, LAYER, xnx, xdx, xper, xj, OCHAIN ? oflags : nullptr);
    SEAM(); STAMP(SB + 4 + LAYER);
    if (PH(10)) phase_layout(lds, bar.wave, p);
    SEAM(); STAMP(SB + 5 + LAYER);
    if (PH(11)) { const int* meta = (const int*)(p.ws + RT_META);
      __syncthreads();
      { const int t_ = bar.wave * 64 + lane_id(); if (t_ < 17) tab[t_] = meta[1 + t_]; }
      __syncthreads();
      unsigned* flags = (unsigned*)p.ws + CW_FLAGS + LAYER * 512;
      const int xper = (int)bar.st[0], xnx = (int)bar.st[1], xdx = (int)bar.st[2], xj = (int)bar.st[3];
      pg8::MoeOrder S{xnx, xdx, xper, xj, tab[16], tab, flags};
      pg8::EpiSwiGLU8 E1{p.ws + WS_HOUT, 1.0f / (S8_H * S8_WGU), flags};
      pg8::gemm_phase8<pg8::EpiSwiGLU8, pg8::MoeOrder, true>(ldsl, bar.wave, p.ws + WS_H, p.ws + WS_WGU + (size_t)LAYER * 16 * 1024 * 1024, (size_t)1024 * 1024, 1024, S, E1, (const int*)(p.ws + RT_BUFTOK));
      STAMP(SB + 6 + LAYER);
      pg8::MoeOrderWait S2{xnx, xdx, xper, xj, tab[16], tab, flags};
      pg8::EpiFp8 E2{p.ws + WS_PROJ, 1024, S8_Y / (S8_ACT * S8_WDN)};
      pg8::gemm_phase8<pg8::EpiFp8, pg8::MoeOrderWait, false>(ldsl, bar.wave, p.ws + WS_HOUT, p.ws + WS_WDN + (size_t)LAYER * 16 * 1024 * 512, (size_t)1024 * 512, 512, S2, E2, nullptr); }
    SEAM(); STAMP(SB + 7 + LAYER);
    if (PH(12)) phase_combine(lds, bar.wave, p, LAYER, LAYER == 0);
#undef SEAM
}
__global__ void __launch_bounds__(NTHREADS, 2) mk_fwd(Params p) {
    extern __shared__ __attribute__((aligned(16))) unsigned char lds[];
    cg::grid_group grid = cg::this_grid();
    volatile LAS unsigned* misc = (volatile LAS unsigned*)((LAS unsigned char*)lds + MISC_OFF);
    const int wv0 = __builtin_amdgcn_readfirstlane((int)threadIdx.x >> 6);
    if (threadIdx.x < 32) misc[threadIdx.x] = 0u;
    __syncthreads();
    unsigned* ctl = (unsigned*)p.ws;
    XcdBarrier bar = xcd_barrier_post(ctl + CW_BAR, misc + 8, wv0);
    const int STAMP_WAVE = wv0; (void)STAMP_WAVE;
    STAMP(0);
    if (PH(0)) phase_mod(lds, bar.wave, p);
    __syncthreads();
    STAMP(1);
    if (PH(0)) { phase_wconv(lds, bar.wave, p); __syncthreads(); phase_wconv_pw(lds, bar.wave, p); }
    __syncthreads();
    if (wv0 == 0 && lane_id() == 0) { unsigned sp = 0u; while (xb_ld(ctl + CW_MODCNT) < 192u) { __builtin_amdgcn_s_sleep(4); if (++sp > (1u << 22)) break; }
        __builtin_amdgcn_fence(__ATOMIC_ACQUIRE, "agent"); asm volatile("s_waitcnt vmcnt(0)" ::: "memory"); }
    __syncthreads(); STAMP(2);
    if (PH(1)) phase_hprep0(lds, bar.wave, p);
    grid.sync(); STAMP(3);
    layer_body<0>(p, bar, lds);
    xcd_barrier(bar); STAMP(12);
    layer_body<1>(p, bar, lds);
    STAMP(22);
    if (PROBE_A >= 0 && blockIdx.x == 0 && STAMP_WAVE == 0 && lane_id() == 0) {
        volatile LAS unsigned* ts = (volatile LAS unsigned*)((LAS unsigned char*)lds + STAMP_OFF);
        const unsigned dA = ts[PROBE_A + 1] - ts[PROBE_A], dB = ts[PROBE_B + 1] - ts[PROBE_B];
        const unsigned long long extra = 100ull * ((unsigned long long)(dA / 100u) + 1024ull * (dB / 100u)), t0 = __builtin_amdgcn_s_memrealtime();
        while (__builtin_amdgcn_s_memrealtime() - t0 < extra) __builtin_amdgcn_s_sleep(32);
    }
    if (xb_ld(ctl + CW_BAR + XB_TMO) != 0u) { __syncthreads(); for (size_t i = (size_t)blockIdx.x * NTHREADS + (wv0 * 64 + lane_id()); i < (size_t)NTOK * DM / 4; i += (size_t)gridDim.x * NTHREADS) ((f32x4*)p.out)[i] = (f32x4){1e30f, 1e30f, 1e30f, 1e30f}; }
}

extern "C" void kernel_launch(void* const* d_in, const int* in_sizes, int n_in, void* d_out, int out_size, void* d_ws, size_t ws_size, hipStream_t stream) {
    static int grid_blocks = 0;
    if (!grid_blocks) {
        int dev = 0, cus = 0, per_cu = 0;
        (void)hipGetDevice(&dev);
        (void)hipDeviceGetAttribute(&cus, hipDeviceAttributeMultiprocessorCount, dev);
        (void)hipFuncSetAttribute((const void*)mk_fwd, hipFuncAttributeMaxDynamicSharedMemorySize, LDS_BYTES);
        (void)hipOccupancyMaxActiveBlocksPerMultiprocessor(&per_cu, (const void*)mk_fwd, NTHREADS, LDS_BYTES);
        if (per_cu < 1) { fprintf(stderr, "kernel_launch: occupancy query reports %d blocks/CU\n", per_cu); per_cu = 1; }
        grid_blocks = cus;
        if (ws_size < WS_END || n_in != 24) fprintf(stderr, "kernel_launch: unexpected ws_size %zu (need %zu) or n_in %d\n", ws_size, (size_t)WS_END, n_in);
    }
    (void)hipMemsetAsync(d_ws, 0, CTL_BYTES, stream);
    Params p{};
    const float** pf = (const float**)&p;
    p.x = (const float*)d_in[0]; p.c = (const float*)d_in[1]; p.positions = (const int*)d_in[2]; p.norm1 = (const float*)d_in[3]; p.norm2 = (const float*)d_in[4];
    p.w_ada = (const float*)d_in[5]; p.b_ada = (const float*)d_in[6]; p.a_w_in = (const float*)d_in[7]; p.a_b_if = (const float*)d_in[8]; p.a_h_norm = (const float*)d_in[9];
    p.a_w_out = (const float*)d_in[10]; p.b_w_in = (const float*)d_in[11]; p.b_q_norm = (const float*)d_in[12]; p.b_k_norm = (const float*)d_in[13];
    p.b_lam_q1 = (const float*)d_in[14]; p.b_lam_k1 = (const float*)d_in[15]; p.b_lam_q2 = (const float*)d_in[16]; p.b_lam_k2 = (const float*)d_in[17];
    p.b_o_norm = (const float*)d_in[18]; p.b_w_out = (const float*)d_in[19]; p.w_router = (const float*)d_in[20]; p.router_bias = (const float*)d_in[21];
    p.moe_w_gu = (const float*)d_in[22]; p.moe_w_down = (const float*)d_in[23];
    p.out = (float*)d_out; p.ws = (unsigned char*)d_ws; (void)pf;
    void* args[] = {&p};
    hipError_t e = hipLaunchCooperativeKernel((const void*)mk_fwd, dim3(grid_blocks), dim3(NTHREADS), args, LDS_BYTES, stream);
    if (e != hipSuccess) fprintf(stderr, "cooperative launch failed: %s (grid %d)\n", hipGetErrorString(e), grid_blocks);
}
```

```cpp
#include <hip/hip_runtime.h>
#include <hip/hip_cooperative_groups.h>
#include <hip/hip_bf16.h>
#include <cstdio>
#include <cstdint>
#include <cmath>
namespace cg = cooperative_groups;

#define GAS __attribute__((address_space(1)))
#define LAS __attribute__((address_space(3)))
typedef unsigned short bf16_t;
typedef float f32x4 __attribute__((ext_vector_type(4)));
typedef float f32x2 __attribute__((ext_vector_type(2)));
typedef short bf16x8 __attribute__((ext_vector_type(8)));
typedef short s16x4 __attribute__((ext_vector_type(4)));
typedef unsigned u32x4 __attribute__((ext_vector_type(4)));
typedef unsigned u32x2 __attribute__((ext_vector_type(2)));
typedef __bf16 bf16x2_t __attribute__((ext_vector_type(2)));
typedef int i32x8 __attribute__((ext_vector_type(8)));
typedef int i32x4 __attribute__((ext_vector_type(4)));

constexpr int NTOK = 32768, DM = 1024, SEQ = 2048, NB = 16;
constexpr int NEXP = 16, DEXP = 512;
constexpr int NTHREADS = 512, NWAVES = 8;
constexpr int LDS_BYTES = 149504;
constexpr int MISC_OFF = LDS_BYTES - 128;
constexpr int TAB_OFF = 131072;
constexpr float EPS = 1e-6f;
constexpr int MAXTILES = 272, CAP = MAXTILES * 256;
constexpr float S8_H = 8.0f, S8_WGU = 256.0f, S8_ACT = 4.0f, S8_WDN = 128.0f, S8_WIN = 256.0f, S8_A2 = 16.0f, S8_WOUT = 256.0f, S8_Y = 16.0f;

constexpr size_t MiB = 1u << 20;
constexpr size_t WS_CTL = 0, CTL_BYTES = 1 * MiB;
constexpr int CW_BAR = 4096;
constexpr int CW_MODCNT = 9728;
constexpr int CW_OFLAGS = 9216;
constexpr int CW_FLAGS = 8192;
constexpr size_t WS_MOD = 1 * MiB;
constexpr size_t WS_ROUTE = 2 * MiB;
constexpr size_t RT_BLKCNT = WS_ROUTE;
constexpr size_t RT_INFO = WS_ROUTE + 64 * 1024;
constexpr size_t RT_W = RT_INFO + 128 * 1024;
constexpr size_t RT_DEST = RT_W + 256 * 1024;
constexpr size_t RT_BUFTOK = RT_DEST + 256 * 1024;
constexpr size_t RT_META = RT_BUFTOK + 320 * 1024;
constexpr size_t WS_GATES = 4 * MiB;
constexpr size_t WS_SCALES = 5 * MiB;
constexpr size_t SC_RS_H = WS_SCALES;
constexpr size_t SC_RS_A = WS_SCALES + 128 * 1024;
constexpr size_t SC_RS_TOK = WS_SCALES + 256 * 1024;
constexpr size_t SC_RS_SLOT = WS_SCALES + 384 * 1024;
constexpr size_t SC_CW = WS_SCALES + 704 * 1024;
constexpr int CW_AIN = 0, CW_AOUT = 3072, CW_BIN = 4096, CW_GU = 7168, CW_BOUT = 7168 + 32 * 1024;
constexpr int WQ_OUT1 = 2;
constexpr float A2Q = 127.0f / 6.0f;
constexpr int WQ_IN0 = 2, WQ_IN1 = 1, WQ_OUT0 = 2, WQ_GU = 1;
constexpr size_t WS_WAIN = 6 * MiB, WS_WAOUT = 10 * MiB, WS_WBIN = 12 * MiB, WS_WBOUT = 16 * MiB;
constexpr size_t WS_WGU = 18 * MiB;
constexpr size_t WS_WDN = 50 * MiB;
constexpr size_t WS_H = 66 * MiB;
constexpr size_t WS_XB = 100 * MiB;
constexpr size_t WS_PROJ = 164 * MiB;
constexpr size_t WS_HOUT = 356 * MiB;
constexpr size_t WS_CS = 484 * MiB;
constexpr size_t WS_WAIN_BF = 488 * MiB;
constexpr size_t WS_WAOUT_BF = 506 * MiB, WS_WBOUT_BF = 508 * MiB;
constexpr size_t WS_A2B = 420 * MiB;
constexpr bool OUTPROJ_FP8 = false;
constexpr size_t WS_END = 510 * MiB;
constexpr bool INPROJ0_FP8 = false;

__device__ __forceinline__ unsigned cvtpk(float lo, float hi) { f32x2 v = {lo, hi}; bf16x2_t b = __builtin_convertvector(v, bf16x2_t); return __builtin_bit_cast(unsigned, b); }
__device__ __forceinline__ float clamp448(float v) { return fminf(fmaxf(v, -448.0f), 448.0f); }
__device__ __forceinline__ unsigned cvt4_fp8(float a, float b, float c, float d) {
    int w = __builtin_amdgcn_cvt_pk_fp8_f32(clamp448(a), clamp448(b), 0, false); w = __builtin_amdgcn_cvt_pk_fp8_f32(clamp448(c), clamp448(d), w, true); return (unsigned)w; }
__device__ __forceinline__ float bf2f(unsigned short h) { return __uint_as_float(((unsigned)h) << 16); }
__device__ __forceinline__ float bflo(unsigned w) { return __uint_as_float(w << 16); }
__device__ __forceinline__ float bfhi(unsigned w) { return __uint_as_float(w & 0xffff0000u); }
__device__ __forceinline__ int lane_id() { int l; asm volatile("v_mbcnt_lo_u32_b32 %0, -1, 0\n\tv_mbcnt_hi_u32_b32 %0, -1, %0" : "=v"(l)); return l; }
template <int M> __device__ __forceinline__ float sx(float v) {
    const int i = __float_as_int(v);
    if constexpr (M == 1) return __int_as_float(__builtin_amdgcn_mov_dpp(i, 0xB1, 0xF, 0xF, true));
    else if constexpr (M == 2) return __int_as_float(__builtin_amdgcn_mov_dpp(i, 0x4E, 0xF, 0xF, true));
    else if constexpr (M == 4) return __int_as_float(__builtin_amdgcn_ds_swizzle(i, 0x101F));
    else if constexpr (M == 8) return __int_as_float(__builtin_amdgcn_ds_swizzle(i, 0x201F));
    else if constexpr (M == 16) return __int_as_float(__builtin_amdgcn_ds_swizzle(i, 0x401F));
    else { static_assert(M == 1, "sx: mask"); return v; }
}
__device__ __forceinline__ float sx16p(float v, bool odd_row) {
    auto rr = __builtin_amdgcn_permlane16_swap(__float_as_uint(v), __float_as_uint(v), false, false);
    return __uint_as_float(odd_row ? rr[0] : rr[1]);
}
__device__ __forceinline__ float sx32(float v, bool upper) {
    auto rr = __builtin_amdgcn_permlane32_swap(__float_as_uint(v), __float_as_uint(v), false, false);
    return __uint_as_float(upper ? rr[0] : rr[1]);
}
__device__ __forceinline__ float bperm(float v, int src_lane) { return __int_as_float(__builtin_amdgcn_ds_bpermute(src_lane << 2, __float_as_int(v))); }
__device__ __forceinline__ float rdlane(float v, int l) { return __int_as_float(__builtin_amdgcn_readlane(__float_as_int(v), l)); }
__device__ __forceinline__ float wave_sum(float v) {
    v += sx<1>(v); v += sx<2>(v); v += sx<4>(v); v += sx<8>(v); v += sx<16>(v);
    { auto rr = __builtin_amdgcn_permlane32_swap(__float_as_uint(v), __float_as_uint(v), false, false); v = __uint_as_float(rr[0]) + __uint_as_float(rr[1]); }
    return v;
}
__device__ __forceinline__ float wave_max(float v) {
    v = fmaxf(v, sx<1>(v)); v = fmaxf(v, sx<2>(v)); v = fmaxf(v, sx<4>(v)); v = fmaxf(v, sx<8>(v)); v = fmaxf(v, sx<16>(v));
    { auto rr = __builtin_amdgcn_permlane32_swap(__float_as_uint(v), __float_as_uint(v), false, false); v = fmaxf(__uint_as_float(rr[0]), __uint_as_float(rr[1])); }
    return v;
}
__device__ __forceinline__ unsigned pack4_i8(float a, float b, float c, float d) {
    unsigned w = __builtin_amdgcn_cvt_pk_u8_f32(fminf(fmaxf(rintf(a), -127.f), 127.f) + 128.f, 0, 0u);
    w = __builtin_amdgcn_cvt_pk_u8_f32(fminf(fmaxf(rintf(b), -127.f), 127.f) + 128.f, 1, w);
    w = __builtin_amdgcn_cvt_pk_u8_f32(fminf(fmaxf(rintf(c), -127.f), 127.f) + 128.f, 2, w);
    w = __builtin_amdgcn_cvt_pk_u8_f32(fminf(fmaxf(rintf(d), -127.f), 127.f) + 128.f, 3, w);
    return w ^ 0x80808080u;
}
__device__ __forceinline__ f32x4 i2f4(f32x4 a) { return (f32x4){(float)__float_as_int(a[0]), (float)__float_as_int(a[1]), (float)__float_as_int(a[2]), (float)__float_as_int(a[3])}; }
__device__ __forceinline__ float sigmoidf_(float x) { return __builtin_amdgcn_rcpf(1.0f + __expf(-x)); }

#define XB_TMO      128
#define XB_XCNT(j)  (256  + 64 * (j))
#define XB_XSUB(j)  (1280 + 64 * (j))
#define XB_XGEN(j)  (2304 + 64 * (j))
#define XB_TOP      3328
#define XB_TOPGEN   3392
#define XCD_BAR_WORDS 3456
#define XB_SPIN_CAP (1u << 18)
__device__ __forceinline__ unsigned xb_ld(unsigned* p)              { return __hip_atomic_load(p, __ATOMIC_RELAXED, __HIP_MEMORY_SCOPE_AGENT); }
__device__ __forceinline__ unsigned xb_add(unsigned* p, unsigned v) { return __hip_atomic_fetch_add(p, v, __ATOMIC_RELAXED, __HIP_MEMORY_SCOPE_AGENT); }
__device__ __forceinline__ unsigned xb_xcc_id() { return (unsigned)__builtin_amdgcn_s_getreg((3 << 11) | 20) & 0xFu; }
#define XB_SPIN(cond, bar) do { unsigned _sp = 0; while (cond) { __builtin_amdgcn_s_sleep(1); \
    if ((++_sp & 255u) == 0u) { if (xb_ld(&(bar)[XB_TMO])) break; if (_sp > XB_SPIN_CAP) { atomicAdd(&(bar)[XB_TMO], 1u); break; } } } } while (0)
struct XcdBarrier { unsigned* bar; unsigned x; volatile LAS unsigned* st; int wave; };
__device__ __forceinline__ XcdBarrier xcd_barrier_post(unsigned* bar, volatile LAS unsigned* st, int wave) {
    XcdBarrier b; b.bar = bar; b.x = xb_xcc_id(); b.st = st; b.wave = wave;
    if (wave == 0 && lane_id() == 0) st[3] = xb_add(&bar[XB_XCNT(b.x)], 1u);
    return b;
}
__device__ __forceinline__ void xcd_barrier_complete(unsigned* bar, unsigned x, unsigned& nloc, unsigned& nx, unsigned& dx) {
    const unsigned G = gridDim.x * gridDim.y * gridDim.z;
    unsigned sum, cnt, mine, below, sp = 0u;
    for (;;) {
        sum = 0u; cnt = 0u; mine = 0u; below = 0u;
#pragma unroll
        for (unsigned j = 0; j < 16; ++j) { const unsigned c = xb_ld(&bar[XB_XCNT(j)]); sum += c; cnt += (c > 0u) ? 1u : 0u; mine = (j == x) ? c : mine; below += (j < x && c > 0u) ? 1u : 0u; }
        if (sum == G) break;
        __builtin_amdgcn_s_sleep(1);
        if ((++sp & 255u) == 0u) { if (xb_ld(&bar[XB_TMO])) break; if (sp > XB_SPIN_CAP) { atomicAdd(&bar[XB_TMO], 1u); break; } }
    }
    nloc = mine > 0u ? mine : 1u; nx = cnt > 0u ? cnt : 1u; dx = below;
}
__device__ __forceinline__ void xcd_barrier(const XcdBarrier& b) {
    asm volatile("s_waitcnt vmcnt(0)" ::: "memory");
    __syncthreads();
    if (b.wave == 0 && lane_id() == 0) {
        unsigned* bar = b.bar;
        __builtin_amdgcn_s_waitcnt(0);
        unsigned nloc = b.st[0], nx = b.st[1];
        if (nloc == 0u) { unsigned dx; xcd_barrier_complete(bar, b.x, nloc, nx, dx); b.st[0] = nloc; b.st[1] = nx; b.st[2] = dx; }
        const unsigned old = xb_add(&bar[XB_XSUB(b.x)], 1u);
        const unsigned gen = old / nloc;
        if (old + 1u == (gen + 1u) * nloc) {
            __builtin_amdgcn_fence(__ATOMIC_RELEASE, "agent");
            asm volatile("s_waitcnt vmcnt(0)" ::: "memory");
            const unsigned og = xb_add(&bar[XB_TOP], 1u);
            const unsigned target = (og / nx + 1u) * nx;
            if (og + 1u != target) XB_SPIN(xb_ld(&bar[XB_TOP]) < target, bar);
            __builtin_amdgcn_fence(__ATOMIC_ACQUIRE, "agent");
            xb_add(&bar[XB_XGEN(b.x)], 1u);
            asm volatile("s_waitcnt vmcnt(0)" ::: "memory");
        } else {
            XB_SPIN(xb_ld(&bar[XB_XGEN(b.x)]) == gen, bar);
            __builtin_amdgcn_fence(__ATOMIC_ACQUIRE, "agent");
            asm volatile("s_waitcnt vmcnt(0)" ::: "memory");
        }
    }
    __syncthreads();
}

namespace pg8 {
constexpr int BM = 256, BK = 64, HALF = 128, HTB = HALF * BK * 2, STAGE_BYTES = 8 * HTB, NXCD = 8, WGM = 8;
__device__ __forceinline__ int lds_byte(int r, int c) { const int st = (r >> 4) * 2 + (c >> 5), rr = r & 15, cc = c & 31, ob = rr * 64 + cc * 2; return st * 1024 + (ob ^ (((ob >> 9) & 1) << 5)); }
__device__ __forceinline__ void stage_rc(int b, int& R, int& C) { const int st = b / 1024, sb = b % 1024, swz = sb ^ (((sb >> 9) & 1) << 5); R = (st >> 1) * 16 + swz / 64; C = (st & 1) * 32 + (swz % 64) / 2; }
__device__ __forceinline__ int perm32(int rho) { const int n = rho >> 4, i = rho & 15; return 8 * (i >> 2) + 4 * n + (i & 3); }

struct Unit { int pm, pn, e; };

struct StaticOrder {
    static constexpr bool SIGNAL = false;
    int nM, nN, nwg, G, c;
    __device__ void init(int M, int N, int G_, int c_) { nM = M / BM; nN = N / BM; nwg = nM * nN; G = G_; c = c_; }
    __device__ __forceinline__ bool next(int i, Unit& u) const {
        const long L = (long)i * G + c; if (L >= nwg) return false;
        int wgid = (int)L; { const int q = nwg / NXCD, r = nwg % NXCD, xcd = wgid % NXCD, off = wgid / NXCD; wgid = (xcd < r ? xcd * (q + 1) : r * (q + 1) + (xcd - r) * q) + off; }
        const int nig = WGM * nN, gid = wgid / nig, fm = gid * WGM, gsz = (nM - fm) < WGM ? (nM - fm) : WGM;
        u.pm = __builtin_amdgcn_readfirstlane(fm + ((wgid % nig) % gsz)); u.pn = __builtin_amdgcn_readfirstlane((wgid % nig) / gsz); u.e = 0; return true;
    }
};
struct XcdOrder {
    static constexpr bool SIGNAL = true;
    int nx, dx, per, j, nM, nN; unsigned* flags;
    __device__ __forceinline__ bool next(int i, Unit& u) const {
        const int tlo = (dx * nM) / nx, thi = ((dx + 1) * nM) / nx, n = (thi - tlo) * nN;
        const int q = j + i * per; if (q >= n) return false;
        u.pm = __builtin_amdgcn_readfirstlane(tlo + q / nN); u.pn = __builtin_amdgcn_readfirstlane(q % nN); u.e = 0; return true;
    }
    __device__ __forceinline__ void signal(const Unit& u, int lane) const { asm volatile("s_waitcnt vmcnt(0)" ::: "memory"); if (lane == 0) (void)xb_add(flags + u.pm, 1u); }
};
template <bool WAIT>
struct MoeOrderT {
    static constexpr bool SIGNAL = false;
    int nx, dx, per, j, ntiles; const LAS int* ts; unsigned* flags;
    __device__ __forceinline__ bool next(int i, Unit& u) const {
        const int tlo = (dx * ntiles) / nx, thi = ((dx + 1) * ntiles) / nx, n = 4 * (thi - tlo);
        int jj = j; if (WAIT) { jj = j - (n % per); if (jj < 0) jj += per; }
        const int q = jj + i * per; if (q >= n) return false;
        const int tile = tlo + (q >> 2), pn = q & 3;
        int e = 0;
#pragma unroll
        for (int k = 1; k < 16; ++k) e += (tile >= ts[k]) ? 1 : 0;
        u.pm = __builtin_amdgcn_readfirstlane(tile); u.pn = __builtin_amdgcn_readfirstlane(pn); u.e = __builtin_amdgcn_readfirstlane(e);
        if (WAIT) { unsigned sp = 0u;
            while (xb_ld(flags + u.pm) < 32u) { __builtin_amdgcn_s_sleep(2); if (++sp > (1u << 22)) break; }
            asm volatile("" ::: "memory"); }
        return true;
    }
};
typedef MoeOrderT<false> MoeOrder;
typedef MoeOrderT<true> MoeOrderWait;

struct EpiBf16 {
    static constexpr bool PERM = true, HP = false, SIGNAL = false;
    bf16_t* O; int ldc; int s_lo, s_hi; float scale; float base;
    __device__ __forceinline__ void operator()(const f32x4 (&acc)[2][2][4][2], const Unit& u, int wr, int wc, int fr, int fq) const {
        const int row0 = u.pm * BM + wr * 64 + fr; const int col0 = u.pn * BM + wc * 32 + 8 * fq;
        const float sc = ((u.pn >= s_lo && u.pn < s_hi) ? scale : 1.0f) * base;
#pragma unroll
        for (int ai = 0; ai < 2; ++ai)
#pragma unroll
            for (int m = 0; m < 4; ++m) { bf16_t* rowp = O + (size_t)(row0 + ai * HALF + m * 16) * ldc + col0;
#pragma unroll
                for (int bj = 0; bj < 2; ++bj) { const f32x4 v0 = acc[ai][bj][m][0] * sc, v1 = acc[ai][bj][m][1] * sc;
                    u32x4 w; w.x = cvtpk(v0[0], v0[1]); w.y = cvtpk(v0[2], v0[3]); w.z = cvtpk(v1[0], v1[1]); w.w = cvtpk(v1[2], v1[3]);
                    *(u32x4*)(rowp + bj * HALF) = w; } }
    }
};
struct EpiSwiGLU {
    static constexpr bool PERM = true;
    bf16_t* O;
    __device__ __forceinline__ void operator()(const f32x4 (&acc)[2][2][4][2], const Unit& u, int wr, int wc, int fr, int fq) const {
        const int row0 = u.pm * BM + wr * 64 + fr; const int col0 = u.pn * 128 + wc * 32 + 8 * fq;
#pragma unroll
        for (int ai = 0; ai < 2; ++ai)
#pragma unroll
            for (int m = 0; m < 4; ++m) { bf16_t* rowp = O + (size_t)(row0 + ai * HALF + m * 16) * DEXP + col0;
                float a[8];
#pragma unroll
                for (int n = 0; n < 2; ++n)
#pragma unroll
                    for (int j = 0; j < 4; ++j) { const float g = acc[ai][0][m][n][j], up = acc[ai][1][m][n][j]; a[n * 4 + j] = g * up / (1.0f + __expf(-g)); }
                u32x4 w; w.x = cvtpk(a[0], a[1]); w.y = cvtpk(a[2], a[3]); w.z = cvtpk(a[4], a[5]); w.w = cvtpk(a[6], a[7]);
                *(u32x4*)rowp = w; }
    }
};
struct EpiResid {
    static constexpr bool PERM = false;
    const float* base; float* out; const float* gate;
    __device__ __forceinline__ void operator()(const f32x4 (&acc)[2][2][4][2], const Unit& u, int wr, int wc, int fr, int fq) const {
        const int row0 = u.pm * BM + wr * 64 + fr, col0 = u.pn * BM + wc * 32 + 4 * fq;
        const int b = (u.pm * BM) / SEQ;
        f32x4 gv[2][2];
#pragma unroll
        for (int bj = 0; bj < 2; ++bj)
#pragma unroll
            for (int n = 0; n < 2; ++n) gv[bj][n] = *(const f32x4*)(gate + (size_t)b * 6144 + col0 + bj * HALF + n * 16);
#pragma unroll
        for (int ai = 0; ai < 2; ++ai)
#pragma unroll
            for (int m = 0; m < 4; ++m) { const size_t off = (size_t)(row0 + ai * HALF + m * 16) * DM + col0;
#pragma unroll
                for (int bj = 0; bj < 2; ++bj)
#pragma unroll
                    for (int n = 0; n < 2; ++n) { const f32x4 bs = *(const f32x4*)(base + off + bj * HALF + n * 16);
                        *(f32x4*)(out + off + bj * HALF + n * 16) = bs + gv[bj][n] * acc[ai][bj][m][n]; }
                asm volatile("" ::: "memory"); }
    }
};

struct EpiProjI8 {
    static constexpr bool PERM = true, HP = false;
    bf16_t* O; const float* ra; const float* cw; float kscale;
    __device__ __forceinline__ void operator()(const f32x4 (&acc)[2][2][4][2], const Unit& u, int wr, int wc, int fr, int fq) const {
        const int row0 = u.pm * BM + wr * 64 + fr; const int col0 = u.pn * BM + wc * 32 + 8 * fq;
        const float ks = (u.pn >= 2 && u.pn < 4) ? kscale : 1.0f;
        f32x4 c0[2], c1[2];
#pragma unroll
        for (int bj = 0; bj < 2; ++bj) { c0[bj] = *(const f32x4*)(cw + col0 + bj * HALF) * ks; c1[bj] = *(const f32x4*)(cw + col0 + bj * HALF + 4) * ks; }
#pragma unroll
        for (int ai = 0; ai < 2; ++ai)
#pragma unroll
            for (int m = 0; m < 4; ++m) { const int row = row0 + ai * HALF + m * 16; const float rs = ra[row]; bf16_t* rowp = O + (size_t)row * 3072 + col0;
#pragma unroll
                for (int bj = 0; bj < 2; ++bj) { const f32x4 v0 = i2f4(acc[ai][bj][m][0]) * c0[bj] * rs, v1 = i2f4(acc[ai][bj][m][1]) * c1[bj] * rs;
                    u32x4 w; w.x = cvtpk(v0[0], v0[1]); w.y = cvtpk(v0[2], v0[3]); w.z = cvtpk(v1[0], v1[1]); w.w = cvtpk(v1[2], v1[3]);
                    *(u32x4*)(rowp + bj * HALF) = w; } }
    }
};
struct EpiFp8 {
    static constexpr bool PERM = true, HP = false, SIGNAL = false;
    unsigned char* O; int ldc; float scale;
    __device__ __forceinline__ void operator()(const f32x4 (&acc)[2][2][4][2], const Unit& u, int wr, int wc, int fr, int fq) const {
        const int row0 = u.pm * BM + wr * 64 + fr; const int col0 = u.pn * BM + wc * 32 + 8 * fq;
#pragma unroll
        for (int ai = 0; ai < 2; ++ai)
#pragma unroll
            for (int m = 0; m < 4; ++m) { unsigned char* rowp = O + (size_t)(row0 + ai * HALF + m * 16) * ldc + col0;
#pragma unroll
                for (int bj = 0; bj < 2; ++bj) { const f32x4 v0 = acc[ai][bj][m][0] * scale, v1 = acc[ai][bj][m][1] * scale;
                    u32x2 w; w.x = cvt4_fp8(v0[0], v0[1], v0[2], v0[3]); w.y = cvt4_fp8(v1[0], v1[1], v1[2], v1[3]);
                    *(u32x2*)(rowp + bj * HALF) = w; } }
    }
};
struct EpiQKV {
    static constexpr bool PERM = true, HP = true, SIGNAL = false;
    bf16_t* O; const float* qn; const float* kn; const float* cs; float descale; const LAS float* cst;
    __device__ __forceinline__ void operator()(const f32x4 (&acc)[2][2][4][2], const Unit& u, int wr, int wc, int fr, int fq) const {
        const int row0 = u.pm * BM + wr * 64 + fr; const int col0 = u.pn * BM + wc * 64 + 8 * fq;
        const bool isqk = u.pn < 8; const bool odd = (fq & 1) != 0;
        float w[2][2][4];
        if (isqk) { const float* nw = (u.pn < 4) ? qn : kn;
#pragma unroll
            for (int bj = 0; bj < 2; ++bj)
#pragma unroll
                for (int n = 0; n < 2; ++n) { const f32x4 t = *(const f32x4*)(nw + 32 * bj + 8 * fq + 4 * n); w[bj][n][0] = t[0]; w[bj][n][1] = t[1]; w[bj][n][2] = t[2]; w[bj][n][3] = t[3]; } }
        const float qs = (u.pn < 4) ? 0.125f * 1.4426950408889634f : 1.0f;
#pragma unroll
        for (int ai = 0; ai < 2; ++ai)
#pragma unroll
            for (int m = 0; m < 4; ++m) { const int row = row0 + ai * HALF + m * 16; bf16_t* rowp = O + (size_t)row * 3072 + col0;
                float v[2][2][4];
#pragma unroll
                for (int bj = 0; bj < 2; ++bj)
#pragma unroll
                    for (int n = 0; n < 2; ++n)
#pragma unroll
                        for (int j = 0; j < 4; ++j) v[bj][n][j] = acc[ai][bj][m][n][j] * descale;
                if (isqk) {
                    float ss = 0.f;
#pragma unroll
                    for (int bj = 0; bj < 2; ++bj)
#pragma unroll
                        for (int n = 0; n < 2; ++n)
#pragma unroll
                            for (int j = 0; j < 4; ++j) ss += v[bj][n][j] * v[bj][n][j];
                    ss += sx16p(ss, odd);
                    { auto rr = __builtin_amdgcn_permlane32_swap(__float_as_uint(ss), __float_as_uint(ss), false, false); ss = __uint_as_float(rr[0]) + __uint_as_float(rr[1]); }
                    const float rn = __builtin_amdgcn_rsqf(ss * (1.0f / 64.0f) + EPS);
#pragma unroll
                    for (int bj = 0; bj < 2; ++bj)
#pragma unroll
                        for (int n = 0; n < 2; ++n)
#pragma unroll
                            for (int j = 0; j < 4; ++j) v[bj][n][j] = v[bj][n][j] * rn * w[bj][n][j];
                    const LAS float* ct = cst + (row - u.pm * BM) * 16;
                    const f32x4 c0 = *(const LAS f32x4*)(ct), c1 = *(const LAS f32x4*)(ct + 4), s0 = *(const LAS f32x4*)(ct + 8), s1 = *(const LAS f32x4*)(ct + 12);
#pragma unroll
                    for (int n = 0; n < 2; ++n)
#pragma unroll
                        for (int j = 0; j < 4; ++j) { const float x = v[0][n][j]; const float pr = sx16p(x, odd); const float c = n ? c1[j] : c0[j], sn = n ? s1[j] : s0[j];
                            const float r0 = x * c - pr * sn, r1 = x * c + pr * sn; v[0][n][j] = (fq == 0) ? r0 : (fq == 1) ? r1 : x; }
#pragma unroll
                    for (int bj = 0; bj < 2; ++bj)
#pragma unroll
                        for (int n = 0; n < 2; ++n)
#pragma unroll
                            for (int j = 0; j < 4; ++j) v[bj][n][j] *= qs;
                }
#pragma unroll
                for (int bj = 0; bj < 2; ++bj) { u32x4 wv; wv.x = cvtpk(v[bj][0][0], v[bj][0][1]); wv.y = cvtpk(v[bj][0][2], v[bj][0][3]); wv.z = cvtpk(v[bj][1][0], v[bj][1][1]); wv.w = cvtpk(v[bj][1][2], v[bj][1][3]);
                    *(u32x4*)(rowp + 32 * bj) = wv; } }
    }
};
template <bool BASE_F32, bool I8 = false, bool STATIC_A = false> struct EpiResidB {
    static constexpr bool PERM = true, HP = false, SIGNAL = false;
    const void* base; bf16_t* out; const float* gate; float descale; const float* sc;
    __device__ __forceinline__ void operator()(const f32x4 (&acc)[2][2][4][2], const Unit& u, int wr, int wc, int fr, int fq) const {
        const int row0 = u.pm * BM + wr * 64 + fr, col0 = u.pn * BM + wc * 32 + 8 * fq;
        const int b = (u.pm * BM) / SEQ;
        const float* ra = sc + (SC_RS_A - WS_SCALES) / 4; const float* cw = sc + (SC_CW - WS_SCALES) / 4 + (STATIC_A ? CW_BOUT : CW_AOUT);
        f32x4 gv[2][2];
#pragma unroll
        for (int bj = 0; bj < 2; ++bj)
#pragma unroll
            for (int n = 0; n < 2; ++n) { gv[bj][n] = *(const f32x4*)(gate + (size_t)b * 6144 + col0 + bj * HALF + n * 4); if (!I8) gv[bj][n] = gv[bj][n] * descale; if (I8) gv[bj][n] = gv[bj][n] * *(const f32x4*)(cw + col0 + bj * HALF + n * 4); }
#pragma unroll
        for (int ai = 0; ai < 2; ++ai)
#pragma unroll
            for (int m = 0; m < 4; ++m) { const size_t off = (size_t)(row0 + ai * HALF + m * 16) * DM + col0; const float rs = !I8 ? 1.0f : STATIC_A ? descale : ra[row0 + ai * HALF + m * 16];
#pragma unroll
                for (int bj = 0; bj < 2; ++bj) { f32x4 b0, b1;
                    if (BASE_F32) { b0 = *(const f32x4*)((const float*)base + off + bj * HALF); b1 = *(const f32x4*)((const float*)base + off + bj * HALF + 4); }
                    else { const u32x4 r = *(const u32x4*)((const bf16_t*)base + off + bj * HALF); b0 = (f32x4){bflo(r.x), bfhi(r.x), bflo(r.y), bfhi(r.y)}; b1 = (f32x4){bflo(r.z), bfhi(r.z), bflo(r.w), bfhi(r.w)}; }
                    const f32x4 a0 = I8 ? i2f4(acc[ai][bj][m][0]) * rs : acc[ai][bj][m][0], a1 = I8 ? i2f4(acc[ai][bj][m][1]) * rs : acc[ai][bj][m][1];
                    const f32x4 v0 = b0 + gv[bj][0] * a0, v1 = b1 + gv[bj][1] * a1;
                    u32x4 w; w.x = cvtpk(v0[0], v0[1]); w.y = cvtpk(v0[2], v0[3]); w.z = cvtpk(v1[0], v1[1]); w.w = cvtpk(v1[2], v1[3]);
                    *(u32x4*)(out + off + bj * HALF) = w; }
                asm volatile("" ::: "memory"); }
    }
};
template <class Epi, class Sched, bool GATHER, bool I8 = false>
__device__ __forceinline__ void gemm_phase(LAS unsigned char* lds, int wv, const bf16_t* A, const bf16_t* Bt, size_t bstride, int K, const Sched& S, const Epi& E, const int* aidx) {
    int tid = wv * 64 + lane_id(); asm volatile("" : "+v"(tid));
    const int wid = wv, lane = tid & 63, wr = wid >> 2, wc = wid & 3, fr = lane & 15, fq = lane >> 4;
    const int nt = K / BK;
    int RA[2], CA[2]; unsigned voffB[2];
#pragma unroll
    for (int i = 0; i < 2; ++i) { int R, C; stage_rc(tid * 16 + i * 8192, R, C); const int Rb = Epi::PERM ? ((R & ~31) + perm32(R & 31)) : R;
        RA[i] = R; CA[i] = C; voffB[i] = (unsigned)(Rb * K + C) * 2u; }
    const size_t kstep = (size_t)(BK * 2);
    const size_t hstep = (size_t)HALF * K * 2;
    const size_t tstep = 2 * hstep;
    const unsigned ldsw = (unsigned)wid * 1024u;
    const int aoff = lds_byte(wr * 64 + fr, fq * 8), boff = lds_byte(wc * 32 + fr, fq * 8);
#define PG8_SA(b, h) (((b) * 2 + (h)) * HTB)
#define PG8_SB(b, h) ((4 + (b) * 2 + (h)) * HTB)
#define PG8_STAGE(bufoff, gbase, voff) do { _Pragma("unroll") for (int _i = 0; _i < 2; ++_i) \
        __builtin_amdgcn_global_load_lds((const unsigned*)((const char*)(gbase) + (voff)[_i]), (LAS unsigned*)(lds + (bufoff) + ldsw + _i * 8192), 16, 0, 0); } while (0)
#define PG8_LDA(dst, b, h) do { _Pragma("unroll") for (int m = 0; m < 4; ++m) _Pragma("unroll") for (int k = 0; k < 2; ++k) dst[m][k] = *(const LAS bf16x8*)(lds + PG8_SA(b, h) + aoff + m * 2048 + k * 1024); } while (0)
#define PG8_LDB(dst, b, h) do { _Pragma("unroll") for (int n = 0; n < 2; ++n) _Pragma("unroll") for (int k = 0; k < 2; ++k) dst[n][k] = *(const LAS bf16x8*)(lds + PG8_SB(b, h) + boff + n * 2048 + k * 1024); } while (0)
#define PG8_MMA(ai, bj, At, Bt_) do { __builtin_amdgcn_s_setprio(1); _Pragma("unroll") for (int m = 0; m < 4; ++m) _Pragma("unroll") for (int n = 0; n < 2; ++n) _Pragma("unroll") for (int k = 0; k < 2; ++k) { \
        if constexpr (I8) acc[ai][bj][m][n] = __builtin_bit_cast(f32x4, __builtin_amdgcn_mfma_i32_16x16x64_i8(__builtin_bit_cast(i32x4, Bt_[n][k]), __builtin_bit_cast(i32x4, At[m][k]), __builtin_bit_cast(i32x4, acc[ai][bj][m][n]), 0, 0, 0)); \
        else acc[ai][bj][m][n] = __builtin_amdgcn_mfma_f32_16x16x32_bf16(Bt_[n][k], At[m][k], acc[ai][bj][m][n], 0, 0, 0); } __builtin_amdgcn_s_setprio(0); } while (0)
#define PG8_WAIT_V(n) asm volatile("s_waitcnt vmcnt(" #n ")" ::: "memory")
#define PG8_WAIT_L(n) asm volatile("s_waitcnt lgkmcnt(" #n ")" ::: "memory")
#define PG8_BAR __builtin_amdgcn_s_barrier()
#define PG8_SCHED __builtin_amdgcn_sched_barrier(0)
#define PG8_AOFF(dst, U) do { _Pragma("unroll") for (int _h = 0; _h < 2; ++_h) _Pragma("unroll") for (int _i = 0; _i < 2; ++_i) { \
        const int _row = (U).pm * BM + _h * HALF + RA[_i]; const int _src = GATHER ? aidx[_row] : _row; dst[_h][_i] = (unsigned)(_src * K + CA[_i]) * 2u; } } while (0)
#define PG8_STAGE_A(bufoff, kb, offs, h) do { _Pragma("unroll") for (int _i = 0; _i < 2; ++_i) \
        __builtin_amdgcn_global_load_lds((const unsigned*)((const char*)A + (kb) + (offs)[h][_i]), (LAS unsigned*)(lds + (bufoff) + ldsw + _i * 8192), 16, 0, 0); } while (0)
    Unit cur, nxt; int ui = 0;
    if (!S.next(0, cur)) return;
    f32x4 acc[2][2][4][2];
#pragma unroll
    for (int a = 0; a < 2; ++a)
#pragma unroll
        for (int b = 0; b < 2; ++b)
#pragma unroll
            for (int m = 0; m < 4; ++m)
#pragma unroll
                for (int n = 0; n < 2; ++n) acc[a][b][m][n] = (f32x4){0.f, 0.f, 0.f, 0.f};
    bf16x8 At[4][2], B0[2][2], B1[2][2];
    unsigned ac[2][2], an[2][2];
    PG8_AOFF(ac, cur);
    const char* cB = (const char*)Bt + ((size_t)cur.e * bstride) * 2 + (size_t)cur.pn * tstep;
    PG8_STAGE(PG8_SB(0, 0), cB, voffB); PG8_STAGE(PG8_SB(0, 1), cB + hstep, voffB); PG8_STAGE_A(PG8_SA(0, 0), 0, ac, 0); PG8_STAGE_A(PG8_SA(0, 1), 0, ac, 1);
    if (wr == 1) PG8_BAR;
    PG8_WAIT_V(2); PG8_BAR;
    PG8_STAGE(PG8_SB(1, 0), cB + kstep, voffB); PG8_STAGE_A(PG8_SA(1, 0), kstep, ac, 0); PG8_STAGE(PG8_SB(1, 1), cB + hstep + kstep, voffB);
    PG8_WAIT_V(6); PG8_BAR;
    for (;;) {
        const bool has_next = S.next(ui + 1, nxt);
        if (has_next) { PG8_AOFF(an, nxt); } else {
#pragma unroll
            for (int h = 0; h < 2; ++h)
#pragma unroll
                for (int i = 0; i < 2; ++i) an[h][i] = ac[h][i]; }
        const char* nB = has_next ? (const char*)Bt + ((size_t)nxt.e * bstride) * 2 + (size_t)nxt.pn * tstep : cB;
#pragma unroll 1
        for (int t = 0; t < nt; t += 2) {
            const bool last = (t == nt - 2);
            const size_t k1 = (size_t)(t + 1) * kstep;
            const size_t k2 = last ? 0 : (size_t)(t + 2) * kstep;
            const size_t k3 = k2 + kstep;
            const char* b2 = last ? nB : cB + (size_t)(t + 2) * kstep; const char* b3 = b2 + kstep;
            unsigned a2[2][2];
#pragma unroll
            for (int h = 0; h < 2; ++h)
#pragma unroll
                for (int i = 0; i < 2; ++i) a2[h][i] = last ? an[h][i] : ac[h][i];
            PG8_LDB(B0, 0, 0); PG8_LDB(B1, 0, 1); PG8_SCHED; PG8_LDA(At, 0, 0); PG8_STAGE_A(PG8_SA(1, 1), k1, ac, 1);
            PG8_WAIT_V(8); PG8_WAIT_L(0); PG8_BAR; PG8_MMA(0, 0, At, B0); PG8_MMA(0, 1, At, B1); PG8_BAR; PG8_SCHED;
            PG8_LDA(At, 0, 1); PG8_STAGE(PG8_SB(0, 0), b2, voffB); PG8_STAGE(PG8_SB(0, 1), b2 + hstep, voffB); PG8_STAGE_A(PG8_SA(0, 0), k2, a2, 0);
            PG8_WAIT_V(8); PG8_WAIT_L(0); PG8_BAR; PG8_MMA(1, 0, At, B0); PG8_MMA(1, 1, At, B1); PG8_BAR; PG8_SCHED;
            PG8_LDB(B0, 1, 0); PG8_LDB(B1, 1, 1); PG8_SCHED; PG8_LDA(At, 1, 0); PG8_STAGE_A(PG8_SA(0, 1), k2, a2, 1);
            PG8_WAIT_V(8); PG8_WAIT_L(0); PG8_BAR; PG8_MMA(0, 0, At, B0); PG8_MMA(0, 1, At, B1); PG8_BAR; PG8_SCHED;
            PG8_LDA(At, 1, 1); PG8_STAGE(PG8_SB(1, 0), b3, voffB); PG8_STAGE(PG8_SB(1, 1), b3 + hstep, voffB); PG8_STAGE_A(PG8_SA(1, 0), k3, a2, 0);
            PG8_WAIT_V(8); PG8_WAIT_L(0); PG8_BAR; PG8_MMA(1, 0, At, B0); PG8_MMA(1, 1, At, B1); PG8_BAR; PG8_SCHED;
        }
        if (wr == 0) PG8_BAR;
        E(acc, cur, wr, wc, fr, fq);
        if constexpr (Sched::SIGNAL) S.signal(cur, lane);
        if (!has_next) break;
#pragma unroll
        for (int a = 0; a < 2; ++a)
#pragma unroll
            for (int b = 0; b < 2; ++b)
#pragma unroll
                for (int m = 0; m < 4; ++m)
#pragma unroll
                    for (int n = 0; n < 2; ++n) acc[a][b][m][n] = (f32x4){0.f, 0.f, 0.f, 0.f};
        cur = nxt; cB = nB; ++ui;
#pragma unroll
        for (int h = 0; h < 2; ++h)
#pragma unroll
            for (int i = 0; i < 2; ++i) ac[h][i] = an[h][i];
        if (wr == 1) PG8_BAR;
    }
    PG8_WAIT_V(0);
    PG8_BAR;
#undef PG8_SA
#undef PG8_SB
#undef PG8_STAGE
#undef PG8_LDA
#undef PG8_LDB
#undef PG8_MMA
#undef PG8_WAIT_V
#undef PG8_WAIT_L
#undef PG8_BAR
#undef PG8_SCHED
#undef PG8_AOFF
#undef PG8_STAGE_A
}

__device__ __forceinline__ int x8(int e) { return e ^ ((((e >> 1) ^ (e >> 2)) & 1) << 1); }
struct EpiSwiGLU8 {
    static constexpr bool PERM = true, HP = false, SIGNAL = true;
    unsigned char* O; float descale; unsigned* flags;
    __device__ __forceinline__ void operator()(const f32x4 (&acc)[2][2][4][2], const Unit& u, int wr, int wc, int fr, int fq) const {
        const int row0 = u.pm * BM + wr * 64 + fr; const int col0 = u.pn * 128 + wc * 32 + 8 * fq;
#pragma unroll
        for (int ai = 0; ai < 2; ++ai)
#pragma unroll
            for (int m = 0; m < 4; ++m) { unsigned char* rowp = O + (size_t)(row0 + ai * HALF + m * 16) * DEXP + col0;
                float a[8];
#pragma unroll
                for (int n = 0; n < 2; ++n)
#pragma unroll
                    for (int j = 0; j < 4; ++j) { const float g = acc[ai][0][m][n][j] * descale, up = acc[ai][1][m][n][j] * descale; a[n * 4 + j] = S8_ACT * g * up * __builtin_amdgcn_rcpf(1.0f + __expf(-g)); }
                u32x2 w; w.x = cvt4_fp8(a[0], a[1], a[2], a[3]); w.y = cvt4_fp8(a[4], a[5], a[6], a[7]);
                *(u32x2*)rowp = w; }
    }
};
template <class Epi, class Sched, bool GATHER>
__device__ __forceinline__ void gemm_phase8(LAS unsigned char* lds, int wv, const unsigned char* A, const unsigned char* Bt, size_t bstride, int Kb, const Sched& S, const Epi& E, const int* aidx) {
    int tid = wv * 64 + lane_id(); asm volatile("" : "+v"(tid));
    const int wid = wv, lane = tid & 63, wr = wid >> 2, wc = wid & 3, fr = lane & 15, fq = lane >> 4;
    const int nt = Kb / 128;
    int RA[2], CA[2]; unsigned voffB[2], voffB1[2];
#pragma unroll
    for (int i = 0; i < 2; ++i) { const int b = tid * 16 + i * 8192; const int R = b >> 7, pc = (b >> 4) & 7; const int C = (pc ^ x8((R >> 1) & 7)) * 16;
        const int Rb = Epi::PERM ? ((R & ~31) + perm32(R & 31)) : R;
        RA[i] = R; CA[i] = C;
        if (Epi::HP) { const int g0 = 64 * (R >> 5) + perm32(R & 31); voffB[i] = (unsigned)(g0 * Kb + C); voffB1[i] = (unsigned)((g0 + 32) * Kb + C); }
        else { voffB[i] = (unsigned)(Rb * Kb + C); voffB1[i] = voffB[i] + (unsigned)(HALF * Kb); } }
    const size_t kstep = 128;
    const size_t hstep = (size_t)HALF * Kb;
    const size_t tstep = 2 * hstep;
    const unsigned ldsw = (unsigned)wid * 1024u;
    const int xa = x8((fr >> 1) & 7);
    const int aoff = (wr * 64 + fr) * 128 + (((2 * fq) ^ xa) << 4), boff = (wc * 32 + fr) * 128 + (((2 * fq) ^ xa) << 4);
    const int aoff1 = aoff ^ 16, boff1 = boff ^ 16;
#define PG8_SA(b, h) (((b) * 2 + (h)) * HTB)
#define PG8_SB(b, h) ((4 + (b) * 2 + (h)) * HTB)
#define PG8_STAGE(bufoff, gbase, voff) do { _Pragma("unroll") for (int _i = 0; _i < 2; ++_i) \
        __builtin_amdgcn_global_load_lds((const unsigned*)((const char*)(gbase) + (voff)[_i]), (LAS unsigned*)(lds + (bufoff) + ldsw + _i * 8192), 16, 0, 0); } while (0)
#define PG8_RD32(dst, off, off1) do { const u32x4 _lo = *(const LAS u32x4*)(lds + (off)), _hi = *(const LAS u32x4*)(lds + (off1)); \
        dst = (i32x8){(int)_lo.x, (int)_lo.y, (int)_lo.z, (int)_lo.w, (int)_hi.x, (int)_hi.y, (int)_hi.z, (int)_hi.w}; } while (0)
#define PG8_LDA(dst, b, h) do { _Pragma("unroll") for (int m = 0; m < 4; ++m) PG8_RD32(dst[m], PG8_SA(b, h) + aoff + m * 2048, PG8_SA(b, h) + aoff1 + m * 2048); } while (0)
#define PG8_LDB(dst, b, h) do { _Pragma("unroll") for (int n = 0; n < 2; ++n) PG8_RD32(dst[n], PG8_SB(b, h) + boff + n * 2048, PG8_SB(b, h) + boff1 + n * 2048); } while (0)
#define PG8_MMA(ai, bj, At, Bt_) do { __builtin_amdgcn_s_setprio(1); _Pragma("unroll") for (int m = 0; m < 4; ++m) _Pragma("unroll") for (int n = 0; n < 2; ++n) \
        asm volatile("v_mfma_scale_f32_16x16x128_f8f6f4 %0, %1, %2, %0, %3, %3 op_sel_hi:[0,0,0]" : "+v"(acc[ai][bj][m][n]) : "v"(Bt_[n]), "v"(At[m]), "v"(sc1)); __builtin_amdgcn_s_setprio(0); } while (0)
#define PG8_WAIT_V(n) asm volatile("s_waitcnt vmcnt(" #n ")" ::: "memory")
#define PG8_WAIT_L(n) asm volatile("s_waitcnt lgkmcnt(" #n ")" ::: "memory")
#define PG8_BAR __builtin_amdgcn_s_barrier()
#define PG8_SCHED __builtin_amdgcn_sched_barrier(0)
#define PG8_AOFF(dst, U) do { _Pragma("unroll") for (int _h = 0; _h < 2; ++_h) _Pragma("unroll") for (int _i = 0; _i < 2; ++_i) { \
        const int _row = (U).pm * BM + _h * HALF + RA[_i]; const int _src = GATHER ? aidx[_row] : _row; dst[_h][_i] = (unsigned)(_src * Kb + CA[_i]); } } while (0)
#define PG8_STAGE_A(bufoff, kb, offs, h) do { _Pragma("unroll") for (int _i = 0; _i < 2; ++_i) \
        __builtin_amdgcn_global_load_lds((const unsigned*)((const char*)A + (kb) + (offs)[h][_i]), (LAS unsigned*)(lds + (bufoff) + ldsw + _i * 8192), 16, 0, 0); } while (0)
    Unit cur, nxt; int ui = 0;
    if (!S.next(0, cur)) return;
    f32x4 acc[2][2][4][2];
#pragma unroll
    for (int a = 0; a < 2; ++a)
#pragma unroll
        for (int b = 0; b < 2; ++b)
#pragma unroll
            for (int m = 0; m < 4; ++m)
#pragma unroll
                for (int n = 0; n < 2; ++n) acc[a][b][m][n] = (f32x4){0.f, 0.f, 0.f, 0.f};
    i32x8 At[4], B0[2], B1[2];
    int sc1 = 0x7F7F7F7F; asm volatile("" : "+v"(sc1));
    unsigned ac[2][2], an[2][2];
    PG8_AOFF(ac, cur);
    const char* cB = (const char*)Bt + (size_t)cur.e * bstride + (size_t)cur.pn * tstep;
    PG8_STAGE(PG8_SB(0, 0), cB, voffB); PG8_STAGE(PG8_SB(0, 1), cB, voffB1); PG8_STAGE_A(PG8_SA(0, 0), 0, ac, 0); PG8_STAGE_A(PG8_SA(0, 1), 0, ac, 1);
    if (wr == 1) PG8_BAR;
    PG8_WAIT_V(2); PG8_BAR;
    PG8_STAGE(PG8_SB(1, 0), cB + kstep, voffB); PG8_STAGE_A(PG8_SA(1, 0), kstep, ac, 0); PG8_STAGE(PG8_SB(1, 1), cB + kstep, voffB1);
    PG8_WAIT_V(6); PG8_BAR;
    for (;;) {
        const bool has_next = S.next(ui + 1, nxt);
        if (has_next) { PG8_AOFF(an, nxt); } else {
#pragma unroll
            for (int h = 0; h < 2; ++h)
#pragma unroll
                for (int i = 0; i < 2; ++i) an[h][i] = ac[h][i]; }
        const char* nB = has_next ? (const char*)Bt + (size_t)nxt.e * bstride + (size_t)nxt.pn * tstep : cB;
#pragma unroll 1
        for (int t = 0; t < nt; t += 2) {
            const bool last = (t == nt - 2);
            const size_t k1 = (size_t)(t + 1) * kstep;
            const size_t k2 = last ? 0 : (size_t)(t + 2) * kstep;
            const size_t k3 = k2 + kstep;
            const char* b2 = last ? nB : cB + (size_t)(t + 2) * kstep; const char* b3 = b2 + kstep;
            unsigned a2[2][2];
#pragma unroll
            for (int h = 0; h < 2; ++h)
#pragma unroll
                for (int i = 0; i < 2; ++i) a2[h][i] = last ? an[h][i] : ac[h][i];
            PG8_LDB(B0, 0, 0); PG8_LDB(B1, 0, 1); PG8_SCHED; PG8_LDA(At, 0, 0); PG8_STAGE_A(PG8_SA(1, 1), k1, ac, 1);
            PG8_WAIT_V(8); PG8_WAIT_L(0); PG8_BAR;
            if constexpr (Epi::HP) { if (t == 0 && cur.pn < 8) {
                const char* cb_ = (const char*)(E.cs + (size_t)cur.pm * BM * 16) + wid * 1024; int l16_ = lane_id() * 16; asm volatile("" : "+v"(l16_));
#pragma unroll
                for (int k_ = 0; k_ < 2; ++k_) __builtin_amdgcn_global_load_lds((const unsigned*)(cb_ + k_ * 8192 + l16_), (LAS unsigned*)(lds + TAB_OFF + k_ * 8192 + wid * 1024), 16, 0, 0); } }
            PG8_MMA(0, 0, At, B0); PG8_MMA(0, 1, At, B1); PG8_BAR; PG8_SCHED;
            PG8_LDA(At, 0, 1); PG8_STAGE(PG8_SB(0, 0), b2, voffB); PG8_STAGE(PG8_SB(0, 1), b2, voffB1); PG8_STAGE_A(PG8_SA(0, 0), k2, a2, 0);
            PG8_WAIT_V(8); PG8_WAIT_L(0); PG8_BAR; PG8_MMA(1, 0, At, B0); PG8_MMA(1, 1, At, B1); PG8_BAR; PG8_SCHED;
            PG8_LDB(B0, 1, 0); PG8_LDB(B1, 1, 1); PG8_SCHED; PG8_LDA(At, 1, 0); PG8_STAGE_A(PG8_SA(0, 1), k2, a2, 1);
            PG8_WAIT_V(8); PG8_WAIT_L(0); PG8_BAR; PG8_MMA(0, 0, At, B0); PG8_MMA(0, 1, At, B1); PG8_BAR; PG8_SCHED;
            PG8_LDA(At, 1, 1); PG8_STAGE(PG8_SB(1, 0), b3, voffB); PG8_STAGE(PG8_SB(1, 1), b3, voffB1); PG8_STAGE_A(PG8_SA(1, 0), k3, a2, 0);
            PG8_WAIT_V(8); PG8_WAIT_L(0); PG8_BAR; PG8_MMA(1, 0, At, B0); PG8_MMA(1, 1, At, B1); PG8_BAR; PG8_SCHED;
        }
        if (wr == 0) PG8_BAR;
        asm volatile("s_nop 15\n\ts_nop 15" ::: "memory");
        E(acc, cur, wr, wc, fr, fq);
        if constexpr (Epi::SIGNAL) { asm volatile("s_waitcnt vmcnt(0)" ::: "memory"); if (lane == 0) (void)xb_add(E.flags + cur.pm, 1u); }
        if (!has_next) break;
#pragma unroll
        for (int a = 0; a < 2; ++a)
#pragma unroll
            for (int b = 0; b < 2; ++b)
#pragma unroll
                for (int m = 0; m < 4; ++m)
#pragma unroll
                    for (int n = 0; n < 2; ++n) acc[a][b][m][n] = (f32x4){0.f, 0.f, 0.f, 0.f};
        cur = nxt; cB = nB; ++ui;
#pragma unroll
        for (int h = 0; h < 2; ++h)
#pragma unroll
            for (int i = 0; i < 2; ++i) ac[h][i] = an[h][i];
        if (wr == 1) PG8_BAR;
    }
    PG8_WAIT_V(0);
    PG8_BAR;
#undef PG8_SA
#undef PG8_SB
#undef PG8_STAGE
#undef PG8_RD32
#undef PG8_LDA
#undef PG8_LDB
#undef PG8_MMA
#undef PG8_WAIT_V
#undef PG8_WAIT_L
#undef PG8_BAR
#undef PG8_SCHED
#undef PG8_AOFF
#undef PG8_STAGE_A
}
}

namespace attn_body {
using bf16 = __hip_bfloat16;
using f32x16 = __attribute__((ext_vector_type(16))) float;
constexpr int D = 64, PQ = 3072, PO = 2048;
constexpr int NW = 8, QBLK = 32, QB = QBLK * NW, KVBLK = 64, NQB = SEQ / QB;
__device__ __forceinline__ int crow(int r, int hi) { return (r & 3) + 8 * (r >> 2) + 4 * hi; }
#define SBAR() __builtin_amdgcn_sched_barrier(0)
__device__ __forceinline__ void cmask(f32x16& p0, f32x16& p1, int jb, int qrel, int hi) {
    const float NEG = -INFINITY; int kb = 64 * jb + 4 * hi;
#pragma unroll
    for (int r = 0; r < 16; ++r) { int kv = kb + (r & 3) + 8 * (r >> 2); if (kv > qrel) p0[r] = NEG; if (kv + 32 > qrel) p1[r] = NEG; }
}
constexpr int NSLOT = 3, SLOTB = 8192;
constexpr int LDS_K = 0, LDS_V = NSLOT * SLOTB, LDS_WS = 2 * NSLOT * SLOTB, LDS_OST = LDS_WS + NW * 64 * 4, ATT_LDS_BYTES = LDS_OST + NW * 4096;
__device__ __forceinline__ void glds16(const void* gsrc, unsigned lds_dst) { unsigned keep;
    asm volatile("s_mov_b32 %0, m0\n\ts_mov_b32 m0, %2\n\ts_nop 0\n\tglobal_load_lds_dwordx4 %1, off\n\ts_mov_b32 m0, %0" : "=&s"(keep) : "v"(gsrc), "s"(lds_dst) : "memory"); }
__device__ __forceinline__ float max3f(float a, float b, float c) { float r; asm("v_max3_f32 %0, %1, %2, %3" : "=v"(r) : "v"(a), "v"(b), "v"(c)); return r; }
__device__ __forceinline__ float max2f(float a, float b) { float r; asm("v_max_f32_e32 %0, %1, %2" : "=v"(r) : "v"(a), "v"(b)); return r; }
__device__ __forceinline__ float fadd_s(float a, float b) { float r; asm("v_add_f32_e32 %0, %1, %2" : "=v"(r) : "v"(a), "v"(b)); return r; }
__device__ __forceinline__ float fsub_s(float a, float b) { float r; asm("v_sub_f32_e32 %0, %1, %2" : "=v"(r) : "v"(a), "v"(b)); return r; }
__device__ __forceinline__ unsigned cvtpk_s(float lo, float hi) { f32x2 v = {lo, hi}; bf16x2_t b = __builtin_convertvector(v, bf16x2_t); return __builtin_bit_cast(unsigned, b); }
#define WAIT_BAR(N) asm volatile("s_waitcnt vmcnt(" #N ") lgkmcnt(0)\n\ts_barrier" ::: "memory")
__device__ __forceinline__ void qkt(f32x16& p0, f32x16& p1, const char* Kslot, const bf16x8* qr, const f32x16& negm, int r32, int hi) {
    const char* kb = Kslot + hi * 1024 + r32 * 16;
#pragma unroll
    for (int d0 = 0; d0 < 4; ++d0) {
        const bf16x8 b0 = *reinterpret_cast<const bf16x8*>(kb + d0 * 2048);
        const bf16x8 b1 = *reinterpret_cast<const bf16x8*>(kb + d0 * 2048 + 512);
        if (d0 == 0) { p0 = __builtin_amdgcn_mfma_f32_32x32x16_bf16(b0, qr[0], negm, 0, 0, 0); p1 = __builtin_amdgcn_mfma_f32_32x32x16_bf16(b1, qr[0], negm, 0, 0, 0); }
        else { p0 = __builtin_amdgcn_mfma_f32_32x32x16_bf16(b0, qr[d0], p0, 0, 0, 0); p1 = __builtin_amdgcn_mfma_f32_32x32x16_bf16(b1, qr[d0], p1, 0, 0, 0); } }
}
typedef __attribute__((address_space(3))) const char* lds_cptr;
typedef short v4i16_t __attribute__((ext_vector_type(4)));
__device__ __forceinline__ void kload8(bf16x8* kf, lds_cptr kp) {
    kf[0] = *(const LAS bf16x8*)(kp);        kf[1] = *(const LAS bf16x8*)(kp + 512);
    kf[2] = *(const LAS bf16x8*)(kp + 2048); kf[3] = *(const LAS bf16x8*)(kp + 2560);
    kf[4] = *(const LAS bf16x8*)(kp + 4096); kf[5] = *(const LAS bf16x8*)(kp + 4608);
    kf[6] = *(const LAS bf16x8*)(kp + 6144); kf[7] = *(const LAS bf16x8*)(kp + 6656);
}
__device__ __forceinline__ void kload2(bf16x8* kf, lds_cptr kp, int j) { kf[2 * j] = *(const LAS bf16x8*)(kp + j * 2048); kf[2 * j + 1] = *(const LAS bf16x8*)(kp + j * 2048 + 512); }
__device__ __forceinline__ s16x4 vtr(lds_cptr p) { return __builtin_bit_cast(s16x4, __builtin_amdgcn_ds_read_tr16_b64_v4i16((LAS v4i16_t*)p)); }
__device__ __forceinline__ float rowmax(const f32x16& p0, const f32x16& p1) {
    float a = max3f(p0[0], p0[1], p1[0]), b = max3f(p0[2], p0[3], p1[1]); a = max3f(a, p1[2], p1[3]);
#pragma unroll
    for (int r = 4; r < 16; r += 4) { a = max3f(a, p0[r], p0[r + 1]); b = max3f(b, p0[r + 2], p0[r + 3]); a = max3f(a, p1[r], p1[r + 1]); b = max3f(b, p1[r + 2], p1[r + 3]); }
    const float m = max2f(a, b);
    auto rr = __builtin_amdgcn_permlane32_swap(__float_as_uint(m), __float_as_uint(m), false, false);
    return max2f(__uint_as_float(rr[0]), __uint_as_float(rr[1]));
}
__device__ __forceinline__ void pv(f32x16* o, int vb, bf16x8 pa0, bf16x8 pa1, bf16x8 pa2, bf16x8 pa3) {
#pragma unroll
    for (int d0 = 0; d0 < 2; ++d0) { s16x4 lo[4], hi[4];
#pragma unroll
        for (int ks = 0; ks < 4; ++ks) {
            asm volatile("ds_read_b64_tr_b16 %0,%1 offset:%c2" : "=&v"(lo[ks]) : "v"(vb), "i"(d0 * 4096 + ks * 1024) : "memory");
            asm volatile("ds_read_b64_tr_b16 %0,%1 offset:%c2" : "=&v"(hi[ks]) : "v"(vb), "i"(d0 * 4096 + ks * 1024 + 512) : "memory"); }
        asm volatile("s_waitcnt lgkmcnt(0)" ::: "memory"); SBAR();
#define PK(k) (bf16x8){lo[k][0], lo[k][1], lo[k][2], lo[k][3], hi[k][0], hi[k][1], hi[k][2], hi[k][3]}
        o[d0] = __builtin_amdgcn_mfma_f32_32x32x16_bf16(pa0, PK(0), o[d0], 0, 0, 0);
        o[d0] = __builtin_amdgcn_mfma_f32_32x32x16_bf16(pa1, PK(1), o[d0], 0, 0, 0);
        o[d0] = __builtin_amdgcn_mfma_f32_32x32x16_bf16(pa2, PK(2), o[d0], 0, 0, 0);
        o[d0] = __builtin_amdgcn_mfma_f32_32x32x16_bf16(pa3, PK(3), o[d0], 0, 0, 0);
#undef PK
    }
}
#define ATTN_STORE16(p, v) (*(u32x4*)(p) = (v))
template <int THRL> __device__ __forceinline__ void attn_unit(int wv, int pair, int qb, const bf16* Pb, bf16* Obuf, char* shm) {
    const int b = pair >> 5, v5 = pair & 31, hc = v5 >> 1; const int qc = hc * 64, kc = 1024 + hc * 64, vc = 2048 + (v5 >> 2) * 128 + (v5 & 1) * 64, oc = v5 * 64;
    int tid = wv * 64 + lane_id(); asm volatile("" : "+v"(tid));
    const int lane = tid & 63, r32 = lane & 31, hi = lane >> 5; const int wid = wv;
    const long rowbase = (long)b * SEQ; const int q0 = qb * QB;
    const bf16* Qw = Pb + (rowbase + q0 + wid * QBLK) * PQ + qc;
    const bf16* Kh = Pb + rowbase * PQ + kc, *Vh = Pb + rowbase * PQ + vc;
    const unsigned lds0 = (unsigned)(uintptr_t)shm;
    float* wsf = (float*)(shm + LDS_WS) + wid * 64;
    const bf16* ksrc = Kh + (long)lane * PQ + wid * 8;
    const bf16* vsrc = Vh + (long)(16 * (wid & 3) + (lane >> 2)) * PQ + (wid >> 2) * 32 + (lane & 3) * 8;
    const unsigned kdst = lds0 + LDS_K + wid * 1024, vdst = lds0 + LDS_V + wid * 1024;
#define DMA_K(t, slot) glds16(ksrc + (long)(t) * KVBLK * PQ, (unsigned)__builtin_amdgcn_readfirstlane(kdst + (slot)))
#define DMA_V(t, slot) glds16(vsrc + (long)(t) * KVBLK * PQ, (unsigned)__builtin_amdgcn_readfirstlane(vdst + (slot)))
    const int vb0 = (int)(lds0 + LDS_V) + ((lane >> 4) & 1) * 32 + (lane & 3) * 8 + (4 * hi + ((lane & 15) >> 2)) * 64;
    const char* Kbase = shm + LDS_K; bf16x8 kf[8];
    const lds_cptr shm3 = (lds_cptr)shm; const lds_cptr kp0 = shm3 + LDS_K + hi * 1024 + r32 * 16; const lds_cptr vp0 = shm3 + LDS_V + ((lane >> 4) & 1) * 32 + (lane & 3) * 8 + (4 * hi + ((lane & 15) >> 2)) * 64;
    const int NT = (q0 + QB) / KVBLK;
    DMA_K(0, 0); DMA_V(0, 0); DMA_K(1, SLOTB);
    bf16x8 qr[4];
#pragma unroll
    for (int d0 = 0; d0 < 4; ++d0) qr[d0] = *reinterpret_cast<const bf16x8*>(&Qw[(long)r32 * PQ + d0 * 16 + hi * 8]);
    float mhat = 0.f, l_reg = 0.f; f32x16 o[2]; o[0] = f32x16{}; o[1] = f32x16{}; f32x16 negm = f32x16{}; asm volatile("" : "+v"(negm));
    const int qrel = wid * QBLK + r32;
#define CMASK(P0, P1, t) do { int jb_ = (t) - (NT - 4); if (jb_ >= 0) cmask(P0, P1, jb_, qrel, hi); } while (0)
    bool resc = false;
#define START(P0, P1) do { const float rm = rowmax(P0, P1); resc = false; \
    { const float dl = rm; mhat = fadd_s(mhat, dl); \
      _Pragma("unroll") for (int r = 0; r < 16; ++r) { P0[r] = fsub_s(P0[r], dl); P1[r] = fsub_s(P1[r], dl); } \
      _Pragma("unroll") for (int r = 0; r < 16; ++r) negm[r] = -mhat; asm volatile("" : "+v"(negm)); } \
    _Pragma("unroll") for (int r = 0; r < 16; ++r) P0[r] = __builtin_amdgcn_exp2f(P0[r]); } while (0)
#define RESC() do { if (resc) { asm volatile("s_waitcnt lgkmcnt(0)" ::: "memory"); \
      _Pragma("unroll") for (int d_ = 0; d_ < 2; ++d_) _Pragma("unroll") for (int r = 0; r < 16; ++r) o[d_][r] *= wsf[crow(r, hi)]; } } while (0)
    f32x16 pA0, pA1, pB0, pB1;
    int sl_prev = 0, sl_cur = 0, sl_next = SLOTB;
#define ROT() do { sl_prev = sl_cur; sl_cur = sl_next; sl_next = (sl_next == (NSLOT - 1) * SLOTB) ? 0 : sl_next + SLOTB; } while (0)
    DMA_K(2, 2 * SLOTB);
    WAIT_BAR(3);
    qkt(pA0, pA1, Kbase, qr, negm, r32, hi); asm volatile("s_nop 15\n\ts_nop 7" : "+v"(pA0), "+v"(pA1)); CMASK(pA0, pA1, 0);
    START(pA0, pA1);
    _Pragma("unroll") for (int r = 0; r < 16; ++r) pA1[r] = __builtin_amdgcn_exp2f(pA1[r]);
    WAIT_BAR(0);
    DMA_K(3, 0); DMA_V(1, SLOTB);
    ROT();
    kload8(kf, kp0 + sl_cur);
    WAIT_BAR(2);
    s16x4 vlo[8], vhi[8]; u32x4 pw0, pw1, pw2, pw3;
#define PKW(P, B) cvtpk_s(P[B], P[B + 1])
#define PAF(k) __builtin_bit_cast(bf16x8, pw##k)
#define VFR(i) (bf16x8){vlo[i][0], vlo[i][1], vlo[i][2], vlo[i][3], vhi[i][0], vhi[i][1], vhi[i][2], vhi[i][3]}
#define PIN(x) asm volatile("" : "+v"(x))
#define MX3(a, b, c) __builtin_fmaxf(__builtin_fmaxf((a), (b)), (c))
#define GAPA(MF, A0, A1, A2, A3, W0, W1, PW) do { MF; sacc += A0; sacc += A1; sacc += A2; sacc += A3; PIN(sacc); W0; W1; PIN(PW); SBAR(); } while (0)
#define EX(v) __builtin_amdgcn_exp2f(v)
#define GAPB(MF, X, B) do { MF; X[B] = EX(X[B]); X[B + 1] = EX(X[B + 1]); X[B + 2] = EX(X[B + 2]); X[B + 3] = EX(X[B + 3]); PIN(X); SBAR(); } while (0)
#define VRD(i) do { vlo[i] = vtr(vp_ + (((i) >> 2) * 4096 + ((i) & 3) * 1024)); vhi[i] = vtr(vp_ + (((i) >> 2) * 4096 + ((i) & 3) * 1024 + 512)); } while (0)
#define KRD(G, j) do { if (G) { kload2(kf, kp0 + sl_next, j); SBAR(); } } while (0)
#define STEP(C0, C1, P0, P1, t, GK, GV, GL) do { SBAR(); \
    const lds_cptr vp_ = vp0 + sl_prev; \
    VRD(0); SBAR(); float sacc = (P0[0] + P0[1]); \
    GAPA(C0 = __builtin_amdgcn_mfma_f32_32x32x16_bf16(kf[0], qr[0], negm, 0, 0, 0), P0[2], P0[3], P0[4], P0[5],     pw0[0] = PKW(P0, 0), pw0[1] = PKW(P0, 2), pw0); \
    VRD(4); SBAR(); GAPA(C1 = __builtin_amdgcn_mfma_f32_32x32x16_bf16(kf[1], qr[0], negm, 0, 0, 0), P0[6], P0[7], P0[8], P0[9],     pw0[2] = PKW(P0, 4), pw0[3] = PKW(P0, 6), pw0); \
    VRD(1); SBAR(); GAPA(C0 = __builtin_amdgcn_mfma_f32_32x32x16_bf16(kf[2], qr[1], C0, 0, 0, 0),   P0[10], P0[11], P0[12], P0[13], pw1[0] = PKW(P0, 8), pw1[1] = PKW(P0, 10), pw1); \
    VRD(5); SBAR(); GAPA(C1 = __builtin_amdgcn_mfma_f32_32x32x16_bf16(kf[3], qr[1], C1, 0, 0, 0),   P0[14], P0[15], P1[0], P1[1],   pw1[2] = PKW(P0, 12), pw1[3] = PKW(P0, 14), pw1); \
    VRD(2); SBAR(); GAPA(C0 = __builtin_amdgcn_mfma_f32_32x32x16_bf16(kf[4], qr[2], C0, 0, 0, 0),   P1[2], P1[3], P1[4], P1[5],     pw2[0] = PKW(P1, 0), pw2[1] = PKW(P1, 2), pw2); \
    VRD(6); SBAR(); GAPA(C1 = __builtin_amdgcn_mfma_f32_32x32x16_bf16(kf[5], qr[2], C1, 0, 0, 0),   P1[6], P1[7], P1[8], P1[9],     pw2[2] = PKW(P1, 4), pw2[3] = PKW(P1, 6), pw2); \
    VRD(3); SBAR(); GAPA(C0 = __builtin_amdgcn_mfma_f32_32x32x16_bf16(kf[6], qr[3], C0, 0, 0, 0),   P1[10], P1[11], P1[12], P1[13], pw3[0] = PKW(P1, 8), pw3[1] = PKW(P1, 10), pw3); \
    VRD(7); SBAR(); GAPA(C1 = __builtin_amdgcn_mfma_f32_32x32x16_bf16(kf[7], qr[3], C1, 0, 0, 0),   P1[14], P1[15], 0.f, 0.f,       pw3[2] = PKW(P1, 12), pw3[3] = PKW(P1, 14), pw3); \
    l_reg += sacc; \
    if (GK) { DMA_K((t) + 3, sl_cur); } if (GV) { DMA_V((t) + 1, sl_next); } \
    CMASK(C0, C1, t); \
    { float a = MX3(C0[0], C0[1], C1[0]), b = MX3(C0[2], C0[3], C1[1]); a = MX3(a, C1[2], C1[3]); \
      _Pragma("unroll") for (int r = 4; r < 16; r += 4) { a = MX3(a, C0[r], C0[r + 1]); b = MX3(b, C0[r + 2], C0[r + 3]); a = MX3(a, C1[r], C1[r + 1]); b = MX3(b, C1[r + 2], C1[r + 3]); } \
      float rm = __builtin_fmaxf(a, b); { auto rr = __builtin_amdgcn_permlane32_swap(__float_as_uint(rm), __float_as_uint(rm), false, false); rm = __builtin_fmaxf(__uint_as_float(rr[0]), __uint_as_float(rr[1])); } \
      resc = false; \
      if (__builtin_expect(__any(rm > (float)THRL), 0)) { const float dl = __builtin_fmaxf(rm, 0.f); mhat += dl; \
        _Pragma("unroll") for (int r = 0; r < 16; ++r) { C0[r] -= dl; C1[r] -= dl; } \
        _Pragma("unroll") for (int r = 0; r < 16; ++r) negm[r] = -mhat; asm volatile("" : "+v"(negm)); \
        const float f = __builtin_amdgcn_exp2f(-dl); l_reg *= f; if (hi == 0) wsf[r32] = f; resc = true; } } \
    SBAR(); \
    GAPB(o[0] = __builtin_amdgcn_mfma_f32_32x32x16_bf16(PAF(0), VFR(0), o[0], 0, 0, 0), C0, 0); \
    GAPB(o[1] = __builtin_amdgcn_mfma_f32_32x32x16_bf16(PAF(0), VFR(4), o[1], 0, 0, 0), C0, 4); \
    KRD(GL, 0); GAPB(o[0] = __builtin_amdgcn_mfma_f32_32x32x16_bf16(PAF(1), VFR(1), o[0], 0, 0, 0), C0, 8); \
    KRD(GL, 1); GAPB(o[1] = __builtin_amdgcn_mfma_f32_32x32x16_bf16(PAF(1), VFR(5), o[1], 0, 0, 0), C0, 12); \
    KRD(GL, 2); GAPB(o[0] = __builtin_amdgcn_mfma_f32_32x32x16_bf16(PAF(2), VFR(2), o[0], 0, 0, 0), C1, 0); \
    KRD(GL, 3); GAPB(o[1] = __builtin_amdgcn_mfma_f32_32x32x16_bf16(PAF(2), VFR(6), o[1], 0, 0, 0), C1, 4); \
    GAPB(o[0] = __builtin_amdgcn_mfma_f32_32x32x16_bf16(PAF(3), VFR(3), o[0], 0, 0, 0), C1, 8); \
    GAPB(o[1] = __builtin_amdgcn_mfma_f32_32x32x16_bf16(PAF(3), VFR(7), o[1], 0, 0, 0), C1, 12); \
    } while (0)
    int t = 1;
#undef CMASK
#define CMASK(P0, P1, t) do {} while (0)
    for (; t + 5 < NT; t += 2) {
        STEP(pB0, pB1, pA0, pA1, t, true, true, true);     WAIT_BAR(2); RESC(); ROT();
        STEP(pA0, pA1, pB0, pB1, t + 1, true, true, true); WAIT_BAR(2); RESC(); ROT();
    }
#undef CMASK
#define CMASK(P0, P1, t) do { int jb_ = (t) - (NT - 4); if (jb_ >= 0) cmask(P0, P1, jb_, qrel, hi); } while (0)
#define ENDW(tt) do { if ((tt) + 3 < NT) { WAIT_BAR(2); } else if ((tt) + 2 < NT) { WAIT_BAR(1); } else { WAIT_BAR(0); } } while (0)
    for (; t + 1 < NT; t += 2) {
        STEP(pB0, pB1, pA0, pA1, t, (t + 3 < NT), (t + 1 < NT), (t + 1 < NT));         ENDW(t);     RESC(); ROT();
        STEP(pA0, pA1, pB0, pB1, t + 1, (t + 4 < NT), (t + 2 < NT), (t + 2 < NT));     ENDW(t + 1); RESC(); ROT();
    }
    STEP(pB0, pB1, pA0, pA1, NT - 1, false, false, false); RESC();
    { float sacc = pB0[0] + pB0[1]; _Pragma("unroll") for (int r = 2; r < 16; ++r) sacc += pB0[r]; _Pragma("unroll") for (int r = 0; r < 16; ++r) sacc += pB1[r]; l_reg += sacc;
      pw0 = (u32x4){PKW(pB0, 0), PKW(pB0, 2), PKW(pB0, 4), PKW(pB0, 6)}; pw1 = (u32x4){PKW(pB0, 8), PKW(pB0, 10), PKW(pB0, 12), PKW(pB0, 14)}; pw2 = (u32x4){PKW(pB1, 0), PKW(pB1, 2), PKW(pB1, 4), PKW(pB1, 6)}; pw3 = (u32x4){PKW(pB1, 8), PKW(pB1, 10), PKW(pB1, 12), PKW(pB1, 14)};
      SBAR(); pv(o, vb0 + sl_cur, PAF(0), PAF(1), PAF(2), PAF(3)); }
#undef PKW
#undef PAF
#undef VFR
#undef PIN
#undef MX3
#undef GAPA
#undef GAPB
#undef EX
#undef VRD
#undef KRD
#undef STEP
#undef ENDW
    { auto rr = __builtin_amdgcn_permlane32_swap(__float_as_uint(l_reg), __float_as_uint(l_reg), false, false); l_reg = __uint_as_float(rr[0]) + __uint_as_float(rr[1]); }
    if (hi == 0) wsf[32 + r32] = l_reg; asm volatile("s_waitcnt lgkmcnt(0)" ::: "memory");
    float rli[16];
#pragma unroll
    for (int r = 0; r < 16; ++r) rli[r] = __builtin_amdgcn_rcpf(wsf[32 + crow(r, hi)]);
    bf16* Ow = Obuf + (rowbase + q0 + wid * QBLK) * PO + oc;
    { bf16* stg = (bf16*)(shm + LDS_OST) + wid * 2048;
#pragma unroll
      for (int r = 0; r < 16; ++r) { const int orow = crow(r, hi);
#pragma unroll
        for (int d0 = 0; d0 < 2; ++d0) stg[orow * 64 + d0 * 32 + r32] = __float2bfloat16(o[d0][r] * rli[r]); }
      asm volatile("s_waitcnt lgkmcnt(0)" ::: "memory");
#pragma unroll
      for (int i = 0; i < 4; ++i) { const int row = i * 8 + (lane >> 3), ch = lane & 7; const u32x4 v = *(const u32x4*)(stg + row * 64 + ch * 8); ATTN_STORE16(Ow + (long)row * PO + ch * 8, v); } }
    asm volatile("s_waitcnt lgkmcnt(0)\n\ts_barrier" ::: "memory");
#undef DMA_K
#undef DMA_V
#undef CMASK
#undef START
#undef RESC
#undef ROT
}
#undef SBAR
#undef WAIT_BAR
}


namespace at2 {
using f32x16 = __attribute__((ext_vector_type(16))) float;
constexpr int PQ = 3072, PO = 256, DV = 128, DQ = 64;
constexpr int NW = 8, QBLK = 32, KVBLK = 64, QB = NW * QBLK;
constexpr int SHM_V = KVBLK * DV * 2, SHM_K = KVBLK * DQ * 2;
constexpr int OFF_VL = 0, OFF_KL = 2 * SHM_V, OFF_WS = 2 * SHM_V + 2 * SHM_K;
constexpr int OFF_OL = OFF_WS + 2048, OL_RS = 272, OL_WAVE = QBLK * OL_RS;
constexpr float THR2 = 8.f;
#define KSWZ64(row, colB) ((row) * 128 + ((colB) ^ (((row) & 7) << 4)))
#define SBAR() __builtin_amdgcn_sched_barrier(0)
__device__ __forceinline__ int v_st(int k, int c) { const int kk = (k & ~0xC) | ((k & 4) << 1) | ((k & 8) >> 1); return ((kk >> 3) * 4 + (c >> 5)) * 512 + ((kk & 7) * 32 + (c & 31)) * 2; }
__device__ __forceinline__ int v_rd_base(int lane) { return ((lane & 3) << 3) | (((lane >> 2) & 3) << 6) | (((lane >> 4) & 1) << 5) | (((lane >> 5) & 1) << 8); }
constexpr int v_rd_off(int d0, int ks, int half) { return d0 * 512 + ks * 4096 + half * 2048; }
__device__ __forceinline__ int crow(int r, int hi) { return (r & 3) + 8 * (r >> 2) + 4 * hi; }
__device__ __forceinline__ bf16x8 load8(const bf16_t* p) { return *reinterpret_cast<const bf16x8*>(p); }
__device__ __forceinline__ void mask_tile(f32x16& p0, f32x16& p1, int dq) {
    const float NEG = -__builtin_inff();
#pragma unroll
    for (int r = 0; r < 16; ++r) { const int c = (r & 3) + 8 * (r >> 2); if (dq - c < 0) p0[r] = NEG; if (dq - c - 32 < 0) p1[r] = NEG; }
}
__device__ __forceinline__ void partialSM(f32x16& p0, f32x16& p1, float& m_reg, float& mn, float& alpha) {
    float pmax = p0[0];
#pragma unroll
    for (int r = 1; r < 16; ++r) pmax = fmaxf(pmax, p0[r]);
#pragma unroll
    for (int r = 0; r < 16; ++r) pmax = fmaxf(pmax, p1[r]);
    { auto rr = __builtin_amdgcn_permlane32_swap(__float_as_uint(pmax), __float_as_uint(pmax), false, false); pmax = fmaxf(__uint_as_float(rr[0]), __uint_as_float(rr[1])); }
    if (__builtin_expect(__all((pmax - m_reg) <= THR2), 1)) { mn = m_reg; alpha = 1.f; }
    else { mn = fmaxf(m_reg, pmax); alpha = __builtin_amdgcn_exp2f(m_reg - mn); m_reg = mn; }
#pragma unroll
    for (int r = 0; r < 16; ++r) { p0[r] = p0[r] - mn; p1[r] = p1[r] - mn; }
#pragma unroll
    for (int r = 0; r < 16; ++r) p0[r] = __builtin_amdgcn_exp2f(p0[r]);
}
__device__ __forceinline__ void finishSM(f32x16& p0, f32x16& p1, float alpha, float& l_reg, bf16x8& pa0, bf16x8& pa1, bf16x8& pa2, bf16x8& pa3) {
#pragma unroll
    for (int r = 0; r < 16; ++r) p1[r] = __builtin_amdgcn_exp2f(p1[r]);
    float ps = 0;
#pragma unroll
    for (int r = 0; r < 16; ++r) ps += p0[r];
#pragma unroll
    for (int r = 0; r < 16; ++r) ps += p1[r];
    { auto rr = __builtin_amdgcn_permlane32_swap(__float_as_uint(ps), __float_as_uint(ps), false, false); ps = __uint_as_float(rr[0]) + __uint_as_float(rr[1]); }
    l_reg = l_reg * alpha + ps;
#define PK4(P, B_, OUT) do { unsigned a0 = cvtpk(P[B_+0], P[B_+1]), a1 = cvtpk(P[B_+2], P[B_+3]);                          \
        unsigned b0 = cvtpk(P[B_+4], P[B_+5]), b1 = cvtpk(P[B_+6], P[B_+7]);                                             \
        auto r0 = __builtin_amdgcn_permlane32_swap(a0, b0, false, false); auto r1 = __builtin_amdgcn_permlane32_swap(a1, b1, false, false); \
        u32x4 w = {r0[0], r1[0], r0[1], r1[1]}; OUT = *reinterpret_cast<bf16x8*>(&w); } while (0)
    PK4(p0, 0, pa0); PK4(p0, 8, pa1); PK4(p1, 0, pa2); PK4(p1, 8, pa3);
#undef PK4
}
template <int KB>
__device__ __forceinline__ void qkt(f32x16& p0, f32x16& p1, const char* K_lds, int r32, int hi, const bf16x8* qr) {
    p0 = f32x16{}; p1 = f32x16{};
#pragma unroll
    for (int d0 = 0; d0 < 4; ++d0) { const char* a = K_lds + KB * SHM_K + KSWZ64(r32, (d0 * 16 + hi * 8) * 2);
        bf16x8 b0 = *reinterpret_cast<const bf16x8*>(a);
        bf16x8 b1 = *reinterpret_cast<const bf16x8*>(a + 32 * 128);
        p0 = __builtin_amdgcn_mfma_f32_32x32x16_bf16(b0, qr[d0], p0, 0, 0, 0);
        p1 = __builtin_amdgcn_mfma_f32_32x32x16_bf16(b1, qr[d0], p1, 0, 0, 0); }
}
template <int VB>
__device__ __forceinline__ void pv_tile(f32x16* o, int vb0, bf16x8 pa0, bf16x8 pa1, bf16x8 pa2, bf16x8 pa3) {
#define TRRD(dst, off) asm volatile("ds_read_b64_tr_b16 %0, %1 offset:%2" : "=&v"(dst) : "v"(vb0), "i"(off) : "memory")
#define PV_D0(d0) do { s16x4 l0, l1, l2, l3, h0, h1, h2, h3; constexpr int b_ = VB * SHM_V + v_rd_off(d0, 0, 0); \
        TRRD(l0, b_); TRRD(h0, b_ + 2048); TRRD(l1, b_ + 4096); TRRD(h1, b_ + 6144); TRRD(l2, b_ + 8192); TRRD(h2, b_ + 10240); TRRD(l3, b_ + 12288); TRRD(h3, b_ + 14336); \
        asm volatile("s_waitcnt lgkmcnt(0)" ::: "memory"); SBAR();   \
        o[d0] = __builtin_amdgcn_mfma_f32_32x32x16_bf16(pa0, (bf16x8){l0[0], l0[1], l0[2], l0[3], h0[0], h0[1], h0[2], h0[3]}, o[d0], 0, 0, 0);   \
        o[d0] = __builtin_amdgcn_mfma_f32_32x32x16_bf16(pa1, (bf16x8){l1[0], l1[1], l1[2], l1[3], h1[0], h1[1], h1[2], h1[3]}, o[d0], 0, 0, 0);   \
        o[d0] = __builtin_amdgcn_mfma_f32_32x32x16_bf16(pa2, (bf16x8){l2[0], l2[1], l2[2], l2[3], h2[0], h2[1], h2[2], h2[3]}, o[d0], 0, 0, 0);   \
        o[d0] = __builtin_amdgcn_mfma_f32_32x32x16_bf16(pa3, (bf16x8){l3[0], l3[1], l3[2], l3[3], h3[0], h3[1], h3[2], h3[3]}, o[d0], 0, 0, 0); } while (0)
    PV_D0(0); PV_D0(1); PV_D0(2); PV_D0(3);
#undef PV_D0
#undef TRRD
}
struct BlockRef { const bf16_t* Q; const bf16_t* K; const bf16_t* V; int P0; int to_lds; float lam; };
struct Seam { bf16x8 qr[4]; bf16x8 st_v0, st_v1, st_k0; };
#define VMW() asm volatile("s_waitcnt vmcnt(0)" ::: "memory")
#define VMWN(n) asm volatile("s_waitcnt vmcnt(%0)" :: "i"(n) : "memory")
#define SLOAD_H(Kp, Vp, k0) do { S.st_v0 = load8((Vp) + (size_t)((k0) + sr) * PQ + sc); S.st_v1 = load8((Vp) + (size_t)((k0) + 32 + sr) * PQ + sc); \
                                 S.st_k0 = load8((Kp) + (size_t)((k0) + kr) * PQ + kc); } while (0)
#define SWRITE_HK(bf) do { *(bf16x8*)(K_lds + (bf) * SHM_K + kws) = S.st_k0; } while (0)
#define SWRITE_HV(bf) do { *(bf16x8*)(V_lds + (bf) * SHM_V + vst0) = S.st_v0; *(bf16x8*)(V_lds + (bf) * SHM_V + vst1) = S.st_v1; } while (0)
#define SWRITE_H(bf) do { SWRITE_HV(bf); SWRITE_HK(bf); } while (0)
__device__ __forceinline__ void prime(const BlockRef& cur, char* lds, Seam& S, int tid, int wid) {
    const int lane = tid & 63, r32 = lane & 31, hi = lane >> 5;
    const int sr = tid >> 4, sc = (tid & 15) * 8, kr = tid >> 3, kc = (tid & 7) * 8, kws = KSWZ64(kr, kc * 2); char* K_lds = lds + OFF_KL;
#pragma unroll
    for (int d0 = 0; d0 < 4; ++d0) S.qr[d0] = load8(cur.Q + (size_t)(wid * QBLK + r32) * PQ + d0 * 16 + hi * 8);
    SLOAD_H(cur.K, cur.V, 0); VMW(); SWRITE_HK(0);
    __syncthreads();
}
__device__ __forceinline__ void block(const BlockRef& cur, const BlockRef& nxt, char* lds, Seam& S, int tid, int wid) {
    asm volatile("" : "+v"(tid));
    const int lane = tid & 63, r32 = lane & 31, hi = lane >> 5;
    const int NT = (cur.P0 + QB - 1) / KVBLK + 1;
    const int qlo = cur.P0 + wid * QBLK, qm = qlo + r32 - 4 * hi;
    char* V_lds = lds + OFF_VL; char* K_lds = lds + OFF_KL;
    float* ws = (float*)(lds + OFF_WS) + wid * 64; float* li_l = ws, * al_l = ws + 32;
    float m_reg = -1e30f, l_reg = 0; f32x16 o[4] = {};
    const int sr = tid >> 4, sc = (tid & 15) * 8, vst0 = v_st(sr, sc), vst1 = v_st(32 + sr, sc), kr = tid >> 3, kc = (tid & 7) * 8, kws = KSWZ64(kr, kc * 2);
    const int vb0 = (int)(uintptr_t)V_lds + v_rd_base(lane);
    const bf16_t* Kh = cur.K; const bf16_t* Vh = cur.V;
#define RESC(a) do { if (__any((a) < 1.f)) { if (hi == 0) al_l[r32] = (a); asm volatile("s_waitcnt lgkmcnt(0)" ::: "memory");              \
                     _Pragma("unroll") for (int d_ = 0; d_ < 4; ++d_) _Pragma("unroll") for (int r = 0; r < 16; ++r) o[d_][r] *= al_l[crow(r, hi)]; } } while (0)
#define KBASE(t) ((t) * KVBLK)
#define MASKT(P0_, P1_, t) do { const int kb_ = KBASE(t); if (kb_ + KVBLK - 1 > qlo) mask_tile(P0_, P1_, qm - kb_); } while (0)
#define SEAM_K0() do { VMWN(4); SWRITE_HK(0); SBAR(); } while (0)
    f32x16 pA0, pA1, pB0, pB1; float mnA, mnB, alA, alB; bf16x8 pa0, pa1, pa2, pa3;
    SWRITE_HV(0); SBAR();
    if (NT > 1) SLOAD_H(Kh, Vh, KBASE(1));
    SBAR(); qkt<0>(pA0, pA1, K_lds, r32, hi, S.qr);
    MASKT(pA0, pA1, 0); partialSM(pA0, pA1, m_reg, mnA, alA);
    if (NT > 1) { VMW(); SWRITE_H(1); }
    __syncthreads();
#define HALF_STEP(PX0, PX1, mnX, alX, PY0, PY1, alY, t, KB, VB, SB) do {                                                      \
        SBAR(); qkt<KB>(PX0, PX1, K_lds, r32, hi, S.qr);                                                                      \
        finishSM(PY0, PY1, alY, l_reg, pa0, pa1, pa2, pa3); SBAR();                                                           \
        if ((t) + 1 < NT) { SLOAD_H(Kh, Vh, KBASE((t) + 1)); SBAR(); }                                                        \
        pv_tile<VB>(o, vb0, pa0, pa1, pa2, pa3); MASKT(PX0, PX1, (t)); partialSM(PX0, PX1, m_reg, mnX, alX);                 \
        __syncthreads();                                                                                                      \
        if ((t) + 1 < NT) { VMW(); SWRITE_H(SB); }                                                                            \
        RESC(alX); __syncthreads(); } while (0)
    for (int t = 1; t + 1 < NT; t += 2) {
        HALF_STEP(pB0, pB1, mnB, alB, pA0, pA1, alA, t, 1, 0, 0);
        HALF_STEP(pA0, pA1, mnA, alA, pB0, pB1, alB, t + 1, 0, 1, 1);
    }
    const bool even = wid >= 6;
    if (even) { SBAR(); qkt<1>(pB0, pB1, K_lds, r32, hi, S.qr); SBAR(); }
    SLOAD_H(nxt.K, nxt.V, 0); SBAR();
#pragma unroll
    for (int d0 = 0; d0 < 4; ++d0) S.qr[d0] = load8(nxt.Q + (size_t)(wid * QBLK + r32) * PQ + d0 * 16 + hi * 8);
    SBAR();
    finishSM(pA0, pA1, alA, l_reg, pa0, pa1, pa2, pa3); SBAR();
    pv_tile<0>(o, vb0, pa0, pa1, pa2, pa3);
    if (even) { MASKT(pB0, pB1, NT - 1); partialSM(pB0, pB1, m_reg, mnB, alB); __syncthreads(); RESC(alB);
        finishSM(pB0, pB1, alB, l_reg, pa0, pa1, pa2, pa3); SBAR(); pv_tile<1>(o, vb0, pa0, pa1, pa2, pa3); }
    else __syncthreads();
    SBAR(); SEAM_K0();
    if (hi == 0) li_l[r32] = l_reg; asm volatile("s_waitcnt lgkmcnt(0)" ::: "memory");
    float rli[16];
#pragma unroll
    for (int r = 0; r < 16; ++r) rli[r] = __builtin_amdgcn_rcpf(li_l[crow(r, hi)]);
    { char* Ol = lds + OFF_OL + wid * OL_WAVE;
      if (!cur.to_lds) {
#pragma unroll
          for (int d0 = 0; d0 < 4; ++d0)
#pragma unroll
              for (int hq = 0; hq < 2; ++hq) { u32x4 wv_;
#pragma unroll
                  for (int q = 0; q < 4; ++q) { const int r = hq * 8 + q * 2; wv_[q] = cvtpk(o[d0][r] * rli[r], o[d0][r + 1] * rli[r + 1]); }
                  *(u32x4*)(Ol + ((d0 * 2 + hq) * 64 + lane) * 16) = wv_; }
      } else {
          u32x4 o1w[8];
#pragma unroll
          for (int i = 0; i < 8; ++i) o1w[i] = *(const u32x4*)(Ol + (i * 64 + lane) * 16);
          asm volatile("s_waitcnt lgkmcnt(0)" ::: "memory");
#pragma unroll
          for (int r = 0; r < 16; ++r) { const int orow = crow(r, hi);
#pragma unroll
              for (int d0 = 0; d0 < 4; ++d0) { const unsigned w1 = o1w[d0 * 2 + (r >> 3)][(r & 7) >> 1]; const float o1v = (r & 1) ? bfhi(w1) : bflo(w1);
                  const float v = o1v - cur.lam * (o[d0][r] * rli[r]); const float vn = sx<1>(v);
                  if ((r32 & 1) == 0) *(unsigned*)(Ol + orow * OL_RS + (d0 * 32 + r32) * 2) = cvtpk(v, vn); } } } }
    asm volatile("s_waitcnt lgkmcnt(0)\n\ts_barrier" ::: "memory");
#undef RESC
#undef KBASE
#undef MASKT
#undef SEAM_K0
#undef HALF_STEP
}
#undef VMW
#undef VMWN
#undef SLOAD_H
#undef SWRITE_HK
#undef SWRITE_HV
#undef SWRITE_H
#undef SBAR
#undef KSWZ64
}

struct Params {
    const float* x; const float* c; const int* positions; const float* norm1; const float* norm2; const float* w_ada; const float* b_ada;
    const float* a_w_in; const float* a_b_if; const float* a_h_norm; const float* a_w_out;
    const float* b_w_in; const float* b_q_norm; const float* b_k_norm; const float* b_lam_q1; const float* b_lam_k1; const float* b_lam_q2; const float* b_lam_k2;
    const float* b_o_norm; const float* b_w_out; const float* w_router; const float* router_bias; const float* moe_w_gu; const float* moe_w_down;
    float* out; unsigned char* ws;
};
struct Frame { LAS unsigned char* lds; int tid, lane, wave, G, bid, vcu; };
__device__ __forceinline__ Frame make_frame(unsigned char* lds, int wv) {
    Frame F; F.lds = (LAS unsigned char*)lds; int t = wv * 64 + lane_id(); asm volatile("" : "+v"(t)); F.tid = t; F.lane = t & 63; F.wave = wv;
    F.G = gridDim.x; F.bid = blockIdx.x; F.vcu = (F.G % 8 == 0) ? (F.bid % 8) * (F.G / 8) + F.bid / 8 : F.bid; return F;
}

struct WItem { const float* W; unsigned char* WT; float* cs; int ldw, Kr, drow0, n0, mode; float s8; };
constexpr int NW_ITEMS = ((WQ_IN0 == 2) ? 48 : 0) + ((WQ_OUT0 == 2) ? 16 : 0) + ((WQ_OUT1 == 2) ? 16 : 0);
__device__ __forceinline__ WItem decode_witem(int it, const Params& p) {
    float* cw = (float*)(p.ws + SC_CW);
    if (WQ_IN0 == 2) { if (it < 48) { const int nb = it; return WItem{p.a_w_in, p.ws + WS_WAIN, cw + CW_AIN, 3080, 1024, 64 * nb, 64 * nb, 2, 0.f}; } it -= 48; }
    if (WQ_OUT0 == 2) { if (it < 16) { const int nb = it; return WItem{p.a_w_out, p.ws + WS_WAOUT, cw + CW_AOUT, 1024, 1024, 64 * nb, 64 * nb, 2, 0.f}; } it -= 16; }
    { const int nb = it; return WItem{p.b_w_out, p.ws + WS_WBOUT, cw + CW_BOUT, 1024, 1024, 64 * nb, 64 * nb, 2, 0.f}; }
}
__device__ __forceinline__ int witem_owner(int it, int G) { return (G == 256) ? 192 + (it & 63) : it % G; }
struct TItem { const float* W; bf16_t* WT; int ldw, K, drow0, k0, n0; float s8; };
__device__ __forceinline__ TItem decode_item(int it, const Params& p) {
    constexpr int I0 = (WQ_IN0 == 2) ? 0 : 16 * 48, I1 = (WQ_OUT0 == 2) ? 0 : 16 * 16, I2 = 16 * 48, I3 = (WQ_OUT1 == 2) ? 0 : 16 * 16, I4 = 32 * 256;
    TItem t; int r = it;
    if (r < I0) { const int kb = r / 48, nb = r % 48; t = (WQ_IN0 == 1) ? TItem{p.a_w_in, (bf16_t*)(p.ws + WS_WAIN), 3080, 1024, 64 * nb, 64 * kb, 64 * nb, S8_WIN} : TItem{p.a_w_in, (bf16_t*)(p.ws + WS_WAIN_BF), 3080, 1024, 64 * nb, 64 * kb, 64 * nb, 0.f}; return t; } r -= I0;
    if (r < I1) { const int kb = r / 16, nb = r % 16; t = (WQ_OUT0 == 1) ? TItem{p.a_w_out, (bf16_t*)(p.ws + WS_WAOUT), 1024, 1024, 64 * nb, 64 * kb, 64 * nb, S8_WOUT} : TItem{p.a_w_out, (bf16_t*)(p.ws + WS_WAOUT_BF), 1024, 1024, 64 * nb, 64 * kb, 64 * nb, 0.f}; return t; } r -= I1;
    if (r < I2) { const int kb = r / 48, nb = r % 48; t = TItem{p.b_w_in, (bf16_t*)(p.ws + WS_WBIN), 3072, 1024, 64 * nb, 64 * kb, 64 * nb, S8_WIN}; return t; } r -= I2;
    if (r < I3) { const int kb = r / 16, nb = r % 16; t = OUTPROJ_FP8 ? TItem{p.b_w_out, (bf16_t*)(p.ws + WS_WBOUT), 1024, 1024, 64 * nb, 64 * kb, 64 * nb, S8_WOUT} : TItem{p.b_w_out, (bf16_t*)(p.ws + WS_WBOUT_BF), 1024, 1024, 64 * nb, 64 * kb, 64 * nb, 0.f}; return t; } r -= I3;
    if (r < I4) { const int mi = r / 256, q = r % 256, kb = q / 16, nb = q % 16; const int n0 = 64 * nb;
        const int drow = ((n0 & 511) >> 7) * 256 + (n0 >> 9) * 128 + (n0 & 127);
        t = TItem{p.moe_w_gu + (size_t)mi * 1024 * 1024, (bf16_t*)(p.ws + WS_WGU + (size_t)mi * 1024 * 1024), 1024, 1024, drow, 64 * kb, n0, S8_WGU}; return t; } r -= I4;
    { const int mi = r / 128, q = r % 128, kb = q / 16, nb = q % 16;
      t = TItem{p.moe_w_down + (size_t)mi * 512 * 1024, (bf16_t*)(p.ws + WS_WDN + (size_t)mi * 1024 * 512), 1024, 512, 64 * nb, 64 * kb, 64 * nb, S8_WDN}; return t; }
}
__device__ __forceinline__ void phase_mod(unsigned char* lds_, int wv, const Params& p) {
    const Frame F = make_frame(lds_, wv);
    LAS float* cact = (LAS float*)F.lds;
    LAS float* red = (LAS float*)(F.lds + 65536);
    float* mod = (float*)(p.ws + WS_MOD);
    for (int i = F.tid; i < NB * DM; i += NTHREADS) { const int b = i >> 10, k = i & 1023; const float v = p.c[i]; cact[k * 16 + b] = v / (1.0f + expf(-v)); }
    __syncthreads();
    for (int task = F.bid; task < 192; task += F.G) {
        const int l = task / 96, cb = task % 96;
        const float* W = p.w_ada + (size_t)l * DM * 6144 + cb * 64 + F.lane;
        float acc[16];
#pragma unroll
        for (int b = 0; b < 16; ++b) acc[b] = 0.f;
        const int kbeg = F.wave * 128;
        for (int kb = kbeg; kb < kbeg + 128; kb += 16) {
            float wv[16];
#pragma unroll
            for (int u = 0; u < 16; ++u) wv[u] = __builtin_nontemporal_load(W + (size_t)(kb + u) * 6144);
#pragma unroll
            for (int u = 0; u < 16; ++u) {
                const LAS f32x4* cc = (const LAS f32x4*)(cact + (kb + u) * 16);
                const f32x4 c0 = cc[0], c1 = cc[1], c2 = cc[2], c3 = cc[3]; const float w = wv[u];
                acc[0] += c0[0] * w; acc[1] += c0[1] * w; acc[2] += c0[2] * w; acc[3] += c0[3] * w;
                acc[4] += c1[0] * w; acc[5] += c1[1] * w; acc[6] += c1[2] * w; acc[7] += c1[3] * w;
                acc[8] += c2[0] * w; acc[9] += c2[1] * w; acc[10] += c2[2] * w; acc[11] += c2[3] * w;
                acc[12] += c3[0] * w; acc[13] += c3[1] * w; acc[14] += c3[2] * w; acc[15] += c3[3] * w;
            }
        }
#pragma unroll
        for (int b = 0; b < 16; ++b) red[(F.wave * 16 + b) * 64 + F.lane] = acc[b];
        __syncthreads();
        for (int o = F.tid; o < 1024; o += NTHREADS) { const int b = o >> 6, cl = o & 63; float s = 0.f;
#pragma unroll
            for (int w = 0; w < 8; ++w) s += red[(w * 16 + b) * 64 + cl];
            mod[((size_t)l * 16 + b) * 6144 + cb * 64 + cl] = s + p.b_ada[(size_t)l * 6144 + cb * 64 + cl]; }
        asm volatile("s_waitcnt vmcnt(0)" ::: "memory");
        __syncthreads();
        if (F.tid == 0) { __builtin_amdgcn_fence(__ATOMIC_RELEASE, "agent"); asm volatile("s_waitcnt vmcnt(0)" ::: "memory"); (void)xb_add((unsigned*)p.ws + CW_MODCNT, 1u); }
    }
}
__device__ __forceinline__ void phase_wconv(unsigned char* lds_, int wv, const Params& p) {
    const Frame F = make_frame(lds_, wv);
    LAS float* scr = (LAS float*)(F.lds + F.wave * 17408);
    LAS float* cmaxw = (LAS float*)(F.lds + 8 * 17408);
    const int lane = F.lane, lr = lane >> 4, c4 = (lane & 15) * 4, w = F.wave;
    for (int it = 0; it < NW_ITEMS; ++it) {
        if (witem_owner(it, F.G) != F.bid) continue;
        const WItem t = decode_witem(it, p);
        const int RW = t.Kr >> 3, NH = RW >> 6;
        f32x4 v[2][16];
#pragma unroll
        for (int hf = 0; hf < 2; ++hf) if (hf < NH) {
#pragma unroll
            for (int i = 0; i < 16; ++i) v[hf][i] = __builtin_nontemporal_load((const f32x4*)(t.W + (size_t)(w * RW + hf * 64 + 4 * i + lr) * t.ldw + t.n0 + c4)); }
        __syncthreads();
        float qs = t.s8;
        if (t.mode == 2) {
            float mx[4] = {0.f, 0.f, 0.f, 0.f};
#pragma unroll
            for (int hf = 0; hf < 2; ++hf) if (hf < NH) {
#pragma unroll
                for (int i = 0; i < 16; ++i)
#pragma unroll
                    for (int q = 0; q < 4; ++q) mx[q] = fmaxf(mx[q], fabsf(v[hf][i][q])); }
#pragma unroll
            for (int q = 0; q < 4; ++q) { mx[q] = fmaxf(mx[q], sx<16>(mx[q])); auto rr = __builtin_amdgcn_permlane32_swap(__float_as_uint(mx[q]), __float_as_uint(mx[q]), false, false); mx[q] = fmaxf(__uint_as_float(rr[0]), __uint_as_float(rr[1])); }
            if (lr == 0) *(LAS f32x4*)(cmaxw + w * 64 + c4) = (f32x4){mx[0], mx[1], mx[2], mx[3]};
            __syncthreads();
            float cm = 0.f;
#pragma unroll
            for (int ww = 0; ww < 8; ++ww) cm = fmaxf(cm, cmaxw[ww * 64 + lane]);
            qs = cm > 0.f ? 127.0f / cm : 0.f;
            if (w == 0) t.cs[t.drow0 + lane] = cm * (1.0f / 127.0f);
        }
#pragma unroll
        for (int hf = 0; hf < 2; ++hf) if (hf < NH) {
#pragma unroll
            for (int i = 0; i < 16; ++i) *(LAS f32x4*)(scr + (4 * i + lr) * 68 + c4) = v[hf][i];
            const int k0 = w * RW + hf * 64;
            if (t.mode == 0) { bf16_t* orow = (bf16_t*)t.WT + (size_t)(t.drow0 + lane) * t.Kr + k0;
#pragma unroll
                for (int c = 0; c < 8; ++c) { float f[8];
#pragma unroll
                    for (int q = 0; q < 8; ++q) f[q] = scr[(8 * c + q) * 68 + lane];
                    u32x4 o; o.x = cvtpk(f[0], f[1]); o.y = cvtpk(f[2], f[3]); o.z = cvtpk(f[4], f[5]); o.w = cvtpk(f[6], f[7]);
                    *(u32x4*)(orow + 8 * c) = o; } }
            else { unsigned char* orow8 = t.WT + (size_t)(t.drow0 + lane) * t.Kr + k0;
#pragma unroll
                for (int c = 0; c < 4; ++c) { float f[16];
#pragma unroll
                    for (int q = 0; q < 16; ++q) f[q] = scr[(16 * c + q) * 68 + lane] * qs;
                    u32x4 o;
                    if (t.mode == 1) { o.x = cvt4_fp8(f[0], f[1], f[2], f[3]); o.y = cvt4_fp8(f[4], f[5], f[6], f[7]); o.z = cvt4_fp8(f[8], f[9], f[10], f[11]); o.w = cvt4_fp8(f[12], f[13], f[14], f[15]); }
                    else { o.x = pack4_i8(f[0], f[1], f[2], f[3]); o.y = pack4_i8(f[4], f[5], f[6], f[7]); o.z = pack4_i8(f[8], f[9], f[10], f[11]); o.w = pack4_i8(f[12], f[13], f[14], f[15]); }
                    *(u32x4*)(orow8 + 16 * c) = o; } }
            asm volatile("s_waitcnt lgkmcnt(0)" ::: "memory");
        }
    }
}

__device__ __forceinline__ void phase_wconv_pw(unsigned char* lds_, int wv, const Params& p) {
    const Frame F = make_frame(lds_, wv);
    LAS float* scr = (LAS float*)(F.lds + F.wave * 17408);
    const int gw = F.vcu * NWAVES + F.wave, NGW = F.G * NWAVES;
    constexpr int NITEMS = ((WQ_IN0 == 2) ? 0 : 16 * 48) + ((WQ_OUT0 == 2) ? 0 : 16 * 16) + 16 * 48 + ((WQ_OUT1 == 2) ? 0 : 16 * 16) + 32 * 256 + 32 * 128;
    const int lane = F.lane, lr = lane >> 4, c4 = (lane & 15) * 4;
    f32x4 v[16];
    int it = gw;
    if (it < NITEMS) { const TItem t = decode_item(it, p);
#pragma unroll
        for (int i = 0; i < 16; ++i) v[i] = __builtin_nontemporal_load((const f32x4*)(t.W + (size_t)(t.k0 + 4 * i + lr) * t.ldw + t.n0 + c4)); }
    for (; it < NITEMS; it += NGW) {
        const TItem t = decode_item(it, p);
#pragma unroll
        for (int i = 0; i < 16; ++i) *(LAS f32x4*)(scr + (4 * i + lr) * 68 + c4) = v[i];
        const int itn = it + NGW;
        if (itn < NITEMS) { const TItem tn = decode_item(itn, p);
#pragma unroll
            for (int i = 0; i < 16; ++i) v[i] = __builtin_nontemporal_load((const f32x4*)(tn.W + (size_t)(tn.k0 + 4 * i + lr) * tn.ldw + tn.n0 + c4)); }
        if (t.s8 > 0.f) {
            unsigned char* orow8 = (unsigned char*)t.WT + (size_t)(t.drow0 + lane) * t.K + t.k0;
#pragma unroll
            for (int c = 0; c < 4; ++c) { float f[16];
#pragma unroll
                for (int q = 0; q < 16; ++q) f[q] = scr[(16 * c + q) * 68 + lane] * t.s8;
                u32x4 o; o.x = cvt4_fp8(f[0], f[1], f[2], f[3]); o.y = cvt4_fp8(f[4], f[5], f[6], f[7]); o.z = cvt4_fp8(f[8], f[9], f[10], f[11]); o.w = cvt4_fp8(f[12], f[13], f[14], f[15]);
                *(u32x4*)(orow8 + 16 * c) = o; }
        } else {
            bf16_t* orow = t.WT + (size_t)(t.drow0 + lane) * t.K + t.k0;
#pragma unroll
            for (int c = 0; c < 8; ++c) { float f[8];
#pragma unroll
                for (int q = 0; q < 8; ++q) f[q] = scr[(8 * c + q) * 68 + lane];
                u32x4 o; o.x = cvtpk(f[0], f[1]); o.y = cvtpk(f[2], f[3]); o.z = cvtpk(f[4], f[5]); o.w = cvtpk(f[6], f[7]);
                *(u32x4*)(orow + 8 * c) = o; }
        }
    }
}

struct RowConst { f32x4 a[4], b[4]; };
__device__ __forceinline__ RowConst load_rowconst(const float* norm, const float* modb, int sh_off, int sc_off, int lane) {
    RowConst rc;
#pragma unroll
    for (int j = 0; j < 4; ++j) { const int c = 256 * j + 4 * lane;
        const f32x4 nv = *(const f32x4*)(norm + c), sc = *(const f32x4*)(modb + sc_off + c); rc.b[j] = *(const f32x4*)(modb + sh_off + c);
        rc.a[j] = nv * (sc + 1.0f); }
    return rc;
}
__device__ __forceinline__ void row_norm_store(const f32x4 (&v)[4], const RowConst& rc, f32x4 (&h)[4], bf16_t* hrow, int lane) {
    float ss = 0.f;
#pragma unroll
    for (int j = 0; j < 4; ++j) ss += (v[j][0] * v[j][0] + v[j][1] * v[j][1]) + (v[j][2] * v[j][2] + v[j][3] * v[j][3]);
    const float r = __builtin_amdgcn_rsqf(wave_sum(ss) * (1.0f / DM) + EPS);
#pragma unroll
    for (int j = 0; j < 4; ++j) { h[j] = v[j] * r * rc.a[j] + rc.b[j];
        u32x2 w; w.x = cvtpk(h[j][0], h[j][1]); w.y = cvtpk(h[j][2], h[j][3]); *(u32x2*)(hrow + 256 * j + 4 * lane) = w; }
}


__device__ __forceinline__ float reduce16(const float (&v)[16], int lane) {
    float a[8], b[4], c[2];
    const bool b5 = (lane & 32) != 0, b4 = (lane & 16) != 0, b3 = (lane & 8) != 0, b2 = (lane & 4) != 0;
#pragma unroll
    for (int i = 0; i < 8; ++i) { const float send = b5 ? v[i] : v[8 + i], keep = b5 ? v[8 + i] : v[i]; a[i] = keep + sx32(send, b5); }
#pragma unroll
    for (int i = 0; i < 4; ++i) { const float send = b4 ? a[i] : a[4 + i], keep = b4 ? a[4 + i] : a[i]; b[i] = keep + sx<16>(send); }
#pragma unroll
    for (int i = 0; i < 2; ++i) { const float send = b3 ? b[i] : b[2 + i], keep = b3 ? b[2 + i] : b[i]; c[i] = keep + sx<8>(send); }
    const float send = b2 ? c[0] : c[1], keep = b2 ? c[1] : c[0];
    float d = keep + sx<4>(send);
    d += sx<1>(d); d += sx<2>(d);
    return d;
}
__device__ __forceinline__ float reduce8(const float (&v)[8], int lane) {
    float b[4], c[2];
    const bool b5 = (lane & 32) != 0, b4 = (lane & 16) != 0, b3 = (lane & 8) != 0;
#pragma unroll
    for (int i = 0; i < 4; ++i) { const float send = b5 ? v[i] : v[4 + i], keep = b5 ? v[4 + i] : v[i]; b[i] = keep + sx32(send, b5); }
#pragma unroll
    for (int i = 0; i < 2; ++i) { const float send = b4 ? b[i] : b[2 + i], keep = b4 ? b[2 + i] : b[i]; c[i] = keep + sx<16>(send); }
    const float send = b3 ? c[0] : c[1], keep = b3 ? c[1] : c[0];
    float d = keep + sx<8>(send);
    d += sx<1>(d); d += sx<2>(d); d += sx<4>(d);
    return d;
}

__device__ __forceinline__ void row_norm_store8(const f32x4 (&v)[4], const RowConst& rc, f32x4 (&h)[4], unsigned char* hrow, int lane) {
    float ss = 0.f;
#pragma unroll
    for (int j = 0; j < 4; ++j) ss += (v[j][0] * v[j][0] + v[j][1] * v[j][1]) + (v[j][2] * v[j][2] + v[j][3] * v[j][3]);
    const float r = __builtin_amdgcn_rsqf(wave_sum(ss) * (1.0f / DM) + EPS);
#pragma unroll
    for (int j = 0; j < 4; ++j) { h[j] = v[j] * r * rc.a[j] + rc.b[j];
        *(unsigned*)(hrow + 256 * j + 4 * lane) = cvt4_fp8(h[j][0] * S8_H, h[j][1] * S8_H, h[j][2] * S8_H, h[j][3] * S8_H); }
}
__device__ __forceinline__ void row_norm_store_i8(const f32x4 (&v)[4], const RowConst& rc, f32x4 (&h)[4], unsigned char* hrow, float* rs_out, int lane) {
    float ss = 0.f;
#pragma unroll
    for (int j = 0; j < 4; ++j) ss += (v[j][0] * v[j][0] + v[j][1] * v[j][1]) + (v[j][2] * v[j][2] + v[j][3] * v[j][3]);
    const float r = __builtin_amdgcn_rsqf(wave_sum(ss) * (1.0f / DM) + EPS);
    float mx = 0.f;
#pragma unroll
    for (int j = 0; j < 4; ++j) { h[j] = v[j] * r * rc.a[j] + rc.b[j]; mx = fmaxf(fmaxf(mx, fmaxf(fabsf(h[j][0]), fabsf(h[j][1]))), fmaxf(fabsf(h[j][2]), fabsf(h[j][3]))); }
    mx = fmaxf(wave_max(mx), 1e-20f);
    const float qs = 127.0f * __builtin_amdgcn_rcpf(mx);
#pragma unroll
    for (int j = 0; j < 4; ++j) *(unsigned*)(hrow + 256 * j + 4 * lane) = pack4_i8(h[j][0] * qs, h[j][1] * qs, h[j][2] * qs, h[j][3] * qs);
    if (lane == 0) *rs_out = mx * (1.0f / 127.0f);
}
__device__ __forceinline__ void phase_hprep0(unsigned char* lds_, int wv, const Params& p) {
    const Frame F = make_frame(lds_, wv);
    LAS f32x4* Wg = (LAS f32x4*)F.lds;
    for (int idx = F.tid; idx < 2048; idx += NTHREADS) { const int ln = idx & 63, half = (idx >> 6) & 1, i = (idx >> 7) & 3, j = idx >> 9; const int c = 256 * j + 4 * ln + i;
        Wg[idx] = *(const f32x4*)(p.a_w_in + (size_t)c * 3080 + 3072 + half * 4); }
    __syncthreads();
    const float* mod = (const float*)(p.ws + WS_MOD);
    unsigned char* H = p.ws + WS_H; float* gates = (float*)(p.ws + WS_GATES);
    const float bif = p.a_b_if[F.lane & 7];
    float* cst = (float*)(p.ws + WS_CS);
    const float invf_tab[8] = {1.0f, 0.19391788f, 0.037604144f, 0.0072920943f, 0.0014140673f, 0.00027421273f, 5.3174683e-05f, 1.0311522e-05f};
    float invf = 0.f;
#pragma unroll
    for (int i = 0; i < 8; ++i) if ((F.lane & 7) == i) invf = invf_tab[i];
    for (int chunk = F.bid; chunk < 256; chunk += F.G) {
        const int row0 = chunk * 128 + F.wave * 16; const int b = row0 / SEQ;
        const RowConst rc = load_rowconst(p.norm1, mod + (size_t)b * 6144, 0, 1024, F.lane);
        for (int rb = 0; rb < 16; rb += 4) {
            f32x4 v[4][4];
#pragma unroll
            for (int rr = 0; rr < 4; ++rr)
#pragma unroll
                for (int j = 0; j < 4; ++j) v[rr][j] = __builtin_nontemporal_load((const f32x4*)(p.x + (size_t)(row0 + rb + rr) * DM + 256 * j + 4 * F.lane));
            f32x4 h[4][4];
#pragma unroll
            for (int rr = 0; rr < 4; ++rr) { const size_t row_ = (size_t)(row0 + rb + rr);
                if (WQ_IN0 == 2) row_norm_store_i8(v[rr], rc, h[rr], H + row_ * DM, (float*)(p.ws + SC_RS_H) + row_, F.lane);
                else if (WQ_IN0 == 1) row_norm_store8(v[rr], rc, h[rr], H + row_ * DM, F.lane);
                else row_norm_store(v[rr], rc, h[rr], (bf16_t*)H + row_ * DM, F.lane); }
            float g[4][8];
#pragma unroll
            for (int rr = 0; rr < 4; ++rr)
#pragma unroll
                for (int q = 0; q < 8; ++q) g[rr][q] = 0.f;
#pragma unroll
            for (int j = 0; j < 4; ++j)
#pragma unroll
                for (int i = 0; i < 4; ++i) { if (i == 0 || i == 2) asm volatile("" ::: "memory");
                    const f32x4 w0 = Wg[((j * 4 + i) * 2 + 0) * 64 + F.lane], w1 = Wg[((j * 4 + i) * 2 + 1) * 64 + F.lane];
#pragma unroll
                    for (int rr = 0; rr < 4; ++rr) { const float hv = h[rr][j][i];
                        g[rr][0] += hv * w0[0]; g[rr][1] += hv * w0[1]; g[rr][2] += hv * w0[2]; g[rr][3] += hv * w0[3]; g[rr][4] += hv * w1[0]; g[rr][5] += hv * w1[1]; g[rr][6] += hv * w1[2]; g[rr][7] += hv * w1[3]; } }
#pragma unroll
            for (int rr = 0; rr < 4; ++rr) { const int row = row0 + rb + rr;
                const float d = reduce8(g[rr], F.lane);
                const float mine = bperm(d, 8 * (F.lane & 7));
                if (F.lane < 16) { const float ang = (float)p.positions[row] * invf; const double rev = (double)ang * 0.15915494309189535; const float frc = (float)(rev - rint(rev));
                    cst[(size_t)row * 16 + F.lane] = (F.lane < 8) ? __builtin_amdgcn_cosf(frc) : __builtin_amdgcn_sinf(frc); }
                if (F.lane < 8) { float val = mine + bif;
                    if (F.lane >= 4) { const float e_ = __expf(-fabsf(val)), u_ = 1.0f + e_;
                        const float l1p = (u_ == 1.0f) ? e_ : __logf(u_) * e_ * __builtin_amdgcn_rcpf(u_ - 1.0f); val = fminf(val, 0.f) - l1p; }
                    gates[(size_t)row * 8 + F.lane] = val; }
            }
        }
    }
}

namespace mls {
constexpr int RSK = 272, RSV = 176, RSP = 272, RSC = 272;
constexpr int OFF_K = 0, OFF_V = 34816, OFF_P = OFF_V + 22528, OFF_C = OFF_P + 34816, OFF_G = OFF_C + 21760;
typedef short v4i16_t __attribute__((ext_vector_type(4)));
__device__ __forceinline__ bf16x8 tr2(const LAS unsigned char* base, int row, int col, int rs, int lane) {
    const int i = lane & 15, g = lane >> 4;
    const LAS unsigned char* p0 = base + (row + 8 * g + (i >> 2)) * rs + (col + 4 * (i & 3)) * 2;
    const s16x4 lo = __builtin_bit_cast(s16x4, __builtin_amdgcn_ds_read_tr16_b64_v4i16((LAS v4i16_t*)p0));
    const s16x4 hi = __builtin_bit_cast(s16x4, __builtin_amdgcn_ds_read_tr16_b64_v4i16((LAS v4i16_t*)(p0 + 4 * rs)));
    return (bf16x8){lo[0], lo[1], lo[2], lo[3], hi[0], hi[1], hi[2], hi[3]};
}
}
__device__ __forceinline__ void phase_mlstm(unsigned char* lds_, int wv, const Params& p) {
    const Frame F = make_frame(lds_, wv);
    using namespace mls;
    const bf16_t* PR = (const bf16_t*)(p.ws + WS_PROJ); const float* gates = (const float*)(p.ws + WS_GATES); bf16_t* HO = (bf16_t*)(p.ws + WS_HOUT);
    LAS unsigned char* Ks = F.lds + OFF_K; LAS unsigned char* Vs = F.lds + OFF_V; LAS unsigned char* Ps = F.lds + OFF_P; LAS unsigned char* Cs = F.lds + OFF_C;
    LAS float* gbase = (LAS float*)(F.lds + OFF_G);
    const int w = F.wave, lane = F.lane, c = lane & 15, g = lane >> 4, tid = F.tid;
    for (int item = F.vcu; item < 256; item += F.G) {
        const int bh = item >> 2, sl = item & 3, b = bh >> 2, h = bh & 3;
        const size_t tok0 = (size_t)b * SEQ;
        const bf16_t* Qg = PR + h * 128; const bf16_t* Kg = PR + 512 + h * 128; const bf16_t* Vg = PR + 1024 + h * 256 + sl * 64;
        __syncthreads();
        if (tid < 256) { const int row = tid >> 1, part = tid & 1; u32x4 z = {0u, 0u, 0u, 0u}; if (part == 0) z.x = 0x3F80u; *(LAS u32x4*)(Vs + row * RSV + 128 + part * 16) = z; }
        f32x4 cacc[5];
#pragma unroll
        for (int vt = 0; vt < 5; ++vt) cacc[vt] = (f32x4){0.f, 0.f, 0.f, 0.f};
        for (int i = tid; i < 80 * RSC / 16; i += NTHREADS) *(LAS u32x4*)(Cs + i * 16) = (u32x4){0u, 0u, 0u, 0u};
        float m_prev = 0.f;
        u32x4 kst[4], vst[2]; bf16x8 qf[4], qn[4]; float glf0 = 0.f, glf1 = 0.f, gi0 = 0.f, gi1 = 0.f;
        auto load_chunk = [&](int ch) {
            const size_t t0 = tok0 + (size_t)ch * 128;
#pragma unroll
            for (int k = 0; k < 4; ++k) { const int pc = tid + 512 * k, row = pc >> 4, c16 = pc & 15; kst[k] = *(const u32x4*)(Kg + (t0 + row) * 3072 + c16 * 8); }
#pragma unroll
            for (int k = 0; k < 2; ++k) { const int pc = tid + 512 * k, row = pc >> 3, c16 = pc & 7; vst[k] = *(const u32x4*)(Vg + (t0 + row) * 3072 + c16 * 8); }
#pragma unroll
            for (int ks = 0; ks < 4; ++ks) qn[ks] = *(const bf16x8*)(Qg + (t0 + 16 * w + c) * 3072 + 32 * ks + 8 * g);
            if (w == 0) { const float* gp = gates + (t0 + 2 * lane) * 8; gi0 = gp[h]; glf0 = gp[4 + h]; gi1 = gp[8 + h]; glf1 = gp[12 + h]; }
        };
        auto gate_scan = [&](LAS float* gs) {
            LAS float* gu = gs; LAS float* gwv = gs + 128; LAS float* gin = gs + 256; LAS float* gfl = gs + 384; LAS float* gwg = gs + 512;
            float s = glf0 + glf1;
#pragma unroll
            for (int d = 1; d < 64; d <<= 1) { const float t = bperm(s, (lane - d) & 63); if (lane >= d) s += t; }
            const float b1 = s, b0 = s - glf1;
            const float u0 = gi0 - b0, u1 = gi1 - b1;
            float m = fmaxf(u0, u1);
#pragma unroll
            for (int d = 1; d < 64; d <<= 1) { const float t = bperm(m, (lane - d) & 63); if (lane >= d) m = fmaxf(m, t); }
            float ex = bperm(m, (lane - 1) & 63); if (lane == 0) ex = -INFINITY;
            const float wv0 = fmaxf(fmaxf(ex, u0), m_prev), wv1 = fmaxf(m, m_prev);
            const float wlast = rdlane(wv1, 63), blast = rdlane(b1, 63);
            gu[2 * lane] = u0; gu[2 * lane + 1] = u1; gwv[2 * lane] = wv0; gwv[2 * lane + 1] = wv1;
            gin[2 * lane] = __expf(m_prev - wv0); gin[2 * lane + 1] = __expf(m_prev - wv1);
            gfl[2 * lane] = __expf(-(b0 + wv0)); gfl[2 * lane + 1] = __expf(-(b1 + wv1));
            gwg[2 * lane] = __expf(u0 - wlast); gwg[2 * lane + 1] = __expf(u1 - wlast);
            m_prev = blast + wlast;
        };
        auto store_chunk = [&]() {
#pragma unroll
            for (int k = 0; k < 4; ++k) { const int pc = tid + 512 * k, row = pc >> 4, c16 = pc & 15; *(LAS u32x4*)(Ks + row * RSK + c16 * 16) = kst[k]; }
#pragma unroll
            for (int k = 0; k < 2; ++k) { const int pc = tid + 512 * k, row = pc >> 3, c16 = pc & 7; *(LAS u32x4*)(Vs + row * RSV + c16 * 16) = vst[k]; }
#pragma unroll
            for (int ks = 0; ks < 4; ++ks) qf[ks] = qn[ks];
        };
        load_chunk(0);
        store_chunk();
        if (w == 0) gate_scan(gbase);
        __syncthreads();
        for (int ch = 0; ch < 16; ++ch) {
            LAS float* gs = gbase + (ch & 1) * 640;
            LAS float* gu = gs; LAS float* gwv = gs + 128; LAS float* gin = gs + 256; LAS float* gfl = gs + 384; LAS float* gwg = gs + 512;
            if (ch < 15) load_chunk(ch + 1);
            {
                const int t = 16 * w + c; const float wt = gwv[t];
#pragma unroll
                for (int jp = 0; jp < 4; ++jp) {
                    if (2 * jp <= w) {
                        f32x4 sa0 = (f32x4){0.f, 0.f, 0.f, 0.f}, sa1 = sa0;
#pragma unroll
                        for (int ks = 0; ks < 4; ++ks) { const bf16x8 kf0 = *(const LAS bf16x8*)(Ks + (32 * jp + c) * RSK + (32 * ks + 8 * g) * 2), kf1 = *(const LAS bf16x8*)(Ks + (32 * jp + 16 + c) * RSK + (32 * ks + 8 * g) * 2);
                            sa0 = __builtin_amdgcn_mfma_f32_16x16x32_bf16(kf0, qf[ks], sa0, 0, 0, 0); sa1 = __builtin_amdgcn_mfma_f32_16x16x32_bf16(kf1, qf[ks], sa1, 0, 0, 0); }
                        const f32x4 uv0 = *(const LAS f32x4*)(gu + 32 * jp + 4 * g), uv1 = *(const LAS f32x4*)(gu + 32 * jp + 16 + 4 * g);
                        float p0_[4], p1_[4];
#pragma unroll
                        for (int r = 0; r < 4; ++r) { const int s0 = 32 * jp + 4 * g + r, s1 = s0 + 16;
                            const float e0 = __expf(uv0[r] - wt), e1 = __expf(uv1[r] - wt); p0_[r] = (s0 <= t) ? sa0[r] * e0 : 0.f; p1_[r] = (s1 <= t) ? sa1[r] * e1 : 0.f; }
                        u32x2 pk0, pk1; pk0.x = cvtpk(p0_[0], p0_[1]); pk0.y = cvtpk(p0_[2], p0_[3]); pk1.x = cvtpk(p1_[0], p1_[1]); pk1.y = cvtpk(p1_[2], p1_[3]);
                        *(LAS u32x2*)(Ps + t * RSP + (32 * jp + 4 * g) * 2) = pk0; *(LAS u32x2*)(Ps + t * RSP + (32 * jp + 16 + 4 * g) * 2) = pk1;
                    }
                }
            }
            f32x4 nacc[5];
#pragma unroll
            for (int vt = 0; vt < 5; ++vt) { nacc[vt] = (f32x4){0.f, 0.f, 0.f, 0.f};
#pragma unroll
                for (int ks = 0; ks < 4; ++ks) { const bf16x8 cf = *(const LAS bf16x8*)(Cs + (16 * vt + c) * RSC + (32 * ks + 8 * g) * 2); nacc[vt] = __builtin_amdgcn_mfma_f32_16x16x32_bf16(cf, qf[ks], nacc[vt], 0, 0, 0); } }
            { const float iv = gin[16 * w + c];
#pragma unroll
              for (int vt = 0; vt < 5; ++vt) nacc[vt] = nacc[vt] * iv; }
            if (w == 0 && ch < 15) gate_scan(gbase + ((ch + 1) & 1) * 640);
            for (int ks = 0; ks <= (w >> 1); ++ks) {
                const bf16x8 pf = *(const LAS bf16x8*)(Ps + (16 * w + c) * RSP + (32 * ks + 8 * g) * 2);
#pragma unroll
                for (int vt = 0; vt < 5; ++vt) { const bf16x8 vf = tr2(Vs, 32 * ks, 16 * vt, RSV, lane); nacc[vt] = __builtin_amdgcn_mfma_f32_16x16x32_bf16(vf, pf, nacc[vt], 0, 0, 0); }
            }
            { const float den = bperm(nacc[4][0], lane & 15); const float inv = 1.0f / fmaxf(fabsf(den), gfl[16 * w + c]);
              bf16_t* orow = HO + (tok0 + (size_t)ch * 128 + 16 * w + c) * DM + h * 256 + sl * 64 + 4 * g;
#pragma unroll
              for (int vt = 0; vt < 4; ++vt) { u32x2 pk; pk.x = cvtpk(nacc[vt][0] * inv, nacc[vt][1] * inv); pk.y = cvtpk(nacc[vt][2] * inv, nacc[vt][3] * inv); *(u32x2*)(orow + 16 * vt) = pk; } }
            { const float decay = gin[127];
#pragma unroll
              for (int vt = 0; vt < 5; ++vt) cacc[vt] = cacc[vt] * decay;
#pragma unroll
              for (int ks = 0; ks < 4; ++ks) {
                  bf16x8 kf = tr2(Ks, 32 * ks, 16 * w, RSK, lane);
                  const f32x4 w0 = *(const LAS f32x4*)(gwg + 32 * ks + 8 * g), w1 = *(const LAS f32x4*)(gwg + 32 * ks + 8 * g + 4);
                  u32x4 kw = __builtin_bit_cast(u32x4, kf);
                  kw.x = cvtpk(bflo(kw.x) * w0[0], bfhi(kw.x) * w0[1]); kw.y = cvtpk(bflo(kw.y) * w0[2], bfhi(kw.y) * w0[3]);
                  kw.z = cvtpk(bflo(kw.z) * w1[0], bfhi(kw.z) * w1[1]); kw.w = cvtpk(bflo(kw.w) * w1[2], bfhi(kw.w) * w1[3]);
                  kf = __builtin_bit_cast(bf16x8, kw);
#pragma unroll
                  for (int vt = 0; vt < 5; ++vt) { const bf16x8 vf = tr2(Vs, 32 * ks, 16 * vt, RSV, lane); cacc[vt] = __builtin_amdgcn_mfma_f32_16x16x32_bf16(kf, vf, cacc[vt], 0, 0, 0); }
              } }
            asm volatile("s_waitcnt lgkmcnt(0)\n\ts_barrier" ::: "memory");
#pragma unroll
            for (int vt = 0; vt < 5; ++vt) { u32x2 pk; pk.x = cvtpk(cacc[vt][0], cacc[vt][1]); pk.y = cvtpk(cacc[vt][2], cacc[vt][3]); *(LAS u32x2*)(Cs + (16 * vt + c) * RSC + (16 * w + 4 * g) * 2) = pk; }
            if (ch < 15) store_chunk();
            __syncthreads();
        }
    }
}

__device__ __forceinline__ void phase_aprep(unsigned char* lds_, int wv, const Params& p) {
    const Frame F = make_frame(lds_, wv);
    const bf16_t* HO = (const bf16_t*)(p.ws + WS_HOUT); const bf16_t* PR = (const bf16_t*)(p.ws + WS_PROJ); unsigned char* A2 = p.ws + WS_H;
    float hn[16];
#pragma unroll
    for (int i = 0; i < 16; ++i) hn[i] = p.a_h_norm[16 * F.lane + i];
    const int gw = F.bid * NWAVES + F.wave, NGW = F.G * NWAVES;
    for (int rowb = gw; rowb < NTOK; rowb += 4 * NGW) {
        u32x4 h0[4], h1[4], o0[4], o1[4];
#pragma unroll
        for (int rr = 0; rr < 4; ++rr) { const int row = rowb + rr * NGW; if (row < NTOK) {
            h0[rr] = *(const u32x4*)(HO + (size_t)row * DM + 16 * F.lane); h1[rr] = *(const u32x4*)(HO + (size_t)row * DM + 16 * F.lane + 8);
            o0[rr] = *(const u32x4*)(PR + (size_t)row * 3072 + 2048 + 16 * F.lane); o1[rr] = *(const u32x4*)(PR + (size_t)row * 3072 + 2048 + 16 * F.lane + 8); } }
#pragma unroll
        for (int rr = 0; rr < 4; ++rr) { const int row = rowb + rr * NGW; if (row < NTOK) {
            float hv[16], ov[16];
#pragma unroll
            for (int i = 0; i < 4; ++i) { hv[2 * i] = bflo(h0[rr][i]); hv[2 * i + 1] = bfhi(h0[rr][i]); hv[8 + 2 * i] = bflo(h1[rr][i]); hv[8 + 2 * i + 1] = bfhi(h1[rr][i]);
                ov[2 * i] = bflo(o0[rr][i]); ov[2 * i + 1] = bfhi(o0[rr][i]); ov[8 + 2 * i] = bflo(o1[rr][i]); ov[8 + 2 * i + 1] = bfhi(o1[rr][i]); }
            float ss = 0.f;
#pragma unroll
            for (int i = 0; i < 16; ++i) ss += hv[i] * hv[i];
            ss += sx<1>(ss); ss += sx<2>(ss); ss += sx<4>(ss); ss += sx<8>(ss);
            const float r = __builtin_amdgcn_rsqf(ss * (1.0f / 256.0f) + EPS);
            float y[16];
#pragma unroll
            for (int i = 0; i < 16; ++i) y[i] = hv[i] * r * hn[i] * sigmoidf_(ov[i]);
            if (WQ_OUT0 == 2) { float mx = 0.f;
#pragma unroll
                for (int i = 0; i < 16; ++i) mx = fmaxf(mx, fabsf(y[i]));
                mx = fmaxf(wave_max(mx), 1e-20f); const float qs = 127.0f * __builtin_amdgcn_rcpf(mx);
                u32x4 w; w.x = pack4_i8(y[0] * qs, y[1] * qs, y[2] * qs, y[3] * qs); w.y = pack4_i8(y[4] * qs, y[5] * qs, y[6] * qs, y[7] * qs); w.z = pack4_i8(y[8] * qs, y[9] * qs, y[10] * qs, y[11] * qs); w.w = pack4_i8(y[12] * qs, y[13] * qs, y[14] * qs, y[15] * qs);
                *(u32x4*)(A2 + (size_t)row * DM + 16 * F.lane) = w; if (F.lane == 0) ((float*)(p.ws + SC_RS_A))[row] = mx * (1.0f / 127.0f); }
            else if (OUTPROJ_FP8) { u32x4 w; w.x = cvt4_fp8(y[0] * S8_A2, y[1] * S8_A2, y[2] * S8_A2, y[3] * S8_A2); w.y = cvt4_fp8(y[4] * S8_A2, y[5] * S8_A2, y[6] * S8_A2, y[7] * S8_A2);
                w.z = cvt4_fp8(y[8] * S8_A2, y[9] * S8_A2, y[10] * S8_A2, y[11] * S8_A2); w.w = cvt4_fp8(y[12] * S8_A2, y[13] * S8_A2, y[14] * S8_A2, y[15] * S8_A2);
                *(u32x4*)(A2 + (size_t)row * DM + 16 * F.lane) = w; }
            else { bf16_t* a2b = (bf16_t*)(p.ws + WS_A2B) + (size_t)row * DM + 16 * F.lane; u32x4 w0, w1;
                w0.x = cvtpk(y[0], y[1]); w0.y = cvtpk(y[2], y[3]); w0.z = cvtpk(y[4], y[5]); w0.w = cvtpk(y[6], y[7]); w1.x = cvtpk(y[8], y[9]); w1.y = cvtpk(y[10], y[11]); w1.z = cvtpk(y[12], y[13]); w1.w = cvtpk(y[14], y[15]);
                *(u32x4*)a2b = w0; *(u32x4*)(a2b + 8) = w1; }
            } }
    }
}

__device__ __forceinline__ void phase_hprep_router(unsigned char* lds_, int wv, const Params& p, int layer, int xnx, int xdx, int xper, int xj, const unsigned* oflags) {
    const Frame F = make_frame(lds_, wv);
    LAS u32x4* Wf = (LAS u32x4*)F.lds;
    LAS float* mulc = (LAS float*)(F.lds + 65536);
    LAS float* addc = (LAS float*)(F.lds + 65536 + 4096);
    LAS int* cnt = (LAS int*)(F.lds + 73728);
    LAS float* lgs = (LAS float*)(F.lds + 73728 + 64);
    const float* mod = (const float*)(p.ws + WS_MOD) + (size_t)layer * 16 * 6144;
    unsigned char* H = p.ws + WS_H;
    const bf16_t* XB = (const bf16_t*)(p.ws + WS_XB);
    int* blkcnt = (int*)(p.ws + RT_BLKCNT); int* info = (int*)(p.ws + RT_INFO); float* tw = (float*)(p.ws + RT_W);
    if (F.bid == 0) { for (int i = F.tid; i < 256 * DM / 16; i += NTHREADS) *(u32x4*)(H + (size_t)NTOK * DM + i * 16) = (u32x4){0u, 0u, 0u, 0u}; }
    float rb[16];
#pragma unroll
    for (int e = 0; e < 16; ++e) rb[e] = p.router_bias[e];
    const int ctlo = 2 * ((xdx * 128) / xnx), cthi = 2 * (((xdx + 1) * 128) / xnx);
    bool first = true;
    for (int chunk = ctlo + xj; chunk < cthi; chunk += xper) {
        int lane = F.lane; asm volatile("" : "+v"(lane));
        const int fr = lane & 15, fq = lane >> 4;
        const int row = chunk * 128 + F.wave * 16 + fr; const int b = (chunk * 128) / SEQ;
        if (first) { first = false;
            for (int idx = F.tid; idx < 2048; idx += NTHREADS) { const int ln = idx & 63, ks = idx >> 6; const int col0 = 64 * (ks >> 1) + 16 * (ln >> 4) + 8 * (ks & 1);
                const float* wp = p.w_router + (size_t)col0 * 16 + (ln & 15); u32x4 hi, lo;
#pragma unroll
                for (int i = 0; i < 4; ++i) { const float a = wp[(2 * i) * 16], c = wp[(2 * i + 1) * 16]; const unsigned u = cvtpk(a, c); hi[i] = u; lo[i] = cvtpk(a - bflo(u), c - bfhi(u)); }
                Wf[idx] = hi; Wf[2048 + idx] = lo; } }
        for (int c = F.tid; c < DM; c += NTHREADS) { mulc[c] = p.norm2[(size_t)layer * DM + c] * (1.0f + mod[(size_t)b * 6144 + 4096 + c]); addc[c] = mod[(size_t)b * 6144 + 3072 + c]; }
        if (oflags) { unsigned sp = 0u; while (xb_ld((unsigned*)oflags + (chunk >> 1)) < 32u) { __builtin_amdgcn_s_sleep(2); if (++sp > (1u << 22)) break; } asm volatile("" ::: "memory"); }
        u32x4 xv[16][2];
        { const bf16_t* xrow = XB + (size_t)row * DM + 16 * fq;
#pragma unroll
          for (int s = 0; s < 16; ++s) { xv[s][0] = *(const u32x4*)(xrow + 64 * s); xv[s][1] = *(const u32x4*)(xrow + 64 * s + 8); } }
        if (F.tid < 16) cnt[F.tid] = 0;
        __syncthreads();
        float ss = 0.f;
#pragma unroll
        for (int s = 0; s < 16; ++s)
#pragma unroll
            for (int t = 0; t < 2; ++t)
#pragma unroll
                for (int i = 0; i < 4; ++i) { const float a = bflo(xv[s][t][i]), c = bfhi(xv[s][t][i]); ss += a * a + c * c; }
        ss += sx<16>(ss); ss += sx32(ss, lane >= 32);
        const float r = __builtin_amdgcn_rsqf(ss * (1.0f / DM) + EPS);
        f32x4 acc0 = (f32x4){0.f, 0.f, 0.f, 0.f}, acc1 = acc0, acc2 = acc0;
        unsigned char* hrow = H + (size_t)row * DM + 16 * fq;
#pragma unroll
        for (int s = 0; s < 16; ++s) {
            asm volatile("" ::: "memory");
            float h[16];
#pragma unroll
            for (int q = 0; q < 4; ++q) { const f32x4 m = *(const LAS f32x4*)(mulc + 64 * s + 16 * fq + 4 * q), a = *(const LAS f32x4*)(addc + 64 * s + 16 * fq + 4 * q);
                unsigned w0 = xv[s][q >> 1][(q & 1) * 2], w1 = xv[s][q >> 1][(q & 1) * 2 + 1]; asm volatile("" : "+v"(w0), "+v"(w1));
                h[4 * q] = bflo(w0) * r * m[0] + a[0]; h[4 * q + 1] = bfhi(w0) * r * m[1] + a[1]; h[4 * q + 2] = bflo(w1) * r * m[2] + a[2]; h[4 * q + 3] = bfhi(w1) * r * m[3] + a[3]; }
            u32x4 o; o.x = cvt4_fp8(h[0] * S8_H, h[1] * S8_H, h[2] * S8_H, h[3] * S8_H); o.y = cvt4_fp8(h[4] * S8_H, h[5] * S8_H, h[6] * S8_H, h[7] * S8_H);
            o.z = cvt4_fp8(h[8] * S8_H, h[9] * S8_H, h[10] * S8_H, h[11] * S8_H); o.w = cvt4_fp8(h[12] * S8_H, h[13] * S8_H, h[14] * S8_H, h[15] * S8_H);
            *(u32x4*)(hrow + 64 * s) = o;
#pragma unroll
            for (int t = 0; t < 2; ++t) { u32x4 hi, lo;
#pragma unroll
                for (int i = 0; i < 4; ++i) { const float a = h[8 * t + 2 * i], c = h[8 * t + 2 * i + 1]; const unsigned u = cvtpk(a, c); hi[i] = u; lo[i] = cvtpk(a - bflo(u), c - bfhi(u)); }
                const int ks = 2 * s + t;
                const bf16x8 whi = __builtin_bit_cast(bf16x8, Wf[ks * 64 + lane]), wlo = __builtin_bit_cast(bf16x8, Wf[2048 + ks * 64 + lane]);
                const bf16x8 hh = __builtin_bit_cast(bf16x8, hi), hl = __builtin_bit_cast(bf16x8, lo);
                acc0 = __builtin_amdgcn_mfma_f32_16x16x32_bf16(whi, hh, acc0, 0, 0, 0);
                acc1 = __builtin_amdgcn_mfma_f32_16x16x32_bf16(wlo, hh, acc1, 0, 0, 0);
                acc2 = __builtin_amdgcn_mfma_f32_16x16x32_bf16(whi, hl, acc2, 0, 0, 0); }
        }
        { const f32x4 tot = acc0 + (acc1 + acc2);
#pragma unroll
          for (int rr = 0; rr < 4; ++rr) lgs[(F.wave * 16 + fr) * 17 + 4 * fq + rr] = tot[rr]; }
        __syncthreads();
        if (F.tid < 128) {
            const int row = chunk * 128 + F.tid;
            float sc[16], bs[16];
#pragma unroll
            for (int e = 0; e < 16; ++e) { sc[e] = __builtin_amdgcn_rcpf(1.0f + __expf(-lgs[F.tid * 17 + e])); bs[e] = sc[e] + rb[e]; }
            int gsel = 0; float gbest = -INFINITY;
#pragma unroll
            for (int gI = 0; gI < 4; ++gI) { const float a = bs[4 * gI], b2 = bs[4 * gI + 1], c2 = bs[4 * gI + 2], d2 = bs[4 * gI + 3];
                const float hi1 = fmaxf(a, b2), lo1 = fminf(a, b2), hi2 = fmaxf(c2, d2), lo2 = fminf(c2, d2);
                const float top = fmaxf(hi1, hi2), sec = fmaxf(fminf(hi1, hi2), fmaxf(lo1, lo2)); const float gs = top + sec;
                if (gs > gbest) { gbest = gs; gsel = gI; } }
            float v0 = 0.f, v1 = 0.f, v2 = 0.f, v3 = 0.f, s0 = 0.f, s1 = 0.f, s2 = 0.f, s3 = 0.f;
#pragma unroll
            for (int gI = 0; gI < 4; ++gI) if (gI == gsel) { v0 = bs[4 * gI]; v1 = bs[4 * gI + 1]; v2 = bs[4 * gI + 2]; v3 = bs[4 * gI + 3]; s0 = sc[4 * gI]; s1 = sc[4 * gI + 1]; s2 = sc[4 * gI + 2]; s3 = sc[4 * gI + 3]; }
            int i1 = 0; float b1 = v0; if (v1 > b1) { b1 = v1; i1 = 1; } if (v2 > b1) { b1 = v2; i1 = 2; } if (v3 > b1) { b1 = v3; i1 = 3; }
            int i2 = -1; float bb = -INFINITY;
            if (i1 != 0 && v0 > bb) { bb = v0; i2 = 0; } if (i1 != 1 && v1 > bb) { bb = v1; i2 = 1; } if (i1 != 2 && v2 > bb) { bb = v2; i2 = 2; } if (i1 != 3 && v3 > bb) { bb = v3; i2 = 3; }
            const float sa = (i1 == 0) ? s0 : (i1 == 1) ? s1 : (i1 == 2) ? s2 : s3;
            const float sb = (i2 == 0) ? s0 : (i2 == 1) ? s1 : (i2 == 2) ? s2 : s3;
            const int e0 = gsel * 4 + i1, e1 = gsel * 4 + i2;
            const int r0 = __hip_atomic_fetch_add(&cnt[e0], 1, __ATOMIC_RELAXED, __HIP_MEMORY_SCOPE_WORKGROUP); const int r1 = __hip_atomic_fetch_add(&cnt[e1], 1, __ATOMIC_RELAXED, __HIP_MEMORY_SCOPE_WORKGROUP);
            info[row] = e0 | (e1 << 4) | (r0 << 8) | (r1 << 16); const float inv = 1.0f / (sa + sb); *(f32x2*)(tw + (size_t)row * 2) = (f32x2){sa * inv, sb * inv};
        }
        __syncthreads();
        if (F.tid < 16) blkcnt[chunk * 16 + F.tid] = cnt[F.tid];
        __syncthreads();
    }
}

__device__ __forceinline__ void phase_layout(unsigned char* lds_, int wv, const Params& p) {
    const Frame F = make_frame(lds_, wv);
    LAS int* lc = (LAS int*)F.lds;
    LAS int* tot = lc + 4096;
    LAS int* sst = tot + 16;
    LAS int* tst = sst + 16;
    const int* blkcnt = (const int*)(p.ws + RT_BLKCNT); const int* info = (const int*)(p.ws + RT_INFO);
    int* dest = (int*)(p.ws + RT_DEST); int* buftok = (int*)(p.ws + RT_BUFTOK); int* meta = (int*)(p.ws + RT_META);
    for (int i = F.tid; i < 4096; i += NTHREADS) lc[i] = blkcnt[i];
    __syncthreads();
    { const int e = F.tid >> 5, li = F.tid & 31; int v[8]; int s = 0;
      LAS int* part = tst + 32;
#pragma unroll
      for (int k = 0; k < 8; ++k) { v[k] = lc[(8 * li + k) * 16 + e]; s += v[k]; }
      part[e * 32 + li] = s;
      __syncthreads();
      int run = 0, all = 0;
      for (int k = 0; k < 32; ++k) { const int t = part[e * 32 + k]; all += t; if (k < li) run += t; }
#pragma unroll
      for (int k = 0; k < 8; ++k) { lc[(8 * li + k) * 16 + e] = run; run += v[k]; }
      if (li == 31) tot[e] = all; }
    __syncthreads();
    if (F.tid == 0) { int ts = 0; for (int e = 0; e < 16; ++e) { tst[e] = ts; sst[e] = ts * 256; ts += (tot[e] + 255) >> 8; } tst[16] = ts;
        if (F.bid == 0) { meta[0] = ts; for (int e = 0; e <= 16; ++e) meta[1 + e] = tst[e]; } }
    __syncthreads();
    for (int chunk = F.bid; chunk < 256; chunk += F.G) {
        if (F.tid < 128) { const int tok = chunk * 128 + F.tid; const int inf = info[tok]; const int e0 = inf & 15, e1 = (inf >> 4) & 15, r0 = (inf >> 8) & 255, r1 = (inf >> 16) & 255;
            const int d0 = sst[e0] + lc[chunk * 16 + e0] + r0, d1 = sst[e1] + lc[chunk * 16 + e1] + r1;
            buftok[d0] = tok; buftok[d1] = tok; dest[tok * 2] = d0; dest[tok * 2 + 1] = d1; }
    }
    for (int e = F.bid; e < 16; e += F.G) { const int beg = sst[e] + tot[e], end = tst[e + 1] * 256; for (int s = beg + F.tid; s < end; s += NTHREADS) buftok[s] = NTOK; }
}

__device__ __forceinline__ void phase_combine(unsigned char* lds_, int wv, const Params& p, int layer, bool next_prep) {
    const Frame F = make_frame(lds_, wv);
    const float* mod = (const float*)(p.ws + WS_MOD) + (size_t)layer * 16 * 6144;
    const float* modn = (const float*)(p.ws + WS_MOD) + (size_t)(layer + 1) * 16 * 6144;
    const unsigned char* Y = p.ws + WS_PROJ; unsigned char* H = p.ws + WS_H;
    bf16_t* XB = (bf16_t*)(p.ws + WS_XB);
    const int* dest = (const int*)(p.ws + RT_DEST); const float* tw = (const float*)(p.ws + RT_W);
    for (int chunk = F.bid; chunk < 256; chunk += F.G) {
        const int row0 = chunk * 128 + F.wave * 16; const int b = row0 / SEQ;
        f32x4 g2[4];
#pragma unroll
        for (int j = 0; j < 4; ++j) g2[j] = *(const f32x4*)(mod + (size_t)b * 6144 + 5120 + 256 * j + 4 * F.lane) * (1.0f / S8_Y);
        RowConst rc;
        if (next_prep) rc = load_rowconst(p.norm1 + (size_t)(layer + 1) * DM, modn + (size_t)b * 6144, 0, 1024, F.lane);
        for (int rb = 0; rb < 16; rb += 4) {
            int d0[4], d1[4]; float w0[4], w1[4];
#pragma unroll
            for (int rr = 0; rr < 4; ++rr) { const int row = row0 + rb + rr; d0[rr] = dest[row * 2]; d1[rr] = dest[row * 2 + 1]; w0[rr] = tw[row * 2]; w1[rr] = tw[row * 2 + 1]; }
            u32x2 xr[4][4]; unsigned ya[4][4], yb[4][4];
#pragma unroll
            for (int rr = 0; rr < 4; ++rr)
#pragma unroll
                for (int j = 0; j < 4; ++j) { xr[rr][j] = *(const u32x2*)(XB + (size_t)(row0 + rb + rr) * DM + 256 * j + 4 * F.lane);
                    ya[rr][j] = *(const unsigned*)(Y + (size_t)d0[rr] * DM + 256 * j + 4 * F.lane); yb[rr][j] = *(const unsigned*)(Y + (size_t)d1[rr] * DM + 256 * j + 4 * F.lane); }
#pragma unroll
            for (int rr = 0; rr < 4; ++rr) { const int row = row0 + rb + rr;
                f32x4 v[4];
#pragma unroll
                for (int j = 0; j < 4; ++j) { const unsigned a = ya[rr][j], bq = yb[rr][j]; f32x4 yy;
                    const f32x2 a01 = __builtin_amdgcn_cvt_pk_f32_fp8((int)a, false), a23 = __builtin_amdgcn_cvt_pk_f32_fp8((int)a, true), b01 = __builtin_amdgcn_cvt_pk_f32_fp8((int)bq, false), b23 = __builtin_amdgcn_cvt_pk_f32_fp8((int)bq, true);
                    yy[0] = w0[rr] * a01[0] + w1[rr] * b01[0]; yy[1] = w0[rr] * a01[1] + w1[rr] * b01[1]; yy[2] = w0[rr] * a23[0] + w1[rr] * b23[0]; yy[3] = w0[rr] * a23[1] + w1[rr] * b23[1];
                    const f32x4 xv = (f32x4){bflo(xr[rr][j].x), bfhi(xr[rr][j].x), bflo(xr[rr][j].y), bfhi(xr[rr][j].y)};
                    v[j] = xv + g2[j] * yy;
                    if (next_prep) { u32x2 w; w.x = cvtpk(v[j][0], v[j][1]); w.y = cvtpk(v[j][2], v[j][3]); *(u32x2*)(XB + (size_t)row * DM + 256 * j + 4 * F.lane) = w; }
                    else *(f32x4*)(p.out + (size_t)row * DM + 256 * j + 4 * F.lane) = v[j]; }
                if (next_prep) { f32x4 h[4]; row_norm_store8(v, rc, h, H + (size_t)row * DM, F.lane); }
            }
        }
    }
}

__device__ __forceinline__ void phase_qkprep(unsigned char* lds_, int wv, const Params& p) {
    const Frame F = make_frame(lds_, wv);
    bf16_t* PR = (bf16_t*)(p.ws + WS_PROJ);
    const int lane = F.lane, half = lane & 1, sh = lane >> 1;
    float nw[32];
    { const float* nsrc = (sh < 16) ? p.b_q_norm : p.b_k_norm;
#pragma unroll
      for (int i = 0; i < 32; ++i) nw[i] = nsrc[half * 32 + i]; }
    const float qscale = (sh < 16) ? 0.125f * 1.4426950408889634f : 1.0f;
    const float invf_tab[8] = {1.0f, 0.19391788f, 0.037604144f, 0.0072920943f, 0.0014140673f, 0.00027421273f, 5.3174683e-05f, 1.0311522e-05f};
    float invf = 0.f;
#pragma unroll
    for (int i = 0; i < 8; ++i) if ((lane & 7) == i) invf = invf_tab[i];
    const int gw = F.bid * NWAVES + F.wave, NGW = F.G * NWAVES;
    for (int rowb = gw; rowb < NTOK; rowb += 4 * NGW) {
        u32x4 raw[4][4]; int posi[4];
#pragma unroll
        for (int rr = 0; rr < 4; ++rr) { const int row = rowb + rr * NGW; if (row < NTOK) { posi[rr] = p.positions[row]; const bf16_t* ptr = PR + (size_t)row * 3072 + sh * 64 + half * 32;
#pragma unroll
            for (int k = 0; k < 4; ++k) raw[rr][k] = *(const u32x4*)(ptr + 8 * k); } }
#pragma unroll
        for (int rr = 0; rr < 4; ++rr) { const int row = rowb + rr * NGW; if (row < NTOK) {
            const float ang = (float)posi[rr] * invf;
            const double rev = (double)ang * 0.15915494309189535; const float fr = (float)(rev - rint(rev));
            const float cs = __builtin_amdgcn_cosf(fr), sn = __builtin_amdgcn_sinf(fr);
            bf16_t* ptr = PR + (size_t)row * 3072 + sh * 64 + half * 32;
            float v[32];
#pragma unroll
            for (int k = 0; k < 4; ++k)
#pragma unroll
                for (int i = 0; i < 4; ++i) { v[8 * k + 2 * i] = bflo(raw[rr][k][i]); v[8 * k + 2 * i + 1] = bfhi(raw[rr][k][i]); }
            float ss = 0.f;
#pragma unroll
            for (int i = 0; i < 32; ++i) ss += v[i] * v[i];
            ss += sx<1>(ss);
            const float r = 1.0f / sqrtf(ss * (1.0f / 64.0f) + EPS);
#pragma unroll
            for (int i = 0; i < 32; ++i) v[i] = v[i] * r * nw[i];
            float y1[8], y2[8];
#pragma unroll
            for (int i = 0; i < 8; ++i) { const float ci = rdlane(cs, i), si = rdlane(sn, i); y1[i] = v[i] * ci - v[8 + i] * si; y2[i] = v[8 + i] * ci + v[i] * si; }
            if (half == 0) {
#pragma unroll
                for (int i = 0; i < 8; ++i) { v[i] = y1[i]; v[8 + i] = y2[i]; } }
#pragma unroll
            for (int k = 0; k < 4; ++k) { u32x4 o;
#pragma unroll
                for (int i = 0; i < 4; ++i) o[i] = cvtpk(v[8 * k + 2 * i] * qscale, v[8 * k + 2 * i + 1] * qscale);
                *(u32x4*)(ptr + 8 * k) = o; } } }
    }
}

__device__ __forceinline__ void phase_attn(unsigned char* lds_, int wv, const Params& p) {
    const Frame F = make_frame(lds_, wv);
    const bf16_t* PR = (const bf16_t*)(p.ws + WS_PROJ); bf16_t* O4 = (bf16_t*)(p.ws + WS_HOUT) + (size_t)F.bid * 256 * 256;
    unsigned char* A2 = p.ws + WS_H;
    const float lam_init = 0.8f - 0.6f * 0.7408182206817179f;
    const float s1 = wave_sum(p.b_lam_q1[F.lane] * p.b_lam_k1[F.lane]), s2 = wave_sum(p.b_lam_q2[F.lane] * p.b_lam_k2[F.lane]);
    const float lam = expf(s1) - expf(s2) + lam_init;
    const float osc = (WQ_OUT1 == 2) ? A2Q : (1.0f - lam_init) * (OUTPROJ_FP8 ? S8_A2 : 1.0f);
    for (int item = F.vcu; item < 256; item += F.G) {
        const int bh = item >> 1, set = item & 1, b = bh >> 3, h = bh & 7;
        const int qlist = set ? 0x1256 : 0x0347;
#define AT2_REF(R, u) do { const int qb_ = (qlist >> (4 * ((u) >> 1))) & 15, c_ = (u) & 1; const size_t r0_ = (size_t)b * SEQ + qb_ * 256; \
        R.Q = PR + r0_ * 3072 + (h * 2 + c_) * 64; R.K = PR + (size_t)b * SEQ * 3072 + 1024 + (h * 2 + c_) * 64; R.V = PR + (size_t)b * SEQ * 3072 + 2048 + h * 128; \
        R.P0 = qb_ * 256; R.to_lds = c_; R.lam = lam; } while (0)
        at2::Seam S; at2::BlockRef cur, nxt;
        AT2_REF(cur, 0);
        __syncthreads();
        at2::prime(cur, (char*)lds_, S, F.tid, wv);
        for (int u = 0; u < 8; ++u) {
            const int un = (u < 7) ? u + 1 : 7;
            AT2_REF(nxt, un);
            at2::block(cur, nxt, (char*)lds_, S, F.tid, wv);
            if (u & 1) {
                asm volatile("s_waitcnt vmcnt(0)" ::: "memory");
                int lane = F.lane; asm volatile("" : "+v"(lane));
                const int half = lane & 1; const int qb = (qlist >> (4 * (u >> 1))) & 15; const size_t row = (size_t)b * SEQ + qb * 256 + wv * 32 + (lane >> 1);
                const LAS unsigned char* pb = F.lds + at2::OFF_OL + wv * at2::OL_WAVE + (lane >> 1) * at2::OL_RS + half * 128;
                u32x4 bq[8];
#pragma unroll
                for (int i = 0; i < 8; ++i) bq[i] = *(const LAS u32x4*)(pb + 16 * i);
                float d[64]; float ss = 0.f;
#pragma unroll
                for (int i = 0; i < 8; ++i)
#pragma unroll
                    for (int j = 0; j < 4; ++j) { d[8 * i + 2 * j] = bflo(bq[i][j]); d[8 * i + 2 * j + 1] = bfhi(bq[i][j]); }
#pragma unroll
                for (int i = 0; i < 64; ++i) ss += d[i] * d[i];
                ss += sx<1>(ss);
                const float r = osc * __builtin_amdgcn_rsqf(ss * (1.0f / 128.0f) + EPS);
                if (WQ_OUT1 == 2) { unsigned char* po = A2 + row * DM + h * 128 + half * 64;
#pragma unroll
                    for (int i = 0; i < 4; ++i) { const f32x4 n0 = *(const f32x4*)(p.b_o_norm + half * 64 + 16 * i), n1 = *(const f32x4*)(p.b_o_norm + half * 64 + 16 * i + 4), n2 = *(const f32x4*)(p.b_o_norm + half * 64 + 16 * i + 8), n3 = *(const f32x4*)(p.b_o_norm + half * 64 + 16 * i + 12);
                        u32x4 w; w.x = pack4_i8(d[16 * i] * r * n0[0], d[16 * i + 1] * r * n0[1], d[16 * i + 2] * r * n0[2], d[16 * i + 3] * r * n0[3]);
                        w.y = pack4_i8(d[16 * i + 4] * r * n1[0], d[16 * i + 5] * r * n1[1], d[16 * i + 6] * r * n1[2], d[16 * i + 7] * r * n1[3]);
                        w.z = pack4_i8(d[16 * i + 8] * r * n2[0], d[16 * i + 9] * r * n2[1], d[16 * i + 10] * r * n2[2], d[16 * i + 11] * r * n2[3]);
                        w.w = pack4_i8(d[16 * i + 12] * r * n3[0], d[16 * i + 13] * r * n3[1], d[16 * i + 14] * r * n3[2], d[16 * i + 15] * r * n3[3]);
                        *(u32x4*)(po + 16 * i) = w; } }
                else if (OUTPROJ_FP8) { unsigned char* po = A2 + row * DM + h * 128 + half * 64;
#pragma unroll
                    for (int i = 0; i < 4; ++i) { const f32x4 n0 = *(const f32x4*)(p.b_o_norm + half * 64 + 16 * i), n1 = *(const f32x4*)(p.b_o_norm + half * 64 + 16 * i + 4), n2 = *(const f32x4*)(p.b_o_norm + half * 64 + 16 * i + 8), n3 = *(const f32x4*)(p.b_o_norm + half * 64 + 16 * i + 12);
                        u32x4 w; w.x = cvt4_fp8(d[16 * i] * r * n0[0], d[16 * i + 1] * r * n0[1], d[16 * i + 2] * r * n0[2], d[16 * i + 3] * r * n0[3]);
                        w.y = cvt4_fp8(d[16 * i + 4] * r * n1[0], d[16 * i + 5] * r * n1[1], d[16 * i + 6] * r * n1[2], d[16 * i + 7] * r * n1[3]);
                        w.z = cvt4_fp8(d[16 * i + 8] * r * n2[0], d[16 * i + 9] * r * n2[1], d[16 * i + 10] * r * n2[2], d[16 * i + 11] * r * n2[3]);
                        w.w = cvt4_fp8(d[16 * i + 12] * r * n3[0], d[16 * i + 13] * r * n3[1], d[16 * i + 14] * r * n3[2], d[16 * i + 15] * r * n3[3]);
                        *(u32x4*)(po + 16 * i) = w; } }
                else { bf16_t* po = (bf16_t*)(p.ws + WS_A2B) + row * DM + h * 128 + half * 64;
#pragma unroll
                    for (int i = 0; i < 8; ++i) { const f32x4 n0 = *(const f32x4*)(p.b_o_norm + half * 64 + 8 * i), n1 = *(const f32x4*)(p.b_o_norm + half * 64 + 8 * i + 4);
                        u32x4 w; w.x = cvtpk(d[8 * i] * r * n0[0], d[8 * i + 1] * r * n0[1]); w.y = cvtpk(d[8 * i + 2] * r * n0[2], d[8 * i + 3] * r * n0[3]);
                        w.z = cvtpk(d[8 * i + 4] * r * n1[0], d[8 * i + 5] * r * n1[1]); w.w = cvtpk(d[8 * i + 6] * r * n1[2], d[8 * i + 7] * r * n1[3]);
                        *(u32x4*)(po + 8 * i) = w; } }
            }
            cur = nxt;
        }
#undef AT2_REF
    }
}

__device__ __forceinline__ void phase_ocombine(unsigned char* lds_, int wv, const Params& p) {
    const Frame F = make_frame(lds_, wv);
    const bf16_t* O4 = (const bf16_t*)(p.ws + WS_HOUT); unsigned char* A2 = p.ws + WS_H;
    const float lam_init = 0.8f - 0.6f * 0.7408182206817179f;
    const float s1 = wave_sum(p.b_lam_q1[F.lane] * p.b_lam_k1[F.lane]), s2 = wave_sum(p.b_lam_q2[F.lane] * p.b_lam_k2[F.lane]);
    const float lam = expf(s1) - expf(s2) + lam_init;
    const int lane = F.lane, hh = lane >> 3, sub = lane & 7, half = sub >> 2, j0 = (sub & 3) * 16;
    float on[16];
#pragma unroll
    for (int i = 0; i < 16; ++i) on[i] = p.b_o_norm[half * 64 + j0 + i] * (1.0f - lam_init) * S8_A2;
    const int gw = F.bid * NWAVES + F.wave, NGW = F.G * NWAVES;
    for (int rowb = gw; rowb < NTOK; rowb += 4 * NGW) {
        u32x4 a0[4], a1[4], b0[4], b1[4];
#pragma unroll
        for (int rr = 0; rr < 4; ++rr) { const int row = rowb + rr * NGW; if (row < NTOK) {
            const bf16_t* pa = O4 + (size_t)row * 2048 + ((hh * 2 + 0) * 2 + half) * 64 + j0; const bf16_t* pb = O4 + (size_t)row * 2048 + ((hh * 2 + 1) * 2 + half) * 64 + j0;
            a0[rr] = *(const u32x4*)pa; a1[rr] = *(const u32x4*)(pa + 8); b0[rr] = *(const u32x4*)pb; b1[rr] = *(const u32x4*)(pb + 8); } }
#pragma unroll
        for (int rr = 0; rr < 4; ++rr) { const int row = rowb + rr * NGW; if (row < NTOK) {
            float d[16];
#pragma unroll
            for (int i = 0; i < 4; ++i) { d[2 * i] = bflo(a0[rr][i]) - lam * bflo(b0[rr][i]); d[2 * i + 1] = bfhi(a0[rr][i]) - lam * bfhi(b0[rr][i]); d[8 + 2 * i] = bflo(a1[rr][i]) - lam * bflo(b1[rr][i]); d[8 + 2 * i + 1] = bfhi(a1[rr][i]) - lam * bfhi(b1[rr][i]); }
            float ss = 0.f;
#pragma unroll
            for (int i = 0; i < 16; ++i) ss += d[i] * d[i];
            ss += sx<1>(ss); ss += sx<2>(ss); ss += sx<4>(ss);
            const float r = 1.0f / sqrtf(ss * (1.0f / 128.0f) + EPS);
            float y[16];
#pragma unroll
            for (int i = 0; i < 16; ++i) y[i] = d[i] * r * on[i];
            u32x4 w; w.x = cvt4_fp8(y[0], y[1], y[2], y[3]); w.y = cvt4_fp8(y[4], y[5], y[6], y[7]); w.z = cvt4_fp8(y[8], y[9], y[10], y[11]); w.w = cvt4_fp8(y[12], y[13], y[14], y[15]);
            *(u32x4*)(A2 + (size_t)row * DM + hh * 128 + half * 64 + j0) = w; } }
    }
}


#ifndef PHASE_MASK
#define PHASE_MASK 0xFFFFFFFFu
#endif
#ifndef PROBE_A
#define PROBE_A (-1)
#endif
#ifndef PROBE_B
#define PROBE_B (0)
#endif
constexpr int STAMP_OFF = LDS_BYTES - 2048;
#define STAMP(k) do { if (PROBE_A >= 0 && blockIdx.x == 0 && STAMP_WAVE == 0 && lane_id() == 0) ((volatile LAS unsigned*)((LAS unsigned char*)lds + STAMP_OFF))[k] = (unsigned)__builtin_amdgcn_s_memrealtime(); } while (0)
#define PH(n) ((PHASE_MASK >> (n)) & 1u)

template <int LAYER>
__device__ __forceinline__ void layer_body(const Params& p, const XcdBarrier& bar, unsigned char* lds) {
    const int STAMP_WAVE = bar.wave; (void)STAMP_WAVE;
    constexpr int SB = (LAYER == 0) ? 4 : 13;
    const int G_ = gridDim.x, bid_ = blockIdx.x; LAS unsigned char* ldsl = (LAS unsigned char*)lds;
#define SEAM() xcd_barrier(bar)
    const float* mod = (const float*)(p.ws + WS_MOD);
    LAS int* tab = (LAS int*)(ldsl + TAB_OFF);
    if (PH(2)) { pg8::StaticOrder S; S.init(NTOK, 3072, G_, bid_);
      if (LAYER == 0) {
        if (WQ_IN0 == 2) { pg8::EpiProjI8 E{(bf16_t*)(p.ws + WS_PROJ), (const float*)(p.ws + SC_RS_H), (const float*)(p.ws + SC_CW) + CW_AIN, 0.08838834764831845f};
          pg8::gemm_phase<pg8::EpiProjI8, pg8::StaticOrder, false, true>(ldsl, bar.wave, (const bf16_t*)(p.ws + WS_H), (const bf16_t*)(p.ws + WS_WAIN), 0, 512, S, E, nullptr); }
        else { pg8::EpiBf16 E{(bf16_t*)(p.ws + WS_PROJ), 3072, 2, 4, 0.08838834764831845f, WQ_IN0 == 1 ? 1.0f / (S8_H * S8_WIN) : 1.0f};
          if (WQ_IN0 == 1) pg8::gemm_phase8<pg8::EpiBf16, pg8::StaticOrder, false>(ldsl, bar.wave, p.ws + WS_H, p.ws + WS_WAIN, 0, 1024, S, E, nullptr);
          else pg8::gemm_phase<pg8::EpiBf16, pg8::StaticOrder, false>(ldsl, bar.wave, (const bf16_t*)(p.ws + WS_H), (const bf16_t*)(p.ws + WS_WAIN_BF), 0, 1024, S, E, nullptr); } }
      else { pg8::EpiQKV E{(bf16_t*)(p.ws + WS_PROJ), p.b_q_norm, p.b_k_norm, (const float*)(p.ws + WS_CS), 1.0f / (S8_H * S8_WIN), (const LAS float*)(ldsl + TAB_OFF)};
        pg8::gemm_phase8<pg8::EpiQKV, pg8::StaticOrder, false>(ldsl, bar.wave, p.ws + WS_H, p.ws + WS_WBIN, 0, 1024, S, E, nullptr); } }
    SEAM(); STAMP(SB + 0);
    if (LAYER == 0) {
        if (PH(3)) phase_mlstm(lds, bar.wave, p);
        SEAM(); STAMP(SB + 1);
        if (PH(4)) phase_aprep(lds, bar.wave, p);
    } else {
        STAMP(SB + 1);
        if (PH(6)) phase_attn(lds, bar.wave, p);
        STAMP(SB + 2);
    }
    SEAM(); STAMP(SB + 2 + LAYER);
    unsigned* oflags = (unsigned*)p.ws + CW_OFLAGS + LAYER * 128;
    const int xper = (int)bar.st[0], xnx = (int)bar.st[1], xdx = (int)bar.st[2], xj = (int)bar.st[3];
    constexpr bool OCHAIN = (LAYER == 0) ? (WQ_OUT0 == 2) : (WQ_OUT1 == 2);
    if (PH(8)) { pg8::StaticOrder S; S.init(NTOK, 1024, G_, bid_);
      pg8::XcdOrder SX{xnx, xdx, xper, xj, NTOK / 256, 4, oflags};
      if (LAYER == 0 && WQ_OUT0 == 2) { pg8::EpiResidB<true, true> E{(const void*)p.x, (bf16_t*)(p.ws + WS_XB), mod + 2048, 1.0f, (const float*)(p.ws + WS_SCALES)};
        pg8::gemm_phase<pg8::EpiResidB<true, true>, pg8::XcdOrder, false, true>(ldsl, bar.wave, (const bf16_t*)(p.ws + WS_H), (const bf16_t*)(p.ws + WS_WAOUT), 0, 512, SX, E, nullptr); }
      else if (LAYER == 1 && WQ_OUT1 == 2) { pg8::EpiResidB<false, true, true> E{(const void*)(p.ws + WS_XB), (bf16_t*)(p.ws + WS_XB), mod + (size_t)16 * 6144 + 2048, (1.0f - (0.8f - 0.6f * 0.7408182206817179f)) / A2Q, (const float*)(p.ws + WS_SCALES)};
        pg8::gemm_phase<pg8::EpiResidB<false, true, true>, pg8::XcdOrder, false, true>(ldsl, bar.wave, (const bf16_t*)(p.ws + WS_H), (const bf16_t*)(p.ws + WS_WBOUT), 0, 512, SX, E, nullptr); }
      else { pg8::EpiResidB<LAYER == 0> E{LAYER == 0 ? (const void*)p.x : (const void*)(p.ws + WS_XB), (bf16_t*)(p.ws + WS_XB), mod + (size_t)LAYER * 16 * 6144 + 2048, OUTPROJ_FP8 ? 1.0f / (S8_A2 * S8_WOUT) : 1.0f, nullptr};
        if (OUTPROJ_FP8) pg8::gemm_phase8<pg8::EpiResidB<LAYER == 0>, pg8::StaticOrder, false>(ldsl, bar.wave, p.ws + WS_H, p.ws + (LAYER == 0 ? WS_WAOUT : WS_WBOUT), 0, 1024, S, E, nullptr);
        else pg8::gemm_phase<pg8::EpiResidB<LAYER == 0>, pg8::StaticOrder, false>(ldsl, bar.wave, (const bf16_t*)(p.ws + WS_A2B), (const bf16_t*)(p.ws + (LAYER == 0 ? WS_WAOUT_BF : WS_WBOUT_BF)), 0, 1024, S, E, nullptr); } }
    if (!OCHAIN) SEAM();
    STAMP(SB + 3 + LAYER);
    if (PH(9)) phase_hprep_router(lds, bar.wave, p, LAYER, xnx, xdx, xper, xj, OCHAIN ? oflags : nullptr);
    SEAM(); STAMP(SB + 4 + LAYER);
    if (PH(10)) phase_layout(lds, bar.wave, p);
    SEAM(); STAMP(SB + 5 + LAYER);
    if (PH(11)) { const int* meta = (const int*)(p.ws + RT_META);
      __syncthreads();
      { const int t_ = bar.wave * 64 + lane_id(); if (t_ < 17) tab[t_] = meta[1 + t_]; }
      __syncthreads();
      unsigned* flags = (unsigned*)p.ws + CW_FLAGS + LAYER * 512;
      const int xper = (int)bar.st[0], xnx = (int)bar.st[1], xdx = (int)bar.st[2], xj = (int)bar.st[3];
      pg8::MoeOrder S{xnx, xdx, xper, xj, tab[16], tab, flags};
      pg8::EpiSwiGLU8 E1{p.ws + WS_HOUT, 1.0f / (S8_H * S8_WGU), flags};
      pg8::gemm_phase8<pg8::EpiSwiGLU8, pg8::MoeOrder, true>(ldsl, bar.wave, p.ws + WS_H, p.ws + WS_WGU + (size_t)LAYER * 16 * 1024 * 1024, (size_t)1024 * 1024, 1024, S, E1, (const int*)(p.ws + RT_BUFTOK));
      STAMP(SB + 6 + LAYER);
      pg8::MoeOrderWait S2{xnx, xdx, xper, xj, tab[16], tab, flags};
      pg8::EpiFp8 E2{p.ws + WS_PROJ, 1024, S8_Y / (S8_ACT * S8_WDN)};
      pg8::gemm_phase8<pg8::EpiFp8, pg8::MoeOrderWait, false>(ldsl, bar.wave, p.ws + WS_HOUT, p.ws + WS_WDN + (size_t)LAYER * 16 * 1024 * 512, (size_t)1024 * 512, 512, S2, E2, nullptr); }
    SEAM(); STAMP(SB + 7 + LAYER);
    if (PH(12)) phase_combine(lds, bar.wave, p, LAYER, LAYER == 0);
#undef SEAM
}
__global__ void __launch_bounds__(NTHREADS, 2) mk_fwd(Params p) {
    extern __shared__ __attribute__((aligned(16))) unsigned char lds[];
    cg::grid_group grid = cg::this_grid();
    volatile LAS unsigned* misc = (volatile LAS unsigned*)((LAS unsigned char*)lds + MISC_OFF);
    const int wv0 = __builtin_amdgcn_readfirstlane((int)threadIdx.x >> 6);
    if (threadIdx.x < 32) misc[threadIdx.x] = 0u;
    __syncthreads();
    unsigned* ctl = (unsigned*)p.ws;
    XcdBarrier bar = xcd_barrier_post(ctl + CW_BAR, misc + 8, wv0);
    const int STAMP_WAVE = wv0; (void)STAMP_WAVE;
    STAMP(0);
    if (PH(0)) phase_mod(lds, bar.wave, p);
    __syncthreads();
    STAMP(1);
    if (PH(0)) { phase_wconv(lds, bar.wave, p); __syncthreads(); phase_wconv_pw(lds, bar.wave, p); }
    __syncthreads();
    if (wv0 == 0 && lane_id() == 0) { unsigned sp = 0u; while (xb_ld(ctl + CW_MODCNT) < 192u) { __builtin_amdgcn_s_sleep(4); if (++sp > (1u << 22)) break; }
        __builtin_amdgcn_fence(__ATOMIC_ACQUIRE, "agent"); asm volatile("s_waitcnt vmcnt(0)" ::: "memory"); }
    __syncthreads(); STAMP(2);
    if (PH(1)) phase_hprep0(lds, bar.wave, p);
    grid.sync(); STAMP(3);
    layer_body<0>(p, bar, lds);
    xcd_barrier(bar); STAMP(12);
    layer_body<1>(p, bar, lds);
    STAMP(22);
    if (PROBE_A >= 0 && blockIdx.x == 0 && STAMP_WAVE == 0 && lane_id() == 0) {
        volatile LAS unsigned* ts = (volatile LAS unsigned*)((LAS unsigned char*)lds + STAMP_OFF);
        const unsigned dA = ts[PROBE_A + 1] - ts[PROBE_A], dB = ts[PROBE_B + 1] - ts[PROBE_B];
        const unsigned long long extra = 100ull * ((unsigned long long)(dA / 100u) + 1024ull * (dB / 100u)), t0 = __builtin_amdgcn_s_memrealtime();
        while (__builtin_amdgcn_s_memrealtime() - t0 < extra) __builtin_amdgcn_s_sleep(32);
    }
    if (xb_ld(ctl + CW_BAR + XB_TMO) != 0u) { __syncthreads(); for (size_t i = (size_t)blockIdx.x * NTHREADS + (wv0 * 64 + lane_id()); i < (size_t)NTOK * DM / 4; i += (size_t)gridDim.x * NTHREADS) ((f32x4*)p.out)[i] = (f32x4){1e30f, 1e30f, 1e30f, 1e30f}; }
}

extern "C" void kernel_launch(void* const* d_in, const int* in_sizes, int n_in, void* d_out, int out_size, void* d_ws, size_t ws_size, hipStream_t stream) {
    static int grid_blocks = 0;
    if (!grid_blocks) {
        int dev = 0, cus = 0, per_cu = 0;
        (void)hipGetDevice(&dev);
        (void)hipDeviceGetAttribute(&cus, hipDeviceAttributeMultiprocessorCount, dev);
        (void)hipFuncSetAttribute((const void*)mk_fwd, hipFuncAttributeMaxDynamicSharedMemorySize, LDS_BYTES);
        (void)hipOccupancyMaxActiveBlocksPerMultiprocessor(&per_cu, (const void*)mk_fwd, NTHREADS, LDS_BYTES);
        if (per_cu < 1) { fprintf(stderr, "kernel_launch: occupancy query reports %d blocks/CU\n", per_cu); per_cu = 1; }
        grid_blocks = cus;
        if (ws_size < WS_END || n_in != 24) fprintf(stderr, "kernel_launch: unexpected ws_size %zu (need %zu) or n_in %d\n", ws_size, (size_t)WS_END, n_in);
    }
    (void)hipMemsetAsync(d_ws, 0, CTL_BYTES, stream);
    Params p{};
    const float** pf = (const float**)&p;
    p.x = (const float*)d_in[0]; p.c = (const float*)d_in[1]; p.positions = (const int*)d_in[2]; p.norm1 = (const float*)d_in[3]; p.norm2 = (const float*)d_in[4];
    p.w_ada = (const float*)d_in[5]; p.b_ada = (const float*)d_in[6]; p.a_w_in = (const float*)d_in[7]; p.a_b_if = (const float*)d_in[8]; p.a_h_norm = (const float*)d_in[9];
    p.a_w_out = (const float*)d_in[10]; p.b_w_in = (const float*)d_in[11]; p.b_q_norm = (const float*)d_in[12]; p.b_k_norm = (const float*)d_in[13];
    p.b_lam_q1 = (const float*)d_in[14]; p.b_lam_k1 = (const float*)d_in[15]; p.b_lam_q2 = (const float*)d_in[16]; p.b_lam_k2 = (const float*)d_in[17];
    p.b_o_norm = (const float*)d_in[18]; p.b_w_out = (const float*)d_in[19]; p.w_router = (const float*)d_in[20]; p.router_bias = (const float*)d_in[21];
    p.moe_w_gu = (const float*)d_in[22]; p.moe_w_down = (const float*)d_in[23];
    p.out = (float*)d_out; p.ws = (unsigned char*)d_ws; (void)pf;
    void* args[] = {&p};
    hipError_t e = hipLaunchCooperativeKernel((const void*)mk_fwd, dim3(grid_blocks), dim3(NTHREADS), args, LDS_BYTES, stream);
    if (e != hipSuccess) fprintf(stderr, "cooperative launch failed: %s (grid %d)\n", hipGetErrorString(e), grid_blocks);
}
```

```cpp
#include <hip/hip_runtime.h>
#include <hip/hip_cooperative_groups.h>
#include <hip/hip_bf16.h>
#include <cstdio>
#include <cstdint>
#include <cmath>
namespace cg = cooperative_groups;

#define GAS __attribute__((address_space(1)))
#define LAS __attribute__((address_space(3)))
typedef unsigned short bf16_t;
typedef float f32x4 __attribute__((ext_vector_type(4)));
typedef float f32x2 __attribute__((ext_vector_type(2)));
typedef short bf16x8 __attribute__((ext_vector_type(8)));
typedef short s16x4 __attribute__((ext_vector_type(4)));
typedef unsigned u32x4 __attribute__((ext_vector_type(4)));
typedef unsigned u32x2 __attribute__((ext_vector_type(2)));
typedef __bf16 bf16x2_t __attribute__((ext_vector_type(2)));
typedef int i32x8 __attribute__((ext_vector_type(8)));
typedef int i32x4 __attribute__((ext_vector_type(4)));

constexpr int NTOK = 32768, DM = 1024, SEQ = 2048, NB = 16;
constexpr int NEXP = 16, DEXP = 512;
constexpr int NTHREADS = 512, NWAVES = 8;
constexpr int LDS_BYTES = 149504;
constexpr int MISC_OFF = LDS_BYTES - 128;
constexpr int TAB_OFF = 131072;
constexpr float EPS = 1e-6f;
constexpr int MAXTILES = 272, CAP = MAXTILES * 256;
constexpr float S8_H = 8.0f, S8_WGU = 256.0f, S8_ACT = 4.0f, S8_WDN = 128.0f, S8_WIN = 256.0f, S8_A2 = 16.0f, S8_WOUT = 256.0f, S8_Y = 16.0f;

constexpr size_t MiB = 1u << 20;
constexpr size_t WS_CTL = 0, CTL_BYTES = 1 * MiB;
constexpr int CW_BAR = 4096;
constexpr int CW_MODCNT = 9728;
constexpr int CW_OFLAGS = 9216;
constexpr int CW_FLAGS = 8192;
constexpr size_t WS_MOD = 1 * MiB;
constexpr size_t WS_ROUTE = 2 * MiB;
constexpr size_t RT_BLKCNT = WS_ROUTE;
constexpr size_t RT_INFO = WS_ROUTE + 64 * 1024;
constexpr size_t RT_W = RT_INFO + 128 * 1024;
constexpr size_t RT_DEST = RT_W + 256 * 1024;
constexpr size_t RT_BUFTOK = RT_DEST + 256 * 1024;
constexpr size_t RT_META = RT_BUFTOK + 320 * 1024;
constexpr size_t WS_GATES = 4 * MiB;
constexpr size_t WS_SCALES = 5 * MiB;
constexpr size_t SC_RS_H = WS_SCALES;
constexpr size_t SC_RS_A = WS_SCALES + 128 * 1024;
constexpr size_t SC_RS_TOK = WS_SCALES + 256 * 1024;
constexpr size_t SC_RS_SLOT = WS_SCALES + 384 * 1024;
constexpr size_t SC_CW = WS_SCALES + 704 * 1024;
constexpr int CW_AIN = 0, CW_AOUT = 3072, CW_BIN = 4096, CW_GU = 7168, CW_BOUT = 7168 + 32 * 1024;
constexpr int WQ_OUT1 = 2;
constexpr float A2Q = 127.0f / 6.0f;
constexpr int WQ_IN0 = 2, WQ_IN1 = 1, WQ_OUT0 = 2, WQ_GU = 1;
constexpr size_t WS_WAIN = 6 * MiB, WS_WAOUT = 10 * MiB, WS_WBIN = 12 * MiB, WS_WBOUT = 16 * MiB;
constexpr size_t WS_WGU = 18 * MiB;
constexpr size_t WS_WDN = 50 * MiB;
constexpr size_t WS_H = 66 * MiB;
constexpr size_t WS_XB = 100 * MiB;
constexpr size_t WS_PROJ = 164 * MiB;
constexpr size_t WS_HOUT = 356 * MiB;
constexpr size_t WS_CS = 484 * MiB;
constexpr size_t WS_WAIN_BF = 488 * MiB;
constexpr size_t WS_WAOUT_BF = 506 * MiB, WS_WBOUT_BF = 508 * MiB;
constexpr size_t WS_A2B = 420 * MiB;
constexpr bool OUTPROJ_FP8 = false;
constexpr size_t WS_END = 510 * MiB;
constexpr bool INPROJ0_FP8 = false;

__device__ __forceinline__ unsigned cvtpk(float lo, float hi) { f32x2 v = {lo, hi}; bf16x2_t b = __builtin_convertvector(v, bf16x2_t); return __builtin_bit_cast(unsigned, b); }
__device__ __forceinline__ float clamp448(float v) { return fminf(fmaxf(v, -448.0f), 448.0f); }
__device__ __forceinline__ unsigned cvt4_fp8(float a, float b, float c, float d) {
    int w = __builtin_amdgcn_cvt_pk_fp8_f32(clamp448(a), clamp448(b), 0, false); w = __builtin_amdgcn_cvt_pk_fp8_f32(clamp448(c), clamp448(d), w, true); return (unsigned)w; }
__device__ __forceinline__ float bf2f(unsigned short h) { return __uint_as_float(((unsigned)h) << 16); }
__device__ __forceinline__ float bflo(unsigned w) { return __uint_as_float(w << 16); }
__device__ __forceinline__ float bfhi(unsigned w) { return __uint_as_float(w & 0xffff0000u); }
__device__ __forceinline__ int lane_id() { int l; asm volatile("v_mbcnt_lo_u32_b32 %0, -1, 0\n\tv_mbcnt_hi_u32_b32 %0, -1, %0" : "=v"(l)); return l; }
template <int M> __device__ __forceinline__ float sx(float v) {
    const int i = __float_as_int(v);
    if constexpr (M == 1) return __int_as_float(__builtin_amdgcn_mov_dpp(i, 0xB1, 0xF, 0xF, true));
    else if constexpr (M == 2) return __int_as_float(__builtin_amdgcn_mov_dpp(i, 0x4E, 0xF, 0xF, true));
    else if constexpr (M == 4) return __int_as_float(__builtin_amdgcn_ds_swizzle(i, 0x101F));
    else if constexpr (M == 8) return __int_as_float(__builtin_amdgcn_ds_swizzle(i, 0x201F));
    else if constexpr (M == 16) return __int_as_float(__builtin_amdgcn_ds_swizzle(i, 0x401F));
    else { static_assert(M == 1, "sx: mask"); return v; }
}
__device__ __forceinline__ float sx16p(float v, bool odd_row) {
    auto rr = __builtin_amdgcn_permlane16_swap(__float_as_uint(v), __float_as_uint(v), false, false);
    return __uint_as_float(odd_row ? rr[0] : rr[1]);
}
__device__ __forceinline__ float sx32(float v, bool upper) {
    auto rr = __builtin_amdgcn_permlane32_swap(__float_as_uint(v), __float_as_uint(v), false, false);
    return __uint_as_float(upper ? rr[0] : rr[1]);
}
__device__ __forceinline__ float bperm(float v, int src_lane) { return __int_as_float(__builtin_amdgcn_ds_bpermute(src_lane << 2, __float_as_int(v))); }
__device__ __forceinline__ float rdlane(float v, int l) { return __int_as_float(__builtin_amdgcn_readlane(__float_as_int(v), l)); }
__device__ __forceinline__ float wave_sum(float v) {
    v += sx<1>(v); v += sx<2>(v); v += sx<4>(v); v += sx<8>(v); v += sx<16>(v);
    { auto rr = __builtin_amdgcn_permlane32_swap(__float_as_uint(v), __float_as_uint(v), false, false); v = __uint_as_float(rr[0]) + __uint_as_float(rr[1]); }
    return v;
}
__device__ __forceinline__ float wave_max(float v) {
    v = fmaxf(v, sx<1>(v)); v = fmaxf(v, sx<2>(v)); v = fmaxf(v, sx<4>(v)); v = fmaxf(v, sx<8>(v)); v = fmaxf(v, sx<16>(v));
    { auto rr = __builtin_amdgcn_permlane32_swap(__float_as_uint(v), __float_as_uint(v), false, false); v = fmaxf(__uint_as_float(rr[0]), __uint_as_float(rr[1])); }
    return v;
}
__device__ __forceinline__ unsigned pack4_i8(float a, float b, float c, float d) {
    unsigned w = __builtin_amdgcn_cvt_pk_u8_f32(fminf(fmaxf(rintf(a), -127.f), 127.f) + 128.f, 0, 0u);
    w = __builtin_amdgcn_cvt_pk_u8_f32(fminf(fmaxf(rintf(b), -127.f), 127.f) + 128.f, 1, w);
    w = __builtin_amdgcn_cvt_pk_u8_f32(fminf(fmaxf(rintf(c), -127.f), 127.f) + 128.f, 2, w);
    w = __builtin_amdgcn_cvt_pk_u8_f32(fminf(fmaxf(rintf(d), -127.f), 127.f) + 128.f, 3, w);
    return w ^ 0x80808080u;
}
__device__ __forceinline__ f32x4 i2f4(f32x4 a) { return (f32x4){(float)__float_as_int(a[0]), (float)__float_as_int(a[1]), (float)__float_as_int(a[2]), (float)__float_as_int(a[3])}; }
__device__ __forceinline__ float sigmoidf_(float x) { return __builtin_amdgcn_rcpf(1.0f + __expf(-x)); }

#define XB_TMO      128
#define XB_XCNT(j)  (256  + 64 * (j))
#define XB_XSUB(j)  (1280 + 64 * (j))
#define XB_XGEN(j)  (2304 + 64 * (j))
#define XB_TOP      3328
#define XB_TOPGEN   3392
#define XCD_BAR_WORDS 3456
#define XB_SPIN_CAP (1u << 18)
__device__ __forceinline__ unsigned xb_ld(unsigned* p)              { return __hip_atomic_load(p, __ATOMIC_RELAXED, __HIP_MEMORY_SCOPE_AGENT); }
__device__ __forceinline__ unsigned xb_add(unsigned* p, unsigned v) { return __hip_atomic_fetch_add(p, v, __ATOMIC_RELAXED, __HIP_MEMORY_SCOPE_AGENT); }
__device__ __forceinline__ unsigned xb_xcc_id() { return (unsigned)__builtin_amdgcn_s_getreg((3 << 11) | 20) & 0xFu; }
#define XB_SPIN(cond, bar) do { unsigned _sp = 0; while (cond) { __builtin_amdgcn_s_sleep(1); \
    if ((++_sp & 255u) == 0u) { if (xb_ld(&(bar)[XB_TMO])) break; if (_sp > XB_SPIN_CAP) { atomicAdd(&(bar)[XB_TMO], 1u); break; } } } } while (0)
struct XcdBarrier { unsigned* bar; unsigned x; volatile LAS unsigned* st; int wave; };
__device__ __forceinline__ XcdBarrier xcd_barrier_post(unsigned* bar, volatile LAS unsigned* st, int wave) {
    XcdBarrier b; b.bar = bar; b.x = xb_xcc_id(); b.st = st; b.wave = wave;
    if (wave == 0 && lane_id() == 0) st[3] = xb_add(&bar[XB_XCNT(b.x)], 1u);
    return b;
}
__device__ __forceinline__ void xcd_barrier_complete(unsigned* bar, unsigned x, unsigned& nloc, unsigned& nx, unsigned& dx) {
    const unsigned G = gridDim.x * gridDim.y * gridDim.z;
    unsigned sum, cnt, mine, below, sp = 0u;
    for (;;) {
        sum = 0u; cnt = 0u; mine = 0u; below = 0u;
#pragma unroll
        for (unsigned j = 0; j < 16; ++j) { const unsigned c = xb_ld(&bar[XB_XCNT(j)]); sum += c; cnt += (c > 0u) ? 1u : 0u; mine = (j == x) ? c : mine; below += (j < x && c > 0u) ? 1u : 0u; }
        if (sum == G) break;
        __builtin_amdgcn_s_sleep(1);
        if ((++sp & 255u) == 0u) { if (xb_ld(&bar[XB_TMO])) break; if (sp > XB_SPIN_CAP) { atomicAdd(&bar[XB_TMO], 1u); break; } }
    }
    nloc = mine > 0u ? mine : 1u; nx = cnt > 0u ? cnt : 1u; dx = below;
}
__device__ __forceinline__ void xcd_barrier(const XcdBarrier& b) {
    asm volatile("s_waitcnt vmcnt(0)" ::: "memory");
    __syncthreads();
    if (b.wave == 0 && lane_id() == 0) {
        unsigned* bar = b.bar;
        __builtin_amdgcn_s_waitcnt(0);
        unsigned nloc = b.st[0], nx = b.st[1];
        if (nloc == 0u) { unsigned dx; xcd_barrier_complete(bar, b.x, nloc, nx, dx); b.st[0] = nloc; b.st[1] = nx; b.st[2] = dx; }
        const unsigned old = xb_add(&bar[XB_XSUB(b.x)], 1u);
        const unsigned gen = old / nloc;
        if (old + 1u == (gen + 1u) * nloc) {
            __builtin_amdgcn_fence(__ATOMIC_RELEASE, "agent");
            asm volatile("s_waitcnt vmcnt(0)" ::: "memory");
            const unsigned og = xb_add(&bar[XB_TOP], 1u);
            const unsigned target = (og / nx + 1u) * nx;
            if (og + 1u != target) XB_SPIN(xb_ld(&bar[XB_TOP]) < target, bar);
            __builtin_amdgcn_fence(__ATOMIC_ACQUIRE, "agent");
            xb_add(&bar[XB_XGEN(b.x)], 1u);
            asm volatile("s_waitcnt vmcnt(0)" ::: "memory");
        } else {
            XB_SPIN(xb_ld(&bar[XB_XGEN(b.x)]) == gen, bar);
            __builtin_amdgcn_fence(__ATOMIC_ACQUIRE, "agent");
            asm volatile("s_waitcnt vmcnt(0)" ::: "memory");
        }
    }
    __syncthreads();
}

namespace pg8 {
constexpr int BM = 256, BK = 64, HALF = 128, HTB = HALF * BK * 2, STAGE_BYTES = 8 * HTB, NXCD = 8, WGM = 8;
__device__ __forceinline__ int lds_byte(int r, int c) { const int st = (r >> 4) * 2 + (c >> 5), rr = r & 15, cc = c & 31, ob = rr * 64 + cc * 2; return st * 1024 + (ob ^ (((ob >> 9) & 1) << 5)); }
__device__ __forceinline__ void stage_rc(int b, int& R, int& C) { const int st = b / 1024, sb = b % 1024, swz = sb ^ (((sb >> 9) & 1) << 5); R = (st >> 1) * 16 + swz / 64; C = (st & 1) * 32 + (swz % 64) / 2; }
__device__ __forceinline__ int perm32(int rho) { const int n = rho >> 4, i = rho & 15; return 8 * (i >> 2) + 4 * n + (i & 3); }

struct Unit { int pm, pn, e; };

struct StaticOrder {
    static constexpr bool SIGNAL = false;
    int nM, nN, nwg, G, c;
    __device__ void init(int M, int N, int G_, int c_) { nM = M / BM; nN = N / BM; nwg = nM * nN; G = G_; c = c_; }
    __device__ __forceinline__ bool next(int i, Unit& u) const {
        const long L = (long)i * G + c; if (L >= nwg) return false;
        int wgid = (int)L; { const int q = nwg / NXCD, r = nwg % NXCD, xcd = wgid % NXCD, off = wgid / NXCD; wgid = (xcd < r ? xcd * (q + 1) : r * (q + 1) + (xcd - r) * q) + off; }
        const int nig = WGM * nN, gid = wgid / nig, fm = gid * WGM, gsz = (nM - fm) < WGM ? (nM - fm) : WGM;
        u.pm = __builtin_amdgcn_readfirstlane(fm + ((wgid % nig) % gsz)); u.pn = __builtin_amdgcn_readfirstlane((wgid % nig) / gsz); u.e = 0; return true;
    }
};
struct XcdOrder {
    static constexpr bool SIGNAL = true;
    int nx, dx, per, j, nM, nN; unsigned* flags;
    __device__ __forceinline__ bool next(int i, Unit& u) const {
        const int tlo = (dx * nM) / nx, thi = ((dx + 1) * nM) / nx, n = (thi - tlo) * nN;
        const int q = j + i * per; if (q >= n) return false;
        u.pm = __builtin_amdgcn_readfirstlane(tlo + q / nN); u.pn = __builtin_amdgcn_readfirstlane(q % nN); u.e = 0; return true;
    }
    __device__ __forceinline__ void signal(const Unit& u, int lane) const { asm volatile("s_waitcnt vmcnt(0)" ::: "memory"); if (lane == 0) (void)xb_add(flags + u.pm, 1u); }
};
template <bool WAIT>
struct MoeOrderT {
    static constexpr bool SIGNAL = false;
    int nx, dx, per, j, ntiles; const LAS int* ts; unsigned* flags;
    __device__ __forceinline__ bool next(int i, Unit& u) const {
        const int tlo = (dx * ntiles) / nx, thi = ((dx + 1) * ntiles) / nx, n = 4 * (thi - tlo);
        int jj = j; if (WAIT) { jj = j - (n % per); if (jj < 0) jj += per; }
        const int q = jj + i * per; if (q >= n) return false;
        const int tile = tlo + (q >> 2), pn = q & 3;
        int e = 0;
#pragma unroll
        for (int k = 1; k < 16; ++k) e += (tile >= ts[k]) ? 1 : 0;
        u.pm = __builtin_amdgcn_readfirstlane(tile); u.pn = __builtin_amdgcn_readfirstlane(pn); u.e = __builtin_amdgcn_readfirstlane(e);
        if (WAIT) { unsigned sp = 0u;
            while (xb_ld(flags + u.pm) < 32u) { __builtin_amdgcn_s_sleep(2); if (++sp > (1u << 22)) break; }
            asm volatile("" ::: "memory"); }
        return true;
    }
};
typedef MoeOrderT<false> MoeOrder;
typedef MoeOrderT<true> MoeOrderWait;

struct EpiBf16 {
    static constexpr bool PERM = true, HP = false, SIGNAL = false;
    bf16_t* O; int ldc; int s_lo, s_hi; float scale; float base;
    __device__ __forceinline__ void operator()(const f32x4 (&acc)[2][2][4][2], const Unit& u, int wr, int wc, int fr, int fq) const {
        const int row0 = u.pm * BM + wr * 64 + fr; const int col0 = u.pn * BM + wc * 32 + 8 * fq;
        const float sc = ((u.pn >= s_lo && u.pn < s_hi) ? scale : 1.0f) * base;
#pragma unroll
        for (int ai = 0; ai < 2; ++ai)
#pragma unroll
            for (int m = 0; m < 4; ++m) { bf16_t* rowp = O + (size_t)(row0 + ai * HALF + m * 16) * ldc + col0;
#pragma unroll
                for (int bj = 0; bj < 2; ++bj) { const f32x4 v0 = acc[ai][bj][m][0] * sc, v1 = acc[ai][bj][m][1] * sc;
                    u32x4 w; w.x = cvtpk(v0[0], v0[1]); w.y = cvtpk(v0[2], v0[3]); w.z = cvtpk(v1[0], v1[1]); w.w = cvtpk(v1[2], v1[3]);
                    *(u32x4*)(rowp + bj * HALF) = w; } }
    }
};
struct EpiSwiGLU {
    static constexpr bool PERM = true;
    bf16_t* O;
    __device__ __forceinline__ void operator()(const f32x4 (&acc)[2][2][4][2], const Unit& u, int wr, int wc, int fr, int fq) const {
        const int row0 = u.pm * BM + wr * 64 + fr; const int col0 = u.pn * 128 + wc * 32 + 8 * fq;
#pragma unroll
        for (int ai = 0; ai < 2; ++ai)
#pragma unroll
            for (int m = 0; m < 4; ++m) { bf16_t* rowp = O + (size_t)(row0 + ai * HALF + m * 16) * DEXP + col0;
                float a[8];
#pragma unroll
                for (int n = 0; n < 2; ++n)
#pragma unroll
                    for (int j = 0; j < 4; ++j) { const float g = acc[ai][0][m][n][j], up = acc[ai][1][m][n][j]; a[n * 4 + j] = g * up / (1.0f + __expf(-g)); }
                u32x4 w; w.x = cvtpk(a[0], a[1]); w.y = cvtpk(a[2], a[3]); w.z = cvtpk(a[4], a[5]); w.w = cvtpk(a[6], a[7]);
                *(u32x4*)rowp = w; }
    }
};
struct EpiResid {
    static constexpr bool PERM = false;
    const float* base; float* out; const float* gate;
    __device__ __forceinline__ void operator()(const f32x4 (&acc)[2][2][4][2], const Unit& u, int wr, int wc, int fr, int fq) const {
        const int row0 = u.pm * BM + wr * 64 + fr, col0 = u.pn * BM + wc * 32 + 4 * fq;
        const int b = (u.pm * BM) / SEQ;
        f32x4 gv[2][2];
#pragma unroll
        for (int bj = 0; bj < 2; ++bj)
#pragma unroll
            for (int n = 0; n < 2; ++n) gv[bj][n] = *(const f32x4*)(gate + (size_t)b * 6144 + col0 + bj * HALF + n * 16);
#pragma unroll
        for (int ai = 0; ai < 2; ++ai)
#pragma unroll
            for (int m = 0; m < 4; ++m) { const size_t off = (size_t)(row0 + ai * HALF + m * 16) * DM + col0;
#pragma unroll
                for (int bj = 0; bj < 2; ++bj)
#pragma unroll
                    for (int n = 0; n < 2; ++n) { const f32x4 bs = *(const f32x4*)(base + off + bj * HALF + n * 16);
                        *(f32x4*)(out + off + bj * HALF + n * 16) = bs + gv[bj][n] * acc[ai][bj][m][n]; }
                asm volatile("" ::: "memory"); }
    }
};

struct EpiProjI8 {
    static constexpr bool PERM = true, HP = false;
    bf16_t* O; const float* ra; const float* cw; float kscale;
    __device__ __forceinline__ void operator()(const f32x4 (&acc)[2][2][4][2], const Unit& u, int wr, int wc, int fr, int fq) const {
        const int row0 = u.pm * BM + wr * 64 + fr; const int col0 = u.pn * BM + wc * 32 + 8 * fq;
        const float ks = (u.pn >= 2 && u.pn < 4) ? kscale : 1.0f;
        f32x4 c0[2], c1[2];
#pragma unroll
        for (int bj = 0; bj < 2; ++bj) { c0[bj] = *(const f32x4*)(cw + col0 + bj * HALF) * ks; c1[bj] = *(const f32x4*)(cw + col0 + bj * HALF + 4) * ks; }
#pragma unroll
        for (int ai = 0; ai < 2; ++ai)
#pragma unroll
            for (int m = 0; m < 4; ++m) { const int row = row0 + ai * HALF + m * 16; const float rs = ra[row]; bf16_t* rowp = O + (size_t)row * 3072 + col0;
#pragma unroll
                for (int bj = 0; bj < 2; ++bj) { const f32x4 v0 = i2f4(acc[ai][bj][m][0]) * c0[bj] * rs, v1 = i2f4(acc[ai][bj][m][1]) * c1[bj] * rs;
                    u32x4 w; w.x = cvtpk(v0[0], v0[1]); w.y = cvtpk(v0[2], v0[3]); w.z = cvtpk(v1[0], v1[1]); w.w = cvtpk(v1[2], v1[3]);
                    *(u32x4*)(rowp + bj * HALF) = w; } }
    }
};
struct EpiFp8 {
    static constexpr bool PERM = true, HP = false, SIGNAL = false;
    unsigned char* O; int ldc; float scale;
    __device__ __forceinline__ void operator()(const f32x4 (&acc)[2][2][4][2], const Unit& u, int wr, int wc, int fr, int fq) const {
        const int row0 = u.pm * BM + wr * 64 + fr; const int col0 = u.pn * BM + wc * 32 + 8 * fq;
#pragma unroll
        for (int ai = 0; ai < 2; ++ai)
#pragma unroll
            for (int m = 0; m < 4; ++m) { unsigned char* rowp = O + (size_t)(row0 + ai * HALF + m * 16) * ldc + col0;
#pragma unroll
                for (int bj = 0; bj < 2; ++bj) { const f32x4 v0 = acc[ai][bj][m][0] * scale, v1 = acc[ai][bj][m][1] * scale;
                    u32x2 w; w.x = cvt4_fp8(v0[0], v0[1], v0[2], v0[3]); w.y = cvt4_fp8(v1[0], v1[1], v1[2], v1[3]);
                    *(u32x2*)(rowp + bj * HALF) = w; } }
    }
};
struct EpiQKV {
    static constexpr bool PERM = true, HP = true, SIGNAL = false;
    bf16_t* O; const float* qn; const float* kn; const float* cs; float descale; const LAS float* cst;
    __device__ __forceinline__ void operator()(const f32x4 (&acc)[2][2][4][2], const Unit& u, int wr, int wc, int fr, int fq) const {
        const int row0 = u.pm * BM + wr * 64 + fr; const int col0 = u.pn * BM + wc * 64 + 8 * fq;
        const bool isqk = u.pn < 8; const bool odd = (fq & 1) != 0;
        float w[2][2][4];
        if (isqk) { const float* nw = (u.pn < 4) ? qn : kn;
#pragma unroll
            for (int bj = 0; bj < 2; ++bj)
#pragma unroll
                for (int n = 0; n < 2; ++n) { const f32x4 t = *(const f32x4*)(nw + 32 * bj + 8 * fq + 4 * n); w[bj][n][0] = t[0]; w[bj][n][1] = t[1]; w[bj][n][2] = t[2]; w[bj][n][3] = t[3]; } }
        const float qs = (u.pn < 4) ? 0.125f * 1.4426950408889634f : 1.0f;
#pragma unroll
        for (int ai = 0; ai < 2; ++ai)
#pragma unroll
            for (int m = 0; m < 4; ++m) { const int row = row0 + ai * HALF + m * 16; bf16_t* rowp = O + (size_t)row * 3072 + col0;
                float v[2][2][4];
#pragma unroll
                for (int bj = 0; bj < 2; ++bj)
#pragma unroll
                    for (int n = 0; n < 2; ++n)
#pragma unroll
                        for (int j = 0; j < 4; ++j) v[bj][n][j] = acc[ai][bj][m][n][j] * descale;
                if (isqk) {
                    float ss = 0.f;
#pragma unroll
                    for (int bj = 0; bj < 2; ++bj)
#pragma unroll
                        for (int n = 0; n < 2; ++n)
#pragma unroll
                            for (int j = 0; j < 4; ++j) ss += v[bj][n][j] * v[bj][n][j];
                    ss += sx16p(ss, odd);
                    { auto rr = __builtin_amdgcn_permlane32_swap(__float_as_uint(ss), __float_as_uint(ss), false, false); ss = __uint_as_float(rr[0]) + __uint_as_float(rr[1]); }
                    const float rn = __builtin_amdgcn_rsqf(ss * (1.0f / 64.0f) + EPS);
#pragma unroll
                    for (int bj = 0; bj < 2; ++bj)
#pragma unroll
                        for (int n = 0; n < 2; ++n)
#pragma unroll
                            for (int j = 0; j < 4; ++j) v[bj][n][j] = v[bj][n][j] * rn * w[bj][n][j];
                    const LAS float* ct = cst + (row - u.pm * BM) * 16;
                    const f32x4 c0 = *(const LAS f32x4*)(ct), c1 = *(const LAS f32x4*)(ct + 4), s0 = *(const LAS f32x4*)(ct + 8), s1 = *(const LAS f32x4*)(ct + 12);
#pragma unroll
                    for (int n = 0; n < 2; ++n)
#pragma unroll
                        for (int j = 0; j < 4; ++j) { const float x = v[0][n][j]; const float pr = sx16p(x, odd); const float c = n ? c1[j] : c0[j], sn = n ? s1[j] : s0[j];
                            const float r0 = x * c - pr * sn, r1 = x * c + pr * sn; v[0][n][j] = (fq == 0) ? r0 : (fq == 1) ? r1 : x; }
#pragma unroll
                    for (int bj = 0; bj < 2; ++bj)
#pragma unroll
                        for (int n = 0; n < 2; ++n)
#pragma unroll
                            for (int j = 0; j < 4; ++j) v[bj][n][j] *= qs;
                }
#pragma unroll
                for (int bj = 0; bj < 2; ++bj) { u32x4 wv; wv.x = cvtpk(v[bj][0][0], v[bj][0][1]); wv.y = cvtpk(v[bj][0][2], v[bj][0][3]); wv.z = cvtpk(v[bj][1][0], v[bj][1][1]); wv.w = cvtpk(v[bj][1][2], v[bj][1][3]);
                    *(u32x4*)(rowp + 32 * bj) = wv; } }
    }
};
template <bool BASE_F32, bool I8 = false, bool STATIC_A = false> struct EpiResidB {
    static constexpr bool PERM = true, HP = false, SIGNAL = false;
    const void* base; bf16_t* out; const float* gate; float descale; const float* sc;
    __device__ __forceinline__ void operator()(const f32x4 (&acc)[2][2][4][2], const Unit& u, int wr, int wc, int fr, int fq) const {
        const int row0 = u.pm * BM + wr * 64 + fr, col0 = u.pn * BM + wc * 32 + 8 * fq;
        const int b = (u.pm * BM) / SEQ;
        const float* ra = sc + (SC_RS_A - WS_SCALES) / 4; const float* cw = sc + (SC_CW - WS_SCALES) / 4 + (STATIC_A ? CW_BOUT : CW_AOUT);
        f32x4 gv[2][2];
#pragma unroll
        for (int bj = 0; bj < 2; ++bj)
#pragma unroll
            for (int n = 0; n < 2; ++n) { gv[bj][n] = *(const f32x4*)(gate + (size_t)b * 6144 + col0 + bj * HALF + n * 4); if (!I8) gv[bj][n] = gv[bj][n] * descale; if (I8) gv[bj][n] = gv[bj][n] * *(const f32x4*)(cw + col0 + bj * HALF + n * 4); }
#pragma unroll
        for (int ai = 0; ai < 2; ++ai)
#pragma unroll
            for (int m = 0; m < 4; ++m) { const size_t off = (size_t)(row0 + ai * HALF + m * 16) * DM + col0; const float rs = !I8 ? 1.0f : STATIC_A ? descale : ra[row0 + ai * HALF + m * 16];
#pragma unroll
                for (int bj = 0; bj < 2; ++bj) { f32x4 b0, b1;
                    if (BASE_F32) { b0 = *(const f32x4*)((const float*)base + off + bj * HALF); b1 = *(const f32x4*)((const float*)base + off + bj * HALF + 4); }
                    else { const u32x4 r = *(const u32x4*)((const bf16_t*)base + off + bj * HALF); b0 = (f32x4){bflo(r.x), bfhi(r.x), bflo(r.y), bfhi(r.y)}; b1 = (f32x4){bflo(r.z), bfhi(r.z), bflo(r.w), bfhi(r.w)}; }
                    const f32x4 a0 = I8 ? i2f4(acc[ai][bj][m][0]) * rs : acc[ai][bj][m][0], a1 = I8 ? i2f4(acc[ai][bj][m][1]) * rs : acc[ai][bj][m][1];
                    const f32x4 v0 = b0 + gv[bj][0] * a0, v1 = b1 + gv[bj][1] * a1;
                    u32x4 w; w.x = cvtpk(v0[0], v0[1]); w.y = cvtpk(v0[2], v0[3]); w.z = cvtpk(v1[0], v1[1]); w.w = cvtpk(v1[2], v1[3]);
                    *(u32x4*)(out + off + bj * HALF) = w; }
                asm volatile("" ::: "memory"); }
    }
};
template <class Epi, class Sched, bool GATHER, bool I8 = false>
__device__ __forceinline__ void gemm_phase(LAS unsigned char* lds, int wv, const bf16_t* A, const bf16_t* Bt, size_t bstride, int K, const Sched& S, const Epi& E, const int* aidx) {
    int tid = wv * 64 + lane_id(); asm volatile("" : "+v"(tid));
    const int wid = wv, lane = tid & 63, wr = wid >> 2, wc = wid & 3, fr = lane & 15, fq = lane >> 4;
    const int nt = K / BK;
    int RA[2], CA[2]; unsigned voffB[2];
#pragma unroll
    for (int i = 0; i < 2; ++i) { int R, C; stage_rc(tid * 16 + i * 8192, R, C); const int Rb = Epi::PERM ? ((R & ~31) + perm32(R & 31)) : R;
        RA[i] = R; CA[i] = C; voffB[i] = (unsigned)(Rb * K + C) * 2u; }
    const size_t kstep = (size_t)(BK * 2);
    const size_t hstep = (size_t)HALF * K * 2;
    const size_t tstep = 2 * hstep;
    const unsigned ldsw = (unsigned)wid * 1024u;
    const int aoff = lds_byte(wr * 64 + fr, fq * 8), boff = lds_byte(wc * 32 + fr, fq * 8);
#define PG8_SA(b, h) (((b) * 2 + (h)) * HTB)
#define PG8_SB(b, h) ((4 + (b) * 2 + (h)) * HTB)
#define PG8_STAGE(bufoff, gbase, voff) do { _Pragma("unroll") for (int _i = 0; _i < 2; ++_i) \
        __builtin_amdgcn_global_load_lds((const unsigned*)((const char*)(gbase) + (voff)[_i]), (LAS unsigned*)(lds + (bufoff) + ldsw + _i * 8192), 16, 0, 0); } while (0)
#define PG8_LDA(dst, b, h) do { _Pragma("unroll") for (int m = 0; m < 4; ++m) _Pragma("unroll") for (int k = 0; k < 2; ++k) dst[m][k] = *(const LAS bf16x8*)(lds + PG8_SA(b, h) + aoff + m * 2048 + k * 1024); } while (0)
#define PG8_LDB(dst, b, h) do { _Pragma("unroll") for (int n = 0; n < 2; ++n) _Pragma("unroll") for (int k = 0; k < 2; ++k) dst[n][k] = *(const LAS bf16x8*)(lds + PG8_SB(b, h) + boff + n * 2048 + k * 1024); } while (0)
#define PG8_MMA(ai, bj, At, Bt_) do { __builtin_amdgcn_s_setprio(1); _Pragma("unroll") for (int m = 0; m < 4; ++m) _Pragma("unroll") for (int n = 0; n < 2; ++n) _Pragma("unroll") for (int k = 0; k < 2; ++k) { \
        if constexpr (I8) acc[ai][bj][m][n] = __builtin_bit_cast(f32x4, __builtin_amdgcn_mfma_i32_16x16x64_i8(__builtin_bit_cast(i32x4, Bt_[n][k]), __builtin_bit_cast(i32x4, At[m][k]), __builtin_bit_cast(i32x4, acc[ai][bj][m][n]), 0, 0, 0)); \
        else acc[ai][bj][m][n] = __builtin_amdgcn_mfma_f32_16x16x32_bf16(Bt_[n][k], At[m][k], acc[ai][bj][m][n], 0, 0, 0); } __builtin_amdgcn_s_setprio(0); } while (0)
#define PG8_WAIT_V(n) asm volatile("s_waitcnt vmcnt(" #n ")" ::: "memory")
#define PG8_WAIT_L(n) asm volatile("s_waitcnt lgkmcnt(" #n ")" ::: "memory")
#define PG8_BAR __builtin_amdgcn_s_barrier()
#define PG8_SCHED __builtin_amdgcn_sched_barrier(0)
#define PG8_AOFF(dst, U) do { _Pragma("unroll") for (int _h = 0; _h < 2; ++_h) _Pragma("unroll") for (int _i = 0; _i < 2; ++_i) { \
        const int _row = (U).pm * BM + _h * HALF + RA[_i]; const int _src = GATHER ? aidx[_row] : _row; dst[_h][_i] = (unsigned)(_src * K + CA[_i]) * 2u; } } while (0)
#define PG8_STAGE_A(bufoff, kb, offs, h) do { _Pragma("unroll") for (int _i = 0; _i < 2; ++_i) \
        __builtin_amdgcn_global_load_lds((const unsigned*)((const char*)A + (kb) + (offs)[h][_i]), (LAS unsigned*)(lds + (bufoff) + ldsw + _i * 8192), 16, 0, 0); } while (0)
    Unit cur, nxt; int ui = 0;
    if (!S.next(0, cur)) return;
    f32x4 acc[2][2][4][2];
#pragma unroll
    for (int a = 0; a < 2; ++a)
#pragma unroll
        for (int b = 0; b < 2; ++b)
#pragma unroll
            for (int m = 0; m < 4; ++m)
#pragma unroll
                for (int n = 0; n < 2; ++n) acc[a][b][m][n] = (f32x4){0.f, 0.f, 0.f, 0.f};
    bf16x8 At[4][2], B0[2][2], B1[2][2];
    unsigned ac[2][2], an[2][2];
    PG8_AOFF(ac, cur);
    const char* cB = (const char*)Bt + ((size_t)cur.e * bstride) * 2 + (size_t)cur.pn * tstep;
    PG8_STAGE(PG8_SB(0, 0), cB, voffB); PG8_STAGE(PG8_SB(0, 1), cB + hstep, voffB); PG8_STAGE_A(PG8_SA(0, 0), 0, ac, 0); PG8_STAGE_A(PG8_SA(0, 1), 0, ac, 1);
    if (wr == 1) PG8_BAR;
    PG8_WAIT_V(2); PG8_BAR;
    PG8_STAGE(PG8_SB(1, 0), cB + kstep, voffB); PG8_STAGE_A(PG8_SA(1, 0), kstep, ac, 0); PG8_STAGE(PG8_SB(1, 1), cB + hstep + kstep, voffB);
    PG8_WAIT_V(6); PG8_BAR;
    for (;;) {
        const bool has_next = S.next(ui + 1, nxt);
        if (has_next) { PG8_AOFF(an, nxt); } else {
#pragma unroll
            for (int h = 0; h < 2; ++h)
#pragma unroll
                for (int i = 0; i < 2; ++i) an[h][i] = ac[h][i]; }
        const char* nB = has_next ? (const char*)Bt + ((size_t)nxt.e * bstride) * 2 + (size_t)nxt.pn * tstep : cB;
#pragma unroll 1
        for (int t = 0; t < nt; t += 2) {
            const bool last = (t == nt - 2);
            const size_t k1 = (size_t)(t + 1) * kstep;
            const size_t k2 = last ? 0 : (size_t)(t + 2) * kstep;
            const size_t k3 = k2 + kstep;
            const char* b2 = last ? nB : cB + (size_t)(t + 2) * kstep; const char* b3 = b2 + kstep;
            unsigned a2[2][2];
#pragma unroll
            for (int h = 0; h < 2; ++h)
#pragma unroll
                for (int i = 0; i < 2; ++i) a2[h][i] = last ? an[h][i] : ac[h][i];
            PG8_LDB(B0, 0, 0); PG8_LDB(B1, 0, 1); PG8_SCHED; PG8_LDA(At, 0, 0); PG8_STAGE_A(PG8_SA(1, 1), k1, ac, 1);
            PG8_WAIT_V(8); PG8_WAIT_L(0); PG8_BAR; PG8_MMA(0, 0, At, B0); PG8_MMA(0, 1, At, B1); PG8_BAR; PG8_SCHED;
            PG8_LDA(At, 0, 1); PG8_STAGE(PG8_SB(0, 0), b2, voffB); PG8_STAGE(PG8_SB(0, 1), b2 + hstep, voffB); PG8_STAGE_A(PG8_SA(0, 0), k2, a2, 0);
            PG8_WAIT_V(8); PG8_WAIT_L(0); PG8_BAR; PG8_MMA(1, 0, At, B0); PG8_MMA(1, 1, At, B1); PG8_BAR; PG8_SCHED;
            PG8_LDB(B0, 1, 0); PG8_LDB(B1, 1, 1); PG8_SCHED; PG8_LDA(At, 1, 0); PG8_STAGE_A(PG8_SA(0, 1), k2, a2, 1);
            PG8_WAIT_V(8); PG8_WAIT_L(0); PG8_BAR; PG8_MMA(0, 0, At, B0); PG8_MMA(0, 1, At, B1); PG8_BAR; PG8_SCHED;
            PG8_LDA(At, 1, 1); PG8_STAGE(PG8_SB(1, 0), b3, voffB); PG8_STAGE(PG8_SB(1, 1), b3 + hstep, voffB); PG8_STAGE_A(PG8_SA(1, 0), k3, a2, 0);
            PG8_WAIT_V(8); PG8_WAIT_L(0); PG8_BAR; PG8_MMA(1, 0, At, B0); PG8_MMA(1, 1, At, B1); PG8_BAR; PG8_SCHED;
        }
        if (wr == 0) PG8_BAR;
        E(acc, cur, wr, wc, fr, fq);
        if constexpr (Sched::SIGNAL) S.signal(cur, lane);
        if (!has_next) break;
#pragma unroll
        for (int a = 0; a < 2; ++a)
#pragma unroll
            for (int b = 0; b < 2; ++b)
#pragma unroll
                for (int m = 0; m < 4; ++m)
#pragma unroll
                    for (int n = 0; n < 2; ++n) acc[a][b][m][n] = (f32x4){0.f, 0.f, 0.f, 0.f};
        cur = nxt; cB = nB; ++ui;
#pragma unroll
        for (int h = 0; h < 2; ++h)
#pragma unroll
            for (int i = 0; i < 2; ++i) ac[h][i] = an[h][i];
        if (wr == 1) PG8_BAR;
    }
    PG8_WAIT_V(0);
    PG8_BAR;
#undef PG8_SA
#undef PG8_SB
#undef PG8_STAGE
#undef PG8_LDA
#undef PG8_LDB
#undef PG8_MMA
#undef PG8_WAIT_V
#undef PG8_WAIT_L
#undef PG8_BAR
#undef PG8_SCHED
#undef PG8_AOFF
#undef PG8_STAGE_A
}

__device__ __forceinline__ int x8(int e) { return e ^ ((((e >> 1) ^ (e >> 2)) & 1) << 1); }
struct EpiSwiGLU8 {
    static constexpr bool PERM = true, HP = false, SIGNAL = true;
    unsigned char* O; float descale; unsigned* flags;
    __device__ __forceinline__ void operator()(const f32x4 (&acc)[2][2][4][2], const Unit& u, int wr, int wc, int fr, int fq) const {
        const int row0 = u.pm * BM + wr * 64 + fr; const int col0 = u.pn * 128 + wc * 32 + 8 * fq;
#pragma unroll
        for (int ai = 0; ai < 2; ++ai)
#pragma unroll
            for (int m = 0; m < 4; ++m) { unsigned char* rowp = O + (size_t)(row0 + ai * HALF + m * 16) * DEXP + col0;
                float a[8];
#pragma unroll
                for (int n = 0; n < 2; ++n)
#pragma unroll
                    for (int j = 0; j < 4; ++j) { const float g = acc[ai][0][m][n][j] * descale, up = acc[ai][1][m][n][j] * descale; a[n * 4 + j] = S8_ACT * g * up * __builtin_amdgcn_rcpf(1.0f + __expf(-g)); }
                u32x2 w; w.x = cvt4_fp8(a[0], a[1], a[2], a[3]); w.y = cvt4_fp8(a[4], a[5], a[6], a[7]);
                *(u32x2*)rowp = w; }
    }
};
template <class Epi, class Sched, bool GATHER>
__device__ __forceinline__ void gemm_phase8(LAS unsigned char* lds, int wv, const unsigned char* A, const unsigned char* Bt, size_t bstride, int Kb, const Sched& S, const Epi& E, const int* aidx) {
    int tid = wv * 64 + lane_id(); asm volatile("" : "+v"(tid));
    const int wid = wv, lane = tid & 63, wr = wid >> 2, wc = wid & 3, fr = lane & 15, fq = lane >> 4;
    const int nt = Kb / 128;
    int RA[2], CA[2]; unsigned voffB[2], voffB1[2];
#pragma unroll
    for (int i = 0; i < 2; ++i) { const int b = tid * 16 + i * 8192; const int R = b >> 7, pc = (b >> 4) & 7; const int C = (pc ^ x8((R >> 1) & 7)) * 16;
        const int Rb = Epi::PERM ? ((R & ~31) + perm32(R & 31)) : R;
        RA[i] = R; CA[i] = C;
        if (Epi::HP) { const int g0 = 64 * (R >> 5) + perm32(R & 31); voffB[i] = (unsigned)(g0 * Kb + C); voffB1[i] = (unsigned)((g0 + 32) * Kb + C); }
        else { voffB[i] = (unsigned)(Rb * Kb + C); voffB1[i] = voffB[i] + (unsigned)(HALF * Kb); } }
    const size_t kstep = 128;
    const size_t hstep = (size_t)HALF * Kb;
    const size_t tstep = 2 * hstep;
    const unsigned ldsw = (unsigned)wid * 1024u;
    const int xa = x8((fr >> 1) & 7);
    const int aoff = (wr * 64 + fr) * 128 + (((2 * fq) ^ xa) << 4), boff = (wc * 32 + fr) * 128 + (((2 * fq) ^ xa) << 4);
    const int aoff1 = aoff ^ 16, boff1 = boff ^ 16;
#define PG8_SA(b, h) (((b) * 2 + (h)) * HTB)
#define PG8_SB(b, h) ((4 + (b) * 2 + (h)) * HTB)
#define PG8_STAGE(bufoff, gbase, voff) do { _Pragma("unroll") for (int _i = 0; _i < 2; ++_i) \
        __builtin_amdgcn_global_load_lds((const unsigned*)((const char*)(gbase) + (voff)[_i]), (LAS unsigned*)(lds + (bufoff) + ldsw + _i * 8192), 16, 0, 0); } while (0)
#define PG8_RD32(dst, off, off1) do { const u32x4 _lo = *(const LAS u32x4*)(lds + (off)), _hi = *(const LAS u32x4*)(lds + (off1)); \
        dst = (i32x8){(int)_lo.x, (int)_lo.y, (int)_lo.z, (int)_lo.w, (int)_hi.x, (int)_hi.y, (int)_hi.z, (int)_hi.w}; } while (0)
#define PG8_LDA(dst, b, h) do { _Pragma("unroll") for (int m = 0; m < 4; ++m) PG8_RD32(dst[m], PG8_SA(b, h) + aoff + m * 2048, PG8_SA(b, h) + aoff1 + m * 2048); } while (0)
#define PG8_LDB(dst, b, h) do { _Pragma("unroll") for (int n = 0; n < 2; ++n) PG8_RD32(dst[n], PG8_SB(b, h) + boff + n * 2048, PG8_SB(b, h) + boff1 + n * 2048); } while (0)
#define PG8_MMA(ai, bj, At, Bt_) do { __builtin_amdgcn_s_setprio(1); _Pragma("unroll") for (int m = 0; m < 4; ++m) _Pragma("unroll") for (int n = 0; n < 2; ++n) \
        asm volatile("v_mfma_scale_f32_16x16x128_f8f6f4 %0, %1, %2, %0, %3, %3 op_sel_hi:[0,0,0]" : "+v"(acc[ai][bj][m][n]) : "v"(Bt_[n]), "v"(At[m]), "v"(sc1)); __builtin_amdgcn_s_setprio(0); } while (0)
#define PG8_WAIT_V(n) asm volatile("s_waitcnt vmcnt(" #n ")" ::: "memory")
#define PG8_WAIT_L(n) asm volatile("s_waitcnt lgkmcnt(" #n ")" ::: "memory")
#define PG8_BAR __builtin_amdgcn_s_barrier()
#define PG8_SCHED __builtin_amdgcn_sched_barrier(0)
#define PG8_AOFF(dst, U) do { _Pragma("unroll") for (int _h = 0; _h < 2; ++_h) _Pragma("unroll") for (int _i = 0; _i < 2; ++_i) { \
        const int _row = (U).pm * BM + _h * HALF + RA[_i]; const int _src = GATHER ? aidx[_row] : _row; dst[_h][_i] = (unsigned)(_src * Kb + CA[_i]); } } while (0)
#define PG8_STAGE_A(bufoff, kb, offs, h) do { _Pragma("unroll") for (int _i = 0; _i < 2; ++_i) \
        __builtin_amdgcn_global_load_lds((const unsigned*)((const char*)A + (kb) + (offs)[h][_i]), (LAS unsigned*)(lds + (bufoff) + ldsw + _i * 8192), 16, 0, 0); } while (0)
    Unit cur, nxt; int ui = 0;
    if (!S.next(0, cur)) return;
    f32x4 acc[2][2][4][2];
#pragma unroll
    for (int a = 0; a < 2; ++a)
#pragma unroll
        for (int b = 0; b < 2; ++b)
#pragma unroll
            for (int m = 0; m < 4; ++m)
#pragma unroll
                for (int n = 0; n < 2; ++n) acc[a][b][m][n] = (f32x4){0.f, 0.f, 0.f, 0.f};
    i32x8 At[4], B0[2], B1[2];
    int sc1 = 0x7F7F7F7F; asm volatile("" : "+v"(sc1));
    unsigned ac[2][2], an[2][2];
    PG8_AOFF(ac, cur);
    const char* cB = (const char*)Bt + (size_t)cur.e * bstride + (size_t)cur.pn * tstep;
    PG8_STAGE(PG8_SB(0, 0), cB, voffB); PG8_STAGE(PG8_SB(0, 1), cB, voffB1); PG8_STAGE_A(PG8_SA(0, 0), 0, ac, 0); PG8_STAGE_A(PG8_SA(0, 1), 0, ac, 1);
    if (wr == 1) PG8_BAR;
    PG8_WAIT_V(2); PG8_BAR;
    PG8_STAGE(PG8_SB(1, 0), cB + kstep, voffB); PG8_STAGE_A(PG8_SA(1, 0), kstep, ac, 0); PG8_STAGE(PG8_SB(1, 1), cB + kstep, voffB1);
    PG8_WAIT_V(6); PG8_BAR;
    for (;;) {
        const bool has_next = S.next(ui + 1, nxt);
        if (has_next) { PG8_AOFF(an, nxt); } else {
#pragma unroll
            for (int h = 0; h < 2; ++h)
#pragma unroll
                for (int i = 0; i < 2; ++i) an[h][i] = ac[h][i]; }
        const char* nB = has_next ? (const char*)Bt + (size_t)nxt.e * bstride + (size_t)nxt.pn * tstep : cB;
#pragma unroll 1
        for (int t = 0; t < nt; t += 2) {
            const bool last = (t == nt - 2);
            const size_t k1 = (size_t)(t + 1) * kstep;
            const size_t k2 = last ? 0 : (size_t)(t + 2) * kstep;
            const size_t k3 = k2 + kstep;
            const char* b2 = last ? nB : cB + (size_t)(t + 2) * kstep; const char* b3 = b2 + kstep;
            unsigned a2[2][2];
#pragma unroll
            for (int h = 0; h < 2; ++h)
#pragma unroll
                for (int i = 0; i < 2; ++i) a2[h][i] = last ? an[h][i] : ac[h][i];
            PG8_LDB(B0, 0, 0); PG8_LDB(B1, 0, 1); PG8_SCHED; PG8_LDA(At, 0, 0); PG8_STAGE_A(PG8_SA(1, 1), k1, ac, 1);
            PG8_WAIT_V(8); PG8_WAIT_L(0); PG8_BAR;
            if constexpr (Epi::HP) { if (t == 0 && cur.pn < 8) {
                const char* cb_ = (const char*)(E.cs + (size_t)cur.pm * BM * 16) + wid * 1024; int l16_ = lane_id() * 16; asm volatile("" : "+v"(l16_));
#pragma unroll
                for (int k_ = 0; k_ < 2; ++k_) __builtin_amdgcn_global_load_lds((const unsigned*)(cb_ + k_ * 8192 + l16_), (LAS unsigned*)(lds + TAB_OFF + k_ * 8192 + wid * 1024), 16, 0, 0); } }
            PG8_MMA(0, 0, At, B0); PG8_MMA(0, 1, At, B1); PG8_BAR; PG8_SCHED;
            PG8_LDA(At, 0, 1); PG8_STAGE(PG8_SB(0, 0), b2, voffB); PG8_STAGE(PG8_SB(0, 1), b2, voffB1); PG8_STAGE_A(PG8_SA(0, 0), k2, a2, 0);
            PG8_WAIT_V(8); PG8_WAIT_L(0); PG8_BAR; PG8_MMA(1, 0, At, B0); PG8_MMA(1, 1, At, B1); PG8_BAR; PG8_SCHED;
            PG8_LDB(B0, 1, 0); PG8_LDB(B1, 1, 1); PG8_SCHED; PG8_LDA(At, 1, 0); PG8_STAGE_A(PG8_SA(0, 1), k2, a2, 1);
            PG8_WAIT_V(8); PG8_WAIT_L(0); PG8_BAR; PG8_MMA(0, 0, At, B0); PG8_MMA(0, 1, At, B1); PG8_BAR; PG8_SCHED;
            PG8_LDA(At, 1, 1); PG8_STAGE(PG8_SB(1, 0), b3, voffB); PG8_STAGE(PG8_SB(1, 1), b3, voffB1); PG8_STAGE_A(PG8_SA(1, 0), k3, a2, 0);
            PG8_WAIT_V(8); PG8_WAIT_L(0); PG8_BAR; PG8_MMA(1, 0, At, B0); PG8_MMA(1, 1, At, B1); PG8_BAR; PG8_SCHED;
        }
        if (wr == 0) PG8_BAR;
        asm volatile("s_nop 15\n\ts_nop 15" ::: "memory");
        E(acc, cur, wr, wc, fr, fq);
        if constexpr (Epi::SIGNAL) { asm volatile("s_waitcnt vmcnt(0)" ::: "memory"); if (lane == 0) (void)xb_add(E.flags + cur.pm, 1u); }
        if (!has_next) break;
#pragma unroll
        for (int a = 0; a < 2; ++a)
#pragma unroll
            for (int b = 0; b < 2; ++b)
#pragma unroll
                for (int m = 0; m < 4; ++m)
#pragma unroll
                    for (int n = 0; n < 2; ++n) acc[a][b][m][n] = (f32x4){0.f, 0.f, 0.f, 0.f};
        cur = nxt; cB = nB; ++ui;
#pragma unroll
        for (int h = 0; h < 2; ++h)
#pragma unroll
            for (int i = 0; i < 2; ++i) ac[h][i] = an[h][i];
        if (wr == 1) PG8_BAR;
    }
    PG8_WAIT_V(0);
    PG8_BAR;
#undef PG8_SA
#undef PG8_SB
#undef PG8_STAGE
#undef PG8_RD32
#undef PG8_LDA
#undef PG8_LDB
#undef PG8_MMA
#undef PG8_WAIT_V
#undef PG8_WAIT_L
#undef PG8_BAR
#undef PG8_SCHED
#undef PG8_AOFF
#undef PG8_STAGE_A
}
}

namespace attn_body {
using bf16 = __hip_bfloat16;
using f32x16 = __attribute__((ext_vector_type(16))) float;
constexpr int D = 64, PQ = 3072, PO = 2048;
constexpr int NW = 8, QBLK = 32, QB = QBLK * NW, KVBLK = 64, NQB = SEQ / QB;
__device__ __forceinline__ int crow(int r, int hi) { return (r & 3) + 8 * (r >> 2) + 4 * hi; }
#define SBAR() __builtin_amdgcn_sched_barrier(0)
__device__ __forceinline__ void cmask(f32x16& p0, f32x16& p1, int jb, int qrel, int hi) {
    const float NEG = -INFINITY; int kb = 64 * jb + 4 * hi;
#pragma unroll
    for (int r = 0; r < 16; ++r) { int kv = kb + (r & 3) + 8 * (r >> 2); if (kv > qrel) p0[r] = NEG; if (kv + 32 > qrel) p1[r] = NEG; }
}
constexpr int NSLOT = 3, SLOTB = 8192;
constexpr int LDS_K = 0, LDS_V = NSLOT * SLOTB, LDS_WS = 2 * NSLOT * SLOTB, LDS_OST = LDS_WS + NW * 64 * 4, ATT_LDS_BYTES = LDS_OST + NW * 4096;
__device__ __forceinline__ void glds16(const void* gsrc, unsigned lds_dst) { unsigned keep;
    asm volatile("s_mov_b32 %0, m0\n\ts_mov_b32 m0, %2\n\ts_nop 0\n\tglobal_load_lds_dwordx4 %1, off\n\ts_mov_b32 m0, %0" : "=&s"(keep) : "v"(gsrc), "s"(lds_dst) : "memory"); }
__device__ __forceinline__ float max3f(float a, float b, float c) { float r; asm("v_max3_f32 %0, %1, %2, %3" : "=v"(r) : "v"(a), "v"(b), "v"(c)); return r; }
__device__ __forceinline__ float max2f(float a, float b) { float r; asm("v_max_f32_e32 %0, %1, %2" : "=v"(r) : "v"(a), "v"(b)); return r; }
__device__ __forceinline__ float fadd_s(float a, float b) { float r; asm("v_add_f32_e32 %0, %1, %2" : "=v"(r) : "v"(a), "v"(b)); return r; }
__device__ __forceinline__ float fsub_s(float a, float b) { float r; asm("v_sub_f32_e32 %0, %1, %2" : "=v"(r) : "v"(a), "v"(b)); return r; }
__device__ __forceinline__ unsigned cvtpk_s(float lo, float hi) { f32x2 v = {lo, hi}; bf16x2_t b = __builtin_convertvector(v, bf16x2_t); return __builtin_bit_cast(unsigned, b); }
#define WAIT_BAR(N) asm volatile("s_waitcnt vmcnt(" #N ") lgkmcnt(0)\n\ts_barrier" ::: "memory")
__device__ __forceinline__ void qkt(f32x16& p0, f32x16& p1, const char* Kslot, const bf16x8* qr, const f32x16& negm, int r32, int hi) {
    const char* kb = Kslot + hi * 1024 + r32 * 16;
#pragma unroll
    for (int d0 = 0; d0 < 4; ++d0) {
        const bf16x8 b0 = *reinterpret_cast<const bf16x8*>(kb + d0 * 2048);
        const bf16x8 b1 = *reinterpret_cast<const bf16x8*>(kb + d0 * 2048 + 512);
        if (d0 == 0) { p0 = __builtin_amdgcn_mfma_f32_32x32x16_bf16(b0, qr[0], negm, 0, 0, 0); p1 = __builtin_amdgcn_mfma_f32_32x32x16_bf16(b1, qr[0], negm, 0, 0, 0); }
        else { p0 = __builtin_amdgcn_mfma_f32_32x32x16_bf16(b0, qr[d0], p0, 0, 0, 0); p1 = __builtin_amdgcn_mfma_f32_32x32x16_bf16(b1, qr[d0], p1, 0, 0, 0); } }
}
typedef __attribute__((address_space(3))) const char* lds_cptr;
typedef short v4i16_t __attribute__((ext_vector_type(4)));
__device__ __forceinline__ void kload8(bf16x8* kf, lds_cptr kp) {
    kf[0] = *(const LAS bf16x8*)(kp);        kf[1] = *(const LAS bf16x8*)(kp + 512);
    kf[2] = *(const LAS bf16x8*)(kp + 2048); kf[3] = *(const LAS bf16x8*)(kp + 2560);
    kf[4] = *(const LAS bf16x8*)(kp + 4096); kf[5] = *(const LAS bf16x8*)(kp + 4608);
    kf[6] = *(const LAS bf16x8*)(kp + 6144); kf[7] = *(const LAS bf16x8*)(kp + 6656);
}
__device__ __forceinline__ void kload2(bf16x8* kf, lds_cptr kp, int j) { kf[2 * j] = *(const LAS bf16x8*)(kp + j * 2048); kf[2 * j + 1] = *(const LAS bf16x8*)(kp + j * 2048 + 512); }
__device__ __forceinline__ s16x4 vtr(lds_cptr p) { return __builtin_bit_cast(s16x4, __builtin_amdgcn_ds_read_tr16_b64_v4i16((LAS v4i16_t*)p)); }
__device__ __forceinline__ float rowmax(const f32x16& p0, const f32x16& p1) {
    float a = max3f(p0[0], p0[1], p1[0]), b = max3f(p0[2], p0[3], p1[1]); a = max3f(a, p1[2], p1[3]);
#pragma unroll
    for (int r = 4; r < 16; r += 4) { a = max3f(a, p0[r], p0[r + 1]); b = max3f(b, p0[r + 2], p0[r + 3]); a = max3f(a, p1[r], p1[r + 1]); b = max3f(b, p1[r + 2], p1[r + 3]); }
    const float m = max2f(a, b);
    auto rr = __builtin_amdgcn_permlane32_swap(__float_as_uint(m), __float_as_uint(m), false, false);
    return max2f(__uint_as_float(rr[0]), __uint_as_float(rr[1]));
}
__device__ __forceinline__ void pv(f32x16* o, int vb, bf16x8 pa0, bf16x8 pa1, bf16x8 pa2, bf16x8 pa3) {
#pragma unroll
    for (int d0 = 0; d0 < 2; ++d0) { s16x4 lo[4], hi[4];
#pragma unroll
        for (int ks = 0; ks < 4; ++ks) {
            asm volatile("ds_read_b64_tr_b16 %0,%1 offset:%c2" : "=&v"(lo[ks]) : "v"(vb), "i"(d0 * 4096 + ks * 1024) : "memory");
            asm volatile("ds_read_b64_tr_b16 %0,%1 offset:%c2" : "=&v"(hi[ks]) : "v"(vb), "i"(d0 * 4096 + ks * 1024 + 512) : "memory"); }
        asm volatile("s_waitcnt lgkmcnt(0)" ::: "memory"); SBAR();
#define PK(k) (bf16x8){lo[k][0], lo[k][1], lo[k][2], lo[k][3], hi[k][0], hi[k][1], hi[k][2], hi[k][3]}
        o[d0] = __builtin_amdgcn_mfma_f32_32x32x16_bf16(pa0, PK(0), o[d0], 0, 0, 0);
        o[d0] = __builtin_amdgcn_mfma_f32_32x32x16_bf16(pa1, PK(1), o[d0], 0, 0, 0);
        o[d0] = __builtin_amdgcn_mfma_f32_32x32x16_bf16(pa2, PK(2), o[d0], 0, 0, 0);
        o[d0] = __builtin_amdgcn_mfma_f32_32x32x16_bf16(pa3, PK(3), o[d0], 0, 0, 0);
#undef PK
    }
}
#define ATTN_STORE16(p, v) (*(u32x4*)(p) = (v))
template <int THRL> __device__ __forceinline__ void attn_unit(int wv, int pair, int qb, const bf16* Pb, bf16* Obuf, char* shm) {
    const int b = pair >> 5, v5 = pair & 31, hc = v5 >> 1; const int qc = hc * 64, kc = 1024 + hc * 64, vc = 2048 + (v5 >> 2) * 128 + (v5 & 1) * 64, oc = v5 * 64;
    int tid = wv * 64 + lane_id(); asm volatile("" : "+v"(tid));
    const int lane = tid & 63, r32 = lane & 31, hi = lane >> 5; const int wid = wv;
    const long rowbase = (long)b * SEQ; const int q0 = qb * QB;
    const bf16* Qw = Pb + (rowbase + q0 + wid * QBLK) * PQ + qc;
    const bf16* Kh = Pb + rowbase * PQ + kc, *Vh = Pb + rowbase * PQ + vc;
    const unsigned lds0 = (unsigned)(uintptr_t)shm;
    float* wsf = (float*)(shm + LDS_WS) + wid * 64;
    const bf16* ksrc = Kh + (long)lane * PQ + wid * 8;
    const bf16* vsrc = Vh + (long)(16 * (wid & 3) + (lane >> 2)) * PQ + (wid >> 2) * 32 + (lane & 3) * 8;
    const unsigned kdst = lds0 + LDS_K + wid * 1024, vdst = lds0 + LDS_V + wid * 1024;
#define DMA_K(t, slot) glds16(ksrc + (long)(t) * KVBLK * PQ, (unsigned)__builtin_amdgcn_readfirstlane(kdst + (slot)))
#define DMA_V(t, slot) glds16(vsrc + (long)(t) * KVBLK * PQ, (unsigned)__builtin_amdgcn_readfirstlane(vdst + (slot)))
    const int vb0 = (int)(lds0 + LDS_V) + ((lane >> 4) & 1) * 32 + (lane & 3) * 8 + (4 * hi + ((lane & 15) >> 2)) * 64;
    const char* Kbase = shm + LDS_K; bf16x8 kf[8];
    const lds_cptr shm3 = (lds_cptr)shm; const lds_cptr kp0 = shm3 + LDS_K + hi * 1024 + r32 * 16; const lds_cptr vp0 = shm3 + LDS_V + ((lane >> 4) & 1) * 32 + (lane & 3) * 8 + (4 * hi + ((lane & 15) >> 2)) * 64;
    const int NT = (q0 + QB) / KVBLK;
    DMA_K(0, 0); DMA_V(0, 0); DMA_K(1, SLOTB);
    bf16x8 qr[4];
#pragma unroll
    for (int d0 = 0; d0 < 4; ++d0) qr[d0] = *reinterpret_cast<const bf16x8*>(&Qw[(long)r32 * PQ + d0 * 16 + hi * 8]);
    float mhat = 0.f, l_reg = 0.f; f32x16 o[2]; o[0] = f32x16{}; o[1] = f32x16{}; f32x16 negm = f32x16{}; asm volatile("" : "+v"(negm));
    const int qrel = wid * QBLK + r32;
#define CMASK(P0, P1, t) do { int jb_ = (t) - (NT - 4); if (jb_ >= 0) cmask(P0, P1, jb_, qrel, hi); } while (0)
    bool resc = false;
#define START(P0, P1) do { const float rm = rowmax(P0, P1); resc = false; \
    { const float dl = rm; mhat = fadd_s(mhat, dl); \
      _Pragma("unroll") for (int r = 0; r < 16; ++r) { P0[r] = fsub_s(P0[r], dl); P1[r] = fsub_s(P1[r], dl); } \
      _Pragma("unroll") for (int r = 0; r < 16; ++r) negm[r] = -mhat; asm volatile("" : "+v"(negm)); } \
    _Pragma("unroll") for (int r = 0; r < 16; ++r) P0[r] = __builtin_amdgcn_exp2f(P0[r]); } while (0)
#define RESC() do { if (resc) { asm volatile("s_waitcnt lgkmcnt(0)" ::: "memory"); \
      _Pragma("unroll") for (int d_ = 0; d_ < 2; ++d_) _Pragma("unroll") for (int r = 0; r < 16; ++r) o[d_][r] *= wsf[crow(r, hi)]; } } while (0)
    f32x16 pA0, pA1, pB0, pB1;
    int sl_prev = 0, sl_cur = 0, sl_next = SLOTB;
#define ROT() do { sl_prev = sl_cur; sl_cur = sl_next; sl_next = (sl_next == (NSLOT - 1) * SLOTB) ? 0 : sl_next + SLOTB; } while (0)
    DMA_K(2, 2 * SLOTB);
    WAIT_BAR(3);
    qkt(pA0, pA1, Kbase, qr, negm, r32, hi); asm volatile("s_nop 15\n\ts_nop 7" : "+v"(pA0), "+v"(pA1)); CMASK(pA0, pA1, 0);
    START(pA0, pA1);
    _Pragma("unroll") for (int r = 0; r < 16; ++r) pA1[r] = __builtin_amdgcn_exp2f(pA1[r]);
    WAIT_BAR(0);
    DMA_K(3, 0); DMA_V(1, SLOTB);
    ROT();
    kload8(kf, kp0 + sl_cur);
    WAIT_BAR(2);
    s16x4 vlo[8], vhi[8]; u32x4 pw0, pw1, pw2, pw3;
#define PKW(P, B) cvtpk_s(P[B], P[B + 1])
#define PAF(k) __builtin_bit_cast(bf16x8, pw##k)
#define VFR(i) (bf16x8){vlo[i][0], vlo[i][1], vlo[i][2], vlo[i][3], vhi[i][0], vhi[i][1], vhi[i][2], vhi[i][3]}
#define PIN(x) asm volatile("" : "+v"(x))
#define MX3(a, b, c) __builtin_fmaxf(__builtin_fmaxf((a), (b)), (c))
#define GAPA(MF, A0, A1, A2, A3, W0, W1, PW) do { MF; sacc += A0; sacc += A1; sacc += A2; sacc += A3; PIN(sacc); W0; W1; PIN(PW); SBAR(); } while (0)
#define EX(v) __builtin_amdgcn_exp2f(v)
#define GAPB(MF, X, B) do { MF; X[B] = EX(X[B]); X[B + 1] = EX(X[B + 1]); X[B + 2] = EX(X[B + 2]); X[B + 3] = EX(X[B + 3]); PIN(X); SBAR(); } while (0)
#define VRD(i) do { vlo[i] = vtr(vp_ + (((i) >> 2) * 4096 + ((i) & 3) * 1024)); vhi[i] = vtr(vp_ + (((i) >> 2) * 4096 + ((i) & 3) * 1024 + 512)); } while (0)
#define KRD(G, j) do { if (G) { kload2(kf, kp0 + sl_next, j); SBAR(); } } while (0)
#define STEP(C0, C1, P0, P1, t, GK, GV, GL) do { SBAR(); \
    const lds_cptr vp_ = vp0 + sl_prev; \
    VRD(0); SBAR(); float sacc = (P0[0] + P0[1]); \
    GAPA(C0 = __builtin_amdgcn_mfma_f32_32x32x16_bf16(kf[0], qr[0], negm, 0, 0, 0), P0[2], P0[3], P0[4], P0[5],     pw0[0] = PKW(P0, 0), pw0[1] = PKW(P0, 2), pw0); \
    VRD(4); SBAR(); GAPA(C1 = __builtin_amdgcn_mfma_f32_32x32x16_bf16(kf[1], qr[0], negm, 0, 0, 0), P0[6], P0[7], P0[8], P0[9],     pw0[2] = PKW(P0, 4), pw0[3] = PKW(P0, 6), pw0); \
    VRD(1); SBAR(); GAPA(C0 = __builtin_amdgcn_mfma_f32_32x32x16_bf16(kf[2], qr[1], C0, 0, 0, 0),   P0[10], P0[11], P0[12], P0[13], pw1[0] = PKW(P0, 8), pw1[1] = PKW(P0, 10), pw1); \
    VRD(5); SBAR(); GAPA(C1 = __builtin_amdgcn_mfma_f32_32x32x16_bf16(kf[3], qr[1], C1, 0, 0, 0),   P0[14], P0[15], P1[0], P1[1],   pw1[2] = PKW(P0, 12), pw1[3] = PKW(P0, 14), pw1); \
    VRD(2); SBAR(); GAPA(C0 = __builtin_amdgcn_mfma_f32_32x32x16_bf16(kf[4], qr[2], C0, 0, 0, 0),   P1[2], P1[3], P1[4], P1[5],     pw2[0] = PKW(P1, 0), pw2[1] = PKW(P1, 2), pw2); \
    VRD(6); SBAR(); GAPA(C1 = __builtin_amdgcn_mfma_f32_32x32x16_bf16(kf[5], qr[2], C1, 0, 0, 0),   P1[6], P1[7], P1[8], P1[9],     pw2[2] = PKW(P1, 4), pw2[3] = PKW(P1, 6), pw2); \
    VRD(3); SBAR(); GAPA(C0 = __builtin_amdgcn_mfma_f32_32x32x16_bf16(kf[6], qr[3], C0, 0, 0, 0),   P1[10], P1[11], P1[12], P1[13], pw3[0] = PKW(P1, 8), pw3[1] = PKW(P1, 10), pw3); \
    VRD(7); SBAR(); GAPA(C1 = __builtin_amdgcn_mfma_f32_32x32x16_bf16(kf[7], qr[3], C1, 0, 0, 0),   P1[14], P1[15], 0.f, 0.f,       pw3[2] = PKW(P1, 12), pw3[3] = PKW(P1, 14), pw3); \
    l_reg += sacc; \
    if (GK) { DMA_K((t) + 3, sl_cur); } if (GV) { DMA_V((t) + 1, sl_next); } \
    CMASK(C0, C1, t); \
    { float a = MX3(C0[0], C0[1], C1[0]), b = MX3(C0[2], C0[3], C1[1]); a = MX3(a, C1[2], C1[3]); \
      _Pragma("unroll") for (int r = 4; r < 16; r += 4) { a = MX3(a, C0[r], C0[r + 1]); b = MX3(b, C0[r + 2], C0[r + 3]); a = MX3(a, C1[r], C1[r + 1]); b = MX3(b, C1[r + 2], C1[r + 3]); } \
      float rm = __builtin_fmaxf(a, b); { auto rr = __builtin_amdgcn_permlane32_swap(__float_as_uint(rm), __float_as_uint(rm), false, false); rm = __builtin_fmaxf(__uint_as_float(rr[0]), __uint_as_float(rr[1])); } \
      resc = false; \
      if (__builtin_expect(__any(rm > (float)THRL), 0)) { const float dl = __builtin_fmaxf(rm, 0.f); mhat += dl; \
        _Pragma("unroll") for (int r = 0; r < 16; ++r) { C0[r] -= dl; C1[r] -= dl; } \
        _Pragma("unroll") for (int r = 0; r < 16; ++r) negm[r] = -mhat; asm volatile("" : "+v"(negm)); \
        const float f = __builtin_amdgcn_exp2f(-dl); l_reg *= f; if (hi == 0) wsf[r32] = f; resc = true; } } \
    SBAR(); \
    GAPB(o[0] = __builtin_amdgcn_mfma_f32_32x32x16_bf16(PAF(0), VFR(0), o[0], 0, 0, 0), C0, 0); \
    GAPB(o[1] = __builtin_amdgcn_mfma_f32_32x32x16_bf16(PAF(0), VFR(4), o[1], 0, 0, 0), C0, 4); \
    KRD(GL, 0); GAPB(o[0] = __builtin_amdgcn_mfma_f32_32x32x16_bf16(PAF(1), VFR(1), o[0], 0, 0, 0), C0, 8); \
    KRD(GL, 1); GAPB(o[1] = __builtin_amdgcn_mfma_f32_32x32x16_bf16(PAF(1), VFR(5), o[1], 0, 0, 0), C0, 12); \
    KRD(GL, 2); GAPB(o[0] = __builtin_amdgcn_mfma_f32_32x32x16_bf16(PAF(2), VFR(2), o[0], 0, 0, 0), C1, 0); \
    KRD(GL, 3); GAPB(o[1] = __builtin_amdgcn_mfma_f32_32x32x16_bf16(PAF(2), VFR(6), o[1], 0, 0, 0), C1, 4); \
    GAPB(o[0] = __builtin_amdgcn_mfma_f32_32x32x16_bf16(PAF(3), VFR(3), o[0], 0, 0, 0), C1, 8); \
    GAPB(o[1] = __builtin_amdgcn_mfma_f32_32x32x16_bf16(PAF(3), VFR(7), o[1], 0, 0, 0), C1, 12); \
    } while (0)
    int t = 1;
#undef CMASK
#define CMASK(P0, P1, t) do {} while (0)
    for (; t + 5 < NT; t += 2) {
        STEP(pB0, pB1, pA0, pA1, t, true, true, true);     WAIT_BAR(2); RESC(); ROT();
        STEP(pA0, pA1, pB0, pB1, t + 1, true, true, true); WAIT_BAR(2); RESC(); ROT();
    }
#undef CMASK
#define CMASK(P0, P1, t) do { int jb_ = (t) - (NT - 4); if (jb_ >= 0) cmask(P0, P1, jb_, qrel, hi); } while (0)
#define ENDW(tt) do { if ((tt) + 3 < NT) { WAIT_BAR(2); } else if ((tt) + 2 < NT) { WAIT_BAR(1); } else { WAIT_BAR(0); } } while (0)
    for (; t + 1 < NT; t += 2) {
        STEP(pB0, pB1, pA0, pA1, t, (t + 3 < NT), (t + 1 < NT), (t + 1 < NT));         ENDW(t);     RESC(); ROT();
        STEP(pA0, pA1, pB0, pB1, t + 1, (t + 4 < NT), (t + 2 < NT), (t + 2 < NT));     ENDW(t + 1); RESC(); ROT();
    }
    STEP(pB0, pB1, pA0, pA1, NT - 1, false, false, false); RESC();
    { float sacc = pB0[0] + pB0[1]; _Pragma("unroll") for (int r = 2; r < 16; ++r) sacc += pB0[r]; _Pragma("unroll") for (int r = 0; r < 16; ++r) sacc += pB1[r]; l_reg += sacc;
      pw0 = (u32x4){PKW(pB0, 0), PKW(pB0, 2), PKW(pB0, 4), PKW(pB0, 6)}; pw1 = (u32x4){PKW(pB0, 8), PKW(pB0, 10), PKW(pB0, 12), PKW(pB0, 14)}; pw2 = (u32x4){PKW(pB1, 0), PKW(pB1, 2), PKW(pB1, 4), PKW(pB1, 6)}; pw3 = (u32x4){PKW(pB1, 8), PKW(pB1, 10), PKW(pB1, 12), PKW(pB1, 14)};
      SBAR(); pv(o, vb0 + sl_cur, PAF(0), PAF(1), PAF(2), PAF(3)); }
#undef PKW
#undef PAF
#undef VFR
#undef PIN
#undef MX3
#undef GAPA
#undef GAPB
#undef EX
#undef VRD
#undef KRD
#undef STEP
#undef ENDW
    { auto rr = __builtin_amdgcn_permlane32_swap(__float_as_uint(l_reg), __float_as_uint(l_reg), false, false); l_reg = __uint_as_float(rr[0]) + __uint_as_float(rr[1]); }
    if (hi == 0) wsf[32 + r32] = l_reg; asm volatile("s_waitcnt lgkmcnt(0)" ::: "memory");
    float rli[16];
#pragma unroll
    for (int r = 0; r < 16; ++r) rli[r] = __builtin_amdgcn_rcpf(wsf[32 + crow(r, hi)]);
    bf16* Ow = Obuf + (rowbase + q0 + wid * QBLK) * PO + oc;
    { bf16* stg = (bf16*)(shm + LDS_OST) + wid * 2048;
#pragma unroll
      for (int r = 0; r < 16; ++r) { const int orow = crow(r, hi);
#pragma unroll
        for (int d0 = 0; d0 < 2; ++d0) stg[orow * 64 + d0 * 32 + r32] = __float2bfloat16(o[d0][r] * rli[r]); }
      asm volatile("s_waitcnt lgkmcnt(0)" ::: "memory");
#pragma unroll
      for (int i = 0; i < 4; ++i) { const int row = i * 8 + (lane >> 3), ch = lane & 7; const u32x4 v = *(const u32x4*)(stg + row * 64 + ch * 8); ATTN_STORE16(Ow + (long)row * PO + ch * 8, v); } }
    asm volatile("s_waitcnt lgkmcnt(0)\n\ts_barrier" ::: "memory");
#undef DMA_K
#undef DMA_V
#undef CMASK
#undef START
#undef RESC
#undef ROT
}
#undef SBAR
#undef WAIT_BAR
}


namespace at2 {
using f32x16 = __attribute__((ext_vector_type(16))) float;
constexpr int PQ = 3072, PO = 256, DV = 128, DQ = 64;
constexpr int NW = 8, QBLK = 32, KVBLK = 64, QB = NW * QBLK;
constexpr int SHM_V = KVBLK * DV * 2, SHM_K = KVBLK * DQ * 2;
constexpr int OFF_VL = 0, OFF_KL = 2 * SHM_V, OFF_WS = 2 * SHM_V + 2 * SHM_K;
constexpr int OFF_OL = OFF_WS + 2048, OL_RS = 272, OL_WAVE = QBLK * OL_RS;
constexpr float THR2 = 8.f;
#define KSWZ64(row, colB) ((row) * 128 + ((colB) ^ (((row) & 7) << 4)))
#define SBAR() __builtin_amdgcn_sched_barrier(0)
__device__ __forceinline__ int v_st(int k, int c) { const int kk = (k & ~0xC) | ((k & 4) << 1) | ((k & 8) >> 1); return ((kk >> 3) * 4 + (c >> 5)) * 512 + ((kk & 7) * 32 + (c & 31)) * 2; }
__device__ __forceinline__ int v_rd_base(int lane) { return ((lane & 3) << 3) | (((lane >> 2) & 3) << 6) | (((lane >> 4) & 1) << 5) | (((lane >> 5) & 1) << 8); }
constexpr int v_rd_off(int d0, int ks, int half) { return d0 * 512 + ks * 4096 + half * 2048; }
__device__ __forceinline__ int crow(int r, int hi) { return (r & 3) + 8 * (r >> 2) + 4 * hi; }
__device__ __forceinline__ bf16x8 load8(const bf16_t* p) { return *reinterpret_cast<const bf16x8*>(p); }
__device__ __forceinline__ void mask_tile(f32x16& p0, f32x16& p1, int dq) {
    const float NEG = -__builtin_inff();
#pragma unroll
    for (int r = 0; r < 16; ++r) { const int c = (r & 3) + 8 * (r >> 2); if (dq - c < 0) p0[r] = NEG; if (dq - c - 32 < 0) p1[r] = NEG; }
}
__device__ __forceinline__ void partialSM(f32x16& p0, f32x16& p1, float& m_reg, float& mn, float& alpha) {
    float pmax = p0[0];
#pragma unroll
    for (int r = 1; r < 16; ++r) pmax = fmaxf(pmax, p0[r]);
#pragma unroll
    for (int r = 0; r < 16; ++r) pmax = fmaxf(pmax, p1[r]);
    { auto rr = __builtin_amdgcn_permlane32_swap(__float_as_uint(pmax), __float_as_uint(pmax), false, false); pmax = fmaxf(__uint_as_float(rr[0]), __uint_as_float(rr[1])); }
    if (__builtin_expect(__all((pmax - m_reg) <= THR2), 1)) { mn = m_reg; alpha = 1.f; }
    else { mn = fmaxf(m_reg, pmax); alpha = __builtin_amdgcn_exp2f(m_reg - mn); m_reg = mn; }
#pragma unroll
    for (int r = 0; r < 16; ++r) { p0[r] = p0[r] - mn; p1[r] = p1[r] - mn; }
#pragma unroll
    for (int r = 0; r < 16; ++r) p0[r] = __builtin_amdgcn_exp2f(p0[r]);
}
__device__ __forceinline__ void finishSM(f32x16& p0, f32x16& p1, float alpha, float& l_reg, bf16x8& pa0, bf16x8& pa1, bf16x8& pa2, bf16x8& pa3) {
#pragma unroll
    for (int r = 0; r < 16; ++r) p1[r] = __builtin_amdgcn_exp2f(p1[r]);
    float ps = 0;
#pragma unroll
    for (int r = 0; r < 16; ++r) ps += p0[r];
#pragma unroll
    for (int r = 0; r < 16; ++r) ps += p1[r];
    { auto rr = __builtin_amdgcn_permlane32_swap(__float_as_uint(ps), __float_as_uint(ps), false, false); ps = __uint_as_float(rr[0]) + __uint_as_float(rr[1]); }
    l_reg = l_reg * alpha + ps;
#define PK4(P, B_, OUT) do { unsigned a0 = cvtpk(P[B_+0], P[B_+1]), a1 = cvtpk(P[B_+2], P[B_+3]);                          \
        unsigned b0 = cvtpk(P[B_+4], P[B_+5]), b1 = cvtpk(P[B_+6], P[B_+7]);                                             \
        auto r0 = __builtin_amdgcn_permlane32_swap(a0, b0, false, false); auto r1 = __builtin_amdgcn_permlane32_swap(a1, b1, false, false); \
        u32x4 w = {r0[0], r1[0], r0[1], r1[1]}; OUT = *reinterpret_cast<bf16x8*>(&w); } while (0)
    PK4(p0, 0, pa0); PK4(p0, 8, pa1); PK4(p1, 0, pa2); PK4(p1, 8, pa3);
#undef PK4
}
template <int KB>
__device__ __forceinline__ void qkt(f32x16& p0, f32x16& p1, const char* K_lds, int r32, int hi, const bf16x8* qr) {
    p0 = f32x16{}; p1 = f32x16{};
#pragma unroll
    for (int d0 = 0; d0 < 4; ++d0) { const char* a = K_lds + KB * SHM_K + KSWZ64(r32, (d0 * 16 + hi * 8) * 2);
        bf16x8 b0 = *reinterpret_cast<const bf16x8*>(a);
        bf16x8 b1 = *reinterpret_cast<const bf16x8*>(a + 32 * 128);
        p0 = __builtin_amdgcn_mfma_f32_32x32x16_bf16(b0, qr[d0], p0, 0, 0, 0);
        p1 = __builtin_amdgcn_mfma_f32_32x32x16_bf16(b1, qr[d0], p1, 0, 0, 0); }
}
template <int VB>
__device__ __forceinline__ void pv_tile(f32x16* o, int vb0, bf16x8 pa0, bf16x8 pa1, bf16x8 pa2, bf16x8 pa3) {
#define TRRD(dst, off) asm volatile("ds_read_b64_tr_b16 %0, %1 offset:%2" : "=&v"(dst) : "v"(vb0), "i"(off) : "memory")
#define PV_D0(d0) do { s16x4 l0, l1, l2, l3, h0, h1, h2, h3; constexpr int b_ = VB * SHM_V + v_rd_off(d0, 0, 0); \
        TRRD(l0, b_); TRRD(h0, b_ + 2048); TRRD(l1, b_ + 4096); TRRD(h1, b_ + 6144); TRRD(l2, b_ + 8192); TRRD(h2, b_ + 10240); TRRD(l3, b_ + 12288); TRRD(h3, b_ + 14336); \
        asm volatile("s_waitcnt lgkmcnt(0)" ::: "memory"); SBAR();   \
        o[d0] = __builtin_amdgcn_mfma_f32_32x32x16_bf16(pa0, (bf16x8){l0[0], l0[1], l0[2], l0[3], h0[0], h0[1], h0[2], h0[3]}, o[d0], 0, 0, 0);   \
        o[d0] = __builtin_amdgcn_mfma_f32_32x32x16_bf16(pa1, (bf16x8){l1[0], l1[1], l1[2], l1[3], h1[0], h1[1], h1[2], h1[3]}, o[d0], 0, 0, 0);   \
        o[d0] = __builtin_amdgcn_mfma_f32_32x32x16_bf16(pa2, (bf16x8){l2[0], l2[1], l2[2], l2[3], h2[0], h2[1], h2[2], h2[3]}, o[d0], 0, 0, 0);   \
        o[d0] = __builtin_amdgcn_mfma_f32_32x32x16_bf16(pa3, (bf16x8){l3[0], l3[1], l3[2], l3[3], h3[0], h3[1], h3[2], h3[3]}, o[d0], 0, 0, 0); } while (0)
    PV_D0(0); PV_D0(1); PV_D0(2); PV_D0(3);
#undef PV_D0
#undef TRRD
}
struct BlockRef { const bf16_t* Q; const bf16_t* K; const bf16_t* V; int P0; int to_lds; float lam; };
struct Seam { bf16x8 qr[4]; bf16x8 st_v0, st_v1, st_k0; };
#define VMW() asm volatile("s_waitcnt vmcnt(0)" ::: "memory")
#define VMWN(n) asm volatile("s_waitcnt vmcnt(%0)" :: "i"(n) : "memory")
#define SLOAD_H(Kp, Vp, k0) do { S.st_v0 = load8((Vp) + (size_t)((k0) + sr) * PQ + sc); S.st_v1 = load8((Vp) + (size_t)((k0) + 32 + sr) * PQ + sc); \
                                 S.st_k0 = load8((Kp) + (size_t)((k0) + kr) * PQ + kc); } while (0)
#define SWRITE_HK(bf) do { *(bf16x8*)(K_lds + (bf) * SHM_K + kws) = S.st_k0; } while (0)
#define SWRITE_HV(bf) do { *(bf16x8*)(V_lds + (bf) * SHM_V + vst0) = S.st_v0; *(bf16x8*)(V_lds + (bf) * SHM_V + vst1) = S.st_v1; } while (0)
#define SWRITE_H(bf) do { SWRITE_HV(bf); SWRITE_HK(bf); } while (0)
__device__ __forceinline__ void prime(const BlockRef& cur, char* lds, Seam& S, int tid, int wid) {
    const int lane = tid & 63, r32 = lane & 31, hi = lane >> 5;
    const int sr = tid >> 4, sc = (tid & 15) * 8, kr = tid >> 3, kc = (tid & 7) * 8, kws = KSWZ64(kr, kc * 2); char* K_lds = lds + OFF_KL;
#pragma unroll
    for (int d0 = 0; d0 < 4; ++d0) S.qr[d0] = load8(cur.Q + (size_t)(wid * QBLK + r32) * PQ + d0 * 16 + hi * 8);
    SLOAD_H(cur.K, cur.V, 0); VMW(); SWRITE_HK(0);
    __syncthreads();
}
__device__ __forceinline__ void block(const BlockRef& cur, const BlockRef& nxt, char* lds, Seam& S, int tid, int wid) {
    asm volatile("" : "+v"(tid));
    const int lane = tid & 63, r32 = lane & 31, hi = lane >> 5;
    const int NT = (cur.P0 + QB - 1) / KVBLK + 1;
    const int qlo = cur.P0 + wid * QBLK, qm = qlo + r32 - 4 * hi;
    char* V_lds = lds + OFF_VL; char* K_lds = lds + OFF_KL;
    float* ws = (float*)(lds + OFF_WS) + wid * 64; float* li_l = ws, * al_l = ws + 32;
    float m_reg = -1e30f, l_reg = 0; f32x16 o[4] = {};
    const int sr = tid >> 4, sc = (tid & 15) * 8, vst0 = v_st(sr, sc), vst1 = v_st(32 + sr, sc), kr = tid >> 3, kc = (tid & 7) * 8, kws = KSWZ64(kr, kc * 2);
    const int vb0 = (int)(uintptr_t)V_lds + v_rd_base(lane);
    const bf16_t* Kh = cur.K; const bf16_t* Vh = cur.V;
#define RESC(a) do { if (__any((a) < 1.f)) { if (hi == 0) al_l[r32] = (a); asm volatile("s_waitcnt lgkmcnt(0)" ::: "memory");              \
                     _Pragma("unroll") for (int d_ = 0; d_ < 4; ++d_) _Pragma("unroll") for (int r = 0; r < 16; ++r) o[d_][r] *= al_l[crow(r, hi)]; } } while (0)
#define KBASE(t) ((t) * KVBLK)
#define MASKT(P0_, P1_, t) do { const int kb_ = KBASE(t); if (kb_ + KVBLK - 1 > qlo) mask_tile(P0_, P1_, qm - kb_); } while (0)
#define SEAM_K0() do { VMWN(4); SWRITE_HK(0); SBAR(); } while (0)
    f32x16 pA0, pA1, pB0, pB1; float mnA, mnB, alA, alB; bf16x8 pa0, pa1, pa2, pa3;
    SWRITE_HV(0); SBAR();
    if (NT > 1) SLOAD_H(Kh, Vh, KBASE(1));
    SBAR(); qkt<0>(pA0, pA1, K_lds, r32, hi, S.qr);
    MASKT(pA0, pA1, 0); partialSM(pA0, pA1, m_reg, mnA, alA);
    if (NT > 1) { VMW(); SWRITE_H(1); }
    __syncthreads();
#define HALF_STEP(PX0, PX1, mnX, alX, PY0, PY1, alY, t, KB, VB, SB) do {                                                      \
        SBAR(); qkt<KB>(PX0, PX1, K_lds, r32, hi, S.qr);                                                                      \
        finishSM(PY0, PY1, alY, l_reg, pa0, pa1, pa2, pa3); SBAR();                                                           \
        if ((t) + 1 < NT) { SLOAD_H(Kh, Vh, KBASE((t) + 1)); SBAR(); }                                                        \
        pv_tile<VB>(o, vb0, pa0, pa1, pa2, pa3); MASKT(PX0, PX1, (t)); partialSM(PX0, PX1, m_reg, mnX, alX);                 \
        __syncthreads();                                                                                                      \
        if ((t) + 1 < NT) { VMW(); SWRITE_H(SB); }                                                                            \
        RESC(alX); __syncthreads(); } while (0)
    for (int t = 1; t + 1 < NT; t += 2) {
        HALF_STEP(pB0, pB1, mnB, alB, pA0, pA1, alA, t, 1, 0, 0);
        HALF_STEP(pA0, pA1, mnA, alA, pB0, pB1, alB, t + 1, 0, 1, 1);
    }
    const bool even = wid >= 6;
    if (even) { SBAR(); qkt<1>(pB0, pB1, K_lds, r32, hi, S.qr); SBAR(); }
    SLOAD_H(nxt.K, nxt.V, 0); SBAR();
#pragma unroll
    for (int d0 = 0; d0 < 4; ++d0) S.qr[d0] = load8(nxt.Q + (size_t)(wid * QBLK + r32) * PQ + d0 * 16 + hi * 8);
    SBAR();
    finishSM(pA0, pA1, alA, l_reg, pa0, pa1, pa2, pa3); SBAR();
    pv_tile<0>(o, vb0, pa0, pa1, pa2, pa3);
    if (even) { MASKT(pB0, pB1, NT - 1); partialSM(pB0, pB1, m_reg, mnB, alB); __syncthreads(); RESC(alB);
        finishSM(pB0, pB1, alB, l_reg, pa0, pa1, pa2, pa3); SBAR(); pv_tile<1>(o, vb0, pa0, pa1, pa2, pa3); }
    else __syncthreads();
    SBAR(); SEAM_K0();
    if (hi == 0) li_l[r32] = l_reg; asm volatile("s_waitcnt lgkmcnt(0)" ::: "memory");
    float rli[16];
#pragma unroll
    for (int r = 0; r < 16; ++r) rli[r] = __builtin_amdgcn_rcpf(li_l[crow(r, hi)]);
    { char* Ol = lds + OFF_OL + wid * OL_WAVE;
      if (!cur.to_lds) {
#pragma unroll
          for (int d0 = 0; d0 < 4; ++d0)
#pragma unroll
              for (int hq = 0; hq < 2; ++hq) { u32x4 wv_;
#pragma unroll
                  for (int q = 0; q < 4; ++q) { const int r = hq * 8 + q * 2; wv_[q] = cvtpk(o[d0][r] * rli[r], o[d0][r + 1] * rli[r + 1]); }
                  *(u32x4*)(Ol + ((d0 * 2 + hq) * 64 + lane) * 16) = wv_; }
      } else {
          u32x4 o1w[8];
#pragma unroll
          for (int i = 0; i < 8; ++i) o1w[i] = *(const u32x4*)(Ol + (i * 64 + lane) * 16);
          asm volatile("s_waitcnt lgkmcnt(0)" ::: "memory");
#pragma unroll
          for (int r = 0; r < 16; ++r) { const int orow = crow(r, hi);
#pragma unroll
              for (int d0 = 0; d0 < 4; ++d0) { const unsigned w1 = o1w[d0 * 2 + (r >> 3)][(r & 7) >> 1]; const float o1v = (r & 1) ? bfhi(w1) : bflo(w1);
                  const float v = o1v - cur.lam * (o[d0][r] * rli[r]); const float vn = sx<1>(v);
                  if ((r32 & 1) == 0) *(unsigned*)(Ol + orow * OL_RS + (d0 * 32 + r32) * 2) = cvtpk(v, vn); } } } }
    asm volatile("s_waitcnt lgkmcnt(0)\n\ts_barrier" ::: "memory");
#undef RESC
#undef KBASE
#undef MASKT
#undef SEAM_K0
#undef HALF_STEP
}
#undef VMW
#undef VMWN
#undef SLOAD_H
#undef SWRITE_HK
#undef SWRITE_HV
#undef SWRITE_H
#undef SBAR
#undef KSWZ64
}

struct Params {
    const float* x; const float* c; const int* positions; const float* norm1; const float* norm2; const float* w_ada; const float* b_ada;
    const float* a_w_in; const float* a_b_if; const float* a_h_norm; const float* a_w_out;
    const float* b_w_in; const float* b_q_norm; const float* b_k_norm; const float* b_lam_q1; const float* b_lam_k1; const float* b_lam_q2; const float* b_lam_k2;
    const float* b_o_norm; const float* b_w_out; const float* w_router; const float* router_bias; const float* moe_w_gu; const float* moe_w_down;
    float* out; unsigned char* ws;
};
struct Frame { LAS unsigned char* lds; int tid, lane, wave, G, bid, vcu; };
__device__ __forceinline__ Frame make_frame(unsigned char* lds, int wv) {
    Frame F; F.lds = (LAS unsigned char*)lds; int t = wv * 64 + lane_id(); asm volatile("" : "+v"(t)); F.tid = t; F.lane = t & 63; F.wave = wv;
    F.G = gridDim.x; F.bid = blockIdx.x; F.vcu = (F.G % 8 == 0) ? (F.bid % 8) * (F.G / 8) + F.bid / 8 : F.bid; return F;
}

struct WItem { const float* W; unsigned char* WT; float* cs; int ldw, Kr, drow0, n0, mode; float s8; };
constexpr int NW_ITEMS = ((WQ_IN0 == 2) ? 48 : 0) + ((WQ_OUT0 == 2) ? 16 : 0) + ((WQ_OUT1 == 2) ? 16 : 0);
__device__ __forceinline__ WItem decode_witem(int it, const Params& p) {
    float* cw = (float*)(p.ws + SC_CW);
    if (WQ_IN0 == 2) { if (it < 48) { const int nb = it; return WItem{p.a_w_in, p.ws + WS_WAIN, cw + CW_AIN, 3080, 1024, 64 * nb, 64 * nb, 2, 0.f}; } it -= 48; }
    if (WQ_OUT0 == 2) { if (it < 16) { const int nb = it; return WItem{p.a_w_out, p.ws + WS_WAOUT, cw + CW_AOUT, 1024, 1024, 64 * nb, 64 * nb, 2, 0.f}; } it -= 16; }
    { const int nb = it; return WItem{p.b_w_out, p.ws + WS_WBOUT, cw + CW_BOUT, 1024, 1024, 64 * nb, 64 * nb, 2, 0.f}; }
}
__device__ __forceinline__ int witem_owner(int it, int G) { return (G == 256) ? 192 + (it & 63) : it % G; }
struct TItem { const float* W; bf16_t* WT; int ldw, K, drow0, k0, n0; float s8; };
__device__ __forceinline__ TItem decode_item(int it, const Params& p) {
    constexpr int I0 = (WQ_IN0 == 2) ? 0 : 16 * 48, I1 = (WQ_OUT0 == 2) ? 0 : 16 * 16, I2 = 16 * 48, I3 = (WQ_OUT1 == 2) ? 0 : 16 * 16, I4 = 32 * 256;
    TItem t; int r = it;
    if (r < I0) { const int kb = r / 48, nb = r % 48; t = (WQ_IN0 == 1) ? TItem{p.a_w_in, (bf16_t*)(p.ws + WS_WAIN), 3080, 1024, 64 * nb, 64 * kb, 64 * nb, S8_WIN} : TItem{p.a_w_in, (bf16_t*)(p.ws + WS_WAIN_BF), 3080, 1024, 64 * nb, 64 * kb, 64 * nb, 0.f}; return t; } r -= I0;
    if (r < I1) { const int kb = r / 16, nb = r % 16; t = (WQ_OUT0 == 1) ? TItem{p.a_w_out, (bf16_t*)(p.ws + WS_WAOUT), 1024, 1024, 64 * nb, 64 * kb, 64 * nb, S8_WOUT} : TItem{p.a_w_out, (bf16_t*)(p.ws + WS_WAOUT_BF), 1024, 1024, 64 * nb, 64 * kb, 64 * nb, 0.f}; return t; } r -= I1;
    if (r < I2) { const int kb = r / 48, nb = r % 48; t = TItem{p.b_w_in, (bf16_t*)(p.ws + WS_WBIN), 3072, 1024, 64 * nb, 64 * kb, 64 * nb, S8_WIN}; return t; } r -= I2;
    if (r < I3) { const int kb = r / 16, nb = r % 16; t = OUTPROJ_FP8 ? TItem{p.b_w_out, (bf16_t*)(p.ws + WS_WBOUT), 1024, 1024, 64 * nb, 64 * kb, 64 * nb, S8_WOUT} : TItem{p.b_w_out, (bf16_t*)(p.ws + WS_WBOUT_BF), 1024, 1024, 64 * nb, 64 * kb, 64 * nb, 0.f}; return t; } r -= I3;
    if (r < I4) { const int mi = r / 256, q = r % 256, kb = q / 16, nb = q % 16; const int n0 = 64 * nb;
        const int drow = ((n0 & 511) >> 7) * 256 + (n0 >> 9) * 128 + (n0 & 127);
        t = TItem{p.moe_w_gu + (size_t)mi * 1024 * 1024, (bf16_t*)(p.ws + WS_WGU + (size_t)mi * 1024 * 1024), 1024, 1024, drow, 64 * kb, n0, S8_WGU}; return t; } r -= I4;
    { const int mi = r / 128, q = r % 128, kb = q / 16, nb = q % 16;
      t = TItem{p.moe_w_down + (size_t)mi * 512 * 1024, (bf16_t*)(p.ws + WS_WDN + (size_t)mi * 1024 * 512), 1024, 512, 64 * nb, 64 * kb, 64 * nb, S8_WDN}; return t; }
}
__device__ __forceinline__ void phase_mod(unsigned char* lds_, int wv, const Params& p) {
    const Frame F = make_frame(lds_, wv);
    LAS float* cact = (LAS float*)F.lds;
    LAS float* red = (LAS float*)(F.lds + 65536);
    float* mod = (float*)(p.ws + WS_MOD);
    for (int i = F.tid; i < NB * DM; i += NTHREADS) { const int b = i >> 10, k = i & 1023; const float v = p.c[i]; cact[k * 16 + b] = v / (1.0f + expf(-v)); }
    __syncthreads();
    for (int task = F.bid; task < 192; task += F.G) {
        const int l = task / 96, cb = task % 96;
        const float* W = p.w_ada + (size_t)l * DM * 6144 + cb * 64 + F.lane;
        float acc[16];
#pragma unroll
        for (int b = 0; b < 16; ++b) acc[b] = 0.f;
        const int kbeg = F.wave * 128;
        for (int kb = kbeg; kb < kbeg + 128; kb += 16) {
            float wv[16];
#pragma unroll
            for (int u = 0; u < 16; ++u) wv[u] = __builtin_nontemporal_load(W + (size_t)(kb + u) * 6144);
#pragma unroll
            for (int u = 0; u < 16; ++u) {
                const LAS f32x4* cc = (const LAS f32x4*)(cact + (kb + u) * 16);
                const f32x4 c0 = cc[0], c1 = cc[1], c2 = cc[2], c3 = cc[3]; const float w = wv[u];
                acc[0] += c0[0] * w; acc[1] += c0[1] * w; acc[2] += c0[2] * w; acc[3] += c0[3] * w;
                acc[4] += c1[0] * w; acc[5] += c1[1] * w; acc[6] += c1[2] * w; acc[7] += c1[3] * w;
                acc[8] += c2[0] * w; acc[9] += c2[1] * w; acc[10] += c2[2] * w; acc[11] += c2[3] * w;
                acc[12] += c3[0] * w; acc[13] += c3[1] * w; acc[14] += c3[2] * w; acc[15] += c3[3] * w;
            }
        }
#pragma unroll
        for (int b = 0; b < 16; ++b) red[(F.wave * 16 + b) * 64 + F.lane] = acc[b];
        __syncthreads();
        for (int o = F.tid; o < 1024; o += NTHREADS) { const int b = o >> 6, cl = o & 63; float s = 0.f;
#pragma unroll
            for (int w = 0; w < 8; ++w) s += red[(w * 16 + b) * 64 + cl];
            mod[((size_t)l * 16 + b) * 6144 + cb * 64 + cl] = s + p.b_ada[(size_t)l * 6144 + cb * 64 + cl]; }
        asm volatile("s_waitcnt vmcnt(0)" ::: "memory");
        __syncthreads();
        if (F.tid == 0) { __builtin_amdgcn_fence(__ATOMIC_RELEASE, "agent"); asm volatile("s_waitcnt vmcnt(0)" ::: "memory"); (void)xb_add((unsigned*)p.ws + CW_MODCNT, 1u); }
    }
}
__device__ __forceinline__ void phase_wconv(unsigned char* lds_, int wv, const Params& p) {
    const Frame F = make_frame(lds_, wv);
    LAS float* scr = (LAS float*)(F.lds + F.wave * 17408);
    LAS float* cmaxw = (LAS float*)(F.lds + 8 * 17408);
    const int lane = F.lane, lr = lane >> 4, c4 = (lane & 15) * 4, w = F.wave;
    for (int it = 0; it < NW_ITEMS; ++it) {
        if (witem_owner(it, F.G) != F.bid) continue;
        const WItem t = decode_witem(it, p);
        const int RW = t.Kr >> 3, NH = RW >> 6;
        f32x4 v[2][16];
#pragma unroll
        for (int hf = 0; hf < 2; ++hf) if (hf < NH) {
#pragma unroll
            for (int i = 0; i < 16; ++i) v[hf][i] = __builtin_nontemporal_load((const f32x4*)(t.W + (size_t)(w * RW + hf * 64 + 4 * i + lr) * t.ldw + t.n0 + c4)); }
        __syncthreads();
        float qs = t.s8;
        if (t.mode == 2) {
            float mx[4] = {0.f, 0.f, 0.f, 0.f};
#pragma unroll
            for (int hf = 0; hf < 2; ++hf) if (hf < NH) {
#pragma unroll
                for (int i = 0; i < 16; ++i)
#pragma unroll
                    for (int q = 0; q < 4; ++q) mx[q] = fmaxf(mx[q], fabsf(v[hf][i][q])); }
#pragma unroll
            for (int q = 0; q < 4; ++q) { mx[q] = fmaxf(mx[q], sx<16>(mx[q])); auto rr = __builtin_amdgcn_permlane32_swap(__float_as_uint(mx[q]), __float_as_uint(mx[q]), false, false); mx[q] = fmaxf(__uint_as_float(rr[0]), __uint_as_float(rr[1])); }
            if (lr == 0) *(LAS f32x4*)(cmaxw + w * 64 + c4) = (f32x4){mx[0], mx[1], mx[2], mx[3]};
            __syncthreads();
            float cm = 0.f;
#pragma unroll
            for (int ww = 0; ww < 8; ++ww) cm = fmaxf(cm, cmaxw[ww * 64 + lane]);
            qs = cm > 0.f ? 127.0f / cm : 0.f;
            if (w == 0) t.cs[t.drow0 + lane] = cm * (1.0f / 127.0f);
        }
#pragma unroll
        for (int hf = 0; hf < 2; ++hf) if (hf < NH) {
#pragma unroll
            for (int i = 0; i < 16; ++i) *(LAS f32x4*)(scr + (4 * i + lr) * 68 + c4) = v[hf][i];
            const int k0 = w * RW + hf * 64;
            if (t.mode == 0) { bf16_t* orow = (bf16_t*)t.WT + (size_t)(t.drow0 + lane) * t.Kr + k0;
#pragma unroll
                for (int c = 0; c < 8; ++c) { float f[8];
#pragma unroll
                    for (int q = 0; q < 8; ++q) f[q] = scr[(8 * c + q) * 68 + lane];
                    u32x4 o; o.x = cvtpk(f[0], f[1]); o.y = cvtpk(f[2], f[3]); o.z = cvtpk(f[4], f[5]); o.w = cvtpk(f[6], f[7]);
                    *(u32x4*)(orow + 8 * c) = o; } }
            else { unsigned char* orow8 = t.WT + (size_t)(t.drow0 + lane) * t.Kr + k0;
#pragma unroll
                for (int c = 0; c < 4; ++c) { float f[16];
#pragma unroll
                    for (int q = 0; q < 16; ++q) f[q] = scr[(16 * c + q) * 68 + lane] * qs;
                    u32x4 o;
                    if (t.mode == 1) { o.x = cvt4_fp8(f[0], f[1], f[2], f[3]); o.y = cvt4_fp8(f[4], f[5], f[6], f[7]); o.z = cvt4_fp8(f[8], f[9], f[10], f[11]); o.w = cvt4_fp8(f[12], f[13], f[14], f[15]); }
                    else { o.x = pack4_i8(f[0], f[1], f[2], f[3]); o.y = pack4_i8(f[4], f[5], f[6], f[7]); o.z = pack4_i8(f[8], f[9], f[10], f[11]); o.w = pack4_i8(f[12], f[13], f[14], f[15]); }
                    *(u32x4*)(orow8 + 16 * c) = o; } }
            asm volatile("s_waitcnt lgkmcnt(0)" ::: "memory");
        }
    }
}

__device__ __forceinline__ void phase_wconv_pw(unsigned char* lds_, int wv, const Params& p) {
    const Frame F = make_frame(lds_, wv);
    LAS float* scr = (LAS float*)(F.lds + F.wave * 17408);
    const int gw = F.vcu * NWAVES + F.wave, NGW = F.G * NWAVES;
    constexpr int NITEMS = ((WQ_IN0 == 2) ? 0 : 16 * 48) + ((WQ_OUT0 == 2) ? 0 : 16 * 16) + 16 * 48 + ((WQ_OUT1 == 2) ? 0 : 16 * 16) + 32 * 256 + 32 * 128;
    const int lane = F.lane, lr = lane >> 4, c4 = (lane & 15) * 4;
    f32x4 v[16];
    int it = gw;
    if (it < NITEMS) { const TItem t = decode_item(it, p);
#pragma unroll
        for (int i = 0; i < 16; ++i) v[i] = __builtin_nontemporal_load((const f32x4*)(t.W + (size_t)(t.k0 + 4 * i + lr) * t.ldw + t.n0 + c4)); }
    for (; it < NITEMS; it += NGW) {
        const TItem t = decode_item(it, p);
#pragma unroll
        for (int i = 0; i < 16; ++i) *(LAS f32x4*)(scr + (4 * i + lr) * 68 + c4) = v[i];
        const int itn = it + NGW;
        if (itn < NITEMS) { const TItem tn = decode_item(itn, p);
#pragma unroll
            for (int i = 0; i < 16; ++i) v[i] = __builtin_nontemporal_load((const f32x4*)(tn.W + (size_t)(tn.k0 + 4 * i + lr) * tn.ldw + tn.n0 + c4)); }
        if (t.s8 > 0.f) {
            unsigned char* orow8 = (unsigned char*)t.WT + (size_t)(t.drow0 + lane) * t.K + t.k0;
#pragma unroll
            for (int c = 0; c < 4; ++c) { float f[16];
#pragma unroll
                for (int q = 0; q < 16; ++q) f[q] = scr[(16 * c + q) * 68 + lane] * t.s8;
                u32x4 o; o.x = cvt4_fp8(f[0], f[1], f[2], f[3]); o.y = cvt4_fp8(f[4], f[5], f[6], f[7]); o.z = cvt4_fp8(f[8], f[9], f[10], f[11]); o.w = cvt4_fp8(f[12], f[13], f[14], f[15]);
                *(u32x4*)(orow8 + 16 * c) = o; }
        } else {
            bf16_t* orow = t.WT + (size_t)(t.drow0 + lane) * t.K + t.k0;
#pragma unroll
            for (int c = 0; c < 8; ++c) { float f[8];
#pragma unroll
                for (int q = 0; q < 8; ++q) f[q] = scr[(8 * c + q) * 68 + lane];
                u32x4 o; o.x = cvtpk(f[0], f[1]); o.y = cvtpk(f[2], f[3]); o.z = cvtpk(f[4], f[5]); o.w = cvtpk(f[6], f[7]);
                *(u32x4*)(orow + 8 * c) = o; }
        }
    }
}

struct RowConst { f32x4 a[4], b[4]; };
__device__ __forceinline__ RowConst load_rowconst(const float* norm, const float* modb, int sh_off, int sc_off, int lane) {
    RowConst rc;
#pragma unroll
    for (int j = 0; j < 4; ++j) { const int c = 256 * j + 4 * lane;
        const f32x4 nv = *(const f32x4*)(norm + c), sc = *(const f32x4*)(modb + sc_off + c); rc.b[j] = *(const f32x4*)(modb + sh_off + c);
        rc.a[j] = nv * (sc + 1.0f); }
    return rc;
}
__device__ __forceinline__ void row_norm_store(const f32x4 (&v)[4], const RowConst& rc, f32x4 (&h)[4], bf16_t* hrow, int lane) {
    float ss = 0.f;
#pragma unroll
    for (int j = 0; j < 4; ++j) ss += (v[j][0] * v[j][0] + v[j][1] * v[j][1]) + (v[j][2] * v[j][2] + v[j][3] * v[j][3]);
    const float r = __builtin_amdgcn_rsqf(wave_sum(ss) * (1.0f / DM) + EPS);
#pragma unroll
    for (int j = 0; j < 4; ++j) { h[j] = v[j] * r * rc.a[j] + rc.b[j];
        u32x2 w; w.x = cvtpk(h[j][0], h[j][1]); w.y = cvtpk(h[j][2], h[j][3]); *(u32x2*)(hrow + 256 * j + 4 * lane) = w; }
}


__device__ __forceinline__ float reduce16(const float (&v)[16], int lane) {
    float a[8], b[4], c[2];
    const bool b5 = (lane & 32) != 0, b4 = (lane & 16) != 0, b3 = (lane & 8) != 0, b2 = (lane & 4) != 0;
#pragma unroll
    for (int i = 0; i < 8; ++i) { const float send = b5 ? v[i] : v[8 + i], keep = b5 ? v[8 + i] : v[i]; a[i] = keep + sx32(send, b5); }
#pragma unroll
    for (int i = 0; i < 4; ++i) { const float send = b4 ? a[i] : a[4 + i], keep = b4 ? a[4 + i] : a[i]; b[i] = keep + sx<16>(send); }
#pragma unroll
    for (int i = 0; i < 2; ++i) { const float send = b3 ? b[i] : b[2 + i], keep = b3 ? b[2 + i] : b[i]; c[i] = keep + sx<8>(send); }
    const float send = b2 ? c[0] : c[1], keep = b2 ? c[1] : c[0];
    float d = keep + sx<4>(send);
    d += sx<1>(d); d += sx<2>(d);
    return d;
}
__device__ __forceinline__ float reduce8(const float (&v)[8], int lane) {
    float b[4], c[2];
    const bool b5 = (lane & 32) != 0, b4 = (lane & 16) != 0, b3 = (lane & 8) != 0;
#pragma unroll
    for (int i = 0; i < 4; ++i) { const float send = b5 ? v[i] : v[4 + i], keep = b5 ? v[4 + i] : v[i]; b[i] = keep + sx32(send, b5); }
#pragma unroll
    for (int i = 0; i < 2; ++i) { const float send = b4 ? b[i] : b[2 + i], keep = b4 ? b[2 + i] : b[i]; c[i] = keep + sx<16>(send); }
    const float send = b3 ? c[0] : c[1], keep = b3 ? c[1] : c[0];
    float d = keep + sx<8>(send);
    d += sx<1>(d); d += sx<2>(d); d += sx<4>(d);
    return d;
}

__device__ __forceinline__ void row_norm_store8(const f32x4 (&v)[4], const RowConst& rc, f32x4 (&h)[4], unsigned char* hrow, int lane) {
    float ss = 0.f;
#pragma unroll
    for (int j = 0; j < 4; ++j) ss += (v[j][0] * v[j][0] + v[j][1] * v[j][1]) + (v[j][2] * v[j][2] + v[j][3] * v[j][3]);
    const float r = __builtin_amdgcn_rsqf(wave_sum(ss) * (1.0f / DM) + EPS);
#pragma unroll
    for (int j = 0; j < 4; ++j) { h[j] = v[j] * r * rc.a[j] + rc.b[j];
        *(unsigned*)(hrow + 256 * j + 4 * lane) = cvt4_fp8(h[j][0] * S8_H, h[j][1] * S8_H, h[j][2] * S8_H, h[j][3] * S8_H); }
}
__device__ __forceinline__ void row_norm_store_i8(const f32x4 (&v)[4], const RowConst& rc, f32x4 (&h)[4], unsigned char* hrow, float* rs_out, int lane) {
    float ss = 0.f;
#pragma unroll
    for (int j = 0; j < 4; ++j) ss += (v[j][0] * v[j][0] + v[j][1] * v[j][1]) + (v[j][2] * v[j][2] + v[j][3] * v[j][3]);
    const float r = __builtin_amdgcn_rsqf(wave_sum(ss) * (1.0f / DM) + EPS);
    float mx = 0.f;
#pragma unroll
    for (int j = 0; j < 4; ++j) { h[j] = v[j] * r * rc.a[j] + rc.b[j]; mx = fmaxf(fmaxf(mx, fmaxf(fabsf(h[j][0]), fabsf(h[j][1]))), fmaxf(fabsf(h[j][2]), fabsf(h[j][3]))); }
    mx = fmaxf(wave_max(mx), 1e-20f);
    const float qs = 127.0f * __builtin_amdgcn_rcpf(mx);
#pragma unroll
    for (int j = 0; j < 4; ++j) *(unsigned*)(hrow + 256 * j + 4 * lane) = pack4_i8(h[j][0] * qs, h[j][1] * qs, h[j][2] * qs, h[j][3] * qs);
    if (lane == 0) *rs_out = mx * (1.0f / 127.0f);
}
__device__ __forceinline__ void phase_hprep0(unsigned char* lds_, int wv, const Params& p) {
    const Frame F = make_frame(lds_, wv);
    LAS f32x4* Wg = (LAS f32x4*)F.lds;
    for (int idx = F.tid; idx < 2048; idx += NTHREADS) { const int ln = idx & 63, half = (idx >> 6) & 1, i = (idx >> 7) & 3, j = idx >> 9; const int c = 256 * j + 4 * ln + i;
        Wg[idx] = *(const f32x4*)(p.a_w_in + (size_t)c * 3080 + 3072 + half * 4); }
    __syncthreads();
    const float* mod = (const float*)(p.ws + WS_MOD);
    unsigned char* H = p.ws + WS_H; float* gates = (float*)(p.ws + WS_GATES);
    const float bif = p.a_b_if[F.lane & 7];
    float* cst = (float*)(p.ws + WS_CS);
    const float invf_tab[8] = {1.0f, 0.19391788f, 0.037604144f, 0.0072920943f, 0.0014140673f, 0.00027421273f, 5.3174683e-05f, 1.0311522e-05f};
    float invf = 0.f;
#pragma unroll
    for (int i = 0; i < 8; ++i) if ((F.lane & 7) == i) invf = invf_tab[i];
    for (int chunk = F.bid; chunk < 256; chunk += F.G) {
        const int row0 = chunk * 128 + F.wave * 16; const int b = row0 / SEQ;
        const RowConst rc = load_rowconst(p.norm1, mod + (size_t)b * 6144, 0, 1024, F.lane);
        for (int rb = 0; rb < 16; rb += 4) {
            f32x4 v[4][4];
#pragma unroll
            for (int rr = 0; rr < 4; ++rr)
#pragma unroll
                for (int j = 0; j < 4; ++j) v[rr][j] = __builtin_nontemporal_load((const f32x4*)(p.x + (size_t)(row0 + rb + rr) * DM + 256 * j + 4 * F.lane));
            f32x4 h[4][4];
#pragma unroll
            for (int rr = 0; rr < 4; ++rr) { const size_t row_ = (size_t)(row0 + rb + rr);
                if (WQ_IN0 == 2) row_norm_store_i8(v[rr], rc, h[rr], H + row_ * DM, (float*)(p.ws + SC_RS_H) + row_, F.lane);
                else if (WQ_IN0 == 1) row_norm_store8(v[rr], rc, h[rr], H + row_ * DM, F.lane);
                else row_norm_store(v[rr], rc, h[rr], (bf16_t*)H + row_ * DM, F.lane); }
            float g[4][8];
#pragma unroll
            for (int rr = 0; rr < 4; ++rr)
#pragma unroll
                for (int q = 0; q < 8; ++q) g[rr][q] = 0.f;
#pragma unroll
            for (int j = 0; j < 4; ++j)
#pragma unroll
                for (int i = 0; i < 4; ++i) { if (i == 0 || i == 2) asm volatile("" ::: "memory");
                    const f32x4 w0 = Wg[((j * 4 + i) * 2 + 0) * 64 + F.lane], w1 = Wg[((j * 4 + i) * 2 + 1) * 64 + F.lane];
#pragma unroll
                    for (int rr = 0; rr < 4; ++rr) { const float hv = h[rr][j][i];
                        g[rr][0] += hv * w0[0]; g[rr][1] += hv * w0[1]; g[rr][2] += hv * w0[2]; g[rr][3] += hv * w0[3]; g[rr][4] += hv * w1[0]; g[rr][5] += hv * w1[1]; g[rr][6] += hv * w1[2]; g[rr][7] += hv * w1[3]; } }
#pragma unroll
            for (int rr = 0; rr < 4; ++rr) { const int row = row0 + rb + rr;
                const float d = reduce8(g[rr], F.lane);
                const float mine = bperm(d, 8 * (F.lane & 7));
                if (F.lane < 16) { const float ang = (float)p.positions[row] * invf; const double rev = (double)ang * 0.15915494309189535; const float frc = (float)(rev - rint(rev));
                    cst[(size_t)row * 16 + F.lane] = (F.lane < 8) ? __builtin_amdgcn_cosf(frc) : __builtin_amdgcn_sinf(frc); }
                if (F.lane < 8) { float val = mine + bif;
                    if (F.lane >= 4) { const float e_ = __expf(-fabsf(val)), u_ = 1.0f + e_;
                        const float l1p = (u_ == 1.0f) ? e_ : __logf(u_) * e_ * __builtin_amdgcn_rcpf(u_ - 1.0f); val = fminf(val, 0.f) - l1p; }
                    gates[(size_t)row * 8 + F.lane] = val; }
            }
        }
    }
}

namespace mls {
constexpr int RSK = 272, RSV = 176, RSP = 272, RSC = 272;
constexpr int OFF_K = 0, OFF_V = 34816, OFF_P = OFF_V + 22528, OFF_C = OFF_P + 34816, OFF_G = OFF_C + 21760;
typedef short v4i16_t __attribute__((ext_vector_type(4)));
__device__ __forceinline__ bf16x8 tr2(const LAS unsigned char* base, int row, int col, int rs, int lane) {
    const int i = lane & 15, g = lane >> 4;
    const LAS unsigned char* p0 = base + (row + 8 * g + (i >> 2)) * rs + (col + 4 * (i & 3)) * 2;
    const s16x4 lo = __builtin_bit_cast(s16x4, __builtin_amdgcn_ds_read_tr16_b64_v4i16((LAS v4i16_t*)p0));
    const s16x4 hi = __builtin_bit_cast(s16x4, __builtin_amdgcn_ds_read_tr16_b64_v4i16((LAS v4i16_t*)(p0 + 4 * rs)));
    return (bf16x8){lo[0], lo[1], lo[2], lo[3], hi[0], hi[1], hi[2], hi[3]};
}
}
__device__ __forceinline__ void phase_mlstm(unsigned char* lds_, int wv, const Params& p) {
    const Frame F = make_frame(lds_, wv);
    using namespace mls;
    const bf16_t* PR = (const bf16_t*)(p.ws + WS_PROJ); const float* gates = (const float*)(p.ws + WS_GATES); bf16_t* HO = (bf16_t*)(p.ws + WS_HOUT);
    LAS unsigned char* Ks = F.lds + OFF_K; LAS unsigned char* Vs = F.lds + OFF_V; LAS unsigned char* Ps = F.lds + OFF_P; LAS unsigned char* Cs = F.lds + OFF_C;
    LAS float* gbase = (LAS float*)(F.lds + OFF_G);
    const int w = F.wave, lane = F.lane, c = lane & 15, g = lane >> 4, tid = F.tid;
    for (int item = F.vcu; item < 256; item += F.G) {
        const int bh = item >> 2, sl = item & 3, b = bh >> 2, h = bh & 3;
        const size_t tok0 = (size_t)b * SEQ;
        const bf16_t* Qg = PR + h * 128; const bf16_t* Kg = PR + 512 + h * 128; const bf16_t* Vg = PR + 1024 + h * 256 + sl * 64;
        __syncthreads();
        if (tid < 256) { const int row = tid >> 1, part = tid & 1; u32x4 z = {0u, 0u, 0u, 0u}; if (part == 0) z.x = 0x3F80u; *(LAS u32x4*)(Vs + row * RSV + 128 + part * 16) = z; }
        f32x4 cacc[5];
#pragma unroll
        for (int vt = 0; vt < 5; ++vt) cacc[vt] = (f32x4){0.f, 0.f, 0.f, 0.f};
        for (int i = tid; i < 80 * RSC / 16; i += NTHREADS) *(LAS u32x4*)(Cs + i * 16) = (u32x4){0u, 0u, 0u, 0u};
        float m_prev = 0.f;
        u32x4 kst[4], vst[2]; bf16x8 qf[4], qn[4]; float glf0 = 0.f, glf1 = 0.f, gi0 = 0.f, gi1 = 0.f;
        auto load_chunk = [&](int ch) {
            const size_t t0 = tok0 + (size_t)ch * 128;
#pragma unroll
            for (int k = 0; k < 4; ++k) { const int pc = tid + 512 * k, row = pc >> 4, c16 = pc & 15; kst[k] = *(const u32x4*)(Kg + (t0 + row) * 3072 + c16 * 8); }
#pragma unroll
            for (int k = 0; k < 2; ++k) { const int pc = tid + 512 * k, row = pc >> 3, c16 = pc & 7; vst[k] = *(const u32x4*)(Vg + (t0 + row) * 3072 + c16 * 8); }
#pragma unroll
            for (int ks = 0; ks < 4; ++ks) qn[ks] = *(const bf16x8*)(Qg + (t0 + 16 * w + c) * 3072 + 32 * ks + 8 * g);
            if (w == 0) { const float* gp = gates + (t0 + 2 * lane) * 8; gi0 = gp[h]; glf0 = gp[4 + h]; gi1 = gp[8 + h]; glf1 = gp[12 + h]; }
        };
        auto gate_scan = [&](LAS float* gs) {
            LAS float* gu = gs; LAS float* gwv = gs + 128; LAS float* gin = gs + 256; LAS float* gfl = gs + 384; LAS float* gwg = gs + 512;
            float s = glf0 + glf1;
#pragma unroll
            for (int d = 1; d < 64; d <<= 1) { const float t = bperm(s, (lane - d) & 63); if (lane >= d) s += t; }
            const float b1 = s, b0 = s - glf1;
            const float u0 = gi0 - b0, u1 = gi1 - b1;
            float m = fmaxf(u0, u1);
#pragma unroll
            for (int d = 1; d < 64; d <<= 1) { const float t = bperm(m, (lane - d) & 63); if (lane >= d) m = fmaxf(m, t); }
            float ex = bperm(m, (lane - 1) & 63); if (lane == 0) ex = -INFINITY;
            const float wv0 = fmaxf(fmaxf(ex, u0), m_prev), wv1 = fmaxf(m, m_prev);
            const float wlast = rdlane(wv1, 63), blast = rdlane(b1, 63);
            gu[2 * lane] = u0; gu[2 * lane + 1] = u1; gwv[2 * lane] = wv0; gwv[2 * lane + 1] = wv1;
            gin[2 * lane] = __expf(m_prev - wv0); gin[2 * lane + 1] = __expf(m_prev - wv1);
            gfl[2 * lane] = __expf(-(b0 + wv0)); gfl[2 * lane + 1] = __expf(-(b1 + wv1));
            gwg[2 * lane] = __expf(u0 - wlast); gwg[2 * lane + 1] = __expf(u1 - wlast);
            m_prev = blast + wlast;
        };
        auto store_chunk = [&]() {
#pragma unroll
            for (int k = 0; k < 4; ++k) { const int pc = tid + 512 * k, row = pc >> 4, c16 = pc & 15; *(LAS u32x4*)(Ks + row * RSK + c16 * 16) = kst[k]; }
#pragma unroll
            for (int k = 0; k < 2; ++k) { const int pc = tid + 512 * k, row = pc >> 3, c16 = pc & 7; *(LAS u32x4*)(Vs + row * RSV + c16 * 16) = vst[k]; }
#pragma unroll
            for (int ks = 0; ks < 4; ++ks) qf[ks] = qn[ks];
        };
        load_chunk(0);
        store_chunk();
        if (w == 0) gate_scan(gbase);
        __syncthreads();
        for (int ch = 0; ch < 16; ++ch) {
            LAS float* gs = gbase + (ch & 1) * 640;
            LAS float* gu = gs; LAS float* gwv = gs + 128; LAS float* gin = gs + 256; LAS float* gfl = gs + 384; LAS float* gwg = gs + 512;
            if (ch < 15) load_chunk(ch + 1);
            {
                const int t = 16 * w + c; const float wt = gwv[t];
#pragma unroll
                for (int jp = 0; jp < 4; ++jp) {
                    if (2 * jp <= w) {
                        f32x4 sa0 = (f32x4){0.f, 0.f, 0.f, 0.f}, sa1 = sa0;
#pragma unroll
                        for (int ks = 0; ks < 4; ++ks) { const bf16x8 kf0 = *(const LAS bf16x8*)(Ks + (32 * jp + c) * RSK + (32 * ks + 8 * g) * 2), kf1 = *(const LAS bf16x8*)(Ks + (32 * jp + 16 + c) * RSK + (32 * ks + 8 * g) * 2);
                            sa0 = __builtin_amdgcn_mfma_f32_16x16x32_bf16(kf0, qf[ks], sa0, 0, 0, 0); sa1 = __builtin_amdgcn_mfma_f32_16x16x32_bf16(kf1, qf[ks], sa1, 0, 0, 0); }
                        const f32x4 uv0 = *(const LAS f32x4*)(gu + 32 * jp + 4 * g), uv1 = *(const LAS f32x4*)(gu + 32 * jp + 16 + 4 * g);
                        float p0_[4], p1_[4];
#pragma unroll
                        for (int r = 0; r < 4; ++r) { const int s0 = 32 * jp + 4 * g + r, s1 = s0 + 16;
                            const float e0 = __expf(uv0[r] - wt), e1 = __expf(uv1[r] - wt); p0_[r] = (s0 <= t) ? sa0[r] * e0 : 0.f; p1_[r] = (s1 <= t) ? sa1[r] * e1 : 0.f; }
                        u32x2 pk0, pk1; pk0.x = cvtpk(p0_[0], p0_[1]); pk0.y = cvtpk(p0_[2], p0_[3]); pk1.x = cvtpk(p1_[0], p1_[1]); pk1.y = cvtpk(p1_[2], p1_[3]);
                        *(LAS u32x2*)(Ps + t * RSP + (32 * jp + 4 * g) * 2) = pk0; *(LAS u32x2*)(Ps + t * RSP + (32 * jp + 16 + 4 * g) * 2) = pk1;
                    }
                }
            }
            f32x4 nacc[5];
#pragma unroll
            for (int vt = 0; vt < 5; ++vt) { nacc[vt] = (f32x4){0.f, 0.f, 0.f, 0.f};
#pragma unroll
                for (int ks = 0; ks < 4; ++ks) { const bf16x8 cf = *(const LAS bf16x8*)(Cs + (16 * vt + c) * RSC + (32 * ks + 8 * g) * 2); nacc[vt] = __builtin_amdgcn_mfma_f32_16x16x32_bf16(cf, qf[ks], nacc[vt], 0, 0, 0); } }
            { const float iv = gin[16 * w + c];
#pragma unroll
              for (int vt = 0; vt < 5; ++vt) nacc[vt] = nacc[vt] * iv; }
            if (w == 0 && ch < 15) gate_scan(gbase + ((ch + 1) & 1) * 640);
            for (int ks = 0; ks <= (w >> 1); ++ks) {
                const bf16x8 pf = *(const LAS bf16x8*)(Ps + (16 * w + c) * RSP + (32 * ks + 8 * g) * 2);
#pragma unroll
                for (int vt = 0; vt < 5; ++vt) { const bf16x8 vf = tr2(Vs, 32 * ks, 16 * vt, RSV, lane); nacc[vt] = __builtin_amdgcn_mfma_f32_16x16x32_bf16(vf, pf, nacc[vt], 0, 0, 0); }
            }
            { const float den = bperm(nacc[4][0], lane & 15); const float inv = 1.0f / fmaxf(fabsf(den), gfl[16 * w + c]);
              bf16_t* orow = HO + (tok0 + (size_t)ch * 128 + 16 * w + c) * DM + h * 256 + sl * 64 + 4 * g;
#pragma unroll
              for (int vt = 0; vt < 4; ++vt) { u32x2 pk; pk.x = cvtpk(nacc[vt][0] * inv, nacc[vt][1] * inv); pk.y = cvtpk(nacc[vt][2] * inv, nacc[vt][3] * inv); *(u32x2*)(orow + 16 * vt) = pk; } }
            { const float decay = gin[127];
#pragma unroll
              for (int vt = 0; vt < 5; ++vt) cacc[vt] = cacc[vt] * decay;
#pragma unroll
              for (int ks = 0; ks < 4; ++ks) {
                  bf16x8 kf = tr2(Ks, 32 * ks, 16 * w, RSK, lane);
                  const f32x4 w0 = *(const LAS f32x4*)(gwg + 32 * ks + 8 * g), w1 = *(const LAS f32x4*)(gwg + 32 * ks + 8 * g + 4);
                  u32x4 kw = __builtin_bit_cast(u32x4, kf);
                  kw.x = cvtpk(bflo(kw.x) * w0[0], bfhi(kw.x) * w0[1]); kw.y = cvtpk(bflo(kw.y) * w0[2], bfhi(kw.y) * w0[3]);
                  kw.z = cvtpk(bflo(kw.z) * w1[0], bfhi(kw.z) * w1[1]); kw.w = cvtpk(bflo(kw.w) * w1[2], bfhi(kw.w) * w1[3]);
                  kf = __builtin_bit_cast(bf16x8, kw);
#pragma unroll
                  for (int vt = 0; vt < 5; ++vt) { const bf16x8 vf = tr2(Vs, 32 * ks, 16 * vt, RSV, lane); cacc[vt] = __builtin_amdgcn_mfma_f32_16x16x32_bf16(kf, vf, cacc[vt], 0, 0, 0); }
              } }
            asm volatile("s_waitcnt lgkmcnt(0)\n\ts_barrier" ::: "memory");
#pragma unroll
            for (int vt = 0; vt < 5; ++vt) { u32x2 pk; pk.x = cvtpk(cacc[vt][0], cacc[vt][1]); pk.y = cvtpk(cacc[vt][2], cacc[vt][3]); *(LAS u32x2*)(Cs + (16 * vt + c) * RSC + (16 * w + 4 * g) * 2) = pk; }
            if (ch < 15) store_chunk();
            __syncthreads();
        }
    }
}

__device__ __forceinline__ void phase_aprep(unsigned char* lds_, int wv, const Params& p) {
    const Frame F = make_frame(lds_, wv);
    const bf16_t* HO = (const bf16_t*)(p.ws + WS_HOUT); const bf16_t* PR = (const bf16_t*)(p.ws + WS_PROJ); unsigned char* A2 = p.ws + WS_H;
    float hn[16];
#pragma unroll
    for (int i = 0; i < 16; ++i) hn[i] = p.a_h_norm[16 * F.lane + i];
    const int gw = F.bid * NWAVES + F.wave, NGW = F.G * NWAVES;
    for (int rowb = gw; rowb < NTOK; rowb += 4 * NGW) {
        u32x4 h0[4], h1[4], o0[4], o1[4];
#pragma unroll
        for (int rr = 0; rr < 4; ++rr) { const int row = rowb + rr * NGW; if (row < NTOK) {
            h0[rr] = *(const u32x4*)(HO + (size_t)row * DM + 16 * F.lane); h1[rr] = *(const u32x4*)(HO + (size_t)row * DM + 16 * F.lane + 8);
            o0[rr] = *(const u32x4*)(PR + (size_t)row * 3072 + 2048 + 16 * F.lane); o1[rr] = *(const u32x4*)(PR + (size_t)row * 3072 + 2048 + 16 * F.lane + 8); } }
#pragma unroll
        for (int rr = 0; rr < 4; ++rr) { const int row = rowb + rr * NGW; if (row < NTOK) {
            float hv[16], ov[16];
#pragma unroll
            for (int i = 0; i < 4; ++i) { hv[2 * i] = bflo(h0[rr][i]); hv[2 * i + 1] = bfhi(h0[rr][i]); hv[8 + 2 * i] = bflo(h1[rr][i]); hv[8 + 2 * i + 1] = bfhi(h1[rr][i]);
                ov[2 * i] = bflo(o0[rr][i]); ov[2 * i + 1] = bfhi(o0[rr][i]); ov[8 + 2 * i] = bflo(o1[rr][i]); ov[8 + 2 * i + 1] = bfhi(o1[rr][i]); }
            float ss = 0.f;
#pragma unroll
            for (int i = 0; i < 16; ++i) ss += hv[i] * hv[i];
            ss += sx<1>(ss); ss += sx<2>(ss); ss += sx<4>(ss); ss += sx<8>(ss);
            const float r = __builtin_amdgcn_rsqf(ss * (1.0f / 256.0f) + EPS);
            float y[16];
#pragma unroll
            for (int i = 0; i < 16; ++i) y[i] = hv[i] * r * hn[i] * sigmoidf_(ov[i]);
            if (WQ_OUT0 == 2) { float mx = 0.f;
#pragma unroll
                for (int i = 0; i < 16; ++i) mx = fmaxf(mx, fabsf(y[i]));
                mx = fmaxf(wave_max(mx), 1e-20f); const float qs = 127.0f * __builtin_amdgcn_rcpf(mx);
                u32x4 w; w.x = pack4_i8(y[0] * qs, y[1] * qs, y[2] * qs, y[3] * qs); w.y = pack4_i8(y[4] * qs, y[5] * qs, y[6] * qs, y[7] * qs); w.z = pack4_i8(y[8] * qs, y[9] * qs, y[10] * qs, y[11] * qs); w.w = pack4_i8(y[12] * qs, y[13] * qs, y[14] * qs, y[15] * qs);
                *(u32x4*)(A2 + (size_t)row * DM + 16 * F.lane) = w; if (F.lane == 0) ((float*)(p.ws + SC_RS_A))[row] = mx * (1.0f / 127.0f); }
            else if (OUTPROJ_FP8) { u32x4 w; w.x = cvt4_fp8(y[0] * S8_A2, y[1] * S8_A2, y[2] * S8_A2, y[3] * S8_A2); w.y = cvt4_fp8(y[4] * S8_A2, y[5] * S8_A2, y[6] * S8_A2, y[7] * S8_A2);
                w.z = cvt4_fp8(y[8] * S8_A2, y[9] * S8_A2, y[10] * S8_A2, y[11] * S8_A2); w.w = cvt4_fp8(y[12] * S8_A2, y[13] * S8_A2, y[14] * S8_A2, y[15] * S8_A2);
                *(u32x4*)(A2 + (size_t)row * DM + 16 * F.lane) = w; }
            else { bf16_t* a2b = (bf16_t*)(p.ws + WS_A2B) + (size_t)row * DM + 16 * F.lane; u32x4 w0, w1;
                w0.x = cvtpk(y[0], y[1]); w0.y = cvtpk(y[2], y[3]); w0.z = cvtpk(y[4], y[5]); w0.w = cvtpk(y[6], y[7]); w1.x = cvtpk(y[8], y[9]); w1.y = cvtpk(y[10], y[11]); w1.z = cvtpk(y[12], y[13]); w1.w = cvtpk(y[14], y[15]);
                *(u32x4*)a2b = w0; *(u32x4*)(a2b + 8) = w1; }
            } }
    }
}

__device__ __forceinline__ void phase_hprep_router(unsigned char* lds_, int wv, const Params& p, int layer, int xnx, int xdx, int xper, int xj, const unsigned* oflags) {
    const Frame F = make_frame(lds_, wv);
    LAS u32x4* Wf = (LAS u32x4*)F.lds;
    LAS float* mulc = (LAS float*)(F.lds + 65536);
    LAS float* addc = (LAS float*)(F.lds + 65536 + 4096);
    LAS int* cnt = (LAS int*)(F.lds + 73728);
    LAS float* lgs = (LAS float*)(F.lds + 73728 + 64);
    const float* mod = (const float*)(p.ws + WS_MOD) + (size_t)layer * 16 * 6144;
    unsigned char* H = p.ws + WS_H;
    const bf16_t* XB = (const bf16_t*)(p.ws + WS_XB);
    int* blkcnt = (int*)(p.ws + RT_BLKCNT); int* info = (int*)(p.ws + RT_INFO); float* tw = (float*)(p.ws + RT_W);
    if (F.bid == 0) { for (int i = F.tid; i < 256 * DM / 16; i += NTHREADS) *(u32x4*)(H + (size_t)NTOK * DM + i * 16) = (u32x4){0u, 0u, 0u, 0u}; }
    float rb[16];
#pragma unroll
    for (int e = 0; e < 16; ++e) rb[e] = p.router_bias[e];
    const int ctlo = 2 * ((xdx * 128) / xnx), cthi = 2 * (((xdx + 1) * 128) / xnx);
    bool first = true;
    for (int chunk = ctlo + xj; chunk < cthi; chunk += xper) {
        int lane = F.lane; asm volatile("" : "+v"(lane));
        const int fr = lane & 15, fq = lane >> 4;
        const int row = chunk * 128 + F.wave * 16 + fr; const int b = (chunk * 128) / SEQ;
        if (first) { first = false;
            for (int idx = F.tid; idx < 2048; idx += NTHREADS) { const int ln = idx & 63, ks = idx >> 6; const int col0 = 64 * (ks >> 1) + 16 * (ln >> 4) + 8 * (ks & 1);
                const float* wp = p.w_router + (size_t)col0 * 16 + (ln & 15); u32x4 hi, lo;
#pragma unroll
                for (int i = 0; i < 4; ++i) { const float a = wp[(2 * i) * 16], c = wp[(2 * i + 1) * 16]; const unsigned u = cvtpk(a, c); hi[i] = u; lo[i] = cvtpk(a - bflo(u), c - bfhi(u)); }
                Wf[idx] = hi; Wf[2048 + idx] = lo; } }
        for (int c = F.tid; c < DM; c += NTHREADS) { mulc[c] = p.norm2[(size_t)layer * DM + c] * (1.0f + mod[(size_t)b * 6144 + 4096 + c]); addc[c] = mod[(size_t)b * 6144 + 3072 + c]; }
        if (oflags) { unsigned sp = 0u; while (xb_ld((unsigned*)oflags + (chunk >> 1)) < 32u) { __builtin_amdgcn_s_sleep(2); if (++sp > (1u << 22)) break; } asm volatile("" ::: "memory"); }
        u32x4 xv[16][2];
        { const bf16_t* xrow = XB + (size_t)row * DM + 16 * fq;
#pragma unroll
          for (int s = 0; s < 16; ++s) { xv[s][0] = *(const u32x4*)(xrow + 64 * s); xv[s][1] = *(const u32x4*)(xrow + 64 * s + 8); } }
        if (F.tid < 16) cnt[F.tid] = 0;
        __syncthreads();
        float ss = 0.f;
#pragma unroll
        for (int s = 0; s < 16; ++s)
#pragma unroll
            for (int t = 0; t < 2; ++t)
#pragma unroll
                for (int i = 0; i < 4; ++i) { const float a = bflo(xv[s][t][i]), c = bfhi(xv[s][t][i]); ss += a * a + c * c; }
        ss += sx<16>(ss); ss += sx32(ss, lane >= 32);
        const float r = __builtin_amdgcn_rsqf(ss * (1.0f / DM) + EPS);
        f32x4 acc0 = (f32x4){0.f, 0.f, 0.f, 0.f}, acc1 = acc0, acc2 = acc0;
        unsigned char* hrow = H + (size_t)row * DM + 16 * fq;
#pragma unroll
        for (int s = 0; s < 16; ++s) {
            asm volatile("" ::: "memory");
            float h[16];
#pragma unroll
            for (int q = 0; q < 4; ++q) { const f32x4 m = *(const LAS f32x4*)(mulc + 64 * s + 16 * fq + 4 * q), a = *(const LAS f32x4*)(addc + 64 * s + 16 * fq + 4 * q);
                unsigned w0 = xv[s][q >> 1][(q & 1) * 2], w1 = xv[s][q >> 1][(q & 1) * 2 + 1]; asm volatile("" : "+v"(w0), "+v"(w1));
                h[4 * q] = bflo(w0) * r * m[0] + a[0]; h[4 * q + 1] = bfhi(w0) * r * m[1] + a[1]; h[4 * q + 2] = bflo(w1) * r * m[2] + a[2]; h[4 * q + 3] = bfhi(w1) * r * m[3] + a[3]; }
            u32x4 o; o.x = cvt4_fp8(h[0] * S8_H, h[1] * S8_H, h[2] * S8_H, h[3] * S8_H); o.y = cvt4_fp8(h[4] * S8_H, h[5] * S8_H, h[6] * S8_H, h[7] * S8_H);
            o.z = cvt4_fp8(h[8] * S8_H, h[9] * S8_H, h[10] * S8_H, h[11] * S8_H); o.w = cvt4_fp8(h[12] * S8_H, h[13] * S8_H, h[14] * S8_H, h[15] * S8_H);
            *(u32x4*)(hrow + 64 * s) = o;
#pragma unroll
            for (int t = 0; t < 2; ++t) { u32x4 hi, lo;
#pragma unroll
                for (int i = 0; i < 4; ++i) { const float a = h[8 * t + 2 * i], c = h[8 * t + 2 * i + 1]; const unsigned u = cvtpk(a, c); hi[i] = u; lo[i] = cvtpk(a - bflo(u), c - bfhi(u)); }
                const int ks = 2 * s + t;
                const bf16x8 whi = __builtin_bit_cast(bf16x8, Wf[ks * 64 + lane]), wlo = __builtin_bit_cast(bf16x8, Wf[2048 + ks * 64 + lane]);
                const bf16x8 hh = __builtin_bit_cast(bf16x8, hi), hl = __builtin_bit_cast(bf16x8, lo);
                acc0 = __builtin_amdgcn_mfma_f32_16x16x32_bf16(whi, hh, acc0, 0, 0, 0);
                acc1 = __builtin_amdgcn_mfma_f32_16x16x32_bf16(wlo, hh, acc1, 0, 0, 0);
                acc2 = __builtin_amdgcn_mfma_f32_16x16x32_bf16(whi, hl, acc2, 0, 0, 0); }
        }
        { const f32x4 tot = acc0 + (acc1 + acc2);
#pragma unroll
          for (int rr = 0; rr < 4; ++rr) lgs[(F.wave * 16 + fr) * 17 + 4 * fq + rr] = tot[rr]; }
        __syncthreads();
        if (F.tid < 128) {
            const int row = chunk * 128 + F.tid;
            float sc[16], bs[16];
#pragma unroll
            for (int e = 0; e < 16; ++e) { sc[e] = __builtin_amdgcn_rcpf(1.0f + __expf(-lgs[F.tid * 17 + e])); bs[e] = sc[e] + rb[e]; }
            int gsel = 0; float gbest = -INFINITY;
#pragma unroll
            for (int gI = 0; gI < 4; ++gI) { const float a = bs[4 * gI], b2 = bs[4 * gI + 1], c2 = bs[4 * gI + 2], d2 = bs[4 * gI + 3];
                const float hi1 = fmaxf(a, b2), lo1 = fminf(a, b2), hi2 = fmaxf(c2, d2), lo2 = fminf(c2, d2);
                const float top = fmaxf(hi1, hi2), sec = fmaxf(fminf(hi1, hi2), fmaxf(lo1, lo2)); const float gs = top + sec;
                if (gs > gbest) { gbest = gs; gsel = gI; } }
            float v0 = 0.f, v1 = 0.f, v2 = 0.f, v3 = 0.f, s0 = 0.f, s1 = 0.f, s2 = 0.f, s3 = 0.f;
#pragma unroll
            for (int gI = 0; gI < 4; ++gI) if (gI == gsel) { v0 = bs[4 * gI]; v1 = bs[4 * gI + 1]; v2 = bs[4 * gI + 2]; v3 = bs[4 * gI + 3]; s0 = sc[4 * gI]; s1 = sc[4 * gI + 1]; s2 = sc[4 * gI + 2]; s3 = sc[4 * gI + 3]; }
            int i1 = 0; float b1 = v0; if (v1 > b1) { b1 = v1; i1 = 1; } if (v2 > b1) { b1 = v2; i1 = 2; } if (v3 > b1) { b1 = v3; i1 = 3; }
            int i2 = -1; float bb = -INFINITY;
            if (i1 != 0 && v0 > bb) { bb = v0; i2 = 0; } if (i1 != 1 && v1 > bb) { bb = v1; i2 = 1; } if (i1 != 2 && v2 > bb) { bb = v2; i2 = 2; } if (i1 != 3 && v3 > bb) { bb = v3; i2 = 3; }
            const float sa = (i1 == 0) ? s0 : (i1 == 1) ? s1 : (i1 == 2) ? s2 : s3;
            const float sb = (i2 == 0) ? s0 : (i2 == 1) ? s1 : (i2 == 2) ? s2 : s3;
            const int e0 = gsel * 4 + i1, e1 = gsel * 4 + i2;
            const int r0 = __hip_atomic_fetch_add(&cnt[e0], 1, __ATOMIC_RELAXED, __HIP_MEMORY_SCOPE_WORKGROUP); const int r1 = __hip_atomic_fetch_add(&cnt[e1], 1, __ATOMIC_RELAXED, __HIP_MEMORY_SCOPE_WORKGROUP);
            info[row] = e0 | (e1 << 4) | (r0 << 8) | (r1 << 16); const float inv = 1.0f / (sa + sb); *(f32x2*)(tw + (size_t)row * 2) = (f32x2){sa * inv, sb * inv};
        }
        __syncthreads();
        if (F.tid < 16) blkcnt[chunk * 16 + F.tid] = cnt[F.tid];
        __syncthreads();
    }
}

__device__ __forceinline__ void phase_layout(unsigned char* lds_, int wv, const Params& p) {
    const Frame F = make_frame(lds_, wv);
    LAS int* lc = (LAS int*)F.lds;
    LAS int* tot = lc + 4096;
    LAS int* sst = tot + 16;
    LAS int* tst = sst + 16;
    const int* blkcnt = (const int*)(p.ws + RT_BLKCNT); const int* info = (const int*)(p.ws + RT_INFO);
    int* dest = (int*)(p.ws + RT_DEST); int* buftok = (int*)(p.ws + RT_BUFTOK); int* meta = (int*)(p.ws + RT_META);
    for (int i = F.tid; i < 4096; i += NTHREADS) lc[i] = blkcnt[i];
    __syncthreads();
    { const int e = F.tid >> 5, li = F.tid & 31; int v[8]; int s = 0;
      LAS int* part = tst + 32;
#pragma unroll
      for (int k = 0; k < 8; ++k) { v[k] = lc[(8 * li + k) * 16 + e]; s += v[k]; }
      part[e * 32 + li] = s;
      __syncthreads();
      int run = 0, all = 0;
      for (int k = 0; k < 32; ++k) { const int t = part[e * 32 + k]; all += t; if (k < li) run += t; }
#pragma unroll
      for (int k = 0; k < 8; ++k) { lc[(8 * li + k) * 16 + e] = run; run += v[k]; }
      if (li == 31) tot[e] = all; }
    __syncthreads();
    if (F.tid == 0) { int ts = 0; for (int e = 0; e < 16; ++e) { tst[e] = ts; sst[e] = ts * 256; ts += (tot[e] + 255) >> 8; } tst[16] = ts;
        if (F.bid == 0) { meta[0] = ts; for (int e = 0; e <= 16; ++e) meta[1 + e] = tst[e]; } }
    __syncthreads();
    for (int chunk = F.bid; chunk < 256; chunk += F.G) {
        if (F.tid < 128) { const int tok = chunk * 128 + F.tid; const int inf = info[tok]; const int e0 = inf & 15, e1 = (inf >> 4) & 15, r0 = (inf >> 8) & 255, r1 = (inf >> 16) & 255;
            const int d0 = sst[e0] + lc[chunk * 16 + e0] + r0, d1 = sst[e1] + lc[chunk * 16 + e1] + r1;
            buftok[d0] = tok; buftok[d1] = tok; dest[tok * 2] = d0; dest[tok * 2 + 1] = d1; }
    }
    for (int e = F.bid; e < 16; e += F.G) { const int beg = sst[e] + tot[e], end = tst[e + 1] * 256; for (int s = beg + F.tid; s < end; s += NTHREADS) buftok[s] = NTOK; }
}

__device__ __forceinline__ void phase_combine(unsigned char* lds_, int wv, const Params& p, int layer, bool next_prep) {
    const Frame F = make_frame(lds_, wv);
    const float* mod = (const float*)(p.ws + WS_MOD) + (size_t)layer * 16 * 6144;
    const float* modn = (const float*)(p.ws + WS_MOD) + (size_t)(layer + 1) * 16 * 6144;
    const unsigned char* Y = p.ws + WS_PROJ; unsigned char* H = p.ws + WS_H;
    bf16_t* XB = (bf16_t*)(p.ws + WS_XB);
    const int* dest = (const int*)(p.ws + RT_DEST); const float* tw = (const float*)(p.ws + RT_W);
    for (int chunk = F.bid; chunk < 256; chunk += F.G) {
        const int row0 = chunk * 128 + F.wave * 16; const int b = row0 / SEQ;
        f32x4 g2[4];
#pragma unroll
        for (int j = 0; j < 4; ++j) g2[j] = *(const f32x4*)(mod + (size_t)b * 6144 + 5120 + 256 * j + 4 * F.lane) * (1.0f / S8_Y);
        RowConst rc;
        if (next_prep) rc = load_rowconst(p.norm1 + (size_t)(layer + 1) * DM, modn + (size_t)b * 6144, 0, 1024, F.lane);
        for (int rb = 0; rb < 16; rb += 4) {
            int d0[4], d1[4]; float w0[4], w1[4];
#pragma unroll
            for (int rr = 0; rr < 4; ++rr) { const int row = row0 + rb + rr; d0[rr] = dest[row * 2]; d1[rr] = dest[row * 2 + 1]; w0[rr] = tw[row * 2]; w1[rr] = tw[row * 2 + 1]; }
            u32x2 xr[4][4]; unsigned ya[4][4], yb[4][4];
#pragma unroll
            for (int rr = 0; rr < 4; ++rr)
#pragma unroll
                for (int j = 0; j < 4; ++j) { xr[rr][j] = *(const u32x2*)(XB + (size_t)(row0 + rb + rr) * DM + 256 * j + 4 * F.lane);
                    ya[rr][j] = *(const unsigned*)(Y + (size_t)d0[rr] * DM + 256 * j + 4 * F.lane); yb[rr][j] = *(const unsigned*)(Y + (size_t)d1[rr] * DM + 256 * j + 4 * F.lane); }
#pragma unroll
            for (int rr = 0; rr < 4; ++rr) { const int row = row0 + rb + rr;
                f32x4 v[4];
#pragma unroll
                for (int j = 0; j < 4; ++j) { const unsigned a = ya[rr][j], bq = yb[rr][j]; f32x4 yy;
                    const f32x2 a01 = __builtin_amdgcn_cvt_pk_f32_fp8((int)a, false), a23 = __builtin_amdgcn_cvt_pk_f32_fp8((int)a, true), b01 = __builtin_amdgcn_cvt_pk_f32_fp8((int)bq, false), b23 = __builtin_amdgcn_cvt_pk_f32_fp8((int)bq, true);
                    yy[0] = w0[rr] * a01[0] + w1[rr] * b01[0]; yy[1] = w0[rr] * a01[1] + w1[rr] * b01[1]; yy[2] = w0[rr] * a23[0] + w1[rr] * b23[0]; yy[3] = w0[rr] * a23[1] + w1[rr] * b23[1];
                    const f32x4 xv = (f32x4){bflo(xr[rr][j].x), bfhi(xr[rr][j].x), bflo(xr[rr][j].y), bfhi(xr[rr][j].y)};
                    v[j] = xv + g2[j] * yy;
                    if (next_prep) { u32x2 w; w.x = cvtpk(v[j][0], v[j][1]); w.y = cvtpk(v[j][2], v[j][3]); *(u32x2*)(XB + (size_t)row * DM + 256 * j + 4 * F.lane) = w; }
                    else *(f32x4*)(p.out + (size_t)row * DM + 256 * j + 4 * F.lane) = v[j]; }
                if (next_prep) { f32x4 h[4]; row_norm_store8(v, rc, h, H + (size_t)row * DM, F.lane); }
            }
        }
    }
}

__device__ __forceinline__ void phase_qkprep(unsigned char* lds_, int wv, const Params& p) {
    const Frame F = make_frame(lds_, wv);
    bf16_t* PR = (bf16_t*)(p.ws + WS_PROJ);
    const int lane = F.lane, half = lane & 1, sh = lane >> 1;
    float nw[32];
    { const float* nsrc = (sh < 16) ? p.b_q_norm : p.b_k_norm;
#pragma unroll
      for (int i = 0; i < 32; ++i) nw[i] = nsrc[half * 32 + i]; }
    const float qscale = (sh < 16) ? 0.125f * 1.4426950408889634f : 1.0f;
    const float invf_tab[8] = {1.0f, 0.19391788f, 0.037604144f, 0.0072920943f, 0.0014140673f, 0.00027421273f, 5.3174683e-05f, 1.0311522e-05f};
    float invf = 0.f;
#pragma unroll
    for (int i = 0; i < 8; ++i) if ((lane & 7) == i) invf = invf_tab[i];
    const int gw = F.bid * NWAVES + F.wave, NGW = F.G * NWAVES;
    for (int rowb = gw; rowb < NTOK; rowb += 4 * NGW) {
        u32x4 raw[4][4]; int posi[4];
#pragma unroll
        for (int rr = 0; rr < 4; ++rr) { const int row = rowb + rr * NGW; if (row < NTOK) { posi[rr] = p.positions[row]; const bf16_t* ptr = PR + (size_t)row * 3072 + sh * 64 + half * 32;
#pragma unroll
            for (int k = 0; k < 4; ++k) raw[rr][k] = *(const u32x4*)(ptr + 8 * k); } }
#pragma unroll
        for (int rr = 0; rr < 4; ++rr) { const int row = rowb + rr * NGW; if (row < NTOK) {
            const float ang = (float)posi[rr] * invf;
            const double rev = (double)ang * 0.15915494309189535; const float fr = (float)(rev - rint(rev));
            const float cs = __builtin_amdgcn_cosf(fr), sn = __builtin_amdgcn_sinf(fr);
            bf16_t* ptr = PR + (size_t)row * 3072 + sh * 64 + half * 32;
            float v[32];
#pragma unroll
            for (int k = 0; k < 4; ++k)
#pragma unroll
                for (int i = 0; i < 4; ++i) { v[8 * k + 2 * i] = bflo(raw[rr][k][i]); v[8 * k + 2 * i + 1] = bfhi(raw[rr][k][i]); }
            float ss = 0.f;
#pragma unroll
            for (int i = 0; i < 32; ++i) ss += v[i] * v[i];
            ss += sx<1>(ss);
            const float r = 1.0f / sqrtf(ss * (1.0f / 64.0f) + EPS);
#pragma unroll
            for (int i = 0; i < 32; ++i) v[i] = v[i] * r * nw[i];
            float y1[8], y2[8];
#pragma unroll
            for (int i = 0; i < 8; ++i) { const float ci = rdlane(cs, i), si = rdlane(sn, i); y1[i] = v[i] * ci - v[8 + i] * si; y2[i] = v[8 + i] * ci + v[i] * si; }
            if (half == 0) {
#pragma unroll
                for (int i = 0; i < 8; ++i) { v[i] = y1[i]; v[8 + i] = y2[i]; } }
#pragma unroll
            for (int k = 0; k < 4; ++k) { u32x4 o;
#pragma unroll
                for (int i = 0; i < 4; ++i) o[i] = cvtpk(v[8 * k + 2 * i] * qscale, v[8 * k + 2 * i + 1] * qscale);
                *(u32x4*)(ptr + 8 * k) = o; } } }
    }
}

__device__ __forceinline__ void phase_attn(unsigned char* lds_, int wv, const Params& p) {
    const Frame F = make_frame(lds_, wv);
    const bf16_t* PR = (const bf16_t*)(p.ws + WS_PROJ); bf16_t* O4 = (bf16_t*)(p.ws + WS_HOUT) + (size_t)F.bid * 256 * 256;
    unsigned char* A2 = p.ws + WS_H;
    const float lam_init = 0.8f - 0.6f * 0.7408182206817179f;
    const float s1 = wave_sum(p.b_lam_q1[F.lane] * p.b_lam_k1[F.lane]), s2 = wave_sum(p.b_lam_q2[F.lane] * p.b_lam_k2[F.lane]);
    const float lam = expf(s1) - expf(s2) + lam_init;
    const float osc = (WQ_OUT1 == 2) ? A2Q : (1.0f - lam_init) * (OUTPROJ_FP8 ? S8_A2 : 1.0f);
    LAS float* onl = (LAS float*)(F.lds + at2::OFF_OL + 8 * at2::OL_WAVE);
    if (F.tid < 128) onl[F.tid] = p.b_o_norm[F.tid];
    for (int item = F.vcu; item < 256; item += F.G) {
        const int bh = item >> 1, set = item & 1, b = bh >> 3, h = bh & 7;
        const int qlist = set ? 0x1256 : 0x0347;
#define AT2_REF(R, u) do { const int qb_ = (qlist >> (4 * ((u) >> 1))) & 15, c_ = (u) & 1; const size_t r0_ = (size_t)b * SEQ + qb_ * 256; \
        R.Q = PR + r0_ * 3072 + (h * 2 + c_) * 64; R.K = PR + (size_t)b * SEQ * 3072 + 1024 + (h * 2 + c_) * 64; R.V = PR + (size_t)b * SEQ * 3072 + 2048 + h * 128; \
        R.P0 = qb_ * 256; R.to_lds = c_; R.lam = lam; } while (0)
        at2::Seam S; at2::BlockRef cur, nxt;
        AT2_REF(cur, 0);
        __syncthreads();
        at2::prime(cur, (char*)lds_, S, F.tid, wv);
        for (int u = 0; u < 8; ++u) {
            const int un = (u < 7) ? u + 1 : 7;
            AT2_REF(nxt, un);
            at2::block(cur, nxt, (char*)lds_, S, F.tid, wv);
            if (u & 1) {
                asm volatile("s_waitcnt vmcnt(0)" ::: "memory");
                int lane = F.lane; asm volatile("" : "+v"(lane));
                const int half = lane & 1; const int qb = (qlist >> (4 * (u >> 1))) & 15; const size_t row = (size_t)b * SEQ + qb * 256 + wv * 32 + (lane >> 1);
                const LAS unsigned char* pb = F.lds + at2::OFF_OL + wv * at2::OL_WAVE + (lane >> 1) * at2::OL_RS + half * 128;
                u32x4 bq[8];
#pragma unroll
                for (int i = 0; i < 8; ++i) bq[i] = *(const LAS u32x4*)(pb + 16 * i);
                float d[64]; float ss = 0.f;
#pragma unroll
                for (int i = 0; i < 8; ++i)
#pragma unroll
                    for (int j = 0; j < 4; ++j) { d[8 * i + 2 * j] = bflo(bq[i][j]); d[8 * i + 2 * j + 1] = bfhi(bq[i][j]); }
#pragma unroll
                for (int i = 0; i < 64; ++i) ss += d[i] * d[i];
                ss += sx<1>(ss);
                const float r = osc * __builtin_amdgcn_rsqf(ss * (1.0f / 128.0f) + EPS);
                if (WQ_OUT1 == 2) { unsigned char* po = A2 + row * DM + h * 128 + half * 64;
#pragma unroll
                    for (int i = 0; i < 4; ++i) { const f32x4 n0 = *(const LAS f32x4*)(onl + half * 64 + 16 * i), n1 = *(const LAS f32x4*)(onl + half * 64 + 16 * i + 4), n2 = *(const LAS f32x4*)(onl + half * 64 + 16 * i + 8), n3 = *(const LAS f32x4*)(onl + half * 64 + 16 * i + 12);
                        u32x4 w; w.x = pack4_i8(d[16 * i] * r * n0[0], d[16 * i + 1] * r * n0[1], d[16 * i + 2] * r * n0[2], d[16 * i + 3] * r * n0[3]);
                        w.y = pack4_i8(d[16 * i + 4] * r * n1[0], d[16 * i + 5] * r * n1[1], d[16 * i + 6] * r * n1[2], d[16 * i + 7] * r * n1[3]);
                        w.z = pack4_i8(d[16 * i + 8] * r * n2[0], d[16 * i + 9] * r * n2[1], d[16 * i + 10] * r * n2[2], d[16 * i + 11] * r * n2[3]);
                        w.w = pack4_i8(d[16 * i + 12] * r * n3[0], d[16 * i + 13] * r * n3[1], d[16 * i + 14] * r * n3[2], d[16 * i + 15] * r * n3[3]);
                        *(u32x4*)(po + 16 * i) = w; } }
                else if (OUTPROJ_FP8) { unsigned char* po = A2 + row * DM + h * 128 + half * 64;
#pragma unroll
                    for (int i = 0; i < 4; ++i) { const f32x4 n0 = *(const f32x4*)(p.b_o_norm + half * 64 + 16 * i), n1 = *(const f32x4*)(p.b_o_norm + half * 64 + 16 * i + 4), n2 = *(const f32x4*)(p.b_o_norm + half * 64 + 16 * i + 8), n3 = *(const f32x4*)(p.b_o_norm + half * 64 + 16 * i + 12);
                        u32x4 w; w.x = cvt4_fp8(d[16 * i] * r * n0[0], d[16 * i + 1] * r * n0[1], d[16 * i + 2] * r * n0[2], d[16 * i + 3] * r * n0[3]);
                        w.y = cvt4_fp8(d[16 * i + 4] * r * n1[0], d[16 * i + 5] * r * n1[1], d[16 * i + 6] * r * n1[2], d[16 * i + 7] * r * n1[3]);
                        w.z = cvt4_fp8(d[16 * i + 8] * r * n2[0], d[16 * i + 9] * r * n2[1], d[16 * i + 10] * r * n2[2], d[16 * i + 11] * r * n2[3]);
                        w.w = cvt4_fp8(d[16 * i + 12] * r * n3[0], d[16 * i + 13] * r * n3[1], d[16 * i + 14] * r * n3[2], d[16 * i + 15] * r * n3[3]);
                        *(u32x4*)(po + 16 * i) = w; } }
                else { bf16_t* po = (bf16_t*)(p.ws + WS_A2B) + row * DM + h * 128 + half * 64;
#pragma unroll
                    for (int i = 0; i < 8; ++i) { const f32x4 n0 = *(const f32x4*)(p.b_o_norm + half * 64 + 8 * i), n1 = *(const f32x4*)(p.b_o_norm + half * 64 + 8 * i + 4);
                        u32x4 w; w.x = cvtpk(d[8 * i] * r * n0[0], d[8 * i + 1] * r * n0[1]); w.y = cvtpk(d[8 * i + 2] * r * n0[2], d[8 * i + 3] * r * n0[3]);
                        w.z = cvtpk(d[8 * i + 4] * r * n1[0], d[8 * i + 5] * r * n1[1]); w.w = cvtpk(d[8 * i + 6] * r * n1[2], d[8 * i + 7] * r * n1[3]);
                        *(u32x4*)(po + 8 * i) = w; } }
            }
            cur = nxt;
        }
#undef AT2_REF
    }
}

__device__ __forceinline__ void phase_ocombine(unsigned char* lds_, int wv, const Params& p) {
    const Frame F = make_frame(lds_, wv);
    const bf16_t* O4 = (const bf16_t*)(p.ws + WS_HOUT); unsigned char* A2 = p.ws + WS_H;
    const float lam_init = 0.8f - 0.6f * 0.7408182206817179f;
    const float s1 = wave_sum(p.b_lam_q1[F.lane] * p.b_lam_k1[F.lane]), s2 = wave_sum(p.b_lam_q2[F.lane] * p.b_lam_k2[F.lane]);
    const float lam = expf(s1) - expf(s2) + lam_init;
    const int lane = F.lane, hh = lane >> 3, sub = lane & 7, half = sub >> 2, j0 = (sub & 3) * 16;
    float on[16];
#pragma unroll
    for (int i = 0; i < 16; ++i) on[i] = p.b_o_norm[half * 64 + j0 + i] * (1.0f - lam_init) * S8_A2;
    const int gw = F.bid * NWAVES + F.wave, NGW = F.G * NWAVES;
    for (int rowb = gw; rowb < NTOK; rowb += 4 * NGW) {
        u32x4 a0[4], a1[4], b0[4], b1[4];
#pragma unroll
        for (int rr = 0; rr < 4; ++rr) { const int row = rowb + rr * NGW; if (row < NTOK) {
            const bf16_t* pa = O4 + (size_t)row * 2048 + ((hh * 2 + 0) * 2 + half) * 64 + j0; const bf16_t* pb = O4 + (size_t)row * 2048 + ((hh * 2 + 1) * 2 + half) * 64 + j0;
            a0[rr] = *(const u32x4*)pa; a1[rr] = *(const u32x4*)(pa + 8); b0[rr] = *(const u32x4*)pb; b1[rr] = *(const u32x4*)(pb + 8); } }
#pragma unroll
        for (int rr = 0; rr < 4; ++rr) { const int row = rowb + rr * NGW; if (row < NTOK) {
            float d[16];
#pragma unroll
            for (int i = 0; i < 4; ++i) { d[2 * i] = bflo(a0[rr][i]) - lam * bflo(b0[rr][i]); d[2 * i + 1] = bfhi(a0[rr][i]) - lam * bfhi(b0[rr][i]); d[8 + 2 * i] = bflo(a1[rr][i]) - lam * bflo(b1[rr][i]); d[8 + 2 * i + 1] = bfhi(a1[rr][i]) - lam * bfhi(b1[rr][i]); }
            float ss = 0.f;
#pragma unroll
            for (int i = 0; i < 16; ++i) ss += d[i] * d[i];
            ss += sx<1>(ss); ss += sx<2>(ss); ss += sx<4>(ss);
            const float r = 1.0f / sqrtf(ss * (1.0f / 128.0f) + EPS);
            float y[16];
#pragma unroll
            for (int i = 0; i < 16; ++i) y[i] = d[i] * r * on[i];
            u32x4 w; w.x = cvt4_fp8(y[0], y[1], y[2], y[3]); w.y = cvt4_fp8(y[4], y[5], y[6], y[7]); w.z = cvt4_fp8(y[8], y[9], y[10], y[11]); w.w = cvt4_fp8(y[12], y[13], y[14], y[15]);
            *(u32x4*)(A2 + (size_t)row * DM + hh * 128 + half * 64 + j0) = w; } }
    }
}


#ifndef PHASE_MASK
#define PHASE_MASK 0xFFFFFFFFu
#endif
#ifndef PROBE_A
#define PROBE_A (-1)
#endif
#ifndef PROBE_B
#define PROBE_B (0)
#endif
constexpr int STAMP_OFF = LDS_BYTES - 2048;
#define STAMP(k) do { if (PROBE_A >= 0 && blockIdx.x == 0 && STAMP_WAVE == 0 && lane_id() == 0) ((volatile LAS unsigned*)((LAS unsigned char*)lds + STAMP_OFF))[k] = (unsigned)__builtin_amdgcn_s_memrealtime(); } while (0)
#define PH(n) ((PHASE_MASK >> (n)) & 1u)

template <int LAYER>
__device__ __forceinline__ void layer_body(const Params& p, const XcdBarrier& bar, unsigned char* lds) {
    const int STAMP_WAVE = bar.wave; (void)STAMP_WAVE;
    constexpr int SB = (LAYER == 0) ? 4 : 13;
    const int G_ = gridDim.x, bid_ = blockIdx.x; LAS unsigned char* ldsl = (LAS unsigned char*)lds;
#define SEAM() xcd_barrier(bar)
    const float* mod = (const float*)(p.ws + WS_MOD);
    LAS int* tab = (LAS int*)(ldsl + TAB_OFF);
    if (PH(2)) { pg8::StaticOrder S; S.init(NTOK, 3072, G_, bid_);
      if (LAYER == 0) {
        if (WQ_IN0 == 2) { pg8::EpiProjI8 E{(bf16_t*)(p.ws + WS_PROJ), (const float*)(p.ws + SC_RS_H), (const float*)(p.ws + SC_CW) + CW_AIN, 0.08838834764831845f};
          pg8::gemm_phase<pg8::EpiProjI8, pg8::StaticOrder, false, true>(ldsl, bar.wave, (const bf16_t*)(p.ws + WS_H), (const bf16_t*)(p.ws + WS_WAIN), 0, 512, S, E, nullptr); }
        else { pg8::EpiBf16 E{(bf16_t*)(p.ws + WS_PROJ), 3072, 2, 4, 0.08838834764831845f, WQ_IN0 == 1 ? 1.0f / (S8_H * S8_WIN) : 1.0f};
          if (WQ_IN0 == 1) pg8::gemm_phase8<pg8::EpiBf16, pg8::StaticOrder, false>(ldsl, bar.wave, p.ws + WS_H, p.ws + WS_WAIN, 0, 1024, S, E, nullptr);
          else pg8::gemm_phase<pg8::EpiBf16, pg8::StaticOrder, false>(ldsl, bar.wave, (const bf16_t*)(p.ws + WS_H), (const bf16_t*)(p.ws + WS_WAIN_BF), 0, 1024, S, E, nullptr); } }
      else { pg8::EpiQKV E{(bf16_t*)(p.ws + WS_PROJ), p.b_q_norm, p.b_k_norm, (const float*)(p.ws + WS_CS), 1.0f / (S8_H * S8_WIN), (const LAS float*)(ldsl + TAB_OFF)};
        pg8::gemm_phase8<pg8::EpiQKV, pg8::StaticOrder, false>(ldsl, bar.wave, p.ws + WS_H, p.ws + WS_WBIN, 0, 1024, S, E, nullptr); } }
    SEAM(); STAMP(SB + 0);
    if (LAYER == 0) {
        if (PH(3)) phase_mlstm(lds, bar.wave, p);
        SEAM(); STAMP(SB + 1);
        if (PH(4)) phase_aprep(lds, bar.wave, p);
    } else {
        STAMP(SB + 1);
        if (PH(6)) phase_attn(lds, bar.wave, p);
        STAMP(SB + 2);
    }
    SEAM(); STAMP(SB + 2 + LAYER);
    unsigned* oflags = (unsigned*)p.ws + CW_OFLAGS + LAYER * 128;
    const int xper = (int)bar.st[0], xnx = (int)bar.st[1], xdx = (int)bar.st[2], xj = (int)bar.st[3];
    constexpr bool OCHAIN = (LAYER == 0) ? (WQ_OUT0 == 2) : (WQ_OUT1 == 2);
    if (PH(8)) { pg8::StaticOrder S; S.init(NTOK, 1024, G_, bid_);
      pg8::XcdOrder SX{xnx, xdx, xper, xj, NTOK / 256, 4, oflags};
      if (LAYER == 0 && WQ_OUT0 == 2) { pg8::EpiResidB<true, true> E{(const void*)p.x, (bf16_t*)(p.ws + WS_XB), mod + 2048, 1.0f, (const float*)(p.ws + WS_SCALES)};
        pg8::gemm_phase<pg8::EpiResidB<true, true>, pg8::XcdOrder, false, true>(ldsl, bar.wave, (const bf16_t*)(p.ws + WS_H), (const bf16_t*)(p.ws + WS_WAOUT), 0, 512, SX, E, nullptr); }
      else if (LAYER == 1 && WQ_OUT1 == 2) { pg8::EpiResidB<false, true, true> E{(const void*)(p.ws + WS_XB), (bf16_t*)(p.ws + WS_XB), mod + (size_t)16 * 6144 + 2048, (1.0f - (0.8f - 0.6f * 0.7408182206817179f)) / A2Q, (const float*)(p.ws + WS_SCALES)};
        pg8::gemm_phase<pg8::EpiResidB<false, true, true>, pg8::XcdOrder, false, true>(ldsl, bar.wave, (const bf16_t*)(p.ws + WS_H), (const bf16_t*)(p.ws + WS_WBOUT), 0, 512, SX, E, nullptr); }
      else { pg8::EpiResidB<LAYER == 0> E{LAYER == 0 ? (const void*)p.x : (const void*)(p.ws + WS_XB), (bf16_t*)(p.ws + WS_XB), mod + (size_t)LAYER * 16 * 6144 + 2048, OUTPROJ_FP8 ? 1.0f / (S8_A2 * S8_WOUT) : 1.0f, nullptr};
        if (OUTPROJ_FP8) pg8::gemm_phase8<pg8::EpiResidB<LAYER == 0>, pg8::StaticOrder, false>(ldsl, bar.wave, p.ws + WS_H, p.ws + (LAYER == 0 ? WS_WAOUT : WS_WBOUT), 0, 1024, S, E, nullptr);
        else pg8::gemm_phase<pg8::EpiResidB<LAYER == 0>, pg8::StaticOrder, false>(ldsl, bar.wave, (const bf16_t*)(p.ws + WS_A2B), (const bf16_t*)(p.ws + (LAYER == 0 ? WS_WAOUT_BF : WS_WBOUT_BF)), 0, 1024, S, E, nullptr); } }
    if (!OCHAIN) SEAM();
    STAMP(SB + 3 + LAYER);
    if (PH(9)) phase_hprep_router(lds, bar.wave, p, LAYER, xnx, xdx, xper, xj, OCHAIN ? oflags : nullptr);
    SEAM(); STAMP(SB + 4 + LAYER);
    if (PH(10)) phase_layout(lds, bar.wave, p);
    SEAM(); STAMP(SB + 5 + LAYER);
    if (PH(11)) { const int* meta = (const int*)(p.ws + RT_META);
      __syncthreads();
      { const int t_ = bar.wave * 64 + lane_id(); if (t_ < 17) tab[t_] = meta[1 + t_]; }
      __syncthreads();
      unsigned* flags = (unsigned*)p.ws + CW_FLAGS + LAYER * 512;
      const int xper = (int)bar.st[0], xnx = (int)bar.st[1], xdx = (int)bar.st[2], xj = (int)bar.st[3];
      pg8::MoeOrder S{xnx, xdx, xper, xj, tab[16], tab, flags};
      pg8::EpiSwiGLU8 E1{p.ws + WS_HOUT, 1.0f / (S8_H * S8_WGU), flags};
      pg8::gemm_phase8<pg8::EpiSwiGLU8, pg8::MoeOrder, true>(ldsl, bar.wave, p.ws + WS_H, p.ws + WS_WGU + (size_t)LAYER * 16 * 1024 * 1024, (size_t)1024 * 1024, 1024, S, E1, (const int*)(p.ws + RT_BUFTOK));
      STAMP(SB + 6 + LAYER);
      pg8::MoeOrderWait S2{xnx, xdx, xper, xj, tab[16], tab, flags};
      pg8::EpiFp8 E2{p.ws + WS_PROJ, 1024, S8_Y / (S8_ACT * S8_WDN)};
      pg8::gemm_phase8<pg8::EpiFp8, pg8::MoeOrderWait, false>(ldsl, bar.wave, p.ws + WS_HOUT, p.ws + WS_WDN + (size_t)LAYER * 16 * 1024 * 512, (size_t)1024 * 512, 512, S2, E2, nullptr); }
    SEAM(); STAMP(SB + 7 + LAYER);
    if (PH(12)) phase_combine(lds, bar.wave, p, LAYER, LAYER == 0);
#undef SEAM
}
__global__ void __launch_bounds__(NTHREADS, 2) mk_fwd(Params p) {
    extern __shared__ __attribute__((aligned(16))) unsigned char lds[];
    cg::grid_group grid = cg::this_grid();
    volatile LAS unsigned* misc = (volatile LAS unsigned*)((LAS unsigned char*)lds + MISC_OFF);
    const int wv0 = __builtin_amdgcn_readfirstlane((int)threadIdx.x >> 6);
    if (threadIdx.x < 32) misc[threadIdx.x] = 0u;
    __syncthreads();
    unsigned* ctl = (unsigned*)p.ws;
    XcdBarrier bar = xcd_barrier_post(ctl + CW_BAR, misc + 8, wv0);
    const int STAMP_WAVE = wv0; (void)STAMP_WAVE;
    STAMP(0);
    if (PH(0)) phase_mod(lds, bar.wave, p);
    __syncthreads();
    STAMP(1);
    if (PH(0)) { phase_wconv(lds, bar.wave, p); __syncthreads(); phase_wconv_pw(lds, bar.wave, p); }
    __syncthreads();
    if (wv0 == 0 && lane_id() == 0) { unsigned sp = 0u; while (xb_ld(ctl + CW_MODCNT) < 192u) { __builtin_amdgcn_s_sleep(4); if (++sp > (1u << 22)) break; }
        __builtin_amdgcn_fence(__ATOMIC_ACQUIRE, "agent"); asm volatile("s_waitcnt vmcnt(0)" ::: "memory"); }
    __syncthreads(); STAMP(2);
    if (PH(1)) phase_hprep0(lds, bar.wave, p);
    grid.sync(); STAMP(3);
    layer_body<0>(p, bar, lds);
    xcd_barrier(bar); STAMP(12);
    layer_body<1>(p, bar, lds);
    STAMP(22);
    if (PROBE_A >= 0 && blockIdx.x == 0 && STAMP_WAVE == 0 && lane_id() == 0) {
        volatile LAS unsigned* ts = (volatile LAS unsigned*)((LAS unsigned char*)lds + STAMP_OFF);
        const unsigned dA = ts[PROBE_A + 1] - ts[PROBE_A], dB = ts[PROBE_B + 1] - ts[PROBE_B];
        const unsigned long long extra = 100ull * ((unsigned long long)(dA / 100u) + 1024ull * (dB / 100u)), t0 = __builtin_amdgcn_s_memrealtime();
        while (__builtin_amdgcn_s_memrealtime() - t0 < extra) __builtin_amdgcn_s_sleep(32);
    }
    if (xb_ld(ctl + CW_BAR + XB_TMO) != 0u) { __syncthreads(); for (size_t i = (size_t)blockIdx.x * NTHREADS + (wv0 * 64 + lane_id()); i < (size_t)NTOK * DM / 4; i += (size_t)gridDim.x * NTHREADS) ((f32x4*)p.out)[i] = (f32x4){1e30f, 1e30f, 1e30f, 1e30f}; }
}

extern "C" void kernel_launch(void* const* d_in, const int* in_sizes, int n_in, void* d_out, int out_size, void* d_ws, size_t ws_size, hipStream_t stream) {
    static int grid_blocks = 0;
    if (!grid_blocks) {
        int dev = 0, cus = 0, per_cu = 0;
        (void)hipGetDevice(&dev);
        (void)hipDeviceGetAttribute(&cus, hipDeviceAttributeMultiprocessorCount, dev);
        (void)hipFuncSetAttribute((const void*)mk_fwd, hipFuncAttributeMaxDynamicSharedMemorySize, LDS_BYTES);
        (void)hipOccupancyMaxActiveBlocksPerMultiprocessor(&per_cu, (const void*)mk_fwd, NTHREADS, LDS_BYTES);
        if (per_cu < 1) { fprintf(stderr, "kernel_launch: occupancy query reports %d blocks/CU\n", per_cu); per_cu = 1; }
        grid_blocks = cus;
        if (ws_size < WS_END || n_in != 24) fprintf(stderr, "kernel_launch: unexpected ws_size %zu (need %zu) or n_in %d\n", ws_size, (size_t)WS_END, n_in);
    }
    (void)hipMemsetAsync(d_ws, 0, CTL_BYTES, stream);
    Params p{};
    const float** pf = (const float**)&p;
    p.x = (const float*)d_in[0]; p.c = (const float*)d_in[1]; p.positions = (const int*)d_in[2]; p.norm1 = (const float*)d_in[3]; p.norm2 = (const float*)d_in[4];
    p.w_ada = (const float*)d_in[5]; p.b_ada = (const float*)d_in[6]; p.a_w_in = (const float*)d_in[7]; p.a_b_if = (const float*)d_in[8]; p.a_h_norm = (const float*)d_in[9];
    p.a_w_out = (const float*)d_in[10]; p.b_w_in = (const float*)d_in[11]; p.b_q_norm = (const float*)d_in[12]; p.b_k_norm = (const float*)d_in[13];
    p.b_lam_q1 = (const float*)d_in[14]; p.b_lam_k1 = (const float*)d_in[15]; p.b_lam_q2 = (const float*)d_in[16]; p.b_lam_k2 = (const float*)d_in[17];
    p.b_o_norm = (const float*)d_in[18]; p.b_w_out = (const float*)d_in[19]; p.w_router = (const float*)d_in[20]; p.router_bias = (const float*)d_in[21];
    p.moe_w_gu = (const float*)d_in[22]; p.moe_w_down = (const float*)d_in[23];
    p.out = (float*)d_out; p.ws = (unsigned char*)d_ws; (void)pf;
    void* args[] = {&p};
    hipError_t e = hipLaunchCooperativeKernel((const void*)mk_fwd, dim3(grid_blocks), dim3(NTHREADS), args, LDS_BYTES, stream);
    if (e != hipSuccess) fprintf(stderr, "cooperative launch failed: %s (grid %d)\n", hipGetErrorString(e), grid_blocks);
}
```
